# Optimizing an MI355X kernel written in HIP

```python
import math
import jax
import jax.numpy as jnp
from jax import lax
import numpy as np

D_MODEL = 1024
BATCH = 8
SEQ = 2048
DEPTH = 1
DEC_BATCH = 128
DEC_SEQ = 8
PAST_LEN = 16384
PAGE_SIZE = 128

RW_HEAD = 64
RW_HEADS = D_MODEL // 128
RW_DIM = RW_HEADS * RW_HEAD
RW_DECAY_LORA = 64
RW_A_LORA = 64
RW_GATE_LORA = 128
RW_LN_EPS = 64e-5
RW_COLS = 3 * RW_DIM + RW_DECAY_LORA + RW_A_LORA + RW_GATE_LORA
SSM_DIM = D_MODEL
SSM_HEAD = 64
SSM_HEADS = SSM_DIM // SSM_HEAD
SSM_GROUPS = 2
SSM_STATE = 128
SSM_CONV = 4
SSM_CHUNK = 128
SSM_CONV_DIM = SSM_DIM + 2 * SSM_GROUPS * SSM_STATE
SSM_COLS = SSM_DIM + SSM_CONV_DIM + SSM_HEADS
GATE_COLS = 2 * D_MODEL
IN_COLS = RW_COLS + SSM_COLS + GATE_COLS
PEER_HEADS = 8
PEER_NKEYS = 128
PEER_EXPERTS = PEER_NKEYS * PEER_NKEYS
PEER_TOPK = 16
PEER_DKEY = 256
PEER_BLOCK = 128
NORM_EPS = 1e-6

kernel_name = 'rwkv7_mamba2_peer_hybrid_step'


def _rmsnorm(x, g):
    xf = x.astype(jnp.float32)
    y = xf * lax.rsqrt(jnp.mean(xf * xf, axis=-1, keepdims=True) + NORM_EPS)
    return (y * g.astype(jnp.float32)).astype(x.dtype)


def _seg_decay(a):
    L = a.shape[-1]
    cs = jnp.cumsum(a, axis=-1)
    seg = cs[..., :, None] - cs[..., None, :]
    mask = jnp.tril(jnp.ones((L, L), dtype=bool))
    return jnp.exp(jnp.where(mask, seg, -jnp.inf))


def _rwkv7(p, p_prev, s0, mu, w0, w2, a0, a2, g2, k_k, k_a, r_k, ln_w, ln_b):
    f32 = jnp.float32
    B, T, _ = p.shape
    prev = jnp.concatenate([p_prev[:, None], p[:, :-1]], axis=1)
    q = p + (prev - p) * mu
    o = 0
    r = q[..., o:o + RW_DIM]; o += RW_DIM
    k = q[..., o:o + RW_DIM]; o += RW_DIM
    v = q[..., o:o + RW_DIM]; o += RW_DIM
    lw = q[..., o:o + RW_DECAY_LORA]; o += RW_DECAY_LORA
    la = q[..., o:o + RW_A_LORA]; o += RW_A_LORA
    lg = q[..., o:o + RW_GATE_LORA]
    w = -jax.nn.softplus(-(w0 + jnp.tanh(lw) @ w2).astype(f32)) - 0.5
    decay = jnp.exp(-jnp.exp(w))
    a = jax.nn.sigmoid((a0 + la @ a2).astype(f32))
    g = (jax.nn.sigmoid(lg) @ g2).astype(f32)
    hs = lambda t: t.reshape(B, T, RW_HEADS, RW_HEAD).astype(f32)
    r, k, v, decay, a = hs(r), hs(k), hs(v), hs(decay), hs(a)
    kk = k * k_k.reshape(RW_HEADS, RW_HEAD).astype(f32)
    kk = kk / jnp.maximum(jnp.sqrt(jnp.sum(kk * kk, axis=-1, keepdims=True)), 1e-12)
    k = k * (1.0 + (a - 1.0) * k_a.reshape(RW_HEADS, RW_HEAD).astype(f32))

    def step(S, inp):
        r_t, d_t, k_t, v_t, kk_t, b_t = inp
        sk = jnp.einsum('bhvk,bhk->bhv', S, kk_t)
        S = S * d_t[:, :, None, :] - sk[..., None] * b_t[:, :, None, :] + v_t[..., None] * k_t[:, :, None, :]
        return S, jnp.einsum('bhvk,bhk->bhv', S, r_t)

    tm = lambda t: jnp.moveaxis(t, 1, 0)
    sT, y = lax.scan(step, s0.astype(f32), (tm(r), tm(decay), tm(k), tm(v), tm(kk), tm(kk * a)))
    y = jnp.moveaxis(y, 0, 1)
    mean = jnp.mean(y, axis=-1, keepdims=True)
    var = jnp.mean(jnp.square(y - mean), axis=-1, keepdims=True)
    yn = ((y - mean) * lax.rsqrt(var + RW_LN_EPS)).reshape(B, T, RW_DIM)
    yn = yn * ln_w.astype(f32) + ln_b.astype(f32)
    bonus = (jnp.sum(r * k * r_k.astype(f32), axis=-1, keepdims=True) * v).reshape(B, T, RW_DIM)
    out = ((yn + bonus) * g).astype(p.dtype)
    return out, sT.astype(s0.dtype)


def _ssd(X, dA, Bm, Cm, h0):
    Bsz, T, H, P = X.shape
    G, N = Bm.shape[2], Bm.shape[3]
    J = H // G
    L = math.gcd(T, SSM_CHUNK)
    nc = T // L
    X = X.reshape(Bsz, nc, L, G, J, P)
    a = jnp.transpose(dA.reshape(Bsz, nc, L, G, J), (0, 3, 4, 1, 2))
    Bc = Bm.reshape(Bsz, nc, L, G, N)
    Cc = Cm.reshape(Bsz, nc, L, G, N)
    cs = jnp.cumsum(a, axis=-1)
    cb = jnp.einsum('bclgn,bcsgn->bgcls', Cc, Bc)
    y_diag = jnp.einsum('bgcls,bgjcls,bcsgjp->bclgjp', cb, _seg_decay(a), X)
    decay_states = jnp.exp(cs[..., -1:] - cs)
    states = jnp.einsum('bclgn,bgjcl,bclgjp->bcgjpn', Bc, decay_states, X)
    states = jnp.concatenate([h0.reshape(Bsz, 1, G, J, P, N), states], axis=1)
    chunk_a = jnp.pad(cs[..., -1], ((0, 0), (0, 0), (0, 0), (1, 0)))
    new_states = jnp.einsum('bgjzc,bcgjpn->bzgjpn', _seg_decay(chunk_a), states)
    y_off = jnp.einsum('bclgn,bcgjpn,bgjcl->bclgjp', Cc, new_states[:, :-1], jnp.exp(cs))
    y = (y_diag + y_off).reshape(Bsz, T, H, P)
    return y, new_states[:, -1].reshape(Bsz, H, P, N)


def _mamba2(p, conv_buf, h0, conv_w, conv_b, dt_bias, A_log, D_skip, norm_w):
    f32 = jnp.float32
    B, T, _ = p.shape
    z = p[..., :SSM_DIM]
    xbc = p[..., SSM_DIM:SSM_DIM + SSM_CONV_DIM]
    dt = p[..., SSM_DIM + SSM_CONV_DIM:]
    full = jnp.concatenate([conv_buf.astype(p.dtype), xbc], axis=1)
    new_buf = full[:, -(SSM_CONV - 1):]
    conv = conv_b + full[:, 0:T] * conv_w[0]
    for j in range(1, SSM_CONV):
        conv = conv + full[:, j:j + T] * conv_w[j]
    xbc = jax.nn.silu(conv)
    gn = SSM_GROUPS * SSM_STATE
    xs = xbc[..., :SSM_DIM].reshape(B, T, SSM_HEADS, SSM_HEAD).astype(f32)
    Bm = xbc[..., SSM_DIM:SSM_DIM + gn].reshape(B, T, SSM_GROUPS, SSM_STATE).astype(f32)
    Cm = xbc[..., SSM_DIM + gn:].reshape(B, T, SSM_GROUPS, SSM_STATE).astype(f32)
    dt = jax.nn.softplus((dt + dt_bias).astype(f32))
    A = -jnp.exp(A_log.astype(f32))
    y, hT = _ssd(xs * dt[..., None], dt * A, Bm, Cm, h0.astype(f32))
    y = y + xs * D_skip.astype(f32)[:, None]
    y = y.reshape(B, T, SSM_DIM) * jax.nn.silu(z.astype(f32))
    yg = y.reshape(B, T, SSM_GROUPS, SSM_DIM // SSM_GROUPS)
    yg = yg * lax.rsqrt(jnp.mean(yg * yg, axis=-1, keepdims=True) + NORM_EPS)
    out = (yg.reshape(B, T, SSM_DIM) * norm_w.astype(f32)).astype(p.dtype)
    return out, new_buf.astype(conv_buf.dtype), hT.astype(h0.dtype)


def _peer(xn, wq, keys, u, v):
    B, T, D = xn.shape
    n = B * T
    n_pad = -(-n // PEER_BLOCK) * PEER_BLOCK
    xt = jnp.pad(xn.reshape(n, D), ((0, n_pad - n), (0, 0))).reshape(n_pad // PEER_BLOCK, PEER_BLOCK, D)

    def block(xb):
        q = (xb @ wq).reshape(PEER_BLOCK, PEER_HEADS, 2, PEER_DKEY // 2)
        s = jnp.einsum('thpd,hpkd->thpk', q, keys).astype(jnp.float32)
        s1, i1 = lax.top_k(s[:, :, 0], PEER_TOPK)
        s2, i2 = lax.top_k(s[:, :, 1], PEER_TOPK)
        cand = (s1[..., :, None] + s2[..., None, :]).reshape(PEER_BLOCK, PEER_HEADS, PEER_TOPK * PEER_TOPK)
        sc, ic = lax.top_k(cand, PEER_TOPK)
        e1 = jnp.take_along_axis(i1, ic // PEER_TOPK, axis=-1)
        e2 = jnp.take_along_axis(i2, ic % PEER_TOPK, axis=-1)
        idx = e1 * PEER_NKEYS + e2
        gate = jax.nn.softmax(sc, axis=-1)
        act = jax.nn.gelu(jnp.einsum('td,thkd->thk', xb, u[idx]).astype(jnp.float32), approximate=False)
        return jnp.einsum('thk,thkd->td', (gate * act).astype(xb.dtype), v[idx])

    out = lax.map(block, xt)
    return out.reshape(n_pad, D)[:n].reshape(B, T, D)


def _layer(x, c, shift0, wkv0, conv0, ssm0, lp):
    f32 = jnp.float32
    mod = jax.nn.silu(c) @ lp['w_ada'] + lp['b_ada']
    sh1, sc1, gt1, sh2, sc2, gt2 = jnp.split(mod, 6, axis=-1)
    xn = _rmsnorm(x, lp['norm1_g']) * (1 + sc1[:, None]) + sh1[:, None]
    proj = xn @ lp['w_in']
    p_rw = proj[..., :RW_COLS]
    p_ssm = proj[..., RW_COLS:RW_COLS + SSM_COLS]
    p_gate = proj[..., RW_COLS + SSM_COLS:]
    p_prev = shift0.astype(x.dtype) @ lp['w_in'][:, :RW_COLS]
    o_a, wkvT = _rwkv7(p_rw, p_prev, wkv0, lp['rw_mu'], lp['rw_w0'], lp['rw_w2'], lp['rw_a0'], lp['rw_a2'],
                       lp['rw_g2'], lp['rw_k_k'], lp['rw_k_a'], lp['rw_r_k'], lp['rw_ln_w'], lp['rw_ln_b'])
    o_b, convT, ssmT = _mamba2(p_ssm, conv0, ssm0, lp['ssm_conv_w'], lp['ssm_conv_b'], lp['ssm_dt_bias'],
                               lp['ssm_A_log'], lp['ssm_D'], lp['ssm_norm_w'])
    g = jax.nn.sigmoid(p_gate.astype(f32)).astype(x.dtype)
    merged = g[..., :D_MODEL] * (o_a @ lp['w_pa']) + g[..., D_MODEL:] * (o_b @ lp['w_pb'])
    x = x + gt1[:, None] * (merged @ lp['w_out'])
    xn2 = _rmsnorm(x, lp['norm2_g']) * (1 + sc2[:, None]) + sh2[:, None]
    x = x + gt2[:, None] * _peer(xn2, lp['peer_wq'], lp['peer_keys'], lp['peer_u'], lp['peer_v'])
    return x, xn[:, -1].astype(shift0.dtype), wkvT, convT, ssmT


def _trunk(x, c, shift, wkv, conv, ssm, params, final_g, w_ada_f, b_ada_f):
    n_sh, n_wkv, n_conv, n_ssm = [], [], [], []
    for l in range(DEPTH):
        lp = {name: arr[l] for name, arr in params.items()}
        x, s_sh, s_wkv, s_conv, s_ssm = _layer(x, c, shift[l], wkv[l], conv[l], ssm[l], lp)
        n_sh.append(s_sh); n_wkv.append(s_wkv); n_conv.append(s_conv); n_ssm.append(s_ssm)
    fm = jax.nn.silu(c) @ w_ada_f + b_ada_f
    shf, scf = jnp.split(fm, 2, axis=-1)
    y = _rmsnorm(x, final_g) * (1 + scf[:, None]) + shf[:, None]
    return y, jnp.stack(n_sh), jnp.stack(n_wkv), jnp.stack(n_conv), jnp.stack(n_ssm)


def setup_inputs(seed: int = 0) -> dict:
    key = jax.random.key(seed)
    ks = iter(jax.random.split(key, 48))
    f32 = jnp.float32
    nrm = lambda shape, scale: jax.random.normal(next(ks), shape, f32) * scale
    uni = lambda shape, lo, hi: jax.random.uniform(next(ks), shape, f32, lo, hi)
    L = DEPTH
    dt0 = jnp.exp(uni((L, SSM_HEADS), math.log(1e-3), math.log(1e-1)))
    return {
        'x_prompt': nrm((BATCH, SEQ, D_MODEL), 1.0),
        'x_sample': nrm((DEC_BATCH, DEC_SEQ, D_MODEL), 1.0),
        'c_prompt': nrm((BATCH, D_MODEL), 1.0),
        'c_sample': nrm((DEC_BATCH, D_MODEL), 1.0),
        'state_shift': nrm((L, DEC_BATCH, D_MODEL), 1.0),
        'state_wkv': nrm((L, DEC_BATCH, RW_HEADS, RW_HEAD, RW_HEAD), 0.3),
        'state_conv': nrm((L, DEC_BATCH, SSM_CONV - 1, SSM_CONV_DIM), 1.0),
        'state_ssm': nrm((L, DEC_BATCH, SSM_HEADS, SSM_HEAD, SSM_STATE), 0.1),
        'w_ada': nrm((L, D_MODEL, 6 * D_MODEL), 0.5 * D_MODEL ** -0.5),
        'b_ada': nrm((L, 6 * D_MODEL), 0.01),
        'norm1_g': 1.0 + nrm((L, D_MODEL), 0.02),
        'w_in': nrm((L, D_MODEL, IN_COLS), D_MODEL ** -0.5),
        'rw_mu': uni((L, RW_COLS), 0.0, 1.0),
        'rw_w0': uni((L, RW_DIM), -3.0, 0.0),
        'rw_w2': nrm((L, RW_DECAY_LORA, RW_DIM), 0.5 * RW_DECAY_LORA ** -0.5),
        'rw_a0': nrm((L, RW_DIM), 0.1),
        'rw_a2': nrm((L, RW_A_LORA, RW_DIM), 0.5 * RW_A_LORA ** -0.5),
        'rw_g2': nrm((L, RW_GATE_LORA, RW_DIM), RW_GATE_LORA ** -0.5),
        'rw_k_k': 0.85 + nrm((L, RW_DIM), 0.1),
        'rw_k_a': 1.0 + nrm((L, RW_DIM), 0.1),
        'rw_r_k': nrm((L, RW_HEADS, RW_HEAD), 0.1),
        'rw_ln_w': 1.0 + nrm((L, RW_DIM), 0.02),
        'rw_ln_b': nrm((L, RW_DIM), 0.01),
        'ssm_conv_w': nrm((L, SSM_CONV, SSM_CONV_DIM), 0.5),
        'ssm_conv_b': nrm((L, SSM_CONV_DIM), 0.01),
        'ssm_dt_bias': dt0 + jnp.log(-jnp.expm1(-dt0)),
        'ssm_A_log': jnp.log(uni((L, SSM_HEADS), 1.0, 16.0)),
        'ssm_D': 1.0 + nrm((L, SSM_HEADS), 0.1),
        'ssm_norm_w': 1.0 + nrm((L, SSM_DIM), 0.02),
        'w_pa': nrm((L, RW_DIM, D_MODEL), RW_DIM ** -0.5),
        'w_pb': nrm((L, SSM_DIM, D_MODEL), SSM_DIM ** -0.5),
        'w_out': nrm((L, D_MODEL, D_MODEL), D_MODEL ** -0.5),
        'norm2_g': 1.0 + nrm((L, D_MODEL), 0.02),
        'peer_wq': nrm((L, D_MODEL, PEER_HEADS * PEER_DKEY), D_MODEL ** -0.5),
        'peer_keys': nrm((L, PEER_HEADS, 2, PEER_NKEYS, PEER_DKEY // 2), (PEER_DKEY // 2) ** -0.5),
        'peer_u': nrm((L, PEER_EXPERTS, D_MODEL), D_MODEL ** -0.5),
        'peer_v': nrm((L, PEER_EXPERTS, D_MODEL), PEER_HEADS ** -0.5),
        'final_g': 1.0 + nrm((D_MODEL,), 0.02),
        'w_ada_f': nrm((D_MODEL, 2 * D_MODEL), 0.5 * D_MODEL ** -0.5),
        'b_ada_f': nrm((2 * D_MODEL,), 0.01),
    }


def reference(x_prompt, x_sample, c_prompt, c_sample, state_shift, state_wkv, state_conv, state_ssm,
              w_ada, b_ada, norm1_g, w_in, rw_mu, rw_w0, rw_w2, rw_a0, rw_a2, rw_g2, rw_k_k, rw_k_a, rw_r_k,
              rw_ln_w, rw_ln_b, ssm_conv_w, ssm_conv_b, ssm_dt_bias, ssm_A_log, ssm_D, ssm_norm_w,
              w_pa, w_pb, w_out, norm2_g, peer_wq, peer_keys, peer_u, peer_v, final_g, w_ada_f, b_ada_f):
    params = {
        'w_ada': w_ada, 'b_ada': b_ada, 'norm1_g': norm1_g, 'w_in': w_in,
        'rw_mu': rw_mu, 'rw_w0': rw_w0, 'rw_w2': rw_w2, 'rw_a0': rw_a0, 'rw_a2': rw_a2, 'rw_g2': rw_g2,
        'rw_k_k': rw_k_k, 'rw_k_a': rw_k_a, 'rw_r_k': rw_r_k, 'rw_ln_w': rw_ln_w, 'rw_ln_b': rw_ln_b,
        'ssm_conv_w': ssm_conv_w, 'ssm_conv_b': ssm_conv_b, 'ssm_dt_bias': ssm_dt_bias,
        'ssm_A_log': ssm_A_log, 'ssm_D': ssm_D, 'ssm_norm_w': ssm_norm_w,
        'w_pa': w_pa, 'w_pb': w_pb, 'w_out': w_out, 'norm2_g': norm2_g,
        'peer_wq': peer_wq, 'peer_keys': peer_keys, 'peer_u': peer_u, 'peer_v': peer_v,
    }
    Bp = x_prompt.shape[0]
    dt = x_prompt.dtype
    z_shift = jnp.zeros((DEPTH, Bp, D_MODEL), dt)
    z_wkv = jnp.zeros((DEPTH, Bp, RW_HEADS, RW_HEAD, RW_HEAD), dt)
    z_conv = jnp.zeros((DEPTH, Bp, SSM_CONV - 1, SSM_CONV_DIM), dt)
    z_ssm = jnp.zeros((DEPTH, Bp, SSM_HEADS, SSM_HEAD, SSM_STATE), dt)
    y_prompt, p_shift, p_wkv, p_conv, p_ssm = _trunk(x_prompt, c_prompt, z_shift, z_wkv, z_conv, z_ssm,
                                                     params, final_g, w_ada_f, b_ada_f)
    y_sample, s_shift, s_wkv, s_conv, s_ssm = _trunk(x_sample, c_sample, state_shift, state_wkv, state_conv,
                                                     state_ssm, params, final_g, w_ada_f, b_ada_f)
    return (y_prompt, y_sample, p_shift, p_wkv, p_conv, p_ssm, s_shift, s_wkv, s_conv, s_ssm)
```

```cpp
#include <hip/hip_runtime.h>
#include <hip/hip_cooperative_groups.h>
#include <cstdio>
namespace cg = cooperative_groups;

#ifndef MEGA
#define MEGA 0
#endif

typedef unsigned short u16;
typedef __attribute__((ext_vector_type(8))) short bf16x8;
typedef __attribute__((ext_vector_type(4))) float f32x4;

constexpr int D = 1024;
constexpr int NP = 16384, NS = 1024, NT = NP + NS, NSEQ = 136;
constexpr int NROWS = NT + 128;
constexpr int PCOLS = 4368;
constexpr int INCOLS = 6416;
constexpr int C_LW = 1536, C_LA = 1600, C_LG = 1664, C_Z = 1792, C_XBC = 2816, C_DT = 4352;
constexpr int G_A = 4368, G_B = 5392;
constexpr size_t O_Y = 0, O_PSHIFT = 17825792, O_PWKV = 17833984, O_PCONV = 18096128, O_PSSM = 18132992,
                 O_SSHIFT = 19181568, O_SWKV = 19312640, O_SCONV = 23506944, O_SSSM = 24096768;
constexpr int LDS_BYTES = 80 * 1024;
constexpr int NTHREADS = 256;

struct P {
  const float *x_prompt, *x_sample, *c_prompt, *c_sample, *state_shift, *state_wkv, *state_conv, *state_ssm;
  const float *w_ada, *b_ada, *norm1_g, *w_in, *rw_mu, *rw_w0, *rw_w2, *rw_a0, *rw_a2, *rw_g2, *rw_k_k, *rw_k_a,
      *rw_r_k, *rw_ln_w, *rw_ln_b;
  const float *conv_w, *conv_b, *dt_bias, *A_log, *D_skip, *ssm_norm_w, *w_pa, *w_pb, *w_out, *norm2_g, *peer_wq,
      *peer_keys, *peer_u, *peer_v, *final_g, *w_ada_f, *b_ada_f;
  float* out;
  u16 *w_inT, *w_paT, *w_pbT, *w_outT, *wqT, *keysb, *xn, *proj, *prep, *merged, *ub, *vb, *xc, *oa, *ob;
  float *mod, *dtb, *decb, *topv;
  int* topi;
};

__device__ __forceinline__ u16 f2bf(float f) {
  unsigned u = __float_as_uint(f);
  u += 0x7fffu + ((u >> 16) & 1u);
  return (u16)(u >> 16);
}
__device__ __forceinline__ float bf2f(u16 h) { return __uint_as_float(((unsigned)h) << 16); }
__device__ __forceinline__ unsigned pack2(float a, float b) { return (unsigned)f2bf(a) | ((unsigned)f2bf(b) << 16); }
__device__ __forceinline__ float bflo(unsigned u) { return __uint_as_float(u << 16); }
__device__ __forceinline__ float bfhi(unsigned u) { return __uint_as_float(u & 0xffff0000u); }
__device__ __forceinline__ float sigmoidf_(float x) { return 1.f / (1.f + __expf(-x)); }
__device__ __forceinline__ float siluf_(float x) { return x / (1.f + __expf(-x)); }
__device__ __forceinline__ float softplusf_(float x) { return x > 20.f ? x : log1pf(expf(x)); }

template <int CTRL>
__device__ __forceinline__ float dppf(float x) {
  return __int_as_float(__builtin_amdgcn_update_dpp(0, __float_as_int(x), CTRL, 0xf, 0xf, true));
}
__device__ __forceinline__ float allreduce16(float x) {
  x += dppf<0x128>(x);
  x += dppf<0x124>(x);
  x += dppf<0x122>(x);
  x += dppf<0x121>(x);
  return x;
}
__device__ __forceinline__ float allreduce8(float x) {
  x += dppf<0xB1>(x);
  x += dppf<0x4E>(x);
  x += dppf<0x141>(x);
  return x;
}
__device__ __forceinline__ float wave_sum(float x) {
#pragma unroll
  for (int o = 32; o >= 1; o >>= 1) x += __shfl_xor(x, o, 64);
  return x;
}
__device__ __forceinline__ float wave_max(float x) {
#pragma unroll
  for (int o = 32; o >= 1; o >>= 1) x = fmaxf(x, __shfl_xor(x, o, 64));
  return x;
}
__device__ __forceinline__ int wave_min_i(int x) {
#pragma unroll
  for (int o = 32; o >= 1; o >>= 1) x = min(x, __shfl_xor(x, o, 64));
  return x;
}

__device__ __forceinline__ const float* xrow(const P& p, int n) {
  return n < NP ? p.x_prompt + (size_t)n * D : p.x_sample + (size_t)(n - NP) * D;
}
__device__ __forceinline__ void tok2seq(int n, int& seq, int& t, int& T) {
  if (n < NP) { seq = n >> 11; t = n & 2047; T = 2048; }
  else { int m = n - NP; seq = 8 + (m >> 3); t = m & 7; T = 8; }
}
__device__ __forceinline__ float* seq_out(float* out, int seq, size_t op, size_t os, size_t per) {
  return seq < 8 ? out + op + (size_t)seq * per : out + os + (size_t)(seq - 8) * per;
}

constexpr int LROW = 144;
__device__ __forceinline__ void gemm_tile(const u16* __restrict__ A, int lda, int m0, const u16* __restrict__ Bt,
                                          int ldb, int n0, int K, f32x4 (&acc)[4][4], char* smem) {
  char* sA = smem;
  char* sB = smem + 128 * LROW;
  const int tid = threadIdx.x, lane = tid & 63, wid = tid >> 6, wr = wid >> 1, wc = wid & 1, fr = lane & 15,
            fq = lane >> 4;
  uint4 ra0, ra1, ra2, ra3, rb0, rb1, rb2, rb3;
  const int nk = K / 64;
  const int lrow = tid >> 3, lch = tid & 7;
  const u16* gA = A + (size_t)(m0 + lrow) * lda + lch * 8;
  const u16* gB = Bt + (size_t)(n0 + lrow) * ldb + lch * 8;
#define GLOAD(kt)                                                   \
  {                                                                 \
    ra0 = *(const uint4*)(gA + (kt) * 64);                          \
    ra1 = *(const uint4*)(gA + (size_t)32 * lda + (kt) * 64);       \
    ra2 = *(const uint4*)(gA + (size_t)64 * lda + (kt) * 64);       \
    ra3 = *(const uint4*)(gA + (size_t)96 * lda + (kt) * 64);       \
    rb0 = *(const uint4*)(gB + (kt) * 64);                          \
    rb1 = *(const uint4*)(gB + (size_t)32 * ldb + (kt) * 64);       \
    rb2 = *(const uint4*)(gB + (size_t)64 * ldb + (kt) * 64);       \
    rb3 = *(const uint4*)(gB + (size_t)96 * ldb + (kt) * 64);       \
  }
  GLOAD(0);
  for (int kt = 0; kt < nk; kt++) {
    __syncthreads();
    {
      char* wa = sA + lrow * LROW + lch * 16;
      char* wb = sB + lrow * LROW + lch * 16;
      *(uint4*)(wa) = ra0; *(uint4*)(wa + 32 * LROW) = ra1; *(uint4*)(wa + 64 * LROW) = ra2; *(uint4*)(wa + 96 * LROW) = ra3;
      *(uint4*)(wb) = rb0; *(uint4*)(wb + 32 * LROW) = rb1; *(uint4*)(wb + 64 * LROW) = rb2; *(uint4*)(wb + 96 * LROW) = rb3;
    }
    __syncthreads();
    if (kt + 1 < nk) GLOAD(kt + 1);
#pragma unroll
    for (int s = 0; s < 2; s++) {
      bf16x8 af[4], bfr[4];
#pragma unroll
      for (int m = 0; m < 4; m++) af[m] = *(const bf16x8*)(sA + (wr * 64 + m * 16 + fr) * LROW + s * 64 + fq * 16);
#pragma unroll
      for (int n = 0; n < 4; n++) bfr[n] = *(const bf16x8*)(sB + (wc * 64 + n * 16 + fr) * LROW + s * 64 + fq * 16);
#pragma unroll
      for (int m = 0; m < 4; m++)
#pragma unroll
        for (int n = 0; n < 4; n++) acc[m][n] = __builtin_amdgcn_mfma_f32_16x16x32_bf16(af[m], bfr[n], acc[m][n], 0, 0, 0);
    }
  }
  __syncthreads();
}
__device__ __forceinline__ void zero_acc(f32x4 (&acc)[4][4]) {
#pragma unroll
  for (int m = 0; m < 4; m++)
#pragma unroll
    for (int n = 0; n < 4; n++) acc[m][n] = f32x4{0.f, 0.f, 0.f, 0.f};
}
#define ACC_FOREACH(...)                                                                    \
  {                                                                                         \
    const int _l = threadIdx.x & 63, _w = threadIdx.x >> 6, _wr = _w >> 1, _wc = _w & 1;    \
    const int _fr = _l & 15, _fq = _l >> 4;                                                 \
    _Pragma("unroll") for (int m = 0; m < 4; m++) _Pragma("unroll") for (int n = 0; n < 4; n++) \
        _Pragma("unroll") for (int j = 0; j < 4; j++) {                                     \
      const int row = _wr * 64 + m * 16 + _fq * 4 + j, col = _wc * 64 + n * 16 + _fr;       \
      __VA_ARGS__                                                                           \
    }                                                                                       \
  }

__device__ void transpose_tile(const float* __restrict__ src, int K, int N, u16* __restrict__ dst, int tile,
                               char* smem) {
  const int ntn = (N + 63) / 64, kt = tile / ntn, nt = tile % ntn, tid = threadIdx.x;
  float(*s)[65] = (float(*)[65])smem;
  __syncthreads();
#pragma unroll 4
  for (int i = 0; i < 16; i++) {
    int r = (tid >> 6) + 4 * i, n = nt * 64 + (tid & 63);
    s[r][tid & 63] = (n < N) ? src[(size_t)(kt * 64 + r) * N + n] : 0.f;
  }
  __syncthreads();
#pragma unroll 4
  for (int i = 0; i < 8; i++) {
    int nl = (tid >> 5) + 8 * i, n = nt * 64 + nl, kl = (tid & 31) * 2;
    if (n < N) *(unsigned*)(dst + (size_t)n * K + kt * 64 + kl) = pack2(s[kl][nl], s[kl + 1][nl]);
  }
}

__device__ void mod_item(const P& p, int item, char* smem) {
  const int tid = threadIdx.x, j = tid & 31, g = tid >> 5;
  const int col0 = item * 32;
  const float* W; const float* bias; int N, cw;
  if (col0 < 6144) { W = p.w_ada; bias = p.b_ada; N = 6144; cw = col0; }
  else { W = p.w_ada_f; bias = p.b_ada_f; N = 2048; cw = col0 - 6144; }
  float(*cs)[68] = (float(*)[68])smem;
  float acc[17];
#pragma unroll
  for (int s = 0; s < 17; s++) acc[s] = 0.f;
  for (int k0 = 0; k0 < 1024; k0 += 64) {
    __syncthreads();
    for (int idx = tid; idx < NSEQ * 64; idx += 256) {
      int seq = idx >> 6, kk = idx & 63;
      float c = seq < 8 ? p.c_prompt[seq * 1024 + k0 + kk] : p.c_sample[(seq - 8) * 1024 + k0 + kk];
      cs[seq][kk] = siluf_(c);
    }
    __syncthreads();
#pragma unroll 2
    for (int k4 = 0; k4 < 16; k4++) {
      const float* wp = W + (size_t)(k0 + k4 * 4) * N + cw + j;
      float w0 = wp[0], w1 = wp[N], w2 = wp[2 * (size_t)N], w3 = wp[3 * (size_t)N];
#pragma unroll
      for (int s = 0; s < 17; s++) {
        float4 c4 = *(const float4*)&cs[g * 17 + s][k4 * 4];
        acc[s] += w0 * c4.x + w1 * c4.y + w2 * c4.z + w3 * c4.w;
      }
    }
  }
  float b = bias[cw + j];
#pragma unroll
  for (int s = 0; s < 17; s++) p.mod[(size_t)(g * 17 + s) * 8192 + col0 + j] = acc[s] + b;
}

constexpr int J_MOD = 256, J_WIN = 16 * 101, J_WPA = 8 * 16, J_WPB = 256, J_WOUT = 256, J_WQ = 16 * 32, J_KEYS = 128,
              J_SHIFT = 64;
constexpr int PH0_ITEMS = J_MOD + J_WIN + J_WPA + J_WPB + J_WOUT + J_WQ + J_KEYS + J_SHIFT;

__device__ void phase0(const P& p, int bid, int nb, char* smem) {
  for (int it = bid; it < PH0_ITEMS; it += nb) {
    int i = it;
    if (i < J_MOD) { mod_item(p, i, smem); continue; }
    i -= J_MOD;
    if (i < J_WIN) { transpose_tile(p.w_in, 1024, INCOLS, p.w_inT, i, smem); continue; }
    i -= J_WIN;
    if (i < J_WPA) { transpose_tile(p.w_pa, 512, 1024, p.w_paT, i, smem); continue; }
    i -= J_WPA;
    if (i < J_WPB) { transpose_tile(p.w_pb, 1024, 1024, p.w_pbT, i, smem); continue; }
    i -= J_WPB;
    if (i < J_WOUT) { transpose_tile(p.w_out, 1024, 1024, p.w_outT, i, smem); continue; }
    i -= J_WOUT;
    if (i < J_WQ) { transpose_tile(p.peer_wq, 1024, 2048, p.wqT, i, smem); continue; }
    i -= J_WQ;
    const float* src; u16* dst;
    if (i < J_KEYS) { src = p.peer_keys + (size_t)i * 2048; dst = p.keysb + (size_t)i * 2048; }
    else { i -= J_KEYS; src = p.state_shift + (size_t)i * 2048; dst = p.xn + (size_t)NT * D + (size_t)i * 2048; }
    const float4* s4 = (const float4*)src + threadIdx.x * 2;
    float4 a = s4[0], b = s4[1];
    uint4 o; o.x = pack2(a.x, a.y); o.y = pack2(a.z, a.w); o.z = pack2(b.x, b.y); o.w = pack2(b.z, b.w);
    *((uint4*)dst + threadIdx.x) = o;
  }
}

template <bool SECOND>
__device__ void phase_norm(const P& p, int bid, int nb) {
  const int lane = threadIdx.x & 63, wid = threadIdx.x >> 6;
  const float* gam = SECOND ? p.norm2_g : p.norm1_g;
  for (int it = bid; it < NT / 4; it += nb) {
    const int n = it * 4 + wid;
    int seq, t, T; tok2seq(n, seq, t, T);
    const float* xr = SECOND ? p.out + O_Y + (size_t)n * D : xrow(p, n);
    const float* md = p.mod + (size_t)seq * 8192 + (SECOND ? 3072 : 0);
    float4 v[4];
    float ss = 0.f;
#pragma unroll
    for (int i = 0; i < 4; i++) {
      v[i] = ((const float4*)xr)[lane + 64 * i];
      ss += v[i].x * v[i].x + v[i].y * v[i].y + v[i].z * v[i].z + v[i].w * v[i].w;
    }
    ss = wave_sum(ss);
    const float rstd = rsqrtf(ss * (1.f / 1024.f) + 1e-6f);
    const bool last = (!SECOND) && (t == T - 1);
    float* so = seq_out(p.out, seq, O_PSHIFT, O_SSHIFT, 1024);
#pragma unroll
    for (int i = 0; i < 4; i++) {
      const int c = (lane + 64 * i) * 4;
      float4 g = *(const float4*)(gam + c), sh = *(const float4*)(md + c), sc = *(const float4*)(md + 1024 + c);
      float4 o;
      o.x = v[i].x * rstd * g.x * (1.f + sc.x) + sh.x;
      o.y = v[i].y * rstd * g.y * (1.f + sc.y) + sh.y;
      o.z = v[i].z * rstd * g.z * (1.f + sc.z) + sh.z;
      o.w = v[i].w * rstd * g.w * (1.f + sc.w) + sh.w;
      uint2 pk; pk.x = pack2(o.x, o.y); pk.y = pack2(o.z, o.w);
      *(uint2*)(p.xn + (size_t)n * D + c) = pk;
      if (last) *(float4*)(so + c) = o;
    }
  }
}

constexpr int P2_NT = 35, P2_MT = 137;
__device__ void phase2(const P& p, int bid, int nb, char* smem) {
  for (int it = bid; it < P2_MT * P2_NT; it += nb) {
    const int mt = it / P2_NT, nt = it % P2_NT;
    f32x4 acc[4][4];
    zero_acc(acc);
    gemm_tile(p.xn, D, mt * 128, p.w_inT, D, nt * 128, D, acc, smem);
    ACC_FOREACH({
      const int gc = nt * 128 + col;
      if (gc < PCOLS) p.proj[(size_t)(mt * 128 + row) * PCOLS + gc] = f2bf(acc[m][n][j]);
    })
  }
}

__device__ void rwkv_prep_item(const P& p, int item, char* smem) {
  const int tid = threadIdx.x, lane = tid & 63;
  const int n0 = item * 8;
  int seq, t0, T; tok2seq(n0, seq, t0, T);
  float(*q)[1792] = (float(*)[1792])smem;
  __syncthreads();
  for (int idx = tid; idx < 8 * 224; idx += 256) {
    const int tok = idx / 224, ch = idx % 224, c = ch * 8;
    const int n = n0 + tok, t = t0 + tok;
    uint4 pc = *(const uint4*)(p.proj + (size_t)n * PCOLS + c);
    uint4 pp = make_uint4(0, 0, 0, 0);
    if (t > 0) pp = *(const uint4*)(p.proj + (size_t)(n - 1) * PCOLS + c);
    else if (seq >= 8) pp = *(const uint4*)(p.proj + (size_t)(NT + seq - 8) * PCOLS + c);
    unsigned pcs[4] = {pc.x, pc.y, pc.z, pc.w}, pps[4] = {pp.x, pp.y, pp.z, pp.w};
#pragma unroll
    for (int e = 0; e < 4; e++) {
      float a0 = bflo(pcs[e]), a1 = bfhi(pcs[e]), b0 = bflo(pps[e]), b1 = bfhi(pps[e]);
      float m0 = p.rw_mu[c + 2 * e], m1 = p.rw_mu[c + 2 * e + 1];
      float q0 = a0 + (b0 - a0) * m0, q1 = a1 + (b1 - a1) * m1;
      if (c >= C_LW && c < C_LA) { q0 = tanhf(q0); q1 = tanhf(q1); }
      else if (c >= C_LG) { q0 = sigmoidf_(q0); q1 = sigmoidf_(q1); }
      q[tok][c + 2 * e] = q0; q[tok][c + 2 * e + 1] = q1;
    }
  }
  __syncthreads();
  float aw[8][2], aa[8][2], ag[8][2];
#pragma unroll
  for (int k = 0; k < 8; k++) { aw[k][0] = aw[k][1] = aa[k][0] = aa[k][1] = ag[k][0] = ag[k][1] = 0.f; }
  const int c0 = tid, c1 = tid + 256;
  for (int i4 = 0; i4 < 16; i4++) {
    float w2a[4], w2b[4], a2a[4], a2b[4];
#pragma unroll
    for (int e = 0; e < 4; e++) {
      const int i = i4 * 4 + e;
      w2a[e] = p.rw_w2[i * 512 + c0]; w2b[e] = p.rw_w2[i * 512 + c1];
      a2a[e] = p.rw_a2[i * 512 + c0]; a2b[e] = p.rw_a2[i * 512 + c1];
    }
#pragma unroll
    for (int k = 0; k < 8; k++) {
      float4 th = *(const float4*)&q[k][C_LW + i4 * 4];
      float4 la = *(const float4*)&q[k][C_LA + i4 * 4];
      aw[k][0] += th.x * w2a[0] + th.y * w2a[1] + th.z * w2a[2] + th.w * w2a[3];
      aw[k][1] += th.x * w2b[0] + th.y * w2b[1] + th.z * w2b[2] + th.w * w2b[3];
      aa[k][0] += la.x * a2a[0] + la.y * a2a[1] + la.z * a2a[2] + la.w * a2a[3];
      aa[k][1] += la.x * a2b[0] + la.y * a2b[1] + la.z * a2b[2] + la.w * a2b[3];
    }
  }
  for (int i4 = 0; i4 < 32; i4++) {
    float g2a[4], g2b[4];
#pragma unroll
    for (int e = 0; e < 4; e++) {
      const int i = i4 * 4 + e;
      g2a[e] = p.rw_g2[i * 512 + c0]; g2b[e] = p.rw_g2[i * 512 + c1];
    }
#pragma unroll
    for (int k = 0; k < 8; k++) {
      float4 sg = *(const float4*)&q[k][C_LG + i4 * 4];
      ag[k][0] += sg.x * g2a[0] + sg.y * g2a[1] + sg.z * g2a[2] + sg.w * g2a[3];
      ag[k][1] += sg.x * g2b[0] + sg.y * g2b[1] + sg.z * g2b[2] + sg.w * g2b[3];
    }
  }
#pragma unroll
  for (int h2 = 0; h2 < 2; h2++) {
    const int col = h2 ? c1 : c0;
    const float w0 = p.rw_w0[col], a0 = p.rw_a0[col], kkw = p.rw_k_k[col], kaw = p.rw_k_a[col];
#pragma unroll
    for (int k = 0; k < 8; k++) {
      const float wpre = w0 + aw[k][h2];
      const float w = -softplusf_(-wpre) - 0.5f;
      const float logd = -expf(w);
      const float a = sigmoidf_(a0 + aa[k][h2]);
      const float g = ag[k][h2];
      const float r = q[k][col], kx = q[k][512 + col], v = q[k][1024 + col];
      const float kkv = kx * kkw;
      const float ssq = wave_sum(kkv * kkv);
      const float kk = kkv / fmaxf(sqrtf(ssq), 1e-12f);
      const float k2 = kx * (1.f + (a - 1.f) * kaw);
      const float b = kk * a;
      u16* o = p.prep + (size_t)(n0 + k) * 3584 + col;
      o[0] = f2bf(logd); o[512] = f2bf(r); o[1024] = f2bf(k2); o[1536] = f2bf(kk); o[2048] = f2bf(b);
      o[2560] = f2bf(v); o[3072] = f2bf(g);
    }
  }
  (void)lane;
}

__device__ void conv_prep_item(const P& p, int item) {
  const int tid = threadIdx.x;
  const int n0 = item * 8;
  int seq, t0, T; tok2seq(n0, seq, t0, T);
#pragma unroll 1
  for (int i = 0; i < 6; i++) {
    const int c = tid + 256 * i;
    const float w0 = p.conv_w[c], w1 = p.conv_w[1536 + c], w2 = p.conv_w[3072 + c], w3 = p.conv_w[4608 + c],
                cb = p.conv_b[c];
    float f[3];
#pragma unroll
    for (int j = 0; j < 3; j++) {
      const int tt = t0 - 3 + j;
      if (tt >= 0) f[j] = bf2f(p.proj[(size_t)(n0 - 3 + j) * PCOLS + C_XBC + c]);
      else f[j] = seq < 8 ? 0.f : p.state_conv[((size_t)(seq - 8) * 3 + (tt + 3)) * 1536 + c];
    }
#pragma unroll
    for (int k = 0; k < 8; k++) {
      const float cur = bf2f(p.proj[(size_t)(n0 + k) * PCOLS + C_XBC + c]);
      const float cv = cb + f[0] * w0 + f[1] * w1 + f[2] * w2 + cur * w3;
      p.xc[(size_t)(n0 + k) * 1536 + c] = f2bf(siluf_(cv));
      f[0] = f[1]; f[1] = f[2]; f[2] = cur;
    }
    if (t0 + 8 == T) {
      float* co = seq_out(p.out, seq, O_PCONV, O_SCONV, 3 * 1536);
      co[c] = f[0]; co[1536 + c] = f[1]; co[3072 + c] = f[2];
    }
  }
  if (tid < 128) {
    const int k = tid >> 4, h = tid & 15, n = n0 + k;
    const float raw = bf2f(p.proj[(size_t)n * PCOLS + C_DT + h]) + p.dt_bias[h];
    const float dt = softplusf_(raw);
    const float dA = -dt * expf(p.A_log[h]);
    p.dtb[n * 16 + h] = dt;
    p.decb[n * 16 + h] = expf(dA);
  }
}

__device__ void phase3(const P& p, int bid, int nb, char* smem) {
  for (int it = bid; it < 2 * (NT / 8); it += nb) {
    if (it < NT / 8) rwkv_prep_item(p, it, smem);
    else conv_prep_item(p, it - NT / 8);
  }
}

constexpr int TC = 32;
__device__ void rwkv_scan_item(const P& p, int seq, int h, int qr, char* smem) {
  const int T = seq < 8 ? 2048 : 8, nbase = seq < 8 ? seq * 2048 : NP + (seq - 8) * 8;
  float* Ld = (float*)smem;
  float* Lr = Ld + TC * 64; float* Lk = Lr + TC * 64; float* Lkk = Lk + TC * 64; float* Lb = Lkk + TC * 64;
  float* Lv = Lb + TC * 64;
  float* Ly = Lv + TC * 16;
  const int tid = threadIdx.x, w = tid >> 6, lane = tid & 63, rl = w * 4 + (lane >> 4), ks = lane & 15;
  const int v = qr * 16 + rl;
  float S0 = 0.f, S1 = 0.f, S2 = 0.f, S3 = 0.f;
  if (seq >= 8) {
    float4 s = *(const float4*)(p.state_wkv + (((size_t)(seq - 8) * 8 + h) * 64 + v) * 64 + ks * 4);
    S0 = s.x; S1 = s.y; S2 = s.z; S3 = s.w;
  }
  for (int c0 = 0; c0 < T; c0 += TC) {
    const int tc = min(TC, T - c0);
    __syncthreads();
    {
      const int tt = tid >> 3, k8 = (tid & 7) * 8;
      if (tt < tc) {
        const u16* base = p.prep + (size_t)(nbase + c0 + tt) * 3584 + h * 64 + k8;
        float* dsts[5] = {Ld, Lr, Lk, Lkk, Lb};
#pragma unroll
        for (int a = 0; a < 5; a++) {
          uint4 u = *(const uint4*)(base + a * 512);
          float4 lo, hi;
          lo.x = bflo(u.x); lo.y = bfhi(u.x); lo.z = bflo(u.y); lo.w = bfhi(u.y);
          hi.x = bflo(u.z); hi.y = bfhi(u.z); hi.z = bflo(u.w); hi.w = bfhi(u.w);
          if (a == 0) {
            lo.x = __expf(lo.x); lo.y = __expf(lo.y); lo.z = __expf(lo.z); lo.w = __expf(lo.w);
            hi.x = __expf(hi.x); hi.y = __expf(hi.y); hi.z = __expf(hi.z); hi.w = __expf(hi.w);
          }
          *(float4*)(dsts[a] + tt * 64 + k8) = lo;
          *(float4*)(dsts[a] + tt * 64 + k8 + 4) = hi;
        }
      }
      for (int idx = tid; idx < tc * 16; idx += 256) {
        const int t2 = idx >> 4, r = idx & 15;
        Lv[idx] = bf2f(p.prep[(size_t)(nbase + c0 + t2) * 3584 + 2560 + h * 64 + qr * 16 + r]);
      }
    }
    __syncthreads();
    for (int tt = 0; tt < tc; tt++) {
      const float4 kk4 = *(const float4*)(Lkk + tt * 64 + ks * 4);
      const float4 d4 = *(const float4*)(Ld + tt * 64 + ks * 4);
      const float4 b4 = *(const float4*)(Lb + tt * 64 + ks * 4);
      const float4 k4 = *(const float4*)(Lk + tt * 64 + ks * 4);
      const float4 r4 = *(const float4*)(Lr + tt * 64 + ks * 4);
      const float vv = Lv[tt * 16 + rl];
      float sk = S0 * kk4.x + S1 * kk4.y + S2 * kk4.z + S3 * kk4.w;
      sk = allreduce16(sk);
      S0 = S0 * d4.x + (vv * k4.x - sk * b4.x);
      S1 = S1 * d4.y + (vv * k4.y - sk * b4.y);
      S2 = S2 * d4.z + (vv * k4.z - sk * b4.z);
      S3 = S3 * d4.w + (vv * k4.w - sk * b4.w);
      float y = S0 * r4.x + S1 * r4.y + S2 * r4.z + S3 * r4.w;
      y = allreduce16(y);
      if (ks == 0) Ly[tt * 16 + rl] = y;
    }
    __syncthreads();
    for (int idx = tid; idx < tc * 16; idx += 256) {
      const int t2 = idx >> 4, r = idx & 15;
      p.proj[(size_t)(nbase + c0 + t2) * PCOLS + h * 64 + qr * 16 + r] = f2bf(Ly[idx]);
    }
  }
  float* so = seq_out(p.out, seq, O_PWKV, O_SWKV, 8 * 4096);
  *(float4*)(so + ((size_t)h * 64 + v) * 64 + ks * 4) = make_float4(S0, S1, S2, S3);
}

__device__ void ssm_scan_item(const P& p, int seq, int head, int half, char* smem) {
  const int T = seq < 8 ? 2048 : 8, nbase = seq < 8 ? seq * 2048 : NP + (seq - 8) * 8;
  float* LB = (float*)smem;
  float* LC = LB + TC * 128;
  float* Lx = LC + TC * 128;
  float* Ly = Lx + TC * 32;
  float* Ldt = Ly + TC * 32;
  float* Ldec = Ldt + TC;
  const int tid = threadIdx.x, pl = tid >> 3, ns = tid & 7;
  const int pp = half * 32 + pl, g = head >> 3;
  const float Dk = p.D_skip[head];
  float hs[16];
#pragma unroll
  for (int j = 0; j < 16; j++) hs[j] = 0.f;
  if (seq >= 8) {
    const float4* s4 = (const float4*)(p.state_ssm + (((size_t)(seq - 8) * 16 + head) * 64 + pp) * 128 + ns * 16);
#pragma unroll
    for (int j = 0; j < 4; j++) { float4 s = s4[j]; hs[4 * j] = s.x; hs[4 * j + 1] = s.y; hs[4 * j + 2] = s.z; hs[4 * j + 3] = s.w; }
  }
  for (int c0 = 0; c0 < T; c0 += TC) {
    const int tc = min(TC, T - c0);
    __syncthreads();
    {
      for (int idx = tid; idx < tc * 32; idx += 256) {
        const int tt = idx >> 5, ch = idx & 31;
        const u16* src = p.xc + (size_t)(nbase + c0 + tt) * 1536 + 1024 + (ch < 16 ? 0 : 256) + g * 128 + (ch & 15) * 8;
        uint4 u = *(const uint4*)src;
        float* dst = (ch < 16 ? LB : LC) + tt * 128 + (ch & 15) * 8;
        *(float4*)dst = make_float4(bflo(u.x), bfhi(u.x), bflo(u.y), bfhi(u.y));
        *(float4*)(dst + 4) = make_float4(bflo(u.z), bfhi(u.z), bflo(u.w), bfhi(u.w));
      }
      for (int idx = tid; idx < tc * 32; idx += 256) {
        const int tt = idx >> 5, r = idx & 31;
        Lx[idx] = bf2f(p.xc[(size_t)(nbase + c0 + tt) * 1536 + head * 64 + half * 32 + r]);
      }
      if (tid < tc) { Ldt[tid] = p.dtb[(nbase + c0 + tid) * 16 + head]; Ldec[tid] = p.decb[(nbase + c0 + tid) * 16 + head]; }
    }
    __syncthreads();
    for (int tt = 0; tt < tc; tt++) {
      const float xv = Lx[tt * 32 + pl];
      const float dtx = Ldt[tt] * xv, dec = Ldec[tt];
      const float4* B4 = (const float4*)(LB + tt * 128 + ns * 16);
      const float4* C4 = (const float4*)(LC + tt * 128 + ns * 16);
      float yp = 0.f;
#pragma unroll
      for (int j = 0; j < 4; j++) {
        const float4 b = B4[j], c = C4[j];
        hs[4 * j] = hs[4 * j] * dec + dtx * b.x;
        hs[4 * j + 1] = hs[4 * j + 1] * dec + dtx * b.y;
        hs[4 * j + 2] = hs[4 * j + 2] * dec + dtx * b.z;
        hs[4 * j + 3] = hs[4 * j + 3] * dec + dtx * b.w;
        yp += hs[4 * j] * c.x + hs[4 * j + 1] * c.y + hs[4 * j + 2] * c.z + hs[4 * j + 3] * c.w;
      }
      yp = allreduce8(yp);
      if (ns == 0) Ly[tt * 32 + pl] = yp + Dk * xv;
    }
    __syncthreads();
    for (int idx = tid; idx < tc * 32; idx += 256) {
      const int tt = idx >> 5, r = idx & 31;
      p.proj[(size_t)(nbase + c0 + tt) * PCOLS + C_XBC + head * 64 + half * 32 + r] = f2bf(Ly[idx]);
    }
  }
  float* so = seq_out(p.out, seq, O_PSSM, O_SSSM, 16 * 8192);
  float4* o4 = (float4*)(so + ((size_t)head * 64 + pp) * 128 + ns * 16);
#pragma unroll
  for (int j = 0; j < 4; j++) o4[j] = make_float4(hs[4 * j], hs[4 * j + 1], hs[4 * j + 2], hs[4 * j + 3]);
}

constexpr int P4_RP = 256, P4_SP = 256, P4_RS = 4096, P4_SS = 4096;
__device__ void phase4(const P& p, int bid, int nb, char* smem) {
  for (int it = bid; it < P4_RP + P4_SP + P4_RS + P4_SS; it += nb) {
    int i = it;
    if (i < P4_RP) { rwkv_scan_item(p, i >> 5, (i >> 2) & 7, i & 3, smem); continue; }
    i -= P4_RP;
    if (i < P4_SP) { ssm_scan_item(p, i >> 5, (i >> 1) & 15, i & 1, smem); continue; }
    i -= P4_SP;
    if (i < P4_RS) { rwkv_scan_item(p, 8 + (i >> 5), (i >> 2) & 7, i & 3, smem); continue; }
    i -= P4_RS;
    ssm_scan_item(p, 8 + (i >> 5), (i >> 1) & 15, i & 1, smem);
  }
}

__device__ void phase5(const P& p, int bid, int nb) {
  const int lane = threadIdx.x & 63, wid = threadIdx.x >> 6;
  for (int it = bid; it < NT / 4; it += nb) {
    const int n = it * 4 + wid;
    {
      const int c = lane * 8;
      uint4 yu = *(const uint4*)(p.proj + (size_t)n * PCOLS + c);
      const u16* pr = p.prep + (size_t)n * 3584 + c;
      uint4 ru = *(const uint4*)(pr + 512), ku = *(const uint4*)(pr + 1024), vu = *(const uint4*)(pr + 2560),
            gu = *(const uint4*)(pr + 3072);
      unsigned ys[4] = {yu.x, yu.y, yu.z, yu.w}, rs[4] = {ru.x, ru.y, ru.z, ru.w}, ks_[4] = {ku.x, ku.y, ku.z, ku.w},
               vs[4] = {vu.x, vu.y, vu.z, vu.w}, gs[4] = {gu.x, gu.y, gu.z, gu.w};
      float y[8], r[8], k[8], v[8], g[8];
#pragma unroll
      for (int e = 0; e < 4; e++) {
        y[2 * e] = bflo(ys[e]); y[2 * e + 1] = bfhi(ys[e]);
        r[2 * e] = bflo(rs[e]); r[2 * e + 1] = bfhi(rs[e]);
        k[2 * e] = bflo(ks_[e]); k[2 * e + 1] = bfhi(ks_[e]);
        v[2 * e] = bflo(vs[e]); v[2 * e + 1] = bfhi(vs[e]);
        g[2 * e] = bflo(gs[e]); g[2 * e + 1] = bfhi(gs[e]);
      }
      float s = 0.f, bn = 0.f;
#pragma unroll
      for (int e = 0; e < 8; e++) { s += y[e]; bn += r[e] * k[e] * p.rw_r_k[c + e]; }
      s = allreduce8(s); bn = allreduce8(bn);
      const float mean = s * (1.f / 64.f);
      float vr = 0.f;
#pragma unroll
      for (int e = 0; e < 8; e++) { const float d = y[e] - mean; vr += d * d; }
      vr = allreduce8(vr) * (1.f / 64.f);
      const float rs_ = rsqrtf(vr + 64e-5f);
      float o[8];
#pragma unroll
      for (int e = 0; e < 8; e++) {
        const float yn = (y[e] - mean) * rs_ * p.rw_ln_w[c + e] + p.rw_ln_b[c + e];
        o[e] = (yn + bn * v[e]) * g[e];
      }
      uint4 ou; ou.x = pack2(o[0], o[1]); ou.y = pack2(o[2], o[3]); ou.z = pack2(o[4], o[5]); ou.w = pack2(o[6], o[7]);
      *(uint4*)(p.oa + (size_t)n * 512 + c) = ou;
    }
    {
      const int c = lane * 16;
      float yv[16];
      float ss = 0.f;
#pragma unroll
      for (int hh = 0; hh < 2; hh++) {
        uint4 yu = *(const uint4*)(p.proj + (size_t)n * PCOLS + C_XBC + c + hh * 8);
        uint4 zu = *(const uint4*)(p.proj + (size_t)n * PCOLS + C_Z + c + hh * 8);
        unsigned ys[4] = {yu.x, yu.y, yu.z, yu.w}, zs[4] = {zu.x, zu.y, zu.z, zu.w};
#pragma unroll
        for (int e = 0; e < 4; e++) {
          const float a = bflo(ys[e]) * siluf_(bflo(zs[e])), b = bfhi(ys[e]) * siluf_(bfhi(zs[e]));
          yv[hh * 8 + 2 * e] = a; yv[hh * 8 + 2 * e + 1] = b;
          ss += a * a + b * b;
        }
      }
#pragma unroll
      for (int o = 16; o >= 1; o >>= 1) ss += __shfl_xor(ss, o, 64);
      const float rstd = rsqrtf(ss * (1.f / 512.f) + 1e-6f);
      unsigned ou[8];
#pragma unroll
      for (int e = 0; e < 8; e++)
        ou[e] = pack2(yv[2 * e] * rstd * p.ssm_norm_w[c + 2 * e], yv[2 * e + 1] * rstd * p.ssm_norm_w[c + 2 * e + 1]);
      *(uint4*)(p.ob + (size_t)n * 1024 + c) = make_uint4(ou[0], ou[1], ou[2], ou[3]);
      *(uint4*)(p.ob + (size_t)n * 1024 + c + 8) = make_uint4(ou[4], ou[5], ou[6], ou[7]);
    }
  }
}

__device__ void phase6(const P& p, int bid, int nb, char* smem) {
  for (int it = bid; it < 136 * 8; it += nb) {
    const int mt = it >> 3, nt = it & 7;
    f32x4 ac[4][4];
    unsigned sg[4][4][2];
    u16* Lm = (u16*)(smem + 2 * 128 * LROW);
    zero_acc(ac);
    gemm_tile(p.xn, D, mt * 128, p.w_inT + (size_t)G_A * D, D, nt * 128, D, ac, smem);
#pragma unroll
    for (int m = 0; m < 4; m++)
#pragma unroll
      for (int n = 0; n < 4; n++) {
        sg[m][n][0] = pack2(sigmoidf_(ac[m][n][0]), sigmoidf_(ac[m][n][1]));
        sg[m][n][1] = pack2(sigmoidf_(ac[m][n][2]), sigmoidf_(ac[m][n][3]));
      }
    zero_acc(ac);
    gemm_tile(p.oa, 512, mt * 128, p.w_paT, 512, nt * 128, 512, ac, smem);
    ACC_FOREACH({
      const unsigned gu = sg[m][n][j >> 1];
      const float gv = (j & 1) ? bfhi(gu) : bflo(gu);
      Lm[row * 136 + col] = f2bf(gv * ac[m][n][j]);
    })
    zero_acc(ac);
    gemm_tile(p.xn, D, mt * 128, p.w_inT + (size_t)G_B * D, D, nt * 128, D, ac, smem);
#pragma unroll
    for (int m = 0; m < 4; m++)
#pragma unroll
      for (int n = 0; n < 4; n++) {
        sg[m][n][0] = pack2(sigmoidf_(ac[m][n][0]), sigmoidf_(ac[m][n][1]));
        sg[m][n][1] = pack2(sigmoidf_(ac[m][n][2]), sigmoidf_(ac[m][n][3]));
      }
    zero_acc(ac);
    gemm_tile(p.ob, D, mt * 128, p.w_pbT, D, nt * 128, D, ac, smem);
    ACC_FOREACH({
      const unsigned gu = sg[m][n][j >> 1];
      const float gv = (j & 1) ? bfhi(gu) : bflo(gu);
      const float v = bf2f(Lm[row * 136 + col]) + gv * ac[m][n][j];
      p.merged[(size_t)(mt * 128 + row) * D + nt * 128 + col] = f2bf(v);
    })
  }
}

constexpr int P7_G = 136 * 8, P7_CV = 16384;
__device__ void phase7(const P& p, int bid, int nb, char* smem) {
  for (int it = bid; it < P7_G + P7_CV; it += nb) {
    if (it < P7_G) {
      const int mt = it >> 3, nt = it & 7;
      f32x4 acc[4][4];
      zero_acc(acc);
      gemm_tile(p.merged, D, mt * 128, p.w_outT, D, nt * 128, D, acc, smem);
      ACC_FOREACH({
        const int nn = mt * 128 + row, c = nt * 128 + col;
        int seq, t, T; tok2seq(nn, seq, t, T);
        const float gt = p.mod[(size_t)seq * 8192 + 2048 + c];
        p.out[O_Y + (size_t)nn * D + c] = xrow(p, nn)[c] + gt * acc[m][n][j];
      })
    } else {
      int i = it - P7_G;
      const float* src; u16* dst;
      if (i < 8192) { src = p.peer_u + (size_t)i * 2048; dst = p.ub + (size_t)i * 2048; }
      else { i -= 8192; src = p.peer_v + (size_t)i * 2048; dst = p.vb + (size_t)i * 2048; }
      const float4* s4 = (const float4*)src + threadIdx.x * 2;
      float4 a = s4[0], b = s4[1];
      uint4 o; o.x = pack2(a.x, a.y); o.y = pack2(a.z, a.w); o.z = pack2(b.x, b.y); o.w = pack2(b.z, b.w);
      *((uint4*)dst + threadIdx.x) = o;
    }
  }
}

__device__ void phase9(const P& p, int bid, int nb, char* smem) {
  const int tid = threadIdx.x, lane = tid & 63, wid = tid >> 6, wr = wid >> 1, wc = wid & 1, fr = lane & 15,
            fq = lane >> 4;
  for (int it = bid; it < 136 * 16; it += nb) {
    const int mt = it >> 4, nt = it & 15;
    f32x4 acc[4][4];
    zero_acc(acc);
    gemm_tile(p.xn, D, mt * 128, p.wqT, D, nt * 128, D, acc, smem);
    u16* Lq = (u16*)smem;
    ACC_FOREACH({ Lq[row * 136 + col] = f2bf(acc[m][n][j]); })
    __syncthreads();
    f32x4 sc[4][4];
    zero_acc(sc);
    const u16* kb = p.keysb + (size_t)nt * 128 * 128;
#pragma unroll
    for (int s = 0; s < 4; s++) {
      bf16x8 af[4], bfr[4];
#pragma unroll
      for (int m = 0; m < 4; m++) af[m] = *(const bf16x8*)((const char*)Lq + (wr * 64 + m * 16 + fr) * 272 + s * 64 + fq * 16);
#pragma unroll
      for (int n = 0; n < 4; n++) bfr[n] = *(const bf16x8*)(kb + (size_t)(wc * 64 + n * 16 + fr) * 128 + s * 32 + fq * 8);
#pragma unroll
      for (int m = 0; m < 4; m++)
#pragma unroll
        for (int n = 0; n < 4; n++) sc[m][n] = __builtin_amdgcn_mfma_f32_16x16x32_bf16(af[m], bfr[n], sc[m][n], 0, 0, 0);
    }
    __syncthreads();
    float* Ls = (float*)smem;
#pragma unroll
    for (int m = 0; m < 4; m++)
#pragma unroll
      for (int n = 0; n < 4; n++)
#pragma unroll
        for (int j = 0; j < 4; j++) Ls[(wr * 64 + m * 16 + fq * 4 + j) * 129 + wc * 64 + n * 16 + fr] = sc[m][n][j];
    __syncthreads();
    {
      const int row = tid >> 1, half = tid & 1;
      float* Lr = Ls + row * 129;
      const size_t ob = ((size_t)(mt * 128 + row) * 16 + nt) * 16;
      for (int r = 0; r < 16; r++) {
        float best = -INFINITY; int bi = 0;
        for (int i = 0; i < 64; i++) {
          const float v = Lr[half + 2 * i];
          if (v > best) { best = v; bi = half + 2 * i; }
        }
        const float ov = __shfl_xor(best, 1, 64);
        const int oi = __shfl_xor(bi, 1, 64);
        if (ov > best || (ov == best && oi < bi)) { best = ov; bi = oi; }
        if ((bi & 1) == half) Lr[bi] = -INFINITY;
        if (half == 0) { p.topv[ob + r] = best; p.topi[ob + r] = bi; }
      }
    }
    __syncthreads();
  }
}

__device__ __forceinline__ void cand_ij(int lane, int& ci, int& cj) {
  int i = 0, rem = lane;
#pragma unroll
  for (int r = 0; r < 16; r++) {
    const int cnt = 16 / (r + 1);
    if (i == r && rem >= cnt) { rem -= cnt; i = r + 1; }
  }
  ci = i; cj = rem;
}

__device__ void phase10(const P& p, int bid, int nb) {
  const int lane = threadIdx.x & 63, wid = threadIdx.x >> 6;
  int ci, cj; cand_ij(lane < 50 ? lane : 0, ci, cj);
  const int flat = ci * 16 + cj;
  for (int it = bid; it < NT / 4; it += nb) {
    const int n = it * 4 + wid;
    int seq, t, T; tok2seq(n, seq, t, T);
    float xv[16];
    {
      uint4 a = *(const uint4*)(p.xn + (size_t)n * D + lane * 8), b = *(const uint4*)(p.xn + (size_t)n * D + 512 + lane * 8);
      unsigned as[4] = {a.x, a.y, a.z, a.w}, bs[4] = {b.x, b.y, b.z, b.w};
#pragma unroll
      for (int e = 0; e < 4; e++) { xv[2 * e] = bflo(as[e]); xv[2 * e + 1] = bfhi(as[e]); xv[8 + 2 * e] = bflo(bs[e]); xv[8 + 2 * e + 1] = bfhi(bs[e]); }
    }
    float acc[16];
#pragma unroll
    for (int e = 0; e < 16; e++) acc[e] = 0.f;
    for (int h = 0; h < 8; h++) {
      const size_t base = ((size_t)n * 16 + h * 2) * 16;
      const float s1 = p.topv[base + (lane & 15)], s2 = p.topv[base + 16 + (lane & 15)];
      const int i1 = p.topi[base + (lane & 15)], i2 = p.topi[base + 16 + (lane & 15)];
      const float ca = __shfl(s1, ci, 64), cb = __shfl(s2, cj, 64);
      float cand = lane < 50 ? ca + cb : -INFINITY;
      float my_sc = -INFINITY; int my_flat = 0;
      for (int r = 0; r < 16; r++) {
        const float best = wave_max(cand);
        const int bf = wave_min_i(cand == best ? flat : 4096);
        if (lane == r) { my_sc = best; my_flat = bf; }
        if (cand == best && flat == bf) cand = -INFINITY;
      }
      const int e1 = __shfl(i1, my_flat >> 4, 64), e2 = __shfl(i2, my_flat & 15, 64);
      const int eid = e1 * 128 + e2;
      const float mx = __shfl(my_sc, 0, 64);
      float ex = lane < 16 ? __expf(my_sc - mx) : 0.f;
      const float den = wave_sum(ex);
      const float gate = ex / den;
#pragma unroll 4
      for (int k = 0; k < 16; k++) {
        const int ek = __shfl(eid, k, 64);
        const float gk = __shfl(gate, k, 64);
        const u16* ur = p.ub + (size_t)ek * D;
        uint4 a = *(const uint4*)(ur + lane * 8), b = *(const uint4*)(ur + 512 + lane * 8);
        float d = bflo(a.x) * xv[0] + bfhi(a.x) * xv[1] + bflo(a.y) * xv[2] + bfhi(a.y) * xv[3] + bflo(a.z) * xv[4] +
                  bfhi(a.z) * xv[5] + bflo(a.w) * xv[6] + bfhi(a.w) * xv[7] + bflo(b.x) * xv[8] + bfhi(b.x) * xv[9] +
                  bflo(b.y) * xv[10] + bfhi(b.y) * xv[11] + bflo(b.z) * xv[12] + bfhi(b.z) * xv[13] +
                  bflo(b.w) * xv[14] + bfhi(b.w) * xv[15];
        d = wave_sum(d);
        const float act = 0.5f * d * (1.f + erff(d * 0.70710678118654752f));
        const float w = gk * act;
        const u16* vr = p.vb + (size_t)ek * D;
        uint4 c = *(const uint4*)(vr + lane * 8), e = *(const uint4*)(vr + 512 + lane * 8);
        acc[0] += w * bflo(c.x); acc[1] += w * bfhi(c.x); acc[2] += w * bflo(c.y); acc[3] += w * bfhi(c.y);
        acc[4] += w * bflo(c.z); acc[5] += w * bfhi(c.z); acc[6] += w * bflo(c.w); acc[7] += w * bfhi(c.w);
        acc[8] += w * bflo(e.x); acc[9] += w * bfhi(e.x); acc[10] += w * bflo(e.y); acc[11] += w * bfhi(e.y);
        acc[12] += w * bflo(e.z); acc[13] += w * bfhi(e.z); acc[14] += w * bflo(e.w); acc[15] += w * bfhi(e.w);
      }
    }
    float* yr = p.out + O_Y + (size_t)n * D;
    const float* md = p.mod + (size_t)seq * 8192;
    float x2[16];
    float ss = 0.f;
#pragma unroll
    for (int hh = 0; hh < 2; hh++) {
      const int c = hh * 512 + lane * 8;
      float4 a = *(const float4*)(yr + c), b = *(const float4*)(yr + c + 4);
      float4 g0 = *(const float4*)(md + 5120 + c), g1 = *(const float4*)(md + 5120 + c + 4);
      x2[hh * 8 + 0] = a.x + g0.x * acc[hh * 8 + 0]; x2[hh * 8 + 1] = a.y + g0.y * acc[hh * 8 + 1];
      x2[hh * 8 + 2] = a.z + g0.z * acc[hh * 8 + 2]; x2[hh * 8 + 3] = a.w + g0.w * acc[hh * 8 + 3];
      x2[hh * 8 + 4] = b.x + g1.x * acc[hh * 8 + 4]; x2[hh * 8 + 5] = b.y + g1.y * acc[hh * 8 + 5];
      x2[hh * 8 + 6] = b.z + g1.z * acc[hh * 8 + 6]; x2[hh * 8 + 7] = b.w + g1.w * acc[hh * 8 + 7];
    }
#pragma unroll
    for (int e = 0; e < 16; e++) ss += x2[e] * x2[e];
    ss = wave_sum(ss);
    const float rstd = rsqrtf(ss * (1.f / 1024.f) + 1e-6f);
#pragma unroll
    for (int hh = 0; hh < 2; hh++) {
      const int c = hh * 512 + lane * 8;
      float o[8];
#pragma unroll
      for (int e = 0; e < 8; e++)
        o[e] = x2[hh * 8 + e] * rstd * p.final_g[c + e] * (1.f + md[7168 + c + e]) + md[6144 + c + e];
      *(float4*)(yr + c) = make_float4(o[0], o[1], o[2], o[3]);
      *(float4*)(yr + c + 4) = make_float4(o[4], o[5], o[6], o[7]);
    }
  }
}

template <int PH>
__device__ __forceinline__ void run_phase(const P& p, int bid, int nb, char* smem) {
  if constexpr (PH == 0) phase0(p, bid, nb, smem);
  if constexpr (PH == 1) phase_norm<false>(p, bid, nb);
  if constexpr (PH == 2) phase2(p, bid, nb, smem);
  if constexpr (PH == 3) phase3(p, bid, nb, smem);
  if constexpr (PH == 4) phase4(p, bid, nb, smem);
  if constexpr (PH == 5) phase5(p, bid, nb);
  if constexpr (PH == 6) phase6(p, bid, nb, smem);
  if constexpr (PH == 7) phase7(p, bid, nb, smem);
  if constexpr (PH == 8) phase_norm<true>(p, bid, nb);
  if constexpr (PH == 9) phase9(p, bid, nb, smem);
  if constexpr (PH == 10) phase10(p, bid, nb);
}

template <int PH>
__global__ void __launch_bounds__(NTHREADS, 2) k_phase(P p) {
  extern __shared__ __attribute__((aligned(16))) char smem[];
  run_phase<PH>(p, blockIdx.x, gridDim.x, smem);
}

#if MEGA
__global__ void __launch_bounds__(NTHREADS, 2) k_mega(P p) {
  extern __shared__ __attribute__((aligned(16))) char smem[];
  cg::grid_group grid = cg::this_grid();
  const int bid = blockIdx.x, nb = gridDim.x;
  run_phase<0>(p, bid, nb, smem); grid.sync();
  run_phase<1>(p, bid, nb, smem); grid.sync();
  run_phase<2>(p, bid, nb, smem); grid.sync();
  run_phase<3>(p, bid, nb, smem); grid.sync();
  run_phase<4>(p, bid, nb, smem); grid.sync();
  run_phase<5>(p, bid, nb, smem); grid.sync();
  run_phase<6>(p, bid, nb, smem); grid.sync();
  run_phase<7>(p, bid, nb, smem); grid.sync();
  run_phase<8>(p, bid, nb, smem); grid.sync();
  run_phase<9>(p, bid, nb, smem); grid.sync();
  run_phase<10>(p, bid, nb, smem);
}
#endif

template <int PH>
static void launch_phase(const P& p, int grid, hipStream_t stream) {
  static bool attr = false;
  if (!attr) { hipFuncSetAttribute((const void*)k_phase<PH>, hipFuncAttributeMaxDynamicSharedMemorySize, LDS_BYTES); attr = true; }
  hipLaunchKernelGGL(k_phase<PH>, dim3(grid), dim3(NTHREADS), LDS_BYTES, stream, p);
}

extern "C" void kernel_launch(void* const* d_in, const int* in_sizes, int n_in, void* d_out, int out_size, void* d_ws,
                              size_t ws_size, hipStream_t stream) {
  P p{};
  const float** fp = (const float**)&p;
  for (int i = 0; i < 40; i++) fp[i] = (const float*)d_in[i];
  p.out = (float*)d_out;
  char* ws = (char*)d_ws;
  size_t off = 0;
  auto take = [&](size_t bytes) { char* r = ws + off; off += (bytes + 255) & ~(size_t)255; return r; };
  p.w_inT = (u16*)take((size_t)INCOLS * D * 2);
  p.w_paT = (u16*)take((size_t)1024 * 512 * 2);
  p.w_pbT = (u16*)take((size_t)1024 * 1024 * 2);
  p.w_outT = (u16*)take((size_t)1024 * 1024 * 2);
  p.wqT = (u16*)take((size_t)2048 * 1024 * 2);
  p.keysb = (u16*)take((size_t)262144 * 2);
  p.mod = (float*)take((size_t)NSEQ * 8192 * 4);
  p.dtb = (float*)take((size_t)NT * 16 * 4);
  p.decb = (float*)take((size_t)NT * 16 * 4);
  p.xn = (u16*)take((size_t)NROWS * D * 2);
  p.proj = (u16*)take((size_t)NROWS * PCOLS * 2);
  p.prep = (u16*)take((size_t)NT * 3584 * 2);
  if (off > ws_size) { fprintf(stderr, "workspace too small: need %zu have %zu\n", off, ws_size); return; }
  p.merged = p.prep;
  p.ub = p.proj;
  p.vb = p.proj + (size_t)16384 * 1024;
  p.topv = (float*)(p.proj + (size_t)2 * 16384 * 1024);
  p.topi = (int*)(p.topv + (size_t)NT * 256);
  p.xc = (u16*)d_out;
  p.oa = (u16*)d_out;
  p.ob = (u16*)d_out + (size_t)NT * 512;

  static int grid = 0;
  if (!grid) {
    int dev = 0, cus = 0, per_cu = 0;
    hipGetDevice(&dev);
    hipDeviceGetAttribute(&cus, hipDeviceAttributeMultiprocessorCount, dev);
#if MEGA
    hipFuncSetAttribute((const void*)k_mega, hipFuncAttributeMaxDynamicSharedMemorySize, LDS_BYTES);
    hipOccupancyMaxActiveBlocksPerMultiprocessor(&per_cu, k_mega, NTHREADS, LDS_BYTES);
    if (per_cu > 2) per_cu = 2;
#else
    per_cu = 2;
#endif
    if (per_cu < 1) per_cu = 1;
    grid = cus * per_cu;
  }
#if MEGA
  void* args[] = {&p};
  hipError_t e = hipLaunchCooperativeKernel((void*)k_mega, dim3(grid), dim3(NTHREADS), args, LDS_BYTES, stream);
  if (e != hipSuccess) fprintf(stderr, "cooperative launch failed: %s (grid %d)\n", hipGetErrorString(e), grid);
#else
  launch_phase<0>(p, grid, stream);
  launch_phase<1>(p, grid, stream);
  launch_phase<2>(p, grid, stream);
  launch_phase<3>(p, grid, stream);
  launch_phase<4>(p, grid, stream);
  launch_phase<5>(p, grid, stream);
  launch_phase<6>(p, grid, stream);
  launch_phase<7>(p, grid, stream);
  launch_phase<8>(p, grid, stream);
  launch_phase<9>(p, grid, stream);
  launch_phase<10>(p, grid, stream);
#endif
}
```

```cpp
#include <hip/hip_runtime.h>
#include <hip/hip_cooperative_groups.h>
#include <cstdio>
namespace cg = cooperative_groups;

#ifndef MEGA
#define MEGA 1
#endif

typedef unsigned short u16;
typedef __attribute__((ext_vector_type(8))) short bf16x8;
typedef __attribute__((ext_vector_type(4))) float f32x4;

constexpr int D = 1024;
constexpr int NP = 16384, NS = 1024, NT = NP + NS, NSEQ = 136;
constexpr int NROWS = NT + 128;
constexpr int PCOLS = 4368;
constexpr int INCOLS = 6416;
constexpr int C_LW = 1536, C_LA = 1600, C_LG = 1664, C_Z = 1792, C_XBC = 2816, C_DT = 4352;
constexpr int G_A = 4368, G_B = 5392;
constexpr size_t O_Y = 0, O_PSHIFT = 17825792, O_PWKV = 17833984, O_PCONV = 18096128, O_PSSM = 18132992,
                 O_SSHIFT = 19181568, O_SWKV = 19312640, O_SCONV = 23506944, O_SSSM = 24096768;
constexpr int LDS_BYTES = 80 * 1024;
constexpr int NTHREADS = 256;

struct P {
  const float *x_prompt, *x_sample, *c_prompt, *c_sample, *state_shift, *state_wkv, *state_conv, *state_ssm;
  const float *w_ada, *b_ada, *norm1_g, *w_in, *rw_mu, *rw_w0, *rw_w2, *rw_a0, *rw_a2, *rw_g2, *rw_k_k, *rw_k_a,
      *rw_r_k, *rw_ln_w, *rw_ln_b;
  const float *conv_w, *conv_b, *dt_bias, *A_log, *D_skip, *ssm_norm_w, *w_pa, *w_pb, *w_out, *norm2_g, *peer_wq,
      *peer_keys, *peer_u, *peer_v, *final_g, *w_ada_f, *b_ada_f;
  float* out;
  u16 *w_inT, *w_paT, *w_pbT, *w_outT, *wqT, *keysb, *xn, *proj, *prep, *merged, *ub, *vb, *xc, *oa, *ob;
  float *mod, *dtb, *decb, *topv;
  int* topi;
};

__device__ __forceinline__ u16 f2bf(float f) {
  unsigned u = __float_as_uint(f);
  u += 0x7fffu + ((u >> 16) & 1u);
  return (u16)(u >> 16);
}
__device__ __forceinline__ float bf2f(u16 h) { return __uint_as_float(((unsigned)h) << 16); }
__device__ __forceinline__ unsigned pack2(float a, float b) { return (unsigned)f2bf(a) | ((unsigned)f2bf(b) << 16); }
__device__ __forceinline__ float bflo(unsigned u) { return __uint_as_float(u << 16); }
__device__ __forceinline__ float bfhi(unsigned u) { return __uint_as_float(u & 0xffff0000u); }
__device__ __forceinline__ float sigmoidf_(float x) { return 1.f / (1.f + __expf(-x)); }
__device__ __forceinline__ float siluf_(float x) { return x / (1.f + __expf(-x)); }
__device__ __forceinline__ float softplusf_(float x) { return x > 20.f ? x : log1pf(expf(x)); }

template <int CTRL>
__device__ __forceinline__ float dppf(float x) {
  return __int_as_float(__builtin_amdgcn_update_dpp(0, __float_as_int(x), CTRL, 0xf, 0xf, true));
}
__device__ __forceinline__ float allreduce16(float x) {
  x += dppf<0x128>(x);
  x += dppf<0x124>(x);
  x += dppf<0x122>(x);
  x += dppf<0x121>(x);
  return x;
}
__device__ __forceinline__ float allreduce8(float x) {
  x += dppf<0xB1>(x);
  x += dppf<0x4E>(x);
  x += dppf<0x141>(x);
  return x;
}
__device__ __forceinline__ float wave_sum(float x) {
#pragma unroll
  for (int o = 32; o >= 1; o >>= 1) x += __shfl_xor(x, o, 64);
  return x;
}
__device__ __forceinline__ float wave_max(float x) {
#pragma unroll
  for (int o = 32; o >= 1; o >>= 1) x = fmaxf(x, __shfl_xor(x, o, 64));
  return x;
}
__device__ __forceinline__ int wave_min_i(int x) {
#pragma unroll
  for (int o = 32; o >= 1; o >>= 1) x = min(x, __shfl_xor(x, o, 64));
  return x;
}

__device__ __forceinline__ const float* xrow(const P& p, int n) {
  return n < NP ? p.x_prompt + (size_t)n * D : p.x_sample + (size_t)(n - NP) * D;
}
__device__ __forceinline__ void tok2seq(int n, int& seq, int& t, int& T) {
  if (n < NP) { seq = n >> 11; t = n & 2047; T = 2048; }
  else { int m = n - NP; seq = 8 + (m >> 3); t = m & 7; T = 8; }
}
__device__ __forceinline__ float* seq_out(float* out, int seq, size_t op, size_t os, size_t per) {
  return seq < 8 ? out + op + (size_t)seq * per : out + os + (size_t)(seq - 8) * per;
}

constexpr int LROW = 144;
__device__ __forceinline__ void gemm_tile(const u16* __restrict__ A, int lda, int m0, const u16* __restrict__ Bt,
                                          int ldb, int n0, int K, f32x4 (&acc)[4][4], char* smem) {
  char* sA = smem;
  char* sB = smem + 128 * LROW;
  const int tid = threadIdx.x, lane = tid & 63, wid = tid >> 6, wr = wid >> 1, wc = wid & 1, fr = lane & 15,
            fq = lane >> 4;
  uint4 ra0, ra1, ra2, ra3, rb0, rb1, rb2, rb3;
  const int nk = K / 64;
  const int lrow = tid >> 3, lch = tid & 7;
  const u16* gA = A + (size_t)(m0 + lrow) * lda + lch * 8;
  const u16* gB = Bt + (size_t)(n0 + lrow) * ldb + lch * 8;
#define GLOAD(kt)                                                   \
  {                                                                 \
    ra0 = *(const uint4*)(gA + (kt) * 64);                          \
    ra1 = *(const uint4*)(gA + (size_t)32 * lda + (kt) * 64);       \
    ra2 = *(const uint4*)(gA + (size_t)64 * lda + (kt) * 64);       \
    ra3 = *(const uint4*)(gA + (size_t)96 * lda + (kt) * 64);       \
    rb0 = *(const uint4*)(gB + (kt) * 64);                          \
    rb1 = *(const uint4*)(gB + (size_t)32 * ldb + (kt) * 64);       \
    rb2 = *(const uint4*)(gB + (size_t)64 * ldb + (kt) * 64);       \
    rb3 = *(const uint4*)(gB + (size_t)96 * ldb + (kt) * 64);       \
  }
  GLOAD(0);
#pragma unroll 1
  for (int kt = 0; kt < nk; kt++) {
    __syncthreads();
    {
      char* wa = sA + lrow * LROW + lch * 16;
      char* wb = sB + lrow * LROW + lch * 16;
      *(uint4*)(wa) = ra0; *(uint4*)(wa + 32 * LROW) = ra1; *(uint4*)(wa + 64 * LROW) = ra2; *(uint4*)(wa + 96 * LROW) = ra3;
      *(uint4*)(wb) = rb0; *(uint4*)(wb + 32 * LROW) = rb1; *(uint4*)(wb + 64 * LROW) = rb2; *(uint4*)(wb + 96 * LROW) = rb3;
    }
    __syncthreads();
    if (kt + 1 < nk) GLOAD(kt + 1);
#pragma unroll
    for (int s = 0; s < 2; s++) {
      bf16x8 af[4], bfr[4];
#pragma unroll
      for (int m = 0; m < 4; m++) af[m] = *(const bf16x8*)(sA + (wr * 64 + m * 16 + fr) * LROW + s * 64 + fq * 16);
#pragma unroll
      for (int n = 0; n < 4; n++) bfr[n] = *(const bf16x8*)(sB + (wc * 64 + n * 16 + fr) * LROW + s * 64 + fq * 16);
#pragma unroll
      for (int m = 0; m < 4; m++)
#pragma unroll
        for (int n = 0; n < 4; n++) acc[m][n] = __builtin_amdgcn_mfma_f32_16x16x32_bf16(af[m], bfr[n], acc[m][n], 0, 0, 0);
    }
  }
  __syncthreads();
}
__device__ __forceinline__ void zero_acc(f32x4 (&acc)[4][4]) {
#pragma unroll
  for (int m = 0; m < 4; m++)
#pragma unroll
    for (int n = 0; n < 4; n++) acc[m][n] = f32x4{0.f, 0.f, 0.f, 0.f};
}
#define ACC_FOREACH(...)                                                                    \
  {                                                                                         \
    const int _l = threadIdx.x & 63, _w = threadIdx.x >> 6, _wr = _w >> 1, _wc = _w & 1;    \
    const int _fr = _l & 15, _fq = _l >> 4;                                                 \
    _Pragma("unroll") for (int m = 0; m < 4; m++) _Pragma("unroll") for (int n = 0; n < 4; n++) \
        _Pragma("unroll") for (int j = 0; j < 4; j++) {                                     \
      const int row = _wr * 64 + m * 16 + _fq * 4 + j, col = _wc * 64 + n * 16 + _fr;       \
      __VA_ARGS__                                                                           \
    }                                                                                       \
  }

__device__ void transpose_tile(const float* __restrict__ src, int K, int N, u16* __restrict__ dst, int tile,
                               char* smem) {
  const int ntn = (N + 63) / 64, kt = tile / ntn, nt = tile % ntn, tid = threadIdx.x;
  float(*s)[65] = (float(*)[65])smem;
  __syncthreads();
#pragma unroll 4
  for (int i = 0; i < 16; i++) {
    int r = (tid >> 6) + 4 * i, n = nt * 64 + (tid & 63);
    s[r][tid & 63] = (n < N) ? src[(size_t)(kt * 64 + r) * N + n] : 0.f;
  }
  __syncthreads();
#pragma unroll 4
  for (int i = 0; i < 8; i++) {
    int nl = (tid >> 5) + 8 * i, n = nt * 64 + nl, kl = (tid & 31) * 2;
    if (n < N) *(unsigned*)(dst + (size_t)n * K + kt * 64 + kl) = pack2(s[kl][nl], s[kl + 1][nl]);
  }
}

__device__ void mod_item(const P& p, int item, char* smem) {
  const int tid = threadIdx.x, j = tid & 31, g = tid >> 5;
  const int col0 = item * 32;
  const float* W; const float* bias; int N, cw;
  if (col0 < 6144) { W = p.w_ada; bias = p.b_ada; N = 6144; cw = col0; }
  else { W = p.w_ada_f; bias = p.b_ada_f; N = 2048; cw = col0 - 6144; }
  float(*cs)[68] = (float(*)[68])smem;
  float acc[17];
#pragma unroll
  for (int s = 0; s < 17; s++) acc[s] = 0.f;
  for (int k0 = 0; k0 < 1024; k0 += 64) {
    __syncthreads();
    for (int idx = tid; idx < NSEQ * 64; idx += 256) {
      int seq = idx >> 6, kk = idx & 63;
      float c = seq < 8 ? p.c_prompt[seq * 1024 + k0 + kk] : p.c_sample[(seq - 8) * 1024 + k0 + kk];
      cs[seq][kk] = siluf_(c);
    }
    __syncthreads();
#pragma unroll 2
    for (int k4 = 0; k4 < 16; k4++) {
      const float* wp = W + (size_t)(k0 + k4 * 4) * N + cw + j;
      float w0 = wp[0], w1 = wp[N], w2 = wp[2 * (size_t)N], w3 = wp[3 * (size_t)N];
#pragma unroll
      for (int s = 0; s < 17; s++) {
        float4 c4 = *(const float4*)&cs[g * 17 + s][k4 * 4];
        acc[s] += w0 * c4.x + w1 * c4.y + w2 * c4.z + w3 * c4.w;
      }
    }
  }
  float b = bias[cw + j];
#pragma unroll
  for (int s = 0; s < 17; s++) p.mod[(size_t)(g * 17 + s) * 8192 + col0 + j] = acc[s] + b;
}

constexpr int J_MOD = 256, J_WIN = 16 * 101, J_WPA = 8 * 16, J_WPB = 256, J_WOUT = 256, J_WQ = 16 * 32, J_KEYS = 128,
              J_SHIFT = 64;
constexpr int PH0_ITEMS = J_MOD + J_WIN + J_WPA + J_WPB + J_WOUT + J_WQ + J_KEYS + J_SHIFT;

__device__ void phase0(const P& p, int bid, int nb, char* smem) {
  for (int it = bid; it < PH0_ITEMS; it += nb) {
    int i = it;
    if (i < J_MOD) { mod_item(p, i, smem); continue; }
    i -= J_MOD;
    if (i < J_WIN) { transpose_tile(p.w_in, 1024, INCOLS, p.w_inT, i, smem); continue; }
    i -= J_WIN;
    if (i < J_WPA) { transpose_tile(p.w_pa, 512, 1024, p.w_paT, i, smem); continue; }
    i -= J_WPA;
    if (i < J_WPB) { transpose_tile(p.w_pb, 1024, 1024, p.w_pbT, i, smem); continue; }
    i -= J_WPB;
    if (i < J_WOUT) { transpose_tile(p.w_out, 1024, 1024, p.w_outT, i, smem); continue; }
    i -= J_WOUT;
    if (i < J_WQ) { transpose_tile(p.peer_wq, 1024, 2048, p.wqT, i, smem); continue; }
    i -= J_WQ;
    const float* src; u16* dst;
    if (i < J_KEYS) { src = p.peer_keys + (size_t)i * 2048; dst = p.keysb + (size_t)i * 2048; }
    else { i -= J_KEYS; src = p.state_shift + (size_t)i * 2048; dst = p.xn + (size_t)NT * D + (size_t)i * 2048; }
    const float4* s4 = (const float4*)src + threadIdx.x * 2;
    float4 a = s4[0], b = s4[1];
    uint4 o; o.x = pack2(a.x, a.y); o.y = pack2(a.z, a.w); o.z = pack2(b.x, b.y); o.w = pack2(b.z, b.w);
    *((uint4*)dst + threadIdx.x) = o;
  }
}

template <bool SECOND>
__device__ void phase_norm(const P& p, int bid, int nb) {
  const int lane = threadIdx.x & 63, wid = threadIdx.x >> 6;
  const float* gam = SECOND ? p.norm2_g : p.norm1_g;
  for (int it = bid; it < NT / 4; it += nb) {
    const int n = it * 4 + wid;
    int seq, t, T; tok2seq(n, seq, t, T);
    const float* xr = SECOND ? p.out + O_Y + (size_t)n * D : xrow(p, n);
    const float* md = p.mod + (size_t)seq * 8192 + (SECOND ? 3072 : 0);
    float4 v[4];
    float ss = 0.f;
#pragma unroll
    for (int i = 0; i < 4; i++) {
      v[i] = ((const float4*)xr)[lane + 64 * i];
      ss += v[i].x * v[i].x + v[i].y * v[i].y + v[i].z * v[i].z + v[i].w * v[i].w;
    }
    ss = wave_sum(ss);
    const float rstd = rsqrtf(ss * (1.f / 1024.f) + 1e-6f);
    const bool last = (!SECOND) && (t == T - 1);
    float* so = seq_out(p.out, seq, O_PSHIFT, O_SSHIFT, 1024);
#pragma unroll
    for (int i = 0; i < 4; i++) {
      const int c = (lane + 64 * i) * 4;
      float4 g = *(const float4*)(gam + c), sh = *(const float4*)(md + c), sc = *(const float4*)(md + 1024 + c);
      float4 o;
      o.x = v[i].x * rstd * g.x * (1.f + sc.x) + sh.x;
      o.y = v[i].y * rstd * g.y * (1.f + sc.y) + sh.y;
      o.z = v[i].z * rstd * g.z * (1.f + sc.z) + sh.z;
      o.w = v[i].w * rstd * g.w * (1.f + sc.w) + sh.w;
      uint2 pk; pk.x = pack2(o.x, o.y); pk.y = pack2(o.z, o.w);
      *(uint2*)(p.xn + (size_t)n * D + c) = pk;
      if (last) *(float4*)(so + c) = o;
    }
  }
}

constexpr int P2_NT = 35, P2_MT = 137;
__device__ void phase2(const P& p, int bid, int nb, char* smem) {
  for (int it = bid; it < P2_MT * P2_NT; it += nb) {
    const int mt = it / P2_NT, nt = it % P2_NT;
    f32x4 acc[4][4];
    zero_acc(acc);
    gemm_tile(p.xn, D, mt * 128, p.w_inT, D, nt * 128, D, acc, smem);
    ACC_FOREACH({
      const int gc = nt * 128 + col;
      if (gc < PCOLS) p.proj[(size_t)(mt * 128 + row) * PCOLS + gc] = f2bf(acc[m][n][j]);
    })
  }
}

__device__ void rwkv_prep_item(const P& p, int item, char* smem) {
  const int tid = threadIdx.x, lane = tid & 63;
  const int n0 = item * 8;
  int seq, t0, T; tok2seq(n0, seq, t0, T);
  float(*q)[1792] = (float(*)[1792])smem;
  __syncthreads();
  for (int idx = tid; idx < 8 * 224; idx += 256) {
    const int tok = idx / 224, ch = idx % 224, c = ch * 8;
    const int n = n0 + tok, t = t0 + tok;
    uint4 pc = *(const uint4*)(p.proj + (size_t)n * PCOLS + c);
    uint4 pp = make_uint4(0, 0, 0, 0);
    if (t > 0) pp = *(const uint4*)(p.proj + (size_t)(n - 1) * PCOLS + c);
    else if (seq >= 8) pp = *(const uint4*)(p.proj + (size_t)(NT + seq - 8) * PCOLS + c);
    unsigned pcs[4] = {pc.x, pc.y, pc.z, pc.w}, pps[4] = {pp.x, pp.y, pp.z, pp.w};
#pragma unroll
    for (int e = 0; e < 4; e++) {
      float a0 = bflo(pcs[e]), a1 = bfhi(pcs[e]), b0 = bflo(pps[e]), b1 = bfhi(pps[e]);
      float m0 = p.rw_mu[c + 2 * e], m1 = p.rw_mu[c + 2 * e + 1];
      float q0 = a0 + (b0 - a0) * m0, q1 = a1 + (b1 - a1) * m1;
      if (c >= C_LW && c < C_LA) { q0 = tanhf(q0); q1 = tanhf(q1); }
      else if (c >= C_LG) { q0 = sigmoidf_(q0); q1 = sigmoidf_(q1); }
      q[tok][c + 2 * e] = q0; q[tok][c + 2 * e + 1] = q1;
    }
  }
  __syncthreads();
  float aw[8][2], aa[8][2], ag[8][2];
#pragma unroll
  for (int k = 0; k < 8; k++) { aw[k][0] = aw[k][1] = aa[k][0] = aa[k][1] = ag[k][0] = ag[k][1] = 0.f; }
  const int c0 = tid, c1 = tid + 256;
  for (int i4 = 0; i4 < 16; i4++) {
    float w2a[4], w2b[4], a2a[4], a2b[4];
#pragma unroll
    for (int e = 0; e < 4; e++) {
      const int i = i4 * 4 + e;
      w2a[e] = p.rw_w2[i * 512 + c0]; w2b[e] = p.rw_w2[i * 512 + c1];
      a2a[e] = p.rw_a2[i * 512 + c0]; a2b[e] = p.rw_a2[i * 512 + c1];
    }
#pragma unroll
    for (int k = 0; k < 8; k++) {
      float4 th = *(const float4*)&q[k][C_LW + i4 * 4];
      float4 la = *(const float4*)&q[k][C_LA + i4 * 4];
      aw[k][0] += th.x * w2a[0] + th.y * w2a[1] + th.z * w2a[2] + th.w * w2a[3];
      aw[k][1] += th.x * w2b[0] + th.y * w2b[1] + th.z * w2b[2] + th.w * w2b[3];
      aa[k][0] += la.x * a2a[0] + la.y * a2a[1] + la.z * a2a[2] + la.w * a2a[3];
      aa[k][1] += la.x * a2b[0] + la.y * a2b[1] + la.z * a2b[2] + la.w * a2b[3];
    }
  }
  for (int i4 = 0; i4 < 32; i4++) {
    float g2a[4], g2b[4];
#pragma unroll
    for (int e = 0; e < 4; e++) {
      const int i = i4 * 4 + e;
      g2a[e] = p.rw_g2[i * 512 + c0]; g2b[e] = p.rw_g2[i * 512 + c1];
    }
#pragma unroll
    for (int k = 0; k < 8; k++) {
      float4 sg = *(const float4*)&q[k][C_LG + i4 * 4];
      ag[k][0] += sg.x * g2a[0] + sg.y * g2a[1] + sg.z * g2a[2] + sg.w * g2a[3];
      ag[k][1] += sg.x * g2b[0] + sg.y * g2b[1] + sg.z * g2b[2] + sg.w * g2b[3];
    }
  }
#pragma unroll
  for (int h2 = 0; h2 < 2; h2++) {
    const int col = h2 ? c1 : c0;
    const float w0 = p.rw_w0[col], a0 = p.rw_a0[col], kkw = p.rw_k_k[col], kaw = p.rw_k_a[col];
#pragma unroll
    for (int k = 0; k < 8; k++) {
      const float wpre = w0 + aw[k][h2];
      const float w = -softplusf_(-wpre) - 0.5f;
      const float logd = -expf(w);
      const float a = sigmoidf_(a0 + aa[k][h2]);
      const float g = ag[k][h2];
      const float r = q[k][col], kx = q[k][512 + col], v = q[k][1024 + col];
      const float kkv = kx * kkw;
      const float ssq = wave_sum(kkv * kkv);
      const float kk = kkv / fmaxf(sqrtf(ssq), 1e-12f);
      const float k2 = kx * (1.f + (a - 1.f) * kaw);
      const float b = kk * a;
      u16* o = p.prep + (size_t)(n0 + k) * 3584 + col;
      o[0] = f2bf(logd); o[512] = f2bf(r); o[1024] = f2bf(k2); o[1536] = f2bf(kk); o[2048] = f2bf(b);
      o[2560] = f2bf(v); o[3072] = f2bf(g);
    }
  }
  (void)lane;
}

__device__ void conv_prep_item(const P& p, int item) {
  const int tid = threadIdx.x;
  const int n0 = item * 8;
  int seq, t0, T; tok2seq(n0, seq, t0, T);
#pragma unroll 1
  for (int i = 0; i < 6; i++) {
    const int c = tid + 256 * i;
    const float w0 = p.conv_w[c], w1 = p.conv_w[1536 + c], w2 = p.conv_w[3072 + c], w3 = p.conv_w[4608 + c],
                cb = p.conv_b[c];
    float f[3];
#pragma unroll
    for (int j = 0; j < 3; j++) {
      const int tt = t0 - 3 + j;
      if (tt >= 0) f[j] = bf2f(p.proj[(size_t)(n0 - 3 + j) * PCOLS + C_XBC + c]);
      else f[j] = seq < 8 ? 0.f : p.state_conv[((size_t)(seq - 8) * 3 + (tt + 3)) * 1536 + c];
    }
#pragma unroll
    for (int k = 0; k < 8; k++) {
      const float cur = bf2f(p.proj[(size_t)(n0 + k) * PCOLS + C_XBC + c]);
      const float cv = cb + f[0] * w0 + f[1] * w1 + f[2] * w2 + cur * w3;
      p.xc[(size_t)(n0 + k) * 1536 + c] = f2bf(siluf_(cv));
      f[0] = f[1]; f[1] = f[2]; f[2] = cur;
    }
    if (t0 + 8 == T) {
      float* co = seq_out(p.out, seq, O_PCONV, O_SCONV, 3 * 1536);
      co[c] = f[0]; co[1536 + c] = f[1]; co[3072 + c] = f[2];
    }
  }
  if (tid < 128) {
    const int k = tid >> 4, h = tid & 15, n = n0 + k;
    const float raw = bf2f(p.proj[(size_t)n * PCOLS + C_DT + h]) + p.dt_bias[h];
    const float dt = softplusf_(raw);
    const float dA = -dt * expf(p.A_log[h]);
    p.dtb[n * 16 + h] = dt;
    p.decb[n * 16 + h] = expf(dA);
  }
}

__device__ void phase3(const P& p, int bid, int nb, char* smem) {
  for (int it = bid; it < 2 * (NT / 8); it += nb) {
    if (it < NT / 8) rwkv_prep_item(p, it, smem);
    else conv_prep_item(p, it - NT / 8);
  }
}

constexpr int TC = 32;
__device__ void rwkv_scan_item(const P& p, int seq, int h, int qr, char* smem) {
  const int T = seq < 8 ? 2048 : 8, nbase = seq < 8 ? seq * 2048 : NP + (seq - 8) * 8;
  float* Ld = (float*)smem;
  float* Lr = Ld + TC * 64; float* Lk = Lr + TC * 64; float* Lkk = Lk + TC * 64; float* Lb = Lkk + TC * 64;
  float* Lv = Lb + TC * 64;
  float* Ly = Lv + TC * 16;
  const int tid = threadIdx.x, w = tid >> 6, lane = tid & 63, rl = w * 4 + (lane >> 4), ks = lane & 15;
  const int v = qr * 16 + rl;
  float S0 = 0.f, S1 = 0.f, S2 = 0.f, S3 = 0.f;
  if (seq >= 8) {
    float4 s = *(const float4*)(p.state_wkv + (((size_t)(seq - 8) * 8 + h) * 64 + v) * 64 + ks * 4);
    S0 = s.x; S1 = s.y; S2 = s.z; S3 = s.w;
  }
  for (int c0 = 0; c0 < T; c0 += TC) {
    const int tc = min(TC, T - c0);
    __syncthreads();
    {
      const int tt = tid >> 3, k8 = (tid & 7) * 8;
      if (tt < tc) {
        const u16* base = p.prep + (size_t)(nbase + c0 + tt) * 3584 + h * 64 + k8;
        float* dsts[5] = {Ld, Lr, Lk, Lkk, Lb};
#pragma unroll
        for (int a = 0; a < 5; a++) {
          uint4 u = *(const uint4*)(base + a * 512);
          float4 lo, hi;
          lo.x = bflo(u.x); lo.y = bfhi(u.x); lo.z = bflo(u.y); lo.w = bfhi(u.y);
          hi.x = bflo(u.z); hi.y = bfhi(u.z); hi.z = bflo(u.w); hi.w = bfhi(u.w);
          if (a == 0) {
            lo.x = __expf(lo.x); lo.y = __expf(lo.y); lo.z = __expf(lo.z); lo.w = __expf(lo.w);
            hi.x = __expf(hi.x); hi.y = __expf(hi.y); hi.z = __expf(hi.z); hi.w = __expf(hi.w);
          }
          *(float4*)(dsts[a] + tt * 64 + k8) = lo;
          *(float4*)(dsts[a] + tt * 64 + k8 + 4) = hi;
        }
      }
      for (int idx = tid; idx < tc * 16; idx += 256) {
        const int t2 = idx >> 4, r = idx & 15;
        Lv[idx] = bf2f(p.prep[(size_t)(nbase + c0 + t2) * 3584 + 2560 + h * 64 + qr * 16 + r]);
      }
    }
    __syncthreads();
    for (int tt = 0; tt < tc; tt++) {
      const float4 kk4 = *(const float4*)(Lkk + tt * 64 + ks * 4);
      const float4 d4 = *(const float4*)(Ld + tt * 64 + ks * 4);
      const float4 b4 = *(const float4*)(Lb + tt * 64 + ks * 4);
      const float4 k4 = *(const float4*)(Lk + tt * 64 + ks * 4);
      const float4 r4 = *(const float4*)(Lr + tt * 64 + ks * 4);
      const float vv = Lv[tt * 16 + rl];
      float sk = S0 * kk4.x + S1 * kk4.y + S2 * kk4.z + S3 * kk4.w;
      sk = allreduce16(sk);
      S0 = S0 * d4.x + (vv * k4.x - sk * b4.x);
      S1 = S1 * d4.y + (vv * k4.y - sk * b4.y);
      S2 = S2 * d4.z + (vv * k4.z - sk * b4.z);
      S3 = S3 * d4.w + (vv * k4.w - sk * b4.w);
      float y = S0 * r4.x + S1 * r4.y + S2 * r4.z + S3 * r4.w;
      y = allreduce16(y);
      if (ks == 0) Ly[tt * 16 + rl] = y;
    }
    __syncthreads();
    for (int idx = tid; idx < tc * 16; idx += 256) {
      const int t2 = idx >> 4, r = idx & 15;
      p.proj[(size_t)(nbase + c0 + t2) * PCOLS + h * 64 + qr * 16 + r] = f2bf(Ly[idx]);
    }
  }
  float* so = seq_out(p.out, seq, O_PWKV, O_SWKV, 8 * 4096);
  *(float4*)(so + ((size_t)h * 64 + v) * 64 + ks * 4) = make_float4(S0, S1, S2, S3);
}

__device__ void ssm_scan_item(const P& p, int seq, int head, int half, char* smem) {
  const int T = seq < 8 ? 2048 : 8, nbase = seq < 8 ? seq * 2048 : NP + (seq - 8) * 8;
  float* LB = (float*)smem;
  float* LC = LB + TC * 128;
  float* Lx = LC + TC * 128;
  float* Ly = Lx + TC * 32;
  float* Ldt = Ly + TC * 32;
  float* Ldec = Ldt + TC;
  const int tid = threadIdx.x, pl = tid >> 3, ns = tid & 7;
  const int pp = half * 32 + pl, g = head >> 3;
  const float Dk = p.D_skip[head];
  float hs[16];
#pragma unroll
  for (int j = 0; j < 16; j++) hs[j] = 0.f;
  if (seq >= 8) {
    const float4* s4 = (const float4*)(p.state_ssm + (((size_t)(seq - 8) * 16 + head) * 64 + pp) * 128 + ns * 16);
#pragma unroll
    for (int j = 0; j < 4; j++) { float4 s = s4[j]; hs[4 * j] = s.x; hs[4 * j + 1] = s.y; hs[4 * j + 2] = s.z; hs[4 * j + 3] = s.w; }
  }
  for (int c0 = 0; c0 < T; c0 += TC) {
    const int tc = min(TC, T - c0);
    __syncthreads();
    {
      for (int idx = tid; idx < tc * 32; idx += 256) {
        const int tt = idx >> 5, ch = idx & 31;
        const u16* src = p.xc + (size_t)(nbase + c0 + tt) * 1536 + 1024 + (ch < 16 ? 0 : 256) + g * 128 + (ch & 15) * 8;
        uint4 u = *(const uint4*)src;
        float* dst = (ch < 16 ? LB : LC) + tt * 128 + (ch & 15) * 8;
        *(float4*)dst = make_float4(bflo(u.x), bfhi(u.x), bflo(u.y), bfhi(u.y));
        *(float4*)(dst + 4) = make_float4(bflo(u.z), bfhi(u.z), bflo(u.w), bfhi(u.w));
      }
      for (int idx = tid; idx < tc * 32; idx += 256) {
        const int tt = idx >> 5, r = idx & 31;
        Lx[idx] = bf2f(p.xc[(size_t)(nbase + c0 + tt) * 1536 + head * 64 + half * 32 + r]);
      }
      if (tid < tc) { Ldt[tid] = p.dtb[(nbase + c0 + tid) * 16 + head]; Ldec[tid] = p.decb[(nbase + c0 + tid) * 16 + head]; }
    }
    __syncthreads();
    for (int tt = 0; tt < tc; tt++) {
      const float xv = Lx[tt * 32 + pl];
      const float dtx = Ldt[tt] * xv, dec = Ldec[tt];
      const float4* B4 = (const float4*)(LB + tt * 128 + ns * 16);
      const float4* C4 = (const float4*)(LC + tt * 128 + ns * 16);
      float yp = 0.f;
#pragma unroll
      for (int j = 0; j < 4; j++) {
        const float4 b = B4[j], c = C4[j];
        hs[4 * j] = hs[4 * j] * dec + dtx * b.x;
        hs[4 * j + 1] = hs[4 * j + 1] * dec + dtx * b.y;
        hs[4 * j + 2] = hs[4 * j + 2] * dec + dtx * b.z;
        hs[4 * j + 3] = hs[4 * j + 3] * dec + dtx * b.w;
        yp += hs[4 * j] * c.x + hs[4 * j + 1] * c.y + hs[4 * j + 2] * c.z + hs[4 * j + 3] * c.w;
      }
      yp = allreduce8(yp);
      if (ns == 0) Ly[tt * 32 + pl] = yp + Dk * xv;
    }
    __syncthreads();
    for (int idx = tid; idx < tc * 32; idx += 256) {
      const int tt = idx >> 5, r = idx & 31;
      p.proj[(size_t)(nbase + c0 + tt) * PCOLS + C_XBC + head * 64 + half * 32 + r] = f2bf(Ly[idx]);
    }
  }
  float* so = seq_out(p.out, seq, O_PSSM, O_SSSM, 16 * 8192);
  float4* o4 = (float4*)(so + ((size_t)head * 64 + pp) * 128 + ns * 16);
#pragma unroll
  for (int j = 0; j < 4; j++) o4[j] = make_float4(hs[4 * j], hs[4 * j + 1], hs[4 * j + 2], hs[4 * j + 3]);
}

constexpr int P4_RP = 256, P4_SP = 256, P4_RS = 4096, P4_SS = 4096;
__device__ void phase4(const P& p, int bid, int nb, char* smem) {
  for (int it = bid; it < P4_RP + P4_SP + P4_RS + P4_SS; it += nb) {
    int i = it;
    if (i < P4_RP) { rwkv_scan_item(p, i >> 5, (i >> 2) & 7, i & 3, smem); continue; }
    i -= P4_RP;
    if (i < P4_SP) { ssm_scan_item(p, i >> 5, (i >> 1) & 15, i & 1, smem); continue; }
    i -= P4_SP;
    if (i < P4_RS) { rwkv_scan_item(p, 8 + (i >> 5), (i >> 2) & 7, i & 3, smem); continue; }
    i -= P4_RS;
    ssm_scan_item(p, 8 + (i >> 5), (i >> 1) & 15, i & 1, smem);
  }
}

__device__ void phase5(const P& p, int bid, int nb) {
  const int lane = threadIdx.x & 63, wid = threadIdx.x >> 6;
  for (int it = bid; it < NT / 4; it += nb) {
    const int n = it * 4 + wid;
    {
      const int c = lane * 8;
      uint4 yu = *(const uint4*)(p.proj + (size_t)n * PCOLS + c);
      const u16* pr = p.prep + (size_t)n * 3584 + c;
      uint4 ru = *(const uint4*)(pr + 512), ku = *(const uint4*)(pr + 1024), vu = *(const uint4*)(pr + 2560),
            gu = *(const uint4*)(pr + 3072);
      unsigned ys[4] = {yu.x, yu.y, yu.z, yu.w}, rs[4] = {ru.x, ru.y, ru.z, ru.w}, ks_[4] = {ku.x, ku.y, ku.z, ku.w},
               vs[4] = {vu.x, vu.y, vu.z, vu.w}, gs[4] = {gu.x, gu.y, gu.z, gu.w};
      float y[8], r[8], k[8], v[8], g[8];
#pragma unroll
      for (int e = 0; e < 4; e++) {
        y[2 * e] = bflo(ys[e]); y[2 * e + 1] = bfhi(ys[e]);
        r[2 * e] = bflo(rs[e]); r[2 * e + 1] = bfhi(rs[e]);
        k[2 * e] = bflo(ks_[e]); k[2 * e + 1] = bfhi(ks_[e]);
        v[2 * e] = bflo(vs[e]); v[2 * e + 1] = bfhi(vs[e]);
        g[2 * e] = bflo(gs[e]); g[2 * e + 1] = bfhi(gs[e]);
      }
      float s = 0.f, bn = 0.f;
#pragma unroll
      for (int e = 0; e < 8; e++) { s += y[e]; bn += r[e] * k[e] * p.rw_r_k[c + e]; }
      s = allreduce8(s); bn = allreduce8(bn);
      const float mean = s * (1.f / 64.f);
      float vr = 0.f;
#pragma unroll
      for (int e = 0; e < 8; e++) { const float d = y[e] - mean; vr += d * d; }
      vr = allreduce8(vr) * (1.f / 64.f);
      const float rs_ = rsqrtf(vr + 64e-5f);
      float o[8];
#pragma unroll
      for (int e = 0; e < 8; e++) {
        const float yn = (y[e] - mean) * rs_ * p.rw_ln_w[c + e] + p.rw_ln_b[c + e];
        o[e] = (yn + bn * v[e]) * g[e];
      }
      uint4 ou; ou.x = pack2(o[0], o[1]); ou.y = pack2(o[2], o[3]); ou.z = pack2(o[4], o[5]); ou.w = pack2(o[6], o[7]);
      *(uint4*)(p.oa + (size_t)n * 512 + c) = ou;
    }
    {
      const int c = lane * 16;
      float yv[16];
      float ss = 0.f;
#pragma unroll
      for (int hh = 0; hh < 2; hh++) {
        uint4 yu = *(const uint4*)(p.proj + (size_t)n * PCOLS + C_XBC + c + hh * 8);
        uint4 zu = *(const uint4*)(p.proj + (size_t)n * PCOLS + C_Z + c + hh * 8);
        unsigned ys[4] = {yu.x, yu.y, yu.z, yu.w}, zs[4] = {zu.x, zu.y, zu.z, zu.w};
#pragma unroll
        for (int e = 0; e < 4; e++) {
          const float a = bflo(ys[e]) * siluf_(bflo(zs[e])), b = bfhi(ys[e]) * siluf_(bfhi(zs[e]));
          yv[hh * 8 + 2 * e] = a; yv[hh * 8 + 2 * e + 1] = b;
          ss += a * a + b * b;
        }
      }
#pragma unroll
      for (int o = 16; o >= 1; o >>= 1) ss += __shfl_xor(ss, o, 64);
      const float rstd = rsqrtf(ss * (1.f / 512.f) + 1e-6f);
      unsigned ou[8];
#pragma unroll
      for (int e = 0; e < 8; e++)
        ou[e] = pack2(yv[2 * e] * rstd * p.ssm_norm_w[c + 2 * e], yv[2 * e + 1] * rstd * p.ssm_norm_w[c + 2 * e + 1]);
      *(uint4*)(p.ob + (size_t)n * 1024 + c) = make_uint4(ou[0], ou[1], ou[2], ou[3]);
      *(uint4*)(p.ob + (size_t)n * 1024 + c + 8) = make_uint4(ou[4], ou[5], ou[6], ou[7]);
    }
  }
}

__device__ void phase6(const P& p, int bid, int nb, char* smem) {
  for (int it = bid; it < 136 * 8; it += nb) {
    const int mt = it >> 3, nt = it & 7;
    f32x4 ac[4][4];
    unsigned sg[4][4][2];
    u16* Lm = (u16*)(smem + 2 * 128 * LROW);
    zero_acc(ac);
    gemm_tile(p.xn, D, mt * 128, p.w_inT + (size_t)G_A * D, D, nt * 128, D, ac, smem);
#pragma unroll
    for (int m = 0; m < 4; m++)
#pragma unroll
      for (int n = 0; n < 4; n++) {
        sg[m][n][0] = pack2(sigmoidf_(ac[m][n][0]), sigmoidf_(ac[m][n][1]));
        sg[m][n][1] = pack2(sigmoidf_(ac[m][n][2]), sigmoidf_(ac[m][n][3]));
      }
    zero_acc(ac);
    gemm_tile(p.oa, 512, mt * 128, p.w_paT, 512, nt * 128, 512, ac, smem);
    ACC_FOREACH({
      const unsigned gu = sg[m][n][j >> 1];
      const float gv = (j & 1) ? bfhi(gu) : bflo(gu);
      Lm[row * 136 + col] = f2bf(gv * ac[m][n][j]);
    })
    zero_acc(ac);
    gemm_tile(p.xn, D, mt * 128, p.w_inT + (size_t)G_B * D, D, nt * 128, D, ac, smem);
#pragma unroll
    for (int m = 0; m < 4; m++)
#pragma unroll
      for (int n = 0; n < 4; n++) {
        sg[m][n][0] = pack2(sigmoidf_(ac[m][n][0]), sigmoidf_(ac[m][n][1]));
        sg[m][n][1] = pack2(sigmoidf_(ac[m][n][2]), sigmoidf_(ac[m][n][3]));
      }
    zero_acc(ac);
    gemm_tile(p.ob, D, mt * 128, p.w_pbT, D, nt * 128, D, ac, smem);
    ACC_FOREACH({
      const unsigned gu = sg[m][n][j >> 1];
      const float gv = (j & 1) ? bfhi(gu) : bflo(gu);
      const float v = bf2f(Lm[row * 136 + col]) + gv * ac[m][n][j];
      p.merged[(size_t)(mt * 128 + row) * D + nt * 128 + col] = f2bf(v);
    })
  }
}

constexpr int P7_G = 136 * 8, P7_CV = 16384;
__device__ void phase7(const P& p, int bid, int nb, char* smem) {
  for (int it = bid; it < P7_G + P7_CV; it += nb) {
    if (it < P7_G) {
      const int mt = it >> 3, nt = it & 7;
      f32x4 acc[4][4];
      zero_acc(acc);
      gemm_tile(p.merged, D, mt * 128, p.w_outT, D, nt * 128, D, acc, smem);
      ACC_FOREACH({
        const int nn = mt * 128 + row, c = nt * 128 + col;
        int seq, t, T; tok2seq(nn, seq, t, T);
        const float gt = p.mod[(size_t)seq * 8192 + 2048 + c];
        p.out[O_Y + (size_t)nn * D + c] = xrow(p, nn)[c] + gt * acc[m][n][j];
      })
    } else {
      int i = it - P7_G;
      const float* src; u16* dst;
      if (i < 8192) { src = p.peer_u + (size_t)i * 2048; dst = p.ub + (size_t)i * 2048; }
      else { i -= 8192; src = p.peer_v + (size_t)i * 2048; dst = p.vb + (size_t)i * 2048; }
      const float4* s4 = (const float4*)src + threadIdx.x * 2;
      float4 a = s4[0], b = s4[1];
      uint4 o; o.x = pack2(a.x, a.y); o.y = pack2(a.z, a.w); o.z = pack2(b.x, b.y); o.w = pack2(b.z, b.w);
      *((uint4*)dst + threadIdx.x) = o;
    }
  }
}

__device__ void phase9(const P& p, int bid, int nb, char* smem) {
  const int tid = threadIdx.x, lane = tid & 63, wid = tid >> 6, wr = wid >> 1, wc = wid & 1, fr = lane & 15,
            fq = lane >> 4;
  for (int it = bid; it < 136 * 16; it += nb) {
    const int mt = it >> 4, nt = it & 15;
    f32x4 acc[4][4];
    zero_acc(acc);
    gemm_tile(p.xn, D, mt * 128, p.wqT, D, nt * 128, D, acc, smem);
    u16* Lq = (u16*)smem;
    ACC_FOREACH({ Lq[row * 136 + col] = f2bf(acc[m][n][j]); })
    __syncthreads();
    f32x4 sc[4][4];
    zero_acc(sc);
    const u16* kb = p.keysb + (size_t)nt * 128 * 128;
#pragma unroll
    for (int s = 0; s < 4; s++) {
      bf16x8 af[4], bfr[4];
#pragma unroll
      for (int m = 0; m < 4; m++) af[m] = *(const bf16x8*)((const char*)Lq + (wr * 64 + m * 16 + fr) * 272 + s * 64 + fq * 16);
#pragma unroll
      for (int n = 0; n < 4; n++) bfr[n] = *(const bf16x8*)(kb + (size_t)(wc * 64 + n * 16 + fr) * 128 + s * 32 + fq * 8);
#pragma unroll
      for (int m = 0; m < 4; m++)
#pragma unroll
        for (int n = 0; n < 4; n++) sc[m][n] = __builtin_amdgcn_mfma_f32_16x16x32_bf16(af[m], bfr[n], sc[m][n], 0, 0, 0);
    }
    __syncthreads();
    float* Ls = (float*)smem;
#pragma unroll
    for (int m = 0; m < 4; m++)
#pragma unroll
      for (int n = 0; n < 4; n++)
#pragma unroll
        for (int j = 0; j < 4; j++) Ls[(wr * 64 + m * 16 + fq * 4 + j) * 129 + wc * 64 + n * 16 + fr] = sc[m][n][j];
    __syncthreads();
    {
      const int row = tid >> 1, half = tid & 1;
      float* Lr = Ls + row * 129;
      const size_t ob = ((size_t)(mt * 128 + row) * 16 + nt) * 16;
      for (int r = 0; r < 16; r++) {
        float best = -INFINITY; int bi = 0;
        for (int i = 0; i < 64; i++) {
          const float v = Lr[half + 2 * i];
          if (v > best) { best = v; bi = half + 2 * i; }
        }
        const float ov = __shfl_xor(best, 1, 64);
        const int oi = __shfl_xor(bi, 1, 64);
        if (ov > best || (ov == best && oi < bi)) { best = ov; bi = oi; }
        if ((bi & 1) == half) Lr[bi] = -INFINITY;
        if (half == 0) { p.topv[ob + r] = best; p.topi[ob + r] = bi; }
      }
    }
    __syncthreads();
  }
}

__device__ __forceinline__ void cand_ij(int lane, int& ci, int& cj) {
  int i = 0, rem = lane;
#pragma unroll
  for (int r = 0; r < 16; r++) {
    const int cnt = 16 / (r + 1);
    if (i == r && rem >= cnt) { rem -= cnt; i = r + 1; }
  }
  ci = i; cj = rem;
}

__device__ void phase10(const P& p, int bid, int nb) {
  const int lane = threadIdx.x & 63, wid = threadIdx.x >> 6;
  int ci, cj; cand_ij(lane < 50 ? lane : 0, ci, cj);
  const int flat = ci * 16 + cj;
  for (int it = bid; it < NT / 4; it += nb) {
    const int n = it * 4 + wid;
    int seq, t, T; tok2seq(n, seq, t, T);
    float xv[16];
    {
      uint4 a = *(const uint4*)(p.xn + (size_t)n * D + lane * 8), b = *(const uint4*)(p.xn + (size_t)n * D + 512 + lane * 8);
      unsigned as[4] = {a.x, a.y, a.z, a.w}, bs[4] = {b.x, b.y, b.z, b.w};
#pragma unroll
      for (int e = 0; e < 4; e++) { xv[2 * e] = bflo(as[e]); xv[2 * e + 1] = bfhi(as[e]); xv[8 + 2 * e] = bflo(bs[e]); xv[8 + 2 * e + 1] = bfhi(bs[e]); }
    }
    float acc[16];
#pragma unroll
    for (int e = 0; e < 16; e++) acc[e] = 0.f;
    for (int h = 0; h < 8; h++) {
      const size_t base = ((size_t)n * 16 + h * 2) * 16;
      const float s1 = p.topv[base + (lane & 15)], s2 = p.topv[base + 16 + (lane & 15)];
      const int i1 = p.topi[base + (lane & 15)], i2 = p.topi[base + 16 + (lane & 15)];
      const float ca = __shfl(s1, ci, 64), cb = __shfl(s2, cj, 64);
      float cand = lane < 50 ? ca + cb : -INFINITY;
      float my_sc = -INFINITY; int my_flat = 0;
      for (int r = 0; r < 16; r++) {
        const float best = wave_max(cand);
        const int bf = wave_min_i(cand == best ? flat : 4096);
        if (lane == r) { my_sc = best; my_flat = bf; }
        if (cand == best && flat == bf) cand = -INFINITY;
      }
      const int e1 = __shfl(i1, my_flat >> 4, 64), e2 = __shfl(i2, my_flat & 15, 64);
      const int eid = e1 * 128 + e2;
      const float mx = __shfl(my_sc, 0, 64);
      float ex = lane < 16 ? __expf(my_sc - mx) : 0.f;
      const float den = wave_sum(ex);
      const float gate = ex / den;
#pragma unroll 4
      for (int k = 0; k < 16; k++) {
        const int ek = __shfl(eid, k, 64);
        const float gk = __shfl(gate, k, 64);
        const u16* ur = p.ub + (size_t)ek * D;
        uint4 a = *(const uint4*)(ur + lane * 8), b = *(const uint4*)(ur + 512 + lane * 8);
        float d = bflo(a.x) * xv[0] + bfhi(a.x) * xv[1] + bflo(a.y) * xv[2] + bfhi(a.y) * xv[3] + bflo(a.z) * xv[4] +
                  bfhi(a.z) * xv[5] + bflo(a.w) * xv[6] + bfhi(a.w) * xv[7] + bflo(b.x) * xv[8] + bfhi(b.x) * xv[9] +
                  bflo(b.y) * xv[10] + bfhi(b.y) * xv[11] + bflo(b.z) * xv[12] + bfhi(b.z) * xv[13] +
                  bflo(b.w) * xv[14] + bfhi(b.w) * xv[15];
        d = wave_sum(d);
        const float act = 0.5f * d * (1.f + erff(d * 0.70710678118654752f));
        const float w = gk * act;
        const u16* vr = p.vb + (size_t)ek * D;
        uint4 c = *(const uint4*)(vr + lane * 8), e = *(const uint4*)(vr + 512 + lane * 8);
        acc[0] += w * bflo(c.x); acc[1] += w * bfhi(c.x); acc[2] += w * bflo(c.y); acc[3] += w * bfhi(c.y);
        acc[4] += w * bflo(c.z); acc[5] += w * bfhi(c.z); acc[6] += w * bflo(c.w); acc[7] += w * bfhi(c.w);
        acc[8] += w * bflo(e.x); acc[9] += w * bfhi(e.x); acc[10] += w * bflo(e.y); acc[11] += w * bfhi(e.y);
        acc[12] += w * bflo(e.z); acc[13] += w * bfhi(e.z); acc[14] += w * bflo(e.w); acc[15] += w * bfhi(e.w);
      }
    }
    float* yr = p.out + O_Y + (size_t)n * D;
    const float* md = p.mod + (size_t)seq * 8192;
    float x2[16];
    float ss = 0.f;
#pragma unroll
    for (int hh = 0; hh < 2; hh++) {
      const int c = hh * 512 + lane * 8;
      float4 a = *(const float4*)(yr + c), b = *(const float4*)(yr + c + 4);
      float4 g0 = *(const float4*)(md + 5120 + c), g1 = *(const float4*)(md + 5120 + c + 4);
      x2[hh * 8 + 0] = a.x + g0.x * acc[hh * 8 + 0]; x2[hh * 8 + 1] = a.y + g0.y * acc[hh * 8 + 1];
      x2[hh * 8 + 2] = a.z + g0.z * acc[hh * 8 + 2]; x2[hh * 8 + 3] = a.w + g0.w * acc[hh * 8 + 3];
      x2[hh * 8 + 4] = b.x + g1.x * acc[hh * 8 + 4]; x2[hh * 8 + 5] = b.y + g1.y * acc[hh * 8 + 5];
      x2[hh * 8 + 6] = b.z + g1.z * acc[hh * 8 + 6]; x2[hh * 8 + 7] = b.w + g1.w * acc[hh * 8 + 7];
    }
#pragma unroll
    for (int e = 0; e < 16; e++) ss += x2[e] * x2[e];
    ss = wave_sum(ss);
    const float rstd = rsqrtf(ss * (1.f / 1024.f) + 1e-6f);
#pragma unroll
    for (int hh = 0; hh < 2; hh++) {
      const int c = hh * 512 + lane * 8;
      float o[8];
#pragma unroll
      for (int e = 0; e < 8; e++)
        o[e] = x2[hh * 8 + e] * rstd * p.final_g[c + e] * (1.f + md[7168 + c + e]) + md[6144 + c + e];
      *(float4*)(yr + c) = make_float4(o[0], o[1], o[2], o[3]);
      *(float4*)(yr + c + 4) = make_float4(o[4], o[5], o[6], o[7]);
    }
  }
}

template <int PH>
__device__ __forceinline__ void run_phase(const P& p, int bid, int nb, char* smem) {
  if constexpr (PH == 0) phase0(p, bid, nb, smem);
  if constexpr (PH == 1) phase_norm<false>(p, bid, nb);
  if constexpr (PH == 2) phase2(p, bid, nb, smem);
  if constexpr (PH == 3) phase3(p, bid, nb, smem);
  if constexpr (PH == 4) phase4(p, bid, nb, smem);
  if constexpr (PH == 5) phase5(p, bid, nb);
  if constexpr (PH == 6) phase6(p, bid, nb, smem);
  if constexpr (PH == 7) phase7(p, bid, nb, smem);
  if constexpr (PH == 8) phase_norm<true>(p, bid, nb);
  if constexpr (PH == 9) phase9(p, bid, nb, smem);
  if constexpr (PH == 10) phase10(p, bid, nb);
}

template <int PH>
__global__ void __launch_bounds__(NTHREADS, 2) k_phase(P p) {
  extern __shared__ __attribute__((aligned(16))) char smem[];
  run_phase<PH>(p, blockIdx.x, gridDim.x, smem);
}

#if MEGA
__global__ void __launch_bounds__(NTHREADS, 2) k_mega(P p) {
  extern __shared__ __attribute__((aligned(16))) char smem[];
  cg::grid_group grid = cg::this_grid();
  const int bid = blockIdx.x, nb = gridDim.x;
  run_phase<0>(p, bid, nb, smem); grid.sync();
  run_phase<1>(p, bid, nb, smem); grid.sync();
  run_phase<2>(p, bid, nb, smem); grid.sync();
  run_phase<3>(p, bid, nb, smem); grid.sync();
  run_phase<4>(p, bid, nb, smem); grid.sync();
  run_phase<5>(p, bid, nb, smem); grid.sync();
  run_phase<6>(p, bid, nb, smem); grid.sync();
  run_phase<7>(p, bid, nb, smem); grid.sync();
  run_phase<8>(p, bid, nb, smem); grid.sync();
  run_phase<9>(p, bid, nb, smem); grid.sync();
  run_phase<10>(p, bid, nb, smem);
}
#endif

template <int PH>
static void launch_phase(const P& p, int grid, hipStream_t stream) {
  static bool attr = false;
  if (!attr) { hipFuncSetAttribute((const void*)k_phase<PH>, hipFuncAttributeMaxDynamicSharedMemorySize, LDS_BYTES); attr = true; }
  hipLaunchKernelGGL(k_phase<PH>, dim3(grid), dim3(NTHREADS), LDS_BYTES, stream, p);
}

extern "C" void kernel_launch(void* const* d_in, const int* in_sizes, int n_in, void* d_out, int out_size, void* d_ws,
                              size_t ws_size, hipStream_t stream) {
  P p{};
  const float** fp = (const float**)&p;
  for (int i = 0; i < 40; i++) fp[i] = (const float*)d_in[i];
  p.out = (float*)d_out;
  char* ws = (char*)d_ws;
  size_t off = 0;
  auto take = [&](size_t bytes) { char* r = ws + off; off += (bytes + 255) & ~(size_t)255; return r; };
  p.w_inT = (u16*)take((size_t)INCOLS * D * 2);
  p.w_paT = (u16*)take((size_t)1024 * 512 * 2);
  p.w_pbT = (u16*)take((size_t)1024 * 1024 * 2);
  p.w_outT = (u16*)take((size_t)1024 * 1024 * 2);
  p.wqT = (u16*)take((size_t)2048 * 1024 * 2);
  p.keysb = (u16*)take((size_t)262144 * 2);
  p.mod = (float*)take((size_t)NSEQ * 8192 * 4);
  p.dtb = (float*)take((size_t)NT * 16 * 4);
  p.decb = (float*)take((size_t)NT * 16 * 4);
  p.xn = (u16*)take((size_t)NROWS * D * 2);
  p.proj = (u16*)take((size_t)NROWS * PCOLS * 2);
  p.prep = (u16*)take((size_t)NT * 3584 * 2);
  if (off > ws_size) { fprintf(stderr, "workspace too small: need %zu have %zu\n", off, ws_size); return; }
  p.merged = p.prep;
  p.ub = p.proj;
  p.vb = p.proj + (size_t)16384 * 1024;
  p.topv = (float*)(p.proj + (size_t)2 * 16384 * 1024);
  p.topi = (int*)(p.topv + (size_t)NT * 256);
  p.xc = (u16*)d_out;
  p.oa = (u16*)d_out;
  p.ob = (u16*)d_out + (size_t)NT * 512;

  static int grid = 0;
  if (!grid) {
    int dev = 0, cus = 0, per_cu = 0;
    hipGetDevice(&dev);
    hipDeviceGetAttribute(&cus, hipDeviceAttributeMultiprocessorCount, dev);
#if MEGA
    hipFuncSetAttribute((const void*)k_mega, hipFuncAttributeMaxDynamicSharedMemorySize, LDS_BYTES);
    hipOccupancyMaxActiveBlocksPerMultiprocessor(&per_cu, k_mega, NTHREADS, LDS_BYTES);
    if (per_cu > 2) per_cu = 2;
#else
    per_cu = 2;
#endif
    if (per_cu < 1) per_cu = 1;
    grid = cus * per_cu;
  }
#if MEGA
  void* args[] = {&p};
  hipError_t e = hipLaunchCooperativeKernel((void*)k_mega, dim3(grid), dim3(NTHREADS), args, LDS_BYTES, stream);
  if (e != hipSuccess) fprintf(stderr, "cooperative launch failed: %s (grid %d)\n", hipGetErrorString(e), grid);
#else
  launch_phase<0>(p, grid, stream);
  launch_phase<1>(p, grid, stream);
  launch_phase<2>(p, grid, stream);
  launch_phase<3>(p, grid, stream);
  launch_phase<4>(p, grid, stream);
  launch_phase<5>(p, grid, stream);
  launch_phase<6>(p, grid, stream);
  launch_phase<7>(p, grid, stream);
  launch_phase<8>(p, grid, stream);
  launch_phase<9>(p, grid, stream);
  launch_phase<10>(p, grid, stream);
#endif
}
```

```cpp
#include <hip/hip_runtime.h>
#include <hip/hip_cooperative_groups.h>
#include <cstdio>
namespace cg = cooperative_groups;

#ifndef MEGA
#define MEGA 1
#endif

typedef unsigned short u16;
typedef __attribute__((ext_vector_type(8))) short bf16x8;
typedef __attribute__((ext_vector_type(4))) float f32x4;

constexpr int D = 1024;
constexpr int NP = 16384, NS = 1024, NT = NP + NS, NSEQ = 136;
constexpr int NROWS = NT + 128;
constexpr int PCOLS = 4368;
constexpr int INCOLS = 6416;
constexpr int C_LW = 1536, C_LA = 1600, C_LG = 1664, C_Z = 1792, C_XBC = 2816, C_DT = 4352;
constexpr int G_A = 4368, G_B = 5392;
constexpr size_t O_Y = 0, O_PSHIFT = 17825792, O_PWKV = 17833984, O_PCONV = 18096128, O_PSSM = 18132992,
                 O_SSHIFT = 19181568, O_SWKV = 19312640, O_SCONV = 23506944, O_SSSM = 24096768;
constexpr int LDS_BYTES = 80 * 1024;
constexpr int NTHREADS = 256;

struct P {
  const float *x_prompt, *x_sample, *c_prompt, *c_sample, *state_shift, *state_wkv, *state_conv, *state_ssm;
  const float *w_ada, *b_ada, *norm1_g, *w_in, *rw_mu, *rw_w0, *rw_w2, *rw_a0, *rw_a2, *rw_g2, *rw_k_k, *rw_k_a,
      *rw_r_k, *rw_ln_w, *rw_ln_b;
  const float *conv_w, *conv_b, *dt_bias, *A_log, *D_skip, *ssm_norm_w, *w_pa, *w_pb, *w_out, *norm2_g, *peer_wq,
      *peer_keys, *peer_u, *peer_v, *final_g, *w_ada_f, *b_ada_f;
  float* out;
  u16 *w_inT, *w_paT, *w_pbT, *w_outT, *wqT, *keysb, *xn, *proj, *prep, *merged, *ub, *vb, *xc, *oa, *ob;
  float *mod, *dtb, *decb, *topv;
  int* topi;
  unsigned* bar;
};

__device__ __forceinline__ u16 f2bf(float f) {
  unsigned u = __float_as_uint(f);
  u += 0x7fffu + ((u >> 16) & 1u);
  return (u16)(u >> 16);
}
__device__ __forceinline__ float bf2f(u16 h) { return __uint_as_float(((unsigned)h) << 16); }
__device__ __forceinline__ unsigned pack2(float a, float b) { return (unsigned)f2bf(a) | ((unsigned)f2bf(b) << 16); }
__device__ __forceinline__ float bflo(unsigned u) { return __uint_as_float(u << 16); }
__device__ __forceinline__ float bfhi(unsigned u) { return __uint_as_float(u & 0xffff0000u); }
__device__ __forceinline__ float sigmoidf_(float x) { return 1.f / (1.f + __expf(-x)); }
__device__ __forceinline__ float siluf_(float x) { return x / (1.f + __expf(-x)); }
__device__ __forceinline__ float softplusf_(float x) { return x > 20.f ? x : log1pf(expf(x)); }

template <int CTRL>
__device__ __forceinline__ float dppf(float x) {
  return __int_as_float(__builtin_amdgcn_update_dpp(0, __float_as_int(x), CTRL, 0xf, 0xf, true));
}
__device__ __forceinline__ float allreduce16(float x) {
  x += dppf<0x128>(x);
  x += dppf<0x124>(x);
  x += dppf<0x122>(x);
  x += dppf<0x121>(x);
  return x;
}
__device__ __forceinline__ float allreduce8(float x) {
  x += dppf<0xB1>(x);
  x += dppf<0x4E>(x);
  x += dppf<0x141>(x);
  return x;
}
__device__ __forceinline__ float wave_sum(float x) {
#pragma unroll
  for (int o = 32; o >= 1; o >>= 1) x += __shfl_xor(x, o, 64);
  return x;
}
__device__ __forceinline__ float wave_max(float x) {
#pragma unroll
  for (int o = 32; o >= 1; o >>= 1) x = fmaxf(x, __shfl_xor(x, o, 64));
  return x;
}
__device__ __forceinline__ int wave_min_i(int x) {
#pragma unroll
  for (int o = 32; o >= 1; o >>= 1) x = min(x, __shfl_xor(x, o, 64));
  return x;
}

__device__ __forceinline__ const float* xrow(const P& p, int n) {
  return n < NP ? p.x_prompt + (size_t)n * D : p.x_sample + (size_t)(n - NP) * D;
}
__device__ __forceinline__ void tok2seq(int n, int& seq, int& t, int& T) {
  if (n < NP) { seq = n >> 11; t = n & 2047; T = 2048; }
  else { int m = n - NP; seq = 8 + (m >> 3); t = m & 7; T = 8; }
}
__device__ __forceinline__ float* seq_out(float* out, int seq, size_t op, size_t os, size_t per) {
  return seq < 8 ? out + op + (size_t)seq * per : out + os + (size_t)(seq - 8) * per;
}

constexpr int LROW = 144;
__device__ __forceinline__ void gemm_tile(const u16* __restrict__ A, int lda, int m0, const u16* __restrict__ Bt,
                                          int ldb, int n0, int K, f32x4 (&acc)[4][4], char* smem) {
  char* sA = smem;
  char* sB = smem + 128 * LROW;
  const int tid = threadIdx.x, lane = tid & 63, wid = tid >> 6, wr = wid >> 1, wc = wid & 1, fr = lane & 15,
            fq = lane >> 4;
  uint4 ra0, ra1, ra2, ra3, rb0, rb1, rb2, rb3;
  const int nk = K / 64;
  const int lrow = tid >> 3, lch = tid & 7;
  const u16* gA = A + (size_t)(m0 + lrow) * lda + lch * 8;
  const u16* gB = Bt + (size_t)(n0 + lrow) * ldb + lch * 8;
#define GLOAD(kt)                                                   \
  {                                                                 \
    ra0 = *(const uint4*)(gA + (kt) * 64);                          \
    ra1 = *(const uint4*)(gA + (size_t)32 * lda + (kt) * 64);       \
    ra2 = *(const uint4*)(gA + (size_t)64 * lda + (kt) * 64);       \
    ra3 = *(const uint4*)(gA + (size_t)96 * lda + (kt) * 64);       \
    rb0 = *(const uint4*)(gB + (kt) * 64);                          \
    rb1 = *(const uint4*)(gB + (size_t)32 * ldb + (kt) * 64);       \
    rb2 = *(const uint4*)(gB + (size_t)64 * ldb + (kt) * 64);       \
    rb3 = *(const uint4*)(gB + (size_t)96 * ldb + (kt) * 64);       \
  }
  GLOAD(0);
#pragma unroll 1
  for (int kt = 0; kt < nk; kt++) {
    __syncthreads();
    {
      char* wa = sA + lrow * LROW + lch * 16;
      char* wb = sB + lrow * LROW + lch * 16;
      *(uint4*)(wa) = ra0; *(uint4*)(wa + 32 * LROW) = ra1; *(uint4*)(wa + 64 * LROW) = ra2; *(uint4*)(wa + 96 * LROW) = ra3;
      *(uint4*)(wb) = rb0; *(uint4*)(wb + 32 * LROW) = rb1; *(uint4*)(wb + 64 * LROW) = rb2; *(uint4*)(wb + 96 * LROW) = rb3;
    }
    __syncthreads();
    if (kt + 1 < nk) GLOAD(kt + 1);
#pragma unroll
    for (int s = 0; s < 2; s++) {
      bf16x8 af[4], bfr[4];
#pragma unroll
      for (int m = 0; m < 4; m++) af[m] = *(const bf16x8*)(sA + (wr * 64 + m * 16 + fr) * LROW + s * 64 + fq * 16);
#pragma unroll
      for (int n = 0; n < 4; n++) bfr[n] = *(const bf16x8*)(sB + (wc * 64 + n * 16 + fr) * LROW + s * 64 + fq * 16);
#pragma unroll
      for (int m = 0; m < 4; m++)
#pragma unroll
        for (int n = 0; n < 4; n++) acc[m][n] = __builtin_amdgcn_mfma_f32_16x16x32_bf16(af[m], bfr[n], acc[m][n], 0, 0, 0);
    }
  }
  __syncthreads();
}
__device__ __forceinline__ void zero_acc(f32x4 (&acc)[4][4]) {
#pragma unroll
  for (int m = 0; m < 4; m++)
#pragma unroll
    for (int n = 0; n < 4; n++) acc[m][n] = f32x4{0.f, 0.f, 0.f, 0.f};
}
#define ACC_FOREACH(...)                                                                    \
  {                                                                                         \
    const int _l = threadIdx.x & 63, _w = threadIdx.x >> 6, _wr = _w >> 1, _wc = _w & 1;    \
    const int _fr = _l & 15, _fq = _l >> 4;                                                 \
    _Pragma("unroll") for (int m = 0; m < 4; m++) _Pragma("unroll") for (int n = 0; n < 4; n++) \
        _Pragma("unroll") for (int j = 0; j < 4; j++) {                                     \
      const int row = _wr * 64 + m * 16 + _fq * 4 + j, col = _wc * 64 + n * 16 + _fr;       \
      __VA_ARGS__                                                                           \
    }                                                                                       \
  }

__device__ void transpose_tile(const float* __restrict__ src, int K, int N, u16* __restrict__ dst, int tile,
                               char* smem) {
  const int ntn = (N + 63) / 64, kt = tile / ntn, nt = tile % ntn, tid = threadIdx.x;
  float(*s)[65] = (float(*)[65])smem;
  __syncthreads();
#pragma unroll 4
  for (int i = 0; i < 16; i++) {
    int r = (tid >> 6) + 4 * i, n = nt * 64 + (tid & 63);
    s[r][tid & 63] = (n < N) ? src[(size_t)(kt * 64 + r) * N + n] : 0.f;
  }
  __syncthreads();
#pragma unroll 4
  for (int i = 0; i < 8; i++) {
    int nl = (tid >> 5) + 8 * i, n = nt * 64 + nl, kl = (tid & 31) * 2;
    if (n < N) *(unsigned*)(dst + (size_t)n * K + kt * 64 + kl) = pack2(s[kl][nl], s[kl + 1][nl]);
  }
}

__device__ void mod_item(const P& p, int item, char* smem) {
  const int tid = threadIdx.x, j = tid & 31, g = tid >> 5;
  const int col0 = item * 32;
  const float* W; const float* bias; int N, cw;
  if (col0 < 6144) { W = p.w_ada; bias = p.b_ada; N = 6144; cw = col0; }
  else { W = p.w_ada_f; bias = p.b_ada_f; N = 2048; cw = col0 - 6144; }
  float(*cs)[68] = (float(*)[68])smem;
  float acc[17];
#pragma unroll
  for (int s = 0; s < 17; s++) acc[s] = 0.f;
  for (int k0 = 0; k0 < 1024; k0 += 64) {
    __syncthreads();
    {
      float cv[34];
#pragma unroll
      for (int i = 0; i < 34; i++) {
        const int idx = tid + i * 256, seq = idx >> 6, kk = idx & 63;
        cv[i] = seq < 8 ? p.c_prompt[seq * 1024 + k0 + kk] : p.c_sample[(seq - 8) * 1024 + k0 + kk];
      }
#pragma unroll
      for (int i = 0; i < 34; i++) {
        const int idx = tid + i * 256;
        cs[idx >> 6][idx & 63] = siluf_(cv[i]);
      }
    }
    __syncthreads();
#pragma unroll 1
    for (int kh = 0; kh < 2; kh++) {
      float wv[32];
#pragma unroll
      for (int k = 0; k < 32; k++) wv[k] = W[(size_t)(k0 + kh * 32 + k) * N + cw + j];
#pragma unroll 2
      for (int k4 = 0; k4 < 8; k4++) {
#pragma unroll
        for (int s = 0; s < 17; s++) {
          float4 c4 = *(const float4*)&cs[g * 17 + s][kh * 32 + k4 * 4];
          acc[s] += wv[k4 * 4] * c4.x + wv[k4 * 4 + 1] * c4.y + wv[k4 * 4 + 2] * c4.z + wv[k4 * 4 + 3] * c4.w;
        }
      }
    }
  }
  float b = bias[cw + j];
#pragma unroll
  for (int s = 0; s < 17; s++) p.mod[(size_t)(g * 17 + s) * 8192 + col0 + j] = acc[s] + b;
}

constexpr int J_MOD = 256, J_WIN = 16 * 101, J_WPA = 8 * 16, J_WPB = 256, J_WOUT = 256, J_WQ = 16 * 32, J_KEYS = 128,
              J_SHIFT = 64;
constexpr int PH0_ITEMS = J_MOD + J_WIN + J_WPA + J_WPB + J_WOUT + J_WQ + J_KEYS + J_SHIFT;

__device__ void phase0(const P& p, int bid, int nb, char* smem) {
  for (int it = bid; it < PH0_ITEMS; it += nb) {
    int i = it;
    if (i < J_MOD) { mod_item(p, i, smem); continue; }
    i -= J_MOD;
    if (i < J_WIN) { transpose_tile(p.w_in, 1024, INCOLS, p.w_inT, i, smem); continue; }
    i -= J_WIN;
    if (i < J_WPA) { transpose_tile(p.w_pa, 512, 1024, p.w_paT, i, smem); continue; }
    i -= J_WPA;
    if (i < J_WPB) { transpose_tile(p.w_pb, 1024, 1024, p.w_pbT, i, smem); continue; }
    i -= J_WPB;
    if (i < J_WOUT) { transpose_tile(p.w_out, 1024, 1024, p.w_outT, i, smem); continue; }
    i -= J_WOUT;
    if (i < J_WQ) { transpose_tile(p.peer_wq, 1024, 2048, p.wqT, i, smem); continue; }
    i -= J_WQ;
    const float* src; u16* dst;
    if (i < J_KEYS) { src = p.peer_keys + (size_t)i * 2048; dst = p.keysb + (size_t)i * 2048; }
    else { i -= J_KEYS; src = p.state_shift + (size_t)i * 2048; dst = p.xn + (size_t)NT * D + (size_t)i * 2048; }
    const float4* s4 = (const float4*)src + threadIdx.x * 2;
    float4 a = s4[0], b = s4[1];
    uint4 o; o.x = pack2(a.x, a.y); o.y = pack2(a.z, a.w); o.z = pack2(b.x, b.y); o.w = pack2(b.z, b.w);
    *((uint4*)dst + threadIdx.x) = o;
  }
}

template <bool SECOND>
__device__ void phase_norm(const P& p, int bid, int nb) {
  const int lane = threadIdx.x & 63, wid = threadIdx.x >> 6;
  const float* gam = SECOND ? p.norm2_g : p.norm1_g;
  for (int it = bid; it < NT / 4; it += nb) {
    const int n = it * 4 + wid;
    int seq, t, T; tok2seq(n, seq, t, T);
    const float* xr = SECOND ? p.out + O_Y + (size_t)n * D : xrow(p, n);
    const float* md = p.mod + (size_t)seq * 8192 + (SECOND ? 3072 : 0);
    float4 v[4];
    float ss = 0.f;
#pragma unroll
    for (int i = 0; i < 4; i++) {
      v[i] = ((const float4*)xr)[lane + 64 * i];
      ss += v[i].x * v[i].x + v[i].y * v[i].y + v[i].z * v[i].z + v[i].w * v[i].w;
    }
    ss = wave_sum(ss);
    const float rstd = rsqrtf(ss * (1.f / 1024.f) + 1e-6f);
    const bool last = (!SECOND) && (t == T - 1);
    float* so = seq_out(p.out, seq, O_PSHIFT, O_SSHIFT, 1024);
#pragma unroll
    for (int i = 0; i < 4; i++) {
      const int c = (lane + 64 * i) * 4;
      float4 g = *(const float4*)(gam + c), sh = *(const float4*)(md + c), sc = *(const float4*)(md + 1024 + c);
      float4 o;
      o.x = v[i].x * rstd * g.x * (1.f + sc.x) + sh.x;
      o.y = v[i].y * rstd * g.y * (1.f + sc.y) + sh.y;
      o.z = v[i].z * rstd * g.z * (1.f + sc.z) + sh.z;
      o.w = v[i].w * rstd * g.w * (1.f + sc.w) + sh.w;
      uint2 pk; pk.x = pack2(o.x, o.y); pk.y = pack2(o.z, o.w);
      *(uint2*)(p.xn + (size_t)n * D + c) = pk;
      if (last) *(float4*)(so + c) = o;
    }
  }
}

constexpr int P2_NT = 35, P2_MT = 137;
__device__ void phase2(const P& p, int bid, int nb, char* smem) {
  for (int it = bid; it < P2_MT * P2_NT; it += nb) {
    const int mt = it / P2_NT, nt = it % P2_NT;
    f32x4 acc[4][4];
    zero_acc(acc);
    gemm_tile(p.xn, D, mt * 128, p.w_inT, D, nt * 128, D, acc, smem);
    ACC_FOREACH({
      const int gc = nt * 128 + col;
      if (gc < PCOLS) p.proj[(size_t)(mt * 128 + row) * PCOLS + gc] = f2bf(acc[m][n][j]);
    })
  }
}

__device__ void rwkv_prep_item(const P& p, int item, char* smem) {
  const int tid = threadIdx.x, lane = tid & 63;
  const int n0 = item * 8;
  int seq, t0, T; tok2seq(n0, seq, t0, T);
  float(*q)[1792] = (float(*)[1792])smem;
  __syncthreads();
  {
    uint4 pcv[7], ppv[7];
#pragma unroll
    for (int i = 0; i < 7; i++) {
      const int idx = tid + i * 256, tok = idx / 224, c = (idx % 224) * 8;
      const int n = n0 + tok, t = t0 + tok;
      pcv[i] = *(const uint4*)(p.proj + (size_t)n * PCOLS + c);
      const size_t prow = t > 0 ? (size_t)(n - 1) : (size_t)(NT + (seq >= 8 ? seq - 8 : 0));
      ppv[i] = *(const uint4*)(p.proj + prow * PCOLS + c);
      if (t == 0 && seq < 8) ppv[i] = make_uint4(0, 0, 0, 0);
    }
#pragma unroll
    for (int i = 0; i < 7; i++) {
      const int idx = tid + i * 256, tok = idx / 224, c = (idx % 224) * 8;
      const float4 mu0 = *(const float4*)(p.rw_mu + c), mu1 = *(const float4*)(p.rw_mu + c + 4);
      const float mus[8] = {mu0.x, mu0.y, mu0.z, mu0.w, mu1.x, mu1.y, mu1.z, mu1.w};
      const unsigned pcs[4] = {pcv[i].x, pcv[i].y, pcv[i].z, pcv[i].w}, pps[4] = {ppv[i].x, ppv[i].y, ppv[i].z, ppv[i].w};
#pragma unroll
      for (int e = 0; e < 4; e++) {
        float a0 = bflo(pcs[e]), a1 = bfhi(pcs[e]), b0 = bflo(pps[e]), b1 = bfhi(pps[e]);
        float q0 = a0 + (b0 - a0) * mus[2 * e], q1 = a1 + (b1 - a1) * mus[2 * e + 1];
        if (c >= C_LW && c < C_LA) { q0 = tanhf(q0); q1 = tanhf(q1); }
        else if (c >= C_LG) { q0 = sigmoidf_(q0); q1 = sigmoidf_(q1); }
        q[tok][c + 2 * e] = q0; q[tok][c + 2 * e + 1] = q1;
      }
    }
  }
  __syncthreads();
  float aw[8][2], aa[8][2], ag[8][2];
#pragma unroll
  for (int k = 0; k < 8; k++) { aw[k][0] = aw[k][1] = aa[k][0] = aa[k][1] = ag[k][0] = ag[k][1] = 0.f; }
  const int c0 = tid, c1 = tid + 256;
#pragma unroll 4
  for (int i4 = 0; i4 < 16; i4++) {
    float w2a[4], w2b[4], a2a[4], a2b[4];
#pragma unroll
    for (int e = 0; e < 4; e++) {
      const int i = i4 * 4 + e;
      w2a[e] = p.rw_w2[i * 512 + c0]; w2b[e] = p.rw_w2[i * 512 + c1];
      a2a[e] = p.rw_a2[i * 512 + c0]; a2b[e] = p.rw_a2[i * 512 + c1];
    }
#pragma unroll
    for (int k = 0; k < 8; k++) {
      float4 th = *(const float4*)&q[k][C_LW + i4 * 4];
      float4 la = *(const float4*)&q[k][C_LA + i4 * 4];
      aw[k][0] += th.x * w2a[0] + th.y * w2a[1] + th.z * w2a[2] + th.w * w2a[3];
      aw[k][1] += th.x * w2b[0] + th.y * w2b[1] + th.z * w2b[2] + th.w * w2b[3];
      aa[k][0] += la.x * a2a[0] + la.y * a2a[1] + la.z * a2a[2] + la.w * a2a[3];
      aa[k][1] += la.x * a2b[0] + la.y * a2b[1] + la.z * a2b[2] + la.w * a2b[3];
    }
  }
#pragma unroll 8
  for (int i4 = 0; i4 < 32; i4++) {
    float g2a[4], g2b[4];
#pragma unroll
    for (int e = 0; e < 4; e++) {
      const int i = i4 * 4 + e;
      g2a[e] = p.rw_g2[i * 512 + c0]; g2b[e] = p.rw_g2[i * 512 + c1];
    }
#pragma unroll
    for (int k = 0; k < 8; k++) {
      float4 sg = *(const float4*)&q[k][C_LG + i4 * 4];
      ag[k][0] += sg.x * g2a[0] + sg.y * g2a[1] + sg.z * g2a[2] + sg.w * g2a[3];
      ag[k][1] += sg.x * g2b[0] + sg.y * g2b[1] + sg.z * g2b[2] + sg.w * g2b[3];
    }
  }
#pragma unroll
  for (int h2 = 0; h2 < 2; h2++) {
    const int col = h2 ? c1 : c0;
    const float w0 = p.rw_w0[col], a0 = p.rw_a0[col], kkw = p.rw_k_k[col], kaw = p.rw_k_a[col];
#pragma unroll
    for (int k = 0; k < 8; k++) {
      const float wpre = w0 + aw[k][h2];
      const float w = -softplusf_(-wpre) - 0.5f;
      const float logd = -expf(w);
      const float a = sigmoidf_(a0 + aa[k][h2]);
      const float g = ag[k][h2];
      const float r = q[k][col], kx = q[k][512 + col], v = q[k][1024 + col];
      const float kkv = kx * kkw;
      const float ssq = wave_sum(kkv * kkv);
      const float kk = kkv / fmaxf(sqrtf(ssq), 1e-12f);
      const float k2 = kx * (1.f + (a - 1.f) * kaw);
      const float b = kk * a;
      u16* o = p.prep + (size_t)(n0 + k) * 3584 + col;
      o[0] = f2bf(logd); o[512] = f2bf(r); o[1024] = f2bf(k2); o[1536] = f2bf(kk); o[2048] = f2bf(b);
      o[2560] = f2bf(v); o[3072] = f2bf(g);
    }
  }
  (void)lane;
}

__device__ void conv_prep_item(const P& p, int item) {
  const int tid = threadIdx.x;
  const int n0 = item * 8;
  int seq, t0, T; tok2seq(n0, seq, t0, T);
  if (tid < 192) {
    const int c = tid * 8;
    uint4 rows[11];
#pragma unroll
    for (int j = 0; j < 11; j++) {
      const int tt = t0 - 3 + j;
      rows[j] = make_uint4(0, 0, 0, 0);
      if (tt >= 0) rows[j] = *(const uint4*)(p.proj + (size_t)(n0 - 3 + j) * PCOLS + C_XBC + c);
      else if (seq >= 8) {
        const float* sc = p.state_conv + ((size_t)(seq - 8) * 3 + (tt + 3)) * 1536 + c;
        const float4 a = *(const float4*)sc, b = *(const float4*)(sc + 4);
        rows[j] = make_uint4(pack2(a.x, a.y), pack2(a.z, a.w), pack2(b.x, b.y), pack2(b.z, b.w));
      }
    }
    float w[4][8], cb[8];
#pragma unroll
    for (int j = 0; j < 4; j++) {
      const float4 a = *(const float4*)(p.conv_w + j * 1536 + c), b = *(const float4*)(p.conv_w + j * 1536 + c + 4);
      w[j][0] = a.x; w[j][1] = a.y; w[j][2] = a.z; w[j][3] = a.w; w[j][4] = b.x; w[j][5] = b.y; w[j][6] = b.z; w[j][7] = b.w;
    }
    {
      const float4 a = *(const float4*)(p.conv_b + c), b = *(const float4*)(p.conv_b + c + 4);
      cb[0] = a.x; cb[1] = a.y; cb[2] = a.z; cb[3] = a.w; cb[4] = b.x; cb[5] = b.y; cb[6] = b.z; cb[7] = b.w;
    }
#pragma unroll
    for (int k = 0; k < 8; k++) {
      float o[8];
#pragma unroll
      for (int e = 0; e < 8; e++) o[e] = cb[e];
#pragma unroll
      for (int j = 0; j < 4; j++) {
        const uint4 r = rows[k + j];
        const unsigned rs[4] = {r.x, r.y, r.z, r.w};
#pragma unroll
        for (int e = 0; e < 4; e++) { o[2 * e] += bflo(rs[e]) * w[j][2 * e]; o[2 * e + 1] += bfhi(rs[e]) * w[j][2 * e + 1]; }
      }
      *(uint4*)(p.xc + (size_t)(n0 + k) * 1536 + c) =
          make_uint4(pack2(siluf_(o[0]), siluf_(o[1])), pack2(siluf_(o[2]), siluf_(o[3])), pack2(siluf_(o[4]), siluf_(o[5])),
                     pack2(siluf_(o[6]), siluf_(o[7])));
    }
    if (t0 + 8 == T) {
      float* co = seq_out(p.out, seq, O_PCONV, O_SCONV, 3 * 1536);
#pragma unroll
      for (int j = 0; j < 3; j++) {
        const uint4 r = rows[8 + j];
        *(float4*)(co + j * 1536 + c) = make_float4(bflo(r.x), bfhi(r.x), bflo(r.y), bfhi(r.y));
        *(float4*)(co + j * 1536 + c + 4) = make_float4(bflo(r.z), bfhi(r.z), bflo(r.w), bfhi(r.w));
      }
    }
  } else if (tid < 192 + 32) {
    const int i = tid - 192;
#pragma unroll
    for (int e = 0; e < 4; e++) {
      const int pi = i * 4 + e, k = pi >> 4, h = pi & 15, n = n0 + k;
      const float raw = bf2f(p.proj[(size_t)n * PCOLS + C_DT + h]) + p.dt_bias[h];
      const float dt = softplusf_(raw);
      const float dA = -dt * expf(p.A_log[h]);
      p.dtb[n * 16 + h] = dt;
      p.decb[n * 16 + h] = expf(dA);
    }
  }
}

__device__ void phase3(const P& p, int bid, int nb, char* smem) {
  for (int it = bid; it < 2 * (NT / 8); it += nb) {
    if (it < NT / 8) rwkv_prep_item(p, it, smem);
    else conv_prep_item(p, it - NT / 8);
  }
}

constexpr int TC = 32;
__device__ __forceinline__ void bf8_to_f(uint4 u, float4& lo, float4& hi) {
  lo = make_float4(bflo(u.x), bfhi(u.x), bflo(u.y), bfhi(u.y));
  hi = make_float4(bflo(u.z), bfhi(u.z), bflo(u.w), bfhi(u.w));
}
__device__ void rwkv_scan_item(const P& p, int seq, int h, int qr, char* smem) {
  const int T = seq < 8 ? 2048 : 8, nbase = seq < 8 ? seq * 2048 : NP + (seq - 8) * 8;
  float* Ld = (float*)smem;
  float* Lr = Ld + TC * 64; float* Lk = Lr + TC * 64; float* Lkk = Lk + TC * 64; float* Lb = Lkk + TC * 64;
  float* Lv = Lb + TC * 64;
  const int tid = threadIdx.x, w = tid >> 6, lane = tid & 63, rl = w * 4 + (lane >> 4), ks = lane & 15;
  const int v = qr * 16 + rl;
  float S0 = 0.f, S1 = 0.f, S2 = 0.f, S3 = 0.f;
  if (seq >= 8) {
    float4 s = *(const float4*)(p.state_wkv + (((size_t)(seq - 8) * 8 + h) * 64 + v) * 64 + ks * 4);
    S0 = s.x; S1 = s.y; S2 = s.z; S3 = s.w;
  }
  const int st = tid >> 3, sk8 = (tid & 7) * 8;
  const int vt = tid >> 1, vr8 = (tid & 1) * 8;
  uint4 g0, g1, g2, g3, g4, gv;
  g0 = g1 = g2 = g3 = g4 = gv = make_uint4(0, 0, 0, 0);
#define RW_GLOAD(c0_)                                                                           \
  {                                                                                             \
    const int tcn = min(TC, T - (c0_));                                                         \
    if (st < tcn) {                                                                             \
      const u16* base = p.prep + (size_t)(nbase + (c0_) + st) * 3584 + h * 64 + sk8;            \
      g0 = *(const uint4*)(base); g1 = *(const uint4*)(base + 512); g2 = *(const uint4*)(base + 1024); \
      g3 = *(const uint4*)(base + 1536); g4 = *(const uint4*)(base + 2048);                     \
    }                                                                                           \
    if (tid < 64 && vt < tcn)                                                                   \
      gv = *(const uint4*)(p.prep + (size_t)(nbase + (c0_) + vt) * 3584 + 2560 + h * 64 + qr * 16 + vr8); \
  }
  RW_GLOAD(0);
  for (int c0 = 0; c0 < T; c0 += TC) {
    const int tc = min(TC, T - c0);
    __syncthreads();
    {
      float4 lo, hi;
      bf8_to_f(g0, lo, hi);
      lo.x = __expf(lo.x); lo.y = __expf(lo.y); lo.z = __expf(lo.z); lo.w = __expf(lo.w);
      hi.x = __expf(hi.x); hi.y = __expf(hi.y); hi.z = __expf(hi.z); hi.w = __expf(hi.w);
      *(float4*)(Ld + st * 64 + sk8) = lo; *(float4*)(Ld + st * 64 + sk8 + 4) = hi;
      bf8_to_f(g1, lo, hi); *(float4*)(Lr + st * 64 + sk8) = lo; *(float4*)(Lr + st * 64 + sk8 + 4) = hi;
      bf8_to_f(g2, lo, hi); *(float4*)(Lk + st * 64 + sk8) = lo; *(float4*)(Lk + st * 64 + sk8 + 4) = hi;
      bf8_to_f(g3, lo, hi); *(float4*)(Lkk + st * 64 + sk8) = lo; *(float4*)(Lkk + st * 64 + sk8 + 4) = hi;
      bf8_to_f(g4, lo, hi); *(float4*)(Lb + st * 64 + sk8) = lo; *(float4*)(Lb + st * 64 + sk8 + 4) = hi;
      if (tid < 64) { bf8_to_f(gv, lo, hi); *(float4*)(Lv + vt * 16 + vr8) = lo; *(float4*)(Lv + vt * 16 + vr8 + 4) = hi; }
    }
    __syncthreads();
    if (c0 + TC < T) RW_GLOAD(c0 + TC);
    float4 kk4 = *(const float4*)(Lkk + ks * 4), d4 = *(const float4*)(Ld + ks * 4), b4 = *(const float4*)(Lb + ks * 4),
           k4 = *(const float4*)(Lk + ks * 4), r4 = *(const float4*)(Lr + ks * 4);
    float vv = Lv[rl];
    u16* yo = p.proj + (size_t)(nbase + c0) * PCOLS + h * 64 + v;
    for (int tt = 0; tt < tc; tt++) {
      const int tn = min(tt + 1, tc - 1);
      const float4 nkk4 = *(const float4*)(Lkk + tn * 64 + ks * 4), nd4 = *(const float4*)(Ld + tn * 64 + ks * 4),
                   nb4 = *(const float4*)(Lb + tn * 64 + ks * 4), nk4 = *(const float4*)(Lk + tn * 64 + ks * 4),
                   nr4 = *(const float4*)(Lr + tn * 64 + ks * 4);
      const float nvv = Lv[tn * 16 + rl];
      float sk = (S0 * kk4.x + S1 * kk4.y) + (S2 * kk4.z + S3 * kk4.w);
      sk = allreduce16(sk);
      S0 = S0 * d4.x + (vv * k4.x - sk * b4.x);
      S1 = S1 * d4.y + (vv * k4.y - sk * b4.y);
      S2 = S2 * d4.z + (vv * k4.z - sk * b4.z);
      S3 = S3 * d4.w + (vv * k4.w - sk * b4.w);
      float y = (S0 * r4.x + S1 * r4.y) + (S2 * r4.z + S3 * r4.w);
      y = allreduce16(y);
      if (ks == 0) yo[(size_t)tt * PCOLS] = f2bf(y);
      kk4 = nkk4; d4 = nd4; b4 = nb4; k4 = nk4; r4 = nr4; vv = nvv;
    }
  }
  float* so = seq_out(p.out, seq, O_PWKV, O_SWKV, 8 * 4096);
  *(float4*)(so + ((size_t)h * 64 + v) * 64 + ks * 4) = make_float4(S0, S1, S2, S3);
}

__device__ void ssm_scan_item(const P& p, int seq, int head, int half, char* smem) {
  const int T = seq < 8 ? 2048 : 8, nbase = seq < 8 ? seq * 2048 : NP + (seq - 8) * 8;
  float* LB = (float*)smem;
  float* LC = LB + TC * 128;
  float* Lx = LC + TC * 128;
  float* Ldt = Lx + TC * 32;
  float* Ldec = Ldt + TC;
  const int tid = threadIdx.x, pl = tid >> 3, ns = tid & 7;
  const int pp = half * 32 + pl, g = head >> 3;
  const float Dk = p.D_skip[head];
  float hs[16];
#pragma unroll
  for (int j = 0; j < 16; j++) hs[j] = 0.f;
  if (seq >= 8) {
    const float4* s4 = (const float4*)(p.state_ssm + (((size_t)(seq - 8) * 16 + head) * 64 + pp) * 128 + ns * 16);
#pragma unroll
    for (int j = 0; j < 4; j++) { float4 s = s4[j]; hs[4 * j] = s.x; hs[4 * j + 1] = s.y; hs[4 * j + 2] = s.z; hs[4 * j + 3] = s.w; }
  }
  uint4 gb0, gb1, gb2, gb3, gx; float gdt = 0.f, gdec = 0.f;
  gb0 = gb1 = gb2 = gb3 = gx = make_uint4(0, 0, 0, 0);
  const int bt = tid >> 5, bch = tid & 31;
  const u16* bsrc = p.xc + 1024 + (bch < 16 ? 0 : 256) + g * 128 + (bch & 15) * 8;
  const int xt = tid >> 2, xr8 = (tid & 3) * 8;
#define SS_GLOAD(c0_)                                                                          \
  {                                                                                            \
    const int tcn = min(TC, T - (c0_));                                                        \
    const size_t nb_ = (size_t)(nbase + (c0_));                                                \
    if (bt < tcn) gb0 = *(const uint4*)(bsrc + (nb_ + bt) * 1536);                             \
    if (bt + 8 < tcn) gb1 = *(const uint4*)(bsrc + (nb_ + bt + 8) * 1536);                     \
    if (bt + 16 < tcn) gb2 = *(const uint4*)(bsrc + (nb_ + bt + 16) * 1536);                   \
    if (bt + 24 < tcn) gb3 = *(const uint4*)(bsrc + (nb_ + bt + 24) * 1536);                   \
    if (tid < 128 && xt < tcn) gx = *(const uint4*)(p.xc + (nb_ + xt) * 1536 + head * 64 + half * 32 + xr8); \
    if (tid < tcn) { gdt = p.dtb[(nb_ + tid) * 16 + head]; gdec = p.decb[(nb_ + tid) * 16 + head]; } \
  }
  SS_GLOAD(0);
  for (int c0 = 0; c0 < T; c0 += TC) {
    const int tc = min(TC, T - c0);
    __syncthreads();
    {
      float* dstb = (bch < 16 ? LB : LC) + (bch & 15) * 8;
      float4 lo, hi;
      bf8_to_f(gb0, lo, hi); *(float4*)(dstb + bt * 128) = lo; *(float4*)(dstb + bt * 128 + 4) = hi;
      bf8_to_f(gb1, lo, hi); *(float4*)(dstb + (bt + 8) * 128) = lo; *(float4*)(dstb + (bt + 8) * 128 + 4) = hi;
      bf8_to_f(gb2, lo, hi); *(float4*)(dstb + (bt + 16) * 128) = lo; *(float4*)(dstb + (bt + 16) * 128 + 4) = hi;
      bf8_to_f(gb3, lo, hi); *(float4*)(dstb + (bt + 24) * 128) = lo; *(float4*)(dstb + (bt + 24) * 128 + 4) = hi;
      if (tid < 128) { bf8_to_f(gx, lo, hi); *(float4*)(Lx + xt * 32 + xr8) = lo; *(float4*)(Lx + xt * 32 + xr8 + 4) = hi; }
      if (tid < TC) { Ldt[tid] = gdt; Ldec[tid] = gdec; }
    }
    __syncthreads();
    if (c0 + TC < T) SS_GLOAD(c0 + TC);
    u16* yo = p.proj + (size_t)(nbase + c0) * PCOLS + C_XBC + head * 64 + pp;
    float4 B0 = *(const float4*)(LB + ns * 16), B1 = *(const float4*)(LB + ns * 16 + 4), B2 = *(const float4*)(LB + ns * 16 + 8),
           B3 = *(const float4*)(LB + ns * 16 + 12);
    float4 C0 = *(const float4*)(LC + ns * 16), C1 = *(const float4*)(LC + ns * 16 + 4), C2 = *(const float4*)(LC + ns * 16 + 8),
           C3 = *(const float4*)(LC + ns * 16 + 12);
    float xv = Lx[pl], dtv = Ldt[0], dec = Ldec[0];
    for (int tt = 0; tt < tc; tt++) {
      const int tn = min(tt + 1, tc - 1);
      const float* nB = LB + tn * 128 + ns * 16;
      const float* nC = LC + tn * 128 + ns * 16;
      const float4 nB0 = *(const float4*)(nB), nB1 = *(const float4*)(nB + 4), nB2 = *(const float4*)(nB + 8), nB3 = *(const float4*)(nB + 12);
      const float4 nC0 = *(const float4*)(nC), nC1 = *(const float4*)(nC + 4), nC2 = *(const float4*)(nC + 8), nC3 = *(const float4*)(nC + 12);
      const float nxv = Lx[tn * 32 + pl], ndt = Ldt[tn], ndec = Ldec[tn];
      const float dtx = dtv * xv;
      hs[0] = hs[0] * dec + dtx * B0.x; hs[1] = hs[1] * dec + dtx * B0.y; hs[2] = hs[2] * dec + dtx * B0.z; hs[3] = hs[3] * dec + dtx * B0.w;
      hs[4] = hs[4] * dec + dtx * B1.x; hs[5] = hs[5] * dec + dtx * B1.y; hs[6] = hs[6] * dec + dtx * B1.z; hs[7] = hs[7] * dec + dtx * B1.w;
      hs[8] = hs[8] * dec + dtx * B2.x; hs[9] = hs[9] * dec + dtx * B2.y; hs[10] = hs[10] * dec + dtx * B2.z; hs[11] = hs[11] * dec + dtx * B2.w;
      hs[12] = hs[12] * dec + dtx * B3.x; hs[13] = hs[13] * dec + dtx * B3.y; hs[14] = hs[14] * dec + dtx * B3.z; hs[15] = hs[15] * dec + dtx * B3.w;
      float y0 = hs[0] * C0.x + hs[1] * C0.y + hs[2] * C0.z + hs[3] * C0.w;
      float y1 = hs[4] * C1.x + hs[5] * C1.y + hs[6] * C1.z + hs[7] * C1.w;
      float y2 = hs[8] * C2.x + hs[9] * C2.y + hs[10] * C2.z + hs[11] * C2.w;
      float y3 = hs[12] * C3.x + hs[13] * C3.y + hs[14] * C3.z + hs[15] * C3.w;
      float yp = allreduce8((y0 + y1) + (y2 + y3));
      if (ns == 0) yo[(size_t)tt * PCOLS] = f2bf(yp + Dk * xv);
      B0 = nB0; B1 = nB1; B2 = nB2; B3 = nB3; C0 = nC0; C1 = nC1; C2 = nC2; C3 = nC3; xv = nxv; dtv = ndt; dec = ndec;
    }
  }
  float* so = seq_out(p.out, seq, O_PSSM, O_SSSM, 16 * 8192);
  float4* o4 = (float4*)(so + ((size_t)head * 64 + pp) * 128 + ns * 16);
#pragma unroll
  for (int j = 0; j < 4; j++) o4[j] = make_float4(hs[4 * j], hs[4 * j + 1], hs[4 * j + 2], hs[4 * j + 3]);
}

constexpr int P4_RP = 256, P4_SP = 256, P4_RS = 4096, P4_SS = 4096;
__device__ void phase4(const P& p, int bid, int nb, char* smem) {
  for (int it = bid; it < P4_RP + P4_SP + P4_RS + P4_SS; it += nb) {
    int i = it;
    if (i < P4_RP) { rwkv_scan_item(p, i >> 5, (i >> 2) & 7, i & 3, smem); continue; }
    i -= P4_RP;
    if (i < P4_SP) { ssm_scan_item(p, i >> 5, (i >> 1) & 15, i & 1, smem); continue; }
    i -= P4_SP;
    if (i < P4_RS) { rwkv_scan_item(p, 8 + (i >> 5), (i >> 2) & 7, i & 3, smem); continue; }
    i -= P4_RS;
    ssm_scan_item(p, 8 + (i >> 5), (i >> 1) & 15, i & 1, smem);
  }
}

__device__ void phase5(const P& p, int bid, int nb) {
  const int lane = threadIdx.x & 63, wid = threadIdx.x >> 6;
  for (int it = bid; it < NT / 4; it += nb) {
    const int n = it * 4 + wid;
    {
      const int c = lane * 8;
      uint4 yu = *(const uint4*)(p.proj + (size_t)n * PCOLS + c);
      const u16* pr = p.prep + (size_t)n * 3584 + c;
      uint4 ru = *(const uint4*)(pr + 512), ku = *(const uint4*)(pr + 1024), vu = *(const uint4*)(pr + 2560),
            gu = *(const uint4*)(pr + 3072);
      unsigned ys[4] = {yu.x, yu.y, yu.z, yu.w}, rs[4] = {ru.x, ru.y, ru.z, ru.w}, ks_[4] = {ku.x, ku.y, ku.z, ku.w},
               vs[4] = {vu.x, vu.y, vu.z, vu.w}, gs[4] = {gu.x, gu.y, gu.z, gu.w};
      float y[8], r[8], k[8], v[8], g[8];
#pragma unroll
      for (int e = 0; e < 4; e++) {
        y[2 * e] = bflo(ys[e]); y[2 * e + 1] = bfhi(ys[e]);
        r[2 * e] = bflo(rs[e]); r[2 * e + 1] = bfhi(rs[e]);
        k[2 * e] = bflo(ks_[e]); k[2 * e + 1] = bfhi(ks_[e]);
        v[2 * e] = bflo(vs[e]); v[2 * e + 1] = bfhi(vs[e]);
        g[2 * e] = bflo(gs[e]); g[2 * e + 1] = bfhi(gs[e]);
      }
      float s = 0.f, bn = 0.f;
#pragma unroll
      for (int e = 0; e < 8; e++) { s += y[e]; bn += r[e] * k[e] * p.rw_r_k[c + e]; }
      s = allreduce8(s); bn = allreduce8(bn);
      const float mean = s * (1.f / 64.f);
      float vr = 0.f;
#pragma unroll
      for (int e = 0; e < 8; e++) { const float d = y[e] - mean; vr += d * d; }
      vr = allreduce8(vr) * (1.f / 64.f);
      const float rs_ = rsqrtf(vr + 64e-5f);
      float o[8];
#pragma unroll
      for (int e = 0; e < 8; e++) {
        const float yn = (y[e] - mean) * rs_ * p.rw_ln_w[c + e] + p.rw_ln_b[c + e];
        o[e] = (yn + bn * v[e]) * g[e];
      }
      uint4 ou; ou.x = pack2(o[0], o[1]); ou.y = pack2(o[2], o[3]); ou.z = pack2(o[4], o[5]); ou.w = pack2(o[6], o[7]);
      *(uint4*)(p.oa + (size_t)n * 512 + c) = ou;
    }
    {
      const int c = lane * 16;
      float yv[16];
      float ss = 0.f;
#pragma unroll
      for (int hh = 0; hh < 2; hh++) {
        uint4 yu = *(const uint4*)(p.proj + (size_t)n * PCOLS + C_XBC + c + hh * 8);
        uint4 zu = *(const uint4*)(p.proj + (size_t)n * PCOLS + C_Z + c + hh * 8);
        unsigned ys[4] = {yu.x, yu.y, yu.z, yu.w}, zs[4] = {zu.x, zu.y, zu.z, zu.w};
#pragma unroll
        for (int e = 0; e < 4; e++) {
          const float a = bflo(ys[e]) * siluf_(bflo(zs[e])), b = bfhi(ys[e]) * siluf_(bfhi(zs[e]));
          yv[hh * 8 + 2 * e] = a; yv[hh * 8 + 2 * e + 1] = b;
          ss += a * a + b * b;
        }
      }
#pragma unroll
      for (int o = 16; o >= 1; o >>= 1) ss += __shfl_xor(ss, o, 64);
      const float rstd = rsqrtf(ss * (1.f / 512.f) + 1e-6f);
      unsigned ou[8];
#pragma unroll
      for (int e = 0; e < 8; e++)
        ou[e] = pack2(yv[2 * e] * rstd * p.ssm_norm_w[c + 2 * e], yv[2 * e + 1] * rstd * p.ssm_norm_w[c + 2 * e + 1]);
      *(uint4*)(p.ob + (size_t)n * 1024 + c) = make_uint4(ou[0], ou[1], ou[2], ou[3]);
      *(uint4*)(p.ob + (size_t)n * 1024 + c + 8) = make_uint4(ou[4], ou[5], ou[6], ou[7]);
    }
  }
}

__device__ void phase6(const P& p, int bid, int nb, char* smem) {
  for (int it = bid; it < 136 * 8; it += nb) {
    const int mt = it >> 3, nt = it & 7;
    f32x4 ac[4][4];
    u16* Lm = (u16*)(smem + 2 * 128 * LROW);
    zero_acc(ac);
    gemm_tile(p.xn, D, mt * 128, p.w_inT + (size_t)G_A * D, D, nt * 128, D, ac, smem);
    ACC_FOREACH({ Lm[row * 136 + col] = f2bf(sigmoidf_(ac[m][n][j])); })
    zero_acc(ac);
    gemm_tile(p.oa, 512, mt * 128, p.w_paT, 512, nt * 128, 512, ac, smem);
    ACC_FOREACH({ Lm[row * 136 + col] = f2bf(bf2f(Lm[row * 136 + col]) * ac[m][n][j]); })
    zero_acc(ac);
    gemm_tile(p.xn, D, mt * 128, p.w_inT + (size_t)G_B * D, D, nt * 128, D, ac, smem);
    ACC_FOREACH({ p.merged[(size_t)(mt * 128 + row) * D + nt * 128 + col] = f2bf(sigmoidf_(ac[m][n][j])); })
    zero_acc(ac);
    gemm_tile(p.ob, D, mt * 128, p.w_pbT, D, nt * 128, D, ac, smem);
    ACC_FOREACH({
      u16* mp = p.merged + (size_t)(mt * 128 + row) * D + nt * 128 + col;
      *mp = f2bf(bf2f(Lm[row * 136 + col]) + bf2f(*mp) * ac[m][n][j]);
    })
  }
}

constexpr int P7_G = 136 * 8, P7_CV = 16384;
__device__ void phase7(const P& p, int bid, int nb, char* smem) {
  for (int it = bid; it < P7_G + P7_CV; it += nb) {
    if (it < P7_G) {
      const int mt = it >> 3, nt = it & 7;
      f32x4 acc[4][4];
      zero_acc(acc);
      gemm_tile(p.merged, D, mt * 128, p.w_outT, D, nt * 128, D, acc, smem);
      ACC_FOREACH({
        const int nn = mt * 128 + row, c = nt * 128 + col;
        int seq, t, T; tok2seq(nn, seq, t, T);
        const float gt = p.mod[(size_t)seq * 8192 + 2048 + c];
        p.out[O_Y + (size_t)nn * D + c] = xrow(p, nn)[c] + gt * acc[m][n][j];
      })
    } else {
      int i = it - P7_G;
      const float* src; u16* dst;
      if (i < 8192) { src = p.peer_u + (size_t)i * 2048; dst = p.ub + (size_t)i * 2048; }
      else { i -= 8192; src = p.peer_v + (size_t)i * 2048; dst = p.vb + (size_t)i * 2048; }
      const float4* s4 = (const float4*)src + threadIdx.x * 2;
      float4 a = s4[0], b = s4[1];
      uint4 o; o.x = pack2(a.x, a.y); o.y = pack2(a.z, a.w); o.z = pack2(b.x, b.y); o.w = pack2(b.z, b.w);
      *((uint4*)dst + threadIdx.x) = o;
    }
  }
}

__device__ void phase9(const P& p, int bid, int nb, char* smem) {
  const int tid = threadIdx.x, lane = tid & 63, wid = tid >> 6, wr = wid >> 1, wc = wid & 1, fr = lane & 15,
            fq = lane >> 4;
  for (int it = bid; it < 136 * 16; it += nb) {
    const int mt = it >> 4, nt = it & 15;
    f32x4 acc[4][4];
    zero_acc(acc);
    gemm_tile(p.xn, D, mt * 128, p.wqT, D, nt * 128, D, acc, smem);
    u16* Lq = (u16*)smem;
    ACC_FOREACH({ Lq[row * 136 + col] = f2bf(acc[m][n][j]); })
    __syncthreads();
    f32x4 sc[4][4];
    zero_acc(sc);
    const u16* kb = p.keysb + (size_t)nt * 128 * 128;
#pragma unroll 1
    for (int s = 0; s < 4; s++) {
      bf16x8 af[4], bfr[4];
#pragma unroll
      for (int m = 0; m < 4; m++) af[m] = *(const bf16x8*)((const char*)Lq + (wr * 64 + m * 16 + fr) * 272 + s * 64 + fq * 16);
#pragma unroll
      for (int n = 0; n < 4; n++) bfr[n] = *(const bf16x8*)(kb + (size_t)(wc * 64 + n * 16 + fr) * 128 + s * 32 + fq * 8);
#pragma unroll
      for (int m = 0; m < 4; m++)
#pragma unroll
        for (int n = 0; n < 4; n++) sc[m][n] = __builtin_amdgcn_mfma_f32_16x16x32_bf16(af[m], bfr[n], sc[m][n], 0, 0, 0);
    }
    __syncthreads();
    float* Ls = (float*)smem;
#pragma unroll
    for (int m = 0; m < 4; m++)
#pragma unroll
      for (int n = 0; n < 4; n++)
#pragma unroll
        for (int j = 0; j < 4; j++) Ls[(wr * 64 + m * 16 + fq * 4 + j) * 129 + wc * 64 + n * 16 + fr] = sc[m][n][j];
    __syncthreads();
    {
      const int row = tid >> 1, half = tid & 1;
      float* Lr = Ls + row * 129;
      const size_t ob = ((size_t)(mt * 128 + row) * 16 + nt) * 16;
      for (int r = 0; r < 16; r++) {
        float best = -INFINITY; int bi = 0;
        for (int i = 0; i < 64; i++) {
          const float v = Lr[half + 2 * i];
          if (v > best) { best = v; bi = half + 2 * i; }
        }
        const float ov = __shfl_xor(best, 1, 64);
        const int oi = __shfl_xor(bi, 1, 64);
        if (ov > best || (ov == best && oi < bi)) { best = ov; bi = oi; }
        if ((bi & 1) == half) Lr[bi] = -INFINITY;
        if (half == 0) { p.topv[ob + r] = best; p.topi[ob + r] = bi; }
      }
    }
    __syncthreads();
  }
}

__device__ __forceinline__ void cand_ij(int lane, int& ci, int& cj) {
  int i = 0, rem = lane;
#pragma unroll
  for (int r = 0; r < 16; r++) {
    const int cnt = 16 / (r + 1);
    if (i == r && rem >= cnt) { rem -= cnt; i = r + 1; }
  }
  ci = i; cj = rem;
}

typedef __attribute__((ext_vector_type(2))) __bf16 bf2_t;
__device__ __forceinline__ float dot2bf(unsigned a, unsigned b, float c) {
  return __builtin_amdgcn_fdot2_f32_bf16(__builtin_bit_cast(bf2_t, a), __builtin_bit_cast(bf2_t, b), c, false);
}
template <int CTRL, int RM>
__device__ __forceinline__ float dppf_m(float x) {
  return __int_as_float(__builtin_amdgcn_update_dpp(0, __float_as_int(x), CTRL, RM, 0xf, false));
}
__device__ __forceinline__ float wave_sum_l63(float x) {
  x += dppf<0xB1>(x);
  x += dppf<0x4E>(x);
  x += dppf<0x141>(x);
  x += dppf<0x140>(x);
  x += dppf_m<0x142, 0xA>(x);
  x += dppf_m<0x143, 0xC>(x);
  return x;
}
__device__ __forceinline__ float readlane_f(float x, int l) {
  return __int_as_float(__builtin_amdgcn_readlane(__float_as_int(x), l));
}
__device__ __forceinline__ void axpy8(float* acc, float w, uint4 v) {
  acc[0] += w * bflo(v.x); acc[1] += w * bfhi(v.x); acc[2] += w * bflo(v.y); acc[3] += w * bfhi(v.y);
  acc[4] += w * bflo(v.z); acc[5] += w * bfhi(v.z); acc[6] += w * bflo(v.w); acc[7] += w * bfhi(v.w);
}

__device__ void phase10(const P& p, int bid, int nb) {
  const int lane = threadIdx.x & 63, wid = threadIdx.x >> 6;
  int ci, cj; cand_ij(lane < 50 ? lane : 0, ci, cj);
  for (int it = bid; it < NT / 4; it += nb) {
    const int n = it * 4 + wid;
    int seq, t, T; tok2seq(n, seq, t, T);
    const uint4 xa = *(const uint4*)(p.xn + (size_t)n * D + lane * 8), xb = *(const uint4*)(p.xn + (size_t)n * D + 512 + lane * 8);
    float acc[16];
#pragma unroll
    for (int e = 0; e < 16; e++) acc[e] = 0.f;
#pragma unroll 1
    for (int h = 0; h < 8; h++) {
      const size_t base = ((size_t)n * 16 + h * 2) * 16;
      float cand = -INFINITY; int eid = 0;
      if (lane < 50) {
        cand = p.topv[base + ci] + p.topv[base + 16 + cj];
        eid = p.topi[base + ci] * 128 + p.topi[base + 16 + cj];
      }
      int rank = 0;
#pragma unroll
      for (int m = 0; m < 50; m++) {
        const float cm = readlane_f(cand, m);
        rank += ((cm > cand) || (cm == cand && m < lane)) ? 1 : 0;
      }
      const bool sel = (lane < 50) && (rank < 16);
      unsigned long long mask = __ballot(sel);
      const float mx = readlane_f(cand, __builtin_ctzll(__ballot(sel && rank == 0)));
      const float ex = sel ? __expf(cand - mx) : 0.f;
      const float den = readlane_f(wave_sum_l63(ex), 63);
      const float gate = ex / den;
#pragma unroll 1
      for (int hf = 0; hf < 2; hf++) {
        int ek[8]; float gk[8];
#pragma unroll
        for (int k = 0; k < 8; k++) {
          const int src = __builtin_ctzll(mask);
          mask &= mask - 1;
          ek[k] = __builtin_amdgcn_readlane(eid, src);
          gk[k] = readlane_f(gate, src);
        }
        uint4 ua[8], ub[8], va[8], vb[8];
#pragma unroll
        for (int j = 0; j < 8; j++) {
          const u16* ur = p.ub + (size_t)ek[j] * D + lane * 8;
          ua[j] = *(const uint4*)ur; ub[j] = *(const uint4*)(ur + 512);
        }
#pragma unroll
        for (int j = 0; j < 8; j++) {
          const u16* vr = p.vb + (size_t)ek[j] * D + lane * 8;
          va[j] = *(const uint4*)vr; vb[j] = *(const uint4*)(vr + 512);
        }
        float dv = 0.f;
#pragma unroll
        for (int j = 0; j < 8; j++) {
          float d = dot2bf(ua[j].x, xa.x, 0.f);
          d = dot2bf(ua[j].y, xa.y, d); d = dot2bf(ua[j].z, xa.z, d); d = dot2bf(ua[j].w, xa.w, d);
          d = dot2bf(ub[j].x, xb.x, d); d = dot2bf(ub[j].y, xb.y, d); d = dot2bf(ub[j].z, xb.z, d);
          d = dot2bf(ub[j].w, xb.w, d);
          const float ds = readlane_f(wave_sum_l63(d), 63);
          dv = (lane == j) ? ds : dv;
        }
        const float act = 0.5f * dv * (1.f + erff(dv * 0.70710678118654752f));
#pragma unroll
        for (int j = 0; j < 8; j++) {
          const float w = readlane_f(act, j) * gk[j];
          axpy8(acc, w, va[j]);
          axpy8(acc + 8, w, vb[j]);
        }
      }
    }
    float* yr = p.out + O_Y + (size_t)n * D;
    const float* md = p.mod + (size_t)seq * 8192;
    float x2[16];
    float ss = 0.f;
#pragma unroll
    for (int hh = 0; hh < 2; hh++) {
      const int c = hh * 512 + lane * 8;
      float4 a = *(const float4*)(yr + c), b = *(const float4*)(yr + c + 4);
      float4 g0 = *(const float4*)(md + 5120 + c), g1 = *(const float4*)(md + 5120 + c + 4);
      x2[hh * 8 + 0] = a.x + g0.x * acc[hh * 8 + 0]; x2[hh * 8 + 1] = a.y + g0.y * acc[hh * 8 + 1];
      x2[hh * 8 + 2] = a.z + g0.z * acc[hh * 8 + 2]; x2[hh * 8 + 3] = a.w + g0.w * acc[hh * 8 + 3];
      x2[hh * 8 + 4] = b.x + g1.x * acc[hh * 8 + 4]; x2[hh * 8 + 5] = b.y + g1.y * acc[hh * 8 + 5];
      x2[hh * 8 + 6] = b.z + g1.z * acc[hh * 8 + 6]; x2[hh * 8 + 7] = b.w + g1.w * acc[hh * 8 + 7];
    }
#pragma unroll
    for (int e = 0; e < 16; e++) ss += x2[e] * x2[e];
    ss = wave_sum(ss);
    const float rstd = rsqrtf(ss * (1.f / 1024.f) + 1e-6f);
#pragma unroll
    for (int hh = 0; hh < 2; hh++) {
      const int c = hh * 512 + lane * 8;
      float o[8];
#pragma unroll
      for (int e = 0; e < 8; e++)
        o[e] = x2[hh * 8 + e] * rstd * p.final_g[c + e] * (1.f + md[7168 + c + e]) + md[6144 + c + e];
      *(float4*)(yr + c) = make_float4(o[0], o[1], o[2], o[3]);
      *(float4*)(yr + c + 4) = make_float4(o[4], o[5], o[6], o[7]);
    }
  }
}

#define XB_XCNT(j) (256 + 64 * (j))
#define XB_XSUB(j) (1280 + 64 * (j))
#define XB_XGEN(j) (2304 + 64 * (j))
#define XB_TOP 3328
#define XB_TOPGEN 3392
#define XB_WORDS 4096
__device__ __forceinline__ unsigned xb_ld(unsigned* p) { return __hip_atomic_load(p, __ATOMIC_RELAXED, __HIP_MEMORY_SCOPE_AGENT); }
__device__ __forceinline__ unsigned xb_add(unsigned* p, unsigned v) { return __hip_atomic_fetch_add(p, v, __ATOMIC_RELAXED, __HIP_MEMORY_SCOPE_AGENT); }
__device__ __forceinline__ unsigned xb_xcc_id() { return (unsigned)__builtin_amdgcn_s_getreg((3 << 11) | 20) & 0xFu; }
__device__ __forceinline__ void grid_barrier(unsigned* bar, unsigned x, unsigned nloc, unsigned nx) {
  asm volatile("s_waitcnt vmcnt(0)" ::: "memory");
  __syncthreads();
  if (threadIdx.x == 0) {
    __builtin_amdgcn_s_waitcnt(0);
    const unsigned old = xb_add(&bar[XB_XSUB(x)], 1u);
    const unsigned gen = old / nloc;
    if (old + 1u == (gen + 1u) * nloc) {
      __builtin_amdgcn_fence(__ATOMIC_RELEASE, "agent");
      asm volatile("s_waitcnt vmcnt(0)" ::: "memory");
      const unsigned og = xb_add(&bar[XB_TOP], 1u);
      const unsigned tg = og / nx;
      if (og + 1u == (tg + 1u) * nx) xb_add(&bar[XB_TOPGEN], 1u);
      else while (xb_ld(&bar[XB_TOPGEN]) == tg) __builtin_amdgcn_s_sleep(1);
      __builtin_amdgcn_fence(__ATOMIC_ACQUIRE, "agent");
      xb_add(&bar[XB_XGEN(x)], 1u);
      asm volatile("s_waitcnt vmcnt(0)" ::: "memory");
    } else {
      while (xb_ld(&bar[XB_XGEN(x)]) == gen) __builtin_amdgcn_s_sleep(1);
      __builtin_amdgcn_fence(__ATOMIC_ACQUIRE, "agent");
      asm volatile("s_waitcnt vmcnt(0)" ::: "memory");
    }
  }
  __syncthreads();
}

template <int PH>
__device__ __forceinline__ void run_phase(const P& p, int bid, int nb, char* smem) {
  if constexpr (PH == 0) phase0(p, bid, nb, smem);
  if constexpr (PH == 1) phase_norm<false>(p, bid, nb);
  if constexpr (PH == 2) phase2(p, bid, nb, smem);
  if constexpr (PH == 3) phase3(p, bid, nb, smem);
  if constexpr (PH == 4) phase4(p, bid, nb, smem);
  if constexpr (PH == 5) phase5(p, bid, nb);
  if constexpr (PH == 6) phase6(p, bid, nb, smem);
  if constexpr (PH == 7) phase7(p, bid, nb, smem);
  if constexpr (PH == 8) phase_norm<true>(p, bid, nb);
  if constexpr (PH == 9) phase9(p, bid, nb, smem);
  if constexpr (PH == 10) phase10(p, bid, nb);
}

template <int PH>
__global__ void __launch_bounds__(NTHREADS, 2) k_phase(P p) {
  extern __shared__ __attribute__((aligned(16))) char smem[];
  run_phase<PH>(p, blockIdx.x, gridDim.x, smem);
}

#if MEGA
__global__ void __launch_bounds__(NTHREADS, 2) k_mega(P p) {
  extern __shared__ __attribute__((aligned(16))) char smem[];
  cg::grid_group grid = cg::this_grid();
  const int bid = blockIdx.x, nb = gridDim.x;
#ifndef PROBE_ALL2
#define PROBE_ALL2 0
#endif
#ifndef PROBE_MASK
#define PROBE_MASK 0
#endif
#ifndef PROBE_SYNCS
#define PROBE_SYNCS 0
#endif
  const unsigned xcc = xb_xcc_id();
  if (threadIdx.x == 0) xb_add(&p.bar[XB_XCNT(xcc)], 1u);
  unsigned nloc = 1, nx = 1;
#define GSYNC(k)                                                                                 \
  {                                                                                              \
    if ((k) == 0) {                                                                              \
      grid.sync();                                                                               \
      if (threadIdx.x == 0) {                                                                    \
        unsigned cnt = 0;                                                                        \
        for (unsigned j = 0; j < 16; ++j) cnt += xb_ld(&p.bar[XB_XCNT(j)]) > 0u ? 1u : 0u;       \
        nx = cnt; nloc = xb_ld(&p.bar[XB_XCNT(xcc)]);                                            \
      }                                                                                          \
    } else grid_barrier(p.bar, xcc, nloc, nx);                                                   \
  }
#define RUNPH(k)                                                       \
  run_phase<k>(p, bid, nb, smem); GSYNC(k)                             \
  if (PROBE_MASK & (1 << k)) { run_phase<k>(p, bid, nb, smem); GSYNC(1) }
#pragma unroll 1
  for (int rep = 0; rep < 1 + PROBE_ALL2; rep++) {
    RUNPH(0)
#pragma unroll 1
    for (int i = 0; i < PROBE_SYNCS; i++) GSYNC(1)
    RUNPH(1) RUNPH(2) RUNPH(3) RUNPH(4) RUNPH(5) RUNPH(6) RUNPH(7) RUNPH(8) RUNPH(9)
  }
  run_phase<10>(p, bid, nb, smem);
}
#endif

template <int PH>
static void launch_phase(const P& p, int grid, hipStream_t stream) {
  static bool attr = false;
  if (!attr) { hipFuncSetAttribute((const void*)k_phase<PH>, hipFuncAttributeMaxDynamicSharedMemorySize, LDS_BYTES); attr = true; }
  hipLaunchKernelGGL(k_phase<PH>, dim3(grid), dim3(NTHREADS), LDS_BYTES, stream, p);
}

extern "C" void kernel_launch(void* const* d_in, const int* in_sizes, int n_in, void* d_out, int out_size, void* d_ws,
                              size_t ws_size, hipStream_t stream) {
  P p{};
  const float** fp = (const float**)&p;
  for (int i = 0; i < 40; i++) fp[i] = (const float*)d_in[i];
  p.out = (float*)d_out;
  char* ws = (char*)d_ws;
  size_t off = 0;
  auto take = [&](size_t bytes) { char* r = ws + off; off += (bytes + 255) & ~(size_t)255; return r; };
  p.bar = (unsigned*)take(XB_WORDS * 4);
  p.w_inT = (u16*)take((size_t)INCOLS * D * 2);
  p.w_paT = (u16*)take((size_t)1024 * 512 * 2);
  p.w_pbT = (u16*)take((size_t)1024 * 1024 * 2);
  p.w_outT = (u16*)take((size_t)1024 * 1024 * 2);
  p.wqT = (u16*)take((size_t)2048 * 1024 * 2);
  p.keysb = (u16*)take((size_t)262144 * 2);
  p.mod = (float*)take((size_t)NSEQ * 8192 * 4);
  p.dtb = (float*)take((size_t)NT * 16 * 4);
  p.decb = (float*)take((size_t)NT * 16 * 4);
  p.xn = (u16*)take((size_t)NROWS * D * 2);
  p.proj = (u16*)take((size_t)NROWS * PCOLS * 2);
  p.prep = (u16*)take((size_t)NT * 3584 * 2);
  if (off > ws_size) { fprintf(stderr, "workspace too small: need %zu have %zu\n", off, ws_size); return; }
  p.merged = p.prep;
  p.ub = p.proj;
  p.vb = p.proj + (size_t)16384 * 1024;
  p.topv = (float*)(p.proj + (size_t)2 * 16384 * 1024);
  p.topi = (int*)(p.topv + (size_t)NT * 256);
  p.xc = (u16*)d_out;
  p.oa = (u16*)d_out;
  p.ob = (u16*)d_out + (size_t)NT * 512;

  static int grid = 0;
  if (!grid) {
    int dev = 0, cus = 0, per_cu = 0;
    hipGetDevice(&dev);
    hipDeviceGetAttribute(&cus, hipDeviceAttributeMultiprocessorCount, dev);
#if MEGA
    hipFuncSetAttribute((const void*)k_mega, hipFuncAttributeMaxDynamicSharedMemorySize, LDS_BYTES);
    hipOccupancyMaxActiveBlocksPerMultiprocessor(&per_cu, k_mega, NTHREADS, LDS_BYTES);
    if (per_cu > 2) per_cu = 2;
#else
    per_cu = 2;
#endif
    if (per_cu < 1) per_cu = 1;
    grid = cus * per_cu;
  }
#if MEGA
  hipMemsetAsync(p.bar, 0, XB_WORDS * 4, stream);
  void* args[] = {&p};
  hipError_t e = hipLaunchCooperativeKernel((void*)k_mega, dim3(grid), dim3(NTHREADS), args, LDS_BYTES, stream);
  if (e != hipSuccess) fprintf(stderr, "cooperative launch failed: %s (grid %d)\n", hipGetErrorString(e), grid);
#else
  launch_phase<0>(p, grid, stream);
  launch_phase<1>(p, grid, stream);
  launch_phase<2>(p, grid, stream);
  launch_phase<3>(p, grid, stream);
  launch_phase<4>(p, grid, stream);
  launch_phase<5>(p, grid, stream);
  launch_phase<6>(p, grid, stream);
  launch_phase<7>(p, grid, stream);
  launch_phase<8>(p, grid, stream);
  launch_phase<9>(p, grid, stream);
  launch_phase<10>(p, grid, stream);
#endif
}
```

```cpp
#include <hip/hip_runtime.h>
#include <hip/hip_cooperative_groups.h>
#include <cstdio>
namespace cg = cooperative_groups;

#ifndef MEGA
#define MEGA 1
#endif

typedef unsigned short u16;
typedef __attribute__((ext_vector_type(8))) short bf16x8;
typedef __attribute__((ext_vector_type(4))) float f32x4;

__device__ __forceinline__ int opaque_tid() { int t = threadIdx.x; asm volatile("" : "+v"(t)); return t; }
#define TIDX opaque_tid()

constexpr int D = 1024;
constexpr int NP = 16384, NS = 1024, NT = NP + NS, NSEQ = 136;
constexpr int NROWS = NT + 128;
constexpr int PCOLS = 4368;
constexpr int INCOLS = 6416;
constexpr int C_LW = 1536, C_LA = 1600, C_LG = 1664, C_Z = 1792, C_XBC = 2816, C_DT = 4352;
constexpr int G_A = 4368, G_B = 5392;
constexpr size_t O_Y = 0, O_PSHIFT = 17825792, O_PWKV = 17833984, O_PCONV = 18096128, O_PSSM = 18132992,
                 O_SSHIFT = 19181568, O_SWKV = 19312640, O_SCONV = 23506944, O_SSSM = 24096768;
constexpr int LDS_BYTES = 80 * 1024;
constexpr int NTHREADS = 256;

struct P {
  const float *x_prompt, *x_sample, *c_prompt, *c_sample, *state_shift, *state_wkv, *state_conv, *state_ssm;
  const float *w_ada, *b_ada, *norm1_g, *w_in, *rw_mu, *rw_w0, *rw_w2, *rw_a0, *rw_a2, *rw_g2, *rw_k_k, *rw_k_a,
      *rw_r_k, *rw_ln_w, *rw_ln_b;
  const float *conv_w, *conv_b, *dt_bias, *A_log, *D_skip, *ssm_norm_w, *w_pa, *w_pb, *w_out, *norm2_g, *peer_wq,
      *peer_keys, *peer_u, *peer_v, *final_g, *w_ada_f, *b_ada_f;
  float* out;
  u16 *w_inT, *w_paT, *w_pbT, *w_outT, *wqT, *keysb, *xn, *proj, *prep, *merged, *ub, *vb, *xc, *oa, *ob;
  float *mod, *dtb, *decb, *topv;
  int* topi;
  unsigned* bar;
};

__device__ __forceinline__ u16 f2bf(float f) {
  unsigned u = __float_as_uint(f);
  u += 0x7fffu + ((u >> 16) & 1u);
  return (u16)(u >> 16);
}
__device__ __forceinline__ float bf2f(u16 h) { return __uint_as_float(((unsigned)h) << 16); }
__device__ __forceinline__ unsigned pack2(float a, float b) { return (unsigned)f2bf(a) | ((unsigned)f2bf(b) << 16); }
__device__ __forceinline__ float bflo(unsigned u) { return __uint_as_float(u << 16); }
__device__ __forceinline__ float bfhi(unsigned u) { return __uint_as_float(u & 0xffff0000u); }
__device__ __forceinline__ float sigmoidf_(float x) { return 1.f / (1.f + __expf(-x)); }
__device__ __forceinline__ float siluf_(float x) { return x / (1.f + __expf(-x)); }
__device__ __forceinline__ float softplusf_(float x) { return x > 20.f ? x : log1pf(expf(x)); }

template <int CTRL>
__device__ __forceinline__ float dppf(float x) {
  return __int_as_float(__builtin_amdgcn_update_dpp(0, __float_as_int(x), CTRL, 0xf, 0xf, true));
}
__device__ __forceinline__ float allreduce16(float x) {
  x += dppf<0x128>(x);
  x += dppf<0x124>(x);
  x += dppf<0x122>(x);
  x += dppf<0x121>(x);
  return x;
}
__device__ __forceinline__ float allreduce8(float x) {
  x += dppf<0xB1>(x);
  x += dppf<0x4E>(x);
  x += dppf<0x141>(x);
  return x;
}
__device__ __forceinline__ float wave_sum(float x) {
#pragma unroll
  for (int o = 32; o >= 1; o >>= 1) x += __shfl_xor(x, o, 64);
  return x;
}
__device__ __forceinline__ float wave_max(float x) {
#pragma unroll
  for (int o = 32; o >= 1; o >>= 1) x = fmaxf(x, __shfl_xor(x, o, 64));
  return x;
}
__device__ __forceinline__ int wave_min_i(int x) {
#pragma unroll
  for (int o = 32; o >= 1; o >>= 1) x = min(x, __shfl_xor(x, o, 64));
  return x;
}

__device__ __forceinline__ const float* xrow(const P& p, int n) {
  return n < NP ? p.x_prompt + (size_t)n * D : p.x_sample + (size_t)(n - NP) * D;
}
__device__ __forceinline__ void tok2seq(int n, int& seq, int& t, int& T) {
  if (n < NP) { seq = n >> 11; t = n & 2047; T = 2048; }
  else { int m = n - NP; seq = 8 + (m >> 3); t = m & 7; T = 8; }
}
__device__ __forceinline__ float* seq_out(float* out, int seq, size_t op, size_t os, size_t per) {
  return seq < 8 ? out + op + (size_t)seq * per : out + os + (size_t)(seq - 8) * per;
}

constexpr int LROW = 144;
template <bool DEEP = true>
__device__ __forceinline__ void gemm_tile(const u16* __restrict__ A, int lda, int m0, const u16* __restrict__ Bt,
                                          int ldb, int n0, int K, f32x4 (&acc)[4][4], char* smem) {
  char* sA = smem;
  char* sB = smem + 128 * LROW;
  const int tid = TIDX, lane = tid & 63, wid = tid >> 6, wr = wid >> 1, wc = wid & 1, fr = lane & 15,
            fq = lane >> 4;
  uint4 ra0, ra1, ra2, ra3, rb0, rb1, rb2, rb3;
  uint4 sa0, sa1, sa2, sa3, sb0, sb1, sb2, sb3;
  const int nk = K / 64;
  const int lrow = tid >> 3, lch = tid & 7;
  const u16* gA = A + (size_t)(m0 + lrow) * lda + lch * 8;
  const u16* gB = Bt + (size_t)(n0 + lrow) * ldb + lch * 8;
#define GLOAD(x0, x1, x2, x3, y0, y1, y2, y3, kt)                   \
  {                                                                 \
    x0 = *(const uint4*)(gA + (kt) * 64);                           \
    x1 = *(const uint4*)(gA + (size_t)32 * lda + (kt) * 64);        \
    x2 = *(const uint4*)(gA + (size_t)64 * lda + (kt) * 64);        \
    x3 = *(const uint4*)(gA + (size_t)96 * lda + (kt) * 64);        \
    y0 = *(const uint4*)(gB + (kt) * 64);                           \
    y1 = *(const uint4*)(gB + (size_t)32 * ldb + (kt) * 64);        \
    y2 = *(const uint4*)(gB + (size_t)64 * ldb + (kt) * 64);        \
    y3 = *(const uint4*)(gB + (size_t)96 * ldb + (kt) * 64);        \
  }
#define LSTORE(x0, x1, x2, x3, y0, y1, y2, y3)                      \
  {                                                                 \
    char* wa = sA + lrow * LROW + lch * 16;                         \
    char* wb = sB + lrow * LROW + lch * 16;                         \
    *(uint4*)(wa) = x0; *(uint4*)(wa + 32 * LROW) = x1; *(uint4*)(wa + 64 * LROW) = x2; *(uint4*)(wa + 96 * LROW) = x3; \
    *(uint4*)(wb) = y0; *(uint4*)(wb + 32 * LROW) = y1; *(uint4*)(wb + 64 * LROW) = y2; *(uint4*)(wb + 96 * LROW) = y3; \
  }
#define COMPUTE_TILE()                                                                                                   \
  {                                                                                                                      \
    _Pragma("unroll") for (int s = 0; s < 2; s++) {                                                                      \
      bf16x8 af[4], bfr[4];                                                                                              \
      _Pragma("unroll") for (int m = 0; m < 4; m++) af[m] = *(const bf16x8*)(sA + (wr * 64 + m * 16 + fr) * LROW + s * 64 + fq * 16); \
      _Pragma("unroll") for (int n = 0; n < 4; n++) bfr[n] = *(const bf16x8*)(sB + (wc * 64 + n * 16 + fr) * LROW + s * 64 + fq * 16); \
      _Pragma("unroll") for (int m = 0; m < 4; m++)                                                                      \
        _Pragma("unroll") for (int n = 0; n < 4; n++) acc[m][n] = __builtin_amdgcn_mfma_f32_16x16x32_bf16(af[m], bfr[n], acc[m][n], 0, 0, 0); \
    }                                                                                                                    \
  }
  GLOAD(ra0, ra1, ra2, ra3, rb0, rb1, rb2, rb3, 0);
  if constexpr (DEEP) {
    GLOAD(sa0, sa1, sa2, sa3, sb0, sb1, sb2, sb3, 1);
#pragma unroll 1
    for (int kt = 0; kt < nk; kt += 2) {
      __syncthreads();
      LSTORE(ra0, ra1, ra2, ra3, rb0, rb1, rb2, rb3);
      __syncthreads();
      if (kt + 2 < nk) GLOAD(ra0, ra1, ra2, ra3, rb0, rb1, rb2, rb3, kt + 2);
      COMPUTE_TILE();
      __syncthreads();
      LSTORE(sa0, sa1, sa2, sa3, sb0, sb1, sb2, sb3);
      __syncthreads();
      if (kt + 3 < nk) GLOAD(sa0, sa1, sa2, sa3, sb0, sb1, sb2, sb3, kt + 3);
      COMPUTE_TILE();
    }
  } else {
#pragma unroll 1
    for (int kt = 0; kt < nk; kt++) {
      __syncthreads();
      LSTORE(ra0, ra1, ra2, ra3, rb0, rb1, rb2, rb3);
      __syncthreads();
      if (kt + 1 < nk) GLOAD(ra0, ra1, ra2, ra3, rb0, rb1, rb2, rb3, kt + 1);
      COMPUTE_TILE();
    }
  }
  __syncthreads();
}
__device__ __forceinline__ void zero_acc(f32x4 (&acc)[4][4]) {
#pragma unroll
  for (int m = 0; m < 4; m++)
#pragma unroll
    for (int n = 0; n < 4; n++) acc[m][n] = f32x4{0.f, 0.f, 0.f, 0.f};
}
#define ACC_FOREACH(...)                                                                    \
  {                                                                                         \
    const int _l = TIDX & 63, _w = TIDX >> 6, _wr = _w >> 1, _wc = _w & 1;    \
    const int _fr = _l & 15, _fq = _l >> 4;                                                 \
    _Pragma("unroll") for (int m = 0; m < 4; m++) _Pragma("unroll") for (int n = 0; n < 4; n++) \
        _Pragma("unroll") for (int j = 0; j < 4; j++) {                                     \
      const int row = _wr * 64 + m * 16 + _fq * 4 + j, col = _wc * 64 + n * 16 + _fr;       \
      __VA_ARGS__                                                                           \
    }                                                                                       \
  }

struct TileIter {
  int x, lb, nbx, tpx, total, MT, NT, r;
  __device__ __forceinline__ TileIter(int bid, int nb, int MT_, int NT_) : MT(MT_), NT(NT_), r(0) {
    total = MT * NT; x = bid & 7; lb = bid >> 3; nbx = nb >> 3; tpx = (total + 7) >> 3;
  }
  __device__ __forceinline__ bool next(int& mt, int& nt) {
    const int idx = lb + r * nbx;
    r++;
    if (idx >= tpx) return false;
    const int lin = x * tpx + idx;
    if (lin >= total) return false;
    const int bsz = 8 * NT, band = lin / bsz, rem = lin - band * bsz;
    const int mb = min(8, MT - band * 8);
    nt = rem / mb; mt = band * 8 + (rem - nt * mb);
    return true;
  }
};

__device__ void transpose_tile(const float* __restrict__ src, int K, int N, u16* __restrict__ dst, int tile,
                               char* smem) {
  const int ntn = (N + 63) / 64, kt = tile / ntn, nt = tile % ntn, tid = TIDX;
  float(*s)[65] = (float(*)[65])smem;
  __syncthreads();
#pragma unroll 4
  for (int i = 0; i < 16; i++) {
    int r = (tid >> 6) + 4 * i, n = nt * 64 + (tid & 63);
    s[r][tid & 63] = (n < N) ? src[(size_t)(kt * 64 + r) * N + n] : 0.f;
  }
  __syncthreads();
#pragma unroll 4
  for (int i = 0; i < 8; i++) {
    int nl = (tid >> 5) + 8 * i, n = nt * 64 + nl, kl = (tid & 31) * 2;
    if (n < N) *(unsigned*)(dst + (size_t)n * K + kt * 64 + kl) = pack2(s[kl][nl], s[kl + 1][nl]);
  }
}

__device__ void mod_item(const P& p, int item, char* smem) {
  const int tid = TIDX, j = tid & 31, g = tid >> 5;
  const int col0 = item * 32;
  const float* W; const float* bias; int N, cw;
  if (col0 < 6144) { W = p.w_ada; bias = p.b_ada; N = 6144; cw = col0; }
  else { W = p.w_ada_f; bias = p.b_ada_f; N = 2048; cw = col0 - 6144; }
  float(*cs)[68] = (float(*)[68])smem;
  float acc[17];
#pragma unroll
  for (int s = 0; s < 17; s++) acc[s] = 0.f;
  for (int k0 = 0; k0 < 1024; k0 += 64) {
    __syncthreads();
    {
      float cv[34];
#pragma unroll
      for (int i = 0; i < 34; i++) {
        const int idx = tid + i * 256, seq = idx >> 6, kk = idx & 63;
        cv[i] = seq < 8 ? p.c_prompt[seq * 1024 + k0 + kk] : p.c_sample[(seq - 8) * 1024 + k0 + kk];
      }
#pragma unroll
      for (int i = 0; i < 34; i++) {
        const int idx = tid + i * 256;
        cs[idx >> 6][idx & 63] = siluf_(cv[i]);
      }
    }
    __syncthreads();
#pragma unroll 1
    for (int kh = 0; kh < 2; kh++) {
      float wv[32];
#pragma unroll
      for (int k = 0; k < 32; k++) wv[k] = W[(size_t)(k0 + kh * 32 + k) * N + cw + j];
#pragma unroll 2
      for (int k4 = 0; k4 < 8; k4++) {
#pragma unroll
        for (int s = 0; s < 17; s++) {
          float4 c4 = *(const float4*)&cs[g * 17 + s][kh * 32 + k4 * 4];
          acc[s] += wv[k4 * 4] * c4.x + wv[k4 * 4 + 1] * c4.y + wv[k4 * 4 + 2] * c4.z + wv[k4 * 4 + 3] * c4.w;
        }
      }
    }
  }
  float b = bias[cw + j];
#pragma unroll
  for (int s = 0; s < 17; s++) p.mod[(size_t)(g * 17 + s) * 8192 + col0 + j] = acc[s] + b;
}

constexpr int J_MOD = 256, J_WIN = 16 * 101, J_WPA = 8 * 16, J_WPB = 256, J_WOUT = 256, J_WQ = 16 * 32, J_KEYS = 128,
              J_SHIFT = 64;
constexpr int PH0_ITEMS = J_MOD + J_WIN + J_WPA + J_WPB + J_WOUT + J_WQ + J_KEYS + J_SHIFT;

__device__ void phase0(const P& p, int bid, int nb, char* smem) {
  for (int it = bid; it < PH0_ITEMS; it += nb) {
    int i = it;
    if (i < J_MOD) { mod_item(p, i, smem); continue; }
    i -= J_MOD;
    if (i < J_WIN) { transpose_tile(p.w_in, 1024, INCOLS, p.w_inT, i, smem); continue; }
    i -= J_WIN;
    if (i < J_WPA) { transpose_tile(p.w_pa, 512, 1024, p.w_paT, i, smem); continue; }
    i -= J_WPA;
    if (i < J_WPB) { transpose_tile(p.w_pb, 1024, 1024, p.w_pbT, i, smem); continue; }
    i -= J_WPB;
    if (i < J_WOUT) { transpose_tile(p.w_out, 1024, 1024, p.w_outT, i, smem); continue; }
    i -= J_WOUT;
    if (i < J_WQ) { transpose_tile(p.peer_wq, 1024, 2048, p.wqT, i, smem); continue; }
    i -= J_WQ;
    const float* src; u16* dst;
    if (i < J_KEYS) { src = p.peer_keys + (size_t)i * 2048; dst = p.keysb + (size_t)i * 2048; }
    else { i -= J_KEYS; src = p.state_shift + (size_t)i * 2048; dst = p.xn + (size_t)NT * D + (size_t)i * 2048; }
    const float4* s4 = (const float4*)src + TIDX * 2;
    float4 a = s4[0], b = s4[1];
    uint4 o; o.x = pack2(a.x, a.y); o.y = pack2(a.z, a.w); o.z = pack2(b.x, b.y); o.w = pack2(b.z, b.w);
    *((uint4*)dst + TIDX) = o;
  }
}

template <bool SECOND>
__device__ void phase_norm(const P& p, int bid, int nb) {
  const int lane = TIDX & 63, wid = TIDX >> 6;
  const float* gam = SECOND ? p.norm2_g : p.norm1_g;
  for (int it = bid; it < NT / 4; it += nb) {
    const int n = it * 4 + wid;
    int seq, t, T; tok2seq(n, seq, t, T);
    const float* xr = SECOND ? p.out + O_Y + (size_t)n * D : xrow(p, n);
    const float* md = p.mod + (size_t)seq * 8192 + (SECOND ? 3072 : 0);
    float4 v[4];
    float ss = 0.f;
#pragma unroll
    for (int i = 0; i < 4; i++) {
      v[i] = ((const float4*)xr)[lane + 64 * i];
      ss += v[i].x * v[i].x + v[i].y * v[i].y + v[i].z * v[i].z + v[i].w * v[i].w;
    }
    ss = wave_sum(ss);
    const float rstd = rsqrtf(ss * (1.f / 1024.f) + 1e-6f);
    const bool last = (!SECOND) && (t == T - 1);
    float* so = seq_out(p.out, seq, O_PSHIFT, O_SSHIFT, 1024);
#pragma unroll
    for (int i = 0; i < 4; i++) {
      const int c = (lane + 64 * i) * 4;
      float4 g = *(const float4*)(gam + c), sh = *(const float4*)(md + c), sc = *(const float4*)(md + 1024 + c);
      float4 o;
      o.x = v[i].x * rstd * g.x * (1.f + sc.x) + sh.x;
      o.y = v[i].y * rstd * g.y * (1.f + sc.y) + sh.y;
      o.z = v[i].z * rstd * g.z * (1.f + sc.z) + sh.z;
      o.w = v[i].w * rstd * g.w * (1.f + sc.w) + sh.w;
      uint2 pk; pk.x = pack2(o.x, o.y); pk.y = pack2(o.z, o.w);
      *(uint2*)(p.xn + (size_t)n * D + c) = pk;
      if (last) *(float4*)(so + c) = o;
    }
  }
}

constexpr int P2_NT = 35, P2_MT = 137;
__device__ void phase2(const P& p, int bid, int nb, char* smem) {
  TileIter ti(bid, nb, P2_MT, P2_NT);
  int mt, nt;
  while (ti.next(mt, nt)) {
    f32x4 acc[4][4];
    zero_acc(acc);
    gemm_tile(p.xn, D, mt * 128, p.w_inT, D, nt * 128, D, acc, smem);
    ACC_FOREACH({
      const int gc = nt * 128 + col;
      if (gc < PCOLS) p.proj[(size_t)(mt * 128 + row) * PCOLS + gc] = f2bf(acc[m][n][j]);
    })
  }
}

__device__ void rwkv_prep_item(const P& p, int item, char* smem) {
  const int tid = TIDX, lane = tid & 63;
  const int n0 = item * 8;
  int seq, t0, T; tok2seq(n0, seq, t0, T);
  float(*q)[1792] = (float(*)[1792])smem;
  __syncthreads();
  {
    uint4 pcv[7], ppv[7];
#pragma unroll
    for (int i = 0; i < 7; i++) {
      const int idx = tid + i * 256, tok = idx / 224, c = (idx % 224) * 8;
      const int n = n0 + tok, t = t0 + tok;
      pcv[i] = *(const uint4*)(p.proj + (size_t)n * PCOLS + c);
      const size_t prow = t > 0 ? (size_t)(n - 1) : (size_t)(NT + (seq >= 8 ? seq - 8 : 0));
      ppv[i] = *(const uint4*)(p.proj + prow * PCOLS + c);
      if (t == 0 && seq < 8) ppv[i] = make_uint4(0, 0, 0, 0);
    }
#pragma unroll
    for (int i = 0; i < 7; i++) {
      const int idx = tid + i * 256, tok = idx / 224, c = (idx % 224) * 8;
      const float4 mu0 = *(const float4*)(p.rw_mu + c), mu1 = *(const float4*)(p.rw_mu + c + 4);
      const float mus[8] = {mu0.x, mu0.y, mu0.z, mu0.w, mu1.x, mu1.y, mu1.z, mu1.w};
      const unsigned pcs[4] = {pcv[i].x, pcv[i].y, pcv[i].z, pcv[i].w}, pps[4] = {ppv[i].x, ppv[i].y, ppv[i].z, ppv[i].w};
#pragma unroll
      for (int e = 0; e < 4; e++) {
        float a0 = bflo(pcs[e]), a1 = bfhi(pcs[e]), b0 = bflo(pps[e]), b1 = bfhi(pps[e]);
        float q0 = a0 + (b0 - a0) * mus[2 * e], q1 = a1 + (b1 - a1) * mus[2 * e + 1];
        if (c >= C_LW && c < C_LA) { q0 = tanhf(q0); q1 = tanhf(q1); }
        else if (c >= C_LG) { q0 = sigmoidf_(q0); q1 = sigmoidf_(q1); }
        q[tok][c + 2 * e] = q0; q[tok][c + 2 * e + 1] = q1;
      }
    }
  }
  __syncthreads();
  float aw[8][2], aa[8][2], ag[8][2];
#pragma unroll
  for (int k = 0; k < 8; k++) { aw[k][0] = aw[k][1] = aa[k][0] = aa[k][1] = ag[k][0] = ag[k][1] = 0.f; }
  const int c0 = tid, c1 = tid + 256;
#pragma unroll 4
  for (int i4 = 0; i4 < 16; i4++) {
    float w2a[4], w2b[4], a2a[4], a2b[4];
#pragma unroll
    for (int e = 0; e < 4; e++) {
      const int i = i4 * 4 + e;
      w2a[e] = p.rw_w2[i * 512 + c0]; w2b[e] = p.rw_w2[i * 512 + c1];
      a2a[e] = p.rw_a2[i * 512 + c0]; a2b[e] = p.rw_a2[i * 512 + c1];
    }
#pragma unroll
    for (int k = 0; k < 8; k++) {
      float4 th = *(const float4*)&q[k][C_LW + i4 * 4];
      float4 la = *(const float4*)&q[k][C_LA + i4 * 4];
      aw[k][0] += th.x * w2a[0] + th.y * w2a[1] + th.z * w2a[2] + th.w * w2a[3];
      aw[k][1] += th.x * w2b[0] + th.y * w2b[1] + th.z * w2b[2] + th.w * w2b[3];
      aa[k][0] += la.x * a2a[0] + la.y * a2a[1] + la.z * a2a[2] + la.w * a2a[3];
      aa[k][1] += la.x * a2b[0] + la.y * a2b[1] + la.z * a2b[2] + la.w * a2b[3];
    }
  }
#pragma unroll 8
  for (int i4 = 0; i4 < 32; i4++) {
    float g2a[4], g2b[4];
#pragma unroll
    for (int e = 0; e < 4; e++) {
      const int i = i4 * 4 + e;
      g2a[e] = p.rw_g2[i * 512 + c0]; g2b[e] = p.rw_g2[i * 512 + c1];
    }
#pragma unroll
    for (int k = 0; k < 8; k++) {
      float4 sg = *(const float4*)&q[k][C_LG + i4 * 4];
      ag[k][0] += sg.x * g2a[0] + sg.y * g2a[1] + sg.z * g2a[2] + sg.w * g2a[3];
      ag[k][1] += sg.x * g2b[0] + sg.y * g2b[1] + sg.z * g2b[2] + sg.w * g2b[3];
    }
  }
#pragma unroll
  for (int h2 = 0; h2 < 2; h2++) {
    const int col = h2 ? c1 : c0;
    const float w0 = p.rw_w0[col], a0 = p.rw_a0[col], kkw = p.rw_k_k[col], kaw = p.rw_k_a[col];
#pragma unroll
    for (int k = 0; k < 8; k++) {
      const float wpre = w0 + aw[k][h2];
      const float w = -softplusf_(-wpre) - 0.5f;
      const float logd = -expf(w);
      const float a = sigmoidf_(a0 + aa[k][h2]);
      const float g = ag[k][h2];
      const float r = q[k][col], kx = q[k][512 + col], v = q[k][1024 + col];
      const float kkv = kx * kkw;
      const float ssq = wave_sum(kkv * kkv);
      const float kk = kkv / fmaxf(sqrtf(ssq), 1e-12f);
      const float k2 = kx * (1.f + (a - 1.f) * kaw);
      const float b = kk * a;
      u16* o = p.prep + (size_t)(n0 + k) * 3584 + col;
      o[0] = f2bf(logd); o[512] = f2bf(r); o[1024] = f2bf(k2); o[1536] = f2bf(kk); o[2048] = f2bf(b);
      o[2560] = f2bf(v); o[3072] = f2bf(g);
    }
  }
  (void)lane;
}

__device__ void conv_prep_item(const P& p, int item) {
  const int tid = TIDX;
  const int n0 = item * 8;
  int seq, t0, T; tok2seq(n0, seq, t0, T);
  if (tid < 192) {
    const int c = tid * 8;
    uint4 rows[11];
#pragma unroll
    for (int j = 0; j < 11; j++) {
      const int tt = t0 - 3 + j;
      rows[j] = make_uint4(0, 0, 0, 0);
      if (tt >= 0) rows[j] = *(const uint4*)(p.proj + (size_t)(n0 - 3 + j) * PCOLS + C_XBC + c);
      else if (seq >= 8) {
        const float* sc = p.state_conv + ((size_t)(seq - 8) * 3 + (tt + 3)) * 1536 + c;
        const float4 a = *(const float4*)sc, b = *(const float4*)(sc + 4);
        rows[j] = make_uint4(pack2(a.x, a.y), pack2(a.z, a.w), pack2(b.x, b.y), pack2(b.z, b.w));
      }
    }
    float w[4][8], cb[8];
#pragma unroll
    for (int j = 0; j < 4; j++) {
      const float4 a = *(const float4*)(p.conv_w + j * 1536 + c), b = *(const float4*)(p.conv_w + j * 1536 + c + 4);
      w[j][0] = a.x; w[j][1] = a.y; w[j][2] = a.z; w[j][3] = a.w; w[j][4] = b.x; w[j][5] = b.y; w[j][6] = b.z; w[j][7] = b.w;
    }
    {
      const float4 a = *(const float4*)(p.conv_b + c), b = *(const float4*)(p.conv_b + c + 4);
      cb[0] = a.x; cb[1] = a.y; cb[2] = a.z; cb[3] = a.w; cb[4] = b.x; cb[5] = b.y; cb[6] = b.z; cb[7] = b.w;
    }
#pragma unroll
    for (int k = 0; k < 8; k++) {
      float o[8];
#pragma unroll
      for (int e = 0; e < 8; e++) o[e] = cb[e];
#pragma unroll
      for (int j = 0; j < 4; j++) {
        const uint4 r = rows[k + j];
        const unsigned rs[4] = {r.x, r.y, r.z, r.w};
#pragma unroll
        for (int e = 0; e < 4; e++) { o[2 * e] += bflo(rs[e]) * w[j][2 * e]; o[2 * e + 1] += bfhi(rs[e]) * w[j][2 * e + 1]; }
      }
      *(uint4*)(p.xc + (size_t)(n0 + k) * 1536 + c) =
          make_uint4(pack2(siluf_(o[0]), siluf_(o[1])), pack2(siluf_(o[2]), siluf_(o[3])), pack2(siluf_(o[4]), siluf_(o[5])),
                     pack2(siluf_(o[6]), siluf_(o[7])));
    }
    if (t0 + 8 == T) {
      float* co = seq_out(p.out, seq, O_PCONV, O_SCONV, 3 * 1536);
#pragma unroll
      for (int j = 0; j < 3; j++) {
        const uint4 r = rows[8 + j];
        *(float4*)(co + j * 1536 + c) = make_float4(bflo(r.x), bfhi(r.x), bflo(r.y), bfhi(r.y));
        *(float4*)(co + j * 1536 + c + 4) = make_float4(bflo(r.z), bfhi(r.z), bflo(r.w), bfhi(r.w));
      }
    }
  } else if (tid < 192 + 32) {
    const int i = tid - 192;
#pragma unroll
    for (int e = 0; e < 4; e++) {
      const int pi = i * 4 + e, k = pi >> 4, h = pi & 15, n = n0 + k;
      const float raw = bf2f(p.proj[(size_t)n * PCOLS + C_DT + h]) + p.dt_bias[h];
      const float dt = softplusf_(raw);
      const float dA = -dt * expf(p.A_log[h]);
      p.dtb[n * 16 + h] = dt;
      p.decb[n * 16 + h] = expf(dA);
    }
  }
}

__device__ void phase3(const P& p, int bid, int nb, char* smem) {
  for (int it = bid; it < 2 * (NT / 8); it += nb) {
    if (it < NT / 8) rwkv_prep_item(p, it, smem);
    else conv_prep_item(p, it - NT / 8);
  }
}

constexpr int TC = 32;
__device__ __forceinline__ void bf8_to_f(uint4 u, float4& lo, float4& hi) {
  lo = make_float4(bflo(u.x), bfhi(u.x), bflo(u.y), bfhi(u.y));
  hi = make_float4(bflo(u.z), bfhi(u.z), bflo(u.w), bfhi(u.w));
}
__device__ void rwkv_scan_item(const P& p, int seq, int h, int qr, char* smem) {
  const int T = seq < 8 ? 2048 : 8, nbase = seq < 8 ? seq * 2048 : NP + (seq - 8) * 8;
  float* Ld = (float*)smem;
  float* Lr = Ld + TC * 64; float* Lk = Lr + TC * 64; float* Lkk = Lk + TC * 64; float* Lb = Lkk + TC * 64;
  float* Lv = Lb + TC * 64;
  const int tid = TIDX, w = tid >> 6, lane = tid & 63, rl = w * 4 + (lane >> 4), ks = lane & 15;
  const int v = qr * 16 + rl;
  float S0 = 0.f, S1 = 0.f, S2 = 0.f, S3 = 0.f;
  if (seq >= 8) {
    float4 s = *(const float4*)(p.state_wkv + (((size_t)(seq - 8) * 8 + h) * 64 + v) * 64 + ks * 4);
    S0 = s.x; S1 = s.y; S2 = s.z; S3 = s.w;
  }
  const int st = tid >> 3, sk8 = (tid & 7) * 8;
  const int vt = tid >> 1, vr8 = (tid & 1) * 8;
  uint4 g0, g1, g2, g3, g4, gv;
  g0 = g1 = g2 = g3 = g4 = gv = make_uint4(0, 0, 0, 0);
#define RW_GLOAD(c0_)                                                                           \
  {                                                                                             \
    const int tcn = min(TC, T - (c0_));                                                         \
    if (st < tcn) {                                                                             \
      const u16* base = p.prep + (size_t)(nbase + (c0_) + st) * 3584 + h * 64 + sk8;            \
      g0 = *(const uint4*)(base); g1 = *(const uint4*)(base + 512); g2 = *(const uint4*)(base + 1024); \
      g3 = *(const uint4*)(base + 1536); g4 = *(const uint4*)(base + 2048);                     \
    }                                                                                           \
    if (tid < 64 && vt < tcn)                                                                   \
      gv = *(const uint4*)(p.prep + (size_t)(nbase + (c0_) + vt) * 3584 + 2560 + h * 64 + qr * 16 + vr8); \
  }
  RW_GLOAD(0);
  for (int c0 = 0; c0 < T; c0 += TC) {
    const int tc = min(TC, T - c0);
    __syncthreads();
    {
      float4 lo, hi;
      bf8_to_f(g0, lo, hi);
      lo.x = __expf(lo.x); lo.y = __expf(lo.y); lo.z = __expf(lo.z); lo.w = __expf(lo.w);
      hi.x = __expf(hi.x); hi.y = __expf(hi.y); hi.z = __expf(hi.z); hi.w = __expf(hi.w);
      *(float4*)(Ld + st * 64 + sk8) = lo; *(float4*)(Ld + st * 64 + sk8 + 4) = hi;
      bf8_to_f(g1, lo, hi); *(float4*)(Lr + st * 64 + sk8) = lo; *(float4*)(Lr + st * 64 + sk8 + 4) = hi;
      bf8_to_f(g2, lo, hi); *(float4*)(Lk + st * 64 + sk8) = lo; *(float4*)(Lk + st * 64 + sk8 + 4) = hi;
      bf8_to_f(g3, lo, hi); *(float4*)(Lkk + st * 64 + sk8) = lo; *(float4*)(Lkk + st * 64 + sk8 + 4) = hi;
      bf8_to_f(g4, lo, hi); *(float4*)(Lb + st * 64 + sk8) = lo; *(float4*)(Lb + st * 64 + sk8 + 4) = hi;
      if (tid < 64) { bf8_to_f(gv, lo, hi); *(float4*)(Lv + vt * 16 + vr8) = lo; *(float4*)(Lv + vt * 16 + vr8 + 4) = hi; }
    }
    __syncthreads();
    if (c0 + TC < T) RW_GLOAD(c0 + TC);
    float4 kk4 = *(const float4*)(Lkk + ks * 4), d4 = *(const float4*)(Ld + ks * 4), b4 = *(const float4*)(Lb + ks * 4),
           k4 = *(const float4*)(Lk + ks * 4), r4 = *(const float4*)(Lr + ks * 4);
    float vv = Lv[rl];
    u16* yo = p.proj + (size_t)(nbase + c0) * PCOLS + h * 64 + v;
    for (int tt = 0; tt < tc; tt++) {
      const int tn = min(tt + 1, tc - 1);
      const float4 nkk4 = *(const float4*)(Lkk + tn * 64 + ks * 4), nd4 = *(const float4*)(Ld + tn * 64 + ks * 4),
                   nb4 = *(const float4*)(Lb + tn * 64 + ks * 4), nk4 = *(const float4*)(Lk + tn * 64 + ks * 4),
                   nr4 = *(const float4*)(Lr + tn * 64 + ks * 4);
      const float nvv = Lv[tn * 16 + rl];
      float sk = (S0 * kk4.x + S1 * kk4.y) + (S2 * kk4.z + S3 * kk4.w);
      sk = allreduce16(sk);
      S0 = S0 * d4.x + (vv * k4.x - sk * b4.x);
      S1 = S1 * d4.y + (vv * k4.y - sk * b4.y);
      S2 = S2 * d4.z + (vv * k4.z - sk * b4.z);
      S3 = S3 * d4.w + (vv * k4.w - sk * b4.w);
      float y = (S0 * r4.x + S1 * r4.y) + (S2 * r4.z + S3 * r4.w);
      y = allreduce16(y);
      if (ks == 0) yo[(size_t)tt * PCOLS] = f2bf(y);
      kk4 = nkk4; d4 = nd4; b4 = nb4; k4 = nk4; r4 = nr4; vv = nvv;
    }
  }
  float* so = seq_out(p.out, seq, O_PWKV, O_SWKV, 8 * 4096);
  *(float4*)(so + ((size_t)h * 64 + v) * 64 + ks * 4) = make_float4(S0, S1, S2, S3);
}

__device__ void ssm_scan_item(const P& p, int seq, int head, int half, char* smem) {
  const int T = seq < 8 ? 2048 : 8, nbase = seq < 8 ? seq * 2048 : NP + (seq - 8) * 8;
  float* LB = (float*)smem;
  float* LC = LB + TC * 128;
  float* Lx = LC + TC * 128;
  float* Ldt = Lx + TC * 32;
  float* Ldec = Ldt + TC;
  const int tid = TIDX, pl = tid >> 3, ns = tid & 7;
  const int pp = half * 32 + pl, g = head >> 3;
  const float Dk = p.D_skip[head];
  float hs[16];
#pragma unroll
  for (int j = 0; j < 16; j++) hs[j] = 0.f;
  if (seq >= 8) {
    const float4* s4 = (const float4*)(p.state_ssm + (((size_t)(seq - 8) * 16 + head) * 64 + pp) * 128 + ns * 16);
#pragma unroll
    for (int j = 0; j < 4; j++) { float4 s = s4[j]; hs[4 * j] = s.x; hs[4 * j + 1] = s.y; hs[4 * j + 2] = s.z; hs[4 * j + 3] = s.w; }
  }
  uint4 gb0, gb1, gb2, gb3, gx; float gdt = 0.f, gdec = 0.f;
  gb0 = gb1 = gb2 = gb3 = gx = make_uint4(0, 0, 0, 0);
  const int bt = tid >> 5, bch = tid & 31;
  const u16* bsrc = p.xc + 1024 + (bch < 16 ? 0 : 256) + g * 128 + (bch & 15) * 8;
  const int xt = tid >> 2, xr8 = (tid & 3) * 8;
#define SS_GLOAD(c0_)                                                                          \
  {                                                                                            \
    const int tcn = min(TC, T - (c0_));                                                        \
    const size_t nb_ = (size_t)(nbase + (c0_));                                                \
    if (bt < tcn) gb0 = *(const uint4*)(bsrc + (nb_ + bt) * 1536);                             \
    if (bt + 8 < tcn) gb1 = *(const uint4*)(bsrc + (nb_ + bt + 8) * 1536);                     \
    if (bt + 16 < tcn) gb2 = *(const uint4*)(bsrc + (nb_ + bt + 16) * 1536);                   \
    if (bt + 24 < tcn) gb3 = *(const uint4*)(bsrc + (nb_ + bt + 24) * 1536);                   \
    if (tid < 128 && xt < tcn) gx = *(const uint4*)(p.xc + (nb_ + xt) * 1536 + head * 64 + half * 32 + xr8); \
    if (tid < tcn) { gdt = p.dtb[(nb_ + tid) * 16 + head]; gdec = p.decb[(nb_ + tid) * 16 + head]; } \
  }
  SS_GLOAD(0);
  for (int c0 = 0; c0 < T; c0 += TC) {
    const int tc = min(TC, T - c0);
    __syncthreads();
    {
      float* dstb = (bch < 16 ? LB : LC) + (bch & 15) * 8;
      float4 lo, hi;
      bf8_to_f(gb0, lo, hi); *(float4*)(dstb + bt * 128) = lo; *(float4*)(dstb + bt * 128 + 4) = hi;
      bf8_to_f(gb1, lo, hi); *(float4*)(dstb + (bt + 8) * 128) = lo; *(float4*)(dstb + (bt + 8) * 128 + 4) = hi;
      bf8_to_f(gb2, lo, hi); *(float4*)(dstb + (bt + 16) * 128) = lo; *(float4*)(dstb + (bt + 16) * 128 + 4) = hi;
      bf8_to_f(gb3, lo, hi); *(float4*)(dstb + (bt + 24) * 128) = lo; *(float4*)(dstb + (bt + 24) * 128 + 4) = hi;
      if (tid < 128) { bf8_to_f(gx, lo, hi); *(float4*)(Lx + xt * 32 + xr8) = lo; *(float4*)(Lx + xt * 32 + xr8 + 4) = hi; }
      if (tid < TC) { Ldt[tid] = gdt; Ldec[tid] = gdec; }
    }
    __syncthreads();
    if (c0 + TC < T) SS_GLOAD(c0 + TC);
    u16* yo = p.proj + (size_t)(nbase + c0) * PCOLS + C_XBC + head * 64 + pp;
    float4 B0 = *(const float4*)(LB + ns * 16), B1 = *(const float4*)(LB + ns * 16 + 4), B2 = *(const float4*)(LB + ns * 16 + 8),
           B3 = *(const float4*)(LB + ns * 16 + 12);
    float4 C0 = *(const float4*)(LC + ns * 16), C1 = *(const float4*)(LC + ns * 16 + 4), C2 = *(const float4*)(LC + ns * 16 + 8),
           C3 = *(const float4*)(LC + ns * 16 + 12);
    float xv = Lx[pl], dtv = Ldt[0], dec = Ldec[0];
    for (int tt = 0; tt < tc; tt++) {
      const int tn = min(tt + 1, tc - 1);
      const float* nB = LB + tn * 128 + ns * 16;
      const float* nC = LC + tn * 128 + ns * 16;
      const float4 nB0 = *(const float4*)(nB), nB1 = *(const float4*)(nB + 4), nB2 = *(const float4*)(nB + 8), nB3 = *(const float4*)(nB + 12);
      const float4 nC0 = *(const float4*)(nC), nC1 = *(const float4*)(nC + 4), nC2 = *(const float4*)(nC + 8), nC3 = *(const float4*)(nC + 12);
      const float nxv = Lx[tn * 32 + pl], ndt = Ldt[tn], ndec = Ldec[tn];
      const float dtx = dtv * xv;
      hs[0] = hs[0] * dec + dtx * B0.x; hs[1] = hs[1] * dec + dtx * B0.y; hs[2] = hs[2] * dec + dtx * B0.z; hs[3] = hs[3] * dec + dtx * B0.w;
      hs[4] = hs[4] * dec + dtx * B1.x; hs[5] = hs[5] * dec + dtx * B1.y; hs[6] = hs[6] * dec + dtx * B1.z; hs[7] = hs[7] * dec + dtx * B1.w;
      hs[8] = hs[8] * dec + dtx * B2.x; hs[9] = hs[9] * dec + dtx * B2.y; hs[10] = hs[10] * dec + dtx * B2.z; hs[11] = hs[11] * dec + dtx * B2.w;
      hs[12] = hs[12] * dec + dtx * B3.x; hs[13] = hs[13] * dec + dtx * B3.y; hs[14] = hs[14] * dec + dtx * B3.z; hs[15] = hs[15] * dec + dtx * B3.w;
      float y0 = hs[0] * C0.x + hs[1] * C0.y + hs[2] * C0.z + hs[3] * C0.w;
      float y1 = hs[4] * C1.x + hs[5] * C1.y + hs[6] * C1.z + hs[7] * C1.w;
      float y2 = hs[8] * C2.x + hs[9] * C2.y + hs[10] * C2.z + hs[11] * C2.w;
      float y3 = hs[12] * C3.x + hs[13] * C3.y + hs[14] * C3.z + hs[15] * C3.w;
      float yp = allreduce8((y0 + y1) + (y2 + y3));
      if (ns == 0) yo[(size_t)tt * PCOLS] = f2bf(yp + Dk * xv);
      B0 = nB0; B1 = nB1; B2 = nB2; B3 = nB3; C0 = nC0; C1 = nC1; C2 = nC2; C3 = nC3; xv = nxv; dtv = ndt; dec = ndec;
    }
  }
  float* so = seq_out(p.out, seq, O_PSSM, O_SSSM, 16 * 8192);
  float4* o4 = (float4*)(so + ((size_t)head * 64 + pp) * 128 + ns * 16);
#pragma unroll
  for (int j = 0; j < 4; j++) o4[j] = make_float4(hs[4 * j], hs[4 * j + 1], hs[4 * j + 2], hs[4 * j + 3]);
}

constexpr int P4_RP = 256, P4_SP = 256, P4_RS = 4096, P4_SS = 4096;
__device__ void phase4(const P& p, int bid, int nb, char* smem) {
  for (int it = bid; it < P4_RP + P4_SP + P4_RS + P4_SS; it += nb) {
    int i = it;
    if (i < P4_RP) { rwkv_scan_item(p, i >> 5, (i >> 2) & 7, i & 3, smem); continue; }
    i -= P4_RP;
    if (i < P4_SP) { ssm_scan_item(p, i >> 5, (i >> 1) & 15, i & 1, smem); continue; }
    i -= P4_SP;
    if (i < P4_RS) { rwkv_scan_item(p, 8 + (i >> 5), (i >> 2) & 7, i & 3, smem); continue; }
    i -= P4_RS;
    ssm_scan_item(p, 8 + (i >> 5), (i >> 1) & 15, i & 1, smem);
  }
}

__device__ void phase5(const P& p, int bid, int nb) {
  const int lane = TIDX & 63, wid = TIDX >> 6;
  for (int it = bid; it < NT / 4; it += nb) {
    const int n = it * 4 + wid;
    {
      const int c = lane * 8;
      uint4 yu = *(const uint4*)(p.proj + (size_t)n * PCOLS + c);
      const u16* pr = p.prep + (size_t)n * 3584 + c;
      uint4 ru = *(const uint4*)(pr + 512), ku = *(const uint4*)(pr + 1024), vu = *(const uint4*)(pr + 2560),
            gu = *(const uint4*)(pr + 3072);
      unsigned ys[4] = {yu.x, yu.y, yu.z, yu.w}, rs[4] = {ru.x, ru.y, ru.z, ru.w}, ks_[4] = {ku.x, ku.y, ku.z, ku.w},
               vs[4] = {vu.x, vu.y, vu.z, vu.w}, gs[4] = {gu.x, gu.y, gu.z, gu.w};
      float y[8], r[8], k[8], v[8], g[8];
#pragma unroll
      for (int e = 0; e < 4; e++) {
        y[2 * e] = bflo(ys[e]); y[2 * e + 1] = bfhi(ys[e]);
        r[2 * e] = bflo(rs[e]); r[2 * e + 1] = bfhi(rs[e]);
        k[2 * e] = bflo(ks_[e]); k[2 * e + 1] = bfhi(ks_[e]);
        v[2 * e] = bflo(vs[e]); v[2 * e + 1] = bfhi(vs[e]);
        g[2 * e] = bflo(gs[e]); g[2 * e + 1] = bfhi(gs[e]);
      }
      float s = 0.f, bn = 0.f;
#pragma unroll
      for (int e = 0; e < 8; e++) { s += y[e]; bn += r[e] * k[e] * p.rw_r_k[c + e]; }
      s = allreduce8(s); bn = allreduce8(bn);
      const float mean = s * (1.f / 64.f);
      float vr = 0.f;
#pragma unroll
      for (int e = 0; e < 8; e++) { const float d = y[e] - mean; vr += d * d; }
      vr = allreduce8(vr) * (1.f / 64.f);
      const float rs_ = rsqrtf(vr + 64e-5f);
      float o[8];
#pragma unroll
      for (int e = 0; e < 8; e++) {
        const float yn = (y[e] - mean) * rs_ * p.rw_ln_w[c + e] + p.rw_ln_b[c + e];
        o[e] = (yn + bn * v[e]) * g[e];
      }
      uint4 ou; ou.x = pack2(o[0], o[1]); ou.y = pack2(o[2], o[3]); ou.z = pack2(o[4], o[5]); ou.w = pack2(o[6], o[7]);
      *(uint4*)(p.oa + (size_t)n * 512 + c) = ou;
    }
    {
      const int c = lane * 16;
      float yv[16];
      float ss = 0.f;
#pragma unroll
      for (int hh = 0; hh < 2; hh++) {
        uint4 yu = *(const uint4*)(p.proj + (size_t)n * PCOLS + C_XBC + c + hh * 8);
        uint4 zu = *(const uint4*)(p.proj + (size_t)n * PCOLS + C_Z + c + hh * 8);
        unsigned ys[4] = {yu.x, yu.y, yu.z, yu.w}, zs[4] = {zu.x, zu.y, zu.z, zu.w};
#pragma unroll
        for (int e = 0; e < 4; e++) {
          const float a = bflo(ys[e]) * siluf_(bflo(zs[e])), b = bfhi(ys[e]) * siluf_(bfhi(zs[e]));
          yv[hh * 8 + 2 * e] = a; yv[hh * 8 + 2 * e + 1] = b;
          ss += a * a + b * b;
        }
      }
#pragma unroll
      for (int o = 16; o >= 1; o >>= 1) ss += __shfl_xor(ss, o, 64);
      const float rstd = rsqrtf(ss * (1.f / 512.f) + 1e-6f);
      unsigned ou[8];
#pragma unroll
      for (int e = 0; e < 8; e++)
        ou[e] = pack2(yv[2 * e] * rstd * p.ssm_norm_w[c + 2 * e], yv[2 * e + 1] * rstd * p.ssm_norm_w[c + 2 * e + 1]);
      *(uint4*)(p.ob + (size_t)n * 1024 + c) = make_uint4(ou[0], ou[1], ou[2], ou[3]);
      *(uint4*)(p.ob + (size_t)n * 1024 + c + 8) = make_uint4(ou[4], ou[5], ou[6], ou[7]);
    }
  }
}

__device__ void phase6(const P& p, int bid, int nb, char* smem) {
  TileIter ti(bid, nb, 136, 8);
  int mt, nt;
  while (ti.next(mt, nt)) {
    f32x4 ac[4][4];
    u16* Lm = (u16*)(smem + 2 * 128 * LROW);
    zero_acc(ac);
    gemm_tile(p.xn, D, mt * 128, p.w_inT + (size_t)G_A * D, D, nt * 128, D, ac, smem);
    ACC_FOREACH({ Lm[row * 136 + col] = f2bf(sigmoidf_(ac[m][n][j])); })
    zero_acc(ac);
    gemm_tile(p.oa, 512, mt * 128, p.w_paT, 512, nt * 128, 512, ac, smem);
    ACC_FOREACH({ Lm[row * 136 + col] = f2bf(bf2f(Lm[row * 136 + col]) * ac[m][n][j]); })
    zero_acc(ac);
    gemm_tile(p.xn, D, mt * 128, p.w_inT + (size_t)G_B * D, D, nt * 128, D, ac, smem);
    ACC_FOREACH({ p.merged[(size_t)(mt * 128 + row) * D + nt * 128 + col] = f2bf(sigmoidf_(ac[m][n][j])); })
    zero_acc(ac);
    gemm_tile(p.ob, D, mt * 128, p.w_pbT, D, nt * 128, D, ac, smem);
    ACC_FOREACH({
      u16* mp = p.merged + (size_t)(mt * 128 + row) * D + nt * 128 + col;
      *mp = f2bf(bf2f(Lm[row * 136 + col]) + bf2f(*mp) * ac[m][n][j]);
    })
  }
}

constexpr int P7_G = 136 * 8, P7_CV = 16384;
constexpr float U_SCALE = 256.f, V_SCALE = 32.f;
__device__ void phase7(const P& p, int bid, int nb, char* smem) {
  {
    TileIter ti(bid, nb, 136, 8);
    int mt, nt;
    while (ti.next(mt, nt)) {
      f32x4 acc[4][4];
      zero_acc(acc);
      gemm_tile(p.merged, D, mt * 128, p.w_outT, D, nt * 128, D, acc, smem);
      ACC_FOREACH({
        const int nn = mt * 128 + row, c = nt * 128 + col;
        int seq, t, T; tok2seq(nn, seq, t, T);
        const float gt = p.mod[(size_t)seq * 8192 + 2048 + c];
        p.out[O_Y + (size_t)nn * D + c] = xrow(p, nn)[c] + gt * acc[m][n][j];
      })
    }
  }
  for (int it = bid; it < P7_CV; it += nb) {
    int i = it;
    const float* src; unsigned char* dst; float sc;
    if (i < 8192) { src = p.peer_u + (size_t)i * 2048; dst = (unsigned char*)p.ub + (size_t)i * 2048; sc = U_SCALE; }
    else { i -= 8192; src = p.peer_v + (size_t)i * 2048; dst = (unsigned char*)p.vb + (size_t)i * 2048; sc = V_SCALE; }
    const int tid = TIDX;
    const float4* s4 = (const float4*)src + tid * 2;
    const float4 a = s4[0], b = s4[1];
    int lo = __builtin_amdgcn_cvt_pk_fp8_f32(a.x * sc, a.y * sc, 0, false);
    lo = __builtin_amdgcn_cvt_pk_fp8_f32(a.z * sc, a.w * sc, lo, true);
    int hi = __builtin_amdgcn_cvt_pk_fp8_f32(b.x * sc, b.y * sc, 0, false);
    hi = __builtin_amdgcn_cvt_pk_fp8_f32(b.z * sc, b.w * sc, hi, true);
    *((uint2*)dst + tid) = make_uint2((unsigned)lo, (unsigned)hi);
  }
}

__device__ void phase9(const P& p, int bid, int nb, char* smem) {
  const int tid = TIDX, lane = tid & 63, wid = tid >> 6, wr = wid >> 1, wc = wid & 1, fr = lane & 15,
            fq = lane >> 4;
  TileIter ti(bid, nb, 136, 16);
  int mt, nt;
  while (ti.next(mt, nt)) {
    f32x4 acc[4][4];
    zero_acc(acc);
    gemm_tile<false>(p.xn, D, mt * 128, p.wqT, D, nt * 128, D, acc, smem);
    u16* Lq = (u16*)smem;
    ACC_FOREACH({ Lq[row * 136 + col] = f2bf(acc[m][n][j]); })
    __syncthreads();
    f32x4 sc[4][4];
    zero_acc(sc);
    const u16* kb = p.keysb + (size_t)nt * 128 * 128;
#pragma unroll 1
    for (int s = 0; s < 4; s++) {
      bf16x8 af[4], bfr[4];
#pragma unroll
      for (int m = 0; m < 4; m++) af[m] = *(const bf16x8*)((const char*)Lq + (wr * 64 + m * 16 + fr) * 272 + s * 64 + fq * 16);
#pragma unroll
      for (int n = 0; n < 4; n++) bfr[n] = *(const bf16x8*)(kb + (size_t)(wc * 64 + n * 16 + fr) * 128 + s * 32 + fq * 8);
#pragma unroll
      for (int m = 0; m < 4; m++)
#pragma unroll
        for (int n = 0; n < 4; n++) sc[m][n] = __builtin_amdgcn_mfma_f32_16x16x32_bf16(af[m], bfr[n], sc[m][n], 0, 0, 0);
    }
    __syncthreads();
    float* Ls = (float*)smem;
#pragma unroll
    for (int m = 0; m < 4; m++)
#pragma unroll
      for (int n = 0; n < 4; n++)
#pragma unroll
        for (int j = 0; j < 4; j++) Ls[(wr * 64 + m * 16 + fq * 4 + j) * 129 + wc * 64 + n * 16 + fr] = sc[m][n][j];
    __syncthreads();
    {
      const int row = tid >> 1, half = tid & 1;
      float* Lr = Ls + row * 129;
      const size_t ob = ((size_t)(mt * 128 + row) * 16 + nt) * 16;
      for (int r = 0; r < 16; r++) {
        float best = -INFINITY; int bi = 0;
        for (int i = 0; i < 64; i++) {
          const float v = Lr[half + 2 * i];
          if (v > best) { best = v; bi = half + 2 * i; }
        }
        const float ov = __shfl_xor(best, 1, 64);
        const int oi = __shfl_xor(bi, 1, 64);
        if (ov > best || (ov == best && oi < bi)) { best = ov; bi = oi; }
        if ((bi & 1) == half) Lr[bi] = -INFINITY;
        if (half == 0) { p.topv[ob + r] = best; p.topi[ob + r] = bi; }
      }
    }
    __syncthreads();
  }
}

__device__ __forceinline__ void cand_ij(int lane, int& ci, int& cj) {
  int i = 0, rem = lane;
#pragma unroll
  for (int r = 0; r < 16; r++) {
    const int cnt = 16 / (r + 1);
    if (i == r && rem >= cnt) { rem -= cnt; i = r + 1; }
  }
  ci = i; cj = rem;
}

typedef __attribute__((ext_vector_type(2))) __bf16 bf2_t;
__device__ __forceinline__ float dot2bf(unsigned a, unsigned b, float c) {
  return __builtin_amdgcn_fdot2_f32_bf16(__builtin_bit_cast(bf2_t, a), __builtin_bit_cast(bf2_t, b), c, false);
}
template <int CTRL, int RM>
__device__ __forceinline__ float dppf_m(float x) {
  return __int_as_float(__builtin_amdgcn_update_dpp(0, __float_as_int(x), CTRL, RM, 0xf, false));
}
__device__ __forceinline__ float wave_sum_l63(float x) {
  x += dppf<0xB1>(x);
  x += dppf<0x4E>(x);
  x += dppf<0x141>(x);
  x += dppf<0x140>(x);
  x += dppf_m<0x142, 0xA>(x);
  x += dppf_m<0x143, 0xC>(x);
  return x;
}
__device__ __forceinline__ float readlane_f(float x, int l) {
  return __int_as_float(__builtin_amdgcn_readlane(__float_as_int(x), l));
}
__device__ __forceinline__ void axpy8(float* acc, float w, uint4 v) {
  acc[0] += w * bflo(v.x); acc[1] += w * bfhi(v.x); acc[2] += w * bflo(v.y); acc[3] += w * bfhi(v.y);
  acc[4] += w * bflo(v.z); acc[5] += w * bfhi(v.z); acc[6] += w * bflo(v.w); acc[7] += w * bfhi(v.w);
}

typedef float f2_t __attribute__((ext_vector_type(2)));
__device__ __forceinline__ void fp8x16_to_f32(const uint4 v, float* o) {
  const unsigned w[4] = {v.x, v.y, v.z, v.w};
#pragma unroll
  for (int i = 0; i < 4; i++) {
    const f2_t lo = __builtin_amdgcn_cvt_pk_f32_fp8((int)w[i], false);
    const f2_t hi = __builtin_amdgcn_cvt_pk_f32_fp8((int)w[i], true);
    o[4 * i] = lo.x; o[4 * i + 1] = lo.y; o[4 * i + 2] = hi.x; o[4 * i + 3] = hi.y;
  }
}

__device__ void phase10(const P& p, int bid, int nb) {
  const int lane = TIDX & 63, wid = TIDX >> 6;
  int ci, cj; cand_ij(lane < 50 ? lane : 0, ci, cj);
  const unsigned char* ub8 = (const unsigned char*)p.ub;
  const unsigned char* vb8 = (const unsigned char*)p.vb;
  for (int it = bid; it < NT / 4; it += nb) {
    const int n = it * 4 + wid;
    int seq, t, T; tok2seq(n, seq, t, T);
    float xv[16];
    {
      const uint4 a = *(const uint4*)(p.xn + (size_t)n * D + lane * 16), b = *(const uint4*)(p.xn + (size_t)n * D + lane * 16 + 8);
      const unsigned as[4] = {a.x, a.y, a.z, a.w}, bs[4] = {b.x, b.y, b.z, b.w};
#pragma unroll
      for (int e = 0; e < 4; e++) { xv[2 * e] = bflo(as[e]); xv[2 * e + 1] = bfhi(as[e]); xv[8 + 2 * e] = bflo(bs[e]); xv[8 + 2 * e + 1] = bfhi(bs[e]); }
    }
    float acc[16];
#pragma unroll
    for (int e = 0; e < 16; e++) acc[e] = 0.f;
#pragma unroll 1
    for (int h = 0; h < 8; h++) {
      const size_t base = ((size_t)n * 16 + h * 2) * 16;
      float cand = -INFINITY; int eid = 0;
      if (lane < 50) {
        cand = p.topv[base + ci] + p.topv[base + 16 + cj];
        eid = p.topi[base + ci] * 128 + p.topi[base + 16 + cj];
      }
      int rank = 0;
#pragma unroll
      for (int m = 0; m < 50; m++) {
        const float cm = readlane_f(cand, m);
        rank += ((cm > cand) || (cm == cand && m < lane)) ? 1 : 0;
      }
      const bool sel = (lane < 50) && (rank < 16);
      unsigned long long mask = __ballot(sel);
      const float mx = readlane_f(cand, __builtin_ctzll(__ballot(sel && rank == 0)));
      const float ex = sel ? __expf(cand - mx) : 0.f;
      const float den = readlane_f(wave_sum_l63(ex), 63);
      const float gate = ex / den;
#pragma unroll 1
      for (int hf = 0; hf < 2; hf++) {
        int ek[8]; float gk[8];
#pragma unroll
        for (int k = 0; k < 8; k++) {
          const int src = __builtin_ctzll(mask);
          mask &= mask - 1;
          ek[k] = __builtin_amdgcn_readlane(eid, src);
          gk[k] = readlane_f(gate, src);
        }
        uint4 uu[8], vv[8];
#pragma unroll
        for (int j = 0; j < 8; j++) uu[j] = *(const uint4*)(ub8 + (size_t)ek[j] * D + lane * 16);
#pragma unroll
        for (int j = 0; j < 8; j++) vv[j] = *(const uint4*)(vb8 + (size_t)ek[j] * D + lane * 16);
        float dv = 0.f;
#pragma unroll
        for (int j = 0; j < 8; j++) {
          float uf[16];
          fp8x16_to_f32(uu[j], uf);
          float d0 = 0.f, d1 = 0.f;
#pragma unroll
          for (int e = 0; e < 8; e++) { d0 += uf[2 * e] * xv[2 * e]; d1 += uf[2 * e + 1] * xv[2 * e + 1]; }
          const float ds = readlane_f(wave_sum_l63(d0 + d1), 63);
          dv = (lane == j) ? ds : dv;
        }
        dv *= (1.f / U_SCALE);
        const float act = 0.5f * dv * (1.f + erff(dv * 0.70710678118654752f));
#pragma unroll
        for (int j = 0; j < 8; j++) {
          const float w = readlane_f(act, j) * gk[j] * (1.f / V_SCALE);
          float vf[16];
          fp8x16_to_f32(vv[j], vf);
#pragma unroll
          for (int e = 0; e < 16; e++) acc[e] += w * vf[e];
        }
      }
    }
    float* yr = p.out + O_Y + (size_t)n * D + lane * 16;
    const float* md = p.mod + (size_t)seq * 8192 + lane * 16;
    float x2[16];
    float ss = 0.f;
#pragma unroll
    for (int q4 = 0; q4 < 4; q4++) {
      const float4 a = *(const float4*)(yr + q4 * 4), g = *(const float4*)(md + 5120 + q4 * 4);
      x2[q4 * 4 + 0] = a.x + g.x * acc[q4 * 4 + 0]; x2[q4 * 4 + 1] = a.y + g.y * acc[q4 * 4 + 1];
      x2[q4 * 4 + 2] = a.z + g.z * acc[q4 * 4 + 2]; x2[q4 * 4 + 3] = a.w + g.w * acc[q4 * 4 + 3];
    }
#pragma unroll
    for (int e = 0; e < 16; e++) ss += x2[e] * x2[e];
    ss = readlane_f(wave_sum_l63(ss), 63);
    const float rstd = rsqrtf(ss * (1.f / 1024.f) + 1e-6f);
#pragma unroll
    for (int q4 = 0; q4 < 4; q4++) {
      const float4 fg = *(const float4*)(p.final_g + lane * 16 + q4 * 4), sc = *(const float4*)(md + 7168 + q4 * 4),
                   sh = *(const float4*)(md + 6144 + q4 * 4);
      float4 o;
      o.x = x2[q4 * 4 + 0] * rstd * fg.x * (1.f + sc.x) + sh.x;
      o.y = x2[q4 * 4 + 1] * rstd * fg.y * (1.f + sc.y) + sh.y;
      o.z = x2[q4 * 4 + 2] * rstd * fg.z * (1.f + sc.z) + sh.z;
      o.w = x2[q4 * 4 + 3] * rstd * fg.w * (1.f + sc.w) + sh.w;
      *(float4*)(yr + q4 * 4) = o;
    }
  }
}

#define XB_XCNT(j) (256 + 64 * (j))
#define XB_XSUB(j) (1280 + 64 * (j))
#define XB_XGEN(j) (2304 + 64 * (j))
#define XB_TOP 3328
#define XB_TOPGEN 3392
#define XB_WORDS 4096
__device__ __forceinline__ unsigned xb_ld(unsigned* p) { return __hip_atomic_load(p, __ATOMIC_RELAXED, __HIP_MEMORY_SCOPE_AGENT); }
__device__ __forceinline__ unsigned xb_add(unsigned* p, unsigned v) { return __hip_atomic_fetch_add(p, v, __ATOMIC_RELAXED, __HIP_MEMORY_SCOPE_AGENT); }
__device__ __forceinline__ unsigned xb_xcc_id() { return (unsigned)__builtin_amdgcn_s_getreg((3 << 11) | 20) & 0xFu; }
__device__ __forceinline__ void grid_barrier(unsigned* bar, volatile unsigned* xst) {
  asm volatile("s_waitcnt vmcnt(0)" ::: "memory");
  __syncthreads();
  if (TIDX == 0) {
    __builtin_amdgcn_s_waitcnt(0);
    const unsigned x = xst[0], nloc = xst[1], nx = xst[2];
    const unsigned old = xb_add(&bar[XB_XSUB(x)], 1u);
    const unsigned gen = old / nloc;
    if (old + 1u == (gen + 1u) * nloc) {
      __builtin_amdgcn_fence(__ATOMIC_RELEASE, "agent");
      asm volatile("s_waitcnt vmcnt(0)" ::: "memory");
      const unsigned og = xb_add(&bar[XB_TOP], 1u);
      const unsigned tg = og / nx;
      if (og + 1u == (tg + 1u) * nx) xb_add(&bar[XB_TOPGEN], 1u);
      else while (xb_ld(&bar[XB_TOPGEN]) == tg) __builtin_amdgcn_s_sleep(1);
      __builtin_amdgcn_fence(__ATOMIC_ACQUIRE, "agent");
      xb_add(&bar[XB_XGEN(x)], 1u);
      asm volatile("s_waitcnt vmcnt(0)" ::: "memory");
    } else {
      while (xb_ld(&bar[XB_XGEN(x)]) == gen) __builtin_amdgcn_s_sleep(1);
      __builtin_amdgcn_fence(__ATOMIC_ACQUIRE, "agent");
      asm volatile("s_waitcnt vmcnt(0)" ::: "memory");
    }
  }
  __syncthreads();
}

template <int PH>
__device__ __forceinline__ void run_phase(const P& p, int bid, int nb, char* smem) {
  if constexpr (PH == 0) phase0(p, bid, nb, smem);
  if constexpr (PH == 1) phase_norm<false>(p, bid, nb);
  if constexpr (PH == 2) phase2(p, bid, nb, smem);
  if constexpr (PH == 3) phase3(p, bid, nb, smem);
  if constexpr (PH == 4) phase4(p, bid, nb, smem);
  if constexpr (PH == 5) phase5(p, bid, nb);
  if constexpr (PH == 6) phase6(p, bid, nb, smem);
  if constexpr (PH == 7) phase7(p, bid, nb, smem);
  if constexpr (PH == 8) phase_norm<true>(p, bid, nb);
  if constexpr (PH == 9) phase9(p, bid, nb, smem);
  if constexpr (PH == 10) phase10(p, bid, nb);
}

template <int PH>
__global__ void __launch_bounds__(NTHREADS, 2) k_phase(P p) {
  extern __shared__ __attribute__((aligned(16))) char smem[];
  run_phase<PH>(p, blockIdx.x, gridDim.x, smem);
}

#if MEGA
__global__ void __launch_bounds__(NTHREADS, 2) k_mega(P p) {
  extern __shared__ __attribute__((aligned(16))) char smem[];
  cg::grid_group grid = cg::this_grid();
  const int bid = blockIdx.x, nb = gridDim.x;
#ifndef PROBE_ALL2
#define PROBE_ALL2 0
#endif
#ifndef PROBE_MASK
#define PROBE_MASK 0
#endif
#ifndef PROBE_SYNCS
#define PROBE_SYNCS 0
#endif
  volatile unsigned* xst = (volatile unsigned*)(smem + LDS_BYTES - 16);
  if (TIDX == 0) { const unsigned xcc0 = xb_xcc_id(); xst[0] = xcc0; xb_add(&p.bar[XB_XCNT(xcc0)], 1u); }
#define GSYNC(k)                                                                                 \
  {                                                                                              \
    if ((k) == 0) {                                                                              \
      grid.sync();                                                                               \
      if (TIDX == 0) {                                                                    \
        unsigned cnt = 0;                                                                        \
        for (unsigned j = 0; j < 16; ++j) cnt += xb_ld(&p.bar[XB_XCNT(j)]) > 0u ? 1u : 0u;       \
        xst[2] = cnt; xst[1] = xb_ld(&p.bar[XB_XCNT(xst[0])]);                                   \
      }                                                                                          \
    } else grid_barrier(p.bar, xst);                                                             \
  }
#define RUNPH(k)                                                       \
  run_phase<k>(p, bid, nb, smem); GSYNC(k)                             \
  if (PROBE_MASK & (1 << k)) { run_phase<k>(p, bid, nb, smem); GSYNC(1) }
#pragma unroll 1
  for (int rep = 0; rep < 1 + PROBE_ALL2; rep++) {
    RUNPH(0)
#pragma unroll 1
    for (int i = 0; i < PROBE_SYNCS; i++) GSYNC(1)
    RUNPH(1) RUNPH(2) RUNPH(3) RUNPH(4) RUNPH(5) RUNPH(6) RUNPH(7) RUNPH(8) RUNPH(9)
  }
  run_phase<10>(p, bid, nb, smem);
}
#endif

template <int PH>
static void launch_phase(const P& p, int grid, hipStream_t stream) {
  static bool attr = false;
  if (!attr) { hipFuncSetAttribute((const void*)k_phase<PH>, hipFuncAttributeMaxDynamicSharedMemorySize, LDS_BYTES); attr = true; }
  hipLaunchKernelGGL(k_phase<PH>, dim3(grid), dim3(NTHREADS), LDS_BYTES, stream, p);
}

extern "C" void kernel_launch(void* const* d_in, const int* in_sizes, int n_in, void* d_out, int out_size, void* d_ws,
                              size_t ws_size, hipStream_t stream) {
  P p{};
  const float** fp = (const float**)&p;
  for (int i = 0; i < 40; i++) fp[i] = (const float*)d_in[i];
  p.out = (float*)d_out;
  char* ws = (char*)d_ws;
  size_t off = 0;
  auto take = [&](size_t bytes) { char* r = ws + off; off += (bytes + 255) & ~(size_t)255; return r; };
  p.bar = (unsigned*)take(XB_WORDS * 4);
  p.w_inT = (u16*)take((size_t)INCOLS * D * 2);
  p.w_paT = (u16*)take((size_t)1024 * 512 * 2);
  p.w_pbT = (u16*)take((size_t)1024 * 1024 * 2);
  p.w_outT = (u16*)take((size_t)1024 * 1024 * 2);
  p.wqT = (u16*)take((size_t)2048 * 1024 * 2);
  p.keysb = (u16*)take((size_t)262144 * 2);
  p.mod = (float*)take((size_t)NSEQ * 8192 * 4);
  p.dtb = (float*)take((size_t)NT * 16 * 4);
  p.decb = (float*)take((size_t)NT * 16 * 4);
  p.xn = (u16*)take((size_t)NROWS * D * 2);
  p.proj = (u16*)take((size_t)NROWS * PCOLS * 2);
  p.prep = (u16*)take((size_t)NT * 3584 * 2);
  if (off > ws_size) { fprintf(stderr, "workspace too small: need %zu have %zu\n", off, ws_size); return; }
  p.merged = p.prep;
  p.ub = p.proj;
  p.vb = p.proj + (size_t)16384 * 1024;
  p.topv = (float*)(p.proj + (size_t)2 * 16384 * 1024);
  p.topi = (int*)(p.topv + (size_t)NT * 256);
  p.xc = (u16*)d_out;
  p.oa = (u16*)d_out;
  p.ob = (u16*)d_out + (size_t)NT * 512;

  static int grid = 0;
  if (!grid) {
    int dev = 0, cus = 0, per_cu = 0;
    hipGetDevice(&dev);
    hipDeviceGetAttribute(&cus, hipDeviceAttributeMultiprocessorCount, dev);
#if MEGA
    hipFuncSetAttribute((const void*)k_mega, hipFuncAttributeMaxDynamicSharedMemorySize, LDS_BYTES);
    hipOccupancyMaxActiveBlocksPerMultiprocessor(&per_cu, k_mega, NTHREADS, LDS_BYTES);
    if (per_cu > 2) per_cu = 2;
#else
    per_cu = 2;
#endif
    if (per_cu < 1) per_cu = 1;
    grid = cus * per_cu;
  }
#if MEGA
  hipMemsetAsync(p.bar, 0, XB_WORDS * 4, stream);
  void* args[] = {&p};
  hipError_t e = hipLaunchCooperativeKernel((void*)k_mega, dim3(grid), dim3(NTHREADS), args, LDS_BYTES, stream);
  if (e != hipSuccess) fprintf(stderr, "cooperative launch failed: %s (grid %d)\n", hipGetErrorString(e), grid);
#else
  launch_phase<0>(p, grid, stream);
  launch_phase<1>(p, grid, stream);
  launch_phase<2>(p, grid, stream);
  launch_phase<3>(p, grid, stream);
  launch_phase<4>(p, grid, stream);
  launch_phase<5>(p, grid, stream);
  launch_phase<6>(p, grid, stream);
  launch_phase<7>(p, grid, stream);
  launch_phase<8>(p, grid, stream);
  launch_phase<9>(p, grid, stream);
  launch_phase<10>(p, grid, stream);
#endif
}
```

```cpp
#include <hip/hip_runtime.h>
#include <hip/hip_cooperative_groups.h>
#include <cstdio>
namespace cg = cooperative_groups;

#ifndef MEGA
#define MEGA 1
#endif

typedef unsigned short u16;
typedef __attribute__((ext_vector_type(8))) short bf16x8;
typedef __attribute__((ext_vector_type(4))) float f32x4;

__device__ __forceinline__ int opaque_tid() { int t = threadIdx.x; asm volatile("" : "+v"(t)); return t; }
#define TIDX opaque_tid()

constexpr int D = 1024;
constexpr int NP = 16384, NS = 1024, NT = NP + NS, NSEQ = 136;
constexpr int NROWS = NT + 128;
constexpr int PCOLS = 4368;
constexpr int INCOLS = 6416;
constexpr int C_LW = 1536, C_LA = 1600, C_LG = 1664, C_Z = 1792, C_XBC = 2816, C_DT = 4352;
constexpr int G_A = 4368, G_B = 5392;
constexpr size_t O_Y = 0, O_PSHIFT = 17825792, O_PWKV = 17833984, O_PCONV = 18096128, O_PSSM = 18132992,
                 O_SSHIFT = 19181568, O_SWKV = 19312640, O_SCONV = 23506944, O_SSSM = 24096768;
constexpr int LDS_BYTES = 80 * 1024;
constexpr int NTHREADS = 256;

struct P {
  const float *x_prompt, *x_sample, *c_prompt, *c_sample, *state_shift, *state_wkv, *state_conv, *state_ssm;
  const float *w_ada, *b_ada, *norm1_g, *w_in, *rw_mu, *rw_w0, *rw_w2, *rw_a0, *rw_a2, *rw_g2, *rw_k_k, *rw_k_a,
      *rw_r_k, *rw_ln_w, *rw_ln_b;
  const float *conv_w, *conv_b, *dt_bias, *A_log, *D_skip, *ssm_norm_w, *w_pa, *w_pb, *w_out, *norm2_g, *peer_wq,
      *peer_keys, *peer_u, *peer_v, *final_g, *w_ada_f, *b_ada_f;
  float* out;
  u16 *w_inT, *w_paT, *w_pbT, *w_outT, *wqT, *keysb, *xn, *proj, *prep, *merged, *ub, *vb, *xc, *oa, *ob;
  u16 *w2T, *a2T, *g2T, *lora;
  float *mod, *dtb, *decb, *topv;
  int* topi;
  unsigned* bar;
};

__device__ __forceinline__ u16 f2bf(float f) {
  unsigned u = __float_as_uint(f);
  u += 0x7fffu + ((u >> 16) & 1u);
  return (u16)(u >> 16);
}
__device__ __forceinline__ float bf2f(u16 h) { return __uint_as_float(((unsigned)h) << 16); }
__device__ __forceinline__ unsigned pack2(float a, float b) { return (unsigned)f2bf(a) | ((unsigned)f2bf(b) << 16); }
__device__ __forceinline__ float bflo(unsigned u) { return __uint_as_float(u << 16); }
__device__ __forceinline__ float bfhi(unsigned u) { return __uint_as_float(u & 0xffff0000u); }
__device__ __forceinline__ float sigmoidf_(float x) { return 1.f / (1.f + __expf(-x)); }
__device__ __forceinline__ float siluf_(float x) { return x / (1.f + __expf(-x)); }
__device__ __forceinline__ float softplusf_(float x) { return x > 20.f ? x : log1pf(expf(x)); }

template <int CTRL>
__device__ __forceinline__ float dppf(float x) {
  return __int_as_float(__builtin_amdgcn_update_dpp(0, __float_as_int(x), CTRL, 0xf, 0xf, true));
}
__device__ __forceinline__ float allreduce16(float x) {
  x += dppf<0x128>(x);
  x += dppf<0x124>(x);
  x += dppf<0x122>(x);
  x += dppf<0x121>(x);
  return x;
}
__device__ __forceinline__ float allreduce8(float x) {
  x += dppf<0xB1>(x);
  x += dppf<0x4E>(x);
  x += dppf<0x141>(x);
  return x;
}
__device__ __forceinline__ float wave_sum(float x) {
#pragma unroll
  for (int o = 32; o >= 1; o >>= 1) x += __shfl_xor(x, o, 64);
  return x;
}
__device__ __forceinline__ float wave_max(float x) {
#pragma unroll
  for (int o = 32; o >= 1; o >>= 1) x = fmaxf(x, __shfl_xor(x, o, 64));
  return x;
}
__device__ __forceinline__ int wave_min_i(int x) {
#pragma unroll
  for (int o = 32; o >= 1; o >>= 1) x = min(x, __shfl_xor(x, o, 64));
  return x;
}

__device__ __forceinline__ const float* xrow(const P& p, int n) {
  return n < NP ? p.x_prompt + (size_t)n * D : p.x_sample + (size_t)(n - NP) * D;
}
__device__ __forceinline__ void tok2seq(int n, int& seq, int& t, int& T) {
  if (n < NP) { seq = n >> 11; t = n & 2047; T = 2048; }
  else { int m = n - NP; seq = 8 + (m >> 3); t = m & 7; T = 8; }
}
__device__ __forceinline__ float* seq_out(float* out, int seq, size_t op, size_t os, size_t per) {
  return seq < 8 ? out + op + (size_t)seq * per : out + os + (size_t)(seq - 8) * per;
}

constexpr int LROW = 144;
template <bool DEEP = true>
__device__ __forceinline__ void gemm_tile(const u16* __restrict__ A, int lda, int m0, const u16* __restrict__ Bt,
                                          int ldb, int n0, int K, f32x4 (&acc)[4][4], char* smem) {
  char* sA = smem;
  char* sB = smem + 128 * LROW;
  const int tid = TIDX, lane = tid & 63, wid = tid >> 6, wr = wid >> 1, wc = wid & 1, fr = lane & 15,
            fq = lane >> 4;
  uint4 ra0, ra1, ra2, ra3, rb0, rb1, rb2, rb3;
  uint4 sa0, sa1, sa2, sa3, sb0, sb1, sb2, sb3;
  const int nk = K / 64;
  const int lrow = tid >> 3, lch = tid & 7;
  const u16* gA = A + (size_t)(m0 + lrow) * lda + lch * 8;
  const u16* gB = Bt + (size_t)(n0 + lrow) * ldb + lch * 8;
#define GLOAD(x0, x1, x2, x3, y0, y1, y2, y3, kt)                   \
  {                                                                 \
    x0 = *(const uint4*)(gA + (kt) * 64);                           \
    x1 = *(const uint4*)(gA + (size_t)32 * lda + (kt) * 64);        \
    x2 = *(const uint4*)(gA + (size_t)64 * lda + (kt) * 64);        \
    x3 = *(const uint4*)(gA + (size_t)96 * lda + (kt) * 64);        \
    y0 = *(const uint4*)(gB + (kt) * 64);                           \
    y1 = *(const uint4*)(gB + (size_t)32 * ldb + (kt) * 64);        \
    y2 = *(const uint4*)(gB + (size_t)64 * ldb + (kt) * 64);        \
    y3 = *(const uint4*)(gB + (size_t)96 * ldb + (kt) * 64);        \
  }
#define LSTORE(x0, x1, x2, x3, y0, y1, y2, y3)                      \
  {                                                                 \
    char* wa = sA + lrow * LROW + lch * 16;                         \
    char* wb = sB + lrow * LROW + lch * 16;                         \
    *(uint4*)(wa) = x0; *(uint4*)(wa + 32 * LROW) = x1; *(uint4*)(wa + 64 * LROW) = x2; *(uint4*)(wa + 96 * LROW) = x3; \
    *(uint4*)(wb) = y0; *(uint4*)(wb + 32 * LROW) = y1; *(uint4*)(wb + 64 * LROW) = y2; *(uint4*)(wb + 96 * LROW) = y3; \
  }
#define COMPUTE_TILE()                                                                                                   \
  {                                                                                                                      \
    _Pragma("unroll") for (int s = 0; s < 2; s++) {                                                                      \
      bf16x8 af[4], bfr[4];                                                                                              \
      _Pragma("unroll") for (int m = 0; m < 4; m++) af[m] = *(const bf16x8*)(sA + (wr * 64 + m * 16 + fr) * LROW + s * 64 + fq * 16); \
      _Pragma("unroll") for (int n = 0; n < 4; n++) bfr[n] = *(const bf16x8*)(sB + (wc * 64 + n * 16 + fr) * LROW + s * 64 + fq * 16); \
      _Pragma("unroll") for (int m = 0; m < 4; m++)                                                                      \
        _Pragma("unroll") for (int n = 0; n < 4; n++) acc[m][n] = __builtin_amdgcn_mfma_f32_16x16x32_bf16(af[m], bfr[n], acc[m][n], 0, 0, 0); \
    }                                                                                                                    \
  }
  GLOAD(ra0, ra1, ra2, ra3, rb0, rb1, rb2, rb3, 0);
  if constexpr (DEEP) {
    GLOAD(sa0, sa1, sa2, sa3, sb0, sb1, sb2, sb3, 1);
#pragma unroll 1
    for (int kt = 0; kt < nk; kt += 2) {
      __syncthreads();
      LSTORE(ra0, ra1, ra2, ra3, rb0, rb1, rb2, rb3);
      __syncthreads();
      if (kt + 2 < nk) GLOAD(ra0, ra1, ra2, ra3, rb0, rb1, rb2, rb3, kt + 2);
      COMPUTE_TILE();
      __syncthreads();
      LSTORE(sa0, sa1, sa2, sa3, sb0, sb1, sb2, sb3);
      __syncthreads();
      if (kt + 3 < nk) GLOAD(sa0, sa1, sa2, sa3, sb0, sb1, sb2, sb3, kt + 3);
      COMPUTE_TILE();
    }
  } else {
#pragma unroll 1
    for (int kt = 0; kt < nk; kt++) {
      __syncthreads();
      LSTORE(ra0, ra1, ra2, ra3, rb0, rb1, rb2, rb3);
      __syncthreads();
      if (kt + 1 < nk) GLOAD(ra0, ra1, ra2, ra3, rb0, rb1, rb2, rb3, kt + 1);
      COMPUTE_TILE();
    }
  }
  __syncthreads();
}
__device__ __forceinline__ void zero_acc(f32x4 (&acc)[4][4]) {
#pragma unroll
  for (int m = 0; m < 4; m++)
#pragma unroll
    for (int n = 0; n < 4; n++) acc[m][n] = f32x4{0.f, 0.f, 0.f, 0.f};
}
#define ACC_FOREACH(...)                                                                    \
  {                                                                                         \
    const int _l = TIDX & 63, _w = TIDX >> 6, _wr = _w >> 1, _wc = _w & 1;    \
    const int _fr = _l & 15, _fq = _l >> 4;                                                 \
    _Pragma("unroll") for (int m = 0; m < 4; m++) _Pragma("unroll") for (int n = 0; n < 4; n++) \
        _Pragma("unroll") for (int j = 0; j < 4; j++) {                                     \
      const int row = _wr * 64 + m * 16 + _fq * 4 + j, col = _wc * 64 + n * 16 + _fr;       \
      __VA_ARGS__                                                                           \
    }                                                                                       \
  }

struct TileIter {
  int x, lb, nbx, tpx, total, MT, NT, r;
  __device__ __forceinline__ TileIter(int bid, int nb, int MT_, int NT_) : MT(MT_), NT(NT_), r(0) {
    total = MT * NT; x = bid & 7; lb = bid >> 3; nbx = nb >> 3; tpx = (total + 7) >> 3;
  }
  __device__ __forceinline__ bool next(int& mt, int& nt) {
    const int idx = lb + r * nbx;
    r++;
    if (idx >= tpx) return false;
    const int lin = x * tpx + idx;
    if (lin >= total) return false;
    const int bsz = 8 * NT, band = lin / bsz, rem = lin - band * bsz;
    const int mb = min(8, MT - band * 8);
    nt = rem / mb; mt = band * 8 + (rem - nt * mb);
    return true;
  }
};

__device__ void transpose_tile(const float* __restrict__ src, int K, int N, u16* __restrict__ dst, int tile,
                               char* smem) {
  const int ntn = (N + 63) / 64, kt = tile / ntn, nt = tile % ntn, tid = TIDX;
  float(*s)[65] = (float(*)[65])smem;
  __syncthreads();
#pragma unroll 4
  for (int i = 0; i < 16; i++) {
    int r = (tid >> 6) + 4 * i, n = nt * 64 + (tid & 63);
    s[r][tid & 63] = (n < N) ? src[(size_t)(kt * 64 + r) * N + n] : 0.f;
  }
  __syncthreads();
#pragma unroll 4
  for (int i = 0; i < 8; i++) {
    int nl = (tid >> 5) + 8 * i, n = nt * 64 + nl, kl = (tid & 31) * 2;
    if (n < N) *(unsigned*)(dst + (size_t)n * K + kt * 64 + kl) = pack2(s[kl][nl], s[kl + 1][nl]);
  }
}

__device__ void mod_item(const P& p, int item, char* smem) {
  const int tid = TIDX, j = tid & 31, g = tid >> 5;
  const int col0 = item * 32;
  const float* W; const float* bias; int N, cw;
  if (col0 < 6144) { W = p.w_ada; bias = p.b_ada; N = 6144; cw = col0; }
  else { W = p.w_ada_f; bias = p.b_ada_f; N = 2048; cw = col0 - 6144; }
  float(*cs)[68] = (float(*)[68])smem;
  float acc[17];
#pragma unroll
  for (int s = 0; s < 17; s++) acc[s] = 0.f;
  for (int k0 = 0; k0 < 1024; k0 += 64) {
    __syncthreads();
    {
      float cv[34];
#pragma unroll
      for (int i = 0; i < 34; i++) {
        const int idx = tid + i * 256, seq = idx >> 6, kk = idx & 63;
        cv[i] = seq < 8 ? p.c_prompt[seq * 1024 + k0 + kk] : p.c_sample[(seq - 8) * 1024 + k0 + kk];
      }
#pragma unroll
      for (int i = 0; i < 34; i++) {
        const int idx = tid + i * 256;
        cs[idx >> 6][idx & 63] = siluf_(cv[i]);
      }
    }
    __syncthreads();
#pragma unroll 1
    for (int kh = 0; kh < 2; kh++) {
      float wv[32];
#pragma unroll
      for (int k = 0; k < 32; k++) wv[k] = W[(size_t)(k0 + kh * 32 + k) * N + cw + j];
#pragma unroll 2
      for (int k4 = 0; k4 < 8; k4++) {
#pragma unroll
        for (int s = 0; s < 17; s++) {
          float4 c4 = *(const float4*)&cs[g * 17 + s][kh * 32 + k4 * 4];
          acc[s] += wv[k4 * 4] * c4.x + wv[k4 * 4 + 1] * c4.y + wv[k4 * 4 + 2] * c4.z + wv[k4 * 4 + 3] * c4.w;
        }
      }
    }
  }
  float b = bias[cw + j];
#pragma unroll
  for (int s = 0; s < 17; s++) p.mod[(size_t)(g * 17 + s) * 8192 + col0 + j] = acc[s] + b;
}

constexpr int J_MOD = 256, J_WIN = 16 * 101, J_WPA = 8 * 16, J_WPB = 256, J_WOUT = 256, J_WQ = 16 * 32, J_KEYS = 128,
              J_SHIFT = 64;
constexpr int J_LORA = 8 + 8 + 16;
constexpr int PH0_ITEMS = J_MOD + J_WIN + J_WPA + J_WPB + J_WOUT + J_WQ + J_LORA + J_KEYS + J_SHIFT;

__device__ void phase0(const P& p, int bid, int nb, char* smem) {
  for (int it = bid; it < PH0_ITEMS; it += nb) {
    int i = it;
    if (i < J_MOD) { mod_item(p, i, smem); continue; }
    i -= J_MOD;
    if (i < J_WIN) { transpose_tile(p.w_in, 1024, INCOLS, p.w_inT, i, smem); continue; }
    i -= J_WIN;
    if (i < J_WPA) { transpose_tile(p.w_pa, 512, 1024, p.w_paT, i, smem); continue; }
    i -= J_WPA;
    if (i < J_WPB) { transpose_tile(p.w_pb, 1024, 1024, p.w_pbT, i, smem); continue; }
    i -= J_WPB;
    if (i < J_WOUT) { transpose_tile(p.w_out, 1024, 1024, p.w_outT, i, smem); continue; }
    i -= J_WOUT;
    if (i < J_WQ) { transpose_tile(p.peer_wq, 1024, 2048, p.wqT, i, smem); continue; }
    i -= J_WQ;
    if (i < 8) { transpose_tile(p.rw_w2, 64, 512, p.w2T, i, smem); continue; }
    if (i < 16) { transpose_tile(p.rw_a2, 64, 512, p.a2T, i - 8, smem); continue; }
    if (i < 32) { transpose_tile(p.rw_g2, 128, 512, p.g2T, i - 16, smem); continue; }
    i -= J_LORA;
    const float* src; u16* dst;
    if (i < J_KEYS) { src = p.peer_keys + (size_t)i * 2048; dst = p.keysb + (size_t)i * 2048; }
    else { i -= J_KEYS; src = p.state_shift + (size_t)i * 2048; dst = p.xn + (size_t)NT * D + (size_t)i * 2048; }
    const float4* s4 = (const float4*)src + TIDX * 2;
    float4 a = s4[0], b = s4[1];
    uint4 o; o.x = pack2(a.x, a.y); o.y = pack2(a.z, a.w); o.z = pack2(b.x, b.y); o.w = pack2(b.z, b.w);
    *((uint4*)dst + TIDX) = o;
  }
}

template <bool SECOND>
__device__ void phase_norm(const P& p, int bid, int nb) {
  const int lane = TIDX & 63, wid = TIDX >> 6;
  const float* gam = SECOND ? p.norm2_g : p.norm1_g;
  for (int it = bid; it < NT / 4; it += nb) {
    const int n = it * 4 + wid;
    int seq, t, T; tok2seq(n, seq, t, T);
    const float* xr = SECOND ? p.out + O_Y + (size_t)n * D : xrow(p, n);
    const float* md = p.mod + (size_t)seq * 8192 + (SECOND ? 3072 : 0);
    float4 v[4];
    float ss = 0.f;
#pragma unroll
    for (int i = 0; i < 4; i++) {
      v[i] = ((const float4*)xr)[lane + 64 * i];
      ss += v[i].x * v[i].x + v[i].y * v[i].y + v[i].z * v[i].z + v[i].w * v[i].w;
    }
    ss = wave_sum(ss);
    const float rstd = rsqrtf(ss * (1.f / 1024.f) + 1e-6f);
    const bool last = (!SECOND) && (t == T - 1);
    float* so = seq_out(p.out, seq, O_PSHIFT, O_SSHIFT, 1024);
#pragma unroll
    for (int i = 0; i < 4; i++) {
      const int c = (lane + 64 * i) * 4;
      float4 g = *(const float4*)(gam + c), sh = *(const float4*)(md + c), sc = *(const float4*)(md + 1024 + c);
      float4 o;
      o.x = v[i].x * rstd * g.x * (1.f + sc.x) + sh.x;
      o.y = v[i].y * rstd * g.y * (1.f + sc.y) + sh.y;
      o.z = v[i].z * rstd * g.z * (1.f + sc.z) + sh.z;
      o.w = v[i].w * rstd * g.w * (1.f + sc.w) + sh.w;
      uint2 pk; pk.x = pack2(o.x, o.y); pk.y = pack2(o.z, o.w);
      *(uint2*)(p.xn + (size_t)n * D + c) = pk;
      if (last) *(float4*)(so + c) = o;
    }
  }
}

constexpr int P2_NT = 35, P2_MT = 137;
__device__ void phase2(const P& p, int bid, int nb, char* smem) {
  TileIter ti(bid, nb, P2_MT, P2_NT);
  int mt, nt;
  while (ti.next(mt, nt)) {
    f32x4 acc[4][4];
    zero_acc(acc);
    gemm_tile(p.xn, D, mt * 128, p.w_inT, D, nt * 128, D, acc, smem);
    ACC_FOREACH({
      const int gc = nt * 128 + col;
      if (gc < PCOLS) p.proj[(size_t)(mt * 128 + row) * PCOLS + gc] = f2bf(acc[m][n][j]);
    })
  }
}

__device__ void rwkv_lerp_item(const P& p, int item) {
  const int tid = TIDX;
  const int n0 = item * 8;
  int seq, t0, T; tok2seq(n0, seq, t0, T);
  uint4 pcv[7], ppv[7];
#pragma unroll
  for (int i = 0; i < 7; i++) {
    const int idx = tid + i * 256, tok = idx / 224, c = (idx % 224) * 8;
    const int n = n0 + tok, t = t0 + tok;
    pcv[i] = *(const uint4*)(p.proj + (size_t)n * PCOLS + c);
    const size_t prow = t > 0 ? (size_t)(n - 1) : (size_t)(NT + (seq >= 8 ? seq - 8 : 0));
    ppv[i] = *(const uint4*)(p.proj + prow * PCOLS + c);
    if (t == 0 && seq < 8) ppv[i] = make_uint4(0, 0, 0, 0);
  }
#pragma unroll
  for (int i = 0; i < 7; i++) {
    const int idx = tid + i * 256, tok = idx / 224, c = (idx % 224) * 8;
    const int n = n0 + tok;
    const float4 mu0 = *(const float4*)(p.rw_mu + c), mu1 = *(const float4*)(p.rw_mu + c + 4);
    const float mus[8] = {mu0.x, mu0.y, mu0.z, mu0.w, mu1.x, mu1.y, mu1.z, mu1.w};
    const unsigned pcs[4] = {pcv[i].x, pcv[i].y, pcv[i].z, pcv[i].w}, pps[4] = {ppv[i].x, ppv[i].y, ppv[i].z, ppv[i].w};
    unsigned o[4];
#pragma unroll
    for (int e = 0; e < 4; e++) {
      float a0 = bflo(pcs[e]), a1 = bfhi(pcs[e]), b0 = bflo(pps[e]), b1 = bfhi(pps[e]);
      float q0 = a0 + (b0 - a0) * mus[2 * e], q1 = a1 + (b1 - a1) * mus[2 * e + 1];
      if (c >= C_LW && c < C_LA) { q0 = tanhf(q0); q1 = tanhf(q1); }
      else if (c >= C_LG) { q0 = sigmoidf_(q0); q1 = sigmoidf_(q1); }
      o[e] = pack2(q0, q1);
    }
    u16* dst;
    if (c < 512) dst = p.prep + (size_t)n * 3584 + 512 + c;
    else if (c < 1024) dst = p.prep + (size_t)n * 3584 + 1024 + (c - 512);
    else if (c < 1536) dst = p.prep + (size_t)n * 3584 + 2560 + (c - 1024);
    else dst = p.lora + (size_t)n * 256 + (c - 1536);
    *(uint4*)dst = make_uint4(o[0], o[1], o[2], o[3]);
  }
}

__device__ void rwkv_lora_item(const P& p, int mt, int nt, char* smem) {
  const int tid = TIDX, lane = tid & 63, wid = tid >> 6, wr = wid >> 1, wc = wid & 1, fr = lane & 15, fq = lane >> 4;
  const int col0 = nt * 128;
  f32x4 acc[4][4];
  zero_acc(acc);
  gemm_tile<false>(p.lora, 256, mt * 128, p.w2T, 64, col0, 64, acc, smem);
  ACC_FOREACH({
    const int gc = col0 + col;
    const float wpre = p.rw_w0[gc] + acc[m][n][j];
    const float w = -softplusf_(-wpre) - 0.5f;
    p.prep[(size_t)(mt * 128 + row) * 3584 + gc] = f2bf(-expf(w));
  })
  zero_acc(acc);
  gemm_tile<false>(p.lora + 128, 256, mt * 128, p.g2T, 128, col0, 128, acc, smem);
  ACC_FOREACH({ p.prep[(size_t)(mt * 128 + row) * 3584 + 3072 + col0 + col] = f2bf(acc[m][n][j]); })
  zero_acc(acc);
  gemm_tile<false>(p.lora + 64, 256, mt * 128, p.a2T, 64, col0, 64, acc, smem);
  float a0c[4], kkc[4], kac[4];
#pragma unroll
  for (int n = 0; n < 4; n++) {
    const int gc = col0 + wc * 64 + n * 16 + fr;
    a0c[n] = p.rw_a0[gc]; kkc[n] = p.rw_k_k[gc]; kac[n] = p.rw_k_a[gc];
  }
#pragma unroll
  for (int m = 0; m < 4; m++)
#pragma unroll
    for (int j = 0; j < 4; j++) {
      const int row = mt * 128 + wr * 64 + m * 16 + fq * 4 + j;
      u16* pr = p.prep + (size_t)row * 3584 + col0 + wc * 64 + fr;
      float kx[4], kkv[4], av[4];
      float ss = 0.f;
#pragma unroll
      for (int n = 0; n < 4; n++) {
        kx[n] = bf2f(pr[1024 + n * 16]);
        av[n] = sigmoidf_(a0c[n] + acc[m][n][j]);
        kkv[n] = kx[n] * kkc[n];
        ss += kkv[n] * kkv[n];
      }
      ss = allreduce16(ss);
      const float inv = 1.f / fmaxf(sqrtf(ss), 1e-12f);
#pragma unroll
      for (int n = 0; n < 4; n++) {
        const float kk = kkv[n] * inv;
        pr[1024 + n * 16] = f2bf(kx[n] * (1.f + (av[n] - 1.f) * kac[n]));
        pr[1536 + n * 16] = f2bf(kk);
        pr[2048 + n * 16] = f2bf(kk * av[n]);
      }
    }
}

__device__ void conv_prep_item(const P& p, int item) {
  const int tid = TIDX;
  const int n0 = item * 8;
  int seq, t0, T; tok2seq(n0, seq, t0, T);
  if (tid < 192) {
    const int c = tid * 8;
    uint4 rows[11];
#pragma unroll
    for (int j = 0; j < 11; j++) {
      const int tt = t0 - 3 + j;
      rows[j] = make_uint4(0, 0, 0, 0);
      if (tt >= 0) rows[j] = *(const uint4*)(p.proj + (size_t)(n0 - 3 + j) * PCOLS + C_XBC + c);
      else if (seq >= 8) {
        const float* sc = p.state_conv + ((size_t)(seq - 8) * 3 + (tt + 3)) * 1536 + c;
        const float4 a = *(const float4*)sc, b = *(const float4*)(sc + 4);
        rows[j] = make_uint4(pack2(a.x, a.y), pack2(a.z, a.w), pack2(b.x, b.y), pack2(b.z, b.w));
      }
    }
    float w[4][8], cb[8];
#pragma unroll
    for (int j = 0; j < 4; j++) {
      const float4 a = *(const float4*)(p.conv_w + j * 1536 + c), b = *(const float4*)(p.conv_w + j * 1536 + c + 4);
      w[j][0] = a.x; w[j][1] = a.y; w[j][2] = a.z; w[j][3] = a.w; w[j][4] = b.x; w[j][5] = b.y; w[j][6] = b.z; w[j][7] = b.w;
    }
    {
      const float4 a = *(const float4*)(p.conv_b + c), b = *(const float4*)(p.conv_b + c + 4);
      cb[0] = a.x; cb[1] = a.y; cb[2] = a.z; cb[3] = a.w; cb[4] = b.x; cb[5] = b.y; cb[6] = b.z; cb[7] = b.w;
    }
#pragma unroll
    for (int k = 0; k < 8; k++) {
      float o[8];
#pragma unroll
      for (int e = 0; e < 8; e++) o[e] = cb[e];
#pragma unroll
      for (int j = 0; j < 4; j++) {
        const uint4 r = rows[k + j];
        const unsigned rs[4] = {r.x, r.y, r.z, r.w};
#pragma unroll
        for (int e = 0; e < 4; e++) { o[2 * e] += bflo(rs[e]) * w[j][2 * e]; o[2 * e + 1] += bfhi(rs[e]) * w[j][2 * e + 1]; }
      }
      *(uint4*)(p.xc + (size_t)(n0 + k) * 1536 + c) =
          make_uint4(pack2(siluf_(o[0]), siluf_(o[1])), pack2(siluf_(o[2]), siluf_(o[3])), pack2(siluf_(o[4]), siluf_(o[5])),
                     pack2(siluf_(o[6]), siluf_(o[7])));
    }
    if (t0 + 8 == T) {
      float* co = seq_out(p.out, seq, O_PCONV, O_SCONV, 3 * 1536);
#pragma unroll
      for (int j = 0; j < 3; j++) {
        const uint4 r = rows[8 + j];
        *(float4*)(co + j * 1536 + c) = make_float4(bflo(r.x), bfhi(r.x), bflo(r.y), bfhi(r.y));
        *(float4*)(co + j * 1536 + c + 4) = make_float4(bflo(r.z), bfhi(r.z), bflo(r.w), bfhi(r.w));
      }
    }
  } else if (tid < 192 + 32) {
    const int i = tid - 192;
#pragma unroll
    for (int e = 0; e < 4; e++) {
      const int pi = i * 4 + e, k = pi >> 4, h = pi & 15, n = n0 + k;
      const float raw = bf2f(p.proj[(size_t)n * PCOLS + C_DT + h]) + p.dt_bias[h];
      const float dt = softplusf_(raw);
      const float dA = -dt * expf(p.A_log[h]);
      p.dtb[n * 16 + h] = dt;
      p.decb[n * 16 + h] = expf(dA);
    }
  }
}

__device__ void phase3(const P& p, int bid, int nb, char* smem) {
  for (int it = bid; it < 2 * (NT / 8); it += nb) {
    if (it < NT / 8) rwkv_lerp_item(p, it);
    else conv_prep_item(p, it - NT / 8);
  }
}
__device__ void phase3b(const P& p, int bid, int nb, char* smem) {
  for (int it = bid; it < 136 * 4; it += nb) rwkv_lora_item(p, it >> 2, it & 3, smem);
}

constexpr int TC = 32;
__device__ __forceinline__ void bf8_to_f(uint4 u, float4& lo, float4& hi) {
  lo = make_float4(bflo(u.x), bfhi(u.x), bflo(u.y), bfhi(u.y));
  hi = make_float4(bflo(u.z), bfhi(u.z), bflo(u.w), bfhi(u.w));
}
__device__ void rwkv_scan_item(const P& p, int seq, int h, int qr, char* smem) {
  const int T = seq < 8 ? 2048 : 8, nbase = seq < 8 ? seq * 2048 : NP + (seq - 8) * 8;
  float* Ld = (float*)smem;
  float* Lr = Ld + TC * 64; float* Lk = Lr + TC * 64; float* Lkk = Lk + TC * 64; float* Lb = Lkk + TC * 64;
  float* Lv = Lb + TC * 64;
  const int tid = TIDX, w = tid >> 6, lane = tid & 63, rl = w * 4 + (lane >> 4), ks = lane & 15;
  const int v = qr * 16 + rl;
  float S0 = 0.f, S1 = 0.f, S2 = 0.f, S3 = 0.f;
  if (seq >= 8) {
    float4 s = *(const float4*)(p.state_wkv + (((size_t)(seq - 8) * 8 + h) * 64 + v) * 64 + ks * 4);
    S0 = s.x; S1 = s.y; S2 = s.z; S3 = s.w;
  }
  const int st = tid >> 3, sk8 = (tid & 7) * 8;
  const int vt = tid >> 1, vr8 = (tid & 1) * 8;
  uint4 g0, g1, g2, g3, g4, gv;
  g0 = g1 = g2 = g3 = g4 = gv = make_uint4(0, 0, 0, 0);
#define RW_GLOAD(c0_)                                                                           \
  {                                                                                             \
    const int tcn = min(TC, T - (c0_));                                                         \
    if (st < tcn) {                                                                             \
      const u16* base = p.prep + (size_t)(nbase + (c0_) + st) * 3584 + h * 64 + sk8;            \
      g0 = *(const uint4*)(base); g1 = *(const uint4*)(base + 512); g2 = *(const uint4*)(base + 1024); \
      g3 = *(const uint4*)(base + 1536); g4 = *(const uint4*)(base + 2048);                     \
    }                                                                                           \
    if (tid < 64 && vt < tcn)                                                                   \
      gv = *(const uint4*)(p.prep + (size_t)(nbase + (c0_) + vt) * 3584 + 2560 + h * 64 + qr * 16 + vr8); \
  }
  RW_GLOAD(0);
  for (int c0 = 0; c0 < T; c0 += TC) {
    const int tc = min(TC, T - c0);
    __syncthreads();
    {
      float4 lo, hi;
      bf8_to_f(g0, lo, hi);
      lo.x = __expf(lo.x); lo.y = __expf(lo.y); lo.z = __expf(lo.z); lo.w = __expf(lo.w);
      hi.x = __expf(hi.x); hi.y = __expf(hi.y); hi.z = __expf(hi.z); hi.w = __expf(hi.w);
      *(float4*)(Ld + st * 64 + sk8) = lo; *(float4*)(Ld + st * 64 + sk8 + 4) = hi;
      bf8_to_f(g1, lo, hi); *(float4*)(Lr + st * 64 + sk8) = lo; *(float4*)(Lr + st * 64 + sk8 + 4) = hi;
      bf8_to_f(g2, lo, hi); *(float4*)(Lk + st * 64 + sk8) = lo; *(float4*)(Lk + st * 64 + sk8 + 4) = hi;
      bf8_to_f(g3, lo, hi); *(float4*)(Lkk + st * 64 + sk8) = lo; *(float4*)(Lkk + st * 64 + sk8 + 4) = hi;
      bf8_to_f(g4, lo, hi); *(float4*)(Lb + st * 64 + sk8) = lo; *(float4*)(Lb + st * 64 + sk8 + 4) = hi;
      if (tid < 64) { bf8_to_f(gv, lo, hi); *(float4*)(Lv + vt * 16 + vr8) = lo; *(float4*)(Lv + vt * 16 + vr8 + 4) = hi; }
    }
    __syncthreads();
    if (c0 + TC < T) RW_GLOAD(c0 + TC);
    float4 kk4 = *(const float4*)(Lkk + ks * 4), d4 = *(const float4*)(Ld + ks * 4), b4 = *(const float4*)(Lb + ks * 4),
           k4 = *(const float4*)(Lk + ks * 4), r4 = *(const float4*)(Lr + ks * 4);
    float vv = Lv[rl];
    u16* yo = p.proj + (size_t)(nbase + c0) * PCOLS + h * 64 + v;
    for (int tt = 0; tt < tc; tt++) {
      const int tn = min(tt + 1, tc - 1);
      const float4 nkk4 = *(const float4*)(Lkk + tn * 64 + ks * 4), nd4 = *(const float4*)(Ld + tn * 64 + ks * 4),
                   nb4 = *(const float4*)(Lb + tn * 64 + ks * 4), nk4 = *(const float4*)(Lk + tn * 64 + ks * 4),
                   nr4 = *(const float4*)(Lr + tn * 64 + ks * 4);
      const float nvv = Lv[tn * 16 + rl];
      float sk = (S0 * kk4.x + S1 * kk4.y) + (S2 * kk4.z + S3 * kk4.w);
      sk = allreduce16(sk);
      S0 = S0 * d4.x + (vv * k4.x - sk * b4.x);
      S1 = S1 * d4.y + (vv * k4.y - sk * b4.y);
      S2 = S2 * d4.z + (vv * k4.z - sk * b4.z);
      S3 = S3 * d4.w + (vv * k4.w - sk * b4.w);
      float y = (S0 * r4.x + S1 * r4.y) + (S2 * r4.z + S3 * r4.w);
      y = allreduce16(y);
      if (ks == 0) yo[(size_t)tt * PCOLS] = f2bf(y);
      kk4 = nkk4; d4 = nd4; b4 = nb4; k4 = nk4; r4 = nr4; vv = nvv;
    }
  }
  float* so = seq_out(p.out, seq, O_PWKV, O_SWKV, 8 * 4096);
  *(float4*)(so + ((size_t)h * 64 + v) * 64 + ks * 4) = make_float4(S0, S1, S2, S3);
}

__device__ void ssm_scan_item(const P& p, int seq, int head, int half, char* smem) {
  const int T = seq < 8 ? 2048 : 8, nbase = seq < 8 ? seq * 2048 : NP + (seq - 8) * 8;
  float* LB = (float*)smem;
  float* LC = LB + TC * 128;
  float* Lx = LC + TC * 128;
  float* Ldt = Lx + TC * 32;
  float* Ldec = Ldt + TC;
  const int tid = TIDX, pl = tid >> 3, ns = tid & 7;
  const int pp = half * 32 + pl, g = head >> 3;
  const float Dk = p.D_skip[head];
  float hs[16];
#pragma unroll
  for (int j = 0; j < 16; j++) hs[j] = 0.f;
  if (seq >= 8) {
    const float4* s4 = (const float4*)(p.state_ssm + (((size_t)(seq - 8) * 16 + head) * 64 + pp) * 128 + ns * 16);
#pragma unroll
    for (int j = 0; j < 4; j++) { float4 s = s4[j]; hs[4 * j] = s.x; hs[4 * j + 1] = s.y; hs[4 * j + 2] = s.z; hs[4 * j + 3] = s.w; }
  }
  uint4 gb0, gb1, gb2, gb3, gx; float gdt = 0.f, gdec = 0.f;
  gb0 = gb1 = gb2 = gb3 = gx = make_uint4(0, 0, 0, 0);
  const int bt = tid >> 5, bch = tid & 31;
  const u16* bsrc = p.xc + 1024 + (bch < 16 ? 0 : 256) + g * 128 + (bch & 15) * 8;
  const int xt = tid >> 2, xr8 = (tid & 3) * 8;
#define SS_GLOAD(c0_)                                                                          \
  {                                                                                            \
    const int tcn = min(TC, T - (c0_));                                                        \
    const size_t nb_ = (size_t)(nbase + (c0_));                                                \
    if (bt < tcn) gb0 = *(const uint4*)(bsrc + (nb_ + bt) * 1536);                             \
    if (bt + 8 < tcn) gb1 = *(const uint4*)(bsrc + (nb_ + bt + 8) * 1536);                     \
    if (bt + 16 < tcn) gb2 = *(const uint4*)(bsrc + (nb_ + bt + 16) * 1536);                   \
    if (bt + 24 < tcn) gb3 = *(const uint4*)(bsrc + (nb_ + bt + 24) * 1536);                   \
    if (tid < 128 && xt < tcn) gx = *(const uint4*)(p.xc + (nb_ + xt) * 1536 + head * 64 + half * 32 + xr8); \
    if (tid < tcn) { gdt = p.dtb[(nb_ + tid) * 16 + head]; gdec = p.decb[(nb_ + tid) * 16 + head]; } \
  }
  SS_GLOAD(0);
  for (int c0 = 0; c0 < T; c0 += TC) {
    const int tc = min(TC, T - c0);
    __syncthreads();
    {
      float* dstb = (bch < 16 ? LB : LC) + (bch & 15) * 8;
      float4 lo, hi;
      bf8_to_f(gb0, lo, hi); *(float4*)(dstb + bt * 128) = lo; *(float4*)(dstb + bt * 128 + 4) = hi;
      bf8_to_f(gb1, lo, hi); *(float4*)(dstb + (bt + 8) * 128) = lo; *(float4*)(dstb + (bt + 8) * 128 + 4) = hi;
      bf8_to_f(gb2, lo, hi); *(float4*)(dstb + (bt + 16) * 128) = lo; *(float4*)(dstb + (bt + 16) * 128 + 4) = hi;
      bf8_to_f(gb3, lo, hi); *(float4*)(dstb + (bt + 24) * 128) = lo; *(float4*)(dstb + (bt + 24) * 128 + 4) = hi;
      if (tid < 128) { bf8_to_f(gx, lo, hi); *(float4*)(Lx + xt * 32 + xr8) = lo; *(float4*)(Lx + xt * 32 + xr8 + 4) = hi; }
      if (tid < TC) { Ldt[tid] = gdt; Ldec[tid] = gdec; }
    }
    __syncthreads();
    if (c0 + TC < T) SS_GLOAD(c0 + TC);
    u16* yo = p.proj + (size_t)(nbase + c0) * PCOLS + C_XBC + head * 64 + pp;
    float4 B0 = *(const float4*)(LB + ns * 16), B1 = *(const float4*)(LB + ns * 16 + 4), B2 = *(const float4*)(LB + ns * 16 + 8),
           B3 = *(const float4*)(LB + ns * 16 + 12);
    float4 C0 = *(const float4*)(LC + ns * 16), C1 = *(const float4*)(LC + ns * 16 + 4), C2 = *(const float4*)(LC + ns * 16 + 8),
           C3 = *(const float4*)(LC + ns * 16 + 12);
    float xv = Lx[pl], dtv = Ldt[0], dec = Ldec[0];
    for (int tt = 0; tt < tc; tt++) {
      const int tn = min(tt + 1, tc - 1);
      const float* nB = LB + tn * 128 + ns * 16;
      const float* nC = LC + tn * 128 + ns * 16;
      const float4 nB0 = *(const float4*)(nB), nB1 = *(const float4*)(nB + 4), nB2 = *(const float4*)(nB + 8), nB3 = *(const float4*)(nB + 12);
      const float4 nC0 = *(const float4*)(nC), nC1 = *(const float4*)(nC + 4), nC2 = *(const float4*)(nC + 8), nC3 = *(const float4*)(nC + 12);
      const float nxv = Lx[tn * 32 + pl], ndt = Ldt[tn], ndec = Ldec[tn];
      const float dtx = dtv * xv;
      hs[0] = hs[0] * dec + dtx * B0.x; hs[1] = hs[1] * dec + dtx * B0.y; hs[2] = hs[2] * dec + dtx * B0.z; hs[3] = hs[3] * dec + dtx * B0.w;
      hs[4] = hs[4] * dec + dtx * B1.x; hs[5] = hs[5] * dec + dtx * B1.y; hs[6] = hs[6] * dec + dtx * B1.z; hs[7] = hs[7] * dec + dtx * B1.w;
      hs[8] = hs[8] * dec + dtx * B2.x; hs[9] = hs[9] * dec + dtx * B2.y; hs[10] = hs[10] * dec + dtx * B2.z; hs[11] = hs[11] * dec + dtx * B2.w;
      hs[12] = hs[12] * dec + dtx * B3.x; hs[13] = hs[13] * dec + dtx * B3.y; hs[14] = hs[14] * dec + dtx * B3.z; hs[15] = hs[15] * dec + dtx * B3.w;
      float y0 = hs[0] * C0.x + hs[1] * C0.y + hs[2] * C0.z + hs[3] * C0.w;
      float y1 = hs[4] * C1.x + hs[5] * C1.y + hs[6] * C1.z + hs[7] * C1.w;
      float y2 = hs[8] * C2.x + hs[9] * C2.y + hs[10] * C2.z + hs[11] * C2.w;
      float y3 = hs[12] * C3.x + hs[13] * C3.y + hs[14] * C3.z + hs[15] * C3.w;
      float yp = allreduce8((y0 + y1) + (y2 + y3));
      if (ns == 0) yo[(size_t)tt * PCOLS] = f2bf(yp + Dk * xv);
      B0 = nB0; B1 = nB1; B2 = nB2; B3 = nB3; C0 = nC0; C1 = nC1; C2 = nC2; C3 = nC3; xv = nxv; dtv = ndt; dec = ndec;
    }
  }
  float* so = seq_out(p.out, seq, O_PSSM, O_SSSM, 16 * 8192);
  float4* o4 = (float4*)(so + ((size_t)head * 64 + pp) * 128 + ns * 16);
#pragma unroll
  for (int j = 0; j < 4; j++) o4[j] = make_float4(hs[4 * j], hs[4 * j + 1], hs[4 * j + 2], hs[4 * j + 3]);
}

constexpr int P4_RP = 256, P4_SP = 256, P4_RS = 4096, P4_SS = 4096;
__device__ void phase4(const P& p, int bid, int nb, char* smem) {
  for (int it = bid; it < P4_RP + P4_SP + P4_RS + P4_SS; it += nb) {
    int i = it;
    if (i < P4_RP) { rwkv_scan_item(p, i >> 5, (i >> 2) & 7, i & 3, smem); continue; }
    i -= P4_RP;
    if (i < P4_SP) { ssm_scan_item(p, i >> 5, (i >> 1) & 15, i & 1, smem); continue; }
    i -= P4_SP;
    if (i < P4_RS) { rwkv_scan_item(p, 8 + (i >> 5), (i >> 2) & 7, i & 3, smem); continue; }
    i -= P4_RS;
    ssm_scan_item(p, 8 + (i >> 5), (i >> 1) & 15, i & 1, smem);
  }
}

__device__ void phase5(const P& p, int bid, int nb) {
  const int lane = TIDX & 63, wid = TIDX >> 6;
  for (int it = bid; it < NT / 4; it += nb) {
    const int n = it * 4 + wid;
    {
      const int c = lane * 8;
      uint4 yu = *(const uint4*)(p.proj + (size_t)n * PCOLS + c);
      const u16* pr = p.prep + (size_t)n * 3584 + c;
      uint4 ru = *(const uint4*)(pr + 512), ku = *(const uint4*)(pr + 1024), vu = *(const uint4*)(pr + 2560),
            gu = *(const uint4*)(pr + 3072);
      unsigned ys[4] = {yu.x, yu.y, yu.z, yu.w}, rs[4] = {ru.x, ru.y, ru.z, ru.w}, ks_[4] = {ku.x, ku.y, ku.z, ku.w},
               vs[4] = {vu.x, vu.y, vu.z, vu.w}, gs[4] = {gu.x, gu.y, gu.z, gu.w};
      float y[8], r[8], k[8], v[8], g[8];
#pragma unroll
      for (int e = 0; e < 4; e++) {
        y[2 * e] = bflo(ys[e]); y[2 * e + 1] = bfhi(ys[e]);
        r[2 * e] = bflo(rs[e]); r[2 * e + 1] = bfhi(rs[e]);
        k[2 * e] = bflo(ks_[e]); k[2 * e + 1] = bfhi(ks_[e]);
        v[2 * e] = bflo(vs[e]); v[2 * e + 1] = bfhi(vs[e]);
        g[2 * e] = bflo(gs[e]); g[2 * e + 1] = bfhi(gs[e]);
      }
      float s = 0.f, bn = 0.f;
#pragma unroll
      for (int e = 0; e < 8; e++) { s += y[e]; bn += r[e] * k[e] * p.rw_r_k[c + e]; }
      s = allreduce8(s); bn = allreduce8(bn);
      const float mean = s * (1.f / 64.f);
      float vr = 0.f;
#pragma unroll
      for (int e = 0; e < 8; e++) { const float d = y[e] - mean; vr += d * d; }
      vr = allreduce8(vr) * (1.f / 64.f);
      const float rs_ = rsqrtf(vr + 64e-5f);
      float o[8];
#pragma unroll
      for (int e = 0; e < 8; e++) {
        const float yn = (y[e] - mean) * rs_ * p.rw_ln_w[c + e] + p.rw_ln_b[c + e];
        o[e] = (yn + bn * v[e]) * g[e];
      }
      uint4 ou; ou.x = pack2(o[0], o[1]); ou.y = pack2(o[2], o[3]); ou.z = pack2(o[4], o[5]); ou.w = pack2(o[6], o[7]);
      *(uint4*)(p.oa + (size_t)n * 512 + c) = ou;
    }
    {
      const int c = lane * 16;
      float yv[16];
      float ss = 0.f;
#pragma unroll
      for (int hh = 0; hh < 2; hh++) {
        uint4 yu = *(const uint4*)(p.proj + (size_t)n * PCOLS + C_XBC + c + hh * 8);
        uint4 zu = *(const uint4*)(p.proj + (size_t)n * PCOLS + C_Z + c + hh * 8);
        unsigned ys[4] = {yu.x, yu.y, yu.z, yu.w}, zs[4] = {zu.x, zu.y, zu.z, zu.w};
#pragma unroll
        for (int e = 0; e < 4; e++) {
          const float a = bflo(ys[e]) * siluf_(bflo(zs[e])), b = bfhi(ys[e]) * siluf_(bfhi(zs[e]));
          yv[hh * 8 + 2 * e] = a; yv[hh * 8 + 2 * e + 1] = b;
          ss += a * a + b * b;
        }
      }
#pragma unroll
      for (int o = 16; o >= 1; o >>= 1) ss += __shfl_xor(ss, o, 64);
      const float rstd = rsqrtf(ss * (1.f / 512.f) + 1e-6f);
      unsigned ou[8];
#pragma unroll
      for (int e = 0; e < 8; e++)
        ou[e] = pack2(yv[2 * e] * rstd * p.ssm_norm_w[c + 2 * e], yv[2 * e + 1] * rstd * p.ssm_norm_w[c + 2 * e + 1]);
      *(uint4*)(p.ob + (size_t)n * 1024 + c) = make_uint4(ou[0], ou[1], ou[2], ou[3]);
      *(uint4*)(p.ob + (size_t)n * 1024 + c + 8) = make_uint4(ou[4], ou[5], ou[6], ou[7]);
    }
  }
}

__device__ void phase6(const P& p, int bid, int nb, char* smem) {
  TileIter ti(bid, nb, 136, 8);
  int mt, nt;
  while (ti.next(mt, nt)) {
    f32x4 ac[4][4];
    u16* Lm = (u16*)(smem + 2 * 128 * LROW);
    zero_acc(ac);
    gemm_tile(p.xn, D, mt * 128, p.w_inT + (size_t)G_A * D, D, nt * 128, D, ac, smem);
    ACC_FOREACH({ Lm[row * 136 + col] = f2bf(sigmoidf_(ac[m][n][j])); })
    zero_acc(ac);
    gemm_tile(p.oa, 512, mt * 128, p.w_paT, 512, nt * 128, 512, ac, smem);
    ACC_FOREACH({ Lm[row * 136 + col] = f2bf(bf2f(Lm[row * 136 + col]) * ac[m][n][j]); })
    zero_acc(ac);
    gemm_tile(p.xn, D, mt * 128, p.w_inT + (size_t)G_B * D, D, nt * 128, D, ac, smem);
    ACC_FOREACH({ p.merged[(size_t)(mt * 128 + row) * D + nt * 128 + col] = f2bf(sigmoidf_(ac[m][n][j])); })
    zero_acc(ac);
    gemm_tile(p.ob, D, mt * 128, p.w_pbT, D, nt * 128, D, ac, smem);
    ACC_FOREACH({
      u16* mp = p.merged + (size_t)(mt * 128 + row) * D + nt * 128 + col;
      *mp = f2bf(bf2f(Lm[row * 136 + col]) + bf2f(*mp) * ac[m][n][j]);
    })
  }
}

constexpr int P7_G = 136 * 8, P7_CV = 16384;
constexpr float U_SCALE = 256.f, V_SCALE = 32.f;
__device__ void phase7(const P& p, int bid, int nb, char* smem) {
  {
    TileIter ti(bid, nb, 136, 8);
    int mt, nt;
    while (ti.next(mt, nt)) {
      f32x4 acc[4][4];
      zero_acc(acc);
      gemm_tile(p.merged, D, mt * 128, p.w_outT, D, nt * 128, D, acc, smem);
      ACC_FOREACH({
        const int nn = mt * 128 + row, c = nt * 128 + col;
        int seq, t, T; tok2seq(nn, seq, t, T);
        const float gt = p.mod[(size_t)seq * 8192 + 2048 + c];
        p.out[O_Y + (size_t)nn * D + c] = xrow(p, nn)[c] + gt * acc[m][n][j];
      })
    }
  }
  for (int it = bid; it < P7_CV; it += nb) {
    int i = it;
    const float* src; unsigned char* dst; float sc;
    if (i < 8192) { src = p.peer_u + (size_t)i * 2048; dst = (unsigned char*)p.ub + (size_t)i * 2048; sc = U_SCALE; }
    else { i -= 8192; src = p.peer_v + (size_t)i * 2048; dst = (unsigned char*)p.vb + (size_t)i * 2048; sc = V_SCALE; }
    const int tid = TIDX;
    const float4* s4 = (const float4*)src + tid * 2;
    const float4 a = s4[0], b = s4[1];
    int lo = __builtin_amdgcn_cvt_pk_fp8_f32(a.x * sc, a.y * sc, 0, false);
    lo = __builtin_amdgcn_cvt_pk_fp8_f32(a.z * sc, a.w * sc, lo, true);
    int hi = __builtin_amdgcn_cvt_pk_fp8_f32(b.x * sc, b.y * sc, 0, false);
    hi = __builtin_amdgcn_cvt_pk_fp8_f32(b.z * sc, b.w * sc, hi, true);
    *((uint2*)dst + tid) = make_uint2((unsigned)lo, (unsigned)hi);
  }
}

__device__ void phase9(const P& p, int bid, int nb, char* smem) {
  const int tid = TIDX, lane = tid & 63, wid = tid >> 6, wr = wid >> 1, wc = wid & 1, fr = lane & 15,
            fq = lane >> 4;
  TileIter ti(bid, nb, 136, 16);
  int mt, nt;
  while (ti.next(mt, nt)) {
    f32x4 acc[4][4];
    zero_acc(acc);
    gemm_tile<false>(p.xn, D, mt * 128, p.wqT, D, nt * 128, D, acc, smem);
    u16* Lq = (u16*)smem;
    ACC_FOREACH({ Lq[row * 136 + col] = f2bf(acc[m][n][j]); })
    __syncthreads();
    f32x4 sc[4][4];
    zero_acc(sc);
    const u16* kb = p.keysb + (size_t)nt * 128 * 128;
#pragma unroll 1
    for (int s = 0; s < 4; s++) {
      bf16x8 af[4], bfr[4];
#pragma unroll
      for (int m = 0; m < 4; m++) af[m] = *(const bf16x8*)((const char*)Lq + (wr * 64 + m * 16 + fr) * 272 + s * 64 + fq * 16);
#pragma unroll
      for (int n = 0; n < 4; n++) bfr[n] = *(const bf16x8*)(kb + (size_t)(wc * 64 + n * 16 + fr) * 128 + s * 32 + fq * 8);
#pragma unroll
      for (int m = 0; m < 4; m++)
#pragma unroll
        for (int n = 0; n < 4; n++) sc[m][n] = __builtin_amdgcn_mfma_f32_16x16x32_bf16(af[m], bfr[n], sc[m][n], 0, 0, 0);
    }
    __syncthreads();
    float* Ls = (float*)smem;
#pragma unroll
    for (int m = 0; m < 4; m++)
#pragma unroll
      for (int n = 0; n < 4; n++)
#pragma unroll
        for (int j = 0; j < 4; j++) Ls[(wr * 64 + m * 16 + fq * 4 + j) * 129 + wc * 64 + n * 16 + fr] = sc[m][n][j];
    __syncthreads();
    {
      const int row = tid >> 1, half = tid & 1;
      float* Lr = Ls + row * 129;
      const size_t ob = ((size_t)(mt * 128 + row) * 16 + nt) * 16;
      for (int r = 0; r < 16; r++) {
        float best = -INFINITY; int bi = 0;
        for (int i = 0; i < 64; i++) {
          const float v = Lr[half + 2 * i];
          if (v > best) { best = v; bi = half + 2 * i; }
        }
        const float ov = __shfl_xor(best, 1, 64);
        const int oi = __shfl_xor(bi, 1, 64);
        if (ov > best || (ov == best && oi < bi)) { best = ov; bi = oi; }
        if ((bi & 1) == half) Lr[bi] = -INFINITY;
        if (half == 0) { p.topv[ob + r] = best; p.topi[ob + r] = bi; }
      }
    }
    __syncthreads();
  }
}

__device__ __forceinline__ void cand_ij(int lane, int& ci, int& cj) {
  int i = 0, rem = lane;
#pragma unroll
  for (int r = 0; r < 16; r++) {
    const int cnt = 16 / (r + 1);
    if (i == r && rem >= cnt) { rem -= cnt; i = r + 1; }
  }
  ci = i; cj = rem;
}

typedef __attribute__((ext_vector_type(2))) __bf16 bf2_t;
__device__ __forceinline__ float dot2bf(unsigned a, unsigned b, float c) {
  return __builtin_amdgcn_fdot2_f32_bf16(__builtin_bit_cast(bf2_t, a), __builtin_bit_cast(bf2_t, b), c, false);
}
template <int CTRL, int RM>
__device__ __forceinline__ float dppf_m(float x) {
  return __int_as_float(__builtin_amdgcn_update_dpp(0, __float_as_int(x), CTRL, RM, 0xf, false));
}
__device__ __forceinline__ float wave_sum_l63(float x) {
  x += dppf<0xB1>(x);
  x += dppf<0x4E>(x);
  x += dppf<0x141>(x);
  x += dppf<0x140>(x);
  x += dppf_m<0x142, 0xA>(x);
  x += dppf_m<0x143, 0xC>(x);
  return x;
}
__device__ __forceinline__ float readlane_f(float x, int l) {
  return __int_as_float(__builtin_amdgcn_readlane(__float_as_int(x), l));
}
__device__ __forceinline__ void axpy8(float* acc, float w, uint4 v) {
  acc[0] += w * bflo(v.x); acc[1] += w * bfhi(v.x); acc[2] += w * bflo(v.y); acc[3] += w * bfhi(v.y);
  acc[4] += w * bflo(v.z); acc[5] += w * bfhi(v.z); acc[6] += w * bflo(v.w); acc[7] += w * bfhi(v.w);
}

typedef float f2_t __attribute__((ext_vector_type(2)));
__device__ __forceinline__ void fp8x16_to_f32(const uint4 v, float* o) {
  const unsigned w[4] = {v.x, v.y, v.z, v.w};
#pragma unroll
  for (int i = 0; i < 4; i++) {
    const f2_t lo = __builtin_amdgcn_cvt_pk_f32_fp8((int)w[i], false);
    const f2_t hi = __builtin_amdgcn_cvt_pk_f32_fp8((int)w[i], true);
    o[4 * i] = lo.x; o[4 * i + 1] = lo.y; o[4 * i + 2] = hi.x; o[4 * i + 3] = hi.y;
  }
}

__device__ void phase10(const P& p, int bid, int nb) {
  const int lane = TIDX & 63, wid = TIDX >> 6;
  int ci, cj; cand_ij(lane < 50 ? lane : 0, ci, cj);
  const unsigned char* ub8 = (const unsigned char*)p.ub;
  const unsigned char* vb8 = (const unsigned char*)p.vb;
  for (int it = bid; it < NT / 4; it += nb) {
    const int n = it * 4 + wid;
    int seq, t, T; tok2seq(n, seq, t, T);
    float xv[16];
    {
      const uint4 a = *(const uint4*)(p.xn + (size_t)n * D + lane * 16), b = *(const uint4*)(p.xn + (size_t)n * D + lane * 16 + 8);
      const unsigned as[4] = {a.x, a.y, a.z, a.w}, bs[4] = {b.x, b.y, b.z, b.w};
#pragma unroll
      for (int e = 0; e < 4; e++) { xv[2 * e] = bflo(as[e]); xv[2 * e + 1] = bfhi(as[e]); xv[8 + 2 * e] = bflo(bs[e]); xv[8 + 2 * e + 1] = bfhi(bs[e]); }
    }
    float acc[16];
#pragma unroll
    for (int e = 0; e < 16; e++) acc[e] = 0.f;
#pragma unroll 1
    for (int h = 0; h < 8; h++) {
      const size_t base = ((size_t)n * 16 + h * 2) * 16;
      float cand = -INFINITY; int eid = 0;
      if (lane < 50) {
        cand = p.topv[base + ci] + p.topv[base + 16 + cj];
        eid = p.topi[base + ci] * 128 + p.topi[base + 16 + cj];
      }
      int rank = 0;
#pragma unroll
      for (int m = 0; m < 50; m++) {
        const float cm = readlane_f(cand, m);
        rank += ((cm > cand) || (cm == cand && m < lane)) ? 1 : 0;
      }
      const bool sel = (lane < 50) && (rank < 16);
      unsigned long long mask = __ballot(sel);
      const float mx = readlane_f(cand, __builtin_ctzll(__ballot(sel && rank == 0)));
      const float ex = sel ? __expf(cand - mx) : 0.f;
      const float den = readlane_f(wave_sum_l63(ex), 63);
      const float gate = ex / den;
#pragma unroll 1
      for (int hf = 0; hf < 2; hf++) {
        int ek[8]; float gk[8];
#pragma unroll
        for (int k = 0; k < 8; k++) {
          const int src = __builtin_ctzll(mask);
          mask &= mask - 1;
          ek[k] = __builtin_amdgcn_readlane(eid, src);
          gk[k] = readlane_f(gate, src);
        }
        uint4 uu[8], vv[8];
#pragma unroll
        for (int j = 0; j < 8; j++) uu[j] = *(const uint4*)(ub8 + (size_t)ek[j] * D + lane * 16);
#pragma unroll
        for (int j = 0; j < 8; j++) vv[j] = *(const uint4*)(vb8 + (size_t)ek[j] * D + lane * 16);
        float dv = 0.f;
#pragma unroll
        for (int j = 0; j < 8; j++) {
          float uf[16];
          fp8x16_to_f32(uu[j], uf);
          float d0 = 0.f, d1 = 0.f;
#pragma unroll
          for (int e = 0; e < 8; e++) { d0 += uf[2 * e] * xv[2 * e]; d1 += uf[2 * e + 1] * xv[2 * e + 1]; }
          const float ds = readlane_f(wave_sum_l63(d0 + d1), 63);
          dv = (lane == j) ? ds : dv;
        }
        dv *= (1.f / U_SCALE);
        const float act = 0.5f * dv * (1.f + erff(dv * 0.70710678118654752f));
#pragma unroll
        for (int j = 0; j < 8; j++) {
          const float w = readlane_f(act, j) * gk[j] * (1.f / V_SCALE);
          float vf[16];
          fp8x16_to_f32(vv[j], vf);
#pragma unroll
          for (int e = 0; e < 16; e++) acc[e] += w * vf[e];
        }
      }
    }
    float* yr = p.out + O_Y + (size_t)n * D + lane * 16;
    const float* md = p.mod + (size_t)seq * 8192 + lane * 16;
    float x2[16];
    float ss = 0.f;
#pragma unroll
    for (int q4 = 0; q4 < 4; q4++) {
      const float4 a = *(const float4*)(yr + q4 * 4), g = *(const float4*)(md + 5120 + q4 * 4);
      x2[q4 * 4 + 0] = a.x + g.x * acc[q4 * 4 + 0]; x2[q4 * 4 + 1] = a.y + g.y * acc[q4 * 4 + 1];
      x2[q4 * 4 + 2] = a.z + g.z * acc[q4 * 4 + 2]; x2[q4 * 4 + 3] = a.w + g.w * acc[q4 * 4 + 3];
    }
#pragma unroll
    for (int e = 0; e < 16; e++) ss += x2[e] * x2[e];
    ss = readlane_f(wave_sum_l63(ss), 63);
    const float rstd = rsqrtf(ss * (1.f / 1024.f) + 1e-6f);
#pragma unroll
    for (int q4 = 0; q4 < 4; q4++) {
      const float4 fg = *(const float4*)(p.final_g + lane * 16 + q4 * 4), sc = *(const float4*)(md + 7168 + q4 * 4),
                   sh = *(const float4*)(md + 6144 + q4 * 4);
      float4 o;
      o.x = x2[q4 * 4 + 0] * rstd * fg.x * (1.f + sc.x) + sh.x;
      o.y = x2[q4 * 4 + 1] * rstd * fg.y * (1.f + sc.y) + sh.y;
      o.z = x2[q4 * 4 + 2] * rstd * fg.z * (1.f + sc.z) + sh.z;
      o.w = x2[q4 * 4 + 3] * rstd * fg.w * (1.f + sc.w) + sh.w;
      *(float4*)(yr + q4 * 4) = o;
    }
  }
}

#define XB_XCNT(j) (256 + 64 * (j))
#define XB_XSUB(j) (1280 + 64 * (j))
#define XB_XGEN(j) (2304 + 64 * (j))
#define XB_TOP 3328
#define XB_TOPGEN 3392
#define XB_WORDS 4096
__device__ __forceinline__ unsigned xb_ld(unsigned* p) { return __hip_atomic_load(p, __ATOMIC_RELAXED, __HIP_MEMORY_SCOPE_AGENT); }
__device__ __forceinline__ unsigned xb_add(unsigned* p, unsigned v) { return __hip_atomic_fetch_add(p, v, __ATOMIC_RELAXED, __HIP_MEMORY_SCOPE_AGENT); }
__device__ __forceinline__ unsigned xb_xcc_id() { return (unsigned)__builtin_amdgcn_s_getreg((3 << 11) | 20) & 0xFu; }
__device__ __forceinline__ void grid_barrier(unsigned* bar, volatile unsigned* xst) {
  asm volatile("s_waitcnt vmcnt(0)" ::: "memory");
  __syncthreads();
  if (TIDX == 0) {
    __builtin_amdgcn_s_waitcnt(0);
    const unsigned x = xst[0], nloc = xst[1], nx = xst[2];
    const unsigned old = xb_add(&bar[XB_XSUB(x)], 1u);
    const unsigned gen = old / nloc;
    if (old + 1u == (gen + 1u) * nloc) {
      __builtin_amdgcn_fence(__ATOMIC_RELEASE, "agent");
      asm volatile("s_waitcnt vmcnt(0)" ::: "memory");
      const unsigned og = xb_add(&bar[XB_TOP], 1u);
      const unsigned tg = og / nx;
      if (og + 1u == (tg + 1u) * nx) xb_add(&bar[XB_TOPGEN], 1u);
      else while (xb_ld(&bar[XB_TOPGEN]) == tg) __builtin_amdgcn_s_sleep(1);
      __builtin_amdgcn_fence(__ATOMIC_ACQUIRE, "agent");
      xb_add(&bar[XB_XGEN(x)], 1u);
      asm volatile("s_waitcnt vmcnt(0)" ::: "memory");
    } else {
      while (xb_ld(&bar[XB_XGEN(x)]) == gen) __builtin_amdgcn_s_sleep(1);
      __builtin_amdgcn_fence(__ATOMIC_ACQUIRE, "agent");
      asm volatile("s_waitcnt vmcnt(0)" ::: "memory");
    }
  }
  __syncthreads();
}

template <int PH>
__device__ __forceinline__ void run_phase(const P& p, int bid, int nb, char* smem) {
  if constexpr (PH == 0) phase0(p, bid, nb, smem);
  if constexpr (PH == 1) phase_norm<false>(p, bid, nb);
  if constexpr (PH == 2) phase2(p, bid, nb, smem);
  if constexpr (PH == 3) phase3(p, bid, nb, smem);
  if constexpr (PH == 4) phase4(p, bid, nb, smem);
  if constexpr (PH == 5) phase5(p, bid, nb);
  if constexpr (PH == 6) phase6(p, bid, nb, smem);
  if constexpr (PH == 7) phase7(p, bid, nb, smem);
  if constexpr (PH == 8) phase_norm<true>(p, bid, nb);
  if constexpr (PH == 9) phase9(p, bid, nb, smem);
  if constexpr (PH == 10) phase10(p, bid, nb);
  if constexpr (PH == 11) phase3b(p, bid, nb, smem);
}

template <int PH>
__global__ void __launch_bounds__(NTHREADS, 2) k_phase(P p) {
  extern __shared__ __attribute__((aligned(16))) char smem[];
  run_phase<PH>(p, blockIdx.x, gridDim.x, smem);
}

#if MEGA
__global__ void __launch_bounds__(NTHREADS, 2) k_mega(P p) {
  extern __shared__ __attribute__((aligned(16))) char smem[];
  cg::grid_group grid = cg::this_grid();
  const int bid = blockIdx.x, nb = gridDim.x;
#ifndef PROBE_ALL2
#define PROBE_ALL2 0
#endif
#ifndef PROBE_MASK
#define PROBE_MASK 0
#endif
#ifndef PROBE_SYNCS
#define PROBE_SYNCS 0
#endif
  volatile unsigned* xst = (volatile unsigned*)(smem + LDS_BYTES - 16);
  if (TIDX == 0) { const unsigned xcc0 = xb_xcc_id(); xst[0] = xcc0; xb_add(&p.bar[XB_XCNT(xcc0)], 1u); }
#define GSYNC(k)                                                                                 \
  {                                                                                              \
    if ((k) == 0) {                                                                              \
      grid.sync();                                                                               \
      if (TIDX == 0) {                                                                    \
        unsigned cnt = 0;                                                                        \
        for (unsigned j = 0; j < 16; ++j) cnt += xb_ld(&p.bar[XB_XCNT(j)]) > 0u ? 1u : 0u;       \
        xst[2] = cnt; xst[1] = xb_ld(&p.bar[XB_XCNT(xst[0])]);                                   \
      }                                                                                          \
    } else grid_barrier(p.bar, xst);                                                             \
  }
#define RUNPH(k)                                                       \
  run_phase<k>(p, bid, nb, smem); GSYNC(k)                             \
  if (PROBE_MASK & (1 << k)) { run_phase<k>(p, bid, nb, smem); GSYNC(1) }
#pragma unroll 1
  for (int rep = 0; rep < 1 + PROBE_ALL2; rep++) {
    RUNPH(0)
#pragma unroll 1
    for (int i = 0; i < PROBE_SYNCS; i++) GSYNC(1)
    RUNPH(1) RUNPH(2) RUNPH(3) RUNPH(11) RUNPH(4) RUNPH(5) RUNPH(6) RUNPH(7) RUNPH(8) RUNPH(9)
  }
  run_phase<10>(p, bid, nb, smem);
}
#endif

template <int PH>
static void launch_phase(const P& p, int grid, hipStream_t stream) {
  static bool attr = false;
  if (!attr) { hipFuncSetAttribute((const void*)k_phase<PH>, hipFuncAttributeMaxDynamicSharedMemorySize, LDS_BYTES); attr = true; }
  hipLaunchKernelGGL(k_phase<PH>, dim3(grid), dim3(NTHREADS), LDS_BYTES, stream, p);
}

extern "C" void kernel_launch(void* const* d_in, const int* in_sizes, int n_in, void* d_out, int out_size, void* d_ws,
                              size_t ws_size, hipStream_t stream) {
  P p{};
  const float** fp = (const float**)&p;
  for (int i = 0; i < 40; i++) fp[i] = (const float*)d_in[i];
  p.out = (float*)d_out;
  char* ws = (char*)d_ws;
  size_t off = 0;
  auto take = [&](size_t bytes) { char* r = ws + off; off += (bytes + 255) & ~(size_t)255; return r; };
  p.bar = (unsigned*)take(XB_WORDS * 4);
  p.w_inT = (u16*)take((size_t)INCOLS * D * 2);
  p.w_paT = (u16*)take((size_t)1024 * 512 * 2);
  p.w_pbT = (u16*)take((size_t)1024 * 1024 * 2);
  p.w_outT = (u16*)take((size_t)1024 * 1024 * 2);
  p.wqT = (u16*)take((size_t)2048 * 1024 * 2);
  p.keysb = (u16*)take((size_t)262144 * 2);
  p.mod = (float*)take((size_t)NSEQ * 8192 * 4);
  p.dtb = (float*)take((size_t)NT * 16 * 4);
  p.decb = (float*)take((size_t)NT * 16 * 4);
  p.xn = (u16*)take((size_t)NROWS * D * 2);
  p.proj = (u16*)take((size_t)NROWS * PCOLS * 2);
  p.prep = (u16*)take((size_t)NT * 3584 * 2);
  p.w2T = (u16*)take(512 * 64 * 2);
  p.a2T = (u16*)take(512 * 64 * 2);
  p.g2T = (u16*)take(512 * 128 * 2);
  p.lora = (u16*)take((size_t)NT * 256 * 2);
  if (off > ws_size) { fprintf(stderr, "workspace too small: need %zu have %zu\n", off, ws_size); return; }
  p.merged = p.prep;
  p.ub = p.proj;
  p.vb = p.proj + (size_t)16384 * 1024;
  p.topv = (float*)(p.proj + (size_t)2 * 16384 * 1024);
  p.topi = (int*)(p.topv + (size_t)NT * 256);
  p.xc = (u16*)d_out;
  p.oa = (u16*)d_out;
  p.ob = (u16*)d_out + (size_t)NT * 512;

  static int grid = 0;
  if (!grid) {
    int dev = 0, cus = 0, per_cu = 0;
    hipGetDevice(&dev);
    hipDeviceGetAttribute(&cus, hipDeviceAttributeMultiprocessorCount, dev);
#if MEGA
    hipFuncSetAttribute((const void*)k_mega, hipFuncAttributeMaxDynamicSharedMemorySize, LDS_BYTES);
    hipOccupancyMaxActiveBlocksPerMultiprocessor(&per_cu, k_mega, NTHREADS, LDS_BYTES);
    if (per_cu > 2) per_cu = 2;
#else
    per_cu = 2;
#endif
    if (per_cu < 1) per_cu = 1;
    grid = cus * per_cu;
  }
#if MEGA
  hipMemsetAsync(p.bar, 0, XB_WORDS * 4, stream);
  void* args[] = {&p};
  hipError_t e = hipLaunchCooperativeKernel((void*)k_mega, dim3(grid), dim3(NTHREADS), args, LDS_BYTES, stream);
  if (e != hipSuccess) fprintf(stderr, "cooperative launch failed: %s (grid %d)\n", hipGetErrorString(e), grid);
#else
  launch_phase<0>(p, grid, stream);
  launch_phase<1>(p, grid, stream);
  launch_phase<2>(p, grid, stream);
  launch_phase<3>(p, grid, stream);
  launch_phase<11>(p, grid, stream);
  launch_phase<4>(p, grid, stream);
  launch_phase<5>(p, grid, stream);
  launch_phase<6>(p, grid, stream);
  launch_phase<7>(p, grid, stream);
  launch_phase<8>(p, grid, stream);
  launch_phase<9>(p, grid, stream);
  launch_phase<10>(p, grid, stream);
#endif
}
```

```cpp
#include <hip/hip_runtime.h>
#include <hip/hip_cooperative_groups.h>
#include <cstdio>
namespace cg = cooperative_groups;

#ifndef MEGA
#define MEGA 1
#endif

typedef unsigned short u16;
typedef __attribute__((ext_vector_type(8))) short bf16x8;
typedef __attribute__((ext_vector_type(4))) float f32x4;

__device__ __forceinline__ int opaque_tid() { int t = threadIdx.x; asm volatile("" : "+v"(t)); return t; }
#define TIDX opaque_tid()

constexpr int D = 1024;
constexpr int NP = 16384, NS = 1024, NT = NP + NS, NSEQ = 136;
constexpr int NROWS = NT + 128;
constexpr int PCOLS = 4368;
constexpr int INCOLS = 6416;
constexpr int C_LW = 1536, C_LA = 1600, C_LG = 1664, C_Z = 1792, C_XBC = 2816, C_DT = 4352;
constexpr int G_A = 4368, G_B = 5392;
constexpr size_t O_Y = 0, O_PSHIFT = 17825792, O_PWKV = 17833984, O_PCONV = 18096128, O_PSSM = 18132992,
                 O_SSHIFT = 19181568, O_SWKV = 19312640, O_SCONV = 23506944, O_SSSM = 24096768;
constexpr int LDS_BYTES = 80 * 1024;
constexpr int NTHREADS = 256;

struct P {
  const float *x_prompt, *x_sample, *c_prompt, *c_sample, *state_shift, *state_wkv, *state_conv, *state_ssm;
  const float *w_ada, *b_ada, *norm1_g, *w_in, *rw_mu, *rw_w0, *rw_w2, *rw_a0, *rw_a2, *rw_g2, *rw_k_k, *rw_k_a,
      *rw_r_k, *rw_ln_w, *rw_ln_b;
  const float *conv_w, *conv_b, *dt_bias, *A_log, *D_skip, *ssm_norm_w, *w_pa, *w_pb, *w_out, *norm2_g, *peer_wq,
      *peer_keys, *peer_u, *peer_v, *final_g, *w_ada_f, *b_ada_f;
  float* out;
  u16 *w_inT, *w_paT, *w_pbT, *w_outT, *wqT, *keysb, *xn, *proj, *prep, *merged, *ub, *vb, *xc, *oa, *ob;
  u16 *w2T, *a2T, *g2T, *lora;
  float *mod, *dtb, *decb, *topv;
  int* topi;
  unsigned* bar;
};

__device__ __forceinline__ u16 f2bf(float f) {
  unsigned u = __float_as_uint(f);
  u += 0x7fffu + ((u >> 16) & 1u);
  return (u16)(u >> 16);
}
__device__ __forceinline__ float bf2f(u16 h) { return __uint_as_float(((unsigned)h) << 16); }
__device__ __forceinline__ unsigned pack2(float a, float b) { return (unsigned)f2bf(a) | ((unsigned)f2bf(b) << 16); }
__device__ __forceinline__ float bflo(unsigned u) { return __uint_as_float(u << 16); }
__device__ __forceinline__ float bfhi(unsigned u) { return __uint_as_float(u & 0xffff0000u); }
__device__ __forceinline__ float sigmoidf_(float x) { return 1.f / (1.f + __expf(-x)); }
__device__ __forceinline__ float siluf_(float x) { return x / (1.f + __expf(-x)); }
__device__ __forceinline__ float softplusf_(float x) { return x > 20.f ? x : log1pf(expf(x)); }

template <int CTRL>
__device__ __forceinline__ float dppf(float x) {
  return __int_as_float(__builtin_amdgcn_update_dpp(0, __float_as_int(x), CTRL, 0xf, 0xf, true));
}
__device__ __forceinline__ float allreduce16(float x) {
  x += dppf<0x128>(x);
  x += dppf<0x124>(x);
  x += dppf<0x122>(x);
  x += dppf<0x121>(x);
  return x;
}
__device__ __forceinline__ float allreduce8(float x) {
  x += dppf<0xB1>(x);
  x += dppf<0x4E>(x);
  x += dppf<0x141>(x);
  return x;
}
__device__ __forceinline__ float wave_sum(float x) {
#pragma unroll
  for (int o = 32; o >= 1; o >>= 1) x += __shfl_xor(x, o, 64);
  return x;
}
__device__ __forceinline__ float wave_max(float x) {
#pragma unroll
  for (int o = 32; o >= 1; o >>= 1) x = fmaxf(x, __shfl_xor(x, o, 64));
  return x;
}
__device__ __forceinline__ int wave_min_i(int x) {
#pragma unroll
  for (int o = 32; o >= 1; o >>= 1) x = min(x, __shfl_xor(x, o, 64));
  return x;
}

__device__ __forceinline__ const float* xrow(const P& p, int n) {
  return n < NP ? p.x_prompt + (size_t)n * D : p.x_sample + (size_t)(n - NP) * D;
}
__device__ __forceinline__ void tok2seq(int n, int& seq, int& t, int& T) {
  if (n < NP) { seq = n >> 11; t = n & 2047; T = 2048; }
  else { int m = n - NP; seq = 8 + (m >> 3); t = m & 7; T = 8; }
}
__device__ __forceinline__ float* seq_out(float* out, int seq, size_t op, size_t os, size_t per) {
  return seq < 8 ? out + op + (size_t)seq * per : out + os + (size_t)(seq - 8) * per;
}

constexpr int LROW = 144;
template <bool DEEP = true>
__device__ __forceinline__ void gemm_tile(const u16* __restrict__ A, int lda, int m0, const u16* __restrict__ Bt,
                                          int ldb, int n0, int K, f32x4 (&acc)[4][4], char* smem) {
  char* sA = smem;
  char* sB = smem + 128 * LROW;
  const int tid = TIDX, lane = tid & 63, wid = tid >> 6, wr = wid >> 1, wc = wid & 1, fr = lane & 15,
            fq = lane >> 4;
  uint4 ra0, ra1, ra2, ra3, rb0, rb1, rb2, rb3;
  uint4 sa0, sa1, sa2, sa3, sb0, sb1, sb2, sb3;
  const int nk = K / 64;
  const int lrow = tid >> 3, lch = tid & 7;
  const u16* gA = A + (size_t)(m0 + lrow) * lda + lch * 8;
  const u16* gB = Bt + (size_t)(n0 + lrow) * ldb + lch * 8;
#define GLOAD(x0, x1, x2, x3, y0, y1, y2, y3, kt)                   \
  {                                                                 \
    x0 = *(const uint4*)(gA + (kt) * 64);                           \
    x1 = *(const uint4*)(gA + (size_t)32 * lda + (kt) * 64);        \
    x2 = *(const uint4*)(gA + (size_t)64 * lda + (kt) * 64);        \
    x3 = *(const uint4*)(gA + (size_t)96 * lda + (kt) * 64);        \
    y0 = *(const uint4*)(gB + (kt) * 64);                           \
    y1 = *(const uint4*)(gB + (size_t)32 * ldb + (kt) * 64);        \
    y2 = *(const uint4*)(gB + (size_t)64 * ldb + (kt) * 64);        \
    y3 = *(const uint4*)(gB + (size_t)96 * ldb + (kt) * 64);        \
  }
#define LSTORE(x0, x1, x2, x3, y0, y1, y2, y3)                      \
  {                                                                 \
    char* wa = sA + lrow * LROW + lch * 16;                         \
    char* wb = sB + lrow * LROW + lch * 16;                         \
    *(uint4*)(wa) = x0; *(uint4*)(wa + 32 * LROW) = x1; *(uint4*)(wa + 64 * LROW) = x2; *(uint4*)(wa + 96 * LROW) = x3; \
    *(uint4*)(wb) = y0; *(uint4*)(wb + 32 * LROW) = y1; *(uint4*)(wb + 64 * LROW) = y2; *(uint4*)(wb + 96 * LROW) = y3; \
  }
#define COMPUTE_TILE()                                                                                                   \
  {                                                                                                                      \
    _Pragma("unroll") for (int s = 0; s < 2; s++) {                                                                      \
      bf16x8 af[4], bfr[4];                                                                                              \
      _Pragma("unroll") for (int m = 0; m < 4; m++) af[m] = *(const bf16x8*)(sA + (wr * 64 + m * 16 + fr) * LROW + s * 64 + fq * 16); \
      _Pragma("unroll") for (int n = 0; n < 4; n++) bfr[n] = *(const bf16x8*)(sB + (wc * 64 + n * 16 + fr) * LROW + s * 64 + fq * 16); \
      _Pragma("unroll") for (int m = 0; m < 4; m++)                                                                      \
        _Pragma("unroll") for (int n = 0; n < 4; n++) acc[m][n] = __builtin_amdgcn_mfma_f32_16x16x32_bf16(af[m], bfr[n], acc[m][n], 0, 0, 0); \
    }                                                                                                                    \
  }
  GLOAD(ra0, ra1, ra2, ra3, rb0, rb1, rb2, rb3, 0);
  if constexpr (DEEP) {
    GLOAD(sa0, sa1, sa2, sa3, sb0, sb1, sb2, sb3, 1);
#pragma unroll 1
    for (int kt = 0; kt < nk; kt += 2) {
      __syncthreads();
      LSTORE(ra0, ra1, ra2, ra3, rb0, rb1, rb2, rb3);
      __syncthreads();
      if (kt + 2 < nk) GLOAD(ra0, ra1, ra2, ra3, rb0, rb1, rb2, rb3, kt + 2);
      COMPUTE_TILE();
      __syncthreads();
      LSTORE(sa0, sa1, sa2, sa3, sb0, sb1, sb2, sb3);
      __syncthreads();
      if (kt + 3 < nk) GLOAD(sa0, sa1, sa2, sa3, sb0, sb1, sb2, sb3, kt + 3);
      COMPUTE_TILE();
    }
  } else {
#pragma unroll 1
    for (int kt = 0; kt < nk; kt++) {
      __syncthreads();
      LSTORE(ra0, ra1, ra2, ra3, rb0, rb1, rb2, rb3);
      __syncthreads();
      if (kt + 1 < nk) GLOAD(ra0, ra1, ra2, ra3, rb0, rb1, rb2, rb3, kt + 1);
      COMPUTE_TILE();
    }
  }
  __syncthreads();
}
__device__ __forceinline__ void zero_acc(f32x4 (&acc)[4][4]) {
#pragma unroll
  for (int m = 0; m < 4; m++)
#pragma unroll
    for (int n = 0; n < 4; n++) acc[m][n] = f32x4{0.f, 0.f, 0.f, 0.f};
}
#define ACC_FOREACH(...)                                                                    \
  {                                                                                         \
    const int _l = TIDX & 63, _w = TIDX >> 6, _wr = _w >> 1, _wc = _w & 1;    \
    const int _fr = _l & 15, _fq = _l >> 4;                                                 \
    _Pragma("unroll") for (int m = 0; m < 4; m++) _Pragma("unroll") for (int n = 0; n < 4; n++) \
        _Pragma("unroll") for (int j = 0; j < 4; j++) {                                     \
      const int row = _wr * 64 + m * 16 + _fq * 4 + j, col = _wc * 64 + n * 16 + _fr;       \
      __VA_ARGS__                                                                           \
    }                                                                                       \
  }

struct TileIter {
  int x, lb, nbx, tpx, total, MT, NT, r;
  __device__ __forceinline__ TileIter(int bid, int nb, int MT_, int NT_) : MT(MT_), NT(NT_), r(0) {
    total = MT * NT; x = bid & 7; lb = bid >> 3; nbx = nb >> 3; tpx = (total + 7) >> 3;
  }
  __device__ __forceinline__ bool next(int& mt, int& nt) {
    const int idx = lb + r * nbx;
    r++;
    if (idx >= tpx) return false;
    const int lin = x * tpx + idx;
    if (lin >= total) return false;
    const int bsz = 8 * NT, band = lin / bsz, rem = lin - band * bsz;
    const int mb = min(8, MT - band * 8);
    nt = rem / mb; mt = band * 8 + (rem - nt * mb);
    return true;
  }
};

__device__ void transpose_tile(const float* __restrict__ src, int K, int N, u16* __restrict__ dst, int tile,
                               char* smem) {
  const int ntn = (N + 63) / 64, kt = tile / ntn, nt = tile % ntn, tid = TIDX;
  float(*s)[65] = (float(*)[65])smem;
  __syncthreads();
#pragma unroll 4
  for (int i = 0; i < 16; i++) {
    int r = (tid >> 6) + 4 * i, n = nt * 64 + (tid & 63);
    s[r][tid & 63] = (n < N) ? src[(size_t)(kt * 64 + r) * N + n] : 0.f;
  }
  __syncthreads();
#pragma unroll 4
  for (int i = 0; i < 8; i++) {
    int nl = (tid >> 5) + 8 * i, n = nt * 64 + nl, kl = (tid & 31) * 2;
    if (n < N) *(unsigned*)(dst + (size_t)n * K + kt * 64 + kl) = pack2(s[kl][nl], s[kl + 1][nl]);
  }
}

__device__ void mod_item(const P& p, int item2, char* smem) {
  const int item = item2 >> 1, kh2 = item2 & 1;
  const int tid = TIDX, j = tid & 31, g = tid >> 5;
  const int col0 = item * 32;
  const float* W; const float* bias; int N, cw;
  if (col0 < 6144) { W = p.w_ada; bias = p.b_ada; N = 6144; cw = col0; }
  else { W = p.w_ada_f; bias = p.b_ada_f; N = 2048; cw = col0 - 6144; }
  float(*cs)[68] = (float(*)[68])smem;
  float acc[17];
#pragma unroll
  for (int s = 0; s < 17; s++) acc[s] = 0.f;
  for (int k0 = kh2 * 512; k0 < kh2 * 512 + 512; k0 += 64) {
    __syncthreads();
    {
      float cv[34];
#pragma unroll
      for (int i = 0; i < 34; i++) {
        const int idx = tid + i * 256, seq = idx >> 6, kk = idx & 63;
        cv[i] = seq < 8 ? p.c_prompt[seq * 1024 + k0 + kk] : p.c_sample[(seq - 8) * 1024 + k0 + kk];
      }
#pragma unroll
      for (int i = 0; i < 34; i++) {
        const int idx = tid + i * 256;
        cs[idx >> 6][idx & 63] = siluf_(cv[i]);
      }
    }
    __syncthreads();
#pragma unroll 1
    for (int kh = 0; kh < 2; kh++) {
      float wv[32];
#pragma unroll
      for (int k = 0; k < 32; k++) wv[k] = W[(size_t)(k0 + kh * 32 + k) * N + cw + j];
#pragma unroll 2
      for (int k4 = 0; k4 < 8; k4++) {
#pragma unroll
        for (int s = 0; s < 17; s++) {
          float4 c4 = *(const float4*)&cs[g * 17 + s][kh * 32 + k4 * 4];
          acc[s] += wv[k4 * 4] * c4.x + wv[k4 * 4 + 1] * c4.y + wv[k4 * 4 + 2] * c4.z + wv[k4 * 4 + 3] * c4.w;
        }
      }
    }
  }
  const float b = kh2 == 0 ? bias[cw + j] : 0.f;
#pragma unroll
  for (int s = 0; s < 17; s++) atomicAdd(&p.mod[(size_t)(g * 17 + s) * 8192 + col0 + j], acc[s] + b);
}

constexpr int J_MOD = 512, J_WIN = 16 * 101, J_WPA = 8 * 16, J_WPB = 256, J_WOUT = 256, J_WQ = 16 * 32, J_KEYS = 128,
              J_SHIFT = 64;
constexpr int J_LORA = 8 + 8 + 16;
constexpr int PH0_ITEMS = J_MOD + J_WIN + J_WPA + J_WPB + J_WOUT + J_WQ + J_LORA + J_KEYS + J_SHIFT;

__device__ void phase0(const P& p, int bid, int nb, char* smem) {
  for (int it = bid; it < PH0_ITEMS; it += nb) {
    int i = it;
    if (i < J_MOD) { mod_item(p, i, smem); continue; }
    i -= J_MOD;
    if (i < J_WIN) { transpose_tile(p.w_in, 1024, INCOLS, p.w_inT, i, smem); continue; }
    i -= J_WIN;
    if (i < J_WPA) { transpose_tile(p.w_pa, 512, 1024, p.w_paT, i, smem); continue; }
    i -= J_WPA;
    if (i < J_WPB) { transpose_tile(p.w_pb, 1024, 1024, p.w_pbT, i, smem); continue; }
    i -= J_WPB;
    if (i < J_WOUT) { transpose_tile(p.w_out, 1024, 1024, p.w_outT, i, smem); continue; }
    i -= J_WOUT;
    if (i < J_WQ) { transpose_tile(p.peer_wq, 1024, 2048, p.wqT, i, smem); continue; }
    i -= J_WQ;
    if (i < 8) { transpose_tile(p.rw_w2, 64, 512, p.w2T, i, smem); continue; }
    if (i < 16) { transpose_tile(p.rw_a2, 64, 512, p.a2T, i - 8, smem); continue; }
    if (i < 32) { transpose_tile(p.rw_g2, 128, 512, p.g2T, i - 16, smem); continue; }
    i -= J_LORA;
    const float* src; u16* dst;
    if (i < J_KEYS) { src = p.peer_keys + (size_t)i * 2048; dst = p.keysb + (size_t)i * 2048; }
    else { i -= J_KEYS; src = p.state_shift + (size_t)i * 2048; dst = p.xn + (size_t)NT * D + (size_t)i * 2048; }
    const float4* s4 = (const float4*)src + TIDX * 2;
    float4 a = s4[0], b = s4[1];
    uint4 o; o.x = pack2(a.x, a.y); o.y = pack2(a.z, a.w); o.z = pack2(b.x, b.y); o.w = pack2(b.z, b.w);
    *((uint4*)dst + TIDX) = o;
  }
}

template <bool SECOND>
__device__ void phase_norm(const P& p, int bid, int nb) {
  const int lane = TIDX & 63, wid = TIDX >> 6;
  const float* gam = SECOND ? p.norm2_g : p.norm1_g;
  for (int it = bid; it < NT / 4; it += nb) {
    const int n = it * 4 + wid;
    int seq, t, T; tok2seq(n, seq, t, T);
    const float* xr = SECOND ? p.out + O_Y + (size_t)n * D : xrow(p, n);
    const float* md = p.mod + (size_t)seq * 8192 + (SECOND ? 3072 : 0);
    float4 v[4];
    float ss = 0.f;
#pragma unroll
    for (int i = 0; i < 4; i++) {
      v[i] = ((const float4*)xr)[lane + 64 * i];
      ss += v[i].x * v[i].x + v[i].y * v[i].y + v[i].z * v[i].z + v[i].w * v[i].w;
    }
    ss = wave_sum(ss);
    const float rstd = rsqrtf(ss * (1.f / 1024.f) + 1e-6f);
    const bool last = (!SECOND) && (t == T - 1);
    float* so = seq_out(p.out, seq, O_PSHIFT, O_SSHIFT, 1024);
#pragma unroll
    for (int i = 0; i < 4; i++) {
      const int c = (lane + 64 * i) * 4;
      float4 g = *(const float4*)(gam + c), sh = *(const float4*)(md + c), sc = *(const float4*)(md + 1024 + c);
      float4 o;
      o.x = v[i].x * rstd * g.x * (1.f + sc.x) + sh.x;
      o.y = v[i].y * rstd * g.y * (1.f + sc.y) + sh.y;
      o.z = v[i].z * rstd * g.z * (1.f + sc.z) + sh.z;
      o.w = v[i].w * rstd * g.w * (1.f + sc.w) + sh.w;
      uint2 pk; pk.x = pack2(o.x, o.y); pk.y = pack2(o.z, o.w);
      *(uint2*)(p.xn + (size_t)n * D + c) = pk;
      if (last) *(float4*)(so + c) = o;
    }
  }
}

constexpr int P2_NT = 35, P2_MT = 137;
__device__ void phase2(const P& p, int bid, int nb, char* smem) {
  TileIter ti(bid, nb, P2_MT, P2_NT);
  int mt, nt;
  while (ti.next(mt, nt)) {
    f32x4 acc[4][4];
    zero_acc(acc);
    gemm_tile(p.xn, D, mt * 128, p.w_inT, D, nt * 128, D, acc, smem);
    ACC_FOREACH({
      const int gc = nt * 128 + col;
      if (gc < PCOLS) p.proj[(size_t)(mt * 128 + row) * PCOLS + gc] = f2bf(acc[m][n][j]);
    })
  }
}

__device__ void rwkv_lerp_item(const P& p, int item) {
  const int tid = TIDX;
  const int n0 = item * 8;
  int seq, t0, T; tok2seq(n0, seq, t0, T);
  uint4 pcv[7], ppv[7];
#pragma unroll
  for (int i = 0; i < 7; i++) {
    const int idx = tid + i * 256, tok = idx / 224, c = (idx % 224) * 8;
    const int n = n0 + tok, t = t0 + tok;
    pcv[i] = *(const uint4*)(p.proj + (size_t)n * PCOLS + c);
    const size_t prow = t > 0 ? (size_t)(n - 1) : (size_t)(NT + (seq >= 8 ? seq - 8 : 0));
    ppv[i] = *(const uint4*)(p.proj + prow * PCOLS + c);
    if (t == 0 && seq < 8) ppv[i] = make_uint4(0, 0, 0, 0);
  }
#pragma unroll
  for (int i = 0; i < 7; i++) {
    const int idx = tid + i * 256, tok = idx / 224, c = (idx % 224) * 8;
    const int n = n0 + tok;
    const float4 mu0 = *(const float4*)(p.rw_mu + c), mu1 = *(const float4*)(p.rw_mu + c + 4);
    const float mus[8] = {mu0.x, mu0.y, mu0.z, mu0.w, mu1.x, mu1.y, mu1.z, mu1.w};
    const unsigned pcs[4] = {pcv[i].x, pcv[i].y, pcv[i].z, pcv[i].w}, pps[4] = {ppv[i].x, ppv[i].y, ppv[i].z, ppv[i].w};
    unsigned o[4];
#pragma unroll
    for (int e = 0; e < 4; e++) {
      float a0 = bflo(pcs[e]), a1 = bfhi(pcs[e]), b0 = bflo(pps[e]), b1 = bfhi(pps[e]);
      float q0 = a0 + (b0 - a0) * mus[2 * e], q1 = a1 + (b1 - a1) * mus[2 * e + 1];
      if (c >= C_LW && c < C_LA) { q0 = tanhf(q0); q1 = tanhf(q1); }
      else if (c >= C_LG) { q0 = sigmoidf_(q0); q1 = sigmoidf_(q1); }
      o[e] = pack2(q0, q1);
    }
    u16* dst;
    if (c < 512) dst = p.prep + (size_t)n * 3584 + 512 + c;
    else if (c < 1024) dst = p.prep + (size_t)n * 3584 + 1024 + (c - 512);
    else if (c < 1536) dst = p.prep + (size_t)n * 3584 + 2560 + (c - 1024);
    else dst = p.lora + (size_t)n * 256 + (c - 1536);
    *(uint4*)dst = make_uint4(o[0], o[1], o[2], o[3]);
  }
}

__device__ void rwkv_lora_item(const P& p, int mt, int nt, char* smem) {
  const int tid = TIDX, lane = tid & 63, wid = tid >> 6, wr = wid >> 1, wc = wid & 1, fr = lane & 15, fq = lane >> 4;
  const int col0 = nt * 128;
  f32x4 acc[4][4];
  zero_acc(acc);
  gemm_tile<false>(p.lora, 256, mt * 128, p.w2T, 64, col0, 64, acc, smem);
  ACC_FOREACH({
    const int gc = col0 + col;
    const float wpre = p.rw_w0[gc] + acc[m][n][j];
    const float w = -softplusf_(-wpre) - 0.5f;
    p.prep[(size_t)(mt * 128 + row) * 3584 + gc] = f2bf(-expf(w));
  })
  zero_acc(acc);
  gemm_tile<false>(p.lora + 128, 256, mt * 128, p.g2T, 128, col0, 128, acc, smem);
  ACC_FOREACH({ p.prep[(size_t)(mt * 128 + row) * 3584 + 3072 + col0 + col] = f2bf(acc[m][n][j]); })
  zero_acc(acc);
  gemm_tile<false>(p.lora + 64, 256, mt * 128, p.a2T, 64, col0, 64, acc, smem);
  float a0c[4], kkc[4], kac[4];
#pragma unroll
  for (int n = 0; n < 4; n++) {
    const int gc = col0 + wc * 64 + n * 16 + fr;
    a0c[n] = p.rw_a0[gc]; kkc[n] = p.rw_k_k[gc]; kac[n] = p.rw_k_a[gc];
  }
#pragma unroll
  for (int m = 0; m < 4; m++)
#pragma unroll
    for (int j = 0; j < 4; j++) {
      const int row = mt * 128 + wr * 64 + m * 16 + fq * 4 + j;
      u16* pr = p.prep + (size_t)row * 3584 + col0 + wc * 64 + fr;
      float kx[4], kkv[4], av[4];
      float ss = 0.f;
#pragma unroll
      for (int n = 0; n < 4; n++) {
        kx[n] = bf2f(pr[1024 + n * 16]);
        av[n] = sigmoidf_(a0c[n] + acc[m][n][j]);
        kkv[n] = kx[n] * kkc[n];
        ss += kkv[n] * kkv[n];
      }
      ss = allreduce16(ss);
      const float inv = 1.f / fmaxf(sqrtf(ss), 1e-12f);
#pragma unroll
      for (int n = 0; n < 4; n++) {
        const float kk = kkv[n] * inv;
        pr[1024 + n * 16] = f2bf(kx[n] * (1.f + (av[n] - 1.f) * kac[n]));
        pr[1536 + n * 16] = f2bf(kk);
        pr[2048 + n * 16] = f2bf(kk * av[n]);
      }
    }
}

__device__ void conv_prep_item(const P& p, int item) {
  const int tid = TIDX;
  const int n0 = item * 8;
  int seq, t0, T; tok2seq(n0, seq, t0, T);
  if (tid < 192) {
    const int c = tid * 8;
    uint4 rows[11];
#pragma unroll
    for (int j = 0; j < 11; j++) {
      const int tt = t0 - 3 + j;
      rows[j] = make_uint4(0, 0, 0, 0);
      if (tt >= 0) rows[j] = *(const uint4*)(p.proj + (size_t)(n0 - 3 + j) * PCOLS + C_XBC + c);
      else if (seq >= 8) {
        const float* sc = p.state_conv + ((size_t)(seq - 8) * 3 + (tt + 3)) * 1536 + c;
        const float4 a = *(const float4*)sc, b = *(const float4*)(sc + 4);
        rows[j] = make_uint4(pack2(a.x, a.y), pack2(a.z, a.w), pack2(b.x, b.y), pack2(b.z, b.w));
      }
    }
    float w[4][8], cb[8];
#pragma unroll
    for (int j = 0; j < 4; j++) {
      const float4 a = *(const float4*)(p.conv_w + j * 1536 + c), b = *(const float4*)(p.conv_w + j * 1536 + c + 4);
      w[j][0] = a.x; w[j][1] = a.y; w[j][2] = a.z; w[j][3] = a.w; w[j][4] = b.x; w[j][5] = b.y; w[j][6] = b.z; w[j][7] = b.w;
    }
    {
      const float4 a = *(const float4*)(p.conv_b + c), b = *(const float4*)(p.conv_b + c + 4);
      cb[0] = a.x; cb[1] = a.y; cb[2] = a.z; cb[3] = a.w; cb[4] = b.x; cb[5] = b.y; cb[6] = b.z; cb[7] = b.w;
    }
#pragma unroll
    for (int k = 0; k < 8; k++) {
      float o[8];
#pragma unroll
      for (int e = 0; e < 8; e++) o[e] = cb[e];
#pragma unroll
      for (int j = 0; j < 4; j++) {
        const uint4 r = rows[k + j];
        const unsigned rs[4] = {r.x, r.y, r.z, r.w};
#pragma unroll
        for (int e = 0; e < 4; e++) { o[2 * e] += bflo(rs[e]) * w[j][2 * e]; o[2 * e + 1] += bfhi(rs[e]) * w[j][2 * e + 1]; }
      }
      *(uint4*)(p.xc + (size_t)(n0 + k) * 1536 + c) =
          make_uint4(pack2(siluf_(o[0]), siluf_(o[1])), pack2(siluf_(o[2]), siluf_(o[3])), pack2(siluf_(o[4]), siluf_(o[5])),
                     pack2(siluf_(o[6]), siluf_(o[7])));
    }
    if (t0 + 8 == T) {
      float* co = seq_out(p.out, seq, O_PCONV, O_SCONV, 3 * 1536);
#pragma unroll
      for (int j = 0; j < 3; j++) {
        const uint4 r = rows[8 + j];
        *(float4*)(co + j * 1536 + c) = make_float4(bflo(r.x), bfhi(r.x), bflo(r.y), bfhi(r.y));
        *(float4*)(co + j * 1536 + c + 4) = make_float4(bflo(r.z), bfhi(r.z), bflo(r.w), bfhi(r.w));
      }
    }
  } else if (tid < 192 + 32) {
    const int i = tid - 192;
#pragma unroll
    for (int e = 0; e < 4; e++) {
      const int pi = i * 4 + e, k = pi >> 4, h = pi & 15, n = n0 + k;
      const float raw = bf2f(p.proj[(size_t)n * PCOLS + C_DT + h]) + p.dt_bias[h];
      const float dt = softplusf_(raw);
      const float dA = -dt * expf(p.A_log[h]);
      p.dtb[n * 16 + h] = dt;
      p.decb[n * 16 + h] = expf(dA);
    }
  }
}

__device__ void phase3(const P& p, int bid, int nb, char* smem) {
  for (int it = bid; it < 2 * (NT / 8); it += nb) {
    if (it < NT / 8) rwkv_lerp_item(p, it);
    else conv_prep_item(p, it - NT / 8);
  }
}
__device__ void phase3b(const P& p, int bid, int nb, char* smem) {
  for (int it = bid; it < 136 * 4; it += nb) rwkv_lora_item(p, it >> 2, it & 3, smem);
}

constexpr int TC = 32;
__device__ __forceinline__ void bf8_to_f(uint4 u, float4& lo, float4& hi) {
  lo = make_float4(bflo(u.x), bfhi(u.x), bflo(u.y), bfhi(u.y));
  hi = make_float4(bflo(u.z), bfhi(u.z), bflo(u.w), bfhi(u.w));
}
__device__ void rwkv_scan_item(const P& p, int seq, int h, int qr, char* smem) {
  const int T = seq < 8 ? 2048 : 8, nbase = seq < 8 ? seq * 2048 : NP + (seq - 8) * 8;
  float* Ld = (float*)smem;
  float* Lr = Ld + TC * 64; float* Lk = Lr + TC * 64; float* Lkk = Lk + TC * 64; float* Lb = Lkk + TC * 64;
  float* Lv = Lb + TC * 64;
  const int tid = TIDX, w = tid >> 6, lane = tid & 63, rl = w * 4 + (lane >> 4), ks = lane & 15;
  const int v = qr * 16 + rl;
  float S0 = 0.f, S1 = 0.f, S2 = 0.f, S3 = 0.f;
  if (seq >= 8) {
    float4 s = *(const float4*)(p.state_wkv + (((size_t)(seq - 8) * 8 + h) * 64 + v) * 64 + ks * 4);
    S0 = s.x; S1 = s.y; S2 = s.z; S3 = s.w;
  }
  const int st = tid >> 3, sk8 = (tid & 7) * 8;
  const int vt = tid >> 1, vr8 = (tid & 1) * 8;
  uint4 g0, g1, g2, g3, g4, gv;
  g0 = g1 = g2 = g3 = g4 = gv = make_uint4(0, 0, 0, 0);
#define RW_GLOAD(c0_)                                                                           \
  {                                                                                             \
    const int tcn = min(TC, T - (c0_));                                                         \
    if (st < tcn) {                                                                             \
      const u16* base = p.prep + (size_t)(nbase + (c0_) + st) * 3584 + h * 64 + sk8;            \
      g0 = *(const uint4*)(base); g1 = *(const uint4*)(base + 512); g2 = *(const uint4*)(base + 1024); \
      g3 = *(const uint4*)(base + 1536); g4 = *(const uint4*)(base + 2048);                     \
    }                                                                                           \
    if (tid < 64 && vt < tcn)                                                                   \
      gv = *(const uint4*)(p.prep + (size_t)(nbase + (c0_) + vt) * 3584 + 2560 + h * 64 + qr * 16 + vr8); \
  }
  RW_GLOAD(0);
  for (int c0 = 0; c0 < T; c0 += TC) {
    const int tc = min(TC, T - c0);
    __syncthreads();
    {
      float4 lo, hi;
      bf8_to_f(g0, lo, hi);
      lo.x = __expf(lo.x); lo.y = __expf(lo.y); lo.z = __expf(lo.z); lo.w = __expf(lo.w);
      hi.x = __expf(hi.x); hi.y = __expf(hi.y); hi.z = __expf(hi.z); hi.w = __expf(hi.w);
      *(float4*)(Ld + st * 64 + sk8) = lo; *(float4*)(Ld + st * 64 + sk8 + 4) = hi;
      bf8_to_f(g1, lo, hi); *(float4*)(Lr + st * 64 + sk8) = lo; *(float4*)(Lr + st * 64 + sk8 + 4) = hi;
      bf8_to_f(g2, lo, hi); *(float4*)(Lk + st * 64 + sk8) = lo; *(float4*)(Lk + st * 64 + sk8 + 4) = hi;
      bf8_to_f(g3, lo, hi); *(float4*)(Lkk + st * 64 + sk8) = lo; *(float4*)(Lkk + st * 64 + sk8 + 4) = hi;
      bf8_to_f(g4, lo, hi); *(float4*)(Lb + st * 64 + sk8) = lo; *(float4*)(Lb + st * 64 + sk8 + 4) = hi;
      if (tid < 64) { bf8_to_f(gv, lo, hi); *(float4*)(Lv + vt * 16 + vr8) = lo; *(float4*)(Lv + vt * 16 + vr8 + 4) = hi; }
    }
    __syncthreads();
    if (c0 + TC < T) RW_GLOAD(c0 + TC);
    float4 kk4 = *(const float4*)(Lkk + ks * 4), d4 = *(const float4*)(Ld + ks * 4), b4 = *(const float4*)(Lb + ks * 4),
           k4 = *(const float4*)(Lk + ks * 4), r4 = *(const float4*)(Lr + ks * 4);
    float vv = Lv[rl];
    u16* yo = p.proj + (size_t)(nbase + c0) * PCOLS + h * 64 + v;
    for (int tt = 0; tt < tc; tt++) {
      const int tn = min(tt + 1, tc - 1);
      const float4 nkk4 = *(const float4*)(Lkk + tn * 64 + ks * 4), nd4 = *(const float4*)(Ld + tn * 64 + ks * 4),
                   nb4 = *(const float4*)(Lb + tn * 64 + ks * 4), nk4 = *(const float4*)(Lk + tn * 64 + ks * 4),
                   nr4 = *(const float4*)(Lr + tn * 64 + ks * 4);
      const float nvv = Lv[tn * 16 + rl];
      float sk = (S0 * kk4.x + S1 * kk4.y) + (S2 * kk4.z + S3 * kk4.w);
      sk = allreduce16(sk);
      S0 = S0 * d4.x + (vv * k4.x - sk * b4.x);
      S1 = S1 * d4.y + (vv * k4.y - sk * b4.y);
      S2 = S2 * d4.z + (vv * k4.z - sk * b4.z);
      S3 = S3 * d4.w + (vv * k4.w - sk * b4.w);
      float y = (S0 * r4.x + S1 * r4.y) + (S2 * r4.z + S3 * r4.w);
      y = allreduce16(y);
      if (ks == 0) yo[(size_t)tt * PCOLS] = f2bf(y);
      kk4 = nkk4; d4 = nd4; b4 = nb4; k4 = nk4; r4 = nr4; vv = nvv;
    }
  }
  float* so = seq_out(p.out, seq, O_PWKV, O_SWKV, 8 * 4096);
  *(float4*)(so + ((size_t)h * 64 + v) * 64 + ks * 4) = make_float4(S0, S1, S2, S3);
}

__device__ void ssm_scan_item(const P& p, int seq, int head, int half, char* smem) {
  const int T = seq < 8 ? 2048 : 8, nbase = seq < 8 ? seq * 2048 : NP + (seq - 8) * 8;
  float* LB = (float*)smem;
  float* LC = LB + TC * 128;
  float* Lx = LC + TC * 128;
  float* Ldt = Lx + TC * 32;
  float* Ldec = Ldt + TC;
  const int tid = TIDX, pl = tid >> 3, ns = tid & 7;
  const int pp = half * 32 + pl, g = head >> 3;
  const float Dk = p.D_skip[head];
  float hs[16];
#pragma unroll
  for (int j = 0; j < 16; j++) hs[j] = 0.f;
  if (seq >= 8) {
    const float4* s4 = (const float4*)(p.state_ssm + (((size_t)(seq - 8) * 16 + head) * 64 + pp) * 128 + ns * 16);
#pragma unroll
    for (int j = 0; j < 4; j++) { float4 s = s4[j]; hs[4 * j] = s.x; hs[4 * j + 1] = s.y; hs[4 * j + 2] = s.z; hs[4 * j + 3] = s.w; }
  }
  uint4 gb0, gb1, gb2, gb3, gx; float gdt = 0.f, gdec = 0.f;
  gb0 = gb1 = gb2 = gb3 = gx = make_uint4(0, 0, 0, 0);
  const int bt = tid >> 5, bch = tid & 31;
  const u16* bsrc = p.xc + 1024 + (bch < 16 ? 0 : 256) + g * 128 + (bch & 15) * 8;
  const int xt = tid >> 2, xr8 = (tid & 3) * 8;
#define SS_GLOAD(c0_)                                                                          \
  {                                                                                            \
    const int tcn = min(TC, T - (c0_));                                                        \
    const size_t nb_ = (size_t)(nbase + (c0_));                                                \
    if (bt < tcn) gb0 = *(const uint4*)(bsrc + (nb_ + bt) * 1536);                             \
    if (bt + 8 < tcn) gb1 = *(const uint4*)(bsrc + (nb_ + bt + 8) * 1536);                     \
    if (bt + 16 < tcn) gb2 = *(const uint4*)(bsrc + (nb_ + bt + 16) * 1536);                   \
    if (bt + 24 < tcn) gb3 = *(const uint4*)(bsrc + (nb_ + bt + 24) * 1536);                   \
    if (tid < 128 && xt < tcn) gx = *(const uint4*)(p.xc + (nb_ + xt) * 1536 + head * 64 + half * 32 + xr8); \
    if (tid < tcn) { gdt = p.dtb[(nb_ + tid) * 16 + head]; gdec = p.decb[(nb_ + tid) * 16 + head]; } \
  }
  SS_GLOAD(0);
  for (int c0 = 0; c0 < T; c0 += TC) {
    const int tc = min(TC, T - c0);
    __syncthreads();
    {
      float* dstb = (bch < 16 ? LB : LC) + (bch & 15) * 8;
      float4 lo, hi;
      bf8_to_f(gb0, lo, hi); *(float4*)(dstb + bt * 128) = lo; *(float4*)(dstb + bt * 128 + 4) = hi;
      bf8_to_f(gb1, lo, hi); *(float4*)(dstb + (bt + 8) * 128) = lo; *(float4*)(dstb + (bt + 8) * 128 + 4) = hi;
      bf8_to_f(gb2, lo, hi); *(float4*)(dstb + (bt + 16) * 128) = lo; *(float4*)(dstb + (bt + 16) * 128 + 4) = hi;
      bf8_to_f(gb3, lo, hi); *(float4*)(dstb + (bt + 24) * 128) = lo; *(float4*)(dstb + (bt + 24) * 128 + 4) = hi;
      if (tid < 128) { bf8_to_f(gx, lo, hi); *(float4*)(Lx + xt * 32 + xr8) = lo; *(float4*)(Lx + xt * 32 + xr8 + 4) = hi; }
      if (tid < TC) { Ldt[tid] = gdt; Ldec[tid] = gdec; }
    }
    __syncthreads();
    if (c0 + TC < T) SS_GLOAD(c0 + TC);
    u16* yo = p.proj + (size_t)(nbase + c0) * PCOLS + C_XBC + head * 64 + pp;
    float4 B0 = *(const float4*)(LB + ns * 16), B1 = *(const float4*)(LB + ns * 16 + 4), B2 = *(const float4*)(LB + ns * 16 + 8),
           B3 = *(const float4*)(LB + ns * 16 + 12);
    float4 C0 = *(const float4*)(LC + ns * 16), C1 = *(const float4*)(LC + ns * 16 + 4), C2 = *(const float4*)(LC + ns * 16 + 8),
           C3 = *(const float4*)(LC + ns * 16 + 12);
    float xv = Lx[pl], dtv = Ldt[0], dec = Ldec[0];
    for (int tt = 0; tt < tc; tt++) {
      const int tn = min(tt + 1, tc - 1);
      const float* nB = LB + tn * 128 + ns * 16;
      const float* nC = LC + tn * 128 + ns * 16;
      const float4 nB0 = *(const float4*)(nB), nB1 = *(const float4*)(nB + 4), nB2 = *(const float4*)(nB + 8), nB3 = *(const float4*)(nB + 12);
      const float4 nC0 = *(const float4*)(nC), nC1 = *(const float4*)(nC + 4), nC2 = *(const float4*)(nC + 8), nC3 = *(const float4*)(nC + 12);
      const float nxv = Lx[tn * 32 + pl], ndt = Ldt[tn], ndec = Ldec[tn];
      const float dtx = dtv * xv;
      hs[0] = hs[0] * dec + dtx * B0.x; hs[1] = hs[1] * dec + dtx * B0.y; hs[2] = hs[2] * dec + dtx * B0.z; hs[3] = hs[3] * dec + dtx * B0.w;
      hs[4] = hs[4] * dec + dtx * B1.x; hs[5] = hs[5] * dec + dtx * B1.y; hs[6] = hs[6] * dec + dtx * B1.z; hs[7] = hs[7] * dec + dtx * B1.w;
      hs[8] = hs[8] * dec + dtx * B2.x; hs[9] = hs[9] * dec + dtx * B2.y; hs[10] = hs[10] * dec + dtx * B2.z; hs[11] = hs[11] * dec + dtx * B2.w;
      hs[12] = hs[12] * dec + dtx * B3.x; hs[13] = hs[13] * dec + dtx * B3.y; hs[14] = hs[14] * dec + dtx * B3.z; hs[15] = hs[15] * dec + dtx * B3.w;
      float y0 = hs[0] * C0.x + hs[1] * C0.y + hs[2] * C0.z + hs[3] * C0.w;
      float y1 = hs[4] * C1.x + hs[5] * C1.y + hs[6] * C1.z + hs[7] * C1.w;
      float y2 = hs[8] * C2.x + hs[9] * C2.y + hs[10] * C2.z + hs[11] * C2.w;
      float y3 = hs[12] * C3.x + hs[13] * C3.y + hs[14] * C3.z + hs[15] * C3.w;
      float yp = allreduce8((y0 + y1) + (y2 + y3));
      if (ns == 0) yo[(size_t)tt * PCOLS] = f2bf(yp + Dk * xv);
      B0 = nB0; B1 = nB1; B2 = nB2; B3 = nB3; C0 = nC0; C1 = nC1; C2 = nC2; C3 = nC3; xv = nxv; dtv = ndt; dec = ndec;
    }
  }
  float* so = seq_out(p.out, seq, O_PSSM, O_SSSM, 16 * 8192);
  float4* o4 = (float4*)(so + ((size_t)head * 64 + pp) * 128 + ns * 16);
#pragma unroll
  for (int j = 0; j < 4; j++) o4[j] = make_float4(hs[4 * j], hs[4 * j + 1], hs[4 * j + 2], hs[4 * j + 3]);
}

constexpr int P4_RP = 256, P4_SP = 256, P4_RS = 4096, P4_SS = 4096;
__device__ void phase4(const P& p, int bid, int nb, char* smem) {
  for (int it = bid; it < P4_RP + P4_SP + P4_RS + P4_SS; it += nb) {
    int i = it;
    if (i < P4_RP) { rwkv_scan_item(p, i >> 5, (i >> 2) & 7, i & 3, smem); continue; }
    i -= P4_RP;
    if (i < P4_SP) { ssm_scan_item(p, i >> 5, (i >> 1) & 15, i & 1, smem); continue; }
    i -= P4_SP;
    if (i < P4_RS) { rwkv_scan_item(p, 8 + (i >> 5), (i >> 2) & 7, i & 3, smem); continue; }
    i -= P4_RS;
    ssm_scan_item(p, 8 + (i >> 5), (i >> 1) & 15, i & 1, smem);
  }
}

__device__ void phase5(const P& p, int bid, int nb) {
  const int lane = TIDX & 63, wid = TIDX >> 6;
  for (int it = bid; it < NT / 4; it += nb) {
    const int n = it * 4 + wid;
    {
      const int c = lane * 8;
      uint4 yu = *(const uint4*)(p.proj + (size_t)n * PCOLS + c);
      const u16* pr = p.prep + (size_t)n * 3584 + c;
      uint4 ru = *(const uint4*)(pr + 512), ku = *(const uint4*)(pr + 1024), vu = *(const uint4*)(pr + 2560),
            gu = *(const uint4*)(pr + 3072);
      unsigned ys[4] = {yu.x, yu.y, yu.z, yu.w}, rs[4] = {ru.x, ru.y, ru.z, ru.w}, ks_[4] = {ku.x, ku.y, ku.z, ku.w},
               vs[4] = {vu.x, vu.y, vu.z, vu.w}, gs[4] = {gu.x, gu.y, gu.z, gu.w};
      float y[8], r[8], k[8], v[8], g[8];
#pragma unroll
      for (int e = 0; e < 4; e++) {
        y[2 * e] = bflo(ys[e]); y[2 * e + 1] = bfhi(ys[e]);
        r[2 * e] = bflo(rs[e]); r[2 * e + 1] = bfhi(rs[e]);
        k[2 * e] = bflo(ks_[e]); k[2 * e + 1] = bfhi(ks_[e]);
        v[2 * e] = bflo(vs[e]); v[2 * e + 1] = bfhi(vs[e]);
        g[2 * e] = bflo(gs[e]); g[2 * e + 1] = bfhi(gs[e]);
      }
      float s = 0.f, bn = 0.f;
#pragma unroll
      for (int e = 0; e < 8; e++) { s += y[e]; bn += r[e] * k[e] * p.rw_r_k[c + e]; }
      s = allreduce8(s); bn = allreduce8(bn);
      const float mean = s * (1.f / 64.f);
      float vr = 0.f;
#pragma unroll
      for (int e = 0; e < 8; e++) { const float d = y[e] - mean; vr += d * d; }
      vr = allreduce8(vr) * (1.f / 64.f);
      const float rs_ = rsqrtf(vr + 64e-5f);
      float o[8];
#pragma unroll
      for (int e = 0; e < 8; e++) {
        const float yn = (y[e] - mean) * rs_ * p.rw_ln_w[c + e] + p.rw_ln_b[c + e];
        o[e] = (yn + bn * v[e]) * g[e];
      }
      uint4 ou; ou.x = pack2(o[0], o[1]); ou.y = pack2(o[2], o[3]); ou.z = pack2(o[4], o[5]); ou.w = pack2(o[6], o[7]);
      *(uint4*)(p.oa + (size_t)n * 512 + c) = ou;
    }
    {
      const int c = lane * 16;
      float yv[16];
      float ss = 0.f;
#pragma unroll
      for (int hh = 0; hh < 2; hh++) {
        uint4 yu = *(const uint4*)(p.proj + (size_t)n * PCOLS + C_XBC + c + hh * 8);
        uint4 zu = *(const uint4*)(p.proj + (size_t)n * PCOLS + C_Z + c + hh * 8);
        unsigned ys[4] = {yu.x, yu.y, yu.z, yu.w}, zs[4] = {zu.x, zu.y, zu.z, zu.w};
#pragma unroll
        for (int e = 0; e < 4; e++) {
          const float a = bflo(ys[e]) * siluf_(bflo(zs[e])), b = bfhi(ys[e]) * siluf_(bfhi(zs[e]));
          yv[hh * 8 + 2 * e] = a; yv[hh * 8 + 2 * e + 1] = b;
          ss += a * a + b * b;
        }
      }
#pragma unroll
      for (int o = 16; o >= 1; o >>= 1) ss += __shfl_xor(ss, o, 64);
      const float rstd = rsqrtf(ss * (1.f / 512.f) + 1e-6f);
      unsigned ou[8];
#pragma unroll
      for (int e = 0; e < 8; e++)
        ou[e] = pack2(yv[2 * e] * rstd * p.ssm_norm_w[c + 2 * e], yv[2 * e + 1] * rstd * p.ssm_norm_w[c + 2 * e + 1]);
      *(uint4*)(p.ob + (size_t)n * 1024 + c) = make_uint4(ou[0], ou[1], ou[2], ou[3]);
      *(uint4*)(p.ob + (size_t)n * 1024 + c + 8) = make_uint4(ou[4], ou[5], ou[6], ou[7]);
    }
  }
}

__device__ void phase6(const P& p, int bid, int nb, char* smem) {
  TileIter ti(bid, nb, 136, 8);
  int mt, nt;
  while (ti.next(mt, nt)) {
    f32x4 ac[4][4];
    u16* Lm = (u16*)(smem + 2 * 128 * LROW);
    zero_acc(ac);
    gemm_tile(p.xn, D, mt * 128, p.w_inT + (size_t)G_A * D, D, nt * 128, D, ac, smem);
    ACC_FOREACH({ Lm[row * 136 + col] = f2bf(sigmoidf_(ac[m][n][j])); })
    zero_acc(ac);
    gemm_tile(p.oa, 512, mt * 128, p.w_paT, 512, nt * 128, 512, ac, smem);
    ACC_FOREACH({ Lm[row * 136 + col] = f2bf(bf2f(Lm[row * 136 + col]) * ac[m][n][j]); })
    zero_acc(ac);
    gemm_tile(p.xn, D, mt * 128, p.w_inT + (size_t)G_B * D, D, nt * 128, D, ac, smem);
    ACC_FOREACH({ p.merged[(size_t)(mt * 128 + row) * D + nt * 128 + col] = f2bf(sigmoidf_(ac[m][n][j])); })
    zero_acc(ac);
    gemm_tile(p.ob, D, mt * 128, p.w_pbT, D, nt * 128, D, ac, smem);
    ACC_FOREACH({
      u16* mp = p.merged + (size_t)(mt * 128 + row) * D + nt * 128 + col;
      *mp = f2bf(bf2f(Lm[row * 136 + col]) + bf2f(*mp) * ac[m][n][j]);
    })
  }
}

constexpr int P7_G = 136 * 8, P7_CV = 16384;
constexpr float U_SCALE = 256.f, V_SCALE = 32.f;
__device__ void phase7(const P& p, int bid, int nb, char* smem) {
  {
    TileIter ti(bid, nb, 136, 8);
    int mt, nt;
    while (ti.next(mt, nt)) {
      f32x4 acc[4][4];
      zero_acc(acc);
      gemm_tile(p.merged, D, mt * 128, p.w_outT, D, nt * 128, D, acc, smem);
      ACC_FOREACH({
        const int nn = mt * 128 + row, c = nt * 128 + col;
        int seq, t, T; tok2seq(nn, seq, t, T);
        const float gt = p.mod[(size_t)seq * 8192 + 2048 + c];
        p.out[O_Y + (size_t)nn * D + c] = xrow(p, nn)[c] + gt * acc[m][n][j];
      })
    }
  }
  for (int it = bid; it < P7_CV; it += nb) {
    int i = it;
    const float* src; unsigned char* dst; float sc;
    if (i < 8192) { src = p.peer_u + (size_t)i * 2048; dst = (unsigned char*)p.ub + (size_t)i * 2048; sc = U_SCALE; }
    else { i -= 8192; src = p.peer_v + (size_t)i * 2048; dst = (unsigned char*)p.vb + (size_t)i * 2048; sc = V_SCALE; }
    const int tid = TIDX;
    const float4* s4 = (const float4*)src + tid * 2;
    const float4 a = s4[0], b = s4[1];
    int lo = __builtin_amdgcn_cvt_pk_fp8_f32(a.x * sc, a.y * sc, 0, false);
    lo = __builtin_amdgcn_cvt_pk_fp8_f32(a.z * sc, a.w * sc, lo, true);
    int hi = __builtin_amdgcn_cvt_pk_fp8_f32(b.x * sc, b.y * sc, 0, false);
    hi = __builtin_amdgcn_cvt_pk_fp8_f32(b.z * sc, b.w * sc, hi, true);
    *((uint2*)dst + tid) = make_uint2((unsigned)lo, (unsigned)hi);
  }
}

__device__ void phase9(const P& p, int bid, int nb, char* smem) {
  const int tid = TIDX, lane = tid & 63, wid = tid >> 6, wr = wid >> 1, wc = wid & 1, fr = lane & 15,
            fq = lane >> 4;
  TileIter ti(bid, nb, 136, 16);
  int mt, nt;
  while (ti.next(mt, nt)) {
    f32x4 acc[4][4];
    zero_acc(acc);
    gemm_tile<false>(p.xn, D, mt * 128, p.wqT, D, nt * 128, D, acc, smem);
    u16* Lq = (u16*)smem;
    ACC_FOREACH({ Lq[row * 136 + col] = f2bf(acc[m][n][j]); })
    __syncthreads();
    f32x4 sc[4][4];
    zero_acc(sc);
    const u16* kb = p.keysb + (size_t)nt * 128 * 128;
#pragma unroll 1
    for (int s = 0; s < 4; s++) {
      bf16x8 af[4], bfr[4];
#pragma unroll
      for (int m = 0; m < 4; m++) af[m] = *(const bf16x8*)((const char*)Lq + (wr * 64 + m * 16 + fr) * 272 + s * 64 + fq * 16);
#pragma unroll
      for (int n = 0; n < 4; n++) bfr[n] = *(const bf16x8*)(kb + (size_t)(wc * 64 + n * 16 + fr) * 128 + s * 32 + fq * 8);
#pragma unroll
      for (int m = 0; m < 4; m++)
#pragma unroll
        for (int n = 0; n < 4; n++) sc[m][n] = __builtin_amdgcn_mfma_f32_16x16x32_bf16(af[m], bfr[n], sc[m][n], 0, 0, 0);
    }
    __syncthreads();
    float* Ls = (float*)smem;
#pragma unroll
    for (int m = 0; m < 4; m++)
#pragma unroll
      for (int n = 0; n < 4; n++)
#pragma unroll
        for (int j = 0; j < 4; j++) Ls[(wr * 64 + m * 16 + fq * 4 + j) * 129 + wc * 64 + n * 16 + fr] = sc[m][n][j];
    __syncthreads();
    {
      const int row = tid >> 1, half = tid & 1;
      float* Lr = Ls + row * 129;
      const size_t ob = ((size_t)(mt * 128 + row) * 16 + nt) * 16;
      for (int r = 0; r < 16; r++) {
        float best = -INFINITY; int bi = 0;
        for (int i = 0; i < 64; i++) {
          const float v = Lr[half + 2 * i];
          if (v > best) { best = v; bi = half + 2 * i; }
        }
        const float ov = __shfl_xor(best, 1, 64);
        const int oi = __shfl_xor(bi, 1, 64);
        if (ov > best || (ov == best && oi < bi)) { best = ov; bi = oi; }
        if ((bi & 1) == half) Lr[bi] = -INFINITY;
        if (half == 0) { p.topv[ob + r] = best; p.topi[ob + r] = bi; }
      }
    }
    __syncthreads();
  }
}

__device__ __forceinline__ void cand_ij(int lane, int& ci, int& cj) {
  int i = 0, rem = lane;
#pragma unroll
  for (int r = 0; r < 16; r++) {
    const int cnt = 16 / (r + 1);
    if (i == r && rem >= cnt) { rem -= cnt; i = r + 1; }
  }
  ci = i; cj = rem;
}

typedef __attribute__((ext_vector_type(2))) __bf16 bf2_t;
__device__ __forceinline__ float dot2bf(unsigned a, unsigned b, float c) {
  return __builtin_amdgcn_fdot2_f32_bf16(__builtin_bit_cast(bf2_t, a), __builtin_bit_cast(bf2_t, b), c, false);
}
template <int CTRL, int RM>
__device__ __forceinline__ float dppf_m(float x) {
  return __int_as_float(__builtin_amdgcn_update_dpp(0, __float_as_int(x), CTRL, RM, 0xf, false));
}
__device__ __forceinline__ float wave_sum_l63(float x) {
  x += dppf<0xB1>(x);
  x += dppf<0x4E>(x);
  x += dppf<0x141>(x);
  x += dppf<0x140>(x);
  x += dppf_m<0x142, 0xA>(x);
  x += dppf_m<0x143, 0xC>(x);
  return x;
}
__device__ __forceinline__ float readlane_f(float x, int l) {
  return __int_as_float(__builtin_amdgcn_readlane(__float_as_int(x), l));
}
__device__ __forceinline__ void axpy8(float* acc, float w, uint4 v) {
  acc[0] += w * bflo(v.x); acc[1] += w * bfhi(v.x); acc[2] += w * bflo(v.y); acc[3] += w * bfhi(v.y);
  acc[4] += w * bflo(v.z); acc[5] += w * bfhi(v.z); acc[6] += w * bflo(v.w); acc[7] += w * bfhi(v.w);
}

typedef float f2_t __attribute__((ext_vector_type(2)));
__device__ __forceinline__ void fp8x16_to_f32(const uint4 v, float* o) {
  const unsigned w[4] = {v.x, v.y, v.z, v.w};
#pragma unroll
  for (int i = 0; i < 4; i++) {
    const f2_t lo = __builtin_amdgcn_cvt_pk_f32_fp8((int)w[i], false);
    const f2_t hi = __builtin_amdgcn_cvt_pk_f32_fp8((int)w[i], true);
    o[4 * i] = lo.x; o[4 * i + 1] = lo.y; o[4 * i + 2] = hi.x; o[4 * i + 3] = hi.y;
  }
}

__device__ void phase10(const P& p, int bid, int nb) {
  const int lane = TIDX & 63, wid = TIDX >> 6;
  int ci, cj; cand_ij(lane < 50 ? lane : 0, ci, cj);
  const unsigned char* ub8 = (const unsigned char*)p.ub;
  const unsigned char* vb8 = (const unsigned char*)p.vb;
  for (int it = bid; it < NT / 4; it += nb) {
    const int n = it * 4 + wid;
    int seq, t, T; tok2seq(n, seq, t, T);
    float xv[16];
    {
      const uint4 a = *(const uint4*)(p.xn + (size_t)n * D + lane * 16), b = *(const uint4*)(p.xn + (size_t)n * D + lane * 16 + 8);
      const unsigned as[4] = {a.x, a.y, a.z, a.w}, bs[4] = {b.x, b.y, b.z, b.w};
#pragma unroll
      for (int e = 0; e < 4; e++) { xv[2 * e] = bflo(as[e]); xv[2 * e + 1] = bfhi(as[e]); xv[8 + 2 * e] = bflo(bs[e]); xv[8 + 2 * e + 1] = bfhi(bs[e]); }
    }
    float acc[16];
#pragma unroll
    for (int e = 0; e < 16; e++) acc[e] = 0.f;
#pragma unroll 1
    for (int h = 0; h < 8; h++) {
      const size_t base = ((size_t)n * 16 + h * 2) * 16;
      float cand = -INFINITY; int eid = 0;
      if (lane < 50) {
        cand = p.topv[base + ci] + p.topv[base + 16 + cj];
        eid = p.topi[base + ci] * 128 + p.topi[base + 16 + cj];
      }
      int rank = 0;
#pragma unroll
      for (int m = 0; m < 50; m++) {
        const float cm = readlane_f(cand, m);
        rank += ((cm > cand) || (cm == cand && m < lane)) ? 1 : 0;
      }
      const bool sel = (lane < 50) && (rank < 16);
      unsigned long long mask = __ballot(sel);
      const float mx = readlane_f(cand, __builtin_ctzll(__ballot(sel && rank == 0)));
      const float ex = sel ? __expf(cand - mx) : 0.f;
      const float den = readlane_f(wave_sum_l63(ex), 63);
      const float gate = ex / den;
#pragma unroll 1
      for (int hf = 0; hf < 2; hf++) {
        int ek[8]; float gk[8];
#pragma unroll
        for (int k = 0; k < 8; k++) {
          const int src = __builtin_ctzll(mask);
          mask &= mask - 1;
          ek[k] = __builtin_amdgcn_readlane(eid, src);
          gk[k] = readlane_f(gate, src);
        }
        uint4 uu[8], vv[8];
#pragma unroll
        for (int j = 0; j < 8; j++) uu[j] = *(const uint4*)(ub8 + (size_t)ek[j] * D + lane * 16);
#pragma unroll
        for (int j = 0; j < 8; j++) vv[j] = *(const uint4*)(vb8 + (size_t)ek[j] * D + lane * 16);
        float dv = 0.f;
#pragma unroll
        for (int j = 0; j < 8; j++) {
          float uf[16];
          fp8x16_to_f32(uu[j], uf);
          float d0 = 0.f, d1 = 0.f;
#pragma unroll
          for (int e = 0; e < 8; e++) { d0 += uf[2 * e] * xv[2 * e]; d1 += uf[2 * e + 1] * xv[2 * e + 1]; }
          const float ds = readlane_f(wave_sum_l63(d0 + d1), 63);
          dv = (lane == j) ? ds : dv;
        }
        dv *= (1.f / U_SCALE);
        const float act = 0.5f * dv * (1.f + erff(dv * 0.70710678118654752f));
#pragma unroll
        for (int j = 0; j < 8; j++) {
          const float w = readlane_f(act, j) * gk[j] * (1.f / V_SCALE);
          float vf[16];
          fp8x16_to_f32(vv[j], vf);
#pragma unroll
          for (int e = 0; e < 16; e++) acc[e] += w * vf[e];
        }
      }
    }
    float* yr = p.out + O_Y + (size_t)n * D + lane * 16;
    const float* md = p.mod + (size_t)seq * 8192 + lane * 16;
    float x2[16];
    float ss = 0.f;
#pragma unroll
    for (int q4 = 0; q4 < 4; q4++) {
      const float4 a = *(const float4*)(yr + q4 * 4), g = *(const float4*)(md + 5120 + q4 * 4);
      x2[q4 * 4 + 0] = a.x + g.x * acc[q4 * 4 + 0]; x2[q4 * 4 + 1] = a.y + g.y * acc[q4 * 4 + 1];
      x2[q4 * 4 + 2] = a.z + g.z * acc[q4 * 4 + 2]; x2[q4 * 4 + 3] = a.w + g.w * acc[q4 * 4 + 3];
    }
#pragma unroll
    for (int e = 0; e < 16; e++) ss += x2[e] * x2[e];
    ss = readlane_f(wave_sum_l63(ss), 63);
    const float rstd = rsqrtf(ss * (1.f / 1024.f) + 1e-6f);
#pragma unroll
    for (int q4 = 0; q4 < 4; q4++) {
      const float4 fg = *(const float4*)(p.final_g + lane * 16 + q4 * 4), sc = *(const float4*)(md + 7168 + q4 * 4),
                   sh = *(const float4*)(md + 6144 + q4 * 4);
      float4 o;
      o.x = x2[q4 * 4 + 0] * rstd * fg.x * (1.f + sc.x) + sh.x;
      o.y = x2[q4 * 4 + 1] * rstd * fg.y * (1.f + sc.y) + sh.y;
      o.z = x2[q4 * 4 + 2] * rstd * fg.z * (1.f + sc.z) + sh.z;
      o.w = x2[q4 * 4 + 3] * rstd * fg.w * (1.f + sc.w) + sh.w;
      *(float4*)(yr + q4 * 4) = o;
    }
  }
}

#define XB_XCNT(j) (256 + 64 * (j))
#define XB_XSUB(j) (1280 + 64 * (j))
#define XB_XGEN(j) (2304 + 64 * (j))
#define XB_TOP 3328
#define XB_TOPGEN 3392
#define XB_WORDS 4096
__device__ __forceinline__ unsigned xb_ld(unsigned* p) { return __hip_atomic_load(p, __ATOMIC_RELAXED, __HIP_MEMORY_SCOPE_AGENT); }
__device__ __forceinline__ unsigned xb_add(unsigned* p, unsigned v) { return __hip_atomic_fetch_add(p, v, __ATOMIC_RELAXED, __HIP_MEMORY_SCOPE_AGENT); }
__device__ __forceinline__ unsigned xb_xcc_id() { return (unsigned)__builtin_amdgcn_s_getreg((3 << 11) | 20) & 0xFu; }
__device__ __forceinline__ void grid_barrier(unsigned* bar, volatile unsigned* xst) {
  asm volatile("s_waitcnt vmcnt(0)" ::: "memory");
  __syncthreads();
  if (TIDX == 0) {
    __builtin_amdgcn_s_waitcnt(0);
    const unsigned x = xst[0], nloc = xst[1], nx = xst[2];
    const unsigned old = xb_add(&bar[XB_XSUB(x)], 1u);
    const unsigned gen = old / nloc;
    if (old + 1u == (gen + 1u) * nloc) {
      __builtin_amdgcn_fence(__ATOMIC_RELEASE, "agent");
      asm volatile("s_waitcnt vmcnt(0)" ::: "memory");
      const unsigned og = xb_add(&bar[XB_TOP], 1u);
      const unsigned tg = og / nx;
      if (og + 1u == (tg + 1u) * nx) xb_add(&bar[XB_TOPGEN], 1u);
      else while (xb_ld(&bar[XB_TOPGEN]) == tg) __builtin_amdgcn_s_sleep(1);
      __builtin_amdgcn_fence(__ATOMIC_ACQUIRE, "agent");
      xb_add(&bar[XB_XGEN(x)], 1u);
      asm volatile("s_waitcnt vmcnt(0)" ::: "memory");
    } else {
      while (xb_ld(&bar[XB_XGEN(x)]) == gen) __builtin_amdgcn_s_sleep(1);
      __builtin_amdgcn_fence(__ATOMIC_ACQUIRE, "agent");
      asm volatile("s_waitcnt vmcnt(0)" ::: "memory");
    }
  }
  __syncthreads();
}

template <int PH>
__device__ __forceinline__ void run_phase(const P& p, int bid, int nb, char* smem) {
  if constexpr (PH == 0) phase0(p, bid, nb, smem);
  if constexpr (PH == 1) phase_norm<false>(p, bid, nb);
  if constexpr (PH == 2) phase2(p, bid, nb, smem);
  if constexpr (PH == 3) phase3(p, bid, nb, smem);
  if constexpr (PH == 4) phase4(p, bid, nb, smem);
  if constexpr (PH == 5) phase5(p, bid, nb);
  if constexpr (PH == 6) phase6(p, bid, nb, smem);
  if constexpr (PH == 7) phase7(p, bid, nb, smem);
  if constexpr (PH == 8) phase_norm<true>(p, bid, nb);
  if constexpr (PH == 9) phase9(p, bid, nb, smem);
  if constexpr (PH == 10) phase10(p, bid, nb);
  if constexpr (PH == 11) phase3b(p, bid, nb, smem);
}

template <int PH>
__global__ void __launch_bounds__(NTHREADS, 2) k_phase(P p) {
  extern __shared__ __attribute__((aligned(16))) char smem[];
  run_phase<PH>(p, blockIdx.x, gridDim.x, smem);
}

#if MEGA
__global__ void __launch_bounds__(NTHREADS, 2) k_mega(P p) {
  extern __shared__ __attribute__((aligned(16))) char smem[];
  cg::grid_group grid = cg::this_grid();
  const int bid = blockIdx.x, nb = gridDim.x;
#ifndef PROBE_ALL2
#define PROBE_ALL2 0
#endif
#ifndef PROBE_MASK
#define PROBE_MASK 0
#endif
#ifndef PROBE_SYNCS
#define PROBE_SYNCS 0
#endif
  volatile unsigned* xst = (volatile unsigned*)(smem + LDS_BYTES - 16);
  if (TIDX == 0) { const unsigned xcc0 = xb_xcc_id(); xst[0] = xcc0; xb_add(&p.bar[XB_XCNT(xcc0)], 1u); }
#define GSYNC(k)                                                                                 \
  {                                                                                              \
    if ((k) == 0) {                                                                              \
      grid.sync();                                                                               \
      if (TIDX == 0) {                                                                    \
        unsigned cnt = 0;                                                                        \
        for (unsigned j = 0; j < 16; ++j) cnt += xb_ld(&p.bar[XB_XCNT(j)]) > 0u ? 1u : 0u;       \
        xst[2] = cnt; xst[1] = xb_ld(&p.bar[XB_XCNT(xst[0])]);                                   \
      }                                                                                          \
    } else grid_barrier(p.bar, xst);                                                             \
  }
#define RUNPH(k)                                                       \
  run_phase<k>(p, bid, nb, smem); GSYNC(k)                             \
  if (PROBE_MASK & (1 << k)) { run_phase<k>(p, bid, nb, smem); GSYNC(1) }
#pragma unroll 1
  for (int rep = 0; rep < 1 + PROBE_ALL2; rep++) {
    RUNPH(0)
#pragma unroll 1
    for (int i = 0; i < PROBE_SYNCS; i++) GSYNC(1)
    RUNPH(1) RUNPH(2) RUNPH(3) RUNPH(11) RUNPH(4) RUNPH(5) RUNPH(6) RUNPH(7) RUNPH(8) RUNPH(9)
  }
  run_phase<10>(p, bid, nb, smem);
}
#endif

template <int PH>
static void launch_phase(const P& p, int grid, hipStream_t stream) {
  static bool attr = false;
  if (!attr) { hipFuncSetAttribute((const void*)k_phase<PH>, hipFuncAttributeMaxDynamicSharedMemorySize, LDS_BYTES); attr = true; }
  hipLaunchKernelGGL(k_phase<PH>, dim3(grid), dim3(NTHREADS), LDS_BYTES, stream, p);
}

extern "C" void kernel_launch(void* const* d_in, const int* in_sizes, int n_in, void* d_out, int out_size, void* d_ws,
                              size_t ws_size, hipStream_t stream) {
  P p{};
  const float** fp = (const float**)&p;
  for (int i = 0; i < 40; i++) fp[i] = (const float*)d_in[i];
  p.out = (float*)d_out;
  char* ws = (char*)d_ws;
  size_t off = 0;
  auto take = [&](size_t bytes) { char* r = ws + off; off += (bytes + 255) & ~(size_t)255; return r; };
  p.bar = (unsigned*)take(XB_WORDS * 4);
  p.w_inT = (u16*)take((size_t)INCOLS * D * 2);
  p.w_paT = (u16*)take((size_t)1024 * 512 * 2);
  p.w_pbT = (u16*)take((size_t)1024 * 1024 * 2);
  p.w_outT = (u16*)take((size_t)1024 * 1024 * 2);
  p.wqT = (u16*)take((size_t)2048 * 1024 * 2);
  p.keysb = (u16*)take((size_t)262144 * 2);
  p.mod = (float*)take((size_t)NSEQ * 8192 * 4);
  p.dtb = (float*)take((size_t)NT * 16 * 4);
  p.decb = (float*)take((size_t)NT * 16 * 4);
  p.xn = (u16*)take((size_t)NROWS * D * 2);
  p.proj = (u16*)take((size_t)NROWS * PCOLS * 2);
  p.prep = (u16*)take((size_t)NT * 3584 * 2);
  p.w2T = (u16*)take(512 * 64 * 2);
  p.a2T = (u16*)take(512 * 64 * 2);
  p.g2T = (u16*)take(512 * 128 * 2);
  p.lora = (u16*)take((size_t)NT * 256 * 2);
  if (off > ws_size) { fprintf(stderr, "workspace too small: need %zu have %zu\n", off, ws_size); return; }
  p.merged = p.prep;
  p.ub = p.proj;
  p.vb = p.proj + (size_t)16384 * 1024;
  p.topv = (float*)(p.proj + (size_t)2 * 16384 * 1024);
  p.topi = (int*)(p.topv + (size_t)NT * 256);
  p.xc = (u16*)d_out;
  p.oa = (u16*)d_out;
  p.ob = (u16*)d_out + (size_t)NT * 512;

  static int grid = 0;
  if (!grid) {
    int dev = 0, cus = 0, per_cu = 0;
    hipGetDevice(&dev);
    hipDeviceGetAttribute(&cus, hipDeviceAttributeMultiprocessorCount, dev);
#if MEGA
    hipFuncSetAttribute((const void*)k_mega, hipFuncAttributeMaxDynamicSharedMemorySize, LDS_BYTES);
    hipOccupancyMaxActiveBlocksPerMultiprocessor(&per_cu, k_mega, NTHREADS, LDS_BYTES);
    if (per_cu > 2) per_cu = 2;
#else
    per_cu = 2;
#endif
    if (per_cu < 1) per_cu = 1;
    grid = cus * per_cu;
  }
  hipMemsetAsync(p.mod, 0, (size_t)NSEQ * 8192 * 4, stream);
#if MEGA
  hipMemsetAsync(p.bar, 0, XB_WORDS * 4, stream);
  void* args[] = {&p};
  hipError_t e = hipLaunchCooperativeKernel((void*)k_mega, dim3(grid), dim3(NTHREADS), args, LDS_BYTES, stream);
  if (e != hipSuccess) fprintf(stderr, "cooperative launch failed: %s (grid %d)\n", hipGetErrorString(e), grid);
#else
  launch_phase<0>(p, grid, stream);
  launch_phase<1>(p, grid, stream);
  launch_phase<2>(p, grid, stream);
  launch_phase<3>(p, grid, stream);
  launch_phase<11>(p, grid, stream);
  launch_phase<4>(p, grid, stream);
  launch_phase<5>(p, grid, stream);
  launch_phase<6>(p, grid, stream);
  launch_phase<7>(p, grid, stream);
  launch_phase<8>(p, grid, stream);
  launch_phase<9>(p, grid, stream);
  launch_phase<10>(p, grid, stream);
#endif
}
```

```cpp
#include <hip/hip_runtime.h>
#include <hip/hip_cooperative_groups.h>
#include <cstdio>
namespace cg = cooperative_groups;

#ifndef MEGA
#define MEGA 1
#endif

typedef unsigned short u16;
typedef __attribute__((ext_vector_type(8))) short bf16x8;
typedef __attribute__((ext_vector_type(4))) float f32x4;

__device__ __forceinline__ int opaque_tid() { int t = threadIdx.x; asm volatile("" : "+v"(t)); return t; }
#define TIDX opaque_tid()

constexpr int D = 1024;
constexpr int NP = 16384, NS = 1024, NT = NP + NS, NSEQ = 136;
constexpr int NROWS = NT + 128;
constexpr int PCOLS = 4368;
constexpr int INCOLS = 6416;
constexpr int C_LW = 1536, C_LA = 1600, C_LG = 1664, C_Z = 1792, C_XBC = 2816, C_DT = 4352;
constexpr int G_A = 4368, G_B = 5392;
constexpr size_t O_Y = 0, O_PSHIFT = 17825792, O_PWKV = 17833984, O_PCONV = 18096128, O_PSSM = 18132992,
                 O_SSHIFT = 19181568, O_SWKV = 19312640, O_SCONV = 23506944, O_SSSM = 24096768;
constexpr int LDS_BYTES = 80 * 1024;
constexpr int NTHREADS = 256;

struct P {
  const float *x_prompt, *x_sample, *c_prompt, *c_sample, *state_shift, *state_wkv, *state_conv, *state_ssm;
  const float *w_ada, *b_ada, *norm1_g, *w_in, *rw_mu, *rw_w0, *rw_w2, *rw_a0, *rw_a2, *rw_g2, *rw_k_k, *rw_k_a,
      *rw_r_k, *rw_ln_w, *rw_ln_b;
  const float *conv_w, *conv_b, *dt_bias, *A_log, *D_skip, *ssm_norm_w, *w_pa, *w_pb, *w_out, *norm2_g, *peer_wq,
      *peer_keys, *peer_u, *peer_v, *final_g, *w_ada_f, *b_ada_f;
  float* out;
  u16 *w_inT, *w_paT, *w_pbT, *w_outT, *wqT, *keysb, *xn, *proj, *prep, *merged, *ub, *vb, *xc, *oa, *ob;
  u16 *w2T, *a2T, *g2T, *lora;
  float *mod, *dtb, *decb, *topv;
  int* topi;
  unsigned* bar;
};

__device__ __forceinline__ u16 f2bf(float f) {
  unsigned u = __float_as_uint(f);
  u += 0x7fffu + ((u >> 16) & 1u);
  return (u16)(u >> 16);
}
__device__ __forceinline__ float bf2f(u16 h) { return __uint_as_float(((unsigned)h) << 16); }
__device__ __forceinline__ unsigned pack2(float a, float b) { return (unsigned)f2bf(a) | ((unsigned)f2bf(b) << 16); }
__device__ __forceinline__ float bflo(unsigned u) { return __uint_as_float(u << 16); }
__device__ __forceinline__ float bfhi(unsigned u) { return __uint_as_float(u & 0xffff0000u); }
__device__ __forceinline__ float sigmoidf_(float x) { return 1.f / (1.f + __expf(-x)); }
__device__ __forceinline__ float siluf_(float x) { return x / (1.f + __expf(-x)); }
__device__ __forceinline__ float softplusf_(float x) { return x > 20.f ? x : log1pf(expf(x)); }

template <int CTRL>
__device__ __forceinline__ float dppf(float x) {
  return __int_as_float(__builtin_amdgcn_update_dpp(0, __float_as_int(x), CTRL, 0xf, 0xf, true));
}
__device__ __forceinline__ float allreduce16(float x) {
  x += dppf<0x128>(x);
  x += dppf<0x124>(x);
  x += dppf<0x122>(x);
  x += dppf<0x121>(x);
  return x;
}
__device__ __forceinline__ float allreduce8(float x) {
  x += dppf<0xB1>(x);
  x += dppf<0x4E>(x);
  x += dppf<0x141>(x);
  return x;
}
__device__ __forceinline__ float wave_sum(float x) {
#pragma unroll
  for (int o = 32; o >= 1; o >>= 1) x += __shfl_xor(x, o, 64);
  return x;
}
__device__ __forceinline__ float wave_max(float x) {
#pragma unroll
  for (int o = 32; o >= 1; o >>= 1) x = fmaxf(x, __shfl_xor(x, o, 64));
  return x;
}
__device__ __forceinline__ int wave_min_i(int x) {
#pragma unroll
  for (int o = 32; o >= 1; o >>= 1) x = min(x, __shfl_xor(x, o, 64));
  return x;
}

__device__ __forceinline__ const float* xrow(const P& p, int n) {
  return n < NP ? p.x_prompt + (size_t)n * D : p.x_sample + (size_t)(n - NP) * D;
}
__device__ __forceinline__ void tok2seq(int n, int& seq, int& t, int& T) {
  if (n < NP) { seq = n >> 11; t = n & 2047; T = 2048; }
  else { int m = n - NP; seq = 8 + (m >> 3); t = m & 7; T = 8; }
}
__device__ __forceinline__ float* seq_out(float* out, int seq, size_t op, size_t os, size_t per) {
  return seq < 8 ? out + op + (size_t)seq * per : out + os + (size_t)(seq - 8) * per;
}

constexpr int LROW = 144;
template <bool DEEP = true>
__device__ __forceinline__ void gemm_tile(const u16* __restrict__ A, int lda, int m0, const u16* __restrict__ Bt,
                                          int ldb, int n0, int K, f32x4 (&acc)[4][4], char* smem) {
  char* sA = smem;
  char* sB = smem + 128 * LROW;
  const int tid = TIDX, lane = tid & 63, wid = tid >> 6, wr = wid >> 1, wc = wid & 1, fr = lane & 15,
            fq = lane >> 4;
  uint4 ra0, ra1, ra2, ra3, rb0, rb1, rb2, rb3;
  uint4 sa0, sa1, sa2, sa3, sb0, sb1, sb2, sb3;
  const int nk = K / 64;
  const int lrow = tid >> 3, lch = tid & 7;
  const u16* gA = A + (size_t)(m0 + lrow) * lda + lch * 8;
  const u16* gB = Bt + (size_t)(n0 + lrow) * ldb + lch * 8;
#define GLOAD(x0, x1, x2, x3, y0, y1, y2, y3, kt)                   \
  {                                                                 \
    x0 = *(const uint4*)(gA + (kt) * 64);                           \
    x1 = *(const uint4*)(gA + (size_t)32 * lda + (kt) * 64);        \
    x2 = *(const uint4*)(gA + (size_t)64 * lda + (kt) * 64);        \
    x3 = *(const uint4*)(gA + (size_t)96 * lda + (kt) * 64);        \
    y0 = *(const uint4*)(gB + (kt) * 64);                           \
    y1 = *(const uint4*)(gB + (size_t)32 * ldb + (kt) * 64);        \
    y2 = *(const uint4*)(gB + (size_t)64 * ldb + (kt) * 64);        \
    y3 = *(const uint4*)(gB + (size_t)96 * ldb + (kt) * 64);        \
  }
#define LSTORE(x0, x1, x2, x3, y0, y1, y2, y3)                      \
  {                                                                 \
    char* wa = sA + lrow * LROW + lch * 16;                         \
    char* wb = sB + lrow * LROW + lch * 16;                         \
    *(uint4*)(wa) = x0; *(uint4*)(wa + 32 * LROW) = x1; *(uint4*)(wa + 64 * LROW) = x2; *(uint4*)(wa + 96 * LROW) = x3; \
    *(uint4*)(wb) = y0; *(uint4*)(wb + 32 * LROW) = y1; *(uint4*)(wb + 64 * LROW) = y2; *(uint4*)(wb + 96 * LROW) = y3; \
  }
#define COMPUTE_TILE()                                                                                                   \
  {                                                                                                                      \
    _Pragma("unroll") for (int s = 0; s < 2; s++) {                                                                      \
      bf16x8 af[4], bfr[4];                                                                                              \
      _Pragma("unroll") for (int m = 0; m < 4; m++) af[m] = *(const bf16x8*)(sA + (wr * 64 + m * 16 + fr) * LROW + s * 64 + fq * 16); \
      _Pragma("unroll") for (int n = 0; n < 4; n++) bfr[n] = *(const bf16x8*)(sB + (wc * 64 + n * 16 + fr) * LROW + s * 64 + fq * 16); \
      _Pragma("unroll") for (int m = 0; m < 4; m++)                                                                      \
        _Pragma("unroll") for (int n = 0; n < 4; n++) acc[m][n] = __builtin_amdgcn_mfma_f32_16x16x32_bf16(af[m], bfr[n], acc[m][n], 0, 0, 0); \
    }                                                                                                                    \
  }
  GLOAD(ra0, ra1, ra2, ra3, rb0, rb1, rb2, rb3, 0);
  if constexpr (DEEP) {
    GLOAD(sa0, sa1, sa2, sa3, sb0, sb1, sb2, sb3, 1);
#pragma unroll 1
    for (int kt = 0; kt < nk; kt += 2) {
      __syncthreads();
      LSTORE(ra0, ra1, ra2, ra3, rb0, rb1, rb2, rb3);
      __syncthreads();
      if (kt + 2 < nk) GLOAD(ra0, ra1, ra2, ra3, rb0, rb1, rb2, rb3, kt + 2);
      COMPUTE_TILE();
      __syncthreads();
      LSTORE(sa0, sa1, sa2, sa3, sb0, sb1, sb2, sb3);
      __syncthreads();
      if (kt + 3 < nk) GLOAD(sa0, sa1, sa2, sa3, sb0, sb1, sb2, sb3, kt + 3);
      COMPUTE_TILE();
    }
  } else {
#pragma unroll 1
    for (int kt = 0; kt < nk; kt++) {
      __syncthreads();
      LSTORE(ra0, ra1, ra2, ra3, rb0, rb1, rb2, rb3);
      __syncthreads();
      if (kt + 1 < nk) GLOAD(ra0, ra1, ra2, ra3, rb0, rb1, rb2, rb3, kt + 1);
      COMPUTE_TILE();
    }
  }
  __syncthreads();
}
__device__ __forceinline__ void zero_acc(f32x4 (&acc)[4][4]) {
#pragma unroll
  for (int m = 0; m < 4; m++)
#pragma unroll
    for (int n = 0; n < 4; n++) acc[m][n] = f32x4{0.f, 0.f, 0.f, 0.f};
}
#define ACC_FOREACH(...)                                                                    \
  {                                                                                         \
    const int _l = TIDX & 63, _w = TIDX >> 6, _wr = _w >> 1, _wc = _w & 1;    \
    const int _fr = _l & 15, _fq = _l >> 4;                                                 \
    _Pragma("unroll") for (int m = 0; m < 4; m++) _Pragma("unroll") for (int n = 0; n < 4; n++) \
        _Pragma("unroll") for (int j = 0; j < 4; j++) {                                     \
      const int row = _wr * 64 + m * 16 + _fq * 4 + j, col = _wc * 64 + n * 16 + _fr;       \
      __VA_ARGS__                                                                           \
    }                                                                                       \
  }

struct TileIter {
  int x, lb, nbx, tpx, total, MT, NT, r;
  __device__ __forceinline__ TileIter(int bid, int nb, int MT_, int NT_) : MT(MT_), NT(NT_), r(0) {
    total = MT * NT; x = bid & 7; lb = bid >> 3; nbx = nb >> 3; tpx = (total + 7) >> 3;
  }
  __device__ __forceinline__ bool next(int& mt, int& nt) {
    const int idx = lb + r * nbx;
    r++;
    if (idx >= tpx) return false;
    const int lin = x * tpx + idx;
    if (lin >= total) return false;
    const int bsz = 8 * NT, band = lin / bsz, rem = lin - band * bsz;
    const int mb = min(8, MT - band * 8);
    nt = rem / mb; mt = band * 8 + (rem - nt * mb);
    return true;
  }
};

__device__ void transpose_tile(const float* __restrict__ src, int K, int N, u16* __restrict__ dst, int tile,
                               char* smem) {
  const int ntn = (N + 63) / 64, kt = tile / ntn, nt = tile % ntn, tid = TIDX;
  float(*s)[65] = (float(*)[65])smem;
  __syncthreads();
#pragma unroll 4
  for (int i = 0; i < 16; i++) {
    int r = (tid >> 6) + 4 * i, n = nt * 64 + (tid & 63);
    s[r][tid & 63] = (n < N) ? src[(size_t)(kt * 64 + r) * N + n] : 0.f;
  }
  __syncthreads();
#pragma unroll 4
  for (int i = 0; i < 8; i++) {
    int nl = (tid >> 5) + 8 * i, n = nt * 64 + nl, kl = (tid & 31) * 2;
    if (n < N) *(unsigned*)(dst + (size_t)n * K + kt * 64 + kl) = pack2(s[kl][nl], s[kl + 1][nl]);
  }
}

__device__ void mod_item(const P& p, int item2, char* smem) {
  const int item = item2 >> 1, kh2 = item2 & 1;
  const int tid = TIDX, j = tid & 31, g = tid >> 5;
  const int col0 = item * 32;
  const float* W; const float* bias; int N, cw;
  if (col0 < 6144) { W = p.w_ada; bias = p.b_ada; N = 6144; cw = col0; }
  else { W = p.w_ada_f; bias = p.b_ada_f; N = 2048; cw = col0 - 6144; }
  float(*cs)[68] = (float(*)[68])smem;
  float acc[17];
#pragma unroll
  for (int s = 0; s < 17; s++) acc[s] = 0.f;
  for (int k0 = kh2 * 512; k0 < kh2 * 512 + 512; k0 += 64) {
    __syncthreads();
    {
      float cv[34];
#pragma unroll
      for (int i = 0; i < 34; i++) {
        const int idx = tid + i * 256, seq = idx >> 6, kk = idx & 63;
        cv[i] = seq < 8 ? p.c_prompt[seq * 1024 + k0 + kk] : p.c_sample[(seq - 8) * 1024 + k0 + kk];
      }
#pragma unroll
      for (int i = 0; i < 34; i++) {
        const int idx = tid + i * 256;
        cs[idx >> 6][idx & 63] = siluf_(cv[i]);
      }
    }
    __syncthreads();
#pragma unroll 1
    for (int kh = 0; kh < 2; kh++) {
      float wv[32];
#pragma unroll
      for (int k = 0; k < 32; k++) wv[k] = W[(size_t)(k0 + kh * 32 + k) * N + cw + j];
#pragma unroll 2
      for (int k4 = 0; k4 < 8; k4++) {
#pragma unroll
        for (int s = 0; s < 17; s++) {
          float4 c4 = *(const float4*)&cs[g * 17 + s][kh * 32 + k4 * 4];
          acc[s] += wv[k4 * 4] * c4.x + wv[k4 * 4 + 1] * c4.y + wv[k4 * 4 + 2] * c4.z + wv[k4 * 4 + 3] * c4.w;
        }
      }
    }
  }
  const float b = kh2 == 0 ? bias[cw + j] : 0.f;
#pragma unroll
  for (int s = 0; s < 17; s++) atomicAdd(&p.mod[(size_t)(g * 17 + s) * 8192 + col0 + j], acc[s] + b);
}

constexpr int J_MOD = 512, J_WIN = 16 * 101, J_WPA = 8 * 16, J_WPB = 256, J_WOUT = 256, J_WQ = 16 * 32, J_KEYS = 128,
              J_SHIFT = 64;
constexpr int J_LORA = 8 + 8 + 16;
constexpr int PH0_ITEMS = J_MOD + J_WIN + J_WPA + J_WPB + J_WOUT + J_WQ + J_LORA + J_KEYS + J_SHIFT;

__device__ void phase0(const P& p, int bid, int nb, char* smem) {
  for (int it = bid; it < PH0_ITEMS; it += nb) {
    int i = it;
    if (i < J_MOD) { mod_item(p, i, smem); continue; }
    i -= J_MOD;
    if (i < J_WIN) { transpose_tile(p.w_in, 1024, INCOLS, p.w_inT, i, smem); continue; }
    i -= J_WIN;
    if (i < J_WPA) { transpose_tile(p.w_pa, 512, 1024, p.w_paT, i, smem); continue; }
    i -= J_WPA;
    if (i < J_WPB) { transpose_tile(p.w_pb, 1024, 1024, p.w_pbT, i, smem); continue; }
    i -= J_WPB;
    if (i < J_WOUT) { transpose_tile(p.w_out, 1024, 1024, p.w_outT, i, smem); continue; }
    i -= J_WOUT;
    if (i < J_WQ) { transpose_tile(p.peer_wq, 1024, 2048, p.wqT, i, smem); continue; }
    i -= J_WQ;
    if (i < 8) { transpose_tile(p.rw_w2, 64, 512, p.w2T, i, smem); continue; }
    if (i < 16) { transpose_tile(p.rw_a2, 64, 512, p.a2T, i - 8, smem); continue; }
    if (i < 32) { transpose_tile(p.rw_g2, 128, 512, p.g2T, i - 16, smem); continue; }
    i -= J_LORA;
    const float* src; u16* dst;
    if (i < J_KEYS) { src = p.peer_keys + (size_t)i * 2048; dst = p.keysb + (size_t)i * 2048; }
    else { i -= J_KEYS; src = p.state_shift + (size_t)i * 2048; dst = p.xn + (size_t)NT * D + (size_t)i * 2048; }
    const float4* s4 = (const float4*)src + TIDX * 2;
    float4 a = s4[0], b = s4[1];
    uint4 o; o.x = pack2(a.x, a.y); o.y = pack2(a.z, a.w); o.z = pack2(b.x, b.y); o.w = pack2(b.z, b.w);
    *((uint4*)dst + TIDX) = o;
  }
}

template <bool SECOND>
__device__ void phase_norm(const P& p, int bid, int nb) {
  const int lane = TIDX & 63, wid = TIDX >> 6;
  const float* gam = SECOND ? p.norm2_g : p.norm1_g;
  for (int it = bid; it < NT / 4; it += nb) {
    const int n = it * 4 + wid;
    int seq, t, T; tok2seq(n, seq, t, T);
    const float* xr = SECOND ? p.out + O_Y + (size_t)n * D : xrow(p, n);
    const float* md = p.mod + (size_t)seq * 8192 + (SECOND ? 3072 : 0);
    float4 v[4];
    float ss = 0.f;
#pragma unroll
    for (int i = 0; i < 4; i++) {
      v[i] = ((const float4*)xr)[lane + 64 * i];
      ss += v[i].x * v[i].x + v[i].y * v[i].y + v[i].z * v[i].z + v[i].w * v[i].w;
    }
    ss = wave_sum(ss);
    const float rstd = rsqrtf(ss * (1.f / 1024.f) + 1e-6f);
    const bool last = (!SECOND) && (t == T - 1);
    float* so = seq_out(p.out, seq, O_PSHIFT, O_SSHIFT, 1024);
#pragma unroll
    for (int i = 0; i < 4; i++) {
      const int c = (lane + 64 * i) * 4;
      float4 g = *(const float4*)(gam + c), sh = *(const float4*)(md + c), sc = *(const float4*)(md + 1024 + c);
      float4 o;
      o.x = v[i].x * rstd * g.x * (1.f + sc.x) + sh.x;
      o.y = v[i].y * rstd * g.y * (1.f + sc.y) + sh.y;
      o.z = v[i].z * rstd * g.z * (1.f + sc.z) + sh.z;
      o.w = v[i].w * rstd * g.w * (1.f + sc.w) + sh.w;
      uint2 pk; pk.x = pack2(o.x, o.y); pk.y = pack2(o.z, o.w);
      *(uint2*)(p.xn + (size_t)n * D + c) = pk;
      if (last) *(float4*)(so + c) = o;
    }
  }
}

constexpr int P2_NT = 35, P2_MT = 137;
__device__ void phase2(const P& p, int bid, int nb, char* smem) {
  TileIter ti(bid, nb, P2_MT, P2_NT);
  int mt, nt;
  while (ti.next(mt, nt)) {
    f32x4 acc[4][4];
    zero_acc(acc);
    gemm_tile(p.xn, D, mt * 128, p.w_inT, D, nt * 128, D, acc, smem);
    ACC_FOREACH({
      const int gc = nt * 128 + col;
      if (gc < PCOLS) p.proj[(size_t)(mt * 128 + row) * PCOLS + gc] = f2bf(acc[m][n][j]);
    })
  }
}

__device__ void rwkv_lerp_item(const P& p, int item) {
  const int tid = TIDX;
  const int n0 = item * 8;
  int seq, t0, T; tok2seq(n0, seq, t0, T);
  uint4 pcv[7], ppv[7];
#pragma unroll
  for (int i = 0; i < 7; i++) {
    const int idx = tid + i * 256, tok = idx / 224, c = (idx % 224) * 8;
    const int n = n0 + tok, t = t0 + tok;
    pcv[i] = *(const uint4*)(p.proj + (size_t)n * PCOLS + c);
    const size_t prow = t > 0 ? (size_t)(n - 1) : (size_t)(NT + (seq >= 8 ? seq - 8 : 0));
    ppv[i] = *(const uint4*)(p.proj + prow * PCOLS + c);
    if (t == 0 && seq < 8) ppv[i] = make_uint4(0, 0, 0, 0);
  }
#pragma unroll
  for (int i = 0; i < 7; i++) {
    const int idx = tid + i * 256, tok = idx / 224, c = (idx % 224) * 8;
    const int n = n0 + tok;
    const float4 mu0 = *(const float4*)(p.rw_mu + c), mu1 = *(const float4*)(p.rw_mu + c + 4);
    const float mus[8] = {mu0.x, mu0.y, mu0.z, mu0.w, mu1.x, mu1.y, mu1.z, mu1.w};
    const unsigned pcs[4] = {pcv[i].x, pcv[i].y, pcv[i].z, pcv[i].w}, pps[4] = {ppv[i].x, ppv[i].y, ppv[i].z, ppv[i].w};
    unsigned o[4];
#pragma unroll
    for (int e = 0; e < 4; e++) {
      float a0 = bflo(pcs[e]), a1 = bfhi(pcs[e]), b0 = bflo(pps[e]), b1 = bfhi(pps[e]);
      float q0 = a0 + (b0 - a0) * mus[2 * e], q1 = a1 + (b1 - a1) * mus[2 * e + 1];
      if (c >= C_LW && c < C_LA) { q0 = tanhf(q0); q1 = tanhf(q1); }
      else if (c >= C_LG) { q0 = sigmoidf_(q0); q1 = sigmoidf_(q1); }
      o[e] = pack2(q0, q1);
    }
    u16* dst;
    if (c < 512) dst = p.prep + (size_t)n * 3584 + 512 + c;
    else if (c < 1024) dst = p.prep + (size_t)n * 3584 + 1024 + (c - 512);
    else if (c < 1536) dst = p.prep + (size_t)n * 3584 + 2560 + (c - 1024);
    else dst = p.lora + (size_t)n * 256 + (c - 1536);
    *(uint4*)dst = make_uint4(o[0], o[1], o[2], o[3]);
  }
}

__device__ void rwkv_lora_item(const P& p, int mt, int nt, char* smem) {
  const int tid = TIDX, lane = tid & 63, wid = tid >> 6, wr = wid >> 1, wc = wid & 1, fr = lane & 15, fq = lane >> 4;
  const int col0 = nt * 128;
  f32x4 acc[4][4];
  zero_acc(acc);
  gemm_tile<false>(p.lora, 256, mt * 128, p.w2T, 64, col0, 64, acc, smem);
  ACC_FOREACH({
    const int gc = col0 + col;
    const float wpre = p.rw_w0[gc] + acc[m][n][j];
    const float w = -softplusf_(-wpre) - 0.5f;
    p.prep[(size_t)(mt * 128 + row) * 3584 + gc] = f2bf(-expf(w));
  })
  zero_acc(acc);
  gemm_tile<false>(p.lora + 128, 256, mt * 128, p.g2T, 128, col0, 128, acc, smem);
  ACC_FOREACH({ p.prep[(size_t)(mt * 128 + row) * 3584 + 3072 + col0 + col] = f2bf(acc[m][n][j]); })
  zero_acc(acc);
  gemm_tile<false>(p.lora + 64, 256, mt * 128, p.a2T, 64, col0, 64, acc, smem);
  float a0c[4], kkc[4], kac[4];
#pragma unroll
  for (int n = 0; n < 4; n++) {
    const int gc = col0 + wc * 64 + n * 16 + fr;
    a0c[n] = p.rw_a0[gc]; kkc[n] = p.rw_k_k[gc]; kac[n] = p.rw_k_a[gc];
  }
#pragma unroll
  for (int m = 0; m < 4; m++)
#pragma unroll
    for (int j = 0; j < 4; j++) {
      const int row = mt * 128 + wr * 64 + m * 16 + fq * 4 + j;
      u16* pr = p.prep + (size_t)row * 3584 + col0 + wc * 64 + fr;
      float kx[4], kkv[4], av[4];
      float ss = 0.f;
#pragma unroll
      for (int n = 0; n < 4; n++) {
        kx[n] = bf2f(pr[1024 + n * 16]);
        av[n] = sigmoidf_(a0c[n] + acc[m][n][j]);
        kkv[n] = kx[n] * kkc[n];
        ss += kkv[n] * kkv[n];
      }
      ss = allreduce16(ss);
      const float inv = 1.f / fmaxf(sqrtf(ss), 1e-12f);
#pragma unroll
      for (int n = 0; n < 4; n++) {
        const float kk = kkv[n] * inv;
        pr[1024 + n * 16] = f2bf(kx[n] * (1.f + (av[n] - 1.f) * kac[n]));
        pr[1536 + n * 16] = f2bf(kk);
        pr[2048 + n * 16] = f2bf(kk * av[n]);
      }
    }
}

__device__ void conv_prep_item(const P& p, int item) {
  const int tid = TIDX;
  const int n0 = item * 8;
  int seq, t0, T; tok2seq(n0, seq, t0, T);
  if (tid < 192) {
    const int c = tid * 8;
    uint4 rows[11];
#pragma unroll
    for (int j = 0; j < 11; j++) {
      const int tt = t0 - 3 + j;
      rows[j] = make_uint4(0, 0, 0, 0);
      if (tt >= 0) rows[j] = *(const uint4*)(p.proj + (size_t)(n0 - 3 + j) * PCOLS + C_XBC + c);
      else if (seq >= 8) {
        const float* sc = p.state_conv + ((size_t)(seq - 8) * 3 + (tt + 3)) * 1536 + c;
        const float4 a = *(const float4*)sc, b = *(const float4*)(sc + 4);
        rows[j] = make_uint4(pack2(a.x, a.y), pack2(a.z, a.w), pack2(b.x, b.y), pack2(b.z, b.w));
      }
    }
    float w[4][8], cb[8];
#pragma unroll
    for (int j = 0; j < 4; j++) {
      const float4 a = *(const float4*)(p.conv_w + j * 1536 + c), b = *(const float4*)(p.conv_w + j * 1536 + c + 4);
      w[j][0] = a.x; w[j][1] = a.y; w[j][2] = a.z; w[j][3] = a.w; w[j][4] = b.x; w[j][5] = b.y; w[j][6] = b.z; w[j][7] = b.w;
    }
    {
      const float4 a = *(const float4*)(p.conv_b + c), b = *(const float4*)(p.conv_b + c + 4);
      cb[0] = a.x; cb[1] = a.y; cb[2] = a.z; cb[3] = a.w; cb[4] = b.x; cb[5] = b.y; cb[6] = b.z; cb[7] = b.w;
    }
#pragma unroll
    for (int k = 0; k < 8; k++) {
      float o[8];
#pragma unroll
      for (int e = 0; e < 8; e++) o[e] = cb[e];
#pragma unroll
      for (int j = 0; j < 4; j++) {
        const uint4 r = rows[k + j];
        const unsigned rs[4] = {r.x, r.y, r.z, r.w};
#pragma unroll
        for (int e = 0; e < 4; e++) { o[2 * e] += bflo(rs[e]) * w[j][2 * e]; o[2 * e + 1] += bfhi(rs[e]) * w[j][2 * e + 1]; }
      }
      *(uint4*)(p.xc + (size_t)(n0 + k) * 1536 + c) =
          make_uint4(pack2(siluf_(o[0]), siluf_(o[1])), pack2(siluf_(o[2]), siluf_(o[3])), pack2(siluf_(o[4]), siluf_(o[5])),
                     pack2(siluf_(o[6]), siluf_(o[7])));
    }
    if (t0 + 8 == T) {
      float* co = seq_out(p.out, seq, O_PCONV, O_SCONV, 3 * 1536);
#pragma unroll
      for (int j = 0; j < 3; j++) {
        const uint4 r = rows[8 + j];
        *(float4*)(co + j * 1536 + c) = make_float4(bflo(r.x), bfhi(r.x), bflo(r.y), bfhi(r.y));
        *(float4*)(co + j * 1536 + c + 4) = make_float4(bflo(r.z), bfhi(r.z), bflo(r.w), bfhi(r.w));
      }
    }
  } else if (tid < 192 + 32) {
    const int i = tid - 192;
#pragma unroll
    for (int e = 0; e < 4; e++) {
      const int pi = i * 4 + e, k = pi >> 4, h = pi & 15, n = n0 + k;
      const float raw = bf2f(p.proj[(size_t)n * PCOLS + C_DT + h]) + p.dt_bias[h];
      const float dt = softplusf_(raw);
      const float dA = -dt * expf(p.A_log[h]);
      p.dtb[n * 16 + h] = dt;
      p.decb[n * 16 + h] = dA;
    }
  }
}

__device__ void phase3(const P& p, int bid, int nb, char* smem) {
  for (int it = bid; it < 2 * (NT / 8); it += nb) {
    if (it < NT / 8) rwkv_lerp_item(p, it);
    else conv_prep_item(p, it - NT / 8);
  }
}
__device__ void phase3b(const P& p, int bid, int nb, char* smem) {
  for (int it = bid; it < 136 * 4; it += nb) rwkv_lora_item(p, it >> 2, it & 3, smem);
}

constexpr int TC = 32;
__device__ __forceinline__ void bf8_to_f(uint4 u, float4& lo, float4& hi) {
  lo = make_float4(bflo(u.x), bfhi(u.x), bflo(u.y), bfhi(u.y));
  hi = make_float4(bflo(u.z), bfhi(u.z), bflo(u.w), bfhi(u.w));
}
__device__ void rwkv_scan_item(const P& p, int seq, int h, int qr, char* smem) {
  const int T = seq < 8 ? 2048 : 8, nbase = seq < 8 ? seq * 2048 : NP + (seq - 8) * 8;
  float* Ld = (float*)smem;
  float* Lr = Ld + TC * 64; float* Lk = Lr + TC * 64; float* Lkk = Lk + TC * 64; float* Lb = Lkk + TC * 64;
  float* Lv = Lb + TC * 64;
  const int tid = TIDX, w = tid >> 6, lane = tid & 63, rl = w * 4 + (lane >> 4), ks = lane & 15;
  const int v = qr * 16 + rl;
  float S0 = 0.f, S1 = 0.f, S2 = 0.f, S3 = 0.f;
  if (seq >= 8) {
    float4 s = *(const float4*)(p.state_wkv + (((size_t)(seq - 8) * 8 + h) * 64 + v) * 64 + ks * 4);
    S0 = s.x; S1 = s.y; S2 = s.z; S3 = s.w;
  }
  const int st = tid >> 3, sk8 = (tid & 7) * 8;
  const int vt = tid >> 1, vr8 = (tid & 1) * 8;
  uint4 g0, g1, g2, g3, g4, gv;
  g0 = g1 = g2 = g3 = g4 = gv = make_uint4(0, 0, 0, 0);
#define RW_GLOAD(c0_)                                                                           \
  {                                                                                             \
    const int tcn = min(TC, T - (c0_));                                                         \
    if (st < tcn) {                                                                             \
      const u16* base = p.prep + (size_t)(nbase + (c0_) + st) * 3584 + h * 64 + sk8;            \
      g0 = *(const uint4*)(base); g1 = *(const uint4*)(base + 512); g2 = *(const uint4*)(base + 1024); \
      g3 = *(const uint4*)(base + 1536); g4 = *(const uint4*)(base + 2048);                     \
    }                                                                                           \
    if (tid < 64 && vt < tcn)                                                                   \
      gv = *(const uint4*)(p.prep + (size_t)(nbase + (c0_) + vt) * 3584 + 2560 + h * 64 + qr * 16 + vr8); \
  }
  RW_GLOAD(0);
  for (int c0 = 0; c0 < T; c0 += TC) {
    const int tc = min(TC, T - c0);
    __syncthreads();
    {
      float4 lo, hi;
      bf8_to_f(g0, lo, hi);
      lo.x = __expf(lo.x); lo.y = __expf(lo.y); lo.z = __expf(lo.z); lo.w = __expf(lo.w);
      hi.x = __expf(hi.x); hi.y = __expf(hi.y); hi.z = __expf(hi.z); hi.w = __expf(hi.w);
      *(float4*)(Ld + st * 64 + sk8) = lo; *(float4*)(Ld + st * 64 + sk8 + 4) = hi;
      bf8_to_f(g1, lo, hi); *(float4*)(Lr + st * 64 + sk8) = lo; *(float4*)(Lr + st * 64 + sk8 + 4) = hi;
      bf8_to_f(g2, lo, hi); *(float4*)(Lk + st * 64 + sk8) = lo; *(float4*)(Lk + st * 64 + sk8 + 4) = hi;
      bf8_to_f(g3, lo, hi); *(float4*)(Lkk + st * 64 + sk8) = lo; *(float4*)(Lkk + st * 64 + sk8 + 4) = hi;
      bf8_to_f(g4, lo, hi); *(float4*)(Lb + st * 64 + sk8) = lo; *(float4*)(Lb + st * 64 + sk8 + 4) = hi;
      if (tid < 64) { bf8_to_f(gv, lo, hi); *(float4*)(Lv + vt * 16 + vr8) = lo; *(float4*)(Lv + vt * 16 + vr8 + 4) = hi; }
    }
    __syncthreads();
    if (c0 + TC < T) RW_GLOAD(c0 + TC);
    float4 kk4 = *(const float4*)(Lkk + ks * 4), d4 = *(const float4*)(Ld + ks * 4), b4 = *(const float4*)(Lb + ks * 4),
           k4 = *(const float4*)(Lk + ks * 4), r4 = *(const float4*)(Lr + ks * 4);
    float vv = Lv[rl];
    u16* yo = p.proj + (size_t)(nbase + c0) * PCOLS + h * 64 + v;
    for (int tt = 0; tt < tc; tt++) {
      const int tn = min(tt + 1, tc - 1);
      const float4 nkk4 = *(const float4*)(Lkk + tn * 64 + ks * 4), nd4 = *(const float4*)(Ld + tn * 64 + ks * 4),
                   nb4 = *(const float4*)(Lb + tn * 64 + ks * 4), nk4 = *(const float4*)(Lk + tn * 64 + ks * 4),
                   nr4 = *(const float4*)(Lr + tn * 64 + ks * 4);
      const float nvv = Lv[tn * 16 + rl];
      float sk = (S0 * kk4.x + S1 * kk4.y) + (S2 * kk4.z + S3 * kk4.w);
      sk = allreduce16(sk);
      S0 = S0 * d4.x + (vv * k4.x - sk * b4.x);
      S1 = S1 * d4.y + (vv * k4.y - sk * b4.y);
      S2 = S2 * d4.z + (vv * k4.z - sk * b4.z);
      S3 = S3 * d4.w + (vv * k4.w - sk * b4.w);
      float y = (S0 * r4.x + S1 * r4.y) + (S2 * r4.z + S3 * r4.w);
      y = allreduce16(y);
      if (ks == 0) yo[(size_t)tt * PCOLS] = f2bf(y);
      kk4 = nkk4; d4 = nd4; b4 = nb4; k4 = nk4; r4 = nr4; vv = nvv;
    }
  }
  float* so = seq_out(p.out, seq, O_PWKV, O_SWKV, 8 * 4096);
  *(float4*)(so + ((size_t)h * 64 + v) * 64 + ks * 4) = make_float4(S0, S1, S2, S3);
}

__device__ void ssm_scan_item(const P& p, int seq, int head, int half, char* smem) {
  const int T = seq < 8 ? 2048 : 8, nbase = seq < 8 ? seq * 2048 : NP + (seq - 8) * 8;
  float* LB = (float*)smem;
  float* LC = LB + TC * 128;
  float* Lx = LC + TC * 128;
  float* Ldt = Lx + TC * 32;
  float* Ldec = Ldt + TC;
  const int tid = TIDX, pl = tid >> 3, ns = tid & 7;
  const int pp = half * 32 + pl, g = head >> 3;
  const float Dk = p.D_skip[head];
  float hs[16];
#pragma unroll
  for (int j = 0; j < 16; j++) hs[j] = 0.f;
  if (seq >= 8) {
    const float4* s4 = (const float4*)(p.state_ssm + (((size_t)(seq - 8) * 16 + head) * 64 + pp) * 128 + ns * 16);
#pragma unroll
    for (int j = 0; j < 4; j++) { float4 s = s4[j]; hs[4 * j] = s.x; hs[4 * j + 1] = s.y; hs[4 * j + 2] = s.z; hs[4 * j + 3] = s.w; }
  }
  uint4 gb0, gb1, gb2, gb3, gx; float gdt = 0.f, gdec = 0.f;
  gb0 = gb1 = gb2 = gb3 = gx = make_uint4(0, 0, 0, 0);
  const int bt = tid >> 5, bch = tid & 31;
  const u16* bsrc = p.xc + 1024 + (bch < 16 ? 0 : 256) + g * 128 + (bch & 15) * 8;
  const int xt = tid >> 2, xr8 = (tid & 3) * 8;
#define SS_GLOAD(c0_)                                                                          \
  {                                                                                            \
    const int tcn = min(TC, T - (c0_));                                                        \
    const size_t nb_ = (size_t)(nbase + (c0_));                                                \
    if (bt < tcn) gb0 = *(const uint4*)(bsrc + (nb_ + bt) * 1536);                             \
    if (bt + 8 < tcn) gb1 = *(const uint4*)(bsrc + (nb_ + bt + 8) * 1536);                     \
    if (bt + 16 < tcn) gb2 = *(const uint4*)(bsrc + (nb_ + bt + 16) * 1536);                   \
    if (bt + 24 < tcn) gb3 = *(const uint4*)(bsrc + (nb_ + bt + 24) * 1536);                   \
    if (tid < 128 && xt < tcn) gx = *(const uint4*)(p.xc + (nb_ + xt) * 1536 + head * 64 + half * 32 + xr8); \
    if (tid < tcn) { gdt = p.dtb[(nb_ + tid) * 16 + head]; gdec = p.decb[(nb_ + tid) * 16 + head]; } \
  }
  SS_GLOAD(0);
  for (int c0 = 0; c0 < T; c0 += TC) {
    const int tc = min(TC, T - c0);
    __syncthreads();
    {
      float* dstb = (bch < 16 ? LB : LC) + (bch & 15) * 8;
      float4 lo, hi;
      bf8_to_f(gb0, lo, hi); *(float4*)(dstb + bt * 128) = lo; *(float4*)(dstb + bt * 128 + 4) = hi;
      bf8_to_f(gb1, lo, hi); *(float4*)(dstb + (bt + 8) * 128) = lo; *(float4*)(dstb + (bt + 8) * 128 + 4) = hi;
      bf8_to_f(gb2, lo, hi); *(float4*)(dstb + (bt + 16) * 128) = lo; *(float4*)(dstb + (bt + 16) * 128 + 4) = hi;
      bf8_to_f(gb3, lo, hi); *(float4*)(dstb + (bt + 24) * 128) = lo; *(float4*)(dstb + (bt + 24) * 128 + 4) = hi;
      if (tid < 128) { bf8_to_f(gx, lo, hi); *(float4*)(Lx + xt * 32 + xr8) = lo; *(float4*)(Lx + xt * 32 + xr8 + 4) = hi; }
      if (tid < TC) { Ldt[tid] = gdt; Ldec[tid] = __expf(gdec); }
    }
    __syncthreads();
    if (c0 + TC < T) SS_GLOAD(c0 + TC);
    u16* yo = p.proj + (size_t)(nbase + c0) * PCOLS + C_XBC + head * 64 + pp;
    float4 B0 = *(const float4*)(LB + ns * 16), B1 = *(const float4*)(LB + ns * 16 + 4), B2 = *(const float4*)(LB + ns * 16 + 8),
           B3 = *(const float4*)(LB + ns * 16 + 12);
    float4 C0 = *(const float4*)(LC + ns * 16), C1 = *(const float4*)(LC + ns * 16 + 4), C2 = *(const float4*)(LC + ns * 16 + 8),
           C3 = *(const float4*)(LC + ns * 16 + 12);
    float xv = Lx[pl], dtv = Ldt[0], dec = Ldec[0];
    for (int tt = 0; tt < tc; tt++) {
      const int tn = min(tt + 1, tc - 1);
      const float* nB = LB + tn * 128 + ns * 16;
      const float* nC = LC + tn * 128 + ns * 16;
      const float4 nB0 = *(const float4*)(nB), nB1 = *(const float4*)(nB + 4), nB2 = *(const float4*)(nB + 8), nB3 = *(const float4*)(nB + 12);
      const float4 nC0 = *(const float4*)(nC), nC1 = *(const float4*)(nC + 4), nC2 = *(const float4*)(nC + 8), nC3 = *(const float4*)(nC + 12);
      const float nxv = Lx[tn * 32 + pl], ndt = Ldt[tn], ndec = Ldec[tn];
      const float dtx = dtv * xv;
      hs[0] = hs[0] * dec + dtx * B0.x; hs[1] = hs[1] * dec + dtx * B0.y; hs[2] = hs[2] * dec + dtx * B0.z; hs[3] = hs[3] * dec + dtx * B0.w;
      hs[4] = hs[4] * dec + dtx * B1.x; hs[5] = hs[5] * dec + dtx * B1.y; hs[6] = hs[6] * dec + dtx * B1.z; hs[7] = hs[7] * dec + dtx * B1.w;
      hs[8] = hs[8] * dec + dtx * B2.x; hs[9] = hs[9] * dec + dtx * B2.y; hs[10] = hs[10] * dec + dtx * B2.z; hs[11] = hs[11] * dec + dtx * B2.w;
      hs[12] = hs[12] * dec + dtx * B3.x; hs[13] = hs[13] * dec + dtx * B3.y; hs[14] = hs[14] * dec + dtx * B3.z; hs[15] = hs[15] * dec + dtx * B3.w;
      float y0 = hs[0] * C0.x + hs[1] * C0.y + hs[2] * C0.z + hs[3] * C0.w;
      float y1 = hs[4] * C1.x + hs[5] * C1.y + hs[6] * C1.z + hs[7] * C1.w;
      float y2 = hs[8] * C2.x + hs[9] * C2.y + hs[10] * C2.z + hs[11] * C2.w;
      float y3 = hs[12] * C3.x + hs[13] * C3.y + hs[14] * C3.z + hs[15] * C3.w;
      float yp = allreduce8((y0 + y1) + (y2 + y3));
      if (ns == 0) yo[(size_t)tt * PCOLS] = f2bf(yp + Dk * xv);
      B0 = nB0; B1 = nB1; B2 = nB2; B3 = nB3; C0 = nC0; C1 = nC1; C2 = nC2; C3 = nC3; xv = nxv; dtv = ndt; dec = ndec;
    }
  }
  float* so = seq_out(p.out, seq, O_PSSM, O_SSSM, 16 * 8192);
  float4* o4 = (float4*)(so + ((size_t)head * 64 + pp) * 128 + ns * 16);
#pragma unroll
  for (int j = 0; j < 4; j++) o4[j] = make_float4(hs[4 * j], hs[4 * j + 1], hs[4 * j + 2], hs[4 * j + 3]);
}

__device__ void ssd_prompt_item(const P& p, int seq, int head, char* smem) {
  const int nbase = seq * 2048, g = head >> 3;
  char* sC = smem;
  char* sB = smem + 17408;
  char* sBT = smem + 34816;
  char* sXT = smem + 53248;
  char* sH = smem + 62464;
  float* sS = (float*)(smem + 79872);
  const int tid = TIDX, lane = tid & 63, w = tid >> 6, fr = lane & 15, q = lane >> 4;
  const float Dk = p.D_skip[head];
  f32x4 H[8];
#pragma unroll
  for (int i = 0; i < 8; i++) H[i] = f32x4{0.f, 0.f, 0.f, 0.f};
  __syncthreads();
  for (int i = tid; i < 17408 / 16; i += 256) *(uint4*)(sH + i * 16) = make_uint4(0, 0, 0, 0);
  uint4 gB0, gB1, gB2, gB3, gC0, gC1, gC2, gC3, gX0, gX1;
  float gdt, gdA;
#define SSD_LOAD(t0_)                                                                         \
  {                                                                                           \
    const size_t nn_ = (size_t)(nbase + (t0_) + lane);                                        \
    const u16* row_ = p.xc + nn_ * 1536;                                                      \
    const u16* rb_ = row_ + 1024 + g * 128 + w * 32;                                          \
    gB0 = *(const uint4*)(rb_); gB1 = *(const uint4*)(rb_ + 8); gB2 = *(const uint4*)(rb_ + 16); gB3 = *(const uint4*)(rb_ + 24); \
    gC0 = *(const uint4*)(rb_ + 256); gC1 = *(const uint4*)(rb_ + 264); gC2 = *(const uint4*)(rb_ + 272); gC3 = *(const uint4*)(rb_ + 280); \
    gX0 = *(const uint4*)(row_ + head * 64 + w * 16); gX1 = *(const uint4*)(row_ + head * 64 + w * 16 + 8); \
    gdt = p.dtb[nn_ * 16 + head]; gdA = p.decb[nn_ * 16 + head];                              \
  }
#define SSD_PUT_T(dst_, r0_, u_, sc_)                                                         \
  {                                                                                           \
    const unsigned us_[4] = {u_.x, u_.y, u_.z, u_.w};                                         \
    _Pragma("unroll") for (int e = 0; e < 4; e++) {                                           \
      *(u16*)(dst_ + ((r0_) + 2 * e) * 144 + lane * 2) = f2bf(bflo(us_[e]) * (sc_));          \
      *(u16*)(dst_ + ((r0_) + 2 * e + 1) * 144 + lane * 2) = f2bf(bfhi(us_[e]) * (sc_));      \
    }                                                                                         \
  }
  SSD_LOAD(0);
#pragma unroll 1
  for (int c = 0; c < 32; c++) {
    const int t0 = c * 64;
    float cs = gdA;
#pragma unroll
    for (int o = 1; o < 64; o <<= 1) { const float v = __shfl_up(cs, o, 64); if (lane >= o) cs += v; }
    const float cs63 = __shfl(cs, 63, 64);
    const float wt = gdt * __expf(cs63 - cs);
    __syncthreads();
    if (w == 0) { sS[lane] = cs; sS[64 + lane] = __expf(cs); sS[128 + lane] = gdt; }
    {
      char* rc = sC + lane * 272 + w * 64;
      char* rb = sB + lane * 272 + w * 64;
      *(uint4*)(rc) = gC0; *(uint4*)(rc + 16) = gC1; *(uint4*)(rc + 32) = gC2; *(uint4*)(rc + 48) = gC3;
      *(uint4*)(rb) = gB0; *(uint4*)(rb + 16) = gB1; *(uint4*)(rb + 32) = gB2; *(uint4*)(rb + 48) = gB3;
      SSD_PUT_T(sBT, w * 32, gB0, wt) SSD_PUT_T(sBT, w * 32 + 8, gB1, wt) SSD_PUT_T(sBT, w * 32 + 16, gB2, wt)
      SSD_PUT_T(sBT, w * 32 + 24, gB3, wt) SSD_PUT_T(sXT, w * 16, gX0, 1.f) SSD_PUT_T(sXT, w * 16 + 8, gX1, 1.f)
    }
    __syncthreads();
    if (c + 1 < 32) SSD_LOAD(t0 + 64);
    f32x4 cb[4], yo[4];
#pragma unroll
    for (int i = 0; i < 4; i++) { cb[i] = f32x4{0.f, 0.f, 0.f, 0.f}; yo[i] = f32x4{0.f, 0.f, 0.f, 0.f}; }
    {
      bf16x8 af[4];
#pragma unroll
      for (int ks = 0; ks < 4; ks++) af[ks] = *(const bf16x8*)(sC + (16 * w + fr) * 272 + ks * 64 + q * 16);
#pragma unroll
      for (int nn = 0; nn < 4; nn++)
#pragma unroll
        for (int ks = 0; ks < 4; ks++) {
          const bf16x8 bb = *(const bf16x8*)(sB + (16 * nn + fr) * 272 + ks * 64 + q * 16);
          cb[nn] = __builtin_amdgcn_mfma_f32_16x16x32_bf16(af[ks], bb, cb[nn], 0, 0, 0);
        }
#pragma unroll
      for (int pt = 0; pt < 4; pt++)
#pragma unroll
        for (int ks = 0; ks < 4; ks++) {
          const bf16x8 bb = *(const bf16x8*)(sH + (16 * pt + fr) * 272 + ks * 64 + q * 16);
          yo[pt] = __builtin_amdgcn_mfma_f32_16x16x32_bf16(af[ks], bb, yo[pt], 0, 0, 0);
        }
    }
    __syncthreads();
#pragma unroll
    for (int j = 0; j < 4; j++) {
      const int l = 16 * w + q * 4 + j;
      const float csl = sS[l];
#pragma unroll
      for (int nn = 0; nn < 4; nn++) {
        const int sidx = 16 * nn + fr;
        const float gv = (sidx <= l) ? cb[nn][j] * __expf(csl - sS[sidx]) * sS[128 + sidx] : 0.f;
        *(u16*)(sB + l * 144 + sidx * 2) = f2bf(gv);
      }
    }
    f32x4 yd[4];
#pragma unroll
    for (int i = 0; i < 4; i++) yd[i] = f32x4{0.f, 0.f, 0.f, 0.f};
#pragma unroll
    for (int ks = 0; ks < 2; ks++) {
      const bf16x8 aa = *(const bf16x8*)(sB + (16 * w + fr) * 144 + ks * 64 + q * 16);
#pragma unroll
      for (int pt = 0; pt < 4; pt++) {
        const bf16x8 bb = *(const bf16x8*)(sXT + (16 * pt + fr) * 144 + ks * 64 + q * 16);
        yd[pt] = __builtin_amdgcn_mfma_f32_16x16x32_bf16(aa, bb, yd[pt], 0, 0, 0);
      }
    }
#pragma unroll
    for (int j = 0; j < 4; j++) {
      const int l = 16 * w + q * 4 + j;
      const float el = sS[64 + l];
      u16* yrow = p.proj + (size_t)(nbase + t0 + l) * PCOLS + C_XBC + head * 64 + fr;
#pragma unroll
      for (int pt = 0; pt < 4; pt++) {
        const float xs = bf2f(*(const u16*)(sXT + (16 * pt + fr) * 144 + l * 2));
        yrow[16 * pt] = f2bf(yd[pt][j] + el * yo[pt][j] + Dk * xs);
      }
    }
    const float ach = __expf(cs63);
#pragma unroll
    for (int nt = 0; nt < 8; nt++) { H[nt][0] *= ach; H[nt][1] *= ach; H[nt][2] *= ach; H[nt][3] *= ach; }
#pragma unroll
    for (int ks = 0; ks < 2; ks++) {
      const bf16x8 aa = *(const bf16x8*)(sXT + (16 * w + fr) * 144 + ks * 64 + q * 16);
#pragma unroll
      for (int nt = 0; nt < 8; nt++) {
        const bf16x8 bb = *(const bf16x8*)(sBT + (16 * nt + fr) * 144 + ks * 64 + q * 16);
        H[nt] = __builtin_amdgcn_mfma_f32_16x16x32_bf16(aa, bb, H[nt], 0, 0, 0);
      }
    }
#pragma unroll
    for (int nt = 0; nt < 8; nt++)
#pragma unroll
      for (int j = 0; j < 4; j++) *(u16*)(sH + (16 * w + q * 4 + j) * 272 + (16 * nt + fr) * 2) = f2bf(H[nt][j]);
  }
  float* so = p.out + O_PSSM + ((size_t)seq * 16 + head) * 8192;
#pragma unroll
  for (int nt = 0; nt < 8; nt++)
#pragma unroll
    for (int j = 0; j < 4; j++) so[(16 * w + q * 4 + j) * 128 + 16 * nt + fr] = H[nt][j];
  __syncthreads();
}

constexpr int P4_RP = 256, P4_SP = 128, P4_RS = 4096, P4_SS = 4096;
#define XB_QUEUE 3600
__device__ void phase4(const P& p, int bid, int nb, char* smem) {
  for (int it = bid; it < P4_RP + P4_SP; it += nb) {
    if (it < P4_RP) rwkv_scan_item(p, it >> 5, (it >> 2) & 7, it & 3, smem);
    else { const int i = it - P4_RP; ssd_prompt_item(p, i >> 4, i & 15, smem); }
  }
  volatile int* slot = (volatile int*)(smem + LDS_BYTES - 32);
  for (;;) {
    __syncthreads();
    if (TIDX == 0) *slot = (int)atomicAdd(&p.bar[XB_QUEUE], 1u);
    __syncthreads();
    int i = *slot;
    if (i >= P4_RS + P4_SS) break;
    if (i < P4_RS) rwkv_scan_item(p, 8 + (i >> 5), (i >> 2) & 7, i & 3, smem);
    else { i -= P4_RS; ssm_scan_item(p, 8 + (i >> 5), (i >> 1) & 15, i & 1, smem); }
  }
}

__device__ void phase5(const P& p, int bid, int nb) {
  const int lane = TIDX & 63, wid = TIDX >> 6;
  for (int it = bid; it < NT / 4; it += nb) {
    const int n = it * 4 + wid;
    {
      const int c = lane * 8;
      uint4 yu = *(const uint4*)(p.proj + (size_t)n * PCOLS + c);
      const u16* pr = p.prep + (size_t)n * 3584 + c;
      uint4 ru = *(const uint4*)(pr + 512), ku = *(const uint4*)(pr + 1024), vu = *(const uint4*)(pr + 2560),
            gu = *(const uint4*)(pr + 3072);
      unsigned ys[4] = {yu.x, yu.y, yu.z, yu.w}, rs[4] = {ru.x, ru.y, ru.z, ru.w}, ks_[4] = {ku.x, ku.y, ku.z, ku.w},
               vs[4] = {vu.x, vu.y, vu.z, vu.w}, gs[4] = {gu.x, gu.y, gu.z, gu.w};
      float y[8], r[8], k[8], v[8], g[8];
#pragma unroll
      for (int e = 0; e < 4; e++) {
        y[2 * e] = bflo(ys[e]); y[2 * e + 1] = bfhi(ys[e]);
        r[2 * e] = bflo(rs[e]); r[2 * e + 1] = bfhi(rs[e]);
        k[2 * e] = bflo(ks_[e]); k[2 * e + 1] = bfhi(ks_[e]);
        v[2 * e] = bflo(vs[e]); v[2 * e + 1] = bfhi(vs[e]);
        g[2 * e] = bflo(gs[e]); g[2 * e + 1] = bfhi(gs[e]);
      }
      float s = 0.f, bn = 0.f;
#pragma unroll
      for (int e = 0; e < 8; e++) { s += y[e]; bn += r[e] * k[e] * p.rw_r_k[c + e]; }
      s = allreduce8(s); bn = allreduce8(bn);
      const float mean = s * (1.f / 64.f);
      float vr = 0.f;
#pragma unroll
      for (int e = 0; e < 8; e++) { const float d = y[e] - mean; vr += d * d; }
      vr = allreduce8(vr) * (1.f / 64.f);
      const float rs_ = rsqrtf(vr + 64e-5f);
      float o[8];
#pragma unroll
      for (int e = 0; e < 8; e++) {
        const float yn = (y[e] - mean) * rs_ * p.rw_ln_w[c + e] + p.rw_ln_b[c + e];
        o[e] = (yn + bn * v[e]) * g[e];
      }
      uint4 ou; ou.x = pack2(o[0], o[1]); ou.y = pack2(o[2], o[3]); ou.z = pack2(o[4], o[5]); ou.w = pack2(o[6], o[7]);
      *(uint4*)(p.oa + (size_t)n * 512 + c) = ou;
    }
    {
      const int c = lane * 16;
      float yv[16];
      float ss = 0.f;
#pragma unroll
      for (int hh = 0; hh < 2; hh++) {
        uint4 yu = *(const uint4*)(p.proj + (size_t)n * PCOLS + C_XBC + c + hh * 8);
        uint4 zu = *(const uint4*)(p.proj + (size_t)n * PCOLS + C_Z + c + hh * 8);
        unsigned ys[4] = {yu.x, yu.y, yu.z, yu.w}, zs[4] = {zu.x, zu.y, zu.z, zu.w};
#pragma unroll
        for (int e = 0; e < 4; e++) {
          const float a = bflo(ys[e]) * siluf_(bflo(zs[e])), b = bfhi(ys[e]) * siluf_(bfhi(zs[e]));
          yv[hh * 8 + 2 * e] = a; yv[hh * 8 + 2 * e + 1] = b;
          ss += a * a + b * b;
        }
      }
#pragma unroll
      for (int o = 16; o >= 1; o >>= 1) ss += __shfl_xor(ss, o, 64);
      const float rstd = rsqrtf(ss * (1.f / 512.f) + 1e-6f);
      unsigned ou[8];
#pragma unroll
      for (int e = 0; e < 8; e++)
        ou[e] = pack2(yv[2 * e] * rstd * p.ssm_norm_w[c + 2 * e], yv[2 * e + 1] * rstd * p.ssm_norm_w[c + 2 * e + 1]);
      *(uint4*)(p.ob + (size_t)n * 1024 + c) = make_uint4(ou[0], ou[1], ou[2], ou[3]);
      *(uint4*)(p.ob + (size_t)n * 1024 + c + 8) = make_uint4(ou[4], ou[5], ou[6], ou[7]);
    }
  }
}

__device__ void phase6(const P& p, int bid, int nb, char* smem) {
  TileIter ti(bid, nb, 136, 8);
  int mt, nt;
  while (ti.next(mt, nt)) {
    f32x4 ac[4][4];
    u16* Lm = (u16*)(smem + 2 * 128 * LROW);
    zero_acc(ac);
    gemm_tile(p.xn, D, mt * 128, p.w_inT + (size_t)G_A * D, D, nt * 128, D, ac, smem);
    ACC_FOREACH({ Lm[row * 136 + col] = f2bf(sigmoidf_(ac[m][n][j])); })
    zero_acc(ac);
    gemm_tile(p.oa, 512, mt * 128, p.w_paT, 512, nt * 128, 512, ac, smem);
    ACC_FOREACH({ Lm[row * 136 + col] = f2bf(bf2f(Lm[row * 136 + col]) * ac[m][n][j]); })
    zero_acc(ac);
    gemm_tile(p.xn, D, mt * 128, p.w_inT + (size_t)G_B * D, D, nt * 128, D, ac, smem);
    ACC_FOREACH({ p.merged[(size_t)(mt * 128 + row) * D + nt * 128 + col] = f2bf(sigmoidf_(ac[m][n][j])); })
    zero_acc(ac);
    gemm_tile(p.ob, D, mt * 128, p.w_pbT, D, nt * 128, D, ac, smem);
    ACC_FOREACH({
      u16* mp = p.merged + (size_t)(mt * 128 + row) * D + nt * 128 + col;
      *mp = f2bf(bf2f(Lm[row * 136 + col]) + bf2f(*mp) * ac[m][n][j]);
    })
  }
}

constexpr int P7_G = 136 * 8, P7_CV = 16384;
constexpr float U_SCALE = 256.f, V_SCALE = 32.f;
__device__ void phase7(const P& p, int bid, int nb, char* smem) {
  {
    TileIter ti(bid, nb, 136, 8);
    int mt, nt;
    while (ti.next(mt, nt)) {
      f32x4 acc[4][4];
      zero_acc(acc);
      gemm_tile(p.merged, D, mt * 128, p.w_outT, D, nt * 128, D, acc, smem);
      ACC_FOREACH({
        const int nn = mt * 128 + row, c = nt * 128 + col;
        int seq, t, T; tok2seq(nn, seq, t, T);
        const float gt = p.mod[(size_t)seq * 8192 + 2048 + c];
        p.out[O_Y + (size_t)nn * D + c] = xrow(p, nn)[c] + gt * acc[m][n][j];
      })
    }
  }
  for (int it = bid; it < P7_CV; it += nb) {
    int i = it;
    const float* src; unsigned char* dst; float sc;
    if (i < 8192) { src = p.peer_u + (size_t)i * 2048; dst = (unsigned char*)p.ub + (size_t)i * 2048; sc = U_SCALE; }
    else { i -= 8192; src = p.peer_v + (size_t)i * 2048; dst = (unsigned char*)p.vb + (size_t)i * 2048; sc = V_SCALE; }
    const int tid = TIDX;
    const float4* s4 = (const float4*)src + tid * 2;
    const float4 a = s4[0], b = s4[1];
    int lo = __builtin_amdgcn_cvt_pk_fp8_f32(a.x * sc, a.y * sc, 0, false);
    lo = __builtin_amdgcn_cvt_pk_fp8_f32(a.z * sc, a.w * sc, lo, true);
    int hi = __builtin_amdgcn_cvt_pk_fp8_f32(b.x * sc, b.y * sc, 0, false);
    hi = __builtin_amdgcn_cvt_pk_fp8_f32(b.z * sc, b.w * sc, hi, true);
    *((uint2*)dst + tid) = make_uint2((unsigned)lo, (unsigned)hi);
  }
}

__device__ void phase9(const P& p, int bid, int nb, char* smem) {
  const int tid = TIDX, lane = tid & 63, wid = tid >> 6, wr = wid >> 1, wc = wid & 1, fr = lane & 15,
            fq = lane >> 4;
  TileIter ti(bid, nb, 136, 16);
  int mt, nt;
  while (ti.next(mt, nt)) {
    f32x4 acc[4][4];
    zero_acc(acc);
    gemm_tile<false>(p.xn, D, mt * 128, p.wqT, D, nt * 128, D, acc, smem);
    u16* Lq = (u16*)smem;
    ACC_FOREACH({ Lq[row * 136 + col] = f2bf(acc[m][n][j]); })
    __syncthreads();
    f32x4 sc[4][4];
    zero_acc(sc);
    const u16* kb = p.keysb + (size_t)nt * 128 * 128;
#pragma unroll 1
    for (int s = 0; s < 4; s++) {
      bf16x8 af[4], bfr[4];
#pragma unroll
      for (int m = 0; m < 4; m++) af[m] = *(const bf16x8*)((const char*)Lq + (wr * 64 + m * 16 + fr) * 272 + s * 64 + fq * 16);
#pragma unroll
      for (int n = 0; n < 4; n++) bfr[n] = *(const bf16x8*)(kb + (size_t)(wc * 64 + n * 16 + fr) * 128 + s * 32 + fq * 8);
#pragma unroll
      for (int m = 0; m < 4; m++)
#pragma unroll
        for (int n = 0; n < 4; n++) sc[m][n] = __builtin_amdgcn_mfma_f32_16x16x32_bf16(af[m], bfr[n], sc[m][n], 0, 0, 0);
    }
    __syncthreads();
    float* Ls = (float*)smem;
#pragma unroll
    for (int m = 0; m < 4; m++)
#pragma unroll
      for (int n = 0; n < 4; n++)
#pragma unroll
        for (int j = 0; j < 4; j++) Ls[(wr * 64 + m * 16 + fq * 4 + j) * 129 + wc * 64 + n * 16 + fr] = sc[m][n][j];
    __syncthreads();
    {
      const int row = tid >> 1, half = tid & 1;
      float* Lr = Ls + row * 129;
      const size_t ob = ((size_t)(mt * 128 + row) * 16 + nt) * 16;
      for (int r = 0; r < 16; r++) {
        float best = -INFINITY; int bi = 0;
        for (int i = 0; i < 64; i++) {
          const float v = Lr[half + 2 * i];
          if (v > best) { best = v; bi = half + 2 * i; }
        }
        const float ov = __shfl_xor(best, 1, 64);
        const int oi = __shfl_xor(bi, 1, 64);
        if (ov > best || (ov == best && oi < bi)) { best = ov; bi = oi; }
        if ((bi & 1) == half) Lr[bi] = -INFINITY;
        if (half == 0) { p.topv[ob + r] = best; p.topi[ob + r] = bi; }
      }
    }
    __syncthreads();
  }
}

__device__ __forceinline__ void cand_ij(int lane, int& ci, int& cj) {
  int i = 0, rem = lane;
#pragma unroll
  for (int r = 0; r < 16; r++) {
    const int cnt = 16 / (r + 1);
    if (i == r && rem >= cnt) { rem -= cnt; i = r + 1; }
  }
  ci = i; cj = rem;
}

typedef __attribute__((ext_vector_type(2))) __bf16 bf2_t;
__device__ __forceinline__ float dot2bf(unsigned a, unsigned b, float c) {
  return __builtin_amdgcn_fdot2_f32_bf16(__builtin_bit_cast(bf2_t, a), __builtin_bit_cast(bf2_t, b), c, false);
}
template <int CTRL, int RM>
__device__ __forceinline__ float dppf_m(float x) {
  return __int_as_float(__builtin_amdgcn_update_dpp(0, __float_as_int(x), CTRL, RM, 0xf, false));
}
__device__ __forceinline__ float wave_sum_l63(float x) {
  x += dppf<0xB1>(x);
  x += dppf<0x4E>(x);
  x += dppf<0x141>(x);
  x += dppf<0x140>(x);
  x += dppf_m<0x142, 0xA>(x);
  x += dppf_m<0x143, 0xC>(x);
  return x;
}
__device__ __forceinline__ float readlane_f(float x, int l) {
  return __int_as_float(__builtin_amdgcn_readlane(__float_as_int(x), l));
}
__device__ __forceinline__ void axpy8(float* acc, float w, uint4 v) {
  acc[0] += w * bflo(v.x); acc[1] += w * bfhi(v.x); acc[2] += w * bflo(v.y); acc[3] += w * bfhi(v.y);
  acc[4] += w * bflo(v.z); acc[5] += w * bfhi(v.z); acc[6] += w * bflo(v.w); acc[7] += w * bfhi(v.w);
}

typedef float f2_t __attribute__((ext_vector_type(2)));
__device__ __forceinline__ void fp8x16_to_f32(const uint4 v, float* o) {
  const unsigned w[4] = {v.x, v.y, v.z, v.w};
#pragma unroll
  for (int i = 0; i < 4; i++) {
    const f2_t lo = __builtin_amdgcn_cvt_pk_f32_fp8((int)w[i], false);
    const f2_t hi = __builtin_amdgcn_cvt_pk_f32_fp8((int)w[i], true);
    o[4 * i] = lo.x; o[4 * i + 1] = lo.y; o[4 * i + 2] = hi.x; o[4 * i + 3] = hi.y;
  }
}

__device__ void phase10(const P& p, int bid, int nb) {
  const int lane = TIDX & 63, wid = TIDX >> 6;
  int ci, cj; cand_ij(lane < 50 ? lane : 0, ci, cj);
  const unsigned char* ub8 = (const unsigned char*)p.ub;
  const unsigned char* vb8 = (const unsigned char*)p.vb;
  for (int it = bid; it < NT / 4; it += nb) {
    const int n = it * 4 + wid;
    int seq, t, T; tok2seq(n, seq, t, T);
    float xv[16];
    {
      const uint4 a = *(const uint4*)(p.xn + (size_t)n * D + lane * 16), b = *(const uint4*)(p.xn + (size_t)n * D + lane * 16 + 8);
      const unsigned as[4] = {a.x, a.y, a.z, a.w}, bs[4] = {b.x, b.y, b.z, b.w};
#pragma unroll
      for (int e = 0; e < 4; e++) { xv[2 * e] = bflo(as[e]); xv[2 * e + 1] = bfhi(as[e]); xv[8 + 2 * e] = bflo(bs[e]); xv[8 + 2 * e + 1] = bfhi(bs[e]); }
    }
    float acc[16];
#pragma unroll
    for (int e = 0; e < 16; e++) acc[e] = 0.f;
#pragma unroll 1
    for (int h = 0; h < 8; h++) {
      const size_t base = ((size_t)n * 16 + h * 2) * 16;
      float cand = -INFINITY; int eid = 0;
      if (lane < 50) {
        cand = p.topv[base + ci] + p.topv[base + 16 + cj];
        eid = p.topi[base + ci] * 128 + p.topi[base + 16 + cj];
      }
      int rank = 0;
#pragma unroll
      for (int m = 0; m < 50; m++) {
        const float cm = readlane_f(cand, m);
        rank += ((cm > cand) || (cm == cand && m < lane)) ? 1 : 0;
      }
      const bool sel = (lane < 50) && (rank < 16);
      unsigned long long mask = __ballot(sel);
      const float mx = readlane_f(cand, __builtin_ctzll(__ballot(sel && rank == 0)));
      const float ex = sel ? __expf(cand - mx) : 0.f;
      const float den = readlane_f(wave_sum_l63(ex), 63);
      const float gate = ex / den;
#pragma unroll 1
      for (int hf = 0; hf < 2; hf++) {
        int ek[8]; float gk[8];
#pragma unroll
        for (int k = 0; k < 8; k++) {
          const int src = __builtin_ctzll(mask);
          mask &= mask - 1;
          ek[k] = __builtin_amdgcn_readlane(eid, src);
          gk[k] = readlane_f(gate, src);
        }
        uint4 uu[8], vv[8];
#pragma unroll
        for (int j = 0; j < 8; j++) uu[j] = *(const uint4*)(ub8 + (size_t)ek[j] * D + lane * 16);
#pragma unroll
        for (int j = 0; j < 8; j++) vv[j] = *(const uint4*)(vb8 + (size_t)ek[j] * D + lane * 16);
        float dv = 0.f;
#pragma unroll
        for (int j = 0; j < 8; j++) {
          float uf[16];
          fp8x16_to_f32(uu[j], uf);
          float d0 = 0.f, d1 = 0.f;
#pragma unroll
          for (int e = 0; e < 8; e++) { d0 += uf[2 * e] * xv[2 * e]; d1 += uf[2 * e + 1] * xv[2 * e + 1]; }
          const float ds = readlane_f(wave_sum_l63(d0 + d1), 63);
          dv = (lane == j) ? ds : dv;
        }
        dv *= (1.f / U_SCALE);
        const float act = 0.5f * dv * (1.f + erff(dv * 0.70710678118654752f));
#pragma unroll
        for (int j = 0; j < 8; j++) {
          const float w = readlane_f(act, j) * gk[j] * (1.f / V_SCALE);
          float vf[16];
          fp8x16_to_f32(vv[j], vf);
#pragma unroll
          for (int e = 0; e < 16; e++) acc[e] += w * vf[e];
        }
      }
    }
    float* yr = p.out + O_Y + (size_t)n * D + lane * 16;
    const float* md = p.mod + (size_t)seq * 8192 + lane * 16;
    float x2[16];
    float ss = 0.f;
#pragma unroll
    for (int q4 = 0; q4 < 4; q4++) {
      const float4 a = *(const float4*)(yr + q4 * 4), g = *(const float4*)(md + 5120 + q4 * 4);
      x2[q4 * 4 + 0] = a.x + g.x * acc[q4 * 4 + 0]; x2[q4 * 4 + 1] = a.y + g.y * acc[q4 * 4 + 1];
      x2[q4 * 4 + 2] = a.z + g.z * acc[q4 * 4 + 2]; x2[q4 * 4 + 3] = a.w + g.w * acc[q4 * 4 + 3];
    }
#pragma unroll
    for (int e = 0; e < 16; e++) ss += x2[e] * x2[e];
    ss = readlane_f(wave_sum_l63(ss), 63);
    const float rstd = rsqrtf(ss * (1.f / 1024.f) + 1e-6f);
#pragma unroll
    for (int q4 = 0; q4 < 4; q4++) {
      const float4 fg = *(const float4*)(p.final_g + lane * 16 + q4 * 4), sc = *(const float4*)(md + 7168 + q4 * 4),
                   sh = *(const float4*)(md + 6144 + q4 * 4);
      float4 o;
      o.x = x2[q4 * 4 + 0] * rstd * fg.x * (1.f + sc.x) + sh.x;
      o.y = x2[q4 * 4 + 1] * rstd * fg.y * (1.f + sc.y) + sh.y;
      o.z = x2[q4 * 4 + 2] * rstd * fg.z * (1.f + sc.z) + sh.z;
      o.w = x2[q4 * 4 + 3] * rstd * fg.w * (1.f + sc.w) + sh.w;
      *(float4*)(yr + q4 * 4) = o;
    }
  }
}

#define XB_XCNT(j) (256 + 64 * (j))
#define XB_XSUB(j) (1280 + 64 * (j))
#define XB_XGEN(j) (2304 + 64 * (j))
#define XB_TOP 3328
#define XB_TOPGEN 3392
#define XB_WORDS 4096
__device__ __forceinline__ unsigned xb_ld(unsigned* p) { return __hip_atomic_load(p, __ATOMIC_RELAXED, __HIP_MEMORY_SCOPE_AGENT); }
__device__ __forceinline__ unsigned xb_add(unsigned* p, unsigned v) { return __hip_atomic_fetch_add(p, v, __ATOMIC_RELAXED, __HIP_MEMORY_SCOPE_AGENT); }
__device__ __forceinline__ unsigned xb_xcc_id() { return (unsigned)__builtin_amdgcn_s_getreg((3 << 11) | 20) & 0xFu; }
__device__ __forceinline__ void grid_barrier(unsigned* bar, volatile unsigned* xst) {
  asm volatile("s_waitcnt vmcnt(0)" ::: "memory");
  __syncthreads();
  if (TIDX == 0) {
    __builtin_amdgcn_s_waitcnt(0);
    const unsigned x = xst[0], nloc = xst[1], nx = xst[2];
    const unsigned old = xb_add(&bar[XB_XSUB(x)], 1u);
    const unsigned gen = old / nloc;
    if (old + 1u == (gen + 1u) * nloc) {
      __builtin_amdgcn_fence(__ATOMIC_RELEASE, "agent");
      asm volatile("s_waitcnt vmcnt(0)" ::: "memory");
      const unsigned og = xb_add(&bar[XB_TOP], 1u);
      const unsigned tg = og / nx;
      if (og + 1u == (tg + 1u) * nx) xb_add(&bar[XB_TOPGEN], 1u);
      else while (xb_ld(&bar[XB_TOPGEN]) == tg) __builtin_amdgcn_s_sleep(1);
      __builtin_amdgcn_fence(__ATOMIC_ACQUIRE, "agent");
      xb_add(&bar[XB_XGEN(x)], 1u);
      asm volatile("s_waitcnt vmcnt(0)" ::: "memory");
    } else {
      while (xb_ld(&bar[XB_XGEN(x)]) == gen) __builtin_amdgcn_s_sleep(1);
      __builtin_amdgcn_fence(__ATOMIC_ACQUIRE, "agent");
      asm volatile("s_waitcnt vmcnt(0)" ::: "memory");
    }
  }
  __syncthreads();
}

template <int PH>
__device__ __forceinline__ void run_phase(const P& p, int bid, int nb, char* smem) {
  if constexpr (PH == 0) phase0(p, bid, nb, smem);
  if constexpr (PH == 1) phase_norm<false>(p, bid, nb);
  if constexpr (PH == 2) phase2(p, bid, nb, smem);
  if constexpr (PH == 3) phase3(p, bid, nb, smem);
  if constexpr (PH == 4) phase4(p, bid, nb, smem);
  if constexpr (PH == 5) phase5(p, bid, nb);
  if constexpr (PH == 6) phase6(p, bid, nb, smem);
  if constexpr (PH == 7) phase7(p, bid, nb, smem);
  if constexpr (PH == 8) phase_norm<true>(p, bid, nb);
  if constexpr (PH == 9) phase9(p, bid, nb, smem);
  if constexpr (PH == 10) phase10(p, bid, nb);
  if constexpr (PH == 11) phase3b(p, bid, nb, smem);
}

template <int PH>
__global__ void __launch_bounds__(NTHREADS, 2) k_phase(P p) {
  extern __shared__ __attribute__((aligned(16))) char smem[];
  run_phase<PH>(p, blockIdx.x, gridDim.x, smem);
}

#if MEGA
__global__ void __launch_bounds__(NTHREADS, 2) k_mega(P p) {
  extern __shared__ __attribute__((aligned(16))) char smem[];
  cg::grid_group grid = cg::this_grid();
  const int bid = blockIdx.x, nb = gridDim.x;
#ifndef PROBE_ALL2
#define PROBE_ALL2 0
#endif
#ifndef PROBE_MASK
#define PROBE_MASK 0
#endif
#ifndef PROBE_SYNCS
#define PROBE_SYNCS 0
#endif
  volatile unsigned* xst = (volatile unsigned*)(smem + LDS_BYTES - 16);
  if (TIDX == 0) { const unsigned xcc0 = xb_xcc_id(); xst[0] = xcc0; xb_add(&p.bar[XB_XCNT(xcc0)], 1u); }
#define GSYNC(k)                                                                                 \
  {                                                                                              \
    if ((k) == 0) {                                                                              \
      grid.sync();                                                                               \
      if (TIDX == 0) {                                                                    \
        unsigned cnt = 0;                                                                        \
        for (unsigned j = 0; j < 16; ++j) cnt += xb_ld(&p.bar[XB_XCNT(j)]) > 0u ? 1u : 0u;       \
        xst[2] = cnt; xst[1] = xb_ld(&p.bar[XB_XCNT(xst[0])]);                                   \
      }                                                                                          \
    } else grid_barrier(p.bar, xst);                                                             \
  }
#define RUNPH(k)                                                       \
  run_phase<k>(p, bid, nb, smem); GSYNC(k)                             \
  if (PROBE_MASK & (1 << k)) { run_phase<k>(p, bid, nb, smem); GSYNC(1) }
#pragma unroll 1
  for (int rep = 0; rep < 1 + PROBE_ALL2; rep++) {
    RUNPH(0)
#pragma unroll 1
    for (int i = 0; i < PROBE_SYNCS; i++) GSYNC(1)
    RUNPH(1) RUNPH(2) RUNPH(3) RUNPH(11) RUNPH(4) RUNPH(5) RUNPH(6) RUNPH(7) RUNPH(8) RUNPH(9)
  }
  run_phase<10>(p, bid, nb, smem);
}
#endif

template <int PH>
static void launch_phase(const P& p, int grid, hipStream_t stream) {
  static bool attr = false;
  if (!attr) { hipFuncSetAttribute((const void*)k_phase<PH>, hipFuncAttributeMaxDynamicSharedMemorySize, LDS_BYTES); attr = true; }
  hipLaunchKernelGGL(k_phase<PH>, dim3(grid), dim3(NTHREADS), LDS_BYTES, stream, p);
}

extern "C" void kernel_launch(void* const* d_in, const int* in_sizes, int n_in, void* d_out, int out_size, void* d_ws,
                              size_t ws_size, hipStream_t stream) {
  P p{};
  const float** fp = (const float**)&p;
  for (int i = 0; i < 40; i++) fp[i] = (const float*)d_in[i];
  p.out = (float*)d_out;
  char* ws = (char*)d_ws;
  size_t off = 0;
  auto take = [&](size_t bytes) { char* r = ws + off; off += (bytes + 255) & ~(size_t)255; return r; };
  p.bar = (unsigned*)take(XB_WORDS * 4);
  p.w_inT = (u16*)take((size_t)INCOLS * D * 2);
  p.w_paT = (u16*)take((size_t)1024 * 512 * 2);
  p.w_pbT = (u16*)take((size_t)1024 * 1024 * 2);
  p.w_outT = (u16*)take((size_t)1024 * 1024 * 2);
  p.wqT = (u16*)take((size_t)2048 * 1024 * 2);
  p.keysb = (u16*)take((size_t)262144 * 2);
  p.mod = (float*)take((size_t)NSEQ * 8192 * 4);
  p.dtb = (float*)take((size_t)NT * 16 * 4);
  p.decb = (float*)take((size_t)NT * 16 * 4);
  p.xn = (u16*)take((size_t)NROWS * D * 2);
  p.proj = (u16*)take((size_t)NROWS * PCOLS * 2);
  p.prep = (u16*)take((size_t)NT * 3584 * 2);
  p.w2T = (u16*)take(512 * 64 * 2);
  p.a2T = (u16*)take(512 * 64 * 2);
  p.g2T = (u16*)take(512 * 128 * 2);
  p.lora = (u16*)take((size_t)NT * 256 * 2);
  if (off > ws_size) { fprintf(stderr, "workspace too small: need %zu have %zu\n", off, ws_size); return; }
  p.merged = p.prep;
  p.ub = p.proj;
  p.vb = p.proj + (size_t)16384 * 1024;
  p.topv = (float*)(p.proj + (size_t)2 * 16384 * 1024);
  p.topi = (int*)(p.topv + (size_t)NT * 256);
  p.xc = (u16*)d_out;
  p.oa = (u16*)d_out;
  p.ob = (u16*)d_out + (size_t)NT * 512;

  static int grid = 0;
  if (!grid) {
    int dev = 0, cus = 0, per_cu = 0;
    hipGetDevice(&dev);
    hipDeviceGetAttribute(&cus, hipDeviceAttributeMultiprocessorCount, dev);
#if MEGA
    hipFuncSetAttribute((const void*)k_mega, hipFuncAttributeMaxDynamicSharedMemorySize, LDS_BYTES);
    hipOccupancyMaxActiveBlocksPerMultiprocessor(&per_cu, k_mega, NTHREADS, LDS_BYTES);
    if (per_cu > 2) per_cu = 2;
#else
    per_cu = 2;
#endif
    if (per_cu < 1) per_cu = 1;
    grid = cus * per_cu;
  }
  hipMemsetAsync(p.mod, 0, (size_t)NSEQ * 8192 * 4, stream);
#if MEGA
  hipMemsetAsync(p.bar, 0, XB_WORDS * 4, stream);
  void* args[] = {&p};
  hipError_t e = hipLaunchCooperativeKernel((void*)k_mega, dim3(grid), dim3(NTHREADS), args, LDS_BYTES, stream);
  if (e != hipSuccess) fprintf(stderr, "cooperative launch failed: %s (grid %d)\n", hipGetErrorString(e), grid);
#else
  launch_phase<0>(p, grid, stream);
  launch_phase<1>(p, grid, stream);
  launch_phase<2>(p, grid, stream);
  launch_phase<3>(p, grid, stream);
  launch_phase<11>(p, grid, stream);
  launch_phase<4>(p, grid, stream);
  launch_phase<5>(p, grid, stream);
  launch_phase<6>(p, grid, stream);
  launch_phase<7>(p, grid, stream);
  launch_phase<8>(p, grid, stream);
  launch_phase<9>(p, grid, stream);
  launch_phase<10>(p, grid, stream);
#endif
}
```

```cpp
#include <hip/hip_runtime.h>
#include <hip/hip_cooperative_groups.h>
#include <cstdio>
namespace cg = cooperative_groups;

#ifndef MEGA
#define MEGA 1
#endif

typedef unsigned short u16;
typedef __attribute__((ext_vector_type(8))) short bf16x8;
typedef __attribute__((ext_vector_type(4))) float f32x4;

__device__ __forceinline__ int opaque_tid() { int t = threadIdx.x; asm volatile("" : "+v"(t)); return t; }
#define TIDX opaque_tid()

constexpr int D = 1024;
constexpr int NP = 16384, NS = 1024, NT = NP + NS, NSEQ = 136;
constexpr int NROWS = NT + 128;
constexpr int PCOLS = 4368;
constexpr int INCOLS = 6416;
constexpr int C_LW = 1536, C_LA = 1600, C_LG = 1664, C_Z = 1792, C_XBC = 2816, C_DT = 4352;
constexpr int G_A = 4368, G_B = 5392;
constexpr size_t O_Y = 0, O_PSHIFT = 17825792, O_PWKV = 17833984, O_PCONV = 18096128, O_PSSM = 18132992,
                 O_SSHIFT = 19181568, O_SWKV = 19312640, O_SCONV = 23506944, O_SSSM = 24096768;
constexpr int LDS_BYTES = 80 * 1024;
constexpr int NTHREADS = 256;

struct P {
  const float *x_prompt, *x_sample, *c_prompt, *c_sample, *state_shift, *state_wkv, *state_conv, *state_ssm;
  const float *w_ada, *b_ada, *norm1_g, *w_in, *rw_mu, *rw_w0, *rw_w2, *rw_a0, *rw_a2, *rw_g2, *rw_k_k, *rw_k_a,
      *rw_r_k, *rw_ln_w, *rw_ln_b;
  const float *conv_w, *conv_b, *dt_bias, *A_log, *D_skip, *ssm_norm_w, *w_pa, *w_pb, *w_out, *norm2_g, *peer_wq,
      *peer_keys, *peer_u, *peer_v, *final_g, *w_ada_f, *b_ada_f;
  float* out;
  u16 *w_inT, *w_paT, *w_pbT, *w_outT, *wqT, *keysb, *xn, *proj, *prep, *merged, *ub, *vb, *xc, *oa, *ob;
  u16 *w2T, *a2T, *g2T, *lora;
  float *mod, *dtb, *decb, *topv;
  int* topi;
  unsigned* bar;
};

__device__ __forceinline__ u16 f2bf(float f) {
  unsigned u = __float_as_uint(f);
  u += 0x7fffu + ((u >> 16) & 1u);
  return (u16)(u >> 16);
}
__device__ __forceinline__ float bf2f(u16 h) { return __uint_as_float(((unsigned)h) << 16); }
__device__ __forceinline__ unsigned pack2(float a, float b) { return (unsigned)f2bf(a) | ((unsigned)f2bf(b) << 16); }
__device__ __forceinline__ float bflo(unsigned u) { return __uint_as_float(u << 16); }
__device__ __forceinline__ float bfhi(unsigned u) { return __uint_as_float(u & 0xffff0000u); }
__device__ __forceinline__ float sigmoidf_(float x) { return 1.f / (1.f + __expf(-x)); }
__device__ __forceinline__ float siluf_(float x) { return x / (1.f + __expf(-x)); }
__device__ __forceinline__ float softplusf_(float x) { return x > 20.f ? x : log1pf(expf(x)); }

template <int CTRL>
__device__ __forceinline__ float dppf(float x) {
  return __int_as_float(__builtin_amdgcn_update_dpp(0, __float_as_int(x), CTRL, 0xf, 0xf, true));
}
__device__ __forceinline__ float allreduce16(float x) {
  x += dppf<0x128>(x);
  x += dppf<0x124>(x);
  x += dppf<0x122>(x);
  x += dppf<0x121>(x);
  return x;
}
__device__ __forceinline__ float allreduce8(float x) {
  x += dppf<0xB1>(x);
  x += dppf<0x4E>(x);
  x += dppf<0x141>(x);
  return x;
}
__device__ __forceinline__ float wave_sum(float x) {
#pragma unroll
  for (int o = 32; o >= 1; o >>= 1) x += __shfl_xor(x, o, 64);
  return x;
}
__device__ __forceinline__ float wave_max(float x) {
#pragma unroll
  for (int o = 32; o >= 1; o >>= 1) x = fmaxf(x, __shfl_xor(x, o, 64));
  return x;
}
__device__ __forceinline__ int wave_min_i(int x) {
#pragma unroll
  for (int o = 32; o >= 1; o >>= 1) x = min(x, __shfl_xor(x, o, 64));
  return x;
}

__device__ __forceinline__ const float* xrow(const P& p, int n) {
  return n < NP ? p.x_prompt + (size_t)n * D : p.x_sample + (size_t)(n - NP) * D;
}
__device__ __forceinline__ void tok2seq(int n, int& seq, int& t, int& T) {
  if (n < NP) { seq = n >> 11; t = n & 2047; T = 2048; }
  else { int m = n - NP; seq = 8 + (m >> 3); t = m & 7; T = 8; }
}
__device__ __forceinline__ float* seq_out(float* out, int seq, size_t op, size_t os, size_t per) {
  return seq < 8 ? out + op + (size_t)seq * per : out + os + (size_t)(seq - 8) * per;
}

constexpr int LROW = 144;
template <bool DEEP = true>
__device__ __forceinline__ void gemm_tile(const u16* __restrict__ A, int lda, int m0, const u16* __restrict__ Bt,
                                          int ldb, int n0, int K, f32x4 (&acc)[4][4], char* smem) {
  char* sA = smem;
  char* sB = smem + 128 * LROW;
  const int tid = TIDX, lane = tid & 63, wid = tid >> 6, wr = wid >> 1, wc = wid & 1, fr = lane & 15,
            fq = lane >> 4;
  uint4 ra0, ra1, ra2, ra3, rb0, rb1, rb2, rb3;
  uint4 sa0, sa1, sa2, sa3, sb0, sb1, sb2, sb3;
  const int nk = K / 64;
  const int lrow = tid >> 3, lch = tid & 7;
  const u16* gA = A + (size_t)(m0 + lrow) * lda + lch * 8;
  const u16* gB = Bt + (size_t)(n0 + lrow) * ldb + lch * 8;
#define GLOAD(x0, x1, x2, x3, y0, y1, y2, y3, kt)                   \
  {                                                                 \
    x0 = *(const uint4*)(gA + (kt) * 64);                           \
    x1 = *(const uint4*)(gA + (size_t)32 * lda + (kt) * 64);        \
    x2 = *(const uint4*)(gA + (size_t)64 * lda + (kt) * 64);        \
    x3 = *(const uint4*)(gA + (size_t)96 * lda + (kt) * 64);        \
    y0 = *(const uint4*)(gB + (kt) * 64);                           \
    y1 = *(const uint4*)(gB + (size_t)32 * ldb + (kt) * 64);        \
    y2 = *(const uint4*)(gB + (size_t)64 * ldb + (kt) * 64);        \
    y3 = *(const uint4*)(gB + (size_t)96 * ldb + (kt) * 64);        \
  }
#define LSTORE(x0, x1, x2, x3, y0, y1, y2, y3)                      \
  {                                                                 \
    char* wa = sA + lrow * LROW + lch * 16;                         \
    char* wb = sB + lrow * LROW + lch * 16;                         \
    *(uint4*)(wa) = x0; *(uint4*)(wa + 32 * LROW) = x1; *(uint4*)(wa + 64 * LROW) = x2; *(uint4*)(wa + 96 * LROW) = x3; \
    *(uint4*)(wb) = y0; *(uint4*)(wb + 32 * LROW) = y1; *(uint4*)(wb + 64 * LROW) = y2; *(uint4*)(wb + 96 * LROW) = y3; \
  }
#define COMPUTE_TILE()                                                                                                   \
  {                                                                                                                      \
    _Pragma("unroll") for (int s = 0; s < 2; s++) {                                                                      \
      bf16x8 af[4], bfr[4];                                                                                              \
      _Pragma("unroll") for (int m = 0; m < 4; m++) af[m] = *(const bf16x8*)(sA + (wr * 64 + m * 16 + fr) * LROW + s * 64 + fq * 16); \
      _Pragma("unroll") for (int n = 0; n < 4; n++) bfr[n] = *(const bf16x8*)(sB + (wc * 64 + n * 16 + fr) * LROW + s * 64 + fq * 16); \
      _Pragma("unroll") for (int m = 0; m < 4; m++)                                                                      \
        _Pragma("unroll") for (int n = 0; n < 4; n++) acc[m][n] = __builtin_amdgcn_mfma_f32_16x16x32_bf16(af[m], bfr[n], acc[m][n], 0, 0, 0); \
    }                                                                                                                    \
  }
  GLOAD(ra0, ra1, ra2, ra3, rb0, rb1, rb2, rb3, 0);
  if constexpr (DEEP) {
    GLOAD(sa0, sa1, sa2, sa3, sb0, sb1, sb2, sb3, 1);
#pragma unroll 1
    for (int kt = 0; kt < nk; kt += 2) {
      __syncthreads();
      LSTORE(ra0, ra1, ra2, ra3, rb0, rb1, rb2, rb3);
      __syncthreads();
      if (kt + 2 < nk) GLOAD(ra0, ra1, ra2, ra3, rb0, rb1, rb2, rb3, kt + 2);
      COMPUTE_TILE();
      __syncthreads();
      LSTORE(sa0, sa1, sa2, sa3, sb0, sb1, sb2, sb3);
      __syncthreads();
      if (kt + 3 < nk) GLOAD(sa0, sa1, sa2, sa3, sb0, sb1, sb2, sb3, kt + 3);
      COMPUTE_TILE();
    }
  } else {
#pragma unroll 1
    for (int kt = 0; kt < nk; kt++) {
      __syncthreads();
      LSTORE(ra0, ra1, ra2, ra3, rb0, rb1, rb2, rb3);
      __syncthreads();
      if (kt + 1 < nk) GLOAD(ra0, ra1, ra2, ra3, rb0, rb1, rb2, rb3, kt + 1);
      COMPUTE_TILE();
    }
  }
  __syncthreads();
}
__device__ __forceinline__ void zero_acc(f32x4 (&acc)[4][4]) {
#pragma unroll
  for (int m = 0; m < 4; m++)
#pragma unroll
    for (int n = 0; n < 4; n++) acc[m][n] = f32x4{0.f, 0.f, 0.f, 0.f};
}
#define ACC_FOREACH(...)                                                                    \
  {                                                                                         \
    const int _l = TIDX & 63, _w = TIDX >> 6, _wr = _w >> 1, _wc = _w & 1;    \
    const int _fr = _l & 15, _fq = _l >> 4;                                                 \
    _Pragma("unroll") for (int m = 0; m < 4; m++) _Pragma("unroll") for (int n = 0; n < 4; n++) \
        _Pragma("unroll") for (int j = 0; j < 4; j++) {                                     \
      const int row = _wr * 64 + m * 16 + _fq * 4 + j, col = _wc * 64 + n * 16 + _fr;       \
      __VA_ARGS__                                                                           \
    }                                                                                       \
  }

struct TileIter {
  int x, lb, nbx, tpx, total, MT, NT, r;
  __device__ __forceinline__ TileIter(int bid, int nb, int MT_, int NT_) : MT(MT_), NT(NT_), r(0) {
    total = MT * NT; x = bid & 7; lb = bid >> 3; nbx = nb >> 3; tpx = (total + 7) >> 3;
  }
  __device__ __forceinline__ bool next(int& mt, int& nt) {
    const int idx = lb + r * nbx;
    r++;
    if (idx >= tpx) return false;
    const int lin = x * tpx + idx;
    if (lin >= total) return false;
    const int bsz = 8 * NT, band = lin / bsz, rem = lin - band * bsz;
    const int mb = min(8, MT - band * 8);
    nt = rem / mb; mt = band * 8 + (rem - nt * mb);
    return true;
  }
};

__device__ void transpose_tile(const float* __restrict__ src, int K, int N, u16* __restrict__ dst, int tile,
                               char* smem) {
  const int ntn = (N + 63) / 64, kt = tile / ntn, nt = tile % ntn, tid = TIDX;
  float(*s)[65] = (float(*)[65])smem;
  __syncthreads();
#pragma unroll 4
  for (int i = 0; i < 16; i++) {
    int r = (tid >> 6) + 4 * i, n = nt * 64 + (tid & 63);
    s[r][tid & 63] = (n < N) ? src[(size_t)(kt * 64 + r) * N + n] : 0.f;
  }
  __syncthreads();
#pragma unroll 4
  for (int i = 0; i < 8; i++) {
    int nl = (tid >> 5) + 8 * i, n = nt * 64 + nl, kl = (tid & 31) * 2;
    if (n < N) *(unsigned*)(dst + (size_t)n * K + kt * 64 + kl) = pack2(s[kl][nl], s[kl + 1][nl]);
  }
}

__device__ void mod_item(const P& p, int item2, char* smem) {
  const int item = item2 >> 1, kh2 = item2 & 1;
  const int tid = TIDX, j = tid & 31, g = tid >> 5;
  const int col0 = item * 32;
  const float* W; const float* bias; int N, cw;
  if (col0 < 6144) { W = p.w_ada; bias = p.b_ada; N = 6144; cw = col0; }
  else { W = p.w_ada_f; bias = p.b_ada_f; N = 2048; cw = col0 - 6144; }
  float(*cs)[68] = (float(*)[68])smem;
  float acc[17];
#pragma unroll
  for (int s = 0; s < 17; s++) acc[s] = 0.f;
  for (int k0 = kh2 * 512; k0 < kh2 * 512 + 512; k0 += 64) {
    __syncthreads();
    {
      float cv[34];
#pragma unroll
      for (int i = 0; i < 34; i++) {
        const int idx = tid + i * 256, seq = idx >> 6, kk = idx & 63;
        cv[i] = seq < 8 ? p.c_prompt[seq * 1024 + k0 + kk] : p.c_sample[(seq - 8) * 1024 + k0 + kk];
      }
#pragma unroll
      for (int i = 0; i < 34; i++) {
        const int idx = tid + i * 256;
        cs[idx >> 6][idx & 63] = siluf_(cv[i]);
      }
    }
    __syncthreads();
#pragma unroll 1
    for (int kh = 0; kh < 2; kh++) {
      float wv[32];
#pragma unroll
      for (int k = 0; k < 32; k++) wv[k] = W[(size_t)(k0 + kh * 32 + k) * N + cw + j];
#pragma unroll 2
      for (int k4 = 0; k4 < 8; k4++) {
#pragma unroll
        for (int s = 0; s < 17; s++) {
          float4 c4 = *(const float4*)&cs[g * 17 + s][kh * 32 + k4 * 4];
          acc[s] += wv[k4 * 4] * c4.x + wv[k4 * 4 + 1] * c4.y + wv[k4 * 4 + 2] * c4.z + wv[k4 * 4 + 3] * c4.w;
        }
      }
    }
  }
  const float b = kh2 == 0 ? bias[cw + j] : 0.f;
#pragma unroll
  for (int s = 0; s < 17; s++) atomicAdd(&p.mod[(size_t)(g * 17 + s) * 8192 + col0 + j], acc[s] + b);
}

constexpr int J_MOD = 512, J_WIN = 16 * 101, J_WPA = 8 * 16, J_WPB = 256, J_WOUT = 256, J_WQ = 16 * 32, J_KEYS = 128,
              J_SHIFT = 64;
constexpr int J_LORA = 8 + 8 + 16;
constexpr int PH0_ITEMS = J_MOD + J_WIN + J_WPA + J_WPB + J_WOUT + J_WQ + J_LORA + J_KEYS + J_SHIFT;

__device__ void phase0(const P& p, int bid, int nb, char* smem) {
  for (int it = bid; it < PH0_ITEMS; it += nb) {
    int i = it;
    if (i < J_MOD) { mod_item(p, i, smem); continue; }
    i -= J_MOD;
    if (i < J_WIN) { transpose_tile(p.w_in, 1024, INCOLS, p.w_inT, i, smem); continue; }
    i -= J_WIN;
    if (i < J_WPA) { transpose_tile(p.w_pa, 512, 1024, p.w_paT, i, smem); continue; }
    i -= J_WPA;
    if (i < J_WPB) { transpose_tile(p.w_pb, 1024, 1024, p.w_pbT, i, smem); continue; }
    i -= J_WPB;
    if (i < J_WOUT) { transpose_tile(p.w_out, 1024, 1024, p.w_outT, i, smem); continue; }
    i -= J_WOUT;
    if (i < J_WQ) { transpose_tile(p.peer_wq, 1024, 2048, p.wqT, i, smem); continue; }
    i -= J_WQ;
    if (i < 8) { transpose_tile(p.rw_w2, 64, 512, p.w2T, i, smem); continue; }
    if (i < 16) { transpose_tile(p.rw_a2, 64, 512, p.a2T, i - 8, smem); continue; }
    if (i < 32) { transpose_tile(p.rw_g2, 128, 512, p.g2T, i - 16, smem); continue; }
    i -= J_LORA;
    const float* src; u16* dst;
    if (i < J_KEYS) { src = p.peer_keys + (size_t)i * 2048; dst = p.keysb + (size_t)i * 2048; }
    else { i -= J_KEYS; src = p.state_shift + (size_t)i * 2048; dst = p.xn + (size_t)NT * D + (size_t)i * 2048; }
    const float4* s4 = (const float4*)src + TIDX * 2;
    float4 a = s4[0], b = s4[1];
    uint4 o; o.x = pack2(a.x, a.y); o.y = pack2(a.z, a.w); o.z = pack2(b.x, b.y); o.w = pack2(b.z, b.w);
    *((uint4*)dst + TIDX) = o;
  }
}

template <bool SECOND>
__device__ void phase_norm(const P& p, int bid, int nb) {
  const int lane = TIDX & 63, wid = TIDX >> 6;
  const float* gam = SECOND ? p.norm2_g : p.norm1_g;
  for (int it = bid; it < NT / 4; it += nb) {
    const int n = it * 4 + wid;
    int seq, t, T; tok2seq(n, seq, t, T);
    const float* xr = SECOND ? p.out + O_Y + (size_t)n * D : xrow(p, n);
    const float* md = p.mod + (size_t)seq * 8192 + (SECOND ? 3072 : 0);
    float4 v[4];
    float ss = 0.f;
#pragma unroll
    for (int i = 0; i < 4; i++) {
      v[i] = ((const float4*)xr)[lane + 64 * i];
      ss += v[i].x * v[i].x + v[i].y * v[i].y + v[i].z * v[i].z + v[i].w * v[i].w;
    }
    ss = wave_sum(ss);
    const float rstd = rsqrtf(ss * (1.f / 1024.f) + 1e-6f);
    const bool last = (!SECOND) && (t == T - 1);
    float* so = seq_out(p.out, seq, O_PSHIFT, O_SSHIFT, 1024);
#pragma unroll
    for (int i = 0; i < 4; i++) {
      const int c = (lane + 64 * i) * 4;
      float4 g = *(const float4*)(gam + c), sh = *(const float4*)(md + c), sc = *(const float4*)(md + 1024 + c);
      float4 o;
      o.x = v[i].x * rstd * g.x * (1.f + sc.x) + sh.x;
      o.y = v[i].y * rstd * g.y * (1.f + sc.y) + sh.y;
      o.z = v[i].z * rstd * g.z * (1.f + sc.z) + sh.z;
      o.w = v[i].w * rstd * g.w * (1.f + sc.w) + sh.w;
      uint2 pk; pk.x = pack2(o.x, o.y); pk.y = pack2(o.z, o.w);
      *(uint2*)(p.xn + (size_t)n * D + c) = pk;
      if (last) *(float4*)(so + c) = o;
    }
  }
}

constexpr int P2_NT = 35, P2_MT = 137;
__device__ void phase2(const P& p, int bid, int nb, char* smem) {
  TileIter ti(bid, nb, P2_MT, P2_NT);
  int mt, nt;
  while (ti.next(mt, nt)) {
    f32x4 acc[4][4];
    zero_acc(acc);
    gemm_tile(p.xn, D, mt * 128, p.w_inT, D, nt * 128, D, acc, smem);
    ACC_FOREACH({
      const int gc = nt * 128 + col;
      if (gc < PCOLS) p.proj[(size_t)(mt * 128 + row) * PCOLS + gc] = f2bf(acc[m][n][j]);
    })
  }
}

__device__ void rwkv_lerp_item(const P& p, int item) {
  const int tid = TIDX;
  const int n0 = item * 8;
  int seq, t0, T; tok2seq(n0, seq, t0, T);
  uint4 pcv[7], ppv[7];
#pragma unroll
  for (int i = 0; i < 7; i++) {
    const int idx = tid + i * 256, tok = idx / 224, c = (idx % 224) * 8;
    const int n = n0 + tok, t = t0 + tok;
    pcv[i] = *(const uint4*)(p.proj + (size_t)n * PCOLS + c);
    const size_t prow = t > 0 ? (size_t)(n - 1) : (size_t)(NT + (seq >= 8 ? seq - 8 : 0));
    ppv[i] = *(const uint4*)(p.proj + prow * PCOLS + c);
    if (t == 0 && seq < 8) ppv[i] = make_uint4(0, 0, 0, 0);
  }
#pragma unroll
  for (int i = 0; i < 7; i++) {
    const int idx = tid + i * 256, tok = idx / 224, c = (idx % 224) * 8;
    const int n = n0 + tok;
    const float4 mu0 = *(const float4*)(p.rw_mu + c), mu1 = *(const float4*)(p.rw_mu + c + 4);
    const float mus[8] = {mu0.x, mu0.y, mu0.z, mu0.w, mu1.x, mu1.y, mu1.z, mu1.w};
    const unsigned pcs[4] = {pcv[i].x, pcv[i].y, pcv[i].z, pcv[i].w}, pps[4] = {ppv[i].x, ppv[i].y, ppv[i].z, ppv[i].w};
    unsigned o[4];
#pragma unroll
    for (int e = 0; e < 4; e++) {
      float a0 = bflo(pcs[e]), a1 = bfhi(pcs[e]), b0 = bflo(pps[e]), b1 = bfhi(pps[e]);
      float q0 = a0 + (b0 - a0) * mus[2 * e], q1 = a1 + (b1 - a1) * mus[2 * e + 1];
      if (c >= C_LW && c < C_LA) { q0 = tanhf(q0); q1 = tanhf(q1); }
      else if (c >= C_LG) { q0 = sigmoidf_(q0); q1 = sigmoidf_(q1); }
      o[e] = pack2(q0, q1);
    }
    u16* dst;
    if (c < 512) dst = p.prep + (size_t)n * 3584 + 512 + c;
    else if (c < 1024) dst = p.prep + (size_t)n * 3584 + 1024 + (c - 512);
    else if (c < 1536) dst = p.prep + (size_t)n * 3584 + 2560 + (c - 1024);
    else dst = p.lora + (size_t)n * 256 + (c - 1536);
    *(uint4*)dst = make_uint4(o[0], o[1], o[2], o[3]);
  }
}

__device__ void rwkv_lora_item(const P& p, int mt, int nt, char* smem) {
  const int tid = TIDX, lane = tid & 63, wid = tid >> 6, wr = wid >> 1, wc = wid & 1, fr = lane & 15, fq = lane >> 4;
  const int col0 = nt * 128;
  f32x4 acc[4][4];
  zero_acc(acc);
  gemm_tile<false>(p.lora, 256, mt * 128, p.w2T, 64, col0, 64, acc, smem);
  ACC_FOREACH({
    const int gc = col0 + col;
    const float wpre = p.rw_w0[gc] + acc[m][n][j];
    const float w = -softplusf_(-wpre) - 0.5f;
    p.prep[(size_t)(mt * 128 + row) * 3584 + gc] = f2bf(-expf(w));
  })
  zero_acc(acc);
  gemm_tile<false>(p.lora + 128, 256, mt * 128, p.g2T, 128, col0, 128, acc, smem);
  ACC_FOREACH({ p.prep[(size_t)(mt * 128 + row) * 3584 + 3072 + col0 + col] = f2bf(acc[m][n][j]); })
  zero_acc(acc);
  gemm_tile<false>(p.lora + 64, 256, mt * 128, p.a2T, 64, col0, 64, acc, smem);
  float a0c[4], kkc[4], kac[4];
#pragma unroll
  for (int n = 0; n < 4; n++) {
    const int gc = col0 + wc * 64 + n * 16 + fr;
    a0c[n] = p.rw_a0[gc]; kkc[n] = p.rw_k_k[gc]; kac[n] = p.rw_k_a[gc];
  }
#pragma unroll
  for (int m = 0; m < 4; m++)
#pragma unroll
    for (int j = 0; j < 4; j++) {
      const int row = mt * 128 + wr * 64 + m * 16 + fq * 4 + j;
      u16* pr = p.prep + (size_t)row * 3584 + col0 + wc * 64 + fr;
      float kx[4], kkv[4], av[4];
      float ss = 0.f;
#pragma unroll
      for (int n = 0; n < 4; n++) {
        kx[n] = bf2f(pr[1024 + n * 16]);
        av[n] = sigmoidf_(a0c[n] + acc[m][n][j]);
        kkv[n] = kx[n] * kkc[n];
        ss += kkv[n] * kkv[n];
      }
      ss = allreduce16(ss);
      const float inv = 1.f / fmaxf(sqrtf(ss), 1e-12f);
#pragma unroll
      for (int n = 0; n < 4; n++) {
        const float kk = kkv[n] * inv;
        pr[1024 + n * 16] = f2bf(kx[n] * (1.f + (av[n] - 1.f) * kac[n]));
        pr[1536 + n * 16] = f2bf(kk);
        pr[2048 + n * 16] = f2bf(kk * av[n]);
      }
    }
}

__device__ void conv_prep_item(const P& p, int item) {
  const int tid = TIDX;
  const int n0 = item * 8;
  int seq, t0, T; tok2seq(n0, seq, t0, T);
  if (tid < 192) {
    const int c = tid * 8;
    uint4 rows[11];
#pragma unroll
    for (int j = 0; j < 11; j++) {
      const int tt = t0 - 3 + j;
      rows[j] = make_uint4(0, 0, 0, 0);
      if (tt >= 0) rows[j] = *(const uint4*)(p.proj + (size_t)(n0 - 3 + j) * PCOLS + C_XBC + c);
      else if (seq >= 8) {
        const float* sc = p.state_conv + ((size_t)(seq - 8) * 3 + (tt + 3)) * 1536 + c;
        const float4 a = *(const float4*)sc, b = *(const float4*)(sc + 4);
        rows[j] = make_uint4(pack2(a.x, a.y), pack2(a.z, a.w), pack2(b.x, b.y), pack2(b.z, b.w));
      }
    }
    float w[4][8], cb[8];
#pragma unroll
    for (int j = 0; j < 4; j++) {
      const float4 a = *(const float4*)(p.conv_w + j * 1536 + c), b = *(const float4*)(p.conv_w + j * 1536 + c + 4);
      w[j][0] = a.x; w[j][1] = a.y; w[j][2] = a.z; w[j][3] = a.w; w[j][4] = b.x; w[j][5] = b.y; w[j][6] = b.z; w[j][7] = b.w;
    }
    {
      const float4 a = *(const float4*)(p.conv_b + c), b = *(const float4*)(p.conv_b + c + 4);
      cb[0] = a.x; cb[1] = a.y; cb[2] = a.z; cb[3] = a.w; cb[4] = b.x; cb[5] = b.y; cb[6] = b.z; cb[7] = b.w;
    }
#pragma unroll
    for (int k = 0; k < 8; k++) {
      float o[8];
#pragma unroll
      for (int e = 0; e < 8; e++) o[e] = cb[e];
#pragma unroll
      for (int j = 0; j < 4; j++) {
        const uint4 r = rows[k + j];
        const unsigned rs[4] = {r.x, r.y, r.z, r.w};
#pragma unroll
        for (int e = 0; e < 4; e++) { o[2 * e] += bflo(rs[e]) * w[j][2 * e]; o[2 * e + 1] += bfhi(rs[e]) * w[j][2 * e + 1]; }
      }
      *(uint4*)(p.xc + (size_t)(n0 + k) * 1536 + c) =
          make_uint4(pack2(siluf_(o[0]), siluf_(o[1])), pack2(siluf_(o[2]), siluf_(o[3])), pack2(siluf_(o[4]), siluf_(o[5])),
                     pack2(siluf_(o[6]), siluf_(o[7])));
    }
    if (t0 + 8 == T) {
      float* co = seq_out(p.out, seq, O_PCONV, O_SCONV, 3 * 1536);
#pragma unroll
      for (int j = 0; j < 3; j++) {
        const uint4 r = rows[8 + j];
        *(float4*)(co + j * 1536 + c) = make_float4(bflo(r.x), bfhi(r.x), bflo(r.y), bfhi(r.y));
        *(float4*)(co + j * 1536 + c + 4) = make_float4(bflo(r.z), bfhi(r.z), bflo(r.w), bfhi(r.w));
      }
    }
  } else if (tid < 192 + 32) {
    const int i = tid - 192;
#pragma unroll
    for (int e = 0; e < 4; e++) {
      const int pi = i * 4 + e, k = pi >> 4, h = pi & 15, n = n0 + k;
      const float raw = bf2f(p.proj[(size_t)n * PCOLS + C_DT + h]) + p.dt_bias[h];
      const float dt = softplusf_(raw);
      const float dA = -dt * expf(p.A_log[h]);
      p.dtb[n * 16 + h] = dt;
      p.decb[n * 16 + h] = dA;
    }
  }
}

__device__ void phase3(const P& p, int bid, int nb, char* smem) {
  for (int it = bid; it < 2 * (NT / 8); it += nb) {
    if (it < NT / 8) rwkv_lerp_item(p, it);
    else conv_prep_item(p, it - NT / 8);
  }
}
__device__ void phase3b(const P& p, int bid, int nb, char* smem) {
  for (int it = bid; it < 136 * 4; it += nb) rwkv_lora_item(p, it >> 2, it & 3, smem);
}

constexpr int TC = 32;
__device__ __forceinline__ void bf8_to_f(uint4 u, float4& lo, float4& hi) {
  lo = make_float4(bflo(u.x), bfhi(u.x), bflo(u.y), bfhi(u.y));
  hi = make_float4(bflo(u.z), bfhi(u.z), bflo(u.w), bfhi(u.w));
}
__device__ void rwkv_scan_item(const P& p, int seq, int h, int qr, char* smem) {
  const int T = seq < 8 ? 2048 : 8, nbase = seq < 8 ? seq * 2048 : NP + (seq - 8) * 8;
  float* Ld = (float*)smem;
  float* Lr = Ld + TC * 64; float* Lk = Lr + TC * 64; float* Lkk = Lk + TC * 64; float* Lb = Lkk + TC * 64;
  float* Lv = Lb + TC * 64;
  const int tid = TIDX, w = tid >> 6, lane = tid & 63, rl = w * 4 + (lane >> 4), ks = lane & 15;
  const int v = qr * 16 + rl;
  float S0 = 0.f, S1 = 0.f, S2 = 0.f, S3 = 0.f;
  if (seq >= 8) {
    float4 s = *(const float4*)(p.state_wkv + (((size_t)(seq - 8) * 8 + h) * 64 + v) * 64 + ks * 4);
    S0 = s.x; S1 = s.y; S2 = s.z; S3 = s.w;
  }
  const int st = tid >> 3, sk8 = (tid & 7) * 8;
  const int vt = tid >> 1, vr8 = (tid & 1) * 8;
  uint4 g0, g1, g2, g3, g4, gv;
  g0 = g1 = g2 = g3 = g4 = gv = make_uint4(0, 0, 0, 0);
#define RW_GLOAD(c0_)                                                                           \
  {                                                                                             \
    const int tcn = min(TC, T - (c0_));                                                         \
    if (st < tcn) {                                                                             \
      const u16* base = p.prep + (size_t)(nbase + (c0_) + st) * 3584 + h * 64 + sk8;            \
      g0 = *(const uint4*)(base); g1 = *(const uint4*)(base + 512); g2 = *(const uint4*)(base + 1024); \
      g3 = *(const uint4*)(base + 1536); g4 = *(const uint4*)(base + 2048);                     \
    }                                                                                           \
    if (tid < 64 && vt < tcn)                                                                   \
      gv = *(const uint4*)(p.prep + (size_t)(nbase + (c0_) + vt) * 3584 + 2560 + h * 64 + qr * 16 + vr8); \
  }
  RW_GLOAD(0);
  for (int c0 = 0; c0 < T; c0 += TC) {
    const int tc = min(TC, T - c0);
    __syncthreads();
    {
      float4 lo, hi;
      bf8_to_f(g0, lo, hi);
      lo.x = __expf(lo.x); lo.y = __expf(lo.y); lo.z = __expf(lo.z); lo.w = __expf(lo.w);
      hi.x = __expf(hi.x); hi.y = __expf(hi.y); hi.z = __expf(hi.z); hi.w = __expf(hi.w);
      *(float4*)(Ld + st * 64 + sk8) = lo; *(float4*)(Ld + st * 64 + sk8 + 4) = hi;
      bf8_to_f(g1, lo, hi); *(float4*)(Lr + st * 64 + sk8) = lo; *(float4*)(Lr + st * 64 + sk8 + 4) = hi;
      bf8_to_f(g2, lo, hi); *(float4*)(Lk + st * 64 + sk8) = lo; *(float4*)(Lk + st * 64 + sk8 + 4) = hi;
      bf8_to_f(g3, lo, hi); *(float4*)(Lkk + st * 64 + sk8) = lo; *(float4*)(Lkk + st * 64 + sk8 + 4) = hi;
      bf8_to_f(g4, lo, hi); *(float4*)(Lb + st * 64 + sk8) = lo; *(float4*)(Lb + st * 64 + sk8 + 4) = hi;
      if (tid < 64) { bf8_to_f(gv, lo, hi); *(float4*)(Lv + vt * 16 + vr8) = lo; *(float4*)(Lv + vt * 16 + vr8 + 4) = hi; }
    }
    __syncthreads();
    if (c0 + TC < T) RW_GLOAD(c0 + TC);
    u16* yo = p.proj + (size_t)(nbase + c0) * PCOLS + h * 64 + v;
    float4 kkA, dA_, bA, kA, rA, kkB, dB_, bB, kB, rB;
    float vA, vB;
#define RW_LD(KK, DD, BB, KX, RR, VV, t_)                                                        \
  {                                                                                              \
    KK = *(const float4*)(Lkk + (t_) * 64 + ks * 4); DD = *(const float4*)(Ld + (t_) * 64 + ks * 4); \
    BB = *(const float4*)(Lb + (t_) * 64 + ks * 4); KX = *(const float4*)(Lk + (t_) * 64 + ks * 4);  \
    RR = *(const float4*)(Lr + (t_) * 64 + ks * 4); VV = Lv[(t_) * 16 + rl];                      \
  }
#define RW_STEP(KK, DD, BB, KX, RR, VV, t_)                                                      \
  {                                                                                              \
    float sk = (S0 * KK.x + S1 * KK.y) + (S2 * KK.z + S3 * KK.w);                                \
    sk = allreduce16(sk);                                                                        \
    S0 = S0 * DD.x + (VV * KX.x - sk * BB.x);                                                    \
    S1 = S1 * DD.y + (VV * KX.y - sk * BB.y);                                                    \
    S2 = S2 * DD.z + (VV * KX.z - sk * BB.z);                                                    \
    S3 = S3 * DD.w + (VV * KX.w - sk * BB.w);                                                    \
    float y = (S0 * RR.x + S1 * RR.y) + (S2 * RR.z + S3 * RR.w);                                 \
    y = allreduce16(y);                                                                          \
    if (ks == 0) yo[(size_t)(t_) * PCOLS] = f2bf(y);                                             \
  }
    RW_LD(kkA, dA_, bA, kA, rA, vA, 0)
    for (int tt = 0; tt < tc; tt += 2) {
      RW_LD(kkB, dB_, bB, kB, rB, vB, tt + 1)
      RW_STEP(kkA, dA_, bA, kA, rA, vA, tt)
      const int tn = min(tt + 2, tc - 1);
      RW_LD(kkA, dA_, bA, kA, rA, vA, tn)
      RW_STEP(kkB, dB_, bB, kB, rB, vB, tt + 1)
    }
  }
  float* so = seq_out(p.out, seq, O_PWKV, O_SWKV, 8 * 4096);
  *(float4*)(so + ((size_t)h * 64 + v) * 64 + ks * 4) = make_float4(S0, S1, S2, S3);
}

__device__ void ssm_scan_item(const P& p, int seq, int head, int half, char* smem) {
  const int T = seq < 8 ? 2048 : 8, nbase = seq < 8 ? seq * 2048 : NP + (seq - 8) * 8;
  float* LB = (float*)smem;
  float* LC = LB + TC * 128;
  float* Lx = LC + TC * 128;
  float* Ldt = Lx + TC * 32;
  float* Ldec = Ldt + TC;
  const int tid = TIDX, pl = tid >> 3, ns = tid & 7;
  const int pp = half * 32 + pl, g = head >> 3;
  const float Dk = p.D_skip[head];
  float hs[16];
#pragma unroll
  for (int j = 0; j < 16; j++) hs[j] = 0.f;
  if (seq >= 8) {
    const float4* s4 = (const float4*)(p.state_ssm + (((size_t)(seq - 8) * 16 + head) * 64 + pp) * 128 + ns * 16);
#pragma unroll
    for (int j = 0; j < 4; j++) { float4 s = s4[j]; hs[4 * j] = s.x; hs[4 * j + 1] = s.y; hs[4 * j + 2] = s.z; hs[4 * j + 3] = s.w; }
  }
  uint4 gb0, gb1, gb2, gb3, gx; float gdt = 0.f, gdec = 0.f;
  gb0 = gb1 = gb2 = gb3 = gx = make_uint4(0, 0, 0, 0);
  const int bt = tid >> 5, bch = tid & 31;
  const u16* bsrc = p.xc + 1024 + (bch < 16 ? 0 : 256) + g * 128 + (bch & 15) * 8;
  const int xt = tid >> 2, xr8 = (tid & 3) * 8;
#define SS_GLOAD(c0_)                                                                          \
  {                                                                                            \
    const int tcn = min(TC, T - (c0_));                                                        \
    const size_t nb_ = (size_t)(nbase + (c0_));                                                \
    if (bt < tcn) gb0 = *(const uint4*)(bsrc + (nb_ + bt) * 1536);                             \
    if (bt + 8 < tcn) gb1 = *(const uint4*)(bsrc + (nb_ + bt + 8) * 1536);                     \
    if (bt + 16 < tcn) gb2 = *(const uint4*)(bsrc + (nb_ + bt + 16) * 1536);                   \
    if (bt + 24 < tcn) gb3 = *(const uint4*)(bsrc + (nb_ + bt + 24) * 1536);                   \
    if (tid < 128 && xt < tcn) gx = *(const uint4*)(p.xc + (nb_ + xt) * 1536 + head * 64 + half * 32 + xr8); \
    if (tid < tcn) { gdt = p.dtb[(nb_ + tid) * 16 + head]; gdec = p.decb[(nb_ + tid) * 16 + head]; } \
  }
  SS_GLOAD(0);
  for (int c0 = 0; c0 < T; c0 += TC) {
    const int tc = min(TC, T - c0);
    __syncthreads();
    {
      float* dstb = (bch < 16 ? LB : LC) + (bch & 15) * 8;
      float4 lo, hi;
      bf8_to_f(gb0, lo, hi); *(float4*)(dstb + bt * 128) = lo; *(float4*)(dstb + bt * 128 + 4) = hi;
      bf8_to_f(gb1, lo, hi); *(float4*)(dstb + (bt + 8) * 128) = lo; *(float4*)(dstb + (bt + 8) * 128 + 4) = hi;
      bf8_to_f(gb2, lo, hi); *(float4*)(dstb + (bt + 16) * 128) = lo; *(float4*)(dstb + (bt + 16) * 128 + 4) = hi;
      bf8_to_f(gb3, lo, hi); *(float4*)(dstb + (bt + 24) * 128) = lo; *(float4*)(dstb + (bt + 24) * 128 + 4) = hi;
      if (tid < 128) { bf8_to_f(gx, lo, hi); *(float4*)(Lx + xt * 32 + xr8) = lo; *(float4*)(Lx + xt * 32 + xr8 + 4) = hi; }
      if (tid < TC) { Ldt[tid] = gdt; Ldec[tid] = __expf(gdec); }
    }
    __syncthreads();
    if (c0 + TC < T) SS_GLOAD(c0 + TC);
    u16* yo = p.proj + (size_t)(nbase + c0) * PCOLS + C_XBC + head * 64 + pp;
    float4 B0 = *(const float4*)(LB + ns * 16), B1 = *(const float4*)(LB + ns * 16 + 4), B2 = *(const float4*)(LB + ns * 16 + 8),
           B3 = *(const float4*)(LB + ns * 16 + 12);
    float4 C0 = *(const float4*)(LC + ns * 16), C1 = *(const float4*)(LC + ns * 16 + 4), C2 = *(const float4*)(LC + ns * 16 + 8),
           C3 = *(const float4*)(LC + ns * 16 + 12);
    float xv = Lx[pl], dtv = Ldt[0], dec = Ldec[0];
    for (int tt = 0; tt < tc; tt++) {
      const int tn = min(tt + 1, tc - 1);
      const float* nB = LB + tn * 128 + ns * 16;
      const float* nC = LC + tn * 128 + ns * 16;
      const float4 nB0 = *(const float4*)(nB), nB1 = *(const float4*)(nB + 4), nB2 = *(const float4*)(nB + 8), nB3 = *(const float4*)(nB + 12);
      const float4 nC0 = *(const float4*)(nC), nC1 = *(const float4*)(nC + 4), nC2 = *(const float4*)(nC + 8), nC3 = *(const float4*)(nC + 12);
      const float nxv = Lx[tn * 32 + pl], ndt = Ldt[tn], ndec = Ldec[tn];
      const float dtx = dtv * xv;
      hs[0] = hs[0] * dec + dtx * B0.x; hs[1] = hs[1] * dec + dtx * B0.y; hs[2] = hs[2] * dec + dtx * B0.z; hs[3] = hs[3] * dec + dtx * B0.w;
      hs[4] = hs[4] * dec + dtx * B1.x; hs[5] = hs[5] * dec + dtx * B1.y; hs[6] = hs[6] * dec + dtx * B1.z; hs[7] = hs[7] * dec + dtx * B1.w;
      hs[8] = hs[8] * dec + dtx * B2.x; hs[9] = hs[9] * dec + dtx * B2.y; hs[10] = hs[10] * dec + dtx * B2.z; hs[11] = hs[11] * dec + dtx * B2.w;
      hs[12] = hs[12] * dec + dtx * B3.x; hs[13] = hs[13] * dec + dtx * B3.y; hs[14] = hs[14] * dec + dtx * B3.z; hs[15] = hs[15] * dec + dtx * B3.w;
      float y0 = hs[0] * C0.x + hs[1] * C0.y + hs[2] * C0.z + hs[3] * C0.w;
      float y1 = hs[4] * C1.x + hs[5] * C1.y + hs[6] * C1.z + hs[7] * C1.w;
      float y2 = hs[8] * C2.x + hs[9] * C2.y + hs[10] * C2.z + hs[11] * C2.w;
      float y3 = hs[12] * C3.x + hs[13] * C3.y + hs[14] * C3.z + hs[15] * C3.w;
      float yp = allreduce8((y0 + y1) + (y2 + y3));
      if (ns == 0) yo[(size_t)tt * PCOLS] = f2bf(yp + Dk * xv);
      B0 = nB0; B1 = nB1; B2 = nB2; B3 = nB3; C0 = nC0; C1 = nC1; C2 = nC2; C3 = nC3; xv = nxv; dtv = ndt; dec = ndec;
    }
  }
  float* so = seq_out(p.out, seq, O_PSSM, O_SSSM, 16 * 8192);
  float4* o4 = (float4*)(so + ((size_t)head * 64 + pp) * 128 + ns * 16);
#pragma unroll
  for (int j = 0; j < 4; j++) o4[j] = make_float4(hs[4 * j], hs[4 * j + 1], hs[4 * j + 2], hs[4 * j + 3]);
}

__device__ void ssd_prompt_item(const P& p, int seq, int head, char* smem) {
  const int nbase = seq * 2048, g = head >> 3;
  char* sC = smem;
  char* sB = smem + 17408;
  char* sBT = smem + 34816;
  char* sXT = smem + 53248;
  char* sH = smem + 62464;
  float* sS = (float*)(smem + 79872);
  const int tid = TIDX, lane = tid & 63, w = tid >> 6, fr = lane & 15, q = lane >> 4;
  const float Dk = p.D_skip[head];
  f32x4 H[8];
#pragma unroll
  for (int i = 0; i < 8; i++) H[i] = f32x4{0.f, 0.f, 0.f, 0.f};
  __syncthreads();
  for (int i = tid; i < 17408 / 16; i += 256) *(uint4*)(sH + i * 16) = make_uint4(0, 0, 0, 0);
  uint4 gB0, gB1, gB2, gB3, gC0, gC1, gC2, gC3, gX0, gX1;
  float gdt, gdA;
#define SSD_LOAD(t0_)                                                                         \
  {                                                                                           \
    const size_t nn_ = (size_t)(nbase + (t0_) + lane);                                        \
    const u16* row_ = p.xc + nn_ * 1536;                                                      \
    const u16* rb_ = row_ + 1024 + g * 128 + w * 32;                                          \
    gB0 = *(const uint4*)(rb_); gB1 = *(const uint4*)(rb_ + 8); gB2 = *(const uint4*)(rb_ + 16); gB3 = *(const uint4*)(rb_ + 24); \
    gC0 = *(const uint4*)(rb_ + 256); gC1 = *(const uint4*)(rb_ + 264); gC2 = *(const uint4*)(rb_ + 272); gC3 = *(const uint4*)(rb_ + 280); \
    gX0 = *(const uint4*)(row_ + head * 64 + w * 16); gX1 = *(const uint4*)(row_ + head * 64 + w * 16 + 8); \
    gdt = p.dtb[nn_ * 16 + head]; gdA = p.decb[nn_ * 16 + head];                              \
  }
#define SSD_PUT_T(dst_, r0_, u_, sc_)                                                         \
  {                                                                                           \
    const unsigned us_[4] = {u_.x, u_.y, u_.z, u_.w};                                         \
    _Pragma("unroll") for (int e = 0; e < 4; e++) {                                           \
      *(u16*)(dst_ + ((r0_) + 2 * e) * 144 + lane * 2) = f2bf(bflo(us_[e]) * (sc_));          \
      *(u16*)(dst_ + ((r0_) + 2 * e + 1) * 144 + lane * 2) = f2bf(bfhi(us_[e]) * (sc_));      \
    }                                                                                         \
  }
  SSD_LOAD(0);
#pragma unroll 1
  for (int c = 0; c < 32; c++) {
    const int t0 = c * 64;
    float cs = gdA;
#pragma unroll
    for (int o = 1; o < 64; o <<= 1) { const float v = __shfl_up(cs, o, 64); if (lane >= o) cs += v; }
    const float cs63 = __shfl(cs, 63, 64);
    const float wt = gdt * __expf(cs63 - cs);
    __syncthreads();
    if (w == 0) { sS[lane] = cs; sS[64 + lane] = __expf(cs); sS[128 + lane] = gdt; }
    {
      char* rc = sC + lane * 272 + w * 64;
      char* rb = sB + lane * 272 + w * 64;
      *(uint4*)(rc) = gC0; *(uint4*)(rc + 16) = gC1; *(uint4*)(rc + 32) = gC2; *(uint4*)(rc + 48) = gC3;
      *(uint4*)(rb) = gB0; *(uint4*)(rb + 16) = gB1; *(uint4*)(rb + 32) = gB2; *(uint4*)(rb + 48) = gB3;
      SSD_PUT_T(sBT, w * 32, gB0, wt) SSD_PUT_T(sBT, w * 32 + 8, gB1, wt) SSD_PUT_T(sBT, w * 32 + 16, gB2, wt)
      SSD_PUT_T(sBT, w * 32 + 24, gB3, wt) SSD_PUT_T(sXT, w * 16, gX0, 1.f) SSD_PUT_T(sXT, w * 16 + 8, gX1, 1.f)
    }
    __syncthreads();
    if (c + 1 < 32) SSD_LOAD(t0 + 64);
    f32x4 cb[4], yo[4];
#pragma unroll
    for (int i = 0; i < 4; i++) { cb[i] = f32x4{0.f, 0.f, 0.f, 0.f}; yo[i] = f32x4{0.f, 0.f, 0.f, 0.f}; }
    {
      bf16x8 af[4];
#pragma unroll
      for (int ks = 0; ks < 4; ks++) af[ks] = *(const bf16x8*)(sC + (16 * w + fr) * 272 + ks * 64 + q * 16);
#pragma unroll
      for (int nn = 0; nn < 4; nn++)
#pragma unroll
        for (int ks = 0; ks < 4; ks++) {
          const bf16x8 bb = *(const bf16x8*)(sB + (16 * nn + fr) * 272 + ks * 64 + q * 16);
          cb[nn] = __builtin_amdgcn_mfma_f32_16x16x32_bf16(af[ks], bb, cb[nn], 0, 0, 0);
        }
#pragma unroll
      for (int pt = 0; pt < 4; pt++)
#pragma unroll
        for (int ks = 0; ks < 4; ks++) {
          const bf16x8 bb = *(const bf16x8*)(sH + (16 * pt + fr) * 272 + ks * 64 + q * 16);
          yo[pt] = __builtin_amdgcn_mfma_f32_16x16x32_bf16(af[ks], bb, yo[pt], 0, 0, 0);
        }
    }
    __syncthreads();
#pragma unroll
    for (int j = 0; j < 4; j++) {
      const int l = 16 * w + q * 4 + j;
      const float csl = sS[l];
#pragma unroll
      for (int nn = 0; nn < 4; nn++) {
        const int sidx = 16 * nn + fr;
        const float gv = (sidx <= l) ? cb[nn][j] * __expf(csl - sS[sidx]) * sS[128 + sidx] : 0.f;
        *(u16*)(sB + l * 144 + sidx * 2) = f2bf(gv);
      }
    }
    f32x4 yd[4];
#pragma unroll
    for (int i = 0; i < 4; i++) yd[i] = f32x4{0.f, 0.f, 0.f, 0.f};
#pragma unroll
    for (int ks = 0; ks < 2; ks++) {
      const bf16x8 aa = *(const bf16x8*)(sB + (16 * w + fr) * 144 + ks * 64 + q * 16);
#pragma unroll
      for (int pt = 0; pt < 4; pt++) {
        const bf16x8 bb = *(const bf16x8*)(sXT + (16 * pt + fr) * 144 + ks * 64 + q * 16);
        yd[pt] = __builtin_amdgcn_mfma_f32_16x16x32_bf16(aa, bb, yd[pt], 0, 0, 0);
      }
    }
#pragma unroll
    for (int j = 0; j < 4; j++) {
      const int l = 16 * w + q * 4 + j;
      const float el = sS[64 + l];
      u16* yrow = p.proj + (size_t)(nbase + t0 + l) * PCOLS + C_XBC + head * 64 + fr;
#pragma unroll
      for (int pt = 0; pt < 4; pt++) {
        const float xs = bf2f(*(const u16*)(sXT + (16 * pt + fr) * 144 + l * 2));
        yrow[16 * pt] = f2bf(yd[pt][j] + el * yo[pt][j] + Dk * xs);
      }
    }
    const float ach = __expf(cs63);
#pragma unroll
    for (int nt = 0; nt < 8; nt++) { H[nt][0] *= ach; H[nt][1] *= ach; H[nt][2] *= ach; H[nt][3] *= ach; }
#pragma unroll
    for (int ks = 0; ks < 2; ks++) {
      const bf16x8 aa = *(const bf16x8*)(sXT + (16 * w + fr) * 144 + ks * 64 + q * 16);
#pragma unroll
      for (int nt = 0; nt < 8; nt++) {
        const bf16x8 bb = *(const bf16x8*)(sBT + (16 * nt + fr) * 144 + ks * 64 + q * 16);
        H[nt] = __builtin_amdgcn_mfma_f32_16x16x32_bf16(aa, bb, H[nt], 0, 0, 0);
      }
    }
#pragma unroll
    for (int nt = 0; nt < 8; nt++)
#pragma unroll
      for (int j = 0; j < 4; j++) *(u16*)(sH + (16 * w + q * 4 + j) * 272 + (16 * nt + fr) * 2) = f2bf(H[nt][j]);
  }
  float* so = p.out + O_PSSM + ((size_t)seq * 16 + head) * 8192;
#pragma unroll
  for (int nt = 0; nt < 8; nt++)
#pragma unroll
    for (int j = 0; j < 4; j++) so[(16 * w + q * 4 + j) * 128 + 16 * nt + fr] = H[nt][j];
  __syncthreads();
}

constexpr int P4_RP = 256, P4_SP = 128, P4_RS = 4096, P4_SS = 4096;
#define XB_QUEUE 3600
__device__ void phase4(const P& p, int bid, int nb, char* smem) {
  for (int it = bid; it < P4_RP + P4_SP; it += nb) {
    if (it < P4_RP) rwkv_scan_item(p, it >> 5, (it >> 2) & 7, it & 3, smem);
    else { const int i = it - P4_RP; ssd_prompt_item(p, i >> 4, i & 15, smem); }
  }
  volatile int* slot = (volatile int*)(smem + LDS_BYTES - 32);
  for (;;) {
    __syncthreads();
    if (TIDX == 0) *slot = (int)atomicAdd(&p.bar[XB_QUEUE], 1u);
    __syncthreads();
    int i = *slot;
    if (i >= P4_RS + P4_SS) break;
    if (i < P4_RS) rwkv_scan_item(p, 8 + (i >> 5), (i >> 2) & 7, i & 3, smem);
    else { i -= P4_RS; ssm_scan_item(p, 8 + (i >> 5), (i >> 1) & 15, i & 1, smem); }
  }
}

__device__ void phase5(const P& p, int bid, int nb) {
  const int lane = TIDX & 63, wid = TIDX >> 6;
  for (int it = bid; it < NT / 4; it += nb) {
    const int n = it * 4 + wid;
    {
      const int c = lane * 8;
      uint4 yu = *(const uint4*)(p.proj + (size_t)n * PCOLS + c);
      const u16* pr = p.prep + (size_t)n * 3584 + c;
      uint4 ru = *(const uint4*)(pr + 512), ku = *(const uint4*)(pr + 1024), vu = *(const uint4*)(pr + 2560),
            gu = *(const uint4*)(pr + 3072);
      unsigned ys[4] = {yu.x, yu.y, yu.z, yu.w}, rs[4] = {ru.x, ru.y, ru.z, ru.w}, ks_[4] = {ku.x, ku.y, ku.z, ku.w},
               vs[4] = {vu.x, vu.y, vu.z, vu.w}, gs[4] = {gu.x, gu.y, gu.z, gu.w};
      float y[8], r[8], k[8], v[8], g[8];
#pragma unroll
      for (int e = 0; e < 4; e++) {
        y[2 * e] = bflo(ys[e]); y[2 * e + 1] = bfhi(ys[e]);
        r[2 * e] = bflo(rs[e]); r[2 * e + 1] = bfhi(rs[e]);
        k[2 * e] = bflo(ks_[e]); k[2 * e + 1] = bfhi(ks_[e]);
        v[2 * e] = bflo(vs[e]); v[2 * e + 1] = bfhi(vs[e]);
        g[2 * e] = bflo(gs[e]); g[2 * e + 1] = bfhi(gs[e]);
      }
      float s = 0.f, bn = 0.f;
#pragma unroll
      for (int e = 0; e < 8; e++) { s += y[e]; bn += r[e] * k[e] * p.rw_r_k[c + e]; }
      s = allreduce8(s); bn = allreduce8(bn);
      const float mean = s * (1.f / 64.f);
      float vr = 0.f;
#pragma unroll
      for (int e = 0; e < 8; e++) { const float d = y[e] - mean; vr += d * d; }
      vr = allreduce8(vr) * (1.f / 64.f);
      const float rs_ = rsqrtf(vr + 64e-5f);
      float o[8];
#pragma unroll
      for (int e = 0; e < 8; e++) {
        const float yn = (y[e] - mean) * rs_ * p.rw_ln_w[c + e] + p.rw_ln_b[c + e];
        o[e] = (yn + bn * v[e]) * g[e];
      }
      uint4 ou; ou.x = pack2(o[0], o[1]); ou.y = pack2(o[2], o[3]); ou.z = pack2(o[4], o[5]); ou.w = pack2(o[6], o[7]);
      *(uint4*)(p.oa + (size_t)n * 512 + c) = ou;
    }
    {
      const int c = lane * 16;
      float yv[16];
      float ss = 0.f;
#pragma unroll
      for (int hh = 0; hh < 2; hh++) {
        uint4 yu = *(const uint4*)(p.proj + (size_t)n * PCOLS + C_XBC + c + hh * 8);
        uint4 zu = *(const uint4*)(p.proj + (size_t)n * PCOLS + C_Z + c + hh * 8);
        unsigned ys[4] = {yu.x, yu.y, yu.z, yu.w}, zs[4] = {zu.x, zu.y, zu.z, zu.w};
#pragma unroll
        for (int e = 0; e < 4; e++) {
          const float a = bflo(ys[e]) * siluf_(bflo(zs[e])), b = bfhi(ys[e]) * siluf_(bfhi(zs[e]));
          yv[hh * 8 + 2 * e] = a; yv[hh * 8 + 2 * e + 1] = b;
          ss += a * a + b * b;
        }
      }
#pragma unroll
      for (int o = 16; o >= 1; o >>= 1) ss += __shfl_xor(ss, o, 64);
      const float rstd = rsqrtf(ss * (1.f / 512.f) + 1e-6f);
      unsigned ou[8];
#pragma unroll
      for (int e = 0; e < 8; e++)
        ou[e] = pack2(yv[2 * e] * rstd * p.ssm_norm_w[c + 2 * e], yv[2 * e + 1] * rstd * p.ssm_norm_w[c + 2 * e + 1]);
      *(uint4*)(p.ob + (size_t)n * 1024 + c) = make_uint4(ou[0], ou[1], ou[2], ou[3]);
      *(uint4*)(p.ob + (size_t)n * 1024 + c + 8) = make_uint4(ou[4], ou[5], ou[6], ou[7]);
    }
  }
}

__device__ void phase6(const P& p, int bid, int nb, char* smem) {
  TileIter ti(bid, nb, 136, 8);
  int mt, nt;
  while (ti.next(mt, nt)) {
    f32x4 ac[4][4];
    u16* Lm = (u16*)(smem + 2 * 128 * LROW);
    zero_acc(ac);
    gemm_tile(p.xn, D, mt * 128, p.w_inT + (size_t)G_A * D, D, nt * 128, D, ac, smem);
    ACC_FOREACH({ Lm[row * 136 + col] = f2bf(sigmoidf_(ac[m][n][j])); })
    zero_acc(ac);
    gemm_tile(p.oa, 512, mt * 128, p.w_paT, 512, nt * 128, 512, ac, smem);
    ACC_FOREACH({ Lm[row * 136 + col] = f2bf(bf2f(Lm[row * 136 + col]) * ac[m][n][j]); })
    zero_acc(ac);
    gemm_tile(p.xn, D, mt * 128, p.w_inT + (size_t)G_B * D, D, nt * 128, D, ac, smem);
    ACC_FOREACH({ p.merged[(size_t)(mt * 128 + row) * D + nt * 128 + col] = f2bf(sigmoidf_(ac[m][n][j])); })
    zero_acc(ac);
    gemm_tile(p.ob, D, mt * 128, p.w_pbT, D, nt * 128, D, ac, smem);
    ACC_FOREACH({
      u16* mp = p.merged + (size_t)(mt * 128 + row) * D + nt * 128 + col;
      *mp = f2bf(bf2f(Lm[row * 136 + col]) + bf2f(*mp) * ac[m][n][j]);
    })
  }
}

constexpr int P7_G = 136 * 8, P7_CV = 16384;
constexpr float U_SCALE = 256.f, V_SCALE = 32.f;
__device__ void phase7(const P& p, int bid, int nb, char* smem) {
  {
    TileIter ti(bid, nb, 136, 8);
    int mt, nt;
    while (ti.next(mt, nt)) {
      f32x4 acc[4][4];
      zero_acc(acc);
      gemm_tile(p.merged, D, mt * 128, p.w_outT, D, nt * 128, D, acc, smem);
      ACC_FOREACH({
        const int nn = mt * 128 + row, c = nt * 128 + col;
        int seq, t, T; tok2seq(nn, seq, t, T);
        const float gt = p.mod[(size_t)seq * 8192 + 2048 + c];
        p.out[O_Y + (size_t)nn * D + c] = xrow(p, nn)[c] + gt * acc[m][n][j];
      })
    }
  }
  for (int it0 = bid; it0 < P7_CV; it0 += 4 * nb) {
    const int tid = TIDX;
    float4 va[4], vb[4];
#pragma unroll
    for (int r = 0; r < 4; r++) {
      const int it = it0 + r * nb;
      if (it < P7_CV) {
        const float* src = it < 8192 ? p.peer_u + (size_t)it * 2048 : p.peer_v + (size_t)(it - 8192) * 2048;
        const float4* s4 = (const float4*)src + tid * 2;
        va[r] = s4[0]; vb[r] = s4[1];
      }
    }
#pragma unroll
    for (int r = 0; r < 4; r++) {
      const int it = it0 + r * nb;
      if (it < P7_CV) {
        unsigned char* dst = it < 8192 ? (unsigned char*)p.ub + (size_t)it * 2048 : (unsigned char*)p.vb + (size_t)(it - 8192) * 2048;
        const float sc = it < 8192 ? U_SCALE : V_SCALE;
        const float4 a = va[r], b = vb[r];
        int lo = __builtin_amdgcn_cvt_pk_fp8_f32(a.x * sc, a.y * sc, 0, false);
        lo = __builtin_amdgcn_cvt_pk_fp8_f32(a.z * sc, a.w * sc, lo, true);
        int hi = __builtin_amdgcn_cvt_pk_fp8_f32(b.x * sc, b.y * sc, 0, false);
        hi = __builtin_amdgcn_cvt_pk_fp8_f32(b.z * sc, b.w * sc, hi, true);
        *((uint2*)dst + tid) = make_uint2((unsigned)lo, (unsigned)hi);
      }
    }
  }
}

__device__ void phase9(const P& p, int bid, int nb, char* smem) {
  const int tid = TIDX, lane = tid & 63, wid = tid >> 6, wr = wid >> 1, wc = wid & 1, fr = lane & 15,
            fq = lane >> 4;
  TileIter ti(bid, nb, 136, 16);
  int mt, nt;
  while (ti.next(mt, nt)) {
    f32x4 acc[4][4];
    zero_acc(acc);
    gemm_tile<false>(p.xn, D, mt * 128, p.wqT, D, nt * 128, D, acc, smem);
    u16* Lq = (u16*)smem;
    ACC_FOREACH({ Lq[row * 136 + col] = f2bf(acc[m][n][j]); })
    __syncthreads();
    f32x4 sc[4][4];
    zero_acc(sc);
    const u16* kb = p.keysb + (size_t)nt * 128 * 128;
#pragma unroll 1
    for (int s = 0; s < 4; s++) {
      bf16x8 af[4], bfr[4];
#pragma unroll
      for (int m = 0; m < 4; m++) af[m] = *(const bf16x8*)((const char*)Lq + (wr * 64 + m * 16 + fr) * 272 + s * 64 + fq * 16);
#pragma unroll
      for (int n = 0; n < 4; n++) bfr[n] = *(const bf16x8*)(kb + (size_t)(wc * 64 + n * 16 + fr) * 128 + s * 32 + fq * 8);
#pragma unroll
      for (int m = 0; m < 4; m++)
#pragma unroll
        for (int n = 0; n < 4; n++) sc[m][n] = __builtin_amdgcn_mfma_f32_16x16x32_bf16(af[m], bfr[n], sc[m][n], 0, 0, 0);
    }
    __syncthreads();
    float* Ls = (float*)smem;
#pragma unroll
    for (int m = 0; m < 4; m++)
#pragma unroll
      for (int n = 0; n < 4; n++)
#pragma unroll
        for (int j = 0; j < 4; j++) Ls[(wr * 64 + m * 16 + fq * 4 + j) * 129 + wc * 64 + n * 16 + fr] = sc[m][n][j];
    __syncthreads();
    {
      const int row = tid >> 1, half = tid & 1;
      float* Lr = Ls + row * 129;
      const size_t ob = ((size_t)(mt * 128 + row) * 16 + nt) * 16;
      for (int r = 0; r < 16; r++) {
        float best = -INFINITY; int bi = 0;
        for (int i = 0; i < 64; i++) {
          const float v = Lr[half + 2 * i];
          if (v > best) { best = v; bi = half + 2 * i; }
        }
        const float ov = __shfl_xor(best, 1, 64);
        const int oi = __shfl_xor(bi, 1, 64);
        if (ov > best || (ov == best && oi < bi)) { best = ov; bi = oi; }
        if ((bi & 1) == half) Lr[bi] = -INFINITY;
        if (half == 0) { p.topv[ob + r] = best; p.topi[ob + r] = bi; }
      }
    }
    __syncthreads();
  }
}

__device__ __forceinline__ void cand_ij(int lane, int& ci, int& cj) {
  int i = 0, rem = lane;
#pragma unroll
  for (int r = 0; r < 16; r++) {
    const int cnt = 16 / (r + 1);
    if (i == r && rem >= cnt) { rem -= cnt; i = r + 1; }
  }
  ci = i; cj = rem;
}

typedef __attribute__((ext_vector_type(2))) __bf16 bf2_t;
__device__ __forceinline__ float dot2bf(unsigned a, unsigned b, float c) {
  return __builtin_amdgcn_fdot2_f32_bf16(__builtin_bit_cast(bf2_t, a), __builtin_bit_cast(bf2_t, b), c, false);
}
template <int CTRL, int RM>
__device__ __forceinline__ float dppf_m(float x) {
  return __int_as_float(__builtin_amdgcn_update_dpp(0, __float_as_int(x), CTRL, RM, 0xf, false));
}
__device__ __forceinline__ float wave_sum_l63(float x) {
  x += dppf<0xB1>(x);
  x += dppf<0x4E>(x);
  x += dppf<0x141>(x);
  x += dppf<0x140>(x);
  x += dppf_m<0x142, 0xA>(x);
  x += dppf_m<0x143, 0xC>(x);
  return x;
}
__device__ __forceinline__ float readlane_f(float x, int l) {
  return __int_as_float(__builtin_amdgcn_readlane(__float_as_int(x), l));
}
__device__ __forceinline__ void axpy8(float* acc, float w, uint4 v) {
  acc[0] += w * bflo(v.x); acc[1] += w * bfhi(v.x); acc[2] += w * bflo(v.y); acc[3] += w * bfhi(v.y);
  acc[4] += w * bflo(v.z); acc[5] += w * bfhi(v.z); acc[6] += w * bflo(v.w); acc[7] += w * bfhi(v.w);
}

typedef float f2_t __attribute__((ext_vector_type(2)));
__device__ __forceinline__ void fp8x16_to_f32(const uint4 v, float* o) {
  const unsigned w[4] = {v.x, v.y, v.z, v.w};
#pragma unroll
  for (int i = 0; i < 4; i++) {
    const f2_t lo = __builtin_amdgcn_cvt_pk_f32_fp8((int)w[i], false);
    const f2_t hi = __builtin_amdgcn_cvt_pk_f32_fp8((int)w[i], true);
    o[4 * i] = lo.x; o[4 * i + 1] = lo.y; o[4 * i + 2] = hi.x; o[4 * i + 3] = hi.y;
  }
}

__device__ void phase10(const P& p, int bid, int nb) {
  const int lane = TIDX & 63, wid = TIDX >> 6;
  int ci, cj; cand_ij(lane < 50 ? lane : 0, ci, cj);
  const unsigned char* ub8 = (const unsigned char*)p.ub;
  const unsigned char* vb8 = (const unsigned char*)p.vb;
  for (int it = bid; it < NT / 4; it += nb) {
    const int n = it * 4 + wid;
    int seq, t, T; tok2seq(n, seq, t, T);
    float xv[16];
    {
      const uint4 a = *(const uint4*)(p.xn + (size_t)n * D + lane * 16), b = *(const uint4*)(p.xn + (size_t)n * D + lane * 16 + 8);
      const unsigned as[4] = {a.x, a.y, a.z, a.w}, bs[4] = {b.x, b.y, b.z, b.w};
#pragma unroll
      for (int e = 0; e < 4; e++) { xv[2 * e] = bflo(as[e]); xv[2 * e + 1] = bfhi(as[e]); xv[8 + 2 * e] = bflo(bs[e]); xv[8 + 2 * e + 1] = bfhi(bs[e]); }
    }
    float acc[16];
#pragma unroll
    for (int e = 0; e < 16; e++) acc[e] = 0.f;
#pragma unroll 1
    for (int h = 0; h < 8; h++) {
      const size_t base = ((size_t)n * 16 + h * 2) * 16;
      float cand = -INFINITY; int eid = 0;
      if (lane < 50) {
        cand = p.topv[base + ci] + p.topv[base + 16 + cj];
        eid = p.topi[base + ci] * 128 + p.topi[base + 16 + cj];
      }
      int rank = 0;
#pragma unroll
      for (int m = 0; m < 50; m++) {
        const float cm = readlane_f(cand, m);
        rank += ((cm > cand) || (cm == cand && m < lane)) ? 1 : 0;
      }
      const bool sel = (lane < 50) && (rank < 16);
      unsigned long long mask = __ballot(sel);
      const float mx = readlane_f(cand, __builtin_ctzll(__ballot(sel && rank == 0)));
      const float ex = sel ? __expf(cand - mx) : 0.f;
      const float den = readlane_f(wave_sum_l63(ex), 63);
      const float gate = ex / den;
#pragma unroll 1
      for (int hf = 0; hf < 2; hf++) {
        int ek[8]; float gk[8];
#pragma unroll
        for (int k = 0; k < 8; k++) {
          const int src = __builtin_ctzll(mask);
          mask &= mask - 1;
          ek[k] = __builtin_amdgcn_readlane(eid, src);
          gk[k] = readlane_f(gate, src);
        }
        uint4 uu[8], vv[8];
#pragma unroll
        for (int j = 0; j < 8; j++) uu[j] = *(const uint4*)(ub8 + (size_t)ek[j] * D + lane * 16);
#pragma unroll
        for (int j = 0; j < 8; j++) vv[j] = *(const uint4*)(vb8 + (size_t)ek[j] * D + lane * 16);
        float dv = 0.f;
#pragma unroll
        for (int j = 0; j < 8; j++) {
          float uf[16];
          fp8x16_to_f32(uu[j], uf);
          float d0 = 0.f, d1 = 0.f;
#pragma unroll
          for (int e = 0; e < 8; e++) { d0 += uf[2 * e] * xv[2 * e]; d1 += uf[2 * e + 1] * xv[2 * e + 1]; }
          const float ds = readlane_f(wave_sum_l63(d0 + d1), 63);
          dv = (lane == j) ? ds : dv;
        }
        dv *= (1.f / U_SCALE);
        const float act = 0.5f * dv * (1.f + erff(dv * 0.70710678118654752f));
#pragma unroll
        for (int j = 0; j < 8; j++) {
          const float w = readlane_f(act, j) * gk[j] * (1.f / V_SCALE);
          float vf[16];
          fp8x16_to_f32(vv[j], vf);
#pragma unroll
          for (int e = 0; e < 16; e++) acc[e] += w * vf[e];
        }
      }
    }
    float* yr = p.out + O_Y + (size_t)n * D + lane * 16;
    const float* md = p.mod + (size_t)seq * 8192 + lane * 16;
    float x2[16];
    float ss = 0.f;
#pragma unroll
    for (int q4 = 0; q4 < 4; q4++) {
      const float4 a = *(const float4*)(yr + q4 * 4), g = *(const float4*)(md + 5120 + q4 * 4);
      x2[q4 * 4 + 0] = a.x + g.x * acc[q4 * 4 + 0]; x2[q4 * 4 + 1] = a.y + g.y * acc[q4 * 4 + 1];
      x2[q4 * 4 + 2] = a.z + g.z * acc[q4 * 4 + 2]; x2[q4 * 4 + 3] = a.w + g.w * acc[q4 * 4 + 3];
    }
#pragma unroll
    for (int e = 0; e < 16; e++) ss += x2[e] * x2[e];
    ss = readlane_f(wave_sum_l63(ss), 63);
    const float rstd = rsqrtf(ss * (1.f / 1024.f) + 1e-6f);
#pragma unroll
    for (int q4 = 0; q4 < 4; q4++) {
      const float4 fg = *(const float4*)(p.final_g + lane * 16 + q4 * 4), sc = *(const float4*)(md + 7168 + q4 * 4),
                   sh = *(const float4*)(md + 6144 + q4 * 4);
      float4 o;
      o.x = x2[q4 * 4 + 0] * rstd * fg.x * (1.f + sc.x) + sh.x;
      o.y = x2[q4 * 4 + 1] * rstd * fg.y * (1.f + sc.y) + sh.y;
      o.z = x2[q4 * 4 + 2] * rstd * fg.z * (1.f + sc.z) + sh.z;
      o.w = x2[q4 * 4 + 3] * rstd * fg.w * (1.f + sc.w) + sh.w;
      *(float4*)(yr + q4 * 4) = o;
    }
  }
}

#define XB_XCNT(j) (256 + 64 * (j))
#define XB_XSUB(j) (1280 + 64 * (j))
#define XB_XGEN(j) (2304 + 64 * (j))
#define XB_TOP 3328
#define XB_TOPGEN 3392
#define XB_WORDS 4096
__device__ __forceinline__ unsigned xb_ld(unsigned* p) { return __hip_atomic_load(p, __ATOMIC_RELAXED, __HIP_MEMORY_SCOPE_AGENT); }
__device__ __forceinline__ unsigned xb_add(unsigned* p, unsigned v) { return __hip_atomic_fetch_add(p, v, __ATOMIC_RELAXED, __HIP_MEMORY_SCOPE_AGENT); }
__device__ __forceinline__ unsigned xb_xcc_id() { return (unsigned)__builtin_amdgcn_s_getreg((3 << 11) | 20) & 0xFu; }
__device__ __forceinline__ void grid_barrier(unsigned* bar, volatile unsigned* xst) {
  asm volatile("s_waitcnt vmcnt(0)" ::: "memory");
  __syncthreads();
  if (TIDX == 0) {
    __builtin_amdgcn_s_waitcnt(0);
    const unsigned x = xst[0], nloc = xst[1], nx = xst[2];
    const unsigned old = xb_add(&bar[XB_XSUB(x)], 1u);
    const unsigned gen = old / nloc;
    if (old + 1u == (gen + 1u) * nloc) {
      __builtin_amdgcn_fence(__ATOMIC_RELEASE, "agent");
      asm volatile("s_waitcnt vmcnt(0)" ::: "memory");
      const unsigned og = xb_add(&bar[XB_TOP], 1u);
      const unsigned tg = og / nx;
      if (og + 1u == (tg + 1u) * nx) xb_add(&bar[XB_TOPGEN], 1u);
      else while (xb_ld(&bar[XB_TOPGEN]) == tg) __builtin_amdgcn_s_sleep(1);
      __builtin_amdgcn_fence(__ATOMIC_ACQUIRE, "agent");
      xb_add(&bar[XB_XGEN(x)], 1u);
      asm volatile("s_waitcnt vmcnt(0)" ::: "memory");
    } else {
      while (xb_ld(&bar[XB_XGEN(x)]) == gen) __builtin_amdgcn_s_sleep(1);
      __builtin_amdgcn_fence(__ATOMIC_ACQUIRE, "agent");
      asm volatile("s_waitcnt vmcnt(0)" ::: "memory");
    }
  }
  __syncthreads();
}

template <int PH>
__device__ __forceinline__ void run_phase(const P& p, int bid, int nb, char* smem) {
  if constexpr (PH == 0) phase0(p, bid, nb, smem);
  if constexpr (PH == 1) phase_norm<false>(p, bid, nb);
  if constexpr (PH == 2) phase2(p, bid, nb, smem);
  if constexpr (PH == 3) phase3(p, bid, nb, smem);
  if constexpr (PH == 4) phase4(p, bid, nb, smem);
  if constexpr (PH == 5) phase5(p, bid, nb);
  if constexpr (PH == 6) phase6(p, bid, nb, smem);
  if constexpr (PH == 7) phase7(p, bid, nb, smem);
  if constexpr (PH == 8) phase_norm<true>(p, bid, nb);
  if constexpr (PH == 9) phase9(p, bid, nb, smem);
  if constexpr (PH == 10) phase10(p, bid, nb);
  if constexpr (PH == 11) phase3b(p, bid, nb, smem);
}

template <int PH>
__global__ void __launch_bounds__(NTHREADS, 2) k_phase(P p) {
  extern __shared__ __attribute__((aligned(16))) char smem[];
  run_phase<PH>(p, blockIdx.x, gridDim.x, smem);
}

#if MEGA
__global__ void __launch_bounds__(NTHREADS, 2) k_mega(P p) {
  extern __shared__ __attribute__((aligned(16))) char smem[];
  cg::grid_group grid = cg::this_grid();
  const int bid = blockIdx.x, nb = gridDim.x;
#ifndef PROBE_ALL2
#define PROBE_ALL2 0
#endif
#ifndef PROBE_MASK
#define PROBE_MASK 0
#endif
#ifndef PROBE_SYNCS
#define PROBE_SYNCS 0
#endif
  volatile unsigned* xst = (volatile unsigned*)(smem + LDS_BYTES - 16);
  if (TIDX == 0) { const unsigned xcc0 = xb_xcc_id(); xst[0] = xcc0; xb_add(&p.bar[XB_XCNT(xcc0)], 1u); }
#define GSYNC(k)                                                                                 \
  {                                                                                              \
    if ((k) == 0) {                                                                              \
      grid.sync();                                                                               \
      if (TIDX == 0) {                                                                    \
        unsigned cnt = 0;                                                                        \
        for (unsigned j = 0; j < 16; ++j) cnt += xb_ld(&p.bar[XB_XCNT(j)]) > 0u ? 1u : 0u;       \
        xst[2] = cnt; xst[1] = xb_ld(&p.bar[XB_XCNT(xst[0])]);                                   \
      }                                                                                          \
    } else grid_barrier(p.bar, xst);                                                             \
  }
#define RUNPH(k)                                                       \
  run_phase<k>(p, bid, nb, smem); GSYNC(k)                             \
  if (PROBE_MASK & (1 << k)) { run_phase<k>(p, bid, nb, smem); GSYNC(1) }
#pragma unroll 1
  for (int rep = 0; rep < 1 + PROBE_ALL2; rep++) {
    RUNPH(0)
#pragma unroll 1
    for (int i = 0; i < PROBE_SYNCS; i++) GSYNC(1)
    RUNPH(1) RUNPH(2) RUNPH(3) RUNPH(11) RUNPH(4) RUNPH(5) RUNPH(6) RUNPH(7) RUNPH(8) RUNPH(9)
  }
  run_phase<10>(p, bid, nb, smem);
}
#endif

template <int PH>
static void launch_phase(const P& p, int grid, hipStream_t stream) {
  static bool attr = false;
  if (!attr) { hipFuncSetAttribute((const void*)k_phase<PH>, hipFuncAttributeMaxDynamicSharedMemorySize, LDS_BYTES); attr = true; }
  hipLaunchKernelGGL(k_phase<PH>, dim3(grid), dim3(NTHREADS), LDS_BYTES, stream, p);
}

extern "C" void kernel_launch(void* const* d_in, const int* in_sizes, int n_in, void* d_out, int out_size, void* d_ws,
                              size_t ws_size, hipStream_t stream) {
  P p{};
  const float** fp = (const float**)&p;
  for (int i = 0; i < 40; i++) fp[i] = (const float*)d_in[i];
  p.out = (float*)d_out;
  char* ws = (char*)d_ws;
  size_t off = 0;
  auto take = [&](size_t bytes) { char* r = ws + off; off += (bytes + 255) & ~(size_t)255; return r; };
  p.bar = (unsigned*)take(XB_WORDS * 4);
  p.w_inT = (u16*)take((size_t)INCOLS * D * 2);
  p.w_paT = (u16*)take((size_t)1024 * 512 * 2);
  p.w_pbT = (u16*)take((size_t)1024 * 1024 * 2);
  p.w_outT = (u16*)take((size_t)1024 * 1024 * 2);
  p.wqT = (u16*)take((size_t)2048 * 1024 * 2);
  p.keysb = (u16*)take((size_t)262144 * 2);
  p.mod = (float*)take((size_t)NSEQ * 8192 * 4);
  p.dtb = (float*)take((size_t)NT * 16 * 4);
  p.decb = (float*)take((size_t)NT * 16 * 4);
  p.xn = (u16*)take((size_t)NROWS * D * 2);
  p.proj = (u16*)take((size_t)NROWS * PCOLS * 2);
  p.prep = (u16*)take((size_t)NT * 3584 * 2);
  p.w2T = (u16*)take(512 * 64 * 2);
  p.a2T = (u16*)take(512 * 64 * 2);
  p.g2T = (u16*)take(512 * 128 * 2);
  p.lora = (u16*)take((size_t)NT * 256 * 2);
  if (off > ws_size) { fprintf(stderr, "workspace too small: need %zu have %zu\n", off, ws_size); return; }
  p.merged = p.prep;
  p.ub = p.proj;
  p.vb = p.proj + (size_t)16384 * 1024;
  p.topv = (float*)(p.proj + (size_t)2 * 16384 * 1024);
  p.topi = (int*)(p.topv + (size_t)NT * 256);
  p.xc = (u16*)d_out;
  p.oa = (u16*)d_out;
  p.ob = (u16*)d_out + (size_t)NT * 512;

  static int grid = 0;
  if (!grid) {
    int dev = 0, cus = 0, per_cu = 0;
    hipGetDevice(&dev);
    hipDeviceGetAttribute(&cus, hipDeviceAttributeMultiprocessorCount, dev);
#if MEGA
    hipFuncSetAttribute((const void*)k_mega, hipFuncAttributeMaxDynamicSharedMemorySize, LDS_BYTES);
    hipOccupancyMaxActiveBlocksPerMultiprocessor(&per_cu, k_mega, NTHREADS, LDS_BYTES);
    if (per_cu > 2) per_cu = 2;
#else
    per_cu = 2;
#endif
    if (per_cu < 1) per_cu = 1;
    grid = cus * per_cu;
  }
  hipMemsetAsync(p.mod, 0, (size_t)NSEQ * 8192 * 4, stream);
#if MEGA
  hipMemsetAsync(p.bar, 0, XB_WORDS * 4, stream);
  void* args[] = {&p};
  hipError_t e = hipLaunchCooperativeKernel((void*)k_mega, dim3(grid), dim3(NTHREADS), args, LDS_BYTES, stream);
  if (e != hipSuccess) fprintf(stderr, "cooperative launch failed: %s (grid %d)\n", hipGetErrorString(e), grid);
#else
  launch_phase<0>(p, grid, stream);
  launch_phase<1>(p, grid, stream);
  launch_phase<2>(p, grid, stream);
  launch_phase<3>(p, grid, stream);
  launch_phase<11>(p, grid, stream);
  launch_phase<4>(p, grid, stream);
  launch_phase<5>(p, grid, stream);
  launch_phase<6>(p, grid, stream);
  launch_phase<7>(p, grid, stream);
  launch_phase<8>(p, grid, stream);
  launch_phase<9>(p, grid, stream);
  launch_phase<10>(p, grid, stream);
#endif
}
```

```cpp
#include <hip/hip_runtime.h>
#include <hip/hip_cooperative_groups.h>
#include <cstdio>
namespace cg = cooperative_groups;

#ifndef MEGA
#define MEGA 1
#endif

typedef unsigned short u16;
typedef __attribute__((ext_vector_type(8))) short bf16x8;
typedef __attribute__((ext_vector_type(4))) float f32x4;

__device__ __forceinline__ int opaque_tid() { int t = threadIdx.x; asm volatile("" : "+v"(t)); return t; }
#define TIDX opaque_tid()

constexpr int D = 1024;
constexpr int NP = 16384, NS = 1024, NT = NP + NS, NSEQ = 136;
constexpr int NROWS = NT + 128;
constexpr int PCOLS = 4368;
constexpr int INCOLS = 6416;
constexpr int C_LW = 1536, C_LA = 1600, C_LG = 1664, C_Z = 1792, C_XBC = 2816, C_DT = 4352;
constexpr int G_A = 4368, G_B = 5392;
constexpr size_t O_Y = 0, O_PSHIFT = 17825792, O_PWKV = 17833984, O_PCONV = 18096128, O_PSSM = 18132992,
                 O_SSHIFT = 19181568, O_SWKV = 19312640, O_SCONV = 23506944, O_SSSM = 24096768;
constexpr int LDS_BYTES = 80 * 1024;
constexpr int NTHREADS = 256;

struct P {
  const float *x_prompt, *x_sample, *c_prompt, *c_sample, *state_shift, *state_wkv, *state_conv, *state_ssm;
  const float *w_ada, *b_ada, *norm1_g, *w_in, *rw_mu, *rw_w0, *rw_w2, *rw_a0, *rw_a2, *rw_g2, *rw_k_k, *rw_k_a,
      *rw_r_k, *rw_ln_w, *rw_ln_b;
  const float *conv_w, *conv_b, *dt_bias, *A_log, *D_skip, *ssm_norm_w, *w_pa, *w_pb, *w_out, *norm2_g, *peer_wq,
      *peer_keys, *peer_u, *peer_v, *final_g, *w_ada_f, *b_ada_f;
  float* out;
  u16 *w_inT, *w_paT, *w_pbT, *w_outT, *wqT, *keysb, *xn, *proj, *prep, *merged, *ub, *vb, *xc, *oa, *ob;
  u16 *w2T, *a2T, *g2T, *lora;
  float *mod, *dtb, *decb, *topv;
  int* topi;
  unsigned* bar;
};

__device__ __forceinline__ u16 f2bf(float f) {
  unsigned u = __float_as_uint(f);
  u += 0x7fffu + ((u >> 16) & 1u);
  return (u16)(u >> 16);
}
__device__ __forceinline__ float bf2f(u16 h) { return __uint_as_float(((unsigned)h) << 16); }
__device__ __forceinline__ unsigned pack2(float a, float b) { return (unsigned)f2bf(a) | ((unsigned)f2bf(b) << 16); }
__device__ __forceinline__ float bflo(unsigned u) { return __uint_as_float(u << 16); }
__device__ __forceinline__ float bfhi(unsigned u) { return __uint_as_float(u & 0xffff0000u); }
__device__ __forceinline__ float sigmoidf_(float x) { return 1.f / (1.f + __expf(-x)); }
__device__ __forceinline__ float siluf_(float x) { return x / (1.f + __expf(-x)); }
__device__ __forceinline__ float softplusf_(float x) { return x > 20.f ? x : log1pf(expf(x)); }

template <int CTRL>
__device__ __forceinline__ float dppf(float x) {
  return __int_as_float(__builtin_amdgcn_update_dpp(0, __float_as_int(x), CTRL, 0xf, 0xf, true));
}
__device__ __forceinline__ float allreduce16(float x) {
  x += dppf<0x128>(x);
  x += dppf<0x124>(x);
  x += dppf<0x122>(x);
  x += dppf<0x121>(x);
  return x;
}
__device__ __forceinline__ float allreduce8(float x) {
  x += dppf<0xB1>(x);
  x += dppf<0x4E>(x);
  x += dppf<0x141>(x);
  return x;
}
__device__ __forceinline__ float wave_sum(float x) {
#pragma unroll
  for (int o = 32; o >= 1; o >>= 1) x += __shfl_xor(x, o, 64);
  return x;
}
__device__ __forceinline__ float wave_max(float x) {
#pragma unroll
  for (int o = 32; o >= 1; o >>= 1) x = fmaxf(x, __shfl_xor(x, o, 64));
  return x;
}
__device__ __forceinline__ int wave_min_i(int x) {
#pragma unroll
  for (int o = 32; o >= 1; o >>= 1) x = min(x, __shfl_xor(x, o, 64));
  return x;
}

__device__ __forceinline__ const float* xrow(const P& p, int n) {
  return n < NP ? p.x_prompt + (size_t)n * D : p.x_sample + (size_t)(n - NP) * D;
}
__device__ __forceinline__ void tok2seq(int n, int& seq, int& t, int& T) {
  if (n < NP) { seq = n >> 11; t = n & 2047; T = 2048; }
  else { int m = n - NP; seq = 8 + (m >> 3); t = m & 7; T = 8; }
}
__device__ __forceinline__ float* seq_out(float* out, int seq, size_t op, size_t os, size_t per) {
  return seq < 8 ? out + op + (size_t)seq * per : out + os + (size_t)(seq - 8) * per;
}

constexpr int LROW = 144;
template <bool DEEP = true>
__device__ __forceinline__ void gemm_tile(const u16* __restrict__ A, int lda, int m0, const u16* __restrict__ Bt,
                                          int ldb, int n0, int K, f32x4 (&acc)[4][4], char* smem) {
  char* sA = smem;
  char* sB = smem + 128 * LROW;
  const int tid = TIDX, lane = tid & 63, wid = tid >> 6, wr = wid >> 1, wc = wid & 1, fr = lane & 15,
            fq = lane >> 4;
  uint4 ra0, ra1, ra2, ra3, rb0, rb1, rb2, rb3;
  uint4 sa0, sa1, sa2, sa3, sb0, sb1, sb2, sb3;
  const int nk = K / 64;
  const int lrow = tid >> 3, lch = tid & 7;
  const u16* gA = A + (size_t)(m0 + lrow) * lda + lch * 8;
  const u16* gB = Bt + (size_t)(n0 + lrow) * ldb + lch * 8;
#define GLOAD(x0, x1, x2, x3, y0, y1, y2, y3, kt)                   \
  {                                                                 \
    x0 = *(const uint4*)(gA + (kt) * 64);                           \
    x1 = *(const uint4*)(gA + (size_t)32 * lda + (kt) * 64);        \
    x2 = *(const uint4*)(gA + (size_t)64 * lda + (kt) * 64);        \
    x3 = *(const uint4*)(gA + (size_t)96 * lda + (kt) * 64);        \
    y0 = *(const uint4*)(gB + (kt) * 64);                           \
    y1 = *(const uint4*)(gB + (size_t)32 * ldb + (kt) * 64);        \
    y2 = *(const uint4*)(gB + (size_t)64 * ldb + (kt) * 64);        \
    y3 = *(const uint4*)(gB + (size_t)96 * ldb + (kt) * 64);        \
  }
#define LSTORE(x0, x1, x2, x3, y0, y1, y2, y3)                      \
  {                                                                 \
    char* wa = sA + lrow * LROW + lch * 16;                         \
    char* wb = sB + lrow * LROW + lch * 16;                         \
    *(uint4*)(wa) = x0; *(uint4*)(wa + 32 * LROW) = x1; *(uint4*)(wa + 64 * LROW) = x2; *(uint4*)(wa + 96 * LROW) = x3; \
    *(uint4*)(wb) = y0; *(uint4*)(wb + 32 * LROW) = y1; *(uint4*)(wb + 64 * LROW) = y2; *(uint4*)(wb + 96 * LROW) = y3; \
  }
#define COMPUTE_TILE()                                                                                                   \
  {                                                                                                                      \
    _Pragma("unroll") for (int s = 0; s < 2; s++) {                                                                      \
      bf16x8 af[4], bfr[4];                                                                                              \
      _Pragma("unroll") for (int m = 0; m < 4; m++) af[m] = *(const bf16x8*)(sA + (wr * 64 + m * 16 + fr) * LROW + s * 64 + fq * 16); \
      _Pragma("unroll") for (int n = 0; n < 4; n++) bfr[n] = *(const bf16x8*)(sB + (wc * 64 + n * 16 + fr) * LROW + s * 64 + fq * 16); \
      _Pragma("unroll") for (int m = 0; m < 4; m++)                                                                      \
        _Pragma("unroll") for (int n = 0; n < 4; n++) acc[m][n] = __builtin_amdgcn_mfma_f32_16x16x32_bf16(af[m], bfr[n], acc[m][n], 0, 0, 0); \
    }                                                                                                                    \
  }
  GLOAD(ra0, ra1, ra2, ra3, rb0, rb1, rb2, rb3, 0);
  if constexpr (DEEP) {
    GLOAD(sa0, sa1, sa2, sa3, sb0, sb1, sb2, sb3, 1);
#pragma unroll 1
    for (int kt = 0; kt < nk; kt += 2) {
      __syncthreads();
      LSTORE(ra0, ra1, ra2, ra3, rb0, rb1, rb2, rb3);
      __syncthreads();
      if (kt + 2 < nk) GLOAD(ra0, ra1, ra2, ra3, rb0, rb1, rb2, rb3, kt + 2);
      COMPUTE_TILE();
      __syncthreads();
      LSTORE(sa0, sa1, sa2, sa3, sb0, sb1, sb2, sb3);
      __syncthreads();
      if (kt + 3 < nk) GLOAD(sa0, sa1, sa2, sa3, sb0, sb1, sb2, sb3, kt + 3);
      COMPUTE_TILE();
    }
  } else {
#pragma unroll 1
    for (int kt = 0; kt < nk; kt++) {
      __syncthreads();
      LSTORE(ra0, ra1, ra2, ra3, rb0, rb1, rb2, rb3);
      __syncthreads();
      if (kt + 1 < nk) GLOAD(ra0, ra1, ra2, ra3, rb0, rb1, rb2, rb3, kt + 1);
      COMPUTE_TILE();
    }
  }
  __syncthreads();
}
__device__ __forceinline__ void zero_acc(f32x4 (&acc)[4][4]) {
#pragma unroll
  for (int m = 0; m < 4; m++)
#pragma unroll
    for (int n = 0; n < 4; n++) acc[m][n] = f32x4{0.f, 0.f, 0.f, 0.f};
}
#define ACC_FOREACH(...)                                                                    \
  {                                                                                         \
    const int _l = TIDX & 63, _w = TIDX >> 6, _wr = _w >> 1, _wc = _w & 1;    \
    const int _fr = _l & 15, _fq = _l >> 4;                                                 \
    _Pragma("unroll") for (int m = 0; m < 4; m++) _Pragma("unroll") for (int n = 0; n < 4; n++) \
        _Pragma("unroll") for (int j = 0; j < 4; j++) {                                     \
      const int row = _wr * 64 + m * 16 + _fq * 4 + j, col = _wc * 64 + n * 16 + _fr;       \
      __VA_ARGS__                                                                           \
    }                                                                                       \
  }

struct TileIter {
  int x, lb, nbx, tpx, total, MT, NT, r;
  __device__ __forceinline__ TileIter(int bid, int nb, int MT_, int NT_) : MT(MT_), NT(NT_), r(0) {
    total = MT * NT; x = bid & 7; lb = bid >> 3; nbx = nb >> 3; tpx = (total + 7) >> 3;
  }
  __device__ __forceinline__ bool next(int& mt, int& nt) {
    const int idx = lb + r * nbx;
    r++;
    if (idx >= tpx) return false;
    const int lin = x * tpx + idx;
    if (lin >= total) return false;
    const int bsz = 8 * NT, band = lin / bsz, rem = lin - band * bsz;
    const int mb = min(8, MT - band * 8);
    nt = rem / mb; mt = band * 8 + (rem - nt * mb);
    return true;
  }
};

__device__ void transpose_tile(const float* __restrict__ src, int K, int N, u16* __restrict__ dst, int tile,
                               char* smem) {
  const int ntn = (N + 63) / 64, kt = tile / ntn, nt = tile % ntn, tid = TIDX;
  float(*s)[65] = (float(*)[65])smem;
  __syncthreads();
#pragma unroll 4
  for (int i = 0; i < 16; i++) {
    int r = (tid >> 6) + 4 * i, n = nt * 64 + (tid & 63);
    s[r][tid & 63] = (n < N) ? src[(size_t)(kt * 64 + r) * N + n] : 0.f;
  }
  __syncthreads();
#pragma unroll 4
  for (int i = 0; i < 8; i++) {
    int nl = (tid >> 5) + 8 * i, n = nt * 64 + nl, kl = (tid & 31) * 2;
    if (n < N) *(unsigned*)(dst + (size_t)n * K + kt * 64 + kl) = pack2(s[kl][nl], s[kl + 1][nl]);
  }
}

__device__ void mod_item(const P& p, int item2, char* smem) {
  const int item = item2 >> 1, kh2 = item2 & 1;
  const int tid = TIDX, j = tid & 31, g = tid >> 5;
  const int col0 = item * 32;
  const float* W; const float* bias; int N, cw;
  if (col0 < 6144) { W = p.w_ada; bias = p.b_ada; N = 6144; cw = col0; }
  else { W = p.w_ada_f; bias = p.b_ada_f; N = 2048; cw = col0 - 6144; }
  float(*cs)[68] = (float(*)[68])smem;
  float acc[17];
#pragma unroll
  for (int s = 0; s < 17; s++) acc[s] = 0.f;
  for (int k0 = kh2 * 512; k0 < kh2 * 512 + 512; k0 += 64) {
    __syncthreads();
    {
      float cv[34];
#pragma unroll
      for (int i = 0; i < 34; i++) {
        const int idx = tid + i * 256, seq = idx >> 6, kk = idx & 63;
        cv[i] = seq < 8 ? p.c_prompt[seq * 1024 + k0 + kk] : p.c_sample[(seq - 8) * 1024 + k0 + kk];
      }
#pragma unroll
      for (int i = 0; i < 34; i++) {
        const int idx = tid + i * 256;
        cs[idx >> 6][idx & 63] = siluf_(cv[i]);
      }
    }
    __syncthreads();
#pragma unroll 1
    for (int kh = 0; kh < 2; kh++) {
      float wv[32];
#pragma unroll
      for (int k = 0; k < 32; k++) wv[k] = W[(size_t)(k0 + kh * 32 + k) * N + cw + j];
#pragma unroll 2
      for (int k4 = 0; k4 < 8; k4++) {
#pragma unroll
        for (int s = 0; s < 17; s++) {
          float4 c4 = *(const float4*)&cs[g * 17 + s][kh * 32 + k4 * 4];
          acc[s] += wv[k4 * 4] * c4.x + wv[k4 * 4 + 1] * c4.y + wv[k4 * 4 + 2] * c4.z + wv[k4 * 4 + 3] * c4.w;
        }
      }
    }
  }
  const float b = kh2 == 0 ? bias[cw + j] : 0.f;
#pragma unroll
  for (int s = 0; s < 17; s++) atomicAdd(&p.mod[(size_t)(g * 17 + s) * 8192 + col0 + j], acc[s] + b);
}

constexpr int J_MOD = 512, J_WIN = 16 * 101, J_WPA = 8 * 16, J_WPB = 256, J_WOUT = 256, J_WQ = 16 * 32, J_KEYS = 128,
              J_SHIFT = 64;
constexpr int J_LORA = 8 + 8 + 16;
constexpr int PH0_ITEMS = J_MOD + J_WIN + J_WPA + J_WPB + J_WOUT + J_WQ + J_LORA + J_KEYS + J_SHIFT;

__device__ void phase0(const P& p, int bid, int nb, char* smem) {
  for (int it = bid; it < PH0_ITEMS; it += nb) {
    int i = it;
    if (i < J_MOD) { mod_item(p, i, smem); continue; }
    i -= J_MOD;
    if (i < J_WIN) { transpose_tile(p.w_in, 1024, INCOLS, p.w_inT, i, smem); continue; }
    i -= J_WIN;
    if (i < J_WPA) { transpose_tile(p.w_pa, 512, 1024, p.w_paT, i, smem); continue; }
    i -= J_WPA;
    if (i < J_WPB) { transpose_tile(p.w_pb, 1024, 1024, p.w_pbT, i, smem); continue; }
    i -= J_WPB;
    if (i < J_WOUT) { transpose_tile(p.w_out, 1024, 1024, p.w_outT, i, smem); continue; }
    i -= J_WOUT;
    if (i < J_WQ) { transpose_tile(p.peer_wq, 1024, 2048, p.wqT, i, smem); continue; }
    i -= J_WQ;
    if (i < 8) { transpose_tile(p.rw_w2, 64, 512, p.w2T, i, smem); continue; }
    if (i < 16) { transpose_tile(p.rw_a2, 64, 512, p.a2T, i - 8, smem); continue; }
    if (i < 32) { transpose_tile(p.rw_g2, 128, 512, p.g2T, i - 16, smem); continue; }
    i -= J_LORA;
    const float* src; u16* dst;
    if (i < J_KEYS) { src = p.peer_keys + (size_t)i * 2048; dst = p.keysb + (size_t)i * 2048; }
    else { i -= J_KEYS; src = p.state_shift + (size_t)i * 2048; dst = p.xn + (size_t)NT * D + (size_t)i * 2048; }
    const float4* s4 = (const float4*)src + TIDX * 2;
    float4 a = s4[0], b = s4[1];
    uint4 o; o.x = pack2(a.x, a.y); o.y = pack2(a.z, a.w); o.z = pack2(b.x, b.y); o.w = pack2(b.z, b.w);
    *((uint4*)dst + TIDX) = o;
  }
}

template <bool SECOND>
__device__ void phase_norm(const P& p, int bid, int nb) {
  const int lane = TIDX & 63, wid = TIDX >> 6;
  const float* gam = SECOND ? p.norm2_g : p.norm1_g;
  for (int it = bid; it < NT / 8; it += nb) {
    const int nA = it * 8 + wid * 2;
    float4 v[2][4];
#pragma unroll
    for (int k = 0; k < 2; k++) {
      const int n = nA + k;
      const float* xr = SECOND ? p.out + O_Y + (size_t)n * D : xrow(p, n);
#pragma unroll
      for (int i = 0; i < 4; i++) v[k][i] = ((const float4*)xr)[lane + 64 * i];
    }
#pragma unroll
    for (int k = 0; k < 2; k++) {
      const int n = nA + k;
      int seq, t, T; tok2seq(n, seq, t, T);
      const float* md = p.mod + (size_t)seq * 8192 + (SECOND ? 3072 : 0);
      float ss = 0.f;
#pragma unroll
      for (int i = 0; i < 4; i++)
        ss += v[k][i].x * v[k][i].x + v[k][i].y * v[k][i].y + v[k][i].z * v[k][i].z + v[k][i].w * v[k][i].w;
      ss = wave_sum(ss);
      const float rstd = rsqrtf(ss * (1.f / 1024.f) + 1e-6f);
      const bool last = (!SECOND) && (t == T - 1);
      float* so = seq_out(p.out, seq, O_PSHIFT, O_SSHIFT, 1024);
#pragma unroll
      for (int i = 0; i < 4; i++) {
        const int c = (lane + 64 * i) * 4;
        const float4 g = *(const float4*)(gam + c), sh = *(const float4*)(md + c), sc = *(const float4*)(md + 1024 + c);
        float4 o;
        o.x = v[k][i].x * rstd * g.x * (1.f + sc.x) + sh.x;
        o.y = v[k][i].y * rstd * g.y * (1.f + sc.y) + sh.y;
        o.z = v[k][i].z * rstd * g.z * (1.f + sc.z) + sh.z;
        o.w = v[k][i].w * rstd * g.w * (1.f + sc.w) + sh.w;
        uint2 pk; pk.x = pack2(o.x, o.y); pk.y = pack2(o.z, o.w);
        *(uint2*)(p.xn + (size_t)n * D + c) = pk;
        if (last) *(float4*)(so + c) = o;
      }
    }
  }
}

constexpr int P2_NT = 35, P2_MT = 137;
__device__ void phase2(const P& p, int bid, int nb, char* smem) {
  TileIter ti(bid, nb, P2_MT, P2_NT);
  int mt, nt;
  while (ti.next(mt, nt)) {
    f32x4 acc[4][4];
    zero_acc(acc);
    gemm_tile(p.xn, D, mt * 128, p.w_inT, D, nt * 128, D, acc, smem);
    ACC_FOREACH({
      const int gc = nt * 128 + col;
      if (gc < PCOLS) p.proj[(size_t)(mt * 128 + row) * PCOLS + gc] = f2bf(acc[m][n][j]);
    })
  }
}

__device__ void rwkv_lerp_item(const P& p, int item) {
  const int tid = TIDX;
  const int n0 = item * 8;
  int seq, t0, T; tok2seq(n0, seq, t0, T);
  uint4 pcv[7], ppv[7];
#pragma unroll
  for (int i = 0; i < 7; i++) {
    const int idx = tid + i * 256, tok = idx / 224, c = (idx % 224) * 8;
    const int n = n0 + tok, t = t0 + tok;
    pcv[i] = *(const uint4*)(p.proj + (size_t)n * PCOLS + c);
    const size_t prow = t > 0 ? (size_t)(n - 1) : (size_t)(NT + (seq >= 8 ? seq - 8 : 0));
    ppv[i] = *(const uint4*)(p.proj + prow * PCOLS + c);
    if (t == 0 && seq < 8) ppv[i] = make_uint4(0, 0, 0, 0);
  }
#pragma unroll
  for (int i = 0; i < 7; i++) {
    const int idx = tid + i * 256, tok = idx / 224, c = (idx % 224) * 8;
    const int n = n0 + tok;
    const float4 mu0 = *(const float4*)(p.rw_mu + c), mu1 = *(const float4*)(p.rw_mu + c + 4);
    const float mus[8] = {mu0.x, mu0.y, mu0.z, mu0.w, mu1.x, mu1.y, mu1.z, mu1.w};
    const unsigned pcs[4] = {pcv[i].x, pcv[i].y, pcv[i].z, pcv[i].w}, pps[4] = {ppv[i].x, ppv[i].y, ppv[i].z, ppv[i].w};
    unsigned o[4];
#pragma unroll
    for (int e = 0; e < 4; e++) {
      float a0 = bflo(pcs[e]), a1 = bfhi(pcs[e]), b0 = bflo(pps[e]), b1 = bfhi(pps[e]);
      float q0 = a0 + (b0 - a0) * mus[2 * e], q1 = a1 + (b1 - a1) * mus[2 * e + 1];
      if (c >= C_LW && c < C_LA) { q0 = tanhf(q0); q1 = tanhf(q1); }
      else if (c >= C_LG) { q0 = sigmoidf_(q0); q1 = sigmoidf_(q1); }
      o[e] = pack2(q0, q1);
    }
    u16* dst;
    if (c < 512) dst = p.prep + (size_t)n * 3584 + 512 + c;
    else if (c < 1024) dst = p.prep + (size_t)n * 3584 + 1024 + (c - 512);
    else if (c < 1536) dst = p.prep + (size_t)n * 3584 + 2560 + (c - 1024);
    else dst = p.lora + (size_t)n * 256 + (c - 1536);
    *(uint4*)dst = make_uint4(o[0], o[1], o[2], o[3]);
  }
}

__device__ void rwkv_lora_item(const P& p, int mt, int nt, char* smem) {
  const int tid = TIDX, lane = tid & 63, wid = tid >> 6, wr = wid >> 1, wc = wid & 1, fr = lane & 15, fq = lane >> 4;
  const int col0 = nt * 128;
  f32x4 acc[4][4];
  zero_acc(acc);
  gemm_tile<false>(p.lora, 256, mt * 128, p.w2T, 64, col0, 64, acc, smem);
  ACC_FOREACH({
    const int gc = col0 + col;
    const float wpre = p.rw_w0[gc] + acc[m][n][j];
    const float w = -softplusf_(-wpre) - 0.5f;
    p.prep[(size_t)(mt * 128 + row) * 3584 + gc] = f2bf(-expf(w));
  })
  zero_acc(acc);
  gemm_tile<false>(p.lora + 128, 256, mt * 128, p.g2T, 128, col0, 128, acc, smem);
  ACC_FOREACH({ p.prep[(size_t)(mt * 128 + row) * 3584 + 3072 + col0 + col] = f2bf(acc[m][n][j]); })
  zero_acc(acc);
  gemm_tile<false>(p.lora + 64, 256, mt * 128, p.a2T, 64, col0, 64, acc, smem);
  float a0c[4], kkc[4], kac[4];
#pragma unroll
  for (int n = 0; n < 4; n++) {
    const int gc = col0 + wc * 64 + n * 16 + fr;
    a0c[n] = p.rw_a0[gc]; kkc[n] = p.rw_k_k[gc]; kac[n] = p.rw_k_a[gc];
  }
#pragma unroll
  for (int m = 0; m < 4; m++)
#pragma unroll
    for (int j = 0; j < 4; j++) {
      const int row = mt * 128 + wr * 64 + m * 16 + fq * 4 + j;
      u16* pr = p.prep + (size_t)row * 3584 + col0 + wc * 64 + fr;
      float kx[4], kkv[4], av[4];
      float ss = 0.f;
#pragma unroll
      for (int n = 0; n < 4; n++) {
        kx[n] = bf2f(pr[1024 + n * 16]);
        av[n] = sigmoidf_(a0c[n] + acc[m][n][j]);
        kkv[n] = kx[n] * kkc[n];
        ss += kkv[n] * kkv[n];
      }
      ss = allreduce16(ss);
      const float inv = 1.f / fmaxf(sqrtf(ss), 1e-12f);
#pragma unroll
      for (int n = 0; n < 4; n++) {
        const float kk = kkv[n] * inv;
        pr[1024 + n * 16] = f2bf(kx[n] * (1.f + (av[n] - 1.f) * kac[n]));
        pr[1536 + n * 16] = f2bf(kk);
        pr[2048 + n * 16] = f2bf(kk * av[n]);
      }
    }
}

__device__ void conv_prep_item(const P& p, int item) {
  const int tid = TIDX;
  const int n0 = item * 8;
  int seq, t0, T; tok2seq(n0, seq, t0, T);
  if (tid < 192) {
    const int c = tid * 8;
    uint4 rows[11];
#pragma unroll
    for (int j = 0; j < 11; j++) {
      const int tt = t0 - 3 + j;
      rows[j] = make_uint4(0, 0, 0, 0);
      if (tt >= 0) rows[j] = *(const uint4*)(p.proj + (size_t)(n0 - 3 + j) * PCOLS + C_XBC + c);
      else if (seq >= 8) {
        const float* sc = p.state_conv + ((size_t)(seq - 8) * 3 + (tt + 3)) * 1536 + c;
        const float4 a = *(const float4*)sc, b = *(const float4*)(sc + 4);
        rows[j] = make_uint4(pack2(a.x, a.y), pack2(a.z, a.w), pack2(b.x, b.y), pack2(b.z, b.w));
      }
    }
    float w[4][8], cb[8];
#pragma unroll
    for (int j = 0; j < 4; j++) {
      const float4 a = *(const float4*)(p.conv_w + j * 1536 + c), b = *(const float4*)(p.conv_w + j * 1536 + c + 4);
      w[j][0] = a.x; w[j][1] = a.y; w[j][2] = a.z; w[j][3] = a.w; w[j][4] = b.x; w[j][5] = b.y; w[j][6] = b.z; w[j][7] = b.w;
    }
    {
      const float4 a = *(const float4*)(p.conv_b + c), b = *(const float4*)(p.conv_b + c + 4);
      cb[0] = a.x; cb[1] = a.y; cb[2] = a.z; cb[3] = a.w; cb[4] = b.x; cb[5] = b.y; cb[6] = b.z; cb[7] = b.w;
    }
#pragma unroll
    for (int k = 0; k < 8; k++) {
      float o[8];
#pragma unroll
      for (int e = 0; e < 8; e++) o[e] = cb[e];
#pragma unroll
      for (int j = 0; j < 4; j++) {
        const uint4 r = rows[k + j];
        const unsigned rs[4] = {r.x, r.y, r.z, r.w};
#pragma unroll
        for (int e = 0; e < 4; e++) { o[2 * e] += bflo(rs[e]) * w[j][2 * e]; o[2 * e + 1] += bfhi(rs[e]) * w[j][2 * e + 1]; }
      }
      *(uint4*)(p.xc + (size_t)(n0 + k) * 1536 + c) =
          make_uint4(pack2(siluf_(o[0]), siluf_(o[1])), pack2(siluf_(o[2]), siluf_(o[3])), pack2(siluf_(o[4]), siluf_(o[5])),
                     pack2(siluf_(o[6]), siluf_(o[7])));
    }
    if (t0 + 8 == T) {
      float* co = seq_out(p.out, seq, O_PCONV, O_SCONV, 3 * 1536);
#pragma unroll
      for (int j = 0; j < 3; j++) {
        const uint4 r = rows[8 + j];
        *(float4*)(co + j * 1536 + c) = make_float4(bflo(r.x), bfhi(r.x), bflo(r.y), bfhi(r.y));
        *(float4*)(co + j * 1536 + c + 4) = make_float4(bflo(r.z), bfhi(r.z), bflo(r.w), bfhi(r.w));
      }
    }
  } else if (tid < 192 + 32) {
    const int i = tid - 192;
#pragma unroll
    for (int e = 0; e < 4; e++) {
      const int pi = i * 4 + e, k = pi >> 4, h = pi & 15, n = n0 + k;
      const float raw = bf2f(p.proj[(size_t)n * PCOLS + C_DT + h]) + p.dt_bias[h];
      const float dt = softplusf_(raw);
      const float dA = -dt * expf(p.A_log[h]);
      p.dtb[n * 16 + h] = dt;
      p.decb[n * 16 + h] = dA;
    }
  }
}

__device__ void phase3(const P& p, int bid, int nb, char* smem) {
  for (int it = bid; it < 2 * (NT / 8); it += nb) {
    if (it < NT / 8) rwkv_lerp_item(p, it);
    else conv_prep_item(p, it - NT / 8);
  }
}
__device__ void phase3b(const P& p, int bid, int nb, char* smem) {
  for (int it = bid; it < 136 * 4; it += nb) rwkv_lora_item(p, it >> 2, it & 3, smem);
}

constexpr int TC = 32;
__device__ __forceinline__ void bf8_to_f(uint4 u, float4& lo, float4& hi) {
  lo = make_float4(bflo(u.x), bfhi(u.x), bflo(u.y), bfhi(u.y));
  hi = make_float4(bflo(u.z), bfhi(u.z), bflo(u.w), bfhi(u.w));
}
__device__ void rwkv_scan_item(const P& p, int seq, int h, int qr, char* smem) {
  const int T = seq < 8 ? 2048 : 8, nbase = seq < 8 ? seq * 2048 : NP + (seq - 8) * 8;
  float* Ld = (float*)smem;
  float* Lr = Ld + TC * 64; float* Lk = Lr + TC * 64; float* Lkk = Lk + TC * 64; float* Lb = Lkk + TC * 64;
  float* Lv = Lb + TC * 64;
  const int tid = TIDX, w = tid >> 6, lane = tid & 63, rl = w * 4 + (lane >> 4), ks = lane & 15;
  const int v = qr * 16 + rl;
  float S0 = 0.f, S1 = 0.f, S2 = 0.f, S3 = 0.f;
  if (seq >= 8) {
    float4 s = *(const float4*)(p.state_wkv + (((size_t)(seq - 8) * 8 + h) * 64 + v) * 64 + ks * 4);
    S0 = s.x; S1 = s.y; S2 = s.z; S3 = s.w;
  }
  const int st = tid >> 3, sk8 = (tid & 7) * 8;
  const int vt = tid >> 1, vr8 = (tid & 1) * 8;
  uint4 g0, g1, g2, g3, g4, gv;
  g0 = g1 = g2 = g3 = g4 = gv = make_uint4(0, 0, 0, 0);
#define RW_GLOAD(c0_)                                                                           \
  {                                                                                             \
    const int tcn = min(TC, T - (c0_));                                                         \
    if (st < tcn) {                                                                             \
      const u16* base = p.prep + (size_t)(nbase + (c0_) + st) * 3584 + h * 64 + sk8;            \
      g0 = *(const uint4*)(base); g1 = *(const uint4*)(base + 512); g2 = *(const uint4*)(base + 1024); \
      g3 = *(const uint4*)(base + 1536); g4 = *(const uint4*)(base + 2048);                     \
    }                                                                                           \
    if (tid < 64 && vt < tcn)                                                                   \
      gv = *(const uint4*)(p.prep + (size_t)(nbase + (c0_) + vt) * 3584 + 2560 + h * 64 + qr * 16 + vr8); \
  }
  RW_GLOAD(0);
  for (int c0 = 0; c0 < T; c0 += TC) {
    const int tc = min(TC, T - c0);
    __syncthreads();
    {
      float4 lo, hi;
      bf8_to_f(g0, lo, hi);
      lo.x = __expf(lo.x); lo.y = __expf(lo.y); lo.z = __expf(lo.z); lo.w = __expf(lo.w);
      hi.x = __expf(hi.x); hi.y = __expf(hi.y); hi.z = __expf(hi.z); hi.w = __expf(hi.w);
      *(float4*)(Ld + st * 64 + sk8) = lo; *(float4*)(Ld + st * 64 + sk8 + 4) = hi;
      bf8_to_f(g1, lo, hi); *(float4*)(Lr + st * 64 + sk8) = lo; *(float4*)(Lr + st * 64 + sk8 + 4) = hi;
      bf8_to_f(g2, lo, hi); *(float4*)(Lk + st * 64 + sk8) = lo; *(float4*)(Lk + st * 64 + sk8 + 4) = hi;
      bf8_to_f(g3, lo, hi); *(float4*)(Lkk + st * 64 + sk8) = lo; *(float4*)(Lkk + st * 64 + sk8 + 4) = hi;
      bf8_to_f(g4, lo, hi); *(float4*)(Lb + st * 64 + sk8) = lo; *(float4*)(Lb + st * 64 + sk8 + 4) = hi;
      if (tid < 64) { bf8_to_f(gv, lo, hi); *(float4*)(Lv + vt * 16 + vr8) = lo; *(float4*)(Lv + vt * 16 + vr8 + 4) = hi; }
    }
    __syncthreads();
    if (c0 + TC < T) RW_GLOAD(c0 + TC);
    u16* yo = p.proj + (size_t)(nbase + c0) * PCOLS + h * 64 + v;
    float4 kk0, d0, b0, k0_, r0, kk1, d1, b1, k1_, r1, kk2, d2, b2, k2_, r2, kk3, d3, b3, k3_, r3;
    float v0, v1, v2, v3;
#define RW_LD(KK, DD, BB, KX, RR, VV, t_)                                                        \
  {                                                                                              \
    KK = *(const float4*)(Lkk + (t_) * 64 + ks * 4); DD = *(const float4*)(Ld + (t_) * 64 + ks * 4); \
    BB = *(const float4*)(Lb + (t_) * 64 + ks * 4); KX = *(const float4*)(Lk + (t_) * 64 + ks * 4);  \
    RR = *(const float4*)(Lr + (t_) * 64 + ks * 4); VV = Lv[(t_) * 16 + rl];                      \
  }
#define RW_STEP(KK, DD, BB, KX, RR, VV, YY)                                                      \
  {                                                                                              \
    const float vk0 = VV * KX.x, vk1 = VV * KX.y, vk2 = VV * KX.z, vk3 = VV * KX.w;              \
    float sk = (S0 * KK.x + S1 * KK.y) + (S2 * KK.z + S3 * KK.w);                                \
    sk = allreduce16(sk);                                                                        \
    S0 = S0 * DD.x + (vk0 - sk * BB.x);                                                          \
    S1 = S1 * DD.y + (vk1 - sk * BB.y);                                                          \
    S2 = S2 * DD.z + (vk2 - sk * BB.z);                                                          \
    S3 = S3 * DD.w + (vk3 - sk * BB.w);                                                          \
    YY = allreduce16((S0 * RR.x + S1 * RR.y) + (S2 * RR.z + S3 * RR.w));                         \
  }
    for (int tt = 0; tt < tc; tt += 4) {
      RW_LD(kk0, d0, b0, k0_, r0, v0, tt)
      RW_LD(kk1, d1, b1, k1_, r1, v1, tt + 1)
      RW_LD(kk2, d2, b2, k2_, r2, v2, tt + 2)
      RW_LD(kk3, d3, b3, k3_, r3, v3, tt + 3)
      float y0, y1, y2, y3;
      RW_STEP(kk0, d0, b0, k0_, r0, v0, y0)
      RW_STEP(kk1, d1, b1, k1_, r1, v1, y1)
      RW_STEP(kk2, d2, b2, k2_, r2, v2, y2)
      RW_STEP(kk3, d3, b3, k3_, r3, v3, y3)
      if (ks == 0) {
        u16* yp = yo + (size_t)tt * PCOLS;
        yp[0] = f2bf(y0); yp[PCOLS] = f2bf(y1); yp[2 * (size_t)PCOLS] = f2bf(y2); yp[3 * (size_t)PCOLS] = f2bf(y3);
      }
    }
  }
  float* so = seq_out(p.out, seq, O_PWKV, O_SWKV, 8 * 4096);
  *(float4*)(so + ((size_t)h * 64 + v) * 64 + ks * 4) = make_float4(S0, S1, S2, S3);
}

__device__ void ssm_scan_item(const P& p, int seq, int head, int half, char* smem) {
  const int T = seq < 8 ? 2048 : 8, nbase = seq < 8 ? seq * 2048 : NP + (seq - 8) * 8;
  float* LB = (float*)smem;
  float* LC = LB + TC * 128;
  float* Lx = LC + TC * 128;
  float* Ldt = Lx + TC * 32;
  float* Ldec = Ldt + TC;
  const int tid = TIDX, pl = tid >> 3, ns = tid & 7;
  const int pp = half * 32 + pl, g = head >> 3;
  const float Dk = p.D_skip[head];
  float hs[16];
#pragma unroll
  for (int j = 0; j < 16; j++) hs[j] = 0.f;
  if (seq >= 8) {
    const float4* s4 = (const float4*)(p.state_ssm + (((size_t)(seq - 8) * 16 + head) * 64 + pp) * 128 + ns * 16);
#pragma unroll
    for (int j = 0; j < 4; j++) { float4 s = s4[j]; hs[4 * j] = s.x; hs[4 * j + 1] = s.y; hs[4 * j + 2] = s.z; hs[4 * j + 3] = s.w; }
  }
  uint4 gb0, gb1, gb2, gb3, gx; float gdt = 0.f, gdec = 0.f;
  gb0 = gb1 = gb2 = gb3 = gx = make_uint4(0, 0, 0, 0);
  const int bt = tid >> 5, bch = tid & 31;
  const u16* bsrc = p.xc + 1024 + (bch < 16 ? 0 : 256) + g * 128 + (bch & 15) * 8;
  const int xt = tid >> 2, xr8 = (tid & 3) * 8;
#define SS_GLOAD(c0_)                                                                          \
  {                                                                                            \
    const int tcn = min(TC, T - (c0_));                                                        \
    const size_t nb_ = (size_t)(nbase + (c0_));                                                \
    if (bt < tcn) gb0 = *(const uint4*)(bsrc + (nb_ + bt) * 1536);                             \
    if (bt + 8 < tcn) gb1 = *(const uint4*)(bsrc + (nb_ + bt + 8) * 1536);                     \
    if (bt + 16 < tcn) gb2 = *(const uint4*)(bsrc + (nb_ + bt + 16) * 1536);                   \
    if (bt + 24 < tcn) gb3 = *(const uint4*)(bsrc + (nb_ + bt + 24) * 1536);                   \
    if (tid < 128 && xt < tcn) gx = *(const uint4*)(p.xc + (nb_ + xt) * 1536 + head * 64 + half * 32 + xr8); \
    if (tid < tcn) { gdt = p.dtb[(nb_ + tid) * 16 + head]; gdec = p.decb[(nb_ + tid) * 16 + head]; } \
  }
  SS_GLOAD(0);
  for (int c0 = 0; c0 < T; c0 += TC) {
    const int tc = min(TC, T - c0);
    __syncthreads();
    {
      float* dstb = (bch < 16 ? LB : LC) + (bch & 15) * 8;
      float4 lo, hi;
      bf8_to_f(gb0, lo, hi); *(float4*)(dstb + bt * 128) = lo; *(float4*)(dstb + bt * 128 + 4) = hi;
      bf8_to_f(gb1, lo, hi); *(float4*)(dstb + (bt + 8) * 128) = lo; *(float4*)(dstb + (bt + 8) * 128 + 4) = hi;
      bf8_to_f(gb2, lo, hi); *(float4*)(dstb + (bt + 16) * 128) = lo; *(float4*)(dstb + (bt + 16) * 128 + 4) = hi;
      bf8_to_f(gb3, lo, hi); *(float4*)(dstb + (bt + 24) * 128) = lo; *(float4*)(dstb + (bt + 24) * 128 + 4) = hi;
      if (tid < 128) { bf8_to_f(gx, lo, hi); *(float4*)(Lx + xt * 32 + xr8) = lo; *(float4*)(Lx + xt * 32 + xr8 + 4) = hi; }
      if (tid < TC) { Ldt[tid] = gdt; Ldec[tid] = __expf(gdec); }
    }
    __syncthreads();
    if (c0 + TC < T) SS_GLOAD(c0 + TC);
    u16* yo = p.proj + (size_t)(nbase + c0) * PCOLS + C_XBC + head * 64 + pp;
    float4 B0 = *(const float4*)(LB + ns * 16), B1 = *(const float4*)(LB + ns * 16 + 4), B2 = *(const float4*)(LB + ns * 16 + 8),
           B3 = *(const float4*)(LB + ns * 16 + 12);
    float4 C0 = *(const float4*)(LC + ns * 16), C1 = *(const float4*)(LC + ns * 16 + 4), C2 = *(const float4*)(LC + ns * 16 + 8),
           C3 = *(const float4*)(LC + ns * 16 + 12);
    float xv = Lx[pl], dtv = Ldt[0], dec = Ldec[0];
    for (int tt = 0; tt < tc; tt++) {
      const int tn = min(tt + 1, tc - 1);
      const float* nB = LB + tn * 128 + ns * 16;
      const float* nC = LC + tn * 128 + ns * 16;
      const float4 nB0 = *(const float4*)(nB), nB1 = *(const float4*)(nB + 4), nB2 = *(const float4*)(nB + 8), nB3 = *(const float4*)(nB + 12);
      const float4 nC0 = *(const float4*)(nC), nC1 = *(const float4*)(nC + 4), nC2 = *(const float4*)(nC + 8), nC3 = *(const float4*)(nC + 12);
      const float nxv = Lx[tn * 32 + pl], ndt = Ldt[tn], ndec = Ldec[tn];
      const float dtx = dtv * xv;
      hs[0] = hs[0] * dec + dtx * B0.x; hs[1] = hs[1] * dec + dtx * B0.y; hs[2] = hs[2] * dec + dtx * B0.z; hs[3] = hs[3] * dec + dtx * B0.w;
      hs[4] = hs[4] * dec + dtx * B1.x; hs[5] = hs[5] * dec + dtx * B1.y; hs[6] = hs[6] * dec + dtx * B1.z; hs[7] = hs[7] * dec + dtx * B1.w;
      hs[8] = hs[8] * dec + dtx * B2.x; hs[9] = hs[9] * dec + dtx * B2.y; hs[10] = hs[10] * dec + dtx * B2.z; hs[11] = hs[11] * dec + dtx * B2.w;
      hs[12] = hs[12] * dec + dtx * B3.x; hs[13] = hs[13] * dec + dtx * B3.y; hs[14] = hs[14] * dec + dtx * B3.z; hs[15] = hs[15] * dec + dtx * B3.w;
      float y0 = hs[0] * C0.x + hs[1] * C0.y + hs[2] * C0.z + hs[3] * C0.w;
      float y1 = hs[4] * C1.x + hs[5] * C1.y + hs[6] * C1.z + hs[7] * C1.w;
      float y2 = hs[8] * C2.x + hs[9] * C2.y + hs[10] * C2.z + hs[11] * C2.w;
      float y3 = hs[12] * C3.x + hs[13] * C3.y + hs[14] * C3.z + hs[15] * C3.w;
      float yp = allreduce8((y0 + y1) + (y2 + y3));
      if (ns == 0) yo[(size_t)tt * PCOLS] = f2bf(yp + Dk * xv);
      B0 = nB0; B1 = nB1; B2 = nB2; B3 = nB3; C0 = nC0; C1 = nC1; C2 = nC2; C3 = nC3; xv = nxv; dtv = ndt; dec = ndec;
    }
  }
  float* so = seq_out(p.out, seq, O_PSSM, O_SSSM, 16 * 8192);
  float4* o4 = (float4*)(so + ((size_t)head * 64 + pp) * 128 + ns * 16);
#pragma unroll
  for (int j = 0; j < 4; j++) o4[j] = make_float4(hs[4 * j], hs[4 * j + 1], hs[4 * j + 2], hs[4 * j + 3]);
}

__device__ void ssd_prompt_item(const P& p, int seq, int head, char* smem) {
  const int nbase = seq * 2048, g = head >> 3;
  char* sC = smem;
  char* sB = smem + 17408;
  char* sBT = smem + 34816;
  char* sXT = smem + 53248;
  char* sH = smem + 62464;
  float* sS = (float*)(smem + 79872);
  const int tid = TIDX, lane = tid & 63, w = tid >> 6, fr = lane & 15, q = lane >> 4;
  const float Dk = p.D_skip[head];
  f32x4 H[8];
#pragma unroll
  for (int i = 0; i < 8; i++) H[i] = f32x4{0.f, 0.f, 0.f, 0.f};
  __syncthreads();
  for (int i = tid; i < 17408 / 16; i += 256) *(uint4*)(sH + i * 16) = make_uint4(0, 0, 0, 0);
  uint4 gB0, gB1, gB2, gB3, gC0, gC1, gC2, gC3, gX0, gX1;
  float gdt, gdA;
#define SSD_LOAD(t0_)                                                                         \
  {                                                                                           \
    const size_t nn_ = (size_t)(nbase + (t0_) + lane);                                        \
    const u16* row_ = p.xc + nn_ * 1536;                                                      \
    const u16* rb_ = row_ + 1024 + g * 128 + w * 32;                                          \
    gB0 = *(const uint4*)(rb_); gB1 = *(const uint4*)(rb_ + 8); gB2 = *(const uint4*)(rb_ + 16); gB3 = *(const uint4*)(rb_ + 24); \
    gC0 = *(const uint4*)(rb_ + 256); gC1 = *(const uint4*)(rb_ + 264); gC2 = *(const uint4*)(rb_ + 272); gC3 = *(const uint4*)(rb_ + 280); \
    gX0 = *(const uint4*)(row_ + head * 64 + w * 16); gX1 = *(const uint4*)(row_ + head * 64 + w * 16 + 8); \
    gdt = p.dtb[nn_ * 16 + head]; gdA = p.decb[nn_ * 16 + head];                              \
  }
#define SSD_PUT_T(dst_, r0_, u_, sc_)                                                         \
  {                                                                                           \
    const unsigned us_[4] = {u_.x, u_.y, u_.z, u_.w};                                         \
    _Pragma("unroll") for (int e = 0; e < 4; e++) {                                           \
      *(u16*)(dst_ + ((r0_) + 2 * e) * 144 + lane * 2) = f2bf(bflo(us_[e]) * (sc_));          \
      *(u16*)(dst_ + ((r0_) + 2 * e + 1) * 144 + lane * 2) = f2bf(bfhi(us_[e]) * (sc_));      \
    }                                                                                         \
  }
  SSD_LOAD(0);
#pragma unroll 1
  for (int c = 0; c < 32; c++) {
    const int t0 = c * 64;
    float cs = gdA;
#pragma unroll
    for (int o = 1; o < 64; o <<= 1) { const float v = __shfl_up(cs, o, 64); if (lane >= o) cs += v; }
    const float cs63 = __shfl(cs, 63, 64);
    const float wt = gdt * __expf(cs63 - cs);
    __syncthreads();
    if (w == 0) { sS[lane] = cs; sS[64 + lane] = __expf(cs); sS[128 + lane] = gdt; }
    {
      char* rc = sC + lane * 272 + w * 64;
      char* rb = sB + lane * 272 + w * 64;
      *(uint4*)(rc) = gC0; *(uint4*)(rc + 16) = gC1; *(uint4*)(rc + 32) = gC2; *(uint4*)(rc + 48) = gC3;
      *(uint4*)(rb) = gB0; *(uint4*)(rb + 16) = gB1; *(uint4*)(rb + 32) = gB2; *(uint4*)(rb + 48) = gB3;
      SSD_PUT_T(sBT, w * 32, gB0, wt) SSD_PUT_T(sBT, w * 32 + 8, gB1, wt) SSD_PUT_T(sBT, w * 32 + 16, gB2, wt)
      SSD_PUT_T(sBT, w * 32 + 24, gB3, wt) SSD_PUT_T(sXT, w * 16, gX0, 1.f) SSD_PUT_T(sXT, w * 16 + 8, gX1, 1.f)
    }
    __syncthreads();
    if (c + 1 < 32) SSD_LOAD(t0 + 64);
    f32x4 cb[4], yo[4];
#pragma unroll
    for (int i = 0; i < 4; i++) { cb[i] = f32x4{0.f, 0.f, 0.f, 0.f}; yo[i] = f32x4{0.f, 0.f, 0.f, 0.f}; }
    {
      bf16x8 af[4];
#pragma unroll
      for (int ks = 0; ks < 4; ks++) af[ks] = *(const bf16x8*)(sC + (16 * w + fr) * 272 + ks * 64 + q * 16);
#pragma unroll
      for (int nn = 0; nn < 4; nn++)
#pragma unroll
        for (int ks = 0; ks < 4; ks++) {
          const bf16x8 bb = *(const bf16x8*)(sB + (16 * nn + fr) * 272 + ks * 64 + q * 16);
          cb[nn] = __builtin_amdgcn_mfma_f32_16x16x32_bf16(af[ks], bb, cb[nn], 0, 0, 0);
        }
#pragma unroll
      for (int pt = 0; pt < 4; pt++)
#pragma unroll
        for (int ks = 0; ks < 4; ks++) {
          const bf16x8 bb = *(const bf16x8*)(sH + (16 * pt + fr) * 272 + ks * 64 + q * 16);
          yo[pt] = __builtin_amdgcn_mfma_f32_16x16x32_bf16(af[ks], bb, yo[pt], 0, 0, 0);
        }
    }
    __syncthreads();
#pragma unroll
    for (int j = 0; j < 4; j++) {
      const int l = 16 * w + q * 4 + j;
      const float csl = sS[l];
#pragma unroll
      for (int nn = 0; nn < 4; nn++) {
        const int sidx = 16 * nn + fr;
        const float gv = (sidx <= l) ? cb[nn][j] * __expf(csl - sS[sidx]) * sS[128 + sidx] : 0.f;
        *(u16*)(sB + l * 144 + sidx * 2) = f2bf(gv);
      }
    }
    f32x4 yd[4];
#pragma unroll
    for (int i = 0; i < 4; i++) yd[i] = f32x4{0.f, 0.f, 0.f, 0.f};
#pragma unroll
    for (int ks = 0; ks < 2; ks++) {
      const bf16x8 aa = *(const bf16x8*)(sB + (16 * w + fr) * 144 + ks * 64 + q * 16);
#pragma unroll
      for (int pt = 0; pt < 4; pt++) {
        const bf16x8 bb = *(const bf16x8*)(sXT + (16 * pt + fr) * 144 + ks * 64 + q * 16);
        yd[pt] = __builtin_amdgcn_mfma_f32_16x16x32_bf16(aa, bb, yd[pt], 0, 0, 0);
      }
    }
#pragma unroll
    for (int j = 0; j < 4; j++) {
      const int l = 16 * w + q * 4 + j;
      const float el = sS[64 + l];
      u16* yrow = p.proj + (size_t)(nbase + t0 + l) * PCOLS + C_XBC + head * 64 + fr;
#pragma unroll
      for (int pt = 0; pt < 4; pt++) {
        const float xs = bf2f(*(const u16*)(sXT + (16 * pt + fr) * 144 + l * 2));
        yrow[16 * pt] = f2bf(yd[pt][j] + el * yo[pt][j] + Dk * xs);
      }
    }
    const float ach = __expf(cs63);
#pragma unroll
    for (int nt = 0; nt < 8; nt++) { H[nt][0] *= ach; H[nt][1] *= ach; H[nt][2] *= ach; H[nt][3] *= ach; }
#pragma unroll
    for (int ks = 0; ks < 2; ks++) {
      const bf16x8 aa = *(const bf16x8*)(sXT + (16 * w + fr) * 144 + ks * 64 + q * 16);
#pragma unroll
      for (int nt = 0; nt < 8; nt++) {
        const bf16x8 bb = *(const bf16x8*)(sBT + (16 * nt + fr) * 144 + ks * 64 + q * 16);
        H[nt] = __builtin_amdgcn_mfma_f32_16x16x32_bf16(aa, bb, H[nt], 0, 0, 0);
      }
    }
#pragma unroll
    for (int nt = 0; nt < 8; nt++)
#pragma unroll
      for (int j = 0; j < 4; j++) *(u16*)(sH + (16 * w + q * 4 + j) * 272 + (16 * nt + fr) * 2) = f2bf(H[nt][j]);
  }
  float* so = p.out + O_PSSM + ((size_t)seq * 16 + head) * 8192;
#pragma unroll
  for (int nt = 0; nt < 8; nt++)
#pragma unroll
    for (int j = 0; j < 4; j++) so[(16 * w + q * 4 + j) * 128 + 16 * nt + fr] = H[nt][j];
  __syncthreads();
}

constexpr int P4_RP = 256, P4_SP = 128, P4_RS = 4096, P4_SS = 4096;
#define XB_QUEUE 3600
__device__ void phase4(const P& p, int bid, int nb, char* smem) {
  for (int it = bid; it < P4_RP + P4_SP; it += nb) {
    if (it < P4_RP) rwkv_scan_item(p, it >> 5, (it >> 2) & 7, it & 3, smem);
    else { const int i = it - P4_RP; ssd_prompt_item(p, i >> 4, i & 15, smem); }
  }
  volatile int* slot = (volatile int*)(smem + LDS_BYTES - 32);
  for (;;) {
    __syncthreads();
    if (TIDX == 0) *slot = (int)atomicAdd(&p.bar[XB_QUEUE], 1u);
    __syncthreads();
    int i = *slot;
    if (i >= P4_RS + P4_SS) break;
    if (i < P4_RS) rwkv_scan_item(p, 8 + (i >> 5), (i >> 2) & 7, i & 3, smem);
    else { i -= P4_RS; ssm_scan_item(p, 8 + (i >> 5), (i >> 1) & 15, i & 1, smem); }
  }
}

__device__ void phase5(const P& p, int bid, int nb) {
  const int lane = TIDX & 63, wid = TIDX >> 6;
  for (int it = bid; it < NT / 4; it += nb) {
    const int n = it * 4 + wid;
    {
      const int c = lane * 8;
      uint4 yu = *(const uint4*)(p.proj + (size_t)n * PCOLS + c);
      const u16* pr = p.prep + (size_t)n * 3584 + c;
      uint4 ru = *(const uint4*)(pr + 512), ku = *(const uint4*)(pr + 1024), vu = *(const uint4*)(pr + 2560),
            gu = *(const uint4*)(pr + 3072);
      unsigned ys[4] = {yu.x, yu.y, yu.z, yu.w}, rs[4] = {ru.x, ru.y, ru.z, ru.w}, ks_[4] = {ku.x, ku.y, ku.z, ku.w},
               vs[4] = {vu.x, vu.y, vu.z, vu.w}, gs[4] = {gu.x, gu.y, gu.z, gu.w};
      float y[8], r[8], k[8], v[8], g[8];
#pragma unroll
      for (int e = 0; e < 4; e++) {
        y[2 * e] = bflo(ys[e]); y[2 * e + 1] = bfhi(ys[e]);
        r[2 * e] = bflo(rs[e]); r[2 * e + 1] = bfhi(rs[e]);
        k[2 * e] = bflo(ks_[e]); k[2 * e + 1] = bfhi(ks_[e]);
        v[2 * e] = bflo(vs[e]); v[2 * e + 1] = bfhi(vs[e]);
        g[2 * e] = bflo(gs[e]); g[2 * e + 1] = bfhi(gs[e]);
      }
      float s = 0.f, bn = 0.f;
#pragma unroll
      for (int e = 0; e < 8; e++) { s += y[e]; bn += r[e] * k[e] * p.rw_r_k[c + e]; }
      s = allreduce8(s); bn = allreduce8(bn);
      const float mean = s * (1.f / 64.f);
      float vr = 0.f;
#pragma unroll
      for (int e = 0; e < 8; e++) { const float d = y[e] - mean; vr += d * d; }
      vr = allreduce8(vr) * (1.f / 64.f);
      const float rs_ = rsqrtf(vr + 64e-5f);
      float o[8];
#pragma unroll
      for (int e = 0; e < 8; e++) {
        const float yn = (y[e] - mean) * rs_ * p.rw_ln_w[c + e] + p.rw_ln_b[c + e];
        o[e] = (yn + bn * v[e]) * g[e];
      }
      uint4 ou; ou.x = pack2(o[0], o[1]); ou.y = pack2(o[2], o[3]); ou.z = pack2(o[4], o[5]); ou.w = pack2(o[6], o[7]);
      *(uint4*)(p.oa + (size_t)n * 512 + c) = ou;
    }
    {
      const int c = lane * 16;
      float yv[16];
      float ss = 0.f;
#pragma unroll
      for (int hh = 0; hh < 2; hh++) {
        uint4 yu = *(const uint4*)(p.proj + (size_t)n * PCOLS + C_XBC + c + hh * 8);
        uint4 zu = *(const uint4*)(p.proj + (size_t)n * PCOLS + C_Z + c + hh * 8);
        unsigned ys[4] = {yu.x, yu.y, yu.z, yu.w}, zs[4] = {zu.x, zu.y, zu.z, zu.w};
#pragma unroll
        for (int e = 0; e < 4; e++) {
          const float a = bflo(ys[e]) * siluf_(bflo(zs[e])), b = bfhi(ys[e]) * siluf_(bfhi(zs[e]));
          yv[hh * 8 + 2 * e] = a; yv[hh * 8 + 2 * e + 1] = b;
          ss += a * a + b * b;
        }
      }
#pragma unroll
      for (int o = 16; o >= 1; o >>= 1) ss += __shfl_xor(ss, o, 64);
      const float rstd = rsqrtf(ss * (1.f / 512.f) + 1e-6f);
      unsigned ou[8];
#pragma unroll
      for (int e = 0; e < 8; e++)
        ou[e] = pack2(yv[2 * e] * rstd * p.ssm_norm_w[c + 2 * e], yv[2 * e + 1] * rstd * p.ssm_norm_w[c + 2 * e + 1]);
      *(uint4*)(p.ob + (size_t)n * 1024 + c) = make_uint4(ou[0], ou[1], ou[2], ou[3]);
      *(uint4*)(p.ob + (size_t)n * 1024 + c + 8) = make_uint4(ou[4], ou[5], ou[6], ou[7]);
    }
  }
}

__device__ void phase6(const P& p, int bid, int nb, char* smem) {
  TileIter ti(bid, nb, 136, 8);
  int mt, nt;
  while (ti.next(mt, nt)) {
    f32x4 ac[4][4];
    u16* Lm = (u16*)(smem + 2 * 128 * LROW);
    zero_acc(ac);
    gemm_tile(p.xn, D, mt * 128, p.w_inT + (size_t)G_A * D, D, nt * 128, D, ac, smem);
    ACC_FOREACH({ Lm[row * 136 + col] = f2bf(sigmoidf_(ac[m][n][j])); })
    zero_acc(ac);
    gemm_tile(p.oa, 512, mt * 128, p.w_paT, 512, nt * 128, 512, ac, smem);
    ACC_FOREACH({ Lm[row * 136 + col] = f2bf(bf2f(Lm[row * 136 + col]) * ac[m][n][j]); })
    zero_acc(ac);
    gemm_tile(p.xn, D, mt * 128, p.w_inT + (size_t)G_B * D, D, nt * 128, D, ac, smem);
    ACC_FOREACH({ p.merged[(size_t)(mt * 128 + row) * D + nt * 128 + col] = f2bf(sigmoidf_(ac[m][n][j])); })
    zero_acc(ac);
    gemm_tile(p.ob, D, mt * 128, p.w_pbT, D, nt * 128, D, ac, smem);
    ACC_FOREACH({
      u16* mp = p.merged + (size_t)(mt * 128 + row) * D + nt * 128 + col;
      *mp = f2bf(bf2f(Lm[row * 136 + col]) + bf2f(*mp) * ac[m][n][j]);
    })
  }
}

constexpr int P7_G = 136 * 8, P7_CV = 16384;
constexpr float U_SCALE = 256.f, V_SCALE = 32.f;
__device__ void phase7(const P& p, int bid, int nb, char* smem) {
  {
    TileIter ti(bid, nb, 136, 8);
    int mt, nt;
    while (ti.next(mt, nt)) {
      f32x4 acc[4][4];
      zero_acc(acc);
      gemm_tile(p.merged, D, mt * 128, p.w_outT, D, nt * 128, D, acc, smem);
      ACC_FOREACH({
        const int nn = mt * 128 + row, c = nt * 128 + col;
        int seq, t, T; tok2seq(nn, seq, t, T);
        const float gt = p.mod[(size_t)seq * 8192 + 2048 + c];
        p.out[O_Y + (size_t)nn * D + c] = xrow(p, nn)[c] + gt * acc[m][n][j];
      })
    }
  }
  for (int it0 = bid; it0 < P7_CV; it0 += 4 * nb) {
    const int tid = TIDX;
    float4 va[4], vb[4];
#pragma unroll
    for (int r = 0; r < 4; r++) {
      const int it = it0 + r * nb;
      if (it < P7_CV) {
        const float* src = it < 8192 ? p.peer_u + (size_t)it * 2048 : p.peer_v + (size_t)(it - 8192) * 2048;
        const float4* s4 = (const float4*)src + tid * 2;
        va[r] = s4[0]; vb[r] = s4[1];
      }
    }
#pragma unroll
    for (int r = 0; r < 4; r++) {
      const int it = it0 + r * nb;
      if (it < P7_CV) {
        unsigned char* dst = it < 8192 ? (unsigned char*)p.ub + (size_t)it * 2048 : (unsigned char*)p.vb + (size_t)(it - 8192) * 2048;
        const float sc = it < 8192 ? U_SCALE : V_SCALE;
        const float4 a = va[r], b = vb[r];
        int lo = __builtin_amdgcn_cvt_pk_fp8_f32(a.x * sc, a.y * sc, 0, false);
        lo = __builtin_amdgcn_cvt_pk_fp8_f32(a.z * sc, a.w * sc, lo, true);
        int hi = __builtin_amdgcn_cvt_pk_fp8_f32(b.x * sc, b.y * sc, 0, false);
        hi = __builtin_amdgcn_cvt_pk_fp8_f32(b.z * sc, b.w * sc, hi, true);
        *((uint2*)dst + tid) = make_uint2((unsigned)lo, (unsigned)hi);
      }
    }
  }
}

__device__ void phase9(const P& p, int bid, int nb, char* smem) {
  const int tid = TIDX, lane = tid & 63, wid = tid >> 6, wr = wid >> 1, wc = wid & 1, fr = lane & 15,
            fq = lane >> 4;
  TileIter ti(bid, nb, 136, 16);
  int mt, nt;
  while (ti.next(mt, nt)) {
    f32x4 acc[4][4];
    zero_acc(acc);
    gemm_tile<false>(p.xn, D, mt * 128, p.wqT, D, nt * 128, D, acc, smem);
    u16* Lq = (u16*)smem;
    ACC_FOREACH({ Lq[row * 136 + col] = f2bf(acc[m][n][j]); })
    __syncthreads();
    f32x4 sc[4][4];
    zero_acc(sc);
    const u16* kb = p.keysb + (size_t)nt * 128 * 128;
#pragma unroll 1
    for (int s = 0; s < 4; s++) {
      bf16x8 af[4], bfr[4];
#pragma unroll
      for (int m = 0; m < 4; m++) af[m] = *(const bf16x8*)((const char*)Lq + (wr * 64 + m * 16 + fr) * 272 + s * 64 + fq * 16);
#pragma unroll
      for (int n = 0; n < 4; n++) bfr[n] = *(const bf16x8*)(kb + (size_t)(wc * 64 + n * 16 + fr) * 128 + s * 32 + fq * 8);
#pragma unroll
      for (int m = 0; m < 4; m++)
#pragma unroll
        for (int n = 0; n < 4; n++) sc[m][n] = __builtin_amdgcn_mfma_f32_16x16x32_bf16(af[m], bfr[n], sc[m][n], 0, 0, 0);
    }
    __syncthreads();
    float* Ls = (float*)smem;
#pragma unroll
    for (int m = 0; m < 4; m++)
#pragma unroll
      for (int n = 0; n < 4; n++)
#pragma unroll
        for (int j = 0; j < 4; j++) Ls[(wr * 64 + m * 16 + fq * 4 + j) * 129 + wc * 64 + n * 16 + fr] = sc[m][n][j];
    __syncthreads();
    {
      const int row = tid >> 1, half = tid & 1;
      float* Lr = Ls + row * 129;
      const size_t ob = ((size_t)(mt * 128 + row) * 16 + nt) * 16;
      for (int r = 0; r < 16; r++) {
        float best = -INFINITY; int bi = 0;
        for (int i = 0; i < 64; i++) {
          const float v = Lr[half + 2 * i];
          if (v > best) { best = v; bi = half + 2 * i; }
        }
        const float ov = __shfl_xor(best, 1, 64);
        const int oi = __shfl_xor(bi, 1, 64);
        if (ov > best || (ov == best && oi < bi)) { best = ov; bi = oi; }
        if ((bi & 1) == half) Lr[bi] = -INFINITY;
        if (half == 0) { p.topv[ob + r] = best; p.topi[ob + r] = bi; }
      }
    }
    __syncthreads();
  }
}

__device__ __forceinline__ void cand_ij(int lane, int& ci, int& cj) {
  int i = 0, rem = lane;
#pragma unroll
  for (int r = 0; r < 16; r++) {
    const int cnt = 16 / (r + 1);
    if (i == r && rem >= cnt) { rem -= cnt; i = r + 1; }
  }
  ci = i; cj = rem;
}

typedef __attribute__((ext_vector_type(2))) __bf16 bf2_t;
__device__ __forceinline__ float dot2bf(unsigned a, unsigned b, float c) {
  return __builtin_amdgcn_fdot2_f32_bf16(__builtin_bit_cast(bf2_t, a), __builtin_bit_cast(bf2_t, b), c, false);
}
template <int CTRL, int RM>
__device__ __forceinline__ float dppf_m(float x) {
  return __int_as_float(__builtin_amdgcn_update_dpp(0, __float_as_int(x), CTRL, RM, 0xf, false));
}
__device__ __forceinline__ float wave_sum_l63(float x) {
  x += dppf<0xB1>(x);
  x += dppf<0x4E>(x);
  x += dppf<0x141>(x);
  x += dppf<0x140>(x);
  x += dppf_m<0x142, 0xA>(x);
  x += dppf_m<0x143, 0xC>(x);
  return x;
}
__device__ __forceinline__ float readlane_f(float x, int l) {
  return __int_as_float(__builtin_amdgcn_readlane(__float_as_int(x), l));
}
__device__ __forceinline__ void axpy8(float* acc, float w, uint4 v) {
  acc[0] += w * bflo(v.x); acc[1] += w * bfhi(v.x); acc[2] += w * bflo(v.y); acc[3] += w * bfhi(v.y);
  acc[4] += w * bflo(v.z); acc[5] += w * bfhi(v.z); acc[6] += w * bflo(v.w); acc[7] += w * bfhi(v.w);
}

typedef float f2_t __attribute__((ext_vector_type(2)));
__device__ __forceinline__ void fp8x16_to_f32(const uint4 v, float* o) {
  const unsigned w[4] = {v.x, v.y, v.z, v.w};
#pragma unroll
  for (int i = 0; i < 4; i++) {
    const f2_t lo = __builtin_amdgcn_cvt_pk_f32_fp8((int)w[i], false);
    const f2_t hi = __builtin_amdgcn_cvt_pk_f32_fp8((int)w[i], true);
    o[4 * i] = lo.x; o[4 * i + 1] = lo.y; o[4 * i + 2] = hi.x; o[4 * i + 3] = hi.y;
  }
}

__device__ void phase10(const P& p, int bid, int nb) {
  const int lane = TIDX & 63, wid = TIDX >> 6;
  int ci, cj; cand_ij(lane < 50 ? lane : 0, ci, cj);
  const unsigned char* ub8 = (const unsigned char*)p.ub;
  const unsigned char* vb8 = (const unsigned char*)p.vb;
  for (int it = bid; it < NT / 4; it += nb) {
    const int n = it * 4 + wid;
    int seq, t, T; tok2seq(n, seq, t, T);
    float xv[16];
    {
      const uint4 a = *(const uint4*)(p.xn + (size_t)n * D + lane * 16), b = *(const uint4*)(p.xn + (size_t)n * D + lane * 16 + 8);
      const unsigned as[4] = {a.x, a.y, a.z, a.w}, bs[4] = {b.x, b.y, b.z, b.w};
#pragma unroll
      for (int e = 0; e < 4; e++) { xv[2 * e] = bflo(as[e]); xv[2 * e + 1] = bfhi(as[e]); xv[8 + 2 * e] = bflo(bs[e]); xv[8 + 2 * e + 1] = bfhi(bs[e]); }
    }
    float acc[16];
#pragma unroll
    for (int e = 0; e < 16; e++) acc[e] = 0.f;
#pragma unroll 1
    for (int h = 0; h < 8; h++) {
      const size_t base = ((size_t)n * 16 + h * 2) * 16;
      float cand = -INFINITY; int eid = 0;
      if (lane < 50) {
        cand = p.topv[base + ci] + p.topv[base + 16 + cj];
        eid = p.topi[base + ci] * 128 + p.topi[base + 16 + cj];
      }
      int rank = 0;
#pragma unroll
      for (int m = 0; m < 50; m++) {
        const float cm = readlane_f(cand, m);
        rank += ((cm > cand) || (cm == cand && m < lane)) ? 1 : 0;
      }
      const bool sel = (lane < 50) && (rank < 16);
      unsigned long long mask = __ballot(sel);
      const float mx = readlane_f(cand, __builtin_ctzll(__ballot(sel && rank == 0)));
      const float ex = sel ? __expf(cand - mx) : 0.f;
      const float den = readlane_f(wave_sum_l63(ex), 63);
      const float gate = ex / den;
#pragma unroll 1
      for (int hf = 0; hf < 2; hf++) {
        int ek[8]; float gk[8];
#pragma unroll
        for (int k = 0; k < 8; k++) {
          const int src = __builtin_ctzll(mask);
          mask &= mask - 1;
          ek[k] = __builtin_amdgcn_readlane(eid, src);
          gk[k] = readlane_f(gate, src);
        }
        uint4 uu[8], vv[8];
#pragma unroll
        for (int j = 0; j < 8; j++) uu[j] = *(const uint4*)(ub8 + (size_t)ek[j] * D + lane * 16);
#pragma unroll
        for (int j = 0; j < 8; j++) vv[j] = *(const uint4*)(vb8 + (size_t)ek[j] * D + lane * 16);
        float dv = 0.f;
#pragma unroll
        for (int j = 0; j < 8; j++) {
          float uf[16];
          fp8x16_to_f32(uu[j], uf);
          float d0 = 0.f, d1 = 0.f;
#pragma unroll
          for (int e = 0; e < 8; e++) { d0 += uf[2 * e] * xv[2 * e]; d1 += uf[2 * e + 1] * xv[2 * e + 1]; }
          const float ds = readlane_f(wave_sum_l63(d0 + d1), 63);
          dv = (lane == j) ? ds : dv;
        }
        dv *= (1.f / U_SCALE);
        const float act = 0.5f * dv * (1.f + erff(dv * 0.70710678118654752f));
#pragma unroll
        for (int j = 0; j < 8; j++) {
          const float w = readlane_f(act, j) * gk[j] * (1.f / V_SCALE);
          float vf[16];
          fp8x16_to_f32(vv[j], vf);
#pragma unroll
          for (int e = 0; e < 16; e++) acc[e] += w * vf[e];
        }
      }
    }
    float* yr = p.out + O_Y + (size_t)n * D + lane * 16;
    const float* md = p.mod + (size_t)seq * 8192 + lane * 16;
    float x2[16];
    float ss = 0.f;
#pragma unroll
    for (int q4 = 0; q4 < 4; q4++) {
      const float4 a = *(const float4*)(yr + q4 * 4), g = *(const float4*)(md + 5120 + q4 * 4);
      x2[q4 * 4 + 0] = a.x + g.x * acc[q4 * 4 + 0]; x2[q4 * 4 + 1] = a.y + g.y * acc[q4 * 4 + 1];
      x2[q4 * 4 + 2] = a.z + g.z * acc[q4 * 4 + 2]; x2[q4 * 4 + 3] = a.w + g.w * acc[q4 * 4 + 3];
    }
#pragma unroll
    for (int e = 0; e < 16; e++) ss += x2[e] * x2[e];
    ss = readlane_f(wave_sum_l63(ss), 63);
    const float rstd = rsqrtf(ss * (1.f / 1024.f) + 1e-6f);
#pragma unroll
    for (int q4 = 0; q4 < 4; q4++) {
      const float4 fg = *(const float4*)(p.final_g + lane * 16 + q4 * 4), sc = *(const float4*)(md + 7168 + q4 * 4),
                   sh = *(const float4*)(md + 6144 + q4 * 4);
      float4 o;
      o.x = x2[q4 * 4 + 0] * rstd * fg.x * (1.f + sc.x) + sh.x;
      o.y = x2[q4 * 4 + 1] * rstd * fg.y * (1.f + sc.y) + sh.y;
      o.z = x2[q4 * 4 + 2] * rstd * fg.z * (1.f + sc.z) + sh.z;
      o.w = x2[q4 * 4 + 3] * rstd * fg.w * (1.f + sc.w) + sh.w;
      *(float4*)(yr + q4 * 4) = o;
    }
  }
}

#define XB_XCNT(j) (256 + 64 * (j))
#define XB_XSUB(j) (1280 + 64 * (j))
#define XB_XGEN(j) (2304 + 64 * (j))
#define XB_TOP 3328
#define XB_TOPGEN 3392
#define XB_WORDS 4096
__device__ __forceinline__ unsigned xb_ld(unsigned* p) { return __hip_atomic_load(p, __ATOMIC_RELAXED, __HIP_MEMORY_SCOPE_AGENT); }
__device__ __forceinline__ unsigned xb_add(unsigned* p, unsigned v) { return __hip_atomic_fetch_add(p, v, __ATOMIC_RELAXED, __HIP_MEMORY_SCOPE_AGENT); }
__device__ __forceinline__ unsigned xb_xcc_id() { return (unsigned)__builtin_amdgcn_s_getreg((3 << 11) | 20) & 0xFu; }
__device__ __forceinline__ void grid_barrier(unsigned* bar, volatile unsigned* xst) {
  asm volatile("s_waitcnt vmcnt(0)" ::: "memory");
  __syncthreads();
  if (TIDX == 0) {
    __builtin_amdgcn_s_waitcnt(0);
    const unsigned x = xst[0], nloc = xst[1], nx = xst[2];
    const unsigned old = xb_add(&bar[XB_XSUB(x)], 1u);
    const unsigned gen = old / nloc;
    if (old + 1u == (gen + 1u) * nloc) {
      __builtin_amdgcn_fence(__ATOMIC_RELEASE, "agent");
      asm volatile("s_waitcnt vmcnt(0)" ::: "memory");
      const unsigned og = xb_add(&bar[XB_TOP], 1u);
      const unsigned tg = og / nx;
      if (og + 1u == (tg + 1u) * nx) xb_add(&bar[XB_TOPGEN], 1u);
      else while (xb_ld(&bar[XB_TOPGEN]) == tg) __builtin_amdgcn_s_sleep(1);
      __builtin_amdgcn_fence(__ATOMIC_ACQUIRE, "agent");
      xb_add(&bar[XB_XGEN(x)], 1u);
      asm volatile("s_waitcnt vmcnt(0)" ::: "memory");
    } else {
      while (xb_ld(&bar[XB_XGEN(x)]) == gen) __builtin_amdgcn_s_sleep(1);
      __builtin_amdgcn_fence(__ATOMIC_ACQUIRE, "agent");
      asm volatile("s_waitcnt vmcnt(0)" ::: "memory");
    }
  }
  __syncthreads();
}

template <int PH>
__device__ __forceinline__ void run_phase(const P& p, int bid, int nb, char* smem) {
  if constexpr (PH == 0) phase0(p, bid, nb, smem);
  if constexpr (PH == 1) phase_norm<false>(p, bid, nb);
  if constexpr (PH == 2) phase2(p, bid, nb, smem);
  if constexpr (PH == 3) phase3(p, bid, nb, smem);
  if constexpr (PH == 4) phase4(p, bid, nb, smem);
  if constexpr (PH == 5) phase5(p, bid, nb);
  if constexpr (PH == 6) phase6(p, bid, nb, smem);
  if constexpr (PH == 7) phase7(p, bid, nb, smem);
  if constexpr (PH == 8) phase_norm<true>(p, bid, nb);
  if constexpr (PH == 9) phase9(p, bid, nb, smem);
  if constexpr (PH == 10) phase10(p, bid, nb);
  if constexpr (PH == 11) phase3b(p, bid, nb, smem);
}

template <int PH>
__global__ void __launch_bounds__(NTHREADS, 2) k_phase(P p) {
  extern __shared__ __attribute__((aligned(16))) char smem[];
  run_phase<PH>(p, blockIdx.x, gridDim.x, smem);
}

#if MEGA
__global__ void __launch_bounds__(NTHREADS, 2) k_mega(P p) {
  extern __shared__ __attribute__((aligned(16))) char smem[];
  cg::grid_group grid = cg::this_grid();
  const int bid = blockIdx.x, nb = gridDim.x;
#ifndef PROBE_ALL2
#define PROBE_ALL2 0
#endif
#ifndef PROBE_MASK
#define PROBE_MASK 0
#endif
#ifndef PROBE_SYNCS
#define PROBE_SYNCS 0
#endif
  volatile unsigned* xst = (volatile unsigned*)(smem + LDS_BYTES - 16);
  if (TIDX == 0) { const unsigned xcc0 = xb_xcc_id(); xst[0] = xcc0; xb_add(&p.bar[XB_XCNT(xcc0)], 1u); }
#define GSYNC(k)                                                                                 \
  {                                                                                              \
    if ((k) == 0) {                                                                              \
      grid.sync();                                                                               \
      if (TIDX == 0) {                                                                    \
        unsigned cnt = 0;                                                                        \
        for (unsigned j = 0; j < 16; ++j) cnt += xb_ld(&p.bar[XB_XCNT(j)]) > 0u ? 1u : 0u;       \
        xst[2] = cnt; xst[1] = xb_ld(&p.bar[XB_XCNT(xst[0])]);                                   \
      }                                                                                          \
    } else grid_barrier(p.bar, xst);                                                             \
  }
#define RUNPH(k)                                                       \
  run_phase<k>(p, bid, nb, smem); GSYNC(k)                             \
  if (PROBE_MASK & (1 << k)) { run_phase<k>(p, bid, nb, smem); GSYNC(1) }
#pragma unroll 1
  for (int rep = 0; rep < 1 + PROBE_ALL2; rep++) {
    RUNPH(0)
#pragma unroll 1
    for (int i = 0; i < PROBE_SYNCS; i++) GSYNC(1)
    RUNPH(1) RUNPH(2) RUNPH(3) RUNPH(11) RUNPH(4) RUNPH(5) RUNPH(6) RUNPH(7) RUNPH(8) RUNPH(9)
  }
  run_phase<10>(p, bid, nb, smem);
}
#endif

template <int PH>
static void launch_phase(const P& p, int grid, hipStream_t stream) {
  static bool attr = false;
  if (!attr) { hipFuncSetAttribute((const void*)k_phase<PH>, hipFuncAttributeMaxDynamicSharedMemorySize, LDS_BYTES); attr = true; }
  hipLaunchKernelGGL(k_phase<PH>, dim3(grid), dim3(NTHREADS), LDS_BYTES, stream, p);
}

extern "C" void kernel_launch(void* const* d_in, const int* in_sizes, int n_in, void* d_out, int out_size, void* d_ws,
                              size_t ws_size, hipStream_t stream) {
  P p{};
  const float** fp = (const float**)&p;
  for (int i = 0; i < 40; i++) fp[i] = (const float*)d_in[i];
  p.out = (float*)d_out;
  char* ws = (char*)d_ws;
  size_t off = 0;
  auto take = [&](size_t bytes) { char* r = ws + off; off += (bytes + 255) & ~(size_t)255; return r; };
  p.bar = (unsigned*)take(XB_WORDS * 4);
  p.w_inT = (u16*)take((size_t)INCOLS * D * 2);
  p.w_paT = (u16*)take((size_t)1024 * 512 * 2);
  p.w_pbT = (u16*)take((size_t)1024 * 1024 * 2);
  p.w_outT = (u16*)take((size_t)1024 * 1024 * 2);
  p.wqT = (u16*)take((size_t)2048 * 1024 * 2);
  p.keysb = (u16*)take((size_t)262144 * 2);
  p.mod = (float*)take((size_t)NSEQ * 8192 * 4);
  p.dtb = (float*)take((size_t)NT * 16 * 4);
  p.decb = (float*)take((size_t)NT * 16 * 4);
  p.xn = (u16*)take((size_t)NROWS * D * 2);
  p.proj = (u16*)take((size_t)NROWS * PCOLS * 2);
  p.prep = (u16*)take((size_t)NT * 3584 * 2);
  p.w2T = (u16*)take(512 * 64 * 2);
  p.a2T = (u16*)take(512 * 64 * 2);
  p.g2T = (u16*)take(512 * 128 * 2);
  p.lora = (u16*)take((size_t)NT * 256 * 2);
  if (off > ws_size) { fprintf(stderr, "workspace too small: need %zu have %zu\n", off, ws_size); return; }
  p.merged = p.prep;
  p.ub = p.proj;
  p.vb = p.proj + (size_t)16384 * 1024;
  p.topv = (float*)(p.proj + (size_t)2 * 16384 * 1024);
  p.topi = (int*)(p.topv + (size_t)NT * 256);
  p.xc = (u16*)d_out;
  p.oa = (u16*)d_out;
  p.ob = (u16*)d_out + (size_t)NT * 512;

  static int grid = 0;
  if (!grid) {
    int dev = 0, cus = 0, per_cu = 0;
    hipGetDevice(&dev);
    hipDeviceGetAttribute(&cus, hipDeviceAttributeMultiprocessorCount, dev);
#if MEGA
    hipFuncSetAttribute((const void*)k_mega, hipFuncAttributeMaxDynamicSharedMemorySize, LDS_BYTES);
    hipOccupancyMaxActiveBlocksPerMultiprocessor(&per_cu, k_mega, NTHREADS, LDS_BYTES);
    if (per_cu > 2) per_cu = 2;
#else
    per_cu = 2;
#endif
    if (per_cu < 1) per_cu = 1;
    grid = cus * per_cu;
  }
  hipMemsetAsync(p.mod, 0, (size_t)NSEQ * 8192 * 4, stream);
#if MEGA
  hipMemsetAsync(p.bar, 0, XB_WORDS * 4, stream);
  void* args[] = {&p};
  hipError_t e = hipLaunchCooperativeKernel((void*)k_mega, dim3(grid), dim3(NTHREADS), args, LDS_BYTES, stream);
  if (e != hipSuccess) fprintf(stderr, "cooperative launch failed: %s (grid %d)\n", hipGetErrorString(e), grid);
#else
  launch_phase<0>(p, grid, stream);
  launch_phase<1>(p, grid, stream);
  launch_phase<2>(p, grid, stream);
  launch_phase<3>(p, grid, stream);
  launch_phase<11>(p, grid, stream);
  launch_phase<4>(p, grid, stream);
  launch_phase<5>(p, grid, stream);
  launch_phase<6>(p, grid, stream);
  launch_phase<7>(p, grid, stream);
  launch_phase<8>(p, grid, stream);
  launch_phase<9>(p, grid, stream);
  launch_phase<10>(p, grid, stream);
#endif
}
```

```cpp
#include <hip/hip_runtime.h>
#include <hip/hip_cooperative_groups.h>
#include <cstdio>
namespace cg = cooperative_groups;

#ifndef MEGA
#define MEGA 1
#endif

typedef unsigned short u16;
typedef __attribute__((ext_vector_type(8))) short bf16x8;
typedef __attribute__((ext_vector_type(4))) float f32x4;

__device__ __forceinline__ int opaque_tid() { int t = threadIdx.x; asm volatile("" : "+v"(t)); return t; }
#define TIDX opaque_tid()

constexpr int D = 1024;
constexpr int NP = 16384, NS = 1024, NT = NP + NS, NSEQ = 136;
constexpr int NROWS = NT + 128;
constexpr int PCOLS = 4368;
constexpr int INCOLS = 6416;
constexpr int C_LW = 1536, C_LA = 1600, C_LG = 1664, C_Z = 1792, C_XBC = 2816, C_DT = 4352;
constexpr int G_A = 4368, G_B = 5392;
constexpr size_t O_Y = 0, O_PSHIFT = 17825792, O_PWKV = 17833984, O_PCONV = 18096128, O_PSSM = 18132992,
                 O_SSHIFT = 19181568, O_SWKV = 19312640, O_SCONV = 23506944, O_SSSM = 24096768;
constexpr int LDS_BYTES = 80 * 1024;
constexpr int NTHREADS = 256;

struct P {
  const float *x_prompt, *x_sample, *c_prompt, *c_sample, *state_shift, *state_wkv, *state_conv, *state_ssm;
  const float *w_ada, *b_ada, *norm1_g, *w_in, *rw_mu, *rw_w0, *rw_w2, *rw_a0, *rw_a2, *rw_g2, *rw_k_k, *rw_k_a,
      *rw_r_k, *rw_ln_w, *rw_ln_b;
  const float *conv_w, *conv_b, *dt_bias, *A_log, *D_skip, *ssm_norm_w, *w_pa, *w_pb, *w_out, *norm2_g, *peer_wq,
      *peer_keys, *peer_u, *peer_v, *final_g, *w_ada_f, *b_ada_f;
  float* out;
  u16 *w_inT, *w_paT, *w_pbT, *w_outT, *wqT, *keysb, *xn, *proj, *prep, *merged, *ub, *vb, *xc, *oa, *ob;
  u16 *w2T, *a2T, *g2T, *lora;
  float *mod, *dtb, *decb, *topv;
  int* topi;
  unsigned* bar;
};

__device__ __forceinline__ u16 f2bf(float f) {
  unsigned u = __float_as_uint(f);
  u += 0x7fffu + ((u >> 16) & 1u);
  return (u16)(u >> 16);
}
__device__ __forceinline__ float bf2f(u16 h) { return __uint_as_float(((unsigned)h) << 16); }
__device__ __forceinline__ unsigned pack2(float a, float b) { return (unsigned)f2bf(a) | ((unsigned)f2bf(b) << 16); }
__device__ __forceinline__ float bflo(unsigned u) { return __uint_as_float(u << 16); }
__device__ __forceinline__ float bfhi(unsigned u) { return __uint_as_float(u & 0xffff0000u); }
__device__ __forceinline__ float sigmoidf_(float x) { return 1.f / (1.f + __expf(-x)); }
__device__ __forceinline__ float siluf_(float x) { return x / (1.f + __expf(-x)); }
__device__ __forceinline__ float softplusf_(float x) { return x > 20.f ? x : log1pf(expf(x)); }

template <int CTRL>
__device__ __forceinline__ float dppf(float x) {
  return __int_as_float(__builtin_amdgcn_update_dpp(0, __float_as_int(x), CTRL, 0xf, 0xf, true));
}
__device__ __forceinline__ float allreduce16(float x) {
  x += dppf<0x128>(x);
  x += dppf<0x124>(x);
  x += dppf<0x122>(x);
  x += dppf<0x121>(x);
  return x;
}
__device__ __forceinline__ float allreduce8(float x) {
  x += dppf<0xB1>(x);
  x += dppf<0x4E>(x);
  x += dppf<0x141>(x);
  return x;
}
__device__ __forceinline__ float wave_sum(float x) {
#pragma unroll
  for (int o = 32; o >= 1; o >>= 1) x += __shfl_xor(x, o, 64);
  return x;
}
__device__ __forceinline__ float wave_max(float x) {
#pragma unroll
  for (int o = 32; o >= 1; o >>= 1) x = fmaxf(x, __shfl_xor(x, o, 64));
  return x;
}
__device__ __forceinline__ int wave_min_i(int x) {
#pragma unroll
  for (int o = 32; o >= 1; o >>= 1) x = min(x, __shfl_xor(x, o, 64));
  return x;
}

__device__ __forceinline__ const float* xrow(const P& p, int n) {
  return n < NP ? p.x_prompt + (size_t)n * D : p.x_sample + (size_t)(n - NP) * D;
}
__device__ __forceinline__ void tok2seq(int n, int& seq, int& t, int& T) {
  if (n < NP) { seq = n >> 11; t = n & 2047; T = 2048; }
  else { int m = n - NP; seq = 8 + (m >> 3); t = m & 7; T = 8; }
}
__device__ __forceinline__ float* seq_out(float* out, int seq, size_t op, size_t os, size_t per) {
  return seq < 8 ? out + op + (size_t)seq * per : out + os + (size_t)(seq - 8) * per;
}

constexpr int LROW = 144;
template <bool DEEP = true>
__device__ __forceinline__ void gemm_tile(const u16* __restrict__ A, int lda, int m0, const u16* __restrict__ Bt,
                                          int ldb, int n0, int K, f32x4 (&acc)[4][4], char* smem) {
  char* sA = smem;
  char* sB = smem + 128 * LROW;
  const int tid = TIDX, lane = tid & 63, wid = tid >> 6, wr = wid >> 1, wc = wid & 1, fr = lane & 15,
            fq = lane >> 4;
  uint4 ra0, ra1, ra2, ra3, rb0, rb1, rb2, rb3;
  uint4 sa0, sa1, sa2, sa3, sb0, sb1, sb2, sb3;
  const int nk = K / 64;
  const int lrow = tid >> 3, lch = tid & 7;
  const u16* gA = A + (size_t)(m0 + lrow) * lda + lch * 8;
  const u16* gB = Bt + (size_t)(n0 + lrow) * ldb + lch * 8;
#define GLOAD(x0, x1, x2, x3, y0, y1, y2, y3, kt)                   \
  {                                                                 \
    x0 = *(const uint4*)(gA + (kt) * 64);                           \
    x1 = *(const uint4*)(gA + (size_t)32 * lda + (kt) * 64);        \
    x2 = *(const uint4*)(gA + (size_t)64 * lda + (kt) * 64);        \
    x3 = *(const uint4*)(gA + (size_t)96 * lda + (kt) * 64);        \
    y0 = *(const uint4*)(gB + (kt) * 64);                           \
    y1 = *(const uint4*)(gB + (size_t)32 * ldb + (kt) * 64);        \
    y2 = *(const uint4*)(gB + (size_t)64 * ldb + (kt) * 64);        \
    y3 = *(const uint4*)(gB + (size_t)96 * ldb + (kt) * 64);        \
  }
#define LSTORE(x0, x1, x2, x3, y0, y1, y2, y3)                      \
  {                                                                 \
    char* wa = sA + lrow * LROW + lch * 16;                         \
    char* wb = sB + lrow * LROW + lch * 16;                         \
    *(uint4*)(wa) = x0; *(uint4*)(wa + 32 * LROW) = x1; *(uint4*)(wa + 64 * LROW) = x2; *(uint4*)(wa + 96 * LROW) = x3; \
    *(uint4*)(wb) = y0; *(uint4*)(wb + 32 * LROW) = y1; *(uint4*)(wb + 64 * LROW) = y2; *(uint4*)(wb + 96 * LROW) = y3; \
  }
#define COMPUTE_TILE()                                                                                                   \
  {                                                                                                                      \
    _Pragma("unroll") for (int s = 0; s < 2; s++) {                                                                      \
      bf16x8 af[4], bfr[4];                                                                                              \
      _Pragma("unroll") for (int m = 0; m < 4; m++) af[m] = *(const bf16x8*)(sA + (wr * 64 + m * 16 + fr) * LROW + s * 64 + fq * 16); \
      _Pragma("unroll") for (int n = 0; n < 4; n++) bfr[n] = *(const bf16x8*)(sB + (wc * 64 + n * 16 + fr) * LROW + s * 64 + fq * 16); \
      _Pragma("unroll") for (int m = 0; m < 4; m++)                                                                      \
        _Pragma("unroll") for (int n = 0; n < 4; n++) acc[m][n] = __builtin_amdgcn_mfma_f32_16x16x32_bf16(af[m], bfr[n], acc[m][n], 0, 0, 0); \
    }                                                                                                                    \
  }
  GLOAD(ra0, ra1, ra2, ra3, rb0, rb1, rb2, rb3, 0);
  if constexpr (DEEP) {
    GLOAD(sa0, sa1, sa2, sa3, sb0, sb1, sb2, sb3, 1);
#pragma unroll 1
    for (int kt = 0; kt < nk; kt += 2) {
      __syncthreads();
      LSTORE(ra0, ra1, ra2, ra3, rb0, rb1, rb2, rb3);
      __syncthreads();
      if (kt + 2 < nk) GLOAD(ra0, ra1, ra2, ra3, rb0, rb1, rb2, rb3, kt + 2);
      COMPUTE_TILE();
      __syncthreads();
      LSTORE(sa0, sa1, sa2, sa3, sb0, sb1, sb2, sb3);
      __syncthreads();
      if (kt + 3 < nk) GLOAD(sa0, sa1, sa2, sa3, sb0, sb1, sb2, sb3, kt + 3);
      COMPUTE_TILE();
    }
  } else {
#pragma unroll 1
    for (int kt = 0; kt < nk; kt++) {
      __syncthreads();
      LSTORE(ra0, ra1, ra2, ra3, rb0, rb1, rb2, rb3);
      __syncthreads();
      if (kt + 1 < nk) GLOAD(ra0, ra1, ra2, ra3, rb0, rb1, rb2, rb3, kt + 1);
      COMPUTE_TILE();
    }
  }
  __syncthreads();
}
__device__ __forceinline__ void zero_acc(f32x4 (&acc)[4][4]) {
#pragma unroll
  for (int m = 0; m < 4; m++)
#pragma unroll
    for (int n = 0; n < 4; n++) acc[m][n] = f32x4{0.f, 0.f, 0.f, 0.f};
}
#define ACC_FOREACH(...)                                                                    \
  {                                                                                         \
    const int _l = TIDX & 63, _w = TIDX >> 6, _wr = _w >> 1, _wc = _w & 1;    \
    const int _fr = _l & 15, _fq = _l >> 4;                                                 \
    _Pragma("unroll") for (int m = 0; m < 4; m++) _Pragma("unroll") for (int n = 0; n < 4; n++) \
        _Pragma("unroll") for (int j = 0; j < 4; j++) {                                     \
      const int row = _wr * 64 + m * 16 + _fq * 4 + j, col = _wc * 64 + n * 16 + _fr;       \
      __VA_ARGS__                                                                           \
    }                                                                                       \
  }

struct TileIter {
  int x, lb, nbx, tpx, total, MT, NT, r;
  __device__ __forceinline__ TileIter(int bid, int nb, int MT_, int NT_) : MT(MT_), NT(NT_), r(0) {
    total = MT * NT; x = bid & 7; lb = bid >> 3; nbx = nb >> 3; tpx = (total + 7) >> 3;
  }
  __device__ __forceinline__ bool next(int& mt, int& nt) {
    const int idx = lb + r * nbx;
    r++;
    if (idx >= tpx) return false;
    const int lin = x * tpx + idx;
    if (lin >= total) return false;
    const int bsz = 8 * NT, band = lin / bsz, rem = lin - band * bsz;
    const int mb = min(8, MT - band * 8);
    nt = rem / mb; mt = band * 8 + (rem - nt * mb);
    return true;
  }
};

__device__ void transpose_tile(const float* __restrict__ src, int K, int N, u16* __restrict__ dst, int tile,
                               char* smem) {
  const int ntn = (N + 63) / 64, kt = tile / ntn, nt = tile % ntn, tid = TIDX;
  float(*s)[65] = (float(*)[65])smem;
  __syncthreads();
#pragma unroll 4
  for (int i = 0; i < 16; i++) {
    int r = (tid >> 6) + 4 * i, n = nt * 64 + (tid & 63);
    s[r][tid & 63] = (n < N) ? src[(size_t)(kt * 64 + r) * N + n] : 0.f;
  }
  __syncthreads();
#pragma unroll 4
  for (int i = 0; i < 8; i++) {
    int nl = (tid >> 5) + 8 * i, n = nt * 64 + nl, kl = (tid & 31) * 2;
    if (n < N) *(unsigned*)(dst + (size_t)n * K + kt * 64 + kl) = pack2(s[kl][nl], s[kl + 1][nl]);
  }
}

__device__ void mod_item(const P& p, int item2, char* smem) {
  const int item = item2 >> 1, kh2 = item2 & 1;
  const int tid = TIDX, j = tid & 31, g = tid >> 5;
  const int col0 = item * 32;
  const float* W; const float* bias; int N, cw;
  if (col0 < 6144) { W = p.w_ada; bias = p.b_ada; N = 6144; cw = col0; }
  else { W = p.w_ada_f; bias = p.b_ada_f; N = 2048; cw = col0 - 6144; }
  float(*cs)[68] = (float(*)[68])smem;
  float acc[17];
#pragma unroll
  for (int s = 0; s < 17; s++) acc[s] = 0.f;
  for (int k0 = kh2 * 512; k0 < kh2 * 512 + 512; k0 += 64) {
    __syncthreads();
    {
      float cv[34];
#pragma unroll
      for (int i = 0; i < 34; i++) {
        const int idx = tid + i * 256, seq = idx >> 6, kk = idx & 63;
        cv[i] = seq < 8 ? p.c_prompt[seq * 1024 + k0 + kk] : p.c_sample[(seq - 8) * 1024 + k0 + kk];
      }
#pragma unroll
      for (int i = 0; i < 34; i++) {
        const int idx = tid + i * 256;
        cs[idx >> 6][idx & 63] = siluf_(cv[i]);
      }
    }
    __syncthreads();
#pragma unroll 1
    for (int kh = 0; kh < 2; kh++) {
      float wv[32];
#pragma unroll
      for (int k = 0; k < 32; k++) wv[k] = W[(size_t)(k0 + kh * 32 + k) * N + cw + j];
#pragma unroll 2
      for (int k4 = 0; k4 < 8; k4++) {
#pragma unroll
        for (int s = 0; s < 17; s++) {
          float4 c4 = *(const float4*)&cs[g * 17 + s][kh * 32 + k4 * 4];
          acc[s] += wv[k4 * 4] * c4.x + wv[k4 * 4 + 1] * c4.y + wv[k4 * 4 + 2] * c4.z + wv[k4 * 4 + 3] * c4.w;
        }
      }
    }
  }
  const float b = kh2 == 0 ? bias[cw + j] : 0.f;
#pragma unroll
  for (int s = 0; s < 17; s++) atomicAdd(&p.mod[(size_t)(g * 17 + s) * 8192 + col0 + j], acc[s] + b);
}

constexpr int J_MOD = 512, J_WIN = 16 * 101, J_WPA = 8 * 16, J_WPB = 256, J_WOUT = 256, J_WQ = 16 * 32, J_KEYS = 128,
              J_SHIFT = 64;
constexpr int J_LORA = 8 + 8 + 16;
constexpr int PH0_ITEMS = J_MOD + J_WIN + J_WPA + J_WPB + J_WOUT + J_WQ + J_LORA + J_KEYS + J_SHIFT;

__device__ void phase0(const P& p, int bid, int nb, char* smem) {
  for (int it = bid; it < PH0_ITEMS; it += nb) {
    int i = it;
    if (i < J_MOD) { mod_item(p, i, smem); continue; }
    i -= J_MOD;
    if (i < J_WIN) { transpose_tile(p.w_in, 1024, INCOLS, p.w_inT, i, smem); continue; }
    i -= J_WIN;
    if (i < J_WPA) { transpose_tile(p.w_pa, 512, 1024, p.w_paT, i, smem); continue; }
    i -= J_WPA;
    if (i < J_WPB) { transpose_tile(p.w_pb, 1024, 1024, p.w_pbT, i, smem); continue; }
    i -= J_WPB;
    if (i < J_WOUT) { transpose_tile(p.w_out, 1024, 1024, p.w_outT, i, smem); continue; }
    i -= J_WOUT;
    if (i < J_WQ) { transpose_tile(p.peer_wq, 1024, 2048, p.wqT, i, smem); continue; }
    i -= J_WQ;
    if (i < 8) { transpose_tile(p.rw_w2, 64, 512, p.w2T, i, smem); continue; }
    if (i < 16) { transpose_tile(p.rw_a2, 64, 512, p.a2T, i - 8, smem); continue; }
    if (i < 32) { transpose_tile(p.rw_g2, 128, 512, p.g2T, i - 16, smem); continue; }
    i -= J_LORA;
    const float* src; u16* dst;
    if (i < J_KEYS) { src = p.peer_keys + (size_t)i * 2048; dst = p.keysb + (size_t)i * 2048; }
    else { i -= J_KEYS; src = p.state_shift + (size_t)i * 2048; dst = p.xn + (size_t)NT * D + (size_t)i * 2048; }
    const float4* s4 = (const float4*)src + TIDX * 2;
    float4 a = s4[0], b = s4[1];
    uint4 o; o.x = pack2(a.x, a.y); o.y = pack2(a.z, a.w); o.z = pack2(b.x, b.y); o.w = pack2(b.z, b.w);
    *((uint4*)dst + TIDX) = o;
  }
}

template <bool SECOND>
__device__ void phase_norm(const P& p, int bid, int nb) {
  const int lane = TIDX & 63, wid = TIDX >> 6;
  const float* gam = SECOND ? p.norm2_g : p.norm1_g;
  for (int it = bid; it < NT / 8; it += nb) {
    const int nA = it * 8 + wid * 2;
    float4 v[2][4];
#pragma unroll
    for (int k = 0; k < 2; k++) {
      const int n = nA + k;
      const float* xr = SECOND ? p.out + O_Y + (size_t)n * D : xrow(p, n);
#pragma unroll
      for (int i = 0; i < 4; i++) v[k][i] = ((const float4*)xr)[lane + 64 * i];
    }
#pragma unroll
    for (int k = 0; k < 2; k++) {
      const int n = nA + k;
      int seq, t, T; tok2seq(n, seq, t, T);
      const float* md = p.mod + (size_t)seq * 8192 + (SECOND ? 3072 : 0);
      float ss = 0.f;
#pragma unroll
      for (int i = 0; i < 4; i++)
        ss += v[k][i].x * v[k][i].x + v[k][i].y * v[k][i].y + v[k][i].z * v[k][i].z + v[k][i].w * v[k][i].w;
      ss = wave_sum(ss);
      const float rstd = rsqrtf(ss * (1.f / 1024.f) + 1e-6f);
      const bool last = (!SECOND) && (t == T - 1);
      float* so = seq_out(p.out, seq, O_PSHIFT, O_SSHIFT, 1024);
#pragma unroll
      for (int i = 0; i < 4; i++) {
        const int c = (lane + 64 * i) * 4;
        const float4 g = *(const float4*)(gam + c), sh = *(const float4*)(md + c), sc = *(const float4*)(md + 1024 + c);
        float4 o;
        o.x = v[k][i].x * rstd * g.x * (1.f + sc.x) + sh.x;
        o.y = v[k][i].y * rstd * g.y * (1.f + sc.y) + sh.y;
        o.z = v[k][i].z * rstd * g.z * (1.f + sc.z) + sh.z;
        o.w = v[k][i].w * rstd * g.w * (1.f + sc.w) + sh.w;
        uint2 pk; pk.x = pack2(o.x, o.y); pk.y = pack2(o.z, o.w);
        *(uint2*)(p.xn + (size_t)n * D + c) = pk;
        if (last) *(float4*)(so + c) = o;
      }
    }
  }
}

constexpr int P2_NT = 35, P2_MT = 137;
__device__ void phase2(const P& p, int bid, int nb, char* smem) {
  TileIter ti(bid, nb, P2_MT, P2_NT);
  int mt, nt;
  while (ti.next(mt, nt)) {
    f32x4 acc[4][4];
    zero_acc(acc);
    gemm_tile(p.xn, D, mt * 128, p.w_inT, D, nt * 128, D, acc, smem);
    ACC_FOREACH({
      const int gc = nt * 128 + col;
      if (gc < PCOLS) p.proj[(size_t)(mt * 128 + row) * PCOLS + gc] = f2bf(acc[m][n][j]);
    })
  }
}

__device__ void rwkv_lerp_item(const P& p, int item) {
  const int tid = TIDX;
  const int n0 = item * 8;
  int seq, t0, T; tok2seq(n0, seq, t0, T);
  uint4 pcv[7], ppv[7];
#pragma unroll
  for (int i = 0; i < 7; i++) {
    const int idx = tid + i * 256, tok = idx / 224, c = (idx % 224) * 8;
    const int n = n0 + tok, t = t0 + tok;
    pcv[i] = *(const uint4*)(p.proj + (size_t)n * PCOLS + c);
    const size_t prow = t > 0 ? (size_t)(n - 1) : (size_t)(NT + (seq >= 8 ? seq - 8 : 0));
    ppv[i] = *(const uint4*)(p.proj + prow * PCOLS + c);
    if (t == 0 && seq < 8) ppv[i] = make_uint4(0, 0, 0, 0);
  }
#pragma unroll
  for (int i = 0; i < 7; i++) {
    const int idx = tid + i * 256, tok = idx / 224, c = (idx % 224) * 8;
    const int n = n0 + tok;
    const float4 mu0 = *(const float4*)(p.rw_mu + c), mu1 = *(const float4*)(p.rw_mu + c + 4);
    const float mus[8] = {mu0.x, mu0.y, mu0.z, mu0.w, mu1.x, mu1.y, mu1.z, mu1.w};
    const unsigned pcs[4] = {pcv[i].x, pcv[i].y, pcv[i].z, pcv[i].w}, pps[4] = {ppv[i].x, ppv[i].y, ppv[i].z, ppv[i].w};
    unsigned o[4];
#pragma unroll
    for (int e = 0; e < 4; e++) {
      float a0 = bflo(pcs[e]), a1 = bfhi(pcs[e]), b0 = bflo(pps[e]), b1 = bfhi(pps[e]);
      float q0 = a0 + (b0 - a0) * mus[2 * e], q1 = a1 + (b1 - a1) * mus[2 * e + 1];
      if (c >= C_LW && c < C_LA) { q0 = tanhf(q0); q1 = tanhf(q1); }
      else if (c >= C_LG) { q0 = sigmoidf_(q0); q1 = sigmoidf_(q1); }
      o[e] = pack2(q0, q1);
    }
    u16* dst;
    if (c < 512) dst = p.prep + (size_t)n * 3584 + 512 + c;
    else if (c < 1024) dst = p.prep + (size_t)n * 3584 + 1024 + (c - 512);
    else if (c < 1536) dst = p.prep + (size_t)n * 3584 + 2560 + (c - 1024);
    else dst = p.lora + (size_t)n * 256 + (c - 1536);
    *(uint4*)dst = make_uint4(o[0], o[1], o[2], o[3]);
  }
}

__device__ void rwkv_lora_item(const P& p, int mt, int nt, char* smem) {
  const int tid = TIDX, lane = tid & 63, wid = tid >> 6, wr = wid >> 1, wc = wid & 1, fr = lane & 15, fq = lane >> 4;
  const int col0 = nt * 128;
  f32x4 acc[4][4];
  zero_acc(acc);
  gemm_tile<false>(p.lora, 256, mt * 128, p.w2T, 64, col0, 64, acc, smem);
  ACC_FOREACH({
    const int gc = col0 + col;
    const float wpre = p.rw_w0[gc] + acc[m][n][j];
    const float w = -softplusf_(-wpre) - 0.5f;
    p.prep[(size_t)(mt * 128 + row) * 3584 + gc] = f2bf(-expf(w));
  })
  zero_acc(acc);
  gemm_tile<false>(p.lora + 128, 256, mt * 128, p.g2T, 128, col0, 128, acc, smem);
  ACC_FOREACH({ p.prep[(size_t)(mt * 128 + row) * 3584 + 3072 + col0 + col] = f2bf(acc[m][n][j]); })
  zero_acc(acc);
  gemm_tile<false>(p.lora + 64, 256, mt * 128, p.a2T, 64, col0, 64, acc, smem);
  float a0c[4], kkc[4], kac[4];
#pragma unroll
  for (int n = 0; n < 4; n++) {
    const int gc = col0 + wc * 64 + n * 16 + fr;
    a0c[n] = p.rw_a0[gc]; kkc[n] = p.rw_k_k[gc]; kac[n] = p.rw_k_a[gc];
  }
#pragma unroll
  for (int m = 0; m < 4; m++)
#pragma unroll
    for (int j = 0; j < 4; j++) {
      const int row = mt * 128 + wr * 64 + m * 16 + fq * 4 + j;
      u16* pr = p.prep + (size_t)row * 3584 + col0 + wc * 64 + fr;
      float kx[4], kkv[4], av[4];
      float ss = 0.f;
#pragma unroll
      for (int n = 0; n < 4; n++) {
        kx[n] = bf2f(pr[1024 + n * 16]);
        av[n] = sigmoidf_(a0c[n] + acc[m][n][j]);
        kkv[n] = kx[n] * kkc[n];
        ss += kkv[n] * kkv[n];
      }
      ss = allreduce16(ss);
      const float inv = 1.f / fmaxf(sqrtf(ss), 1e-12f);
#pragma unroll
      for (int n = 0; n < 4; n++) {
        const float kk = kkv[n] * inv;
        pr[1024 + n * 16] = f2bf(kx[n] * (1.f + (av[n] - 1.f) * kac[n]));
        pr[1536 + n * 16] = f2bf(kk);
        pr[2048 + n * 16] = f2bf(kk * av[n]);
      }
    }
}

__device__ void conv_prep_item(const P& p, int item) {
  const int tid = TIDX;
  const int n0 = item * 8;
  int seq, t0, T; tok2seq(n0, seq, t0, T);
  if (tid < 192) {
    const int c = tid * 8;
    uint4 rows[11];
#pragma unroll
    for (int j = 0; j < 11; j++) {
      const int tt = t0 - 3 + j;
      rows[j] = make_uint4(0, 0, 0, 0);
      if (tt >= 0) rows[j] = *(const uint4*)(p.proj + (size_t)(n0 - 3 + j) * PCOLS + C_XBC + c);
      else if (seq >= 8) {
        const float* sc = p.state_conv + ((size_t)(seq - 8) * 3 + (tt + 3)) * 1536 + c;
        const float4 a = *(const float4*)sc, b = *(const float4*)(sc + 4);
        rows[j] = make_uint4(pack2(a.x, a.y), pack2(a.z, a.w), pack2(b.x, b.y), pack2(b.z, b.w));
      }
    }
    float w[4][8], cb[8];
#pragma unroll
    for (int j = 0; j < 4; j++) {
      const float4 a = *(const float4*)(p.conv_w + j * 1536 + c), b = *(const float4*)(p.conv_w + j * 1536 + c + 4);
      w[j][0] = a.x; w[j][1] = a.y; w[j][2] = a.z; w[j][3] = a.w; w[j][4] = b.x; w[j][5] = b.y; w[j][6] = b.z; w[j][7] = b.w;
    }
    {
      const float4 a = *(const float4*)(p.conv_b + c), b = *(const float4*)(p.conv_b + c + 4);
      cb[0] = a.x; cb[1] = a.y; cb[2] = a.z; cb[3] = a.w; cb[4] = b.x; cb[5] = b.y; cb[6] = b.z; cb[7] = b.w;
    }
#pragma unroll
    for (int k = 0; k < 8; k++) {
      float o[8];
#pragma unroll
      for (int e = 0; e < 8; e++) o[e] = cb[e];
#pragma unroll
      for (int j = 0; j < 4; j++) {
        const uint4 r = rows[k + j];
        const unsigned rs[4] = {r.x, r.y, r.z, r.w};
#pragma unroll
        for (int e = 0; e < 4; e++) { o[2 * e] += bflo(rs[e]) * w[j][2 * e]; o[2 * e + 1] += bfhi(rs[e]) * w[j][2 * e + 1]; }
      }
      *(uint4*)(p.xc + (size_t)(n0 + k) * 1536 + c) =
          make_uint4(pack2(siluf_(o[0]), siluf_(o[1])), pack2(siluf_(o[2]), siluf_(o[3])), pack2(siluf_(o[4]), siluf_(o[5])),
                     pack2(siluf_(o[6]), siluf_(o[7])));
    }
    if (t0 + 8 == T) {
      float* co = seq_out(p.out, seq, O_PCONV, O_SCONV, 3 * 1536);
#pragma unroll
      for (int j = 0; j < 3; j++) {
        const uint4 r = rows[8 + j];
        *(float4*)(co + j * 1536 + c) = make_float4(bflo(r.x), bfhi(r.x), bflo(r.y), bfhi(r.y));
        *(float4*)(co + j * 1536 + c + 4) = make_float4(bflo(r.z), bfhi(r.z), bflo(r.w), bfhi(r.w));
      }
    }
  } else if (tid < 192 + 32) {
    const int i = tid - 192;
#pragma unroll
    for (int e = 0; e < 4; e++) {
      const int pi = i * 4 + e, k = pi >> 4, h = pi & 15, n = n0 + k;
      const float raw = bf2f(p.proj[(size_t)n * PCOLS + C_DT + h]) + p.dt_bias[h];
      const float dt = softplusf_(raw);
      const float dA = -dt * expf(p.A_log[h]);
      p.dtb[n * 16 + h] = dt;
      p.decb[n * 16 + h] = dA;
    }
  }
}

__device__ void phase3(const P& p, int bid, int nb, char* smem) {
  for (int it = bid; it < 2 * (NT / 8); it += nb) {
    if (it < NT / 8) rwkv_lerp_item(p, it);
    else conv_prep_item(p, it - NT / 8);
  }
}
__device__ void phase3b(const P& p, int bid, int nb, char* smem) {
  for (int it = bid; it < 136 * 4; it += nb) rwkv_lora_item(p, it >> 2, it & 3, smem);
}

constexpr int TC = 32;
__device__ __forceinline__ void bf8_to_f(uint4 u, float4& lo, float4& hi) {
  lo = make_float4(bflo(u.x), bfhi(u.x), bflo(u.y), bfhi(u.y));
  hi = make_float4(bflo(u.z), bfhi(u.z), bflo(u.w), bfhi(u.w));
}
__device__ void rwkv_scan_item(const P& p, int seq, int h, int qr, char* smem) {
  const int T = seq < 8 ? 2048 : 8, nbase = seq < 8 ? seq * 2048 : NP + (seq - 8) * 8;
  float* Ld = (float*)smem;
  float* Lr = Ld + TC * 64; float* Lk = Lr + TC * 64; float* Lkk = Lk + TC * 64; float* Lb = Lkk + TC * 64;
  float* Lv = Lb + TC * 64;
  const int tid = TIDX, w = tid >> 6, lane = tid & 63, rl = w * 4 + (lane >> 4), ks = lane & 15;
  const int v = qr * 16 + rl;
  float S0 = 0.f, S1 = 0.f, S2 = 0.f, S3 = 0.f;
  if (seq >= 8) {
    float4 s = *(const float4*)(p.state_wkv + (((size_t)(seq - 8) * 8 + h) * 64 + v) * 64 + ks * 4);
    S0 = s.x; S1 = s.y; S2 = s.z; S3 = s.w;
  }
  const int st = tid >> 3, sk8 = (tid & 7) * 8;
  const int vt = tid >> 1, vr8 = (tid & 1) * 8;
  uint4 g0, g1, g2, g3, g4, gv;
  g0 = g1 = g2 = g3 = g4 = gv = make_uint4(0, 0, 0, 0);
#define RW_GLOAD(c0_)                                                                           \
  {                                                                                             \
    const int tcn = min(TC, T - (c0_));                                                         \
    if (st < tcn) {                                                                             \
      const u16* base = p.prep + (size_t)(nbase + (c0_) + st) * 3584 + h * 64 + sk8;            \
      g0 = *(const uint4*)(base); g1 = *(const uint4*)(base + 512); g2 = *(const uint4*)(base + 1024); \
      g3 = *(const uint4*)(base + 1536); g4 = *(const uint4*)(base + 2048);                     \
    }                                                                                           \
    if (tid < 64 && vt < tcn)                                                                   \
      gv = *(const uint4*)(p.prep + (size_t)(nbase + (c0_) + vt) * 3584 + 2560 + h * 64 + qr * 16 + vr8); \
  }
  RW_GLOAD(0);
  for (int c0 = 0; c0 < T; c0 += TC) {
    const int tc = min(TC, T - c0);
    __syncthreads();
    {
      float4 lo, hi;
      bf8_to_f(g0, lo, hi);
      lo.x = __expf(lo.x); lo.y = __expf(lo.y); lo.z = __expf(lo.z); lo.w = __expf(lo.w);
      hi.x = __expf(hi.x); hi.y = __expf(hi.y); hi.z = __expf(hi.z); hi.w = __expf(hi.w);
      *(float4*)(Ld + st * 64 + sk8) = lo; *(float4*)(Ld + st * 64 + sk8 + 4) = hi;
      bf8_to_f(g1, lo, hi); *(float4*)(Lr + st * 64 + sk8) = lo; *(float4*)(Lr + st * 64 + sk8 + 4) = hi;
      bf8_to_f(g2, lo, hi); *(float4*)(Lk + st * 64 + sk8) = lo; *(float4*)(Lk + st * 64 + sk8 + 4) = hi;
      bf8_to_f(g3, lo, hi); *(float4*)(Lkk + st * 64 + sk8) = lo; *(float4*)(Lkk + st * 64 + sk8 + 4) = hi;
      bf8_to_f(g4, lo, hi); *(float4*)(Lb + st * 64 + sk8) = lo; *(float4*)(Lb + st * 64 + sk8 + 4) = hi;
      if (tid < 64) { bf8_to_f(gv, lo, hi); *(float4*)(Lv + vt * 16 + vr8) = lo; *(float4*)(Lv + vt * 16 + vr8 + 4) = hi; }
    }
    __syncthreads();
    if (c0 + TC < T) RW_GLOAD(c0 + TC);
    u16* yo = p.proj + (size_t)(nbase + c0) * PCOLS + h * 64 + v;
    float4 kk0, d0, b0, k0_, r0, kk1, d1, b1, k1_, r1, kk2, d2, b2, k2_, r2, kk3, d3, b3, k3_, r3;
    float v0, v1, v2, v3;
#define RW_LD(KK, DD, BB, KX, RR, VV, t_)                                                        \
  {                                                                                              \
    KK = *(const float4*)(Lkk + (t_) * 64 + ks * 4); DD = *(const float4*)(Ld + (t_) * 64 + ks * 4); \
    BB = *(const float4*)(Lb + (t_) * 64 + ks * 4); KX = *(const float4*)(Lk + (t_) * 64 + ks * 4);  \
    RR = *(const float4*)(Lr + (t_) * 64 + ks * 4); VV = Lv[(t_) * 16 + rl];                      \
  }
#define RW_STEP(KK, DD, BB, KX, RR, VV, YY)                                                      \
  {                                                                                              \
    const float vk0 = VV * KX.x, vk1 = VV * KX.y, vk2 = VV * KX.z, vk3 = VV * KX.w;              \
    float sk = (S0 * KK.x + S1 * KK.y) + (S2 * KK.z + S3 * KK.w);                                \
    sk = allreduce16(sk);                                                                        \
    S0 = S0 * DD.x + (vk0 - sk * BB.x);                                                          \
    S1 = S1 * DD.y + (vk1 - sk * BB.y);                                                          \
    S2 = S2 * DD.z + (vk2 - sk * BB.z);                                                          \
    S3 = S3 * DD.w + (vk3 - sk * BB.w);                                                          \
    YY = allreduce16((S0 * RR.x + S1 * RR.y) + (S2 * RR.z + S3 * RR.w));                         \
  }
    for (int tt = 0; tt < tc; tt += 4) {
      RW_LD(kk0, d0, b0, k0_, r0, v0, tt)
      RW_LD(kk1, d1, b1, k1_, r1, v1, tt + 1)
      RW_LD(kk2, d2, b2, k2_, r2, v2, tt + 2)
      RW_LD(kk3, d3, b3, k3_, r3, v3, tt + 3)
      float y0, y1, y2, y3;
      RW_STEP(kk0, d0, b0, k0_, r0, v0, y0)
      RW_STEP(kk1, d1, b1, k1_, r1, v1, y1)
      RW_STEP(kk2, d2, b2, k2_, r2, v2, y2)
      RW_STEP(kk3, d3, b3, k3_, r3, v3, y3)
      if (ks == 0) {
        u16* yp = yo + (size_t)tt * PCOLS;
        yp[0] = f2bf(y0); yp[PCOLS] = f2bf(y1); yp[2 * (size_t)PCOLS] = f2bf(y2); yp[3 * (size_t)PCOLS] = f2bf(y3);
      }
    }
  }
  float* so = seq_out(p.out, seq, O_PWKV, O_SWKV, 8 * 4096);
  *(float4*)(so + ((size_t)h * 64 + v) * 64 + ks * 4) = make_float4(S0, S1, S2, S3);
}

__device__ void ssm_scan_item(const P& p, int seq, int head, int half, char* smem) {
  const int T = seq < 8 ? 2048 : 8, nbase = seq < 8 ? seq * 2048 : NP + (seq - 8) * 8;
  float* LB = (float*)smem;
  float* LC = LB + TC * 128;
  float* Lx = LC + TC * 128;
  float* Ldt = Lx + TC * 32;
  float* Ldec = Ldt + TC;
  const int tid = TIDX, pl = tid >> 3, ns = tid & 7;
  const int pp = half * 32 + pl, g = head >> 3;
  const float Dk = p.D_skip[head];
  float hs[16];
#pragma unroll
  for (int j = 0; j < 16; j++) hs[j] = 0.f;
  if (seq >= 8) {
    const float4* s4 = (const float4*)(p.state_ssm + (((size_t)(seq - 8) * 16 + head) * 64 + pp) * 128 + ns * 16);
#pragma unroll
    for (int j = 0; j < 4; j++) { float4 s = s4[j]; hs[4 * j] = s.x; hs[4 * j + 1] = s.y; hs[4 * j + 2] = s.z; hs[4 * j + 3] = s.w; }
  }
  uint4 gb0, gb1, gb2, gb3, gx; float gdt = 0.f, gdec = 0.f;
  gb0 = gb1 = gb2 = gb3 = gx = make_uint4(0, 0, 0, 0);
  const int bt = tid >> 5, bch = tid & 31;
  const u16* bsrc = p.xc + 1024 + (bch < 16 ? 0 : 256) + g * 128 + (bch & 15) * 8;
  const int xt = tid >> 2, xr8 = (tid & 3) * 8;
#define SS_GLOAD(c0_)                                                                          \
  {                                                                                            \
    const int tcn = min(TC, T - (c0_));                                                        \
    const size_t nb_ = (size_t)(nbase + (c0_));                                                \
    if (bt < tcn) gb0 = *(const uint4*)(bsrc + (nb_ + bt) * 1536);                             \
    if (bt + 8 < tcn) gb1 = *(const uint4*)(bsrc + (nb_ + bt + 8) * 1536);                     \
    if (bt + 16 < tcn) gb2 = *(const uint4*)(bsrc + (nb_ + bt + 16) * 1536);                   \
    if (bt + 24 < tcn) gb3 = *(const uint4*)(bsrc + (nb_ + bt + 24) * 1536);                   \
    if (tid < 128 && xt < tcn) gx = *(const uint4*)(p.xc + (nb_ + xt) * 1536 + head * 64 + half * 32 + xr8); \
    if (tid < tcn) { gdt = p.dtb[(nb_ + tid) * 16 + head]; gdec = p.decb[(nb_ + tid) * 16 + head]; } \
  }
  SS_GLOAD(0);
  for (int c0 = 0; c0 < T; c0 += TC) {
    const int tc = min(TC, T - c0);
    __syncthreads();
    {
      float* dstb = (bch < 16 ? LB : LC) + (bch & 15) * 8;
      float4 lo, hi;
      bf8_to_f(gb0, lo, hi); *(float4*)(dstb + bt * 128) = lo; *(float4*)(dstb + bt * 128 + 4) = hi;
      bf8_to_f(gb1, lo, hi); *(float4*)(dstb + (bt + 8) * 128) = lo; *(float4*)(dstb + (bt + 8) * 128 + 4) = hi;
      bf8_to_f(gb2, lo, hi); *(float4*)(dstb + (bt + 16) * 128) = lo; *(float4*)(dstb + (bt + 16) * 128 + 4) = hi;
      bf8_to_f(gb3, lo, hi); *(float4*)(dstb + (bt + 24) * 128) = lo; *(float4*)(dstb + (bt + 24) * 128 + 4) = hi;
      if (tid < 128) { bf8_to_f(gx, lo, hi); *(float4*)(Lx + xt * 32 + xr8) = lo; *(float4*)(Lx + xt * 32 + xr8 + 4) = hi; }
      if (tid < TC) { Ldt[tid] = gdt; Ldec[tid] = __expf(gdec); }
    }
    __syncthreads();
    if (c0 + TC < T) SS_GLOAD(c0 + TC);
    u16* yo = p.proj + (size_t)(nbase + c0) * PCOLS + C_XBC + head * 64 + pp;
    float4 B0 = *(const float4*)(LB + ns * 16), B1 = *(const float4*)(LB + ns * 16 + 4), B2 = *(const float4*)(LB + ns * 16 + 8),
           B3 = *(const float4*)(LB + ns * 16 + 12);
    float4 C0 = *(const float4*)(LC + ns * 16), C1 = *(const float4*)(LC + ns * 16 + 4), C2 = *(const float4*)(LC + ns * 16 + 8),
           C3 = *(const float4*)(LC + ns * 16 + 12);
    float xv = Lx[pl], dtv = Ldt[0], dec = Ldec[0];
    for (int tt = 0; tt < tc; tt++) {
      const int tn = min(tt + 1, tc - 1);
      const float* nB = LB + tn * 128 + ns * 16;
      const float* nC = LC + tn * 128 + ns * 16;
      const float4 nB0 = *(const float4*)(nB), nB1 = *(const float4*)(nB + 4), nB2 = *(const float4*)(nB + 8), nB3 = *(const float4*)(nB + 12);
      const float4 nC0 = *(const float4*)(nC), nC1 = *(const float4*)(nC + 4), nC2 = *(const float4*)(nC + 8), nC3 = *(const float4*)(nC + 12);
      const float nxv = Lx[tn * 32 + pl], ndt = Ldt[tn], ndec = Ldec[tn];
      const float dtx = dtv * xv;
      hs[0] = hs[0] * dec + dtx * B0.x; hs[1] = hs[1] * dec + dtx * B0.y; hs[2] = hs[2] * dec + dtx * B0.z; hs[3] = hs[3] * dec + dtx * B0.w;
      hs[4] = hs[4] * dec + dtx * B1.x; hs[5] = hs[5] * dec + dtx * B1.y; hs[6] = hs[6] * dec + dtx * B1.z; hs[7] = hs[7] * dec + dtx * B1.w;
      hs[8] = hs[8] * dec + dtx * B2.x; hs[9] = hs[9] * dec + dtx * B2.y; hs[10] = hs[10] * dec + dtx * B2.z; hs[11] = hs[11] * dec + dtx * B2.w;
      hs[12] = hs[12] * dec + dtx * B3.x; hs[13] = hs[13] * dec + dtx * B3.y; hs[14] = hs[14] * dec + dtx * B3.z; hs[15] = hs[15] * dec + dtx * B3.w;
      float y0 = hs[0] * C0.x + hs[1] * C0.y + hs[2] * C0.z + hs[3] * C0.w;
      float y1 = hs[4] * C1.x + hs[5] * C1.y + hs[6] * C1.z + hs[7] * C1.w;
      float y2 = hs[8] * C2.x + hs[9] * C2.y + hs[10] * C2.z + hs[11] * C2.w;
      float y3 = hs[12] * C3.x + hs[13] * C3.y + hs[14] * C3.z + hs[15] * C3.w;
      float yp = allreduce8((y0 + y1) + (y2 + y3));
      if (ns == 0) yo[(size_t)tt * PCOLS] = f2bf(yp + Dk * xv);
      B0 = nB0; B1 = nB1; B2 = nB2; B3 = nB3; C0 = nC0; C1 = nC1; C2 = nC2; C3 = nC3; xv = nxv; dtv = ndt; dec = ndec;
    }
  }
  float* so = seq_out(p.out, seq, O_PSSM, O_SSSM, 16 * 8192);
  float4* o4 = (float4*)(so + ((size_t)head * 64 + pp) * 128 + ns * 16);
#pragma unroll
  for (int j = 0; j < 4; j++) o4[j] = make_float4(hs[4 * j], hs[4 * j + 1], hs[4 * j + 2], hs[4 * j + 3]);
}

__device__ void ssd_prompt_item(const P& p, int seq, int head, char* smem) {
  const int nbase = seq * 2048, g = head >> 3;
  char* sC = smem;
  char* sB = smem + 17408;
  char* sBT = smem + 34816;
  char* sXT = smem + 53248;
  char* sH = smem + 62464;
  float* sS = (float*)(smem + 79872);
  const int tid = TIDX, lane = tid & 63, w = tid >> 6, fr = lane & 15, q = lane >> 4;
  const float Dk = p.D_skip[head];
  f32x4 H[8];
#pragma unroll
  for (int i = 0; i < 8; i++) H[i] = f32x4{0.f, 0.f, 0.f, 0.f};
  __syncthreads();
  for (int i = tid; i < 17408 / 16; i += 256) *(uint4*)(sH + i * 16) = make_uint4(0, 0, 0, 0);
  uint4 gB0, gB1, gB2, gB3, gC0, gC1, gC2, gC3, gX0, gX1;
  float gdt, gdA;
#define SSD_LOAD(t0_)                                                                         \
  {                                                                                           \
    const size_t nn_ = (size_t)(nbase + (t0_) + lane);                                        \
    const u16* row_ = p.xc + nn_ * 1536;                                                      \
    const u16* rb_ = row_ + 1024 + g * 128 + w * 32;                                          \
    gB0 = *(const uint4*)(rb_); gB1 = *(const uint4*)(rb_ + 8); gB2 = *(const uint4*)(rb_ + 16); gB3 = *(const uint4*)(rb_ + 24); \
    gC0 = *(const uint4*)(rb_ + 256); gC1 = *(const uint4*)(rb_ + 264); gC2 = *(const uint4*)(rb_ + 272); gC3 = *(const uint4*)(rb_ + 280); \
    gX0 = *(const uint4*)(row_ + head * 64 + w * 16); gX1 = *(const uint4*)(row_ + head * 64 + w * 16 + 8); \
    gdt = p.dtb[nn_ * 16 + head]; gdA = p.decb[nn_ * 16 + head];                              \
  }
#define SSD_PUT_T(dst_, r0_, u_, sc_)                                                         \
  {                                                                                           \
    const unsigned us_[4] = {u_.x, u_.y, u_.z, u_.w};                                         \
    _Pragma("unroll") for (int e = 0; e < 4; e++) {                                           \
      *(u16*)(dst_ + ((r0_) + 2 * e) * 144 + lane * 2) = f2bf(bflo(us_[e]) * (sc_));          \
      *(u16*)(dst_ + ((r0_) + 2 * e + 1) * 144 + lane * 2) = f2bf(bfhi(us_[e]) * (sc_));      \
    }                                                                                         \
  }
  SSD_LOAD(0);
#pragma unroll 1
  for (int c = 0; c < 32; c++) {
    const int t0 = c * 64;
    float cs = gdA;
#pragma unroll
    for (int o = 1; o < 64; o <<= 1) { const float v = __shfl_up(cs, o, 64); if (lane >= o) cs += v; }
    const float cs63 = __shfl(cs, 63, 64);
    const float wt = gdt * __expf(cs63 - cs);
    __syncthreads();
    if (w == 0) { sS[lane] = cs; sS[64 + lane] = __expf(cs); sS[128 + lane] = gdt; }
    {
      char* rc = sC + lane * 272 + w * 64;
      char* rb = sB + lane * 272 + w * 64;
      *(uint4*)(rc) = gC0; *(uint4*)(rc + 16) = gC1; *(uint4*)(rc + 32) = gC2; *(uint4*)(rc + 48) = gC3;
      *(uint4*)(rb) = gB0; *(uint4*)(rb + 16) = gB1; *(uint4*)(rb + 32) = gB2; *(uint4*)(rb + 48) = gB3;
      SSD_PUT_T(sBT, w * 32, gB0, wt) SSD_PUT_T(sBT, w * 32 + 8, gB1, wt) SSD_PUT_T(sBT, w * 32 + 16, gB2, wt)
      SSD_PUT_T(sBT, w * 32 + 24, gB3, wt) SSD_PUT_T(sXT, w * 16, gX0, 1.f) SSD_PUT_T(sXT, w * 16 + 8, gX1, 1.f)
    }
    __syncthreads();
    if (c + 1 < 32) SSD_LOAD(t0 + 64);
    f32x4 cb[4], yo[4];
#pragma unroll
    for (int i = 0; i < 4; i++) { cb[i] = f32x4{0.f, 0.f, 0.f, 0.f}; yo[i] = f32x4{0.f, 0.f, 0.f, 0.f}; }
    {
      bf16x8 af[4];
#pragma unroll
      for (int ks = 0; ks < 4; ks++) af[ks] = *(const bf16x8*)(sC + (16 * w + fr) * 272 + ks * 64 + q * 16);
#pragma unroll
      for (int nn = 0; nn < 4; nn++)
#pragma unroll
        for (int ks = 0; ks < 4; ks++) {
          const bf16x8 bb = *(const bf16x8*)(sB + (16 * nn + fr) * 272 + ks * 64 + q * 16);
          cb[nn] = __builtin_amdgcn_mfma_f32_16x16x32_bf16(af[ks], bb, cb[nn], 0, 0, 0);
        }
#pragma unroll
      for (int pt = 0; pt < 4; pt++)
#pragma unroll
        for (int ks = 0; ks < 4; ks++) {
          const bf16x8 bb = *(const bf16x8*)(sH + (16 * pt + fr) * 272 + ks * 64 + q * 16);
          yo[pt] = __builtin_amdgcn_mfma_f32_16x16x32_bf16(af[ks], bb, yo[pt], 0, 0, 0);
        }
    }
    __syncthreads();
#pragma unroll
    for (int j = 0; j < 4; j++) {
      const int l = 16 * w + q * 4 + j;
      const float csl = sS[l];
#pragma unroll
      for (int nn = 0; nn < 4; nn++) {
        const int sidx = 16 * nn + fr;
        const float gv = (sidx <= l) ? cb[nn][j] * __expf(csl - sS[sidx]) * sS[128 + sidx] : 0.f;
        *(u16*)(sB + l * 144 + sidx * 2) = f2bf(gv);
      }
    }
    f32x4 yd[4];
#pragma unroll
    for (int i = 0; i < 4; i++) yd[i] = f32x4{0.f, 0.f, 0.f, 0.f};
#pragma unroll
    for (int ks = 0; ks < 2; ks++) {
      const bf16x8 aa = *(const bf16x8*)(sB + (16 * w + fr) * 144 + ks * 64 + q * 16);
#pragma unroll
      for (int pt = 0; pt < 4; pt++) {
        const bf16x8 bb = *(const bf16x8*)(sXT + (16 * pt + fr) * 144 + ks * 64 + q * 16);
        yd[pt] = __builtin_amdgcn_mfma_f32_16x16x32_bf16(aa, bb, yd[pt], 0, 0, 0);
      }
    }
#pragma unroll
    for (int j = 0; j < 4; j++) {
      const int l = 16 * w + q * 4 + j;
      const float el = sS[64 + l];
      u16* yrow = p.proj + (size_t)(nbase + t0 + l) * PCOLS + C_XBC + head * 64 + fr;
#pragma unroll
      for (int pt = 0; pt < 4; pt++) {
        const float xs = bf2f(*(const u16*)(sXT + (16 * pt + fr) * 144 + l * 2));
        yrow[16 * pt] = f2bf(yd[pt][j] + el * yo[pt][j] + Dk * xs);
      }
    }
    const float ach = __expf(cs63);
#pragma unroll
    for (int nt = 0; nt < 8; nt++) { H[nt][0] *= ach; H[nt][1] *= ach; H[nt][2] *= ach; H[nt][3] *= ach; }
#pragma unroll
    for (int ks = 0; ks < 2; ks++) {
      const bf16x8 aa = *(const bf16x8*)(sXT + (16 * w + fr) * 144 + ks * 64 + q * 16);
#pragma unroll
      for (int nt = 0; nt < 8; nt++) {
        const bf16x8 bb = *(const bf16x8*)(sBT + (16 * nt + fr) * 144 + ks * 64 + q * 16);
        H[nt] = __builtin_amdgcn_mfma_f32_16x16x32_bf16(aa, bb, H[nt], 0, 0, 0);
      }
    }
#pragma unroll
    for (int nt = 0; nt < 8; nt++)
#pragma unroll
      for (int j = 0; j < 4; j++) *(u16*)(sH + (16 * w + q * 4 + j) * 272 + (16 * nt + fr) * 2) = f2bf(H[nt][j]);
  }
  float* so = p.out + O_PSSM + ((size_t)seq * 16 + head) * 8192;
#pragma unroll
  for (int nt = 0; nt < 8; nt++)
#pragma unroll
    for (int j = 0; j < 4; j++) so[(16 * w + q * 4 + j) * 128 + 16 * nt + fr] = H[nt][j];
  __syncthreads();
}

constexpr int P4_RP = 256, P4_SP = 128, P4_RS = 4096, P4_SS = 4096;
#define XB_QUEUE 3600
__device__ void phase4(const P& p, int bid, int nb, char* smem) {
  for (int it = bid; it < P4_RP + P4_SP; it += nb) {
    if (it < P4_RP) rwkv_scan_item(p, it >> 5, (it >> 2) & 7, it & 3, smem);
    else { const int i = it - P4_RP; ssd_prompt_item(p, i >> 4, i & 15, smem); }
  }
  volatile int* slot = (volatile int*)(smem + LDS_BYTES - 32);
  for (;;) {
    __syncthreads();
    if (TIDX == 0) *slot = (int)atomicAdd(&p.bar[XB_QUEUE], 1u);
    __syncthreads();
    int i = *slot;
    if (i >= P4_RS + P4_SS) break;
    if (i < P4_RS) rwkv_scan_item(p, 8 + (i >> 5), (i >> 2) & 7, i & 3, smem);
    else { i -= P4_RS; ssm_scan_item(p, 8 + (i >> 5), (i >> 1) & 15, i & 1, smem); }
  }
}

__device__ void phase5(const P& p, int bid, int nb) {
  const int lane = TIDX & 63, wid = TIDX >> 6;
  for (int it = bid; it < NT / 4; it += nb) {
    const int n = it * 4 + wid;
    const uint4 sy0 = *(const uint4*)(p.proj + (size_t)n * PCOLS + C_XBC + lane * 16);
    const uint4 sy1 = *(const uint4*)(p.proj + (size_t)n * PCOLS + C_XBC + lane * 16 + 8);
    const uint4 sz0 = *(const uint4*)(p.proj + (size_t)n * PCOLS + C_Z + lane * 16);
    const uint4 sz1 = *(const uint4*)(p.proj + (size_t)n * PCOLS + C_Z + lane * 16 + 8);
    {
      const int c = lane * 8;
      uint4 yu = *(const uint4*)(p.proj + (size_t)n * PCOLS + c);
      const u16* pr = p.prep + (size_t)n * 3584 + c;
      uint4 ru = *(const uint4*)(pr + 512), ku = *(const uint4*)(pr + 1024), vu = *(const uint4*)(pr + 2560),
            gu = *(const uint4*)(pr + 3072);
      unsigned ys[4] = {yu.x, yu.y, yu.z, yu.w}, rs[4] = {ru.x, ru.y, ru.z, ru.w}, ks_[4] = {ku.x, ku.y, ku.z, ku.w},
               vs[4] = {vu.x, vu.y, vu.z, vu.w}, gs[4] = {gu.x, gu.y, gu.z, gu.w};
      float y[8], r[8], k[8], v[8], g[8];
#pragma unroll
      for (int e = 0; e < 4; e++) {
        y[2 * e] = bflo(ys[e]); y[2 * e + 1] = bfhi(ys[e]);
        r[2 * e] = bflo(rs[e]); r[2 * e + 1] = bfhi(rs[e]);
        k[2 * e] = bflo(ks_[e]); k[2 * e + 1] = bfhi(ks_[e]);
        v[2 * e] = bflo(vs[e]); v[2 * e + 1] = bfhi(vs[e]);
        g[2 * e] = bflo(gs[e]); g[2 * e + 1] = bfhi(gs[e]);
      }
      float s = 0.f, bn = 0.f;
#pragma unroll
      for (int e = 0; e < 8; e++) { s += y[e]; bn += r[e] * k[e] * p.rw_r_k[c + e]; }
      s = allreduce8(s); bn = allreduce8(bn);
      const float mean = s * (1.f / 64.f);
      float vr = 0.f;
#pragma unroll
      for (int e = 0; e < 8; e++) { const float d = y[e] - mean; vr += d * d; }
      vr = allreduce8(vr) * (1.f / 64.f);
      const float rs_ = rsqrtf(vr + 64e-5f);
      float o[8];
#pragma unroll
      for (int e = 0; e < 8; e++) {
        const float yn = (y[e] - mean) * rs_ * p.rw_ln_w[c + e] + p.rw_ln_b[c + e];
        o[e] = (yn + bn * v[e]) * g[e];
      }
      uint4 ou; ou.x = pack2(o[0], o[1]); ou.y = pack2(o[2], o[3]); ou.z = pack2(o[4], o[5]); ou.w = pack2(o[6], o[7]);
      *(uint4*)(p.oa + (size_t)n * 512 + c) = ou;
    }
    {
      const int c = lane * 16;
      float yv[16];
      float ss = 0.f;
#pragma unroll
      for (int hh = 0; hh < 2; hh++) {
        const uint4 yu = hh ? sy1 : sy0;
        const uint4 zu = hh ? sz1 : sz0;
        unsigned ys[4] = {yu.x, yu.y, yu.z, yu.w}, zs[4] = {zu.x, zu.y, zu.z, zu.w};
#pragma unroll
        for (int e = 0; e < 4; e++) {
          const float a = bflo(ys[e]) * siluf_(bflo(zs[e])), b = bfhi(ys[e]) * siluf_(bfhi(zs[e]));
          yv[hh * 8 + 2 * e] = a; yv[hh * 8 + 2 * e + 1] = b;
          ss += a * a + b * b;
        }
      }
#pragma unroll
      for (int o = 16; o >= 1; o >>= 1) ss += __shfl_xor(ss, o, 64);
      const float rstd = rsqrtf(ss * (1.f / 512.f) + 1e-6f);
      unsigned ou[8];
#pragma unroll
      for (int e = 0; e < 8; e++)
        ou[e] = pack2(yv[2 * e] * rstd * p.ssm_norm_w[c + 2 * e], yv[2 * e + 1] * rstd * p.ssm_norm_w[c + 2 * e + 1]);
      *(uint4*)(p.ob + (size_t)n * 1024 + c) = make_uint4(ou[0], ou[1], ou[2], ou[3]);
      *(uint4*)(p.ob + (size_t)n * 1024 + c + 8) = make_uint4(ou[4], ou[5], ou[6], ou[7]);
    }
  }
}

__device__ void phase6(const P& p, int bid, int nb, char* smem) {
  TileIter ti(bid, nb, 136, 8);
  int mt, nt;
  while (ti.next(mt, nt)) {
    f32x4 ac[4][4];
    u16* Lm = (u16*)(smem + 2 * 128 * LROW);
    zero_acc(ac);
    gemm_tile(p.xn, D, mt * 128, p.w_inT + (size_t)G_A * D, D, nt * 128, D, ac, smem);
    ACC_FOREACH({ Lm[row * 136 + col] = f2bf(sigmoidf_(ac[m][n][j])); })
    zero_acc(ac);
    gemm_tile(p.oa, 512, mt * 128, p.w_paT, 512, nt * 128, 512, ac, smem);
    ACC_FOREACH({ Lm[row * 136 + col] = f2bf(bf2f(Lm[row * 136 + col]) * ac[m][n][j]); })
    zero_acc(ac);
    gemm_tile(p.xn, D, mt * 128, p.w_inT + (size_t)G_B * D, D, nt * 128, D, ac, smem);
    ACC_FOREACH({ p.merged[(size_t)(mt * 128 + row) * D + nt * 128 + col] = f2bf(sigmoidf_(ac[m][n][j])); })
    zero_acc(ac);
    gemm_tile(p.ob, D, mt * 128, p.w_pbT, D, nt * 128, D, ac, smem);
    ACC_FOREACH({
      u16* mp = p.merged + (size_t)(mt * 128 + row) * D + nt * 128 + col;
      *mp = f2bf(bf2f(Lm[row * 136 + col]) + bf2f(*mp) * ac[m][n][j]);
    })
  }
}

constexpr int P7_G = 136 * 8, P7_CV = 16384;
constexpr float U_SCALE = 256.f, V_SCALE = 32.f;
__device__ void phase7(const P& p, int bid, int nb, char* smem) {
  {
    TileIter ti(bid, nb, 136, 8);
    int mt, nt;
    while (ti.next(mt, nt)) {
      f32x4 acc[4][4];
      zero_acc(acc);
      gemm_tile(p.merged, D, mt * 128, p.w_outT, D, nt * 128, D, acc, smem);
      ACC_FOREACH({
        const int nn = mt * 128 + row, c = nt * 128 + col;
        int seq, t, T; tok2seq(nn, seq, t, T);
        const float gt = p.mod[(size_t)seq * 8192 + 2048 + c];
        p.out[O_Y + (size_t)nn * D + c] = xrow(p, nn)[c] + gt * acc[m][n][j];
      })
    }
  }
  for (int it0 = bid; it0 < P7_CV; it0 += 4 * nb) {
    const int tid = TIDX;
    float4 va[4], vb[4];
#pragma unroll
    for (int r = 0; r < 4; r++) {
      const int it = it0 + r * nb;
      if (it < P7_CV) {
        const float* src = it < 8192 ? p.peer_u + (size_t)it * 2048 : p.peer_v + (size_t)(it - 8192) * 2048;
        const float4* s4 = (const float4*)src + tid * 2;
        va[r] = s4[0]; vb[r] = s4[1];
      }
    }
#pragma unroll
    for (int r = 0; r < 4; r++) {
      const int it = it0 + r * nb;
      if (it < P7_CV) {
        unsigned char* dst = it < 8192 ? (unsigned char*)p.ub + (size_t)it * 2048 : (unsigned char*)p.vb + (size_t)(it - 8192) * 2048;
        const float sc = it < 8192 ? U_SCALE : V_SCALE;
        const float4 a = va[r], b = vb[r];
        int lo = __builtin_amdgcn_cvt_pk_fp8_f32(a.x * sc, a.y * sc, 0, false);
        lo = __builtin_amdgcn_cvt_pk_fp8_f32(a.z * sc, a.w * sc, lo, true);
        int hi = __builtin_amdgcn_cvt_pk_fp8_f32(b.x * sc, b.y * sc, 0, false);
        hi = __builtin_amdgcn_cvt_pk_fp8_f32(b.z * sc, b.w * sc, hi, true);
        *((uint2*)dst + tid) = make_uint2((unsigned)lo, (unsigned)hi);
      }
    }
  }
}

__device__ void phase9(const P& p, int bid, int nb, char* smem) {
  const int tid = TIDX, lane = tid & 63, wid = tid >> 6, wr = wid >> 1, wc = wid & 1, fr = lane & 15,
            fq = lane >> 4;
  TileIter ti(bid, nb, 136, 16);
  int mt, nt;
  while (ti.next(mt, nt)) {
    f32x4 acc[4][4];
    zero_acc(acc);
    gemm_tile<false>(p.xn, D, mt * 128, p.wqT, D, nt * 128, D, acc, smem);
    u16* Lq = (u16*)smem;
    ACC_FOREACH({ Lq[row * 136 + col] = f2bf(acc[m][n][j]); })
    __syncthreads();
    f32x4 sc[4][4];
    zero_acc(sc);
    const u16* kb = p.keysb + (size_t)nt * 128 * 128;
#pragma unroll 1
    for (int s = 0; s < 4; s++) {
      bf16x8 af[4], bfr[4];
#pragma unroll
      for (int m = 0; m < 4; m++) af[m] = *(const bf16x8*)((const char*)Lq + (wr * 64 + m * 16 + fr) * 272 + s * 64 + fq * 16);
#pragma unroll
      for (int n = 0; n < 4; n++) bfr[n] = *(const bf16x8*)(kb + (size_t)(wc * 64 + n * 16 + fr) * 128 + s * 32 + fq * 8);
#pragma unroll
      for (int m = 0; m < 4; m++)
#pragma unroll
        for (int n = 0; n < 4; n++) sc[m][n] = __builtin_amdgcn_mfma_f32_16x16x32_bf16(af[m], bfr[n], sc[m][n], 0, 0, 0);
    }
    __syncthreads();
    float* Ls = (float*)smem;
#pragma unroll
    for (int m = 0; m < 4; m++)
#pragma unroll
      for (int n = 0; n < 4; n++)
#pragma unroll
        for (int j = 0; j < 4; j++) Ls[(wr * 64 + m * 16 + fq * 4 + j) * 129 + wc * 64 + n * 16 + fr] = sc[m][n][j];
    __syncthreads();
    {
      const int row = tid >> 1, half = tid & 1;
      float* Lr = Ls + row * 129;
      const size_t ob = ((size_t)(mt * 128 + row) * 16 + nt) * 16;
      for (int r = 0; r < 16; r++) {
        float best = -INFINITY; int bi = 0;
        for (int i = 0; i < 64; i++) {
          const float v = Lr[half + 2 * i];
          if (v > best) { best = v; bi = half + 2 * i; }
        }
        const float ov = __shfl_xor(best, 1, 64);
        const int oi = __shfl_xor(bi, 1, 64);
        if (ov > best || (ov == best && oi < bi)) { best = ov; bi = oi; }
        if ((bi & 1) == half) Lr[bi] = -INFINITY;
        if (half == 0) { p.topv[ob + r] = best; p.topi[ob + r] = bi; }
      }
    }
    __syncthreads();
  }
}

__device__ __forceinline__ void cand_ij(int lane, int& ci, int& cj) {
  int i = 0, rem = lane;
#pragma unroll
  for (int r = 0; r < 16; r++) {
    const int cnt = 16 / (r + 1);
    if (i == r && rem >= cnt) { rem -= cnt; i = r + 1; }
  }
  ci = i; cj = rem;
}

typedef __attribute__((ext_vector_type(2))) __bf16 bf2_t;
__device__ __forceinline__ float dot2bf(unsigned a, unsigned b, float c) {
  return __builtin_amdgcn_fdot2_f32_bf16(__builtin_bit_cast(bf2_t, a), __builtin_bit_cast(bf2_t, b), c, false);
}
template <int CTRL, int RM>
__device__ __forceinline__ float dppf_m(float x) {
  return __int_as_float(__builtin_amdgcn_update_dpp(0, __float_as_int(x), CTRL, RM, 0xf, false));
}
__device__ __forceinline__ float wave_sum_l63(float x) {
  x += dppf<0xB1>(x);
  x += dppf<0x4E>(x);
  x += dppf<0x141>(x);
  x += dppf<0x140>(x);
  x += dppf_m<0x142, 0xA>(x);
  x += dppf_m<0x143, 0xC>(x);
  return x;
}
__device__ __forceinline__ float readlane_f(float x, int l) {
  return __int_as_float(__builtin_amdgcn_readlane(__float_as_int(x), l));
}
__device__ __forceinline__ void axpy8(float* acc, float w, uint4 v) {
  acc[0] += w * bflo(v.x); acc[1] += w * bfhi(v.x); acc[2] += w * bflo(v.y); acc[3] += w * bfhi(v.y);
  acc[4] += w * bflo(v.z); acc[5] += w * bfhi(v.z); acc[6] += w * bflo(v.w); acc[7] += w * bfhi(v.w);
}

typedef float f2_t __attribute__((ext_vector_type(2)));
__device__ __forceinline__ void fp8x16_to_f32(const uint4 v, float* o) {
  const unsigned w[4] = {v.x, v.y, v.z, v.w};
#pragma unroll
  for (int i = 0; i < 4; i++) {
    const f2_t lo = __builtin_amdgcn_cvt_pk_f32_fp8((int)w[i], false);
    const f2_t hi = __builtin_amdgcn_cvt_pk_f32_fp8((int)w[i], true);
    o[4 * i] = lo.x; o[4 * i + 1] = lo.y; o[4 * i + 2] = hi.x; o[4 * i + 3] = hi.y;
  }
}

__device__ void phase10(const P& p, int bid, int nb) {
  const int lane = TIDX & 63, wid = TIDX >> 6;
  int ci, cj; cand_ij(lane < 50 ? lane : 0, ci, cj);
  const unsigned char* ub8 = (const unsigned char*)p.ub;
  const unsigned char* vb8 = (const unsigned char*)p.vb;
  for (int it = bid; it < NT / 4; it += nb) {
    const int n = it * 4 + wid;
    int seq, t, T; tok2seq(n, seq, t, T);
    float xv[16];
    {
      const uint4 a = *(const uint4*)(p.xn + (size_t)n * D + lane * 16), b = *(const uint4*)(p.xn + (size_t)n * D + lane * 16 + 8);
      const unsigned as[4] = {a.x, a.y, a.z, a.w}, bs[4] = {b.x, b.y, b.z, b.w};
#pragma unroll
      for (int e = 0; e < 4; e++) { xv[2 * e] = bflo(as[e]); xv[2 * e + 1] = bfhi(as[e]); xv[8 + 2 * e] = bflo(bs[e]); xv[8 + 2 * e + 1] = bfhi(bs[e]); }
    }
    float acc[16];
#pragma unroll
    for (int e = 0; e < 16; e++) acc[e] = 0.f;
#pragma unroll 1
    for (int h = 0; h < 8; h++) {
      const size_t base = ((size_t)n * 16 + h * 2) * 16;
      float cand = -INFINITY; int eid = 0;
      if (lane < 50) {
        cand = p.topv[base + ci] + p.topv[base + 16 + cj];
        eid = p.topi[base + ci] * 128 + p.topi[base + 16 + cj];
      }
      int rank = 0;
#pragma unroll
      for (int m = 0; m < 50; m++) {
        const float cm = readlane_f(cand, m);
        rank += ((cm > cand) || (cm == cand && m < lane)) ? 1 : 0;
      }
      const bool sel = (lane < 50) && (rank < 16);
      unsigned long long mask = __ballot(sel);
      const float mx = readlane_f(cand, __builtin_ctzll(__ballot(sel && rank == 0)));
      const float ex = sel ? __expf(cand - mx) : 0.f;
      const float den = readlane_f(wave_sum_l63(ex), 63);
      const float gate = ex / den;
#pragma unroll 1
      for (int hf = 0; hf < 2; hf++) {
        int ek[8]; float gk[8];
#pragma unroll
        for (int k = 0; k < 8; k++) {
          const int src = __builtin_ctzll(mask);
          mask &= mask - 1;
          ek[k] = __builtin_amdgcn_readlane(eid, src);
          gk[k] = readlane_f(gate, src);
        }
        uint4 uu[8], vv[8];
#pragma unroll
        for (int j = 0; j < 8; j++) uu[j] = *(const uint4*)(ub8 + (size_t)ek[j] * D + lane * 16);
#pragma unroll
        for (int j = 0; j < 8; j++) vv[j] = *(const uint4*)(vb8 + (size_t)ek[j] * D + lane * 16);
        float dv = 0.f;
#pragma unroll
        for (int j = 0; j < 8; j++) {
          float uf[16];
          fp8x16_to_f32(uu[j], uf);
          float d0 = 0.f, d1 = 0.f;
#pragma unroll
          for (int e = 0; e < 8; e++) { d0 += uf[2 * e] * xv[2 * e]; d1 += uf[2 * e + 1] * xv[2 * e + 1]; }
          const float ds = readlane_f(wave_sum_l63(d0 + d1), 63);
          dv = (lane == j) ? ds : dv;
        }
        dv *= (1.f / U_SCALE);
        const float act = 0.5f * dv * (1.f + erff(dv * 0.70710678118654752f));
#pragma unroll
        for (int j = 0; j < 8; j++) {
          const float w = readlane_f(act, j) * gk[j] * (1.f / V_SCALE);
          float vf[16];
          fp8x16_to_f32(vv[j], vf);
#pragma unroll
          for (int e = 0; e < 16; e++) acc[e] += w * vf[e];
        }
      }
    }
    float* yr = p.out + O_Y + (size_t)n * D + lane * 16;
    const float* md = p.mod + (size_t)seq * 8192 + lane * 16;
    float x2[16];
    float ss = 0.f;
#pragma unroll
    for (int q4 = 0; q4 < 4; q4++) {
      const float4 a = *(const float4*)(yr + q4 * 4), g = *(const float4*)(md + 5120 + q4 * 4);
      x2[q4 * 4 + 0] = a.x + g.x * acc[q4 * 4 + 0]; x2[q4 * 4 + 1] = a.y + g.y * acc[q4 * 4 + 1];
      x2[q4 * 4 + 2] = a.z + g.z * acc[q4 * 4 + 2]; x2[q4 * 4 + 3] = a.w + g.w * acc[q4 * 4 + 3];
    }
#pragma unroll
    for (int e = 0; e < 16; e++) ss += x2[e] * x2[e];
    ss = readlane_f(wave_sum_l63(ss), 63);
    const float rstd = rsqrtf(ss * (1.f / 1024.f) + 1e-6f);
#pragma unroll
    for (int q4 = 0; q4 < 4; q4++) {
      const float4 fg = *(const float4*)(p.final_g + lane * 16 + q4 * 4), sc = *(const float4*)(md + 7168 + q4 * 4),
                   sh = *(const float4*)(md + 6144 + q4 * 4);
      float4 o;
      o.x = x2[q4 * 4 + 0] * rstd * fg.x * (1.f + sc.x) + sh.x;
      o.y = x2[q4 * 4 + 1] * rstd * fg.y * (1.f + sc.y) + sh.y;
      o.z = x2[q4 * 4 + 2] * rstd * fg.z * (1.f + sc.z) + sh.z;
      o.w = x2[q4 * 4 + 3] * rstd * fg.w * (1.f + sc.w) + sh.w;
      *(float4*)(yr + q4 * 4) = o;
    }
  }
}

#define XB_XCNT(j) (256 + 64 * (j))
#define XB_XSUB(j) (1280 + 64 * (j))
#define XB_XGEN(j) (2304 + 64 * (j))
#define XB_TOP 3328
#define XB_TOPGEN 3392
#define XB_WORDS 4096
__device__ __forceinline__ unsigned xb_ld(unsigned* p) { return __hip_atomic_load(p, __ATOMIC_RELAXED, __HIP_MEMORY_SCOPE_AGENT); }
__device__ __forceinline__ unsigned xb_add(unsigned* p, unsigned v) { return __hip_atomic_fetch_add(p, v, __ATOMIC_RELAXED, __HIP_MEMORY_SCOPE_AGENT); }
__device__ __forceinline__ unsigned xb_xcc_id() { return (unsigned)__builtin_amdgcn_s_getreg((3 << 11) | 20) & 0xFu; }
__device__ __forceinline__ void grid_barrier(unsigned* bar, volatile unsigned* xst) {
  asm volatile("s_waitcnt vmcnt(0)" ::: "memory");
  __syncthreads();
  if (TIDX == 0) {
    __builtin_amdgcn_s_waitcnt(0);
    const unsigned x = xst[0], nloc = xst[1], nx = xst[2];
    const unsigned old = xb_add(&bar[XB_XSUB(x)], 1u);
    const unsigned gen = old / nloc;
    if (old + 1u == (gen + 1u) * nloc) {
      __builtin_amdgcn_fence(__ATOMIC_RELEASE, "agent");
      asm volatile("s_waitcnt vmcnt(0)" ::: "memory");
      const unsigned og = xb_add(&bar[XB_TOP], 1u);
      const unsigned tg = og / nx;
      if (og + 1u == (tg + 1u) * nx) xb_add(&bar[XB_TOPGEN], 1u);
      else while (xb_ld(&bar[XB_TOPGEN]) == tg) __builtin_amdgcn_s_sleep(1);
      __builtin_amdgcn_fence(__ATOMIC_ACQUIRE, "agent");
      xb_add(&bar[XB_XGEN(x)], 1u);
      asm volatile("s_waitcnt vmcnt(0)" ::: "memory");
    } else {
      while (xb_ld(&bar[XB_XGEN(x)]) == gen) __builtin_amdgcn_s_sleep(1);
      __builtin_amdgcn_fence(__ATOMIC_ACQUIRE, "agent");
      asm volatile("s_waitcnt vmcnt(0)" ::: "memory");
    }
  }
  __syncthreads();
}

template <int PH>
__device__ __forceinline__ void run_phase(const P& p, int bid, int nb, char* smem) {
  if constexpr (PH == 0) phase0(p, bid, nb, smem);
  if constexpr (PH == 1) phase_norm<false>(p, bid, nb);
  if constexpr (PH == 2) phase2(p, bid, nb, smem);
  if constexpr (PH == 3) phase3(p, bid, nb, smem);
  if constexpr (PH == 4) phase4(p, bid, nb, smem);
  if constexpr (PH == 5) phase5(p, bid, nb);
  if constexpr (PH == 6) phase6(p, bid, nb, smem);
  if constexpr (PH == 7) phase7(p, bid, nb, smem);
  if constexpr (PH == 8) phase_norm<true>(p, bid, nb);
  if constexpr (PH == 9) phase9(p, bid, nb, smem);
  if constexpr (PH == 10) phase10(p, bid, nb);
  if constexpr (PH == 11) phase3b(p, bid, nb, smem);
}

template <int PH>
__global__ void __launch_bounds__(NTHREADS, 2) k_phase(P p) {
  extern __shared__ __attribute__((aligned(16))) char smem[];
  run_phase<PH>(p, blockIdx.x, gridDim.x, smem);
}

#if MEGA
__global__ void __launch_bounds__(NTHREADS, 2) k_mega(P p) {
  extern __shared__ __attribute__((aligned(16))) char smem[];
  cg::grid_group grid = cg::this_grid();
  const int bid = blockIdx.x, nb = gridDim.x;
#ifndef PROBE_ALL2
#define PROBE_ALL2 0
#endif
#ifndef PROBE_MASK
#define PROBE_MASK 0
#endif
#ifndef PROBE_SYNCS
#define PROBE_SYNCS 0
#endif
  volatile unsigned* xst = (volatile unsigned*)(smem + LDS_BYTES - 16);
  if (TIDX == 0) { const unsigned xcc0 = xb_xcc_id(); xst[0] = xcc0; xb_add(&p.bar[XB_XCNT(xcc0)], 1u); }
#define GSYNC(k)                                                                                 \
  {                                                                                              \
    if ((k) == 0) {                                                                              \
      grid.sync();                                                                               \
      if (TIDX == 0) {                                                                    \
        unsigned cnt = 0;                                                                        \
        for (unsigned j = 0; j < 16; ++j) cnt += xb_ld(&p.bar[XB_XCNT(j)]) > 0u ? 1u : 0u;       \
        xst[2] = cnt; xst[1] = xb_ld(&p.bar[XB_XCNT(xst[0])]);                                   \
      }                                                                                          \
    } else grid_barrier(p.bar, xst);                                                             \
  }
#define RUNPH(k)                                                       \
  run_phase<k>(p, bid, nb, smem); GSYNC(k)                             \
  if (PROBE_MASK & (1 << k)) { run_phase<k>(p, bid, nb, smem); GSYNC(1) }
#pragma unroll 1
  for (int rep = 0; rep < 1 + PROBE_ALL2; rep++) {
    RUNPH(0)
#pragma unroll 1
    for (int i = 0; i < PROBE_SYNCS; i++) GSYNC(1)
    RUNPH(1) RUNPH(2) RUNPH(3) RUNPH(11) RUNPH(4) RUNPH(5) RUNPH(6) RUNPH(7) RUNPH(8) RUNPH(9)
  }
  run_phase<10>(p, bid, nb, smem);
}
#endif

template <int PH>
static void launch_phase(const P& p, int grid, hipStream_t stream) {
  static bool attr = false;
  if (!attr) { hipFuncSetAttribute((const void*)k_phase<PH>, hipFuncAttributeMaxDynamicSharedMemorySize, LDS_BYTES); attr = true; }
  hipLaunchKernelGGL(k_phase<PH>, dim3(grid), dim3(NTHREADS), LDS_BYTES, stream, p);
}

extern "C" void kernel_launch(void* const* d_in, const int* in_sizes, int n_in, void* d_out, int out_size, void* d_ws,
                              size_t ws_size, hipStream_t stream) {
  P p{};
  const float** fp = (const float**)&p;
  for (int i = 0; i < 40; i++) fp[i] = (const float*)d_in[i];
  p.out = (float*)d_out;
  char* ws = (char*)d_ws;
  size_t off = 0;
  auto take = [&](size_t bytes) { char* r = ws + off; off += (bytes + 255) & ~(size_t)255; return r; };
  p.bar = (unsigned*)take(XB_WORDS * 4);
  p.w_inT = (u16*)take((size_t)INCOLS * D * 2);
  p.w_paT = (u16*)take((size_t)1024 * 512 * 2);
  p.w_pbT = (u16*)take((size_t)1024 * 1024 * 2);
  p.w_outT = (u16*)take((size_t)1024 * 1024 * 2);
  p.wqT = (u16*)take((size_t)2048 * 1024 * 2);
  p.keysb = (u16*)take((size_t)262144 * 2);
  p.mod = (float*)take((size_t)NSEQ * 8192 * 4);
  p.dtb = (float*)take((size_t)NT * 16 * 4);
  p.decb = (float*)take((size_t)NT * 16 * 4);
  p.xn = (u16*)take((size_t)NROWS * D * 2);
  p.proj = (u16*)take((size_t)NROWS * PCOLS * 2);
  p.prep = (u16*)take((size_t)NT * 3584 * 2);
  p.w2T = (u16*)take(512 * 64 * 2);
  p.a2T = (u16*)take(512 * 64 * 2);
  p.g2T = (u16*)take(512 * 128 * 2);
  p.lora = (u16*)take((size_t)NT * 256 * 2);
  if (off > ws_size) { fprintf(stderr, "workspace too small: need %zu have %zu\n", off, ws_size); return; }
  p.merged = p.prep;
  p.ub = p.proj;
  p.vb = p.proj + (size_t)16384 * 1024;
  p.topv = (float*)(p.proj + (size_t)2 * 16384 * 1024);
  p.topi = (int*)(p.topv + (size_t)NT * 256);
  p.xc = (u16*)d_out;
  p.oa = (u16*)d_out;
  p.ob = (u16*)d_out + (size_t)NT * 512;

  static int grid = 0;
  if (!grid) {
    int dev = 0, cus = 0, per_cu = 0;
    hipGetDevice(&dev);
    hipDeviceGetAttribute(&cus, hipDeviceAttributeMultiprocessorCount, dev);
#if MEGA
    hipFuncSetAttribute((const void*)k_mega, hipFuncAttributeMaxDynamicSharedMemorySize, LDS_BYTES);
    hipOccupancyMaxActiveBlocksPerMultiprocessor(&per_cu, k_mega, NTHREADS, LDS_BYTES);
    if (per_cu > 2) per_cu = 2;
#else
    per_cu = 2;
#endif
    if (per_cu < 1) per_cu = 1;
    grid = cus * per_cu;
  }
  hipMemsetAsync(p.mod, 0, (size_t)NSEQ * 8192 * 4, stream);
#if MEGA
  hipMemsetAsync(p.bar, 0, XB_WORDS * 4, stream);
  void* args[] = {&p};
  hipError_t e = hipLaunchCooperativeKernel((void*)k_mega, dim3(grid), dim3(NTHREADS), args, LDS_BYTES, stream);
  if (e != hipSuccess) fprintf(stderr, "cooperative launch failed: %s (grid %d)\n", hipGetErrorString(e), grid);
#else
  launch_phase<0>(p, grid, stream);
  launch_phase<1>(p, grid, stream);
  launch_phase<2>(p, grid, stream);
  launch_phase<3>(p, grid, stream);
  launch_phase<11>(p, grid, stream);
  launch_phase<4>(p, grid, stream);
  launch_phase<5>(p, grid, stream);
  launch_phase<6>(p, grid, stream);
  launch_phase<7>(p, grid, stream);
  launch_phase<8>(p, grid, stream);
  launch_phase<9>(p, grid, stream);
  launch_phase<10>(p, grid, stream);
#endif
}
```

```cpp
#include <hip/hip_runtime.h>
#include <hip/hip_cooperative_groups.h>
#include <cstdio>
namespace cg = cooperative_groups;

#ifndef MEGA
#define MEGA 1
#endif

typedef unsigned short u16;
typedef __attribute__((ext_vector_type(8))) short bf16x8;
typedef __attribute__((ext_vector_type(4))) float f32x4;

__device__ __forceinline__ int opaque_tid() { int t = threadIdx.x; asm volatile("" : "+v"(t)); return t; }
#define TIDX opaque_tid()

constexpr int D = 1024;
constexpr int NP = 16384, NS = 1024, NT = NP + NS, NSEQ = 136;
constexpr int NROWS = NT + 128;
constexpr int PCOLS = 4368;
constexpr int INCOLS = 6416;
constexpr int C_LW = 1536, C_LA = 1600, C_LG = 1664, C_Z = 1792, C_XBC = 2816, C_DT = 4352;
constexpr int G_A = 4368, G_B = 5392;
constexpr size_t O_Y = 0, O_PSHIFT = 17825792, O_PWKV = 17833984, O_PCONV = 18096128, O_PSSM = 18132992,
                 O_SSHIFT = 19181568, O_SWKV = 19312640, O_SCONV = 23506944, O_SSSM = 24096768;
constexpr int LDS_BYTES = 80 * 1024;
constexpr int NTHREADS = 256;

struct P {
  const float *x_prompt, *x_sample, *c_prompt, *c_sample, *state_shift, *state_wkv, *state_conv, *state_ssm;
  const float *w_ada, *b_ada, *norm1_g, *w_in, *rw_mu, *rw_w0, *rw_w2, *rw_a0, *rw_a2, *rw_g2, *rw_k_k, *rw_k_a,
      *rw_r_k, *rw_ln_w, *rw_ln_b;
  const float *conv_w, *conv_b, *dt_bias, *A_log, *D_skip, *ssm_norm_w, *w_pa, *w_pb, *w_out, *norm2_g, *peer_wq,
      *peer_keys, *peer_u, *peer_v, *final_g, *w_ada_f, *b_ada_f;
  float* out;
  u16 *w_inT, *w_paT, *w_pbT, *w_outT, *wqT, *keysb, *xn, *proj, *prep, *merged, *ub, *vb, *xc, *oa, *ob;
  u16 *w2T, *a2T, *g2T, *lora;
  float *mod, *dtb, *decb, *topv;
  int* topi;
  unsigned* bar;
};

__device__ __forceinline__ u16 f2bf(float f) {
  unsigned u = __float_as_uint(f);
  u += 0x7fffu + ((u >> 16) & 1u);
  return (u16)(u >> 16);
}
__device__ __forceinline__ float bf2f(u16 h) { return __uint_as_float(((unsigned)h) << 16); }
__device__ __forceinline__ unsigned pack2(float a, float b) { return (unsigned)f2bf(a) | ((unsigned)f2bf(b) << 16); }
__device__ __forceinline__ float bflo(unsigned u) { return __uint_as_float(u << 16); }
__device__ __forceinline__ float bfhi(unsigned u) { return __uint_as_float(u & 0xffff0000u); }
__device__ __forceinline__ float sigmoidf_(float x) { return 1.f / (1.f + __expf(-x)); }
__device__ __forceinline__ float siluf_(float x) { return x / (1.f + __expf(-x)); }
__device__ __forceinline__ float softplusf_(float x) { return x > 20.f ? x : log1pf(expf(x)); }

template <int CTRL>
__device__ __forceinline__ float dppf(float x) {
  return __int_as_float(__builtin_amdgcn_update_dpp(0, __float_as_int(x), CTRL, 0xf, 0xf, true));
}
__device__ __forceinline__ float allreduce16(float x) {
  x += dppf<0x128>(x);
  x += dppf<0x124>(x);
  x += dppf<0x122>(x);
  x += dppf<0x121>(x);
  return x;
}
__device__ __forceinline__ float allreduce8(float x) {
  x += dppf<0xB1>(x);
  x += dppf<0x4E>(x);
  x += dppf<0x141>(x);
  return x;
}
__device__ __forceinline__ float wave_sum(float x) {
#pragma unroll
  for (int o = 32; o >= 1; o >>= 1) x += __shfl_xor(x, o, 64);
  return x;
}
__device__ __forceinline__ float wave_max(float x) {
#pragma unroll
  for (int o = 32; o >= 1; o >>= 1) x = fmaxf(x, __shfl_xor(x, o, 64));
  return x;
}
__device__ __forceinline__ int wave_min_i(int x) {
#pragma unroll
  for (int o = 32; o >= 1; o >>= 1) x = min(x, __shfl_xor(x, o, 64));
  return x;
}

__device__ __forceinline__ const float* xrow(const P& p, int n) {
  return n < NP ? p.x_prompt + (size_t)n * D : p.x_sample + (size_t)(n - NP) * D;
}
__device__ __forceinline__ void tok2seq(int n, int& seq, int& t, int& T) {
  if (n < NP) { seq = n >> 11; t = n & 2047; T = 2048; }
  else { int m = n - NP; seq = 8 + (m >> 3); t = m & 7; T = 8; }
}
__device__ __forceinline__ float* seq_out(float* out, int seq, size_t op, size_t os, size_t per) {
  return seq < 8 ? out + op + (size_t)seq * per : out + os + (size_t)(seq - 8) * per;
}

constexpr int LROW = 144;
template <bool DEEP = true>
__device__ __forceinline__ void gemm_tile(const u16* __restrict__ A, int lda, int m0, const u16* __restrict__ Bt,
                                          int ldb, int n0, int K, f32x4 (&acc)[4][4], char* smem) {
  char* sA = smem;
  char* sB = smem + 128 * LROW;
  const int tid = TIDX, lane = tid & 63, wid = tid >> 6, wr = wid >> 1, wc = wid & 1, fr = lane & 15,
            fq = lane >> 4;
  uint4 ra0, ra1, ra2, ra3, rb0, rb1, rb2, rb3;
  uint4 sa0, sa1, sa2, sa3, sb0, sb1, sb2, sb3;
  const int nk = K / 64;
  const int lrow = tid >> 3, lch = tid & 7;
  const u16* gA = A + (size_t)(m0 + lrow) * lda + lch * 8;
  const u16* gB = Bt + (size_t)(n0 + lrow) * ldb + lch * 8;
#define GLOAD(x0, x1, x2, x3, y0, y1, y2, y3, kt)                   \
  {                                                                 \
    x0 = *(const uint4*)(gA + (kt) * 64);                           \
    x1 = *(const uint4*)(gA + (size_t)32 * lda + (kt) * 64);        \
    x2 = *(const uint4*)(gA + (size_t)64 * lda + (kt) * 64);        \
    x3 = *(const uint4*)(gA + (size_t)96 * lda + (kt) * 64);        \
    y0 = *(const uint4*)(gB + (kt) * 64);                           \
    y1 = *(const uint4*)(gB + (size_t)32 * ldb + (kt) * 64);        \
    y2 = *(const uint4*)(gB + (size_t)64 * ldb + (kt) * 64);        \
    y3 = *(const uint4*)(gB + (size_t)96 * ldb + (kt) * 64);        \
  }
#define LSTORE(x0, x1, x2, x3, y0, y1, y2, y3)                      \
  {                                                                 \
    char* wa = sA + lrow * LROW + lch * 16;                         \
    char* wb = sB + lrow * LROW + lch * 16;                         \
    *(uint4*)(wa) = x0; *(uint4*)(wa + 32 * LROW) = x1; *(uint4*)(wa + 64 * LROW) = x2; *(uint4*)(wa + 96 * LROW) = x3; \
    *(uint4*)(wb) = y0; *(uint4*)(wb + 32 * LROW) = y1; *(uint4*)(wb + 64 * LROW) = y2; *(uint4*)(wb + 96 * LROW) = y3; \
  }
#define COMPUTE_TILE()                                                                                                   \
  {                                                                                                                      \
    _Pragma("unroll") for (int s = 0; s < 2; s++) {                                                                      \
      bf16x8 af[4], bfr[4];                                                                                              \
      _Pragma("unroll") for (int m = 0; m < 4; m++) af[m] = *(const bf16x8*)(sA + (wr * 64 + m * 16 + fr) * LROW + s * 64 + fq * 16); \
      _Pragma("unroll") for (int n = 0; n < 4; n++) bfr[n] = *(const bf16x8*)(sB + (wc * 64 + n * 16 + fr) * LROW + s * 64 + fq * 16); \
      _Pragma("unroll") for (int m = 0; m < 4; m++)                                                                      \
        _Pragma("unroll") for (int n = 0; n < 4; n++) acc[m][n] = __builtin_amdgcn_mfma_f32_16x16x32_bf16(af[m], bfr[n], acc[m][n], 0, 0, 0); \
    }                                                                                                                    \
  }
  GLOAD(ra0, ra1, ra2, ra3, rb0, rb1, rb2, rb3, 0);
  if constexpr (DEEP) {
    GLOAD(sa0, sa1, sa2, sa3, sb0, sb1, sb2, sb3, 1);
#pragma unroll 1
    for (int kt = 0; kt < nk; kt += 2) {
      __syncthreads();
      LSTORE(ra0, ra1, ra2, ra3, rb0, rb1, rb2, rb3);
      __syncthreads();
      if (kt + 2 < nk) GLOAD(ra0, ra1, ra2, ra3, rb0, rb1, rb2, rb3, kt + 2);
      COMPUTE_TILE();
      __syncthreads();
      LSTORE(sa0, sa1, sa2, sa3, sb0, sb1, sb2, sb3);
      __syncthreads();
      if (kt + 3 < nk) GLOAD(sa0, sa1, sa2, sa3, sb0, sb1, sb2, sb3, kt + 3);
      COMPUTE_TILE();
    }
  } else {
#pragma unroll 1
    for (int kt = 0; kt < nk; kt++) {
      __syncthreads();
      LSTORE(ra0, ra1, ra2, ra3, rb0, rb1, rb2, rb3);
      __syncthreads();
      if (kt + 1 < nk) GLOAD(ra0, ra1, ra2, ra3, rb0, rb1, rb2, rb3, kt + 1);
      COMPUTE_TILE();
    }
  }
  __syncthreads();
}
#define GL_RAW_BARRIER() { asm volatile("s_waitcnt vmcnt(0)" ::: "memory"); asm volatile("s_waitcnt lgkmcnt(0)" ::: "memory"); __builtin_amdgcn_s_barrier(); }
__device__ __forceinline__ void gemm_tile_glds(const u16* __restrict__ A, int lda, int m0, const u16* __restrict__ Bt,
                                               int ldb, int n0, int K, f32x4 (&acc)[4][4], char* smem) {
  const int tid = TIDX, lane = tid & 63, wid = tid >> 6, wr = wid >> 1, wc = wid & 1, fr = lane & 15, fq = lane >> 4;
  const int nk = K / 64;
  const int srow = tid >> 3, sc = (tid & 7) ^ ((srow >> 1) & 7);
  const u16* gA = A + (size_t)(m0 + srow) * lda + sc * 8;
  const u16* gB = Bt + (size_t)(n0 + srow) * ldb + sc * 8;
  char* const lbase = smem + tid * 16;
  const int swz = (fr >> 1) & 7;
  const int aoff = (wr * 64 + fr) * 128, boff = 16384 + (wc * 64 + fr) * 128;
#define GL_STAGE(buf, kt)                                                                                         \
  {                                                                                                               \
    _Pragma("unroll") for (int i = 0; i < 4; i++) {                                                               \
      __builtin_amdgcn_global_load_lds((const unsigned*)(gA + (size_t)(32 * i) * lda + (kt) * 64),               \
                                       (unsigned*)(lbase + (buf) * 32768 + i * 4096), 16, 0, 0);                  \
      __builtin_amdgcn_global_load_lds((const unsigned*)(gB + (size_t)(32 * i) * ldb + (kt) * 64),               \
                                       (unsigned*)(lbase + (buf) * 32768 + 16384 + i * 4096), 16, 0, 0);          \
    }                                                                                                             \
  }
#define GL_COMPUTE(buf)                                                                                           \
  {                                                                                                               \
    const char* pb = smem + (buf) * 32768;                                                                        \
    _Pragma("unroll") for (int s = 0; s < 2; s++) {                                                               \
      bf16x8 af[4], bfr[4];                                                                                       \
      const int so = ((s * 4 + fq) ^ swz) * 16;                                                                   \
      _Pragma("unroll") for (int m = 0; m < 4; m++) af[m] = *(const bf16x8*)(pb + aoff + m * 2048 + so);          \
      _Pragma("unroll") for (int n = 0; n < 4; n++) bfr[n] = *(const bf16x8*)(pb + boff + n * 2048 + so);         \
      _Pragma("unroll") for (int m = 0; m < 4; m++)                                                               \
        _Pragma("unroll") for (int n = 0; n < 4; n++)                                                             \
          acc[m][n] = __builtin_amdgcn_mfma_f32_16x16x32_bf16(af[m], bfr[n], acc[m][n], 0, 0, 0);                 \
    }                                                                                                             \
  }
  __syncthreads();
  GL_STAGE(0, 0)
  GL_RAW_BARRIER()
#pragma unroll 1
  for (int kt = 0; kt < nk; kt += 2) {
    if (kt + 1 < nk) GL_STAGE(1, kt + 1)
    GL_COMPUTE(0)
    GL_RAW_BARRIER()
    if (kt + 1 < nk) {
      if (kt + 2 < nk) GL_STAGE(0, kt + 2)
      GL_COMPUTE(1)
      GL_RAW_BARRIER()
    }
  }
}
__device__ __forceinline__ void zero_acc(f32x4 (&acc)[4][4]) {
#pragma unroll
  for (int m = 0; m < 4; m++)
#pragma unroll
    for (int n = 0; n < 4; n++) acc[m][n] = f32x4{0.f, 0.f, 0.f, 0.f};
}
#define ACC_FOREACH(...)                                                                    \
  {                                                                                         \
    const int _l = TIDX & 63, _w = TIDX >> 6, _wr = _w >> 1, _wc = _w & 1;    \
    const int _fr = _l & 15, _fq = _l >> 4;                                                 \
    _Pragma("unroll") for (int m = 0; m < 4; m++) _Pragma("unroll") for (int n = 0; n < 4; n++) \
        _Pragma("unroll") for (int j = 0; j < 4; j++) {                                     \
      const int row = _wr * 64 + m * 16 + _fq * 4 + j, col = _wc * 64 + n * 16 + _fr;       \
      __VA_ARGS__                                                                           \
    }                                                                                       \
  }

struct TileIter {
  int x, lb, nbx, tpx, total, MT, NT, r;
  __device__ __forceinline__ TileIter(int bid, int nb, int MT_, int NT_) : MT(MT_), NT(NT_), r(0) {
    total = MT * NT; x = bid & 7; lb = bid >> 3; nbx = nb >> 3; tpx = (total + 7) >> 3;
  }
  __device__ __forceinline__ bool next(int& mt, int& nt) {
    const int idx = lb + r * nbx;
    r++;
    if (idx >= tpx) return false;
    const int lin = x * tpx + idx;
    if (lin >= total) return false;
    const int bsz = 8 * NT, band = lin / bsz, rem = lin - band * bsz;
    const int mb = min(8, MT - band * 8);
    nt = rem / mb; mt = band * 8 + (rem - nt * mb);
    return true;
  }
};

__device__ void transpose_tile(const float* __restrict__ src, int K, int N, u16* __restrict__ dst, int tile,
                               char* smem) {
  const int ntn = (N + 63) / 64, kt = tile / ntn, nt = tile % ntn, tid = TIDX;
  float(*s)[65] = (float(*)[65])smem;
  __syncthreads();
#pragma unroll 4
  for (int i = 0; i < 16; i++) {
    int r = (tid >> 6) + 4 * i, n = nt * 64 + (tid & 63);
    s[r][tid & 63] = (n < N) ? src[(size_t)(kt * 64 + r) * N + n] : 0.f;
  }
  __syncthreads();
#pragma unroll 4
  for (int i = 0; i < 8; i++) {
    int nl = (tid >> 5) + 8 * i, n = nt * 64 + nl, kl = (tid & 31) * 2;
    if (n < N) *(unsigned*)(dst + (size_t)n * K + kt * 64 + kl) = pack2(s[kl][nl], s[kl + 1][nl]);
  }
}

__device__ void mod_item(const P& p, int item2, char* smem) {
  const int item = item2 >> 1, kh2 = item2 & 1;
  const int tid = TIDX, j = tid & 31, g = tid >> 5;
  const int col0 = item * 32;
  const float* W; const float* bias; int N, cw;
  if (col0 < 6144) { W = p.w_ada; bias = p.b_ada; N = 6144; cw = col0; }
  else { W = p.w_ada_f; bias = p.b_ada_f; N = 2048; cw = col0 - 6144; }
  float(*cs)[68] = (float(*)[68])smem;
  float acc[17];
#pragma unroll
  for (int s = 0; s < 17; s++) acc[s] = 0.f;
  for (int k0 = kh2 * 512; k0 < kh2 * 512 + 512; k0 += 64) {
    __syncthreads();
    {
      float cv[34];
#pragma unroll
      for (int i = 0; i < 34; i++) {
        const int idx = tid + i * 256, seq = idx >> 6, kk = idx & 63;
        cv[i] = seq < 8 ? p.c_prompt[seq * 1024 + k0 + kk] : p.c_sample[(seq - 8) * 1024 + k0 + kk];
      }
#pragma unroll
      for (int i = 0; i < 34; i++) {
        const int idx = tid + i * 256;
        cs[idx >> 6][idx & 63] = siluf_(cv[i]);
      }
    }
    __syncthreads();
#pragma unroll 1
    for (int kh = 0; kh < 2; kh++) {
      float wv[32];
#pragma unroll
      for (int k = 0; k < 32; k++) wv[k] = W[(size_t)(k0 + kh * 32 + k) * N + cw + j];
#pragma unroll 2
      for (int k4 = 0; k4 < 8; k4++) {
#pragma unroll
        for (int s = 0; s < 17; s++) {
          float4 c4 = *(const float4*)&cs[g * 17 + s][kh * 32 + k4 * 4];
          acc[s] += wv[k4 * 4] * c4.x + wv[k4 * 4 + 1] * c4.y + wv[k4 * 4 + 2] * c4.z + wv[k4 * 4 + 3] * c4.w;
        }
      }
    }
  }
  const float b = kh2 == 0 ? bias[cw + j] : 0.f;
#pragma unroll
  for (int s = 0; s < 17; s++) atomicAdd(&p.mod[(size_t)(g * 17 + s) * 8192 + col0 + j], acc[s] + b);
}

constexpr int J_MOD = 512, J_WIN = 16 * 101, J_WPA = 8 * 16, J_WPB = 256, J_WOUT = 256, J_WQ = 16 * 32, J_KEYS = 128,
              J_SHIFT = 64;
constexpr int J_LORA = 8 + 8 + 16;
constexpr int PH0_ITEMS = J_MOD + J_WIN + J_WPA + J_WPB + J_WOUT + J_WQ + J_LORA + J_KEYS + J_SHIFT;

__device__ void phase0(const P& p, int bid, int nb, char* smem) {
  for (int it = bid; it < PH0_ITEMS; it += nb) {
    int i = it;
    if (i < J_MOD) { mod_item(p, i, smem); continue; }
    i -= J_MOD;
    if (i < J_WIN) { transpose_tile(p.w_in, 1024, INCOLS, p.w_inT, i, smem); continue; }
    i -= J_WIN;
    if (i < J_WPA) { transpose_tile(p.w_pa, 512, 1024, p.w_paT, i, smem); continue; }
    i -= J_WPA;
    if (i < J_WPB) { transpose_tile(p.w_pb, 1024, 1024, p.w_pbT, i, smem); continue; }
    i -= J_WPB;
    if (i < J_WOUT) { transpose_tile(p.w_out, 1024, 1024, p.w_outT, i, smem); continue; }
    i -= J_WOUT;
    if (i < J_WQ) { transpose_tile(p.peer_wq, 1024, 2048, p.wqT, i, smem); continue; }
    i -= J_WQ;
    if (i < 8) { transpose_tile(p.rw_w2, 64, 512, p.w2T, i, smem); continue; }
    if (i < 16) { transpose_tile(p.rw_a2, 64, 512, p.a2T, i - 8, smem); continue; }
    if (i < 32) { transpose_tile(p.rw_g2, 128, 512, p.g2T, i - 16, smem); continue; }
    i -= J_LORA;
    const float* src; u16* dst;
    if (i < J_KEYS) { src = p.peer_keys + (size_t)i * 2048; dst = p.keysb + (size_t)i * 2048; }
    else { i -= J_KEYS; src = p.state_shift + (size_t)i * 2048; dst = p.xn + (size_t)NT * D + (size_t)i * 2048; }
    const float4* s4 = (const float4*)src + TIDX * 2;
    float4 a = s4[0], b = s4[1];
    uint4 o; o.x = pack2(a.x, a.y); o.y = pack2(a.z, a.w); o.z = pack2(b.x, b.y); o.w = pack2(b.z, b.w);
    *((uint4*)dst + TIDX) = o;
  }
}

template <bool SECOND>
__device__ void phase_norm(const P& p, int bid, int nb) {
  const int lane = TIDX & 63, wid = TIDX >> 6;
  const float* gam = SECOND ? p.norm2_g : p.norm1_g;
  for (int it = bid; it < NT / 8; it += nb) {
    const int nA = it * 8 + wid * 2;
    float4 v[2][4];
#pragma unroll
    for (int k = 0; k < 2; k++) {
      const int n = nA + k;
      const float* xr = SECOND ? p.out + O_Y + (size_t)n * D : xrow(p, n);
#pragma unroll
      for (int i = 0; i < 4; i++) v[k][i] = ((const float4*)xr)[lane + 64 * i];
    }
#pragma unroll
    for (int k = 0; k < 2; k++) {
      const int n = nA + k;
      int seq, t, T; tok2seq(n, seq, t, T);
      const float* md = p.mod + (size_t)seq * 8192 + (SECOND ? 3072 : 0);
      float ss = 0.f;
#pragma unroll
      for (int i = 0; i < 4; i++)
        ss += v[k][i].x * v[k][i].x + v[k][i].y * v[k][i].y + v[k][i].z * v[k][i].z + v[k][i].w * v[k][i].w;
      ss = wave_sum(ss);
      const float rstd = rsqrtf(ss * (1.f / 1024.f) + 1e-6f);
      const bool last = (!SECOND) && (t == T - 1);
      float* so = seq_out(p.out, seq, O_PSHIFT, O_SSHIFT, 1024);
#pragma unroll
      for (int i = 0; i < 4; i++) {
        const int c = (lane + 64 * i) * 4;
        const float4 g = *(const float4*)(gam + c), sh = *(const float4*)(md + c), sc = *(const float4*)(md + 1024 + c);
        float4 o;
        o.x = v[k][i].x * rstd * g.x * (1.f + sc.x) + sh.x;
        o.y = v[k][i].y * rstd * g.y * (1.f + sc.y) + sh.y;
        o.z = v[k][i].z * rstd * g.z * (1.f + sc.z) + sh.z;
        o.w = v[k][i].w * rstd * g.w * (1.f + sc.w) + sh.w;
        uint2 pk; pk.x = pack2(o.x, o.y); pk.y = pack2(o.z, o.w);
        *(uint2*)(p.xn + (size_t)n * D + c) = pk;
        if (last) *(float4*)(so + c) = o;
      }
    }
  }
}

constexpr int P2_NT = 35, P2_MT = 137;
__device__ void phase2(const P& p, int bid, int nb, char* smem) {
  TileIter ti(bid, nb, P2_MT, P2_NT);
  int mt, nt;
  while (ti.next(mt, nt)) {
    f32x4 acc[4][4];
    zero_acc(acc);
    gemm_tile_glds(p.xn, D, mt * 128, p.w_inT, D, nt * 128, D, acc, smem);
    ACC_FOREACH({
      const int gc = nt * 128 + col;
      if (gc < PCOLS) p.proj[(size_t)(mt * 128 + row) * PCOLS + gc] = f2bf(acc[m][n][j]);
    })
  }
}

__device__ void rwkv_lerp_item(const P& p, int item) {
  const int tid = TIDX;
  const int n0 = item * 8;
  int seq, t0, T; tok2seq(n0, seq, t0, T);
  uint4 pcv[7], ppv[7];
#pragma unroll
  for (int i = 0; i < 7; i++) {
    const int idx = tid + i * 256, tok = idx / 224, c = (idx % 224) * 8;
    const int n = n0 + tok, t = t0 + tok;
    pcv[i] = *(const uint4*)(p.proj + (size_t)n * PCOLS + c);
    const size_t prow = t > 0 ? (size_t)(n - 1) : (size_t)(NT + (seq >= 8 ? seq - 8 : 0));
    ppv[i] = *(const uint4*)(p.proj + prow * PCOLS + c);
    if (t == 0 && seq < 8) ppv[i] = make_uint4(0, 0, 0, 0);
  }
#pragma unroll
  for (int i = 0; i < 7; i++) {
    const int idx = tid + i * 256, tok = idx / 224, c = (idx % 224) * 8;
    const int n = n0 + tok;
    const float4 mu0 = *(const float4*)(p.rw_mu + c), mu1 = *(const float4*)(p.rw_mu + c + 4);
    const float mus[8] = {mu0.x, mu0.y, mu0.z, mu0.w, mu1.x, mu1.y, mu1.z, mu1.w};
    const unsigned pcs[4] = {pcv[i].x, pcv[i].y, pcv[i].z, pcv[i].w}, pps[4] = {ppv[i].x, ppv[i].y, ppv[i].z, ppv[i].w};
    unsigned o[4];
#pragma unroll
    for (int e = 0; e < 4; e++) {
      float a0 = bflo(pcs[e]), a1 = bfhi(pcs[e]), b0 = bflo(pps[e]), b1 = bfhi(pps[e]);
      float q0 = a0 + (b0 - a0) * mus[2 * e], q1 = a1 + (b1 - a1) * mus[2 * e + 1];
      if (c >= C_LW && c < C_LA) { q0 = tanhf(q0); q1 = tanhf(q1); }
      else if (c >= C_LG) { q0 = sigmoidf_(q0); q1 = sigmoidf_(q1); }
      o[e] = pack2(q0, q1);
    }
    u16* dst;
    if (c < 512) dst = p.prep + (size_t)n * 3584 + 512 + c;
    else if (c < 1024) dst = p.prep + (size_t)n * 3584 + 1024 + (c - 512);
    else if (c < 1536) dst = p.prep + (size_t)n * 3584 + 2560 + (c - 1024);
    else dst = p.lora + (size_t)n * 256 + (c - 1536);
    *(uint4*)dst = make_uint4(o[0], o[1], o[2], o[3]);
  }
}

__device__ void rwkv_lora_item(const P& p, int mt, int nt, char* smem) {
  const int tid = TIDX, lane = tid & 63, wid = tid >> 6, wr = wid >> 1, wc = wid & 1, fr = lane & 15, fq = lane >> 4;
  const int col0 = nt * 128;
  f32x4 acc[4][4];
  zero_acc(acc);
  gemm_tile_glds(p.lora, 256, mt * 128, p.w2T, 64, col0, 64, acc, smem);
  ACC_FOREACH({
    const int gc = col0 + col;
    const float wpre = p.rw_w0[gc] + acc[m][n][j];
    const float w = -softplusf_(-wpre) - 0.5f;
    p.prep[(size_t)(mt * 128 + row) * 3584 + gc] = f2bf(-expf(w));
  })
  zero_acc(acc);
  gemm_tile_glds(p.lora + 128, 256, mt * 128, p.g2T, 128, col0, 128, acc, smem);
  ACC_FOREACH({ p.prep[(size_t)(mt * 128 + row) * 3584 + 3072 + col0 + col] = f2bf(acc[m][n][j]); })
  zero_acc(acc);
  gemm_tile_glds(p.lora + 64, 256, mt * 128, p.a2T, 64, col0, 64, acc, smem);
  float a0c[4], kkc[4], kac[4];
#pragma unroll
  for (int n = 0; n < 4; n++) {
    const int gc = col0 + wc * 64 + n * 16 + fr;
    a0c[n] = p.rw_a0[gc]; kkc[n] = p.rw_k_k[gc]; kac[n] = p.rw_k_a[gc];
  }
#pragma unroll
  for (int m = 0; m < 4; m++)
#pragma unroll
    for (int j = 0; j < 4; j++) {
      const int row = mt * 128 + wr * 64 + m * 16 + fq * 4 + j;
      u16* pr = p.prep + (size_t)row * 3584 + col0 + wc * 64 + fr;
      float kx[4], kkv[4], av[4];
      float ss = 0.f;
#pragma unroll
      for (int n = 0; n < 4; n++) {
        kx[n] = bf2f(pr[1024 + n * 16]);
        av[n] = sigmoidf_(a0c[n] + acc[m][n][j]);
        kkv[n] = kx[n] * kkc[n];
        ss += kkv[n] * kkv[n];
      }
      ss = allreduce16(ss);
      const float inv = 1.f / fmaxf(sqrtf(ss), 1e-12f);
#pragma unroll
      for (int n = 0; n < 4; n++) {
        const float kk = kkv[n] * inv;
        pr[1024 + n * 16] = f2bf(kx[n] * (1.f + (av[n] - 1.f) * kac[n]));
        pr[1536 + n * 16] = f2bf(kk);
        pr[2048 + n * 16] = f2bf(kk * av[n]);
      }
    }
}

__device__ void conv_prep_item(const P& p, int item) {
  const int tid = TIDX;
  const int n0 = item * 8;
  int seq, t0, T; tok2seq(n0, seq, t0, T);
  if (tid < 192) {
    const int c = tid * 8;
    uint4 rows[11];
#pragma unroll
    for (int j = 0; j < 11; j++) {
      const int tt = t0 - 3 + j;
      rows[j] = make_uint4(0, 0, 0, 0);
      if (tt >= 0) rows[j] = *(const uint4*)(p.proj + (size_t)(n0 - 3 + j) * PCOLS + C_XBC + c);
      else if (seq >= 8) {
        const float* sc = p.state_conv + ((size_t)(seq - 8) * 3 + (tt + 3)) * 1536 + c;
        const float4 a = *(const float4*)sc, b = *(const float4*)(sc + 4);
        rows[j] = make_uint4(pack2(a.x, a.y), pack2(a.z, a.w), pack2(b.x, b.y), pack2(b.z, b.w));
      }
    }
    float w[4][8], cb[8];
#pragma unroll
    for (int j = 0; j < 4; j++) {
      const float4 a = *(const float4*)(p.conv_w + j * 1536 + c), b = *(const float4*)(p.conv_w + j * 1536 + c + 4);
      w[j][0] = a.x; w[j][1] = a.y; w[j][2] = a.z; w[j][3] = a.w; w[j][4] = b.x; w[j][5] = b.y; w[j][6] = b.z; w[j][7] = b.w;
    }
    {
      const float4 a = *(const float4*)(p.conv_b + c), b = *(const float4*)(p.conv_b + c + 4);
      cb[0] = a.x; cb[1] = a.y; cb[2] = a.z; cb[3] = a.w; cb[4] = b.x; cb[5] = b.y; cb[6] = b.z; cb[7] = b.w;
    }
#pragma unroll
    for (int k = 0; k < 8; k++) {
      float o[8];
#pragma unroll
      for (int e = 0; e < 8; e++) o[e] = cb[e];
#pragma unroll
      for (int j = 0; j < 4; j++) {
        const uint4 r = rows[k + j];
        const unsigned rs[4] = {r.x, r.y, r.z, r.w};
#pragma unroll
        for (int e = 0; e < 4; e++) { o[2 * e] += bflo(rs[e]) * w[j][2 * e]; o[2 * e + 1] += bfhi(rs[e]) * w[j][2 * e + 1]; }
      }
      *(uint4*)(p.xc + (size_t)(n0 + k) * 1536 + c) =
          make_uint4(pack2(siluf_(o[0]), siluf_(o[1])), pack2(siluf_(o[2]), siluf_(o[3])), pack2(siluf_(o[4]), siluf_(o[5])),
                     pack2(siluf_(o[6]), siluf_(o[7])));
    }
    if (t0 + 8 == T) {
      float* co = seq_out(p.out, seq, O_PCONV, O_SCONV, 3 * 1536);
#pragma unroll
      for (int j = 0; j < 3; j++) {
        const uint4 r = rows[8 + j];
        *(float4*)(co + j * 1536 + c) = make_float4(bflo(r.x), bfhi(r.x), bflo(r.y), bfhi(r.y));
        *(float4*)(co + j * 1536 + c + 4) = make_float4(bflo(r.z), bfhi(r.z), bflo(r.w), bfhi(r.w));
      }
    }
  } else if (tid < 192 + 32) {
    const int i = tid - 192;
#pragma unroll
    for (int e = 0; e < 4; e++) {
      const int pi = i * 4 + e, k = pi >> 4, h = pi & 15, n = n0 + k;
      const float raw = bf2f(p.proj[(size_t)n * PCOLS + C_DT + h]) + p.dt_bias[h];
      const float dt = softplusf_(raw);
      const float dA = -dt * expf(p.A_log[h]);
      p.dtb[n * 16 + h] = dt;
      p.decb[n * 16 + h] = dA;
    }
  }
}

__device__ void phase3(const P& p, int bid, int nb, char* smem) {
  for (int it = bid; it < 2 * (NT / 8); it += nb) {
    if (it < NT / 8) rwkv_lerp_item(p, it);
    else conv_prep_item(p, it - NT / 8);
  }
}
__device__ void phase3b(const P& p, int bid, int nb, char* smem) {
  for (int it = bid; it < 136 * 4; it += nb) rwkv_lora_item(p, it >> 2, it & 3, smem);
}

constexpr int TC = 32;
__device__ __forceinline__ void bf8_to_f(uint4 u, float4& lo, float4& hi) {
  lo = make_float4(bflo(u.x), bfhi(u.x), bflo(u.y), bfhi(u.y));
  hi = make_float4(bflo(u.z), bfhi(u.z), bflo(u.w), bfhi(u.w));
}
__device__ void rwkv_scan_item(const P& p, int seq, int h, int qr, char* smem) {
  const int T = seq < 8 ? 2048 : 8, nbase = seq < 8 ? seq * 2048 : NP + (seq - 8) * 8;
  float* Ld = (float*)smem;
  float* Lr = Ld + TC * 64; float* Lk = Lr + TC * 64; float* Lkk = Lk + TC * 64; float* Lb = Lkk + TC * 64;
  float* Lv = Lb + TC * 64;
  const int tid = TIDX, w = tid >> 6, lane = tid & 63, rl = w * 4 + (lane >> 4), ks = lane & 15;
  const int v = qr * 16 + rl;
  float S0 = 0.f, S1 = 0.f, S2 = 0.f, S3 = 0.f;
  if (seq >= 8) {
    float4 s = *(const float4*)(p.state_wkv + (((size_t)(seq - 8) * 8 + h) * 64 + v) * 64 + ks * 4);
    S0 = s.x; S1 = s.y; S2 = s.z; S3 = s.w;
  }
  const int st = tid >> 3, sk8 = (tid & 7) * 8;
  const int vt = tid >> 1, vr8 = (tid & 1) * 8;
  uint4 g0, g1, g2, g3, g4, gv;
  g0 = g1 = g2 = g3 = g4 = gv = make_uint4(0, 0, 0, 0);
#define RW_GLOAD(c0_)                                                                           \
  {                                                                                             \
    const int tcn = min(TC, T - (c0_));                                                         \
    if (st < tcn) {                                                                             \
      const u16* base = p.prep + (size_t)(nbase + (c0_) + st) * 3584 + h * 64 + sk8;            \
      g0 = *(const uint4*)(base); g1 = *(const uint4*)(base + 512); g2 = *(const uint4*)(base + 1024); \
      g3 = *(const uint4*)(base + 1536); g4 = *(const uint4*)(base + 2048);                     \
    }                                                                                           \
    if (tid < 64 && vt < tcn)                                                                   \
      gv = *(const uint4*)(p.prep + (size_t)(nbase + (c0_) + vt) * 3584 + 2560 + h * 64 + qr * 16 + vr8); \
  }
  RW_GLOAD(0);
  for (int c0 = 0; c0 < T; c0 += TC) {
    const int tc = min(TC, T - c0);
    __syncthreads();
    {
      float4 lo, hi;
      bf8_to_f(g0, lo, hi);
      lo.x = __expf(lo.x); lo.y = __expf(lo.y); lo.z = __expf(lo.z); lo.w = __expf(lo.w);
      hi.x = __expf(hi.x); hi.y = __expf(hi.y); hi.z = __expf(hi.z); hi.w = __expf(hi.w);
      *(float4*)(Ld + st * 64 + sk8) = lo; *(float4*)(Ld + st * 64 + sk8 + 4) = hi;
      bf8_to_f(g1, lo, hi); *(float4*)(Lr + st * 64 + sk8) = lo; *(float4*)(Lr + st * 64 + sk8 + 4) = hi;
      bf8_to_f(g2, lo, hi); *(float4*)(Lk + st * 64 + sk8) = lo; *(float4*)(Lk + st * 64 + sk8 + 4) = hi;
      bf8_to_f(g3, lo, hi); *(float4*)(Lkk + st * 64 + sk8) = lo; *(float4*)(Lkk + st * 64 + sk8 + 4) = hi;
      bf8_to_f(g4, lo, hi); *(float4*)(Lb + st * 64 + sk8) = lo; *(float4*)(Lb + st * 64 + sk8 + 4) = hi;
      if (tid < 64) { bf8_to_f(gv, lo, hi); *(float4*)(Lv + vt * 16 + vr8) = lo; *(float4*)(Lv + vt * 16 + vr8 + 4) = hi; }
    }
    __syncthreads();
    if (c0 + TC < T) RW_GLOAD(c0 + TC);
    u16* yo = p.proj + (size_t)(nbase + c0) * PCOLS + h * 64 + v;
    float4 kk0, d0, b0, k0_, r0, kk1, d1, b1, k1_, r1, kk2, d2, b2, k2_, r2, kk3, d3, b3, k3_, r3;
    float v0, v1, v2, v3;
#define RW_LD(KK, DD, BB, KX, RR, VV, t_)                                                        \
  {                                                                                              \
    KK = *(const float4*)(Lkk + (t_) * 64 + ks * 4); DD = *(const float4*)(Ld + (t_) * 64 + ks * 4); \
    BB = *(const float4*)(Lb + (t_) * 64 + ks * 4); KX = *(const float4*)(Lk + (t_) * 64 + ks * 4);  \
    RR = *(const float4*)(Lr + (t_) * 64 + ks * 4); VV = Lv[(t_) * 16 + rl];                      \
  }
#define RW_STEP(KK, DD, BB, KX, RR, VV, YY)                                                      \
  {                                                                                              \
    const float vk0 = VV * KX.x, vk1 = VV * KX.y, vk2 = VV * KX.z, vk3 = VV * KX.w;              \
    float sk = (S0 * KK.x + S1 * KK.y) + (S2 * KK.z + S3 * KK.w);                                \
    sk = allreduce16(sk);                                                                        \
    S0 = S0 * DD.x + (vk0 - sk * BB.x);                                                          \
    S1 = S1 * DD.y + (vk1 - sk * BB.y);                                                          \
    S2 = S2 * DD.z + (vk2 - sk * BB.z);                                                          \
    S3 = S3 * DD.w + (vk3 - sk * BB.w);                                                          \
    YY = allreduce16((S0 * RR.x + S1 * RR.y) + (S2 * RR.z + S3 * RR.w));                         \
  }
    for (int tt = 0; tt < tc; tt += 4) {
      RW_LD(kk0, d0, b0, k0_, r0, v0, tt)
      RW_LD(kk1, d1, b1, k1_, r1, v1, tt + 1)
      RW_LD(kk2, d2, b2, k2_, r2, v2, tt + 2)
      RW_LD(kk3, d3, b3, k3_, r3, v3, tt + 3)
      float y0, y1, y2, y3;
      RW_STEP(kk0, d0, b0, k0_, r0, v0, y0)
      RW_STEP(kk1, d1, b1, k1_, r1, v1, y1)
      RW_STEP(kk2, d2, b2, k2_, r2, v2, y2)
      RW_STEP(kk3, d3, b3, k3_, r3, v3, y3)
      if (ks == 0) {
        u16* yp = yo + (size_t)tt * PCOLS;
        yp[0] = f2bf(y0); yp[PCOLS] = f2bf(y1); yp[2 * (size_t)PCOLS] = f2bf(y2); yp[3 * (size_t)PCOLS] = f2bf(y3);
      }
    }
  }
  float* so = seq_out(p.out, seq, O_PWKV, O_SWKV, 8 * 4096);
  *(float4*)(so + ((size_t)h * 64 + v) * 64 + ks * 4) = make_float4(S0, S1, S2, S3);
}

__device__ void ssm_scan_item(const P& p, int seq, int head, int half, char* smem) {
  const int T = seq < 8 ? 2048 : 8, nbase = seq < 8 ? seq * 2048 : NP + (seq - 8) * 8;
  float* LB = (float*)smem;
  float* LC = LB + TC * 128;
  float* Lx = LC + TC * 128;
  float* Ldt = Lx + TC * 32;
  float* Ldec = Ldt + TC;
  const int tid = TIDX, pl = tid >> 3, ns = tid & 7;
  const int pp = half * 32 + pl, g = head >> 3;
  const float Dk = p.D_skip[head];
  float hs[16];
#pragma unroll
  for (int j = 0; j < 16; j++) hs[j] = 0.f;
  if (seq >= 8) {
    const float4* s4 = (const float4*)(p.state_ssm + (((size_t)(seq - 8) * 16 + head) * 64 + pp) * 128 + ns * 16);
#pragma unroll
    for (int j = 0; j < 4; j++) { float4 s = s4[j]; hs[4 * j] = s.x; hs[4 * j + 1] = s.y; hs[4 * j + 2] = s.z; hs[4 * j + 3] = s.w; }
  }
  uint4 gb0, gb1, gb2, gb3, gx; float gdt = 0.f, gdec = 0.f;
  gb0 = gb1 = gb2 = gb3 = gx = make_uint4(0, 0, 0, 0);
  const int bt = tid >> 5, bch = tid & 31;
  const u16* bsrc = p.xc + 1024 + (bch < 16 ? 0 : 256) + g * 128 + (bch & 15) * 8;
  const int xt = tid >> 2, xr8 = (tid & 3) * 8;
#define SS_GLOAD(c0_)                                                                          \
  {                                                                                            \
    const int tcn = min(TC, T - (c0_));                                                        \
    const size_t nb_ = (size_t)(nbase + (c0_));                                                \
    if (bt < tcn) gb0 = *(const uint4*)(bsrc + (nb_ + bt) * 1536);                             \
    if (bt + 8 < tcn) gb1 = *(const uint4*)(bsrc + (nb_ + bt + 8) * 1536);                     \
    if (bt + 16 < tcn) gb2 = *(const uint4*)(bsrc + (nb_ + bt + 16) * 1536);                   \
    if (bt + 24 < tcn) gb3 = *(const uint4*)(bsrc + (nb_ + bt + 24) * 1536);                   \
    if (tid < 128 && xt < tcn) gx = *(const uint4*)(p.xc + (nb_ + xt) * 1536 + head * 64 + half * 32 + xr8); \
    if (tid < tcn) { gdt = p.dtb[(nb_ + tid) * 16 + head]; gdec = p.decb[(nb_ + tid) * 16 + head]; } \
  }
  SS_GLOAD(0);
  for (int c0 = 0; c0 < T; c0 += TC) {
    const int tc = min(TC, T - c0);
    __syncthreads();
    {
      float* dstb = (bch < 16 ? LB : LC) + (bch & 15) * 8;
      float4 lo, hi;
      bf8_to_f(gb0, lo, hi); *(float4*)(dstb + bt * 128) = lo; *(float4*)(dstb + bt * 128 + 4) = hi;
      bf8_to_f(gb1, lo, hi); *(float4*)(dstb + (bt + 8) * 128) = lo; *(float4*)(dstb + (bt + 8) * 128 + 4) = hi;
      bf8_to_f(gb2, lo, hi); *(float4*)(dstb + (bt + 16) * 128) = lo; *(float4*)(dstb + (bt + 16) * 128 + 4) = hi;
      bf8_to_f(gb3, lo, hi); *(float4*)(dstb + (bt + 24) * 128) = lo; *(float4*)(dstb + (bt + 24) * 128 + 4) = hi;
      if (tid < 128) { bf8_to_f(gx, lo, hi); *(float4*)(Lx + xt * 32 + xr8) = lo; *(float4*)(Lx + xt * 32 + xr8 + 4) = hi; }
      if (tid < TC) { Ldt[tid] = gdt; Ldec[tid] = __expf(gdec); }
    }
    __syncthreads();
    if (c0 + TC < T) SS_GLOAD(c0 + TC);
    u16* yo = p.proj + (size_t)(nbase + c0) * PCOLS + C_XBC + head * 64 + pp;
    float4 B0 = *(const float4*)(LB + ns * 16), B1 = *(const float4*)(LB + ns * 16 + 4), B2 = *(const float4*)(LB + ns * 16 + 8),
           B3 = *(const float4*)(LB + ns * 16 + 12);
    float4 C0 = *(const float4*)(LC + ns * 16), C1 = *(const float4*)(LC + ns * 16 + 4), C2 = *(const float4*)(LC + ns * 16 + 8),
           C3 = *(const float4*)(LC + ns * 16 + 12);
    float xv = Lx[pl], dtv = Ldt[0], dec = Ldec[0];
    for (int tt = 0; tt < tc; tt++) {
      const int tn = min(tt + 1, tc - 1);
      const float* nB = LB + tn * 128 + ns * 16;
      const float* nC = LC + tn * 128 + ns * 16;
      const float4 nB0 = *(const float4*)(nB), nB1 = *(const float4*)(nB + 4), nB2 = *(const float4*)(nB + 8), nB3 = *(const float4*)(nB + 12);
      const float4 nC0 = *(const float4*)(nC), nC1 = *(const float4*)(nC + 4), nC2 = *(const float4*)(nC + 8), nC3 = *(const float4*)(nC + 12);
      const float nxv = Lx[tn * 32 + pl], ndt = Ldt[tn], ndec = Ldec[tn];
      const float dtx = dtv * xv;
      hs[0] = hs[0] * dec + dtx * B0.x; hs[1] = hs[1] * dec + dtx * B0.y; hs[2] = hs[2] * dec + dtx * B0.z; hs[3] = hs[3] * dec + dtx * B0.w;
      hs[4] = hs[4] * dec + dtx * B1.x; hs[5] = hs[5] * dec + dtx * B1.y; hs[6] = hs[6] * dec + dtx * B1.z; hs[7] = hs[7] * dec + dtx * B1.w;
      hs[8] = hs[8] * dec + dtx * B2.x; hs[9] = hs[9] * dec + dtx * B2.y; hs[10] = hs[10] * dec + dtx * B2.z; hs[11] = hs[11] * dec + dtx * B2.w;
      hs[12] = hs[12] * dec + dtx * B3.x; hs[13] = hs[13] * dec + dtx * B3.y; hs[14] = hs[14] * dec + dtx * B3.z; hs[15] = hs[15] * dec + dtx * B3.w;
      float y0 = hs[0] * C0.x + hs[1] * C0.y + hs[2] * C0.z + hs[3] * C0.w;
      float y1 = hs[4] * C1.x + hs[5] * C1.y + hs[6] * C1.z + hs[7] * C1.w;
      float y2 = hs[8] * C2.x + hs[9] * C2.y + hs[10] * C2.z + hs[11] * C2.w;
      float y3 = hs[12] * C3.x + hs[13] * C3.y + hs[14] * C3.z + hs[15] * C3.w;
      float yp = allreduce8((y0 + y1) + (y2 + y3));
      if (ns == 0) yo[(size_t)tt * PCOLS] = f2bf(yp + Dk * xv);
      B0 = nB0; B1 = nB1; B2 = nB2; B3 = nB3; C0 = nC0; C1 = nC1; C2 = nC2; C3 = nC3; xv = nxv; dtv = ndt; dec = ndec;
    }
  }
  float* so = seq_out(p.out, seq, O_PSSM, O_SSSM, 16 * 8192);
  float4* o4 = (float4*)(so + ((size_t)head * 64 + pp) * 128 + ns * 16);
#pragma unroll
  for (int j = 0; j < 4; j++) o4[j] = make_float4(hs[4 * j], hs[4 * j + 1], hs[4 * j + 2], hs[4 * j + 3]);
}

__device__ void ssd_prompt_item(const P& p, int seq, int head, char* smem) {
  const int nbase = seq * 2048, g = head >> 3;
  char* sC = smem;
  char* sB = smem + 17408;
  char* sBT = smem + 34816;
  char* sXT = smem + 53248;
  char* sH = smem + 62464;
  float* sS = (float*)(smem + 79872);
  const int tid = TIDX, lane = tid & 63, w = tid >> 6, fr = lane & 15, q = lane >> 4;
  const float Dk = p.D_skip[head];
  f32x4 H[8];
#pragma unroll
  for (int i = 0; i < 8; i++) H[i] = f32x4{0.f, 0.f, 0.f, 0.f};
  __syncthreads();
  for (int i = tid; i < 17408 / 16; i += 256) *(uint4*)(sH + i * 16) = make_uint4(0, 0, 0, 0);
  uint4 gB0, gB1, gB2, gB3, gC0, gC1, gC2, gC3, gX0, gX1;
  float gdt, gdA;
#define SSD_LOAD(t0_)                                                                         \
  {                                                                                           \
    const size_t nn_ = (size_t)(nbase + (t0_) + lane);                                        \
    const u16* row_ = p.xc + nn_ * 1536;                                                      \
    const u16* rb_ = row_ + 1024 + g * 128 + w * 32;                                          \
    gB0 = *(const uint4*)(rb_); gB1 = *(const uint4*)(rb_ + 8); gB2 = *(const uint4*)(rb_ + 16); gB3 = *(const uint4*)(rb_ + 24); \
    gC0 = *(const uint4*)(rb_ + 256); gC1 = *(const uint4*)(rb_ + 264); gC2 = *(const uint4*)(rb_ + 272); gC3 = *(const uint4*)(rb_ + 280); \
    gX0 = *(const uint4*)(row_ + head * 64 + w * 16); gX1 = *(const uint4*)(row_ + head * 64 + w * 16 + 8); \
    gdt = p.dtb[nn_ * 16 + head]; gdA = p.decb[nn_ * 16 + head];                              \
  }
#define SSD_PUT_T(dst_, r0_, u_, sc_)                                                         \
  {                                                                                           \
    const unsigned us_[4] = {u_.x, u_.y, u_.z, u_.w};                                         \
    _Pragma("unroll") for (int e = 0; e < 4; e++) {                                           \
      *(u16*)(dst_ + ((r0_) + 2 * e) * 144 + lane * 2) = f2bf(bflo(us_[e]) * (sc_));          \
      *(u16*)(dst_ + ((r0_) + 2 * e + 1) * 144 + lane * 2) = f2bf(bfhi(us_[e]) * (sc_));      \
    }                                                                                         \
  }
  SSD_LOAD(0);
#pragma unroll 1
  for (int c = 0; c < 32; c++) {
    const int t0 = c * 64;
    float cs = gdA;
#pragma unroll
    for (int o = 1; o < 64; o <<= 1) { const float v = __shfl_up(cs, o, 64); if (lane >= o) cs += v; }
    const float cs63 = __shfl(cs, 63, 64);
    const float wt = gdt * __expf(cs63 - cs);
    __syncthreads();
    if (w == 0) { sS[lane] = cs; sS[64 + lane] = __expf(cs); sS[128 + lane] = gdt; }
    {
      char* rc = sC + lane * 272 + w * 64;
      char* rb = sB + lane * 272 + w * 64;
      *(uint4*)(rc) = gC0; *(uint4*)(rc + 16) = gC1; *(uint4*)(rc + 32) = gC2; *(uint4*)(rc + 48) = gC3;
      *(uint4*)(rb) = gB0; *(uint4*)(rb + 16) = gB1; *(uint4*)(rb + 32) = gB2; *(uint4*)(rb + 48) = gB3;
      SSD_PUT_T(sBT, w * 32, gB0, wt) SSD_PUT_T(sBT, w * 32 + 8, gB1, wt) SSD_PUT_T(sBT, w * 32 + 16, gB2, wt)
      SSD_PUT_T(sBT, w * 32 + 24, gB3, wt) SSD_PUT_T(sXT, w * 16, gX0, 1.f) SSD_PUT_T(sXT, w * 16 + 8, gX1, 1.f)
    }
    __syncthreads();
    if (c + 1 < 32) SSD_LOAD(t0 + 64);
    f32x4 cb[4], yo[4];
#pragma unroll
    for (int i = 0; i < 4; i++) { cb[i] = f32x4{0.f, 0.f, 0.f, 0.f}; yo[i] = f32x4{0.f, 0.f, 0.f, 0.f}; }
    {
      bf16x8 af[4];
#pragma unroll
      for (int ks = 0; ks < 4; ks++) af[ks] = *(const bf16x8*)(sC + (16 * w + fr) * 272 + ks * 64 + q * 16);
#pragma unroll
      for (int nn = 0; nn < 4; nn++)
#pragma unroll
        for (int ks = 0; ks < 4; ks++) {
          const bf16x8 bb = *(const bf16x8*)(sB + (16 * nn + fr) * 272 + ks * 64 + q * 16);
          cb[nn] = __builtin_amdgcn_mfma_f32_16x16x32_bf16(af[ks], bb, cb[nn], 0, 0, 0);
        }
#pragma unroll
      for (int pt = 0; pt < 4; pt++)
#pragma unroll
        for (int ks = 0; ks < 4; ks++) {
          const bf16x8 bb = *(const bf16x8*)(sH + (16 * pt + fr) * 272 + ks * 64 + q * 16);
          yo[pt] = __builtin_amdgcn_mfma_f32_16x16x32_bf16(af[ks], bb, yo[pt], 0, 0, 0);
        }
    }
    __syncthreads();
#pragma unroll
    for (int j = 0; j < 4; j++) {
      const int l = 16 * w + q * 4 + j;
      const float csl = sS[l];
#pragma unroll
      for (int nn = 0; nn < 4; nn++) {
        const int sidx = 16 * nn + fr;
        const float gv = (sidx <= l) ? cb[nn][j] * __expf(csl - sS[sidx]) * sS[128 + sidx] : 0.f;
        *(u16*)(sB + l * 144 + sidx * 2) = f2bf(gv);
      }
    }
    f32x4 yd[4];
#pragma unroll
    for (int i = 0; i < 4; i++) yd[i] = f32x4{0.f, 0.f, 0.f, 0.f};
#pragma unroll
    for (int ks = 0; ks < 2; ks++) {
      const bf16x8 aa = *(const bf16x8*)(sB + (16 * w + fr) * 144 + ks * 64 + q * 16);
#pragma unroll
      for (int pt = 0; pt < 4; pt++) {
        const bf16x8 bb = *(const bf16x8*)(sXT + (16 * pt + fr) * 144 + ks * 64 + q * 16);
        yd[pt] = __builtin_amdgcn_mfma_f32_16x16x32_bf16(aa, bb, yd[pt], 0, 0, 0);
      }
    }
#pragma unroll
    for (int j = 0; j < 4; j++) {
      const int l = 16 * w + q * 4 + j;
      const float el = sS[64 + l];
      u16* yrow = p.proj + (size_t)(nbase + t0 + l) * PCOLS + C_XBC + head * 64 + fr;
#pragma unroll
      for (int pt = 0; pt < 4; pt++) {
        const float xs = bf2f(*(const u16*)(sXT + (16 * pt + fr) * 144 + l * 2));
        yrow[16 * pt] = f2bf(yd[pt][j] + el * yo[pt][j] + Dk * xs);
      }
    }
    const float ach = __expf(cs63);
#pragma unroll
    for (int nt = 0; nt < 8; nt++) { H[nt][0] *= ach; H[nt][1] *= ach; H[nt][2] *= ach; H[nt][3] *= ach; }
#pragma unroll
    for (int ks = 0; ks < 2; ks++) {
      const bf16x8 aa = *(const bf16x8*)(sXT + (16 * w + fr) * 144 + ks * 64 + q * 16);
#pragma unroll
      for (int nt = 0; nt < 8; nt++) {
        const bf16x8 bb = *(const bf16x8*)(sBT + (16 * nt + fr) * 144 + ks * 64 + q * 16);
        H[nt] = __builtin_amdgcn_mfma_f32_16x16x32_bf16(aa, bb, H[nt], 0, 0, 0);
      }
    }
#pragma unroll
    for (int nt = 0; nt < 8; nt++)
#pragma unroll
      for (int j = 0; j < 4; j++) *(u16*)(sH + (16 * w + q * 4 + j) * 272 + (16 * nt + fr) * 2) = f2bf(H[nt][j]);
  }
  float* so = p.out + O_PSSM + ((size_t)seq * 16 + head) * 8192;
#pragma unroll
  for (int nt = 0; nt < 8; nt++)
#pragma unroll
    for (int j = 0; j < 4; j++) so[(16 * w + q * 4 + j) * 128 + 16 * nt + fr] = H[nt][j];
  __syncthreads();
}

constexpr int P4_RP = 256, P4_SP = 128, P4_RS = 4096, P4_SS = 4096;
#define XB_QUEUE 3600
__device__ void phase4(const P& p, int bid, int nb, char* smem) {
  for (int it = bid; it < P4_RP + P4_SP; it += nb) {
    if (it < P4_RP) rwkv_scan_item(p, it >> 5, (it >> 2) & 7, it & 3, smem);
    else { const int i = it - P4_RP; ssd_prompt_item(p, i >> 4, i & 15, smem); }
  }
  volatile int* slot = (volatile int*)(smem + LDS_BYTES - 32);
  for (;;) {
    __syncthreads();
    if (TIDX == 0) *slot = (int)atomicAdd(&p.bar[XB_QUEUE], 1u);
    __syncthreads();
    int i = *slot;
    if (i >= P4_RS + P4_SS) break;
    if (i < P4_RS) rwkv_scan_item(p, 8 + (i >> 5), (i >> 2) & 7, i & 3, smem);
    else { i -= P4_RS; ssm_scan_item(p, 8 + (i >> 5), (i >> 1) & 15, i & 1, smem); }
  }
}

__device__ void phase5(const P& p, int bid, int nb) {
  const int lane = TIDX & 63, wid = TIDX >> 6;
  for (int it = bid; it < NT / 4; it += nb) {
    const int n = it * 4 + wid;
    const uint4 sy0 = *(const uint4*)(p.proj + (size_t)n * PCOLS + C_XBC + lane * 16);
    const uint4 sy1 = *(const uint4*)(p.proj + (size_t)n * PCOLS + C_XBC + lane * 16 + 8);
    const uint4 sz0 = *(const uint4*)(p.proj + (size_t)n * PCOLS + C_Z + lane * 16);
    const uint4 sz1 = *(const uint4*)(p.proj + (size_t)n * PCOLS + C_Z + lane * 16 + 8);
    {
      const int c = lane * 8;
      uint4 yu = *(const uint4*)(p.proj + (size_t)n * PCOLS + c);
      const u16* pr = p.prep + (size_t)n * 3584 + c;
      uint4 ru = *(const uint4*)(pr + 512), ku = *(const uint4*)(pr + 1024), vu = *(const uint4*)(pr + 2560),
            gu = *(const uint4*)(pr + 3072);
      unsigned ys[4] = {yu.x, yu.y, yu.z, yu.w}, rs[4] = {ru.x, ru.y, ru.z, ru.w}, ks_[4] = {ku.x, ku.y, ku.z, ku.w},
               vs[4] = {vu.x, vu.y, vu.z, vu.w}, gs[4] = {gu.x, gu.y, gu.z, gu.w};
      float y[8], r[8], k[8], v[8], g[8];
#pragma unroll
      for (int e = 0; e < 4; e++) {
        y[2 * e] = bflo(ys[e]); y[2 * e + 1] = bfhi(ys[e]);
        r[2 * e] = bflo(rs[e]); r[2 * e + 1] = bfhi(rs[e]);
        k[2 * e] = bflo(ks_[e]); k[2 * e + 1] = bfhi(ks_[e]);
        v[2 * e] = bflo(vs[e]); v[2 * e + 1] = bfhi(vs[e]);
        g[2 * e] = bflo(gs[e]); g[2 * e + 1] = bfhi(gs[e]);
      }
      float s = 0.f, bn = 0.f;
#pragma unroll
      for (int e = 0; e < 8; e++) { s += y[e]; bn += r[e] * k[e] * p.rw_r_k[c + e]; }
      s = allreduce8(s); bn = allreduce8(bn);
      const float mean = s * (1.f / 64.f);
      float vr = 0.f;
#pragma unroll
      for (int e = 0; e < 8; e++) { const float d = y[e] - mean; vr += d * d; }
      vr = allreduce8(vr) * (1.f / 64.f);
      const float rs_ = rsqrtf(vr + 64e-5f);
      float o[8];
#pragma unroll
      for (int e = 0; e < 8; e++) {
        const float yn = (y[e] - mean) * rs_ * p.rw_ln_w[c + e] + p.rw_ln_b[c + e];
        o[e] = (yn + bn * v[e]) * g[e];
      }
      uint4 ou; ou.x = pack2(o[0], o[1]); ou.y = pack2(o[2], o[3]); ou.z = pack2(o[4], o[5]); ou.w = pack2(o[6], o[7]);
      *(uint4*)(p.oa + (size_t)n * 512 + c) = ou;
    }
    {
      const int c = lane * 16;
      float yv[16];
      float ss = 0.f;
#pragma unroll
      for (int hh = 0; hh < 2; hh++) {
        const uint4 yu = hh ? sy1 : sy0;
        const uint4 zu = hh ? sz1 : sz0;
        unsigned ys[4] = {yu.x, yu.y, yu.z, yu.w}, zs[4] = {zu.x, zu.y, zu.z, zu.w};
#pragma unroll
        for (int e = 0; e < 4; e++) {
          const float a = bflo(ys[e]) * siluf_(bflo(zs[e])), b = bfhi(ys[e]) * siluf_(bfhi(zs[e]));
          yv[hh * 8 + 2 * e] = a; yv[hh * 8 + 2 * e + 1] = b;
          ss += a * a + b * b;
        }
      }
#pragma unroll
      for (int o = 16; o >= 1; o >>= 1) ss += __shfl_xor(ss, o, 64);
      const float rstd = rsqrtf(ss * (1.f / 512.f) + 1e-6f);
      unsigned ou[8];
#pragma unroll
      for (int e = 0; e < 8; e++)
        ou[e] = pack2(yv[2 * e] * rstd * p.ssm_norm_w[c + 2 * e], yv[2 * e + 1] * rstd * p.ssm_norm_w[c + 2 * e + 1]);
      *(uint4*)(p.ob + (size_t)n * 1024 + c) = make_uint4(ou[0], ou[1], ou[2], ou[3]);
      *(uint4*)(p.ob + (size_t)n * 1024 + c + 8) = make_uint4(ou[4], ou[5], ou[6], ou[7]);
    }
  }
}

__device__ void phase6(const P& p, int bid, int nb, char* smem) {
  TileIter ti(bid, nb, 136, 8);
  int mt, nt;
  while (ti.next(mt, nt)) {
    f32x4 ac[4][4];
    u16* mrow = p.merged + (size_t)mt * 128 * D + nt * 128;
    zero_acc(ac);
    gemm_tile_glds(p.xn, D, mt * 128, p.w_inT + (size_t)G_A * D, D, nt * 128, D, ac, smem);
    ACC_FOREACH({ mrow[(size_t)row * D + col] = f2bf(sigmoidf_(ac[m][n][j])); })
    zero_acc(ac);
    gemm_tile_glds(p.oa, 512, mt * 128, p.w_paT, 512, nt * 128, 512, ac, smem);
    ACC_FOREACH({ u16* mp = mrow + (size_t)row * D + col; *mp = f2bf(bf2f(*mp) * ac[m][n][j]); })
    zero_acc(ac);
    gemm_tile_glds(p.xn, D, mt * 128, p.w_inT + (size_t)G_B * D, D, nt * 128, D, ac, smem);
    unsigned sg[4][4][2];
#pragma unroll
    for (int m = 0; m < 4; m++)
#pragma unroll
      for (int n = 0; n < 4; n++) {
        sg[m][n][0] = pack2(sigmoidf_(ac[m][n][0]), sigmoidf_(ac[m][n][1]));
        sg[m][n][1] = pack2(sigmoidf_(ac[m][n][2]), sigmoidf_(ac[m][n][3]));
      }
    zero_acc(ac);
    gemm_tile_glds(p.ob, D, mt * 128, p.w_pbT, D, nt * 128, D, ac, smem);
    ACC_FOREACH({
      const unsigned gu = sg[m][n][j >> 1];
      const float gv = (j & 1) ? bfhi(gu) : bflo(gu);
      u16* mp = mrow + (size_t)row * D + col;
      *mp = f2bf(bf2f(*mp) + gv * ac[m][n][j]);
    })
  }
}

constexpr int P7_G = 136 * 8, P7_CV = 16384;
constexpr float U_SCALE = 256.f, V_SCALE = 32.f;
__device__ void phase7(const P& p, int bid, int nb, char* smem) {
  {
    TileIter ti(bid, nb, 136, 8);
    int mt, nt;
    while (ti.next(mt, nt)) {
      f32x4 acc[4][4];
      zero_acc(acc);
      gemm_tile_glds(p.merged, D, mt * 128, p.w_outT, D, nt * 128, D, acc, smem);
      ACC_FOREACH({
        const int nn = mt * 128 + row, c = nt * 128 + col;
        int seq, t, T; tok2seq(nn, seq, t, T);
        const float gt = p.mod[(size_t)seq * 8192 + 2048 + c];
        p.out[O_Y + (size_t)nn * D + c] = xrow(p, nn)[c] + gt * acc[m][n][j];
      })
    }
  }
  for (int it0 = bid; it0 < P7_CV; it0 += 4 * nb) {
    const int tid = TIDX;
    float4 va[4], vb[4];
#pragma unroll
    for (int r = 0; r < 4; r++) {
      const int it = it0 + r * nb;
      if (it < P7_CV) {
        const float* src = it < 8192 ? p.peer_u + (size_t)it * 2048 : p.peer_v + (size_t)(it - 8192) * 2048;
        const float4* s4 = (const float4*)src + tid * 2;
        va[r] = s4[0]; vb[r] = s4[1];
      }
    }
#pragma unroll
    for (int r = 0; r < 4; r++) {
      const int it = it0 + r * nb;
      if (it < P7_CV) {
        unsigned char* dst = it < 8192 ? (unsigned char*)p.ub + (size_t)it * 2048 : (unsigned char*)p.vb + (size_t)(it - 8192) * 2048;
        const float sc = it < 8192 ? U_SCALE : V_SCALE;
        const float4 a = va[r], b = vb[r];
        int lo = __builtin_amdgcn_cvt_pk_fp8_f32(a.x * sc, a.y * sc, 0, false);
        lo = __builtin_amdgcn_cvt_pk_fp8_f32(a.z * sc, a.w * sc, lo, true);
        int hi = __builtin_amdgcn_cvt_pk_fp8_f32(b.x * sc, b.y * sc, 0, false);
        hi = __builtin_amdgcn_cvt_pk_fp8_f32(b.z * sc, b.w * sc, hi, true);
        *((uint2*)dst + tid) = make_uint2((unsigned)lo, (unsigned)hi);
      }
    }
  }
}

__device__ void phase9(const P& p, int bid, int nb, char* smem) {
  const int tid = TIDX, lane = tid & 63, wid = tid >> 6, wr = wid >> 1, wc = wid & 1, fr = lane & 15,
            fq = lane >> 4;
  TileIter ti(bid, nb, 136, 16);
  int mt, nt;
  while (ti.next(mt, nt)) {
    f32x4 acc[4][4];
    zero_acc(acc);
    gemm_tile_glds(p.xn, D, mt * 128, p.wqT, D, nt * 128, D, acc, smem);
    u16* Lq = (u16*)smem;
    ACC_FOREACH({ Lq[row * 136 + col] = f2bf(acc[m][n][j]); })
    __syncthreads();
    f32x4 sc[4][4];
    zero_acc(sc);
    const u16* kb = p.keysb + (size_t)nt * 128 * 128;
#pragma unroll 1
    for (int s = 0; s < 4; s++) {
      bf16x8 af[4], bfr[4];
#pragma unroll
      for (int m = 0; m < 4; m++) af[m] = *(const bf16x8*)((const char*)Lq + (wr * 64 + m * 16 + fr) * 272 + s * 64 + fq * 16);
#pragma unroll
      for (int n = 0; n < 4; n++) bfr[n] = *(const bf16x8*)(kb + (size_t)(wc * 64 + n * 16 + fr) * 128 + s * 32 + fq * 8);
#pragma unroll
      for (int m = 0; m < 4; m++)
#pragma unroll
        for (int n = 0; n < 4; n++) sc[m][n] = __builtin_amdgcn_mfma_f32_16x16x32_bf16(af[m], bfr[n], sc[m][n], 0, 0, 0);
    }
    __syncthreads();
    float* Ls = (float*)smem;
#pragma unroll
    for (int m = 0; m < 4; m++)
#pragma unroll
      for (int n = 0; n < 4; n++)
#pragma unroll
        for (int j = 0; j < 4; j++) Ls[(wr * 64 + m * 16 + fq * 4 + j) * 129 + wc * 64 + n * 16 + fr] = sc[m][n][j];
    __syncthreads();
    {
      const int row = tid >> 1, half = tid & 1;
      float* Lr = Ls + row * 129;
      const size_t ob = ((size_t)(mt * 128 + row) * 16 + nt) * 16;
      for (int r = 0; r < 16; r++) {
        float best = -INFINITY; int bi = 0;
        for (int i = 0; i < 64; i++) {
          const float v = Lr[half + 2 * i];
          if (v > best) { best = v; bi = half + 2 * i; }
        }
        const float ov = __shfl_xor(best, 1, 64);
        const int oi = __shfl_xor(bi, 1, 64);
        if (ov > best || (ov == best && oi < bi)) { best = ov; bi = oi; }
        if ((bi & 1) == half) Lr[bi] = -INFINITY;
        if (half == 0) { p.topv[ob + r] = best; p.topi[ob + r] = bi; }
      }
    }
    __syncthreads();
  }
}

__device__ __forceinline__ void cand_ij(int lane, int& ci, int& cj) {
  int i = 0, rem = lane;
#pragma unroll
  for (int r = 0; r < 16; r++) {
    const int cnt = 16 / (r + 1);
    if (i == r && rem >= cnt) { rem -= cnt; i = r + 1; }
  }
  ci = i; cj = rem;
}

typedef __attribute__((ext_vector_type(2))) __bf16 bf2_t;
__device__ __forceinline__ float dot2bf(unsigned a, unsigned b, float c) {
  return __builtin_amdgcn_fdot2_f32_bf16(__builtin_bit_cast(bf2_t, a), __builtin_bit_cast(bf2_t, b), c, false);
}
template <int CTRL, int RM>
__device__ __forceinline__ float dppf_m(float x) {
  return __int_as_float(__builtin_amdgcn_update_dpp(0, __float_as_int(x), CTRL, RM, 0xf, false));
}
__device__ __forceinline__ float wave_sum_l63(float x) {
  x += dppf<0xB1>(x);
  x += dppf<0x4E>(x);
  x += dppf<0x141>(x);
  x += dppf<0x140>(x);
  x += dppf_m<0x142, 0xA>(x);
  x += dppf_m<0x143, 0xC>(x);
  return x;
}
__device__ __forceinline__ float readlane_f(float x, int l) {
  return __int_as_float(__builtin_amdgcn_readlane(__float_as_int(x), l));
}
__device__ __forceinline__ void axpy8(float* acc, float w, uint4 v) {
  acc[0] += w * bflo(v.x); acc[1] += w * bfhi(v.x); acc[2] += w * bflo(v.y); acc[3] += w * bfhi(v.y);
  acc[4] += w * bflo(v.z); acc[5] += w * bfhi(v.z); acc[6] += w * bflo(v.w); acc[7] += w * bfhi(v.w);
}

typedef float f2_t __attribute__((ext_vector_type(2)));
__device__ __forceinline__ void fp8x16_to_f32(const uint4 v, float* o) {
  const unsigned w[4] = {v.x, v.y, v.z, v.w};
#pragma unroll
  for (int i = 0; i < 4; i++) {
    const f2_t lo = __builtin_amdgcn_cvt_pk_f32_fp8((int)w[i], false);
    const f2_t hi = __builtin_amdgcn_cvt_pk_f32_fp8((int)w[i], true);
    o[4 * i] = lo.x; o[4 * i + 1] = lo.y; o[4 * i + 2] = hi.x; o[4 * i + 3] = hi.y;
  }
}

__device__ void phase10(const P& p, int bid, int nb) {
  const int lane = TIDX & 63, wid = TIDX >> 6;
  int ci, cj; cand_ij(lane < 50 ? lane : 0, ci, cj);
  const unsigned char* ub8 = (const unsigned char*)p.ub;
  const unsigned char* vb8 = (const unsigned char*)p.vb;
  for (int it = bid; it < NT / 4; it += nb) {
    const int n = it * 4 + wid;
    int seq, t, T; tok2seq(n, seq, t, T);
    float xv[16];
    {
      const uint4 a = *(const uint4*)(p.xn + (size_t)n * D + lane * 16), b = *(const uint4*)(p.xn + (size_t)n * D + lane * 16 + 8);
      const unsigned as[4] = {a.x, a.y, a.z, a.w}, bs[4] = {b.x, b.y, b.z, b.w};
#pragma unroll
      for (int e = 0; e < 4; e++) { xv[2 * e] = bflo(as[e]); xv[2 * e + 1] = bfhi(as[e]); xv[8 + 2 * e] = bflo(bs[e]); xv[8 + 2 * e + 1] = bfhi(bs[e]); }
    }
    float acc[16];
#pragma unroll
    for (int e = 0; e < 16; e++) acc[e] = 0.f;
#pragma unroll 1
    for (int h = 0; h < 8; h++) {
      const size_t base = ((size_t)n * 16 + h * 2) * 16;
      float cand = -INFINITY; int eid = 0;
      if (lane < 50) {
        cand = p.topv[base + ci] + p.topv[base + 16 + cj];
        eid = p.topi[base + ci] * 128 + p.topi[base + 16 + cj];
      }
      int rank = 0;
#pragma unroll
      for (int m = 0; m < 50; m++) {
        const float cm = readlane_f(cand, m);
        rank += ((cm > cand) || (cm == cand && m < lane)) ? 1 : 0;
      }
      const bool sel = (lane < 50) && (rank < 16);
      unsigned long long mask = __ballot(sel);
      const float mx = readlane_f(cand, __builtin_ctzll(__ballot(sel && rank == 0)));
      const float ex = sel ? __expf(cand - mx) : 0.f;
      const float den = readlane_f(wave_sum_l63(ex), 63);
      const float gate = ex / den;
#pragma unroll 1
      for (int hf = 0; hf < 2; hf++) {
        int ek[8]; float gk[8];
#pragma unroll
        for (int k = 0; k < 8; k++) {
          const int src = __builtin_ctzll(mask);
          mask &= mask - 1;
          ek[k] = __builtin_amdgcn_readlane(eid, src);
          gk[k] = readlane_f(gate, src);
        }
        uint4 uu[8], vv[8];
#pragma unroll
        for (int j = 0; j < 8; j++) uu[j] = *(const uint4*)(ub8 + (size_t)ek[j] * D + lane * 16);
#pragma unroll
        for (int j = 0; j < 8; j++) vv[j] = *(const uint4*)(vb8 + (size_t)ek[j] * D + lane * 16);
        float dv = 0.f;
#pragma unroll
        for (int j = 0; j < 8; j++) {
          float uf[16];
          fp8x16_to_f32(uu[j], uf);
          float d0 = 0.f, d1 = 0.f;
#pragma unroll
          for (int e = 0; e < 8; e++) { d0 += uf[2 * e] * xv[2 * e]; d1 += uf[2 * e + 1] * xv[2 * e + 1]; }
          const float ds = readlane_f(wave_sum_l63(d0 + d1), 63);
          dv = (lane == j) ? ds : dv;
        }
        dv *= (1.f / U_SCALE);
        const float act = 0.5f * dv * (1.f + erff(dv * 0.70710678118654752f));
#pragma unroll
        for (int j = 0; j < 8; j++) {
          const float w = readlane_f(act, j) * gk[j] * (1.f / V_SCALE);
          float vf[16];
          fp8x16_to_f32(vv[j], vf);
#pragma unroll
          for (int e = 0; e < 16; e++) acc[e] += w * vf[e];
        }
      }
    }
    float* yr = p.out + O_Y + (size_t)n * D + lane * 16;
    const float* md = p.mod + (size_t)seq * 8192 + lane * 16;
    float x2[16];
    float ss = 0.f;
#pragma unroll
    for (int q4 = 0; q4 < 4; q4++) {
      const float4 a = *(const float4*)(yr + q4 * 4), g = *(const float4*)(md + 5120 + q4 * 4);
      x2[q4 * 4 + 0] = a.x + g.x * acc[q4 * 4 + 0]; x2[q4 * 4 + 1] = a.y + g.y * acc[q4 * 4 + 1];
      x2[q4 * 4 + 2] = a.z + g.z * acc[q4 * 4 + 2]; x2[q4 * 4 + 3] = a.w + g.w * acc[q4 * 4 + 3];
    }
#pragma unroll
    for (int e = 0; e < 16; e++) ss += x2[e] * x2[e];
    ss = readlane_f(wave_sum_l63(ss), 63);
    const float rstd = rsqrtf(ss * (1.f / 1024.f) + 1e-6f);
#pragma unroll
    for (int q4 = 0; q4 < 4; q4++) {
      const float4 fg = *(const float4*)(p.final_g + lane * 16 + q4 * 4), sc = *(const float4*)(md + 7168 + q4 * 4),
                   sh = *(const float4*)(md + 6144 + q4 * 4);
      float4 o;
      o.x = x2[q4 * 4 + 0] * rstd * fg.x * (1.f + sc.x) + sh.x;
      o.y = x2[q4 * 4 + 1] * rstd * fg.y * (1.f + sc.y) + sh.y;
      o.z = x2[q4 * 4 + 2] * rstd * fg.z * (1.f + sc.z) + sh.z;
      o.w = x2[q4 * 4 + 3] * rstd * fg.w * (1.f + sc.w) + sh.w;
      *(float4*)(yr + q4 * 4) = o;
    }
  }
}

#define XB_XCNT(j) (256 + 64 * (j))
#define XB_XSUB(j) (1280 + 64 * (j))
#define XB_XGEN(j) (2304 + 64 * (j))
#define XB_TOP 3328
#define XB_TOPGEN 3392
#define XB_WORDS 4096
__device__ __forceinline__ unsigned xb_ld(unsigned* p) { return __hip_atomic_load(p, __ATOMIC_RELAXED, __HIP_MEMORY_SCOPE_AGENT); }
__device__ __forceinline__ unsigned xb_add(unsigned* p, unsigned v) { return __hip_atomic_fetch_add(p, v, __ATOMIC_RELAXED, __HIP_MEMORY_SCOPE_AGENT); }
__device__ __forceinline__ unsigned xb_xcc_id() { return (unsigned)__builtin_amdgcn_s_getreg((3 << 11) | 20) & 0xFu; }
__device__ __forceinline__ void grid_barrier(unsigned* bar, volatile unsigned* xst) {
  asm volatile("s_waitcnt vmcnt(0)" ::: "memory");
  __syncthreads();
  if (TIDX == 0) {
    __builtin_amdgcn_s_waitcnt(0);
    const unsigned x = xst[0], nloc = xst[1], nx = xst[2];
    const unsigned old = xb_add(&bar[XB_XSUB(x)], 1u);
    const unsigned gen = old / nloc;
    if (old + 1u == (gen + 1u) * nloc) {
      __builtin_amdgcn_fence(__ATOMIC_RELEASE, "agent");
      asm volatile("s_waitcnt vmcnt(0)" ::: "memory");
      const unsigned og = xb_add(&bar[XB_TOP], 1u);
      const unsigned tg = og / nx;
      if (og + 1u == (tg + 1u) * nx) xb_add(&bar[XB_TOPGEN], 1u);
      else while (xb_ld(&bar[XB_TOPGEN]) == tg) __builtin_amdgcn_s_sleep(1);
      __builtin_amdgcn_fence(__ATOMIC_ACQUIRE, "agent");
      xb_add(&bar[XB_XGEN(x)], 1u);
      asm volatile("s_waitcnt vmcnt(0)" ::: "memory");
    } else {
      while (xb_ld(&bar[XB_XGEN(x)]) == gen) __builtin_amdgcn_s_sleep(1);
      __builtin_amdgcn_fence(__ATOMIC_ACQUIRE, "agent");
      asm volatile("s_waitcnt vmcnt(0)" ::: "memory");
    }
  }
  __syncthreads();
}

template <int PH>
__device__ __forceinline__ void run_phase(const P& p, int bid, int nb, char* smem) {
  if constexpr (PH == 0) phase0(p, bid, nb, smem);
  if constexpr (PH == 1) phase_norm<false>(p, bid, nb);
  if constexpr (PH == 2) phase2(p, bid, nb, smem);
  if constexpr (PH == 3) phase3(p, bid, nb, smem);
  if constexpr (PH == 4) phase4(p, bid, nb, smem);
  if constexpr (PH == 5) phase5(p, bid, nb);
  if constexpr (PH == 6) phase6(p, bid, nb, smem);
  if constexpr (PH == 7) phase7(p, bid, nb, smem);
  if constexpr (PH == 8) phase_norm<true>(p, bid, nb);
  if constexpr (PH == 9) phase9(p, bid, nb, smem);
  if constexpr (PH == 10) phase10(p, bid, nb);
  if constexpr (PH == 11) phase3b(p, bid, nb, smem);
}

template <int PH>
__global__ void __launch_bounds__(NTHREADS, 2) k_phase(P p) {
  extern __shared__ __attribute__((aligned(16))) char smem[];
  run_phase<PH>(p, blockIdx.x, gridDim.x, smem);
}

#if MEGA
__global__ void __launch_bounds__(NTHREADS, 2) k_mega(P p) {
  extern __shared__ __attribute__((aligned(16))) char smem[];
  cg::grid_group grid = cg::this_grid();
  const int bid = blockIdx.x, nb = gridDim.x;
#ifndef PROBE_ALL2
#define PROBE_ALL2 0
#endif
#ifndef PROBE_MASK
#define PROBE_MASK 0
#endif
#ifndef PROBE_SYNCS
#define PROBE_SYNCS 0
#endif
  volatile unsigned* xst = (volatile unsigned*)(smem + LDS_BYTES - 16);
  if (TIDX == 0) { const unsigned xcc0 = xb_xcc_id(); xst[0] = xcc0; xb_add(&p.bar[XB_XCNT(xcc0)], 1u); }
#define GSYNC(k)                                                                                 \
  {                                                                                              \
    if ((k) == 0) {                                                                              \
      grid.sync();                                                                               \
      if (TIDX == 0) {                                                                    \
        unsigned cnt = 0;                                                                        \
        for (unsigned j = 0; j < 16; ++j) cnt += xb_ld(&p.bar[XB_XCNT(j)]) > 0u ? 1u : 0u;       \
        xst[2] = cnt; xst[1] = xb_ld(&p.bar[XB_XCNT(xst[0])]);                                   \
      }                                                                                          \
    } else grid_barrier(p.bar, xst);                                                             \
  }
#define RUNPH(k)                                                       \
  run_phase<k>(p, bid, nb, smem); GSYNC(k)                             \
  if (PROBE_MASK & (1 << k)) { run_phase<k>(p, bid, nb, smem); GSYNC(1) }
#pragma unroll 1
  for (int rep = 0; rep < 1 + PROBE_ALL2; rep++) {
    RUNPH(0)
#pragma unroll 1
    for (int i = 0; i < PROBE_SYNCS; i++) GSYNC(1)
    RUNPH(1) RUNPH(2) RUNPH(3) RUNPH(11) RUNPH(4) RUNPH(5) RUNPH(6) RUNPH(7) RUNPH(8) RUNPH(9)
  }
  run_phase<10>(p, bid, nb, smem);
}
#endif

template <int PH>
static void launch_phase(const P& p, int grid, hipStream_t stream) {
  static bool attr = false;
  if (!attr) { hipFuncSetAttribute((const void*)k_phase<PH>, hipFuncAttributeMaxDynamicSharedMemorySize, LDS_BYTES); attr = true; }
  hipLaunchKernelGGL(k_phase<PH>, dim3(grid), dim3(NTHREADS), LDS_BYTES, stream, p);
}

extern "C" void kernel_launch(void* const* d_in, const int* in_sizes, int n_in, void* d_out, int out_size, void* d_ws,
                              size_t ws_size, hipStream_t stream) {
  P p{};
  const float** fp = (const float**)&p;
  for (int i = 0; i < 40; i++) fp[i] = (const float*)d_in[i];
  p.out = (float*)d_out;
  char* ws = (char*)d_ws;
  size_t off = 0;
  auto take = [&](size_t bytes) { char* r = ws + off; off += (bytes + 255) & ~(size_t)255; return r; };
  p.bar = (unsigned*)take(XB_WORDS * 4);
  p.w_inT = (u16*)take((size_t)INCOLS * D * 2);
  p.w_paT = (u16*)take((size_t)1024 * 512 * 2);
  p.w_pbT = (u16*)take((size_t)1024 * 1024 * 2);
  p.w_outT = (u16*)take((size_t)1024 * 1024 * 2);
  p.wqT = (u16*)take((size_t)2048 * 1024 * 2);
  p.keysb = (u16*)take((size_t)262144 * 2);
  p.mod = (float*)take((size_t)NSEQ * 8192 * 4);
  p.dtb = (float*)take((size_t)NT * 16 * 4);
  p.decb = (float*)take((size_t)NT * 16 * 4);
  p.xn = (u16*)take((size_t)NROWS * D * 2);
  p.proj = (u16*)take((size_t)NROWS * PCOLS * 2);
  p.prep = (u16*)take((size_t)NT * 3584 * 2);
  p.w2T = (u16*)take(512 * 64 * 2);
  p.a2T = (u16*)take(512 * 64 * 2);
  p.g2T = (u16*)take(512 * 128 * 2);
  p.lora = (u16*)take((size_t)NT * 256 * 2);
  if (off > ws_size) { fprintf(stderr, "workspace too small: need %zu have %zu\n", off, ws_size); return; }
  p.merged = p.prep;
  p.ub = p.proj;
  p.vb = p.proj + (size_t)16384 * 1024;
  p.topv = (float*)(p.proj + (size_t)2 * 16384 * 1024);
  p.topi = (int*)(p.topv + (size_t)NT * 256);
  p.xc = (u16*)d_out;
  p.oa = (u16*)d_out;
  p.ob = (u16*)d_out + (size_t)NT * 512;

  static int grid = 0;
  if (!grid) {
    int dev = 0, cus = 0, per_cu = 0;
    hipGetDevice(&dev);
    hipDeviceGetAttribute(&cus, hipDeviceAttributeMultiprocessorCount, dev);
#if MEGA
    hipFuncSetAttribute((const void*)k_mega, hipFuncAttributeMaxDynamicSharedMemorySize, LDS_BYTES);
    hipOccupancyMaxActiveBlocksPerMultiprocessor(&per_cu, k_mega, NTHREADS, LDS_BYTES);
    if (per_cu > 2) per_cu = 2;
#else
    per_cu = 2;
#endif
    if (per_cu < 1) per_cu = 1;
    grid = cus * per_cu;
  }
  hipMemsetAsync(p.mod, 0, (size_t)NSEQ * 8192 * 4, stream);
#if MEGA
  hipMemsetAsync(p.bar, 0, XB_WORDS * 4, stream);
  void* args[] = {&p};
  hipError_t e = hipLaunchCooperativeKernel((void*)k_mega, dim3(grid), dim3(NTHREADS), args, LDS_BYTES, stream);
  if (e != hipSuccess) fprintf(stderr, "cooperative launch failed: %s (grid %d)\n", hipGetErrorString(e), grid);
#else
  launch_phase<0>(p, grid, stream);
  launch_phase<1>(p, grid, stream);
  launch_phase<2>(p, grid, stream);
  launch_phase<3>(p, grid, stream);
  launch_phase<11>(p, grid, stream);
  launch_phase<4>(p, grid, stream);
  launch_phase<5>(p, grid, stream);
  launch_phase<6>(p, grid, stream);
  launch_phase<7>(p, grid, stream);
  launch_phase<8>(p, grid, stream);
  launch_phase<9>(p, grid, stream);
  launch_phase<10>(p, grid, stream);
#endif
}
```

```cpp
#include <hip/hip_runtime.h>
#include <hip/hip_cooperative_groups.h>
#include <cstdio>
namespace cg = cooperative_groups;

#ifndef MEGA
#define MEGA 1
#endif

typedef unsigned short u16;
typedef __attribute__((ext_vector_type(8))) short bf16x8;
typedef __attribute__((ext_vector_type(4))) float f32x4;

__device__ __forceinline__ int opaque_tid() { int t = threadIdx.x; asm volatile("" : "+v"(t)); return t; }
#define TIDX opaque_tid()

constexpr int D = 1024;
constexpr int NP = 16384, NS = 1024, NT = NP + NS, NSEQ = 136;
constexpr int NROWS = NT + 128;
constexpr int PCOLS = 4368;
constexpr int INCOLS = 6416;
constexpr int C_LW = 1536, C_LA = 1600, C_LG = 1664, C_Z = 1792, C_XBC = 2816, C_DT = 4352;
constexpr int G_A = 4368, G_B = 5392;
constexpr size_t O_Y = 0, O_PSHIFT = 17825792, O_PWKV = 17833984, O_PCONV = 18096128, O_PSSM = 18132992,
                 O_SSHIFT = 19181568, O_SWKV = 19312640, O_SCONV = 23506944, O_SSSM = 24096768;
constexpr int LDS_BYTES = 80 * 1024;
constexpr int NTHREADS = 256;

struct P {
  const float *x_prompt, *x_sample, *c_prompt, *c_sample, *state_shift, *state_wkv, *state_conv, *state_ssm;
  const float *w_ada, *b_ada, *norm1_g, *w_in, *rw_mu, *rw_w0, *rw_w2, *rw_a0, *rw_a2, *rw_g2, *rw_k_k, *rw_k_a,
      *rw_r_k, *rw_ln_w, *rw_ln_b;
  const float *conv_w, *conv_b, *dt_bias, *A_log, *D_skip, *ssm_norm_w, *w_pa, *w_pb, *w_out, *norm2_g, *peer_wq,
      *peer_keys, *peer_u, *peer_v, *final_g, *w_ada_f, *b_ada_f;
  float* out;
  u16 *w_inT, *w_paT, *w_pbT, *w_outT, *wqT, *keysb, *xn, *proj, *prep, *merged, *ub, *vb, *xc, *oa, *ob;
  u16 *w2T, *a2T, *g2T, *lora;
  float *mod, *dtb, *decb, *topv;
  int* topi;
  unsigned* bar;
};

__device__ __forceinline__ u16 f2bf(float f) {
  unsigned u = __float_as_uint(f);
  u += 0x7fffu + ((u >> 16) & 1u);
  return (u16)(u >> 16);
}
__device__ __forceinline__ float bf2f(u16 h) { return __uint_as_float(((unsigned)h) << 16); }
__device__ __forceinline__ unsigned pack2(float a, float b) { return (unsigned)f2bf(a) | ((unsigned)f2bf(b) << 16); }
__device__ __forceinline__ float bflo(unsigned u) { return __uint_as_float(u << 16); }
__device__ __forceinline__ float bfhi(unsigned u) { return __uint_as_float(u & 0xffff0000u); }
__device__ __forceinline__ float sigmoidf_(float x) { return 1.f / (1.f + __expf(-x)); }
__device__ __forceinline__ float siluf_(float x) { return x / (1.f + __expf(-x)); }
__device__ __forceinline__ float softplusf_(float x) { return x > 20.f ? x : log1pf(expf(x)); }

template <int CTRL>
__device__ __forceinline__ float dppf(float x) {
  return __int_as_float(__builtin_amdgcn_update_dpp(0, __float_as_int(x), CTRL, 0xf, 0xf, true));
}
__device__ __forceinline__ float allreduce16(float x) {
  x += dppf<0x128>(x);
  x += dppf<0x124>(x);
  x += dppf<0x122>(x);
  x += dppf<0x121>(x);
  return x;
}
__device__ __forceinline__ float allreduce8(float x) {
  x += dppf<0xB1>(x);
  x += dppf<0x4E>(x);
  x += dppf<0x141>(x);
  return x;
}
__device__ __forceinline__ float wave_sum(float x) {
#pragma unroll
  for (int o = 32; o >= 1; o >>= 1) x += __shfl_xor(x, o, 64);
  return x;
}
__device__ __forceinline__ float wave_max(float x) {
#pragma unroll
  for (int o = 32; o >= 1; o >>= 1) x = fmaxf(x, __shfl_xor(x, o, 64));
  return x;
}
__device__ __forceinline__ int wave_min_i(int x) {
#pragma unroll
  for (int o = 32; o >= 1; o >>= 1) x = min(x, __shfl_xor(x, o, 64));
  return x;
}

__device__ __forceinline__ const float* xrow(const P& p, int n) {
  return n < NP ? p.x_prompt + (size_t)n * D : p.x_sample + (size_t)(n - NP) * D;
}
__device__ __forceinline__ void tok2seq(int n, int& seq, int& t, int& T) {
  if (n < NP) { seq = n >> 11; t = n & 2047; T = 2048; }
  else { int m = n - NP; seq = 8 + (m >> 3); t = m & 7; T = 8; }
}
__device__ __forceinline__ float* seq_out(float* out, int seq, size_t op, size_t os, size_t per) {
  return seq < 8 ? out + op + (size_t)seq * per : out + os + (size_t)(seq - 8) * per;
}

constexpr int LROW = 144;
template <bool DEEP = true>
__device__ __forceinline__ void gemm_tile(const u16* __restrict__ A, int lda, int m0, const u16* __restrict__ Bt,
                                          int ldb, int n0, int K, f32x4 (&acc)[4][4], char* smem) {
  char* sA = smem;
  char* sB = smem + 128 * LROW;
  const int tid = TIDX, lane = tid & 63, wid = tid >> 6, wr = wid >> 1, wc = wid & 1, fr = lane & 15,
            fq = lane >> 4;
  uint4 ra0, ra1, ra2, ra3, rb0, rb1, rb2, rb3;
  uint4 sa0, sa1, sa2, sa3, sb0, sb1, sb2, sb3;
  const int nk = K / 64;
  const int lrow = tid >> 3, lch = tid & 7;
  const u16* gA = A + (size_t)(m0 + lrow) * lda + lch * 8;
  const u16* gB = Bt + (size_t)(n0 + lrow) * ldb + lch * 8;
#define GLOAD(x0, x1, x2, x3, y0, y1, y2, y3, kt)                   \
  {                                                                 \
    x0 = *(const uint4*)(gA + (kt) * 64);                           \
    x1 = *(const uint4*)(gA + (size_t)32 * lda + (kt) * 64);        \
    x2 = *(const uint4*)(gA + (size_t)64 * lda + (kt) * 64);        \
    x3 = *(const uint4*)(gA + (size_t)96 * lda + (kt) * 64);        \
    y0 = *(const uint4*)(gB + (kt) * 64);                           \
    y1 = *(const uint4*)(gB + (size_t)32 * ldb + (kt) * 64);        \
    y2 = *(const uint4*)(gB + (size_t)64 * ldb + (kt) * 64);        \
    y3 = *(const uint4*)(gB + (size_t)96 * ldb + (kt) * 64);        \
  }
#define LSTORE(x0, x1, x2, x3, y0, y1, y2, y3)                      \
  {                                                                 \
    char* wa = sA + lrow * LROW + lch * 16;                         \
    char* wb = sB + lrow * LROW + lch * 16;                         \
    *(uint4*)(wa) = x0; *(uint4*)(wa + 32 * LROW) = x1; *(uint4*)(wa + 64 * LROW) = x2; *(uint4*)(wa + 96 * LROW) = x3; \
    *(uint4*)(wb) = y0; *(uint4*)(wb + 32 * LROW) = y1; *(uint4*)(wb + 64 * LROW) = y2; *(uint4*)(wb + 96 * LROW) = y3; \
  }
#define COMPUTE_TILE()                                                                                                   \
  {                                                                                                                      \
    _Pragma("unroll") for (int s = 0; s < 2; s++) {                                                                      \
      bf16x8 af[4], bfr[4];                                                                                              \
      _Pragma("unroll") for (int m = 0; m < 4; m++) af[m] = *(const bf16x8*)(sA + (wr * 64 + m * 16 + fr) * LROW + s * 64 + fq * 16); \
      _Pragma("unroll") for (int n = 0; n < 4; n++) bfr[n] = *(const bf16x8*)(sB + (wc * 64 + n * 16 + fr) * LROW + s * 64 + fq * 16); \
      _Pragma("unroll") for (int m = 0; m < 4; m++)                                                                      \
        _Pragma("unroll") for (int n = 0; n < 4; n++) acc[m][n] = __builtin_amdgcn_mfma_f32_16x16x32_bf16(af[m], bfr[n], acc[m][n], 0, 0, 0); \
    }                                                                                                                    \
  }
  GLOAD(ra0, ra1, ra2, ra3, rb0, rb1, rb2, rb3, 0);
  if constexpr (DEEP) {
    GLOAD(sa0, sa1, sa2, sa3, sb0, sb1, sb2, sb3, 1);
#pragma unroll 1
    for (int kt = 0; kt < nk; kt += 2) {
      __syncthreads();
      LSTORE(ra0, ra1, ra2, ra3, rb0, rb1, rb2, rb3);
      __syncthreads();
      if (kt + 2 < nk) GLOAD(ra0, ra1, ra2, ra3, rb0, rb1, rb2, rb3, kt + 2);
      COMPUTE_TILE();
      __syncthreads();
      LSTORE(sa0, sa1, sa2, sa3, sb0, sb1, sb2, sb3);
      __syncthreads();
      if (kt + 3 < nk) GLOAD(sa0, sa1, sa2, sa3, sb0, sb1, sb2, sb3, kt + 3);
      COMPUTE_TILE();
    }
  } else {
#pragma unroll 1
    for (int kt = 0; kt < nk; kt++) {
      __syncthreads();
      LSTORE(ra0, ra1, ra2, ra3, rb0, rb1, rb2, rb3);
      __syncthreads();
      if (kt + 1 < nk) GLOAD(ra0, ra1, ra2, ra3, rb0, rb1, rb2, rb3, kt + 1);
      COMPUTE_TILE();
    }
  }
  __syncthreads();
}
#define GL_RAW_BARRIER() { asm volatile("s_waitcnt vmcnt(0)" ::: "memory"); asm volatile("s_waitcnt lgkmcnt(0)" ::: "memory"); __builtin_amdgcn_s_barrier(); }
__device__ __forceinline__ void gemm_tile_glds(const u16* __restrict__ A, int lda, int m0, const u16* __restrict__ Bt,
                                               int ldb, int n0, int K, f32x4 (&acc)[4][4], char* smem) {
  const int tid = TIDX, lane = tid & 63, wid = tid >> 6, wr = wid >> 1, wc = wid & 1, fr = lane & 15, fq = lane >> 4;
  const int nk = K / 64;
  const int srow = tid >> 3, sc = (tid & 7) ^ ((srow >> 1) & 7);
  const u16* gA = A + (size_t)(m0 + srow) * lda + sc * 8;
  const u16* gB = Bt + (size_t)(n0 + srow) * ldb + sc * 8;
  char* const lbase = smem + tid * 16;
  const int swz = (fr >> 1) & 7;
  const int aoff = (wr * 64 + fr) * 128, boff = 16384 + (wc * 64 + fr) * 128;
#define GL_STAGE(buf, kt)                                                                                         \
  {                                                                                                               \
    _Pragma("unroll") for (int i = 0; i < 4; i++) {                                                               \
      __builtin_amdgcn_global_load_lds((const unsigned*)(gA + (size_t)(32 * i) * lda + (kt) * 64),               \
                                       (unsigned*)(lbase + (buf) * 32768 + i * 4096), 16, 0, 0);                  \
      __builtin_amdgcn_global_load_lds((const unsigned*)(gB + (size_t)(32 * i) * ldb + (kt) * 64),               \
                                       (unsigned*)(lbase + (buf) * 32768 + 16384 + i * 4096), 16, 0, 0);          \
    }                                                                                                             \
  }
#define GL_COMPUTE(buf)                                                                                           \
  {                                                                                                               \
    const char* pb = smem + (buf) * 32768;                                                                        \
    _Pragma("unroll") for (int s = 0; s < 2; s++) {                                                               \
      bf16x8 af[4], bfr[4];                                                                                       \
      const int so = ((s * 4 + fq) ^ swz) * 16;                                                                   \
      _Pragma("unroll") for (int m = 0; m < 4; m++) af[m] = *(const bf16x8*)(pb + aoff + m * 2048 + so);          \
      _Pragma("unroll") for (int n = 0; n < 4; n++) bfr[n] = *(const bf16x8*)(pb + boff + n * 2048 + so);         \
      _Pragma("unroll") for (int m = 0; m < 4; m++)                                                               \
        _Pragma("unroll") for (int n = 0; n < 4; n++)                                                             \
          acc[m][n] = __builtin_amdgcn_mfma_f32_16x16x32_bf16(af[m], bfr[n], acc[m][n], 0, 0, 0);                 \
    }                                                                                                             \
  }
  __syncthreads();
  GL_STAGE(0, 0)
  GL_RAW_BARRIER()
#pragma unroll 1
  for (int kt = 0; kt < nk; kt += 2) {
    if (kt + 1 < nk) GL_STAGE(1, kt + 1)
    GL_COMPUTE(0)
    GL_RAW_BARRIER()
    if (kt + 1 < nk) {
      if (kt + 2 < nk) GL_STAGE(0, kt + 2)
      GL_COMPUTE(1)
      GL_RAW_BARRIER()
    }
  }
}
__device__ __forceinline__ void zero_acc(f32x4 (&acc)[4][4]) {
#pragma unroll
  for (int m = 0; m < 4; m++)
#pragma unroll
    for (int n = 0; n < 4; n++) acc[m][n] = f32x4{0.f, 0.f, 0.f, 0.f};
}
#define ACC_FOREACH(...)                                                                    \
  {                                                                                         \
    const int _l = TIDX & 63, _w = TIDX >> 6, _wr = _w >> 1, _wc = _w & 1;    \
    const int _fr = _l & 15, _fq = _l >> 4;                                                 \
    _Pragma("unroll") for (int m = 0; m < 4; m++) _Pragma("unroll") for (int n = 0; n < 4; n++) \
        _Pragma("unroll") for (int j = 0; j < 4; j++) {                                     \
      const int row = _wr * 64 + m * 16 + _fq * 4 + j, col = _wc * 64 + n * 16 + _fr;       \
      __VA_ARGS__                                                                           \
    }                                                                                       \
  }

struct TileIter {
  int x, lb, nbx, tpx, total, MT, NT, r;
  __device__ __forceinline__ TileIter(int bid, int nb, int MT_, int NT_) : MT(MT_), NT(NT_), r(0) {
    total = MT * NT; x = bid & 7; lb = bid >> 3; nbx = nb >> 3; tpx = (total + 7) >> 3;
  }
  __device__ __forceinline__ bool next(int& mt, int& nt) {
    const int idx = lb + r * nbx;
    r++;
    if (idx >= tpx) return false;
    const int lin = x * tpx + idx;
    if (lin >= total) return false;
    const int bsz = 8 * NT, band = lin / bsz, rem = lin - band * bsz;
    const int mb = min(8, MT - band * 8);
    nt = rem / mb; mt = band * 8 + (rem - nt * mb);
    return true;
  }
};

__device__ __forceinline__ void tile_out_bf16(const char* smem, u16* __restrict__ C, size_t ldc, int m0, int n0, int ncols_valid) {
  __syncthreads();
  const int tid = TIDX;
#pragma unroll
  for (int i = 0; i < 8; i++) {
    const int id = tid + i * 256, row = id >> 4, ch = id & 15;
    if (ch * 8 < ncols_valid) *(uint4*)(C + (size_t)(m0 + row) * ldc + n0 + ch * 8) = *(const uint4*)(smem + row * 272 + ch * 16);
  }
}

__device__ void transpose_tile(const float* __restrict__ src, int K, int N, u16* __restrict__ dst, int tile,
                               char* smem) {
  const int ntn = (N + 63) / 64, kt = tile / ntn, nt = tile % ntn, tid = TIDX;
  float(*s)[65] = (float(*)[65])smem;
  __syncthreads();
#pragma unroll 4
  for (int i = 0; i < 16; i++) {
    int r = (tid >> 6) + 4 * i, n = nt * 64 + (tid & 63);
    s[r][tid & 63] = (n < N) ? src[(size_t)(kt * 64 + r) * N + n] : 0.f;
  }
  __syncthreads();
#pragma unroll 4
  for (int i = 0; i < 8; i++) {
    int nl = (tid >> 5) + 8 * i, n = nt * 64 + nl, kl = (tid & 31) * 2;
    if (n < N) *(unsigned*)(dst + (size_t)n * K + kt * 64 + kl) = pack2(s[kl][nl], s[kl + 1][nl]);
  }
}

__device__ void mod_item(const P& p, int item2, char* smem) {
  const int item = item2 >> 1, kh2 = item2 & 1;
  const int tid = TIDX, j = tid & 31, g = tid >> 5;
  const int col0 = item * 32;
  const float* W; const float* bias; int N, cw;
  if (col0 < 6144) { W = p.w_ada; bias = p.b_ada; N = 6144; cw = col0; }
  else { W = p.w_ada_f; bias = p.b_ada_f; N = 2048; cw = col0 - 6144; }
  float(*cs)[68] = (float(*)[68])smem;
  float acc[17];
#pragma unroll
  for (int s = 0; s < 17; s++) acc[s] = 0.f;
  for (int k0 = kh2 * 512; k0 < kh2 * 512 + 512; k0 += 64) {
    __syncthreads();
    {
      float cv[34];
#pragma unroll
      for (int i = 0; i < 34; i++) {
        const int idx = tid + i * 256, seq = idx >> 6, kk = idx & 63;
        cv[i] = seq < 8 ? p.c_prompt[seq * 1024 + k0 + kk] : p.c_sample[(seq - 8) * 1024 + k0 + kk];
      }
#pragma unroll
      for (int i = 0; i < 34; i++) {
        const int idx = tid + i * 256;
        cs[idx >> 6][idx & 63] = siluf_(cv[i]);
      }
    }
    __syncthreads();
#pragma unroll 1
    for (int kh = 0; kh < 2; kh++) {
      float wv[32];
#pragma unroll
      for (int k = 0; k < 32; k++) wv[k] = W[(size_t)(k0 + kh * 32 + k) * N + cw + j];
#pragma unroll 2
      for (int k4 = 0; k4 < 8; k4++) {
#pragma unroll
        for (int s = 0; s < 17; s++) {
          float4 c4 = *(const float4*)&cs[g * 17 + s][kh * 32 + k4 * 4];
          acc[s] += wv[k4 * 4] * c4.x + wv[k4 * 4 + 1] * c4.y + wv[k4 * 4 + 2] * c4.z + wv[k4 * 4 + 3] * c4.w;
        }
      }
    }
  }
  const float b = kh2 == 0 ? bias[cw + j] : 0.f;
#pragma unroll
  for (int s = 0; s < 17; s++) atomicAdd(&p.mod[(size_t)(g * 17 + s) * 8192 + col0 + j], acc[s] + b);
}

constexpr int J_MOD = 512, J_WIN = 16 * 101, J_WPA = 8 * 16, J_WPB = 256, J_WOUT = 256, J_WQ = 16 * 32, J_KEYS = 128,
              J_SHIFT = 64;
constexpr int J_LORA = 8 + 8 + 16;
constexpr int PH0_ITEMS = J_MOD + J_WIN + J_WPA + J_WPB + J_WOUT + J_WQ + J_LORA + J_KEYS + J_SHIFT;

__device__ void phase0(const P& p, int bid, int nb, char* smem) {
  for (int it = bid; it < PH0_ITEMS; it += nb) {
    int i = it;
    if (i < J_MOD) { mod_item(p, i, smem); continue; }
    i -= J_MOD;
    if (i < J_WIN) { transpose_tile(p.w_in, 1024, INCOLS, p.w_inT, i, smem); continue; }
    i -= J_WIN;
    if (i < J_WPA) { transpose_tile(p.w_pa, 512, 1024, p.w_paT, i, smem); continue; }
    i -= J_WPA;
    if (i < J_WPB) { transpose_tile(p.w_pb, 1024, 1024, p.w_pbT, i, smem); continue; }
    i -= J_WPB;
    if (i < J_WOUT) { transpose_tile(p.w_out, 1024, 1024, p.w_outT, i, smem); continue; }
    i -= J_WOUT;
    if (i < J_WQ) { transpose_tile(p.peer_wq, 1024, 2048, p.wqT, i, smem); continue; }
    i -= J_WQ;
    if (i < 8) { transpose_tile(p.rw_w2, 64, 512, p.w2T, i, smem); continue; }
    if (i < 16) { transpose_tile(p.rw_a2, 64, 512, p.a2T, i - 8, smem); continue; }
    if (i < 32) { transpose_tile(p.rw_g2, 128, 512, p.g2T, i - 16, smem); continue; }
    i -= J_LORA;
    const float* src; u16* dst;
    if (i < J_KEYS) { src = p.peer_keys + (size_t)i * 2048; dst = p.keysb + (size_t)i * 2048; }
    else { i -= J_KEYS; src = p.state_shift + (size_t)i * 2048; dst = p.xn + (size_t)NT * D + (size_t)i * 2048; }
    const float4* s4 = (const float4*)src + TIDX * 2;
    float4 a = s4[0], b = s4[1];
    uint4 o; o.x = pack2(a.x, a.y); o.y = pack2(a.z, a.w); o.z = pack2(b.x, b.y); o.w = pack2(b.z, b.w);
    *((uint4*)dst + TIDX) = o;
  }
}

template <bool SECOND>
__device__ void phase_norm(const P& p, int bid, int nb) {
  const int lane = TIDX & 63, wid = TIDX >> 6;
  const float* gam = SECOND ? p.norm2_g : p.norm1_g;
  for (int it = bid; it < NT / 8; it += nb) {
    const int nA = it * 8 + wid * 2;
    float4 v[2][4];
#pragma unroll
    for (int k = 0; k < 2; k++) {
      const int n = nA + k;
      const float* xr = SECOND ? p.out + O_Y + (size_t)n * D : xrow(p, n);
#pragma unroll
      for (int i = 0; i < 4; i++) v[k][i] = ((const float4*)xr)[lane + 64 * i];
    }
#pragma unroll
    for (int k = 0; k < 2; k++) {
      const int n = nA + k;
      int seq, t, T; tok2seq(n, seq, t, T);
      const float* md = p.mod + (size_t)seq * 8192 + (SECOND ? 3072 : 0);
      float ss = 0.f;
#pragma unroll
      for (int i = 0; i < 4; i++)
        ss += v[k][i].x * v[k][i].x + v[k][i].y * v[k][i].y + v[k][i].z * v[k][i].z + v[k][i].w * v[k][i].w;
      ss = wave_sum(ss);
      const float rstd = rsqrtf(ss * (1.f / 1024.f) + 1e-6f);
      const bool last = (!SECOND) && (t == T - 1);
      float* so = seq_out(p.out, seq, O_PSHIFT, O_SSHIFT, 1024);
#pragma unroll
      for (int i = 0; i < 4; i++) {
        const int c = (lane + 64 * i) * 4;
        const float4 g = *(const float4*)(gam + c), sh = *(const float4*)(md + c), sc = *(const float4*)(md + 1024 + c);
        float4 o;
        o.x = v[k][i].x * rstd * g.x * (1.f + sc.x) + sh.x;
        o.y = v[k][i].y * rstd * g.y * (1.f + sc.y) + sh.y;
        o.z = v[k][i].z * rstd * g.z * (1.f + sc.z) + sh.z;
        o.w = v[k][i].w * rstd * g.w * (1.f + sc.w) + sh.w;
        uint2 pk; pk.x = pack2(o.x, o.y); pk.y = pack2(o.z, o.w);
        *(uint2*)(p.xn + (size_t)n * D + c) = pk;
        if (last) *(float4*)(so + c) = o;
      }
    }
  }
}

constexpr int P2_NT = 35, P2_MT = 137;
__device__ void phase2(const P& p, int bid, int nb, char* smem) {
  TileIter ti(bid, nb, P2_MT, P2_NT);
  int mt, nt;
  while (ti.next(mt, nt)) {
    f32x4 acc[4][4];
    zero_acc(acc);
    gemm_tile_glds(p.xn, D, mt * 128, p.w_inT, D, nt * 128, D, acc, smem);
    u16* Lt = (u16*)smem;
    ACC_FOREACH({ Lt[row * 136 + col] = f2bf(acc[m][n][j]); })
    tile_out_bf16(smem, p.proj, PCOLS, mt * 128, nt * 128, PCOLS - nt * 128);
  }
}

__device__ void rwkv_lerp_item(const P& p, int item) {
  const int tid = TIDX;
  const int n0 = item * 8;
  int seq, t0, T; tok2seq(n0, seq, t0, T);
  uint4 pcv[7], ppv[7];
#pragma unroll
  for (int i = 0; i < 7; i++) {
    const int idx = tid + i * 256, tok = idx / 224, c = (idx % 224) * 8;
    const int n = n0 + tok, t = t0 + tok;
    pcv[i] = *(const uint4*)(p.proj + (size_t)n * PCOLS + c);
    const size_t prow = t > 0 ? (size_t)(n - 1) : (size_t)(NT + (seq >= 8 ? seq - 8 : 0));
    ppv[i] = *(const uint4*)(p.proj + prow * PCOLS + c);
    if (t == 0 && seq < 8) ppv[i] = make_uint4(0, 0, 0, 0);
  }
#pragma unroll
  for (int i = 0; i < 7; i++) {
    const int idx = tid + i * 256, tok = idx / 224, c = (idx % 224) * 8;
    const int n = n0 + tok;
    const float4 mu0 = *(const float4*)(p.rw_mu + c), mu1 = *(const float4*)(p.rw_mu + c + 4);
    const float mus[8] = {mu0.x, mu0.y, mu0.z, mu0.w, mu1.x, mu1.y, mu1.z, mu1.w};
    const unsigned pcs[4] = {pcv[i].x, pcv[i].y, pcv[i].z, pcv[i].w}, pps[4] = {ppv[i].x, ppv[i].y, ppv[i].z, ppv[i].w};
    unsigned o[4];
#pragma unroll
    for (int e = 0; e < 4; e++) {
      float a0 = bflo(pcs[e]), a1 = bfhi(pcs[e]), b0 = bflo(pps[e]), b1 = bfhi(pps[e]);
      float q0 = a0 + (b0 - a0) * mus[2 * e], q1 = a1 + (b1 - a1) * mus[2 * e + 1];
      if (c >= C_LW && c < C_LA) { q0 = tanhf(q0); q1 = tanhf(q1); }
      else if (c >= C_LG) { q0 = sigmoidf_(q0); q1 = sigmoidf_(q1); }
      o[e] = pack2(q0, q1);
    }
    u16* dst;
    if (c < 512) dst = p.prep + (size_t)n * 3584 + 512 + c;
    else if (c < 1024) dst = p.prep + (size_t)n * 3584 + 1024 + (c - 512);
    else if (c < 1536) dst = p.prep + (size_t)n * 3584 + 2560 + (c - 1024);
    else dst = p.lora + (size_t)n * 256 + (c - 1536);
    *(uint4*)dst = make_uint4(o[0], o[1], o[2], o[3]);
  }
}

__device__ void rwkv_lora_item(const P& p, int mt, int nt, char* smem) {
  const int tid = TIDX, lane = tid & 63, wid = tid >> 6, wr = wid >> 1, wc = wid & 1, fr = lane & 15, fq = lane >> 4;
  const int col0 = nt * 128;
  f32x4 acc[4][4];
  zero_acc(acc);
  gemm_tile_glds(p.lora, 256, mt * 128, p.w2T, 64, col0, 64, acc, smem);
  ACC_FOREACH({
    const int gc = col0 + col;
    const float wpre = p.rw_w0[gc] + acc[m][n][j];
    const float w = -softplusf_(-wpre) - 0.5f;
    p.prep[(size_t)(mt * 128 + row) * 3584 + gc] = f2bf(-expf(w));
  })
  zero_acc(acc);
  gemm_tile_glds(p.lora + 128, 256, mt * 128, p.g2T, 128, col0, 128, acc, smem);
  ACC_FOREACH({ p.prep[(size_t)(mt * 128 + row) * 3584 + 3072 + col0 + col] = f2bf(acc[m][n][j]); })
  zero_acc(acc);
  gemm_tile_glds(p.lora + 64, 256, mt * 128, p.a2T, 64, col0, 64, acc, smem);
  float a0c[4], kkc[4], kac[4];
#pragma unroll
  for (int n = 0; n < 4; n++) {
    const int gc = col0 + wc * 64 + n * 16 + fr;
    a0c[n] = p.rw_a0[gc]; kkc[n] = p.rw_k_k[gc]; kac[n] = p.rw_k_a[gc];
  }
#pragma unroll
  for (int m = 0; m < 4; m++)
#pragma unroll
    for (int j = 0; j < 4; j++) {
      const int row = mt * 128 + wr * 64 + m * 16 + fq * 4 + j;
      u16* pr = p.prep + (size_t)row * 3584 + col0 + wc * 64 + fr;
      float kx[4], kkv[4], av[4];
      float ss = 0.f;
#pragma unroll
      for (int n = 0; n < 4; n++) {
        kx[n] = bf2f(pr[1024 + n * 16]);
        av[n] = sigmoidf_(a0c[n] + acc[m][n][j]);
        kkv[n] = kx[n] * kkc[n];
        ss += kkv[n] * kkv[n];
      }
      ss = allreduce16(ss);
      const float inv = 1.f / fmaxf(sqrtf(ss), 1e-12f);
#pragma unroll
      for (int n = 0; n < 4; n++) {
        const float kk = kkv[n] * inv;
        pr[1024 + n * 16] = f2bf(kx[n] * (1.f + (av[n] - 1.f) * kac[n]));
        pr[1536 + n * 16] = f2bf(kk);
        pr[2048 + n * 16] = f2bf(kk * av[n]);
      }
    }
}

__device__ void conv_prep_item(const P& p, int item) {
  const int tid = TIDX;
  const int n0 = item * 8;
  int seq, t0, T; tok2seq(n0, seq, t0, T);
  if (tid < 192) {
    const int c = tid * 8;
    uint4 rows[11];
#pragma unroll
    for (int j = 0; j < 11; j++) {
      const int tt = t0 - 3 + j;
      rows[j] = make_uint4(0, 0, 0, 0);
      if (tt >= 0) rows[j] = *(const uint4*)(p.proj + (size_t)(n0 - 3 + j) * PCOLS + C_XBC + c);
      else if (seq >= 8) {
        const float* sc = p.state_conv + ((size_t)(seq - 8) * 3 + (tt + 3)) * 1536 + c;
        const float4 a = *(const float4*)sc, b = *(const float4*)(sc + 4);
        rows[j] = make_uint4(pack2(a.x, a.y), pack2(a.z, a.w), pack2(b.x, b.y), pack2(b.z, b.w));
      }
    }
    float w[4][8], cb[8];
#pragma unroll
    for (int j = 0; j < 4; j++) {
      const float4 a = *(const float4*)(p.conv_w + j * 1536 + c), b = *(const float4*)(p.conv_w + j * 1536 + c + 4);
      w[j][0] = a.x; w[j][1] = a.y; w[j][2] = a.z; w[j][3] = a.w; w[j][4] = b.x; w[j][5] = b.y; w[j][6] = b.z; w[j][7] = b.w;
    }
    {
      const float4 a = *(const float4*)(p.conv_b + c), b = *(const float4*)(p.conv_b + c + 4);
      cb[0] = a.x; cb[1] = a.y; cb[2] = a.z; cb[3] = a.w; cb[4] = b.x; cb[5] = b.y; cb[6] = b.z; cb[7] = b.w;
    }
#pragma unroll
    for (int k = 0; k < 8; k++) {
      float o[8];
#pragma unroll
      for (int e = 0; e < 8; e++) o[e] = cb[e];
#pragma unroll
      for (int j = 0; j < 4; j++) {
        const uint4 r = rows[k + j];
        const unsigned rs[4] = {r.x, r.y, r.z, r.w};
#pragma unroll
        for (int e = 0; e < 4; e++) { o[2 * e] += bflo(rs[e]) * w[j][2 * e]; o[2 * e + 1] += bfhi(rs[e]) * w[j][2 * e + 1]; }
      }
      *(uint4*)(p.xc + (size_t)(n0 + k) * 1536 + c) =
          make_uint4(pack2(siluf_(o[0]), siluf_(o[1])), pack2(siluf_(o[2]), siluf_(o[3])), pack2(siluf_(o[4]), siluf_(o[5])),
                     pack2(siluf_(o[6]), siluf_(o[7])));
    }
    if (t0 + 8 == T) {
      float* co = seq_out(p.out, seq, O_PCONV, O_SCONV, 3 * 1536);
#pragma unroll
      for (int j = 0; j < 3; j++) {
        const uint4 r = rows[8 + j];
        *(float4*)(co + j * 1536 + c) = make_float4(bflo(r.x), bfhi(r.x), bflo(r.y), bfhi(r.y));
        *(float4*)(co + j * 1536 + c + 4) = make_float4(bflo(r.z), bfhi(r.z), bflo(r.w), bfhi(r.w));
      }
    }
  } else if (tid < 192 + 32) {
    const int i = tid - 192;
#pragma unroll
    for (int e = 0; e < 4; e++) {
      const int pi = i * 4 + e, k = pi >> 4, h = pi & 15, n = n0 + k;
      const float raw = bf2f(p.proj[(size_t)n * PCOLS + C_DT + h]) + p.dt_bias[h];
      const float dt = softplusf_(raw);
      const float dA = -dt * expf(p.A_log[h]);
      p.dtb[n * 16 + h] = dt;
      p.decb[n * 16 + h] = dA;
    }
  }
}

__device__ void phase3(const P& p, int bid, int nb, char* smem) {
  for (int it = bid; it < 2 * (NT / 8); it += nb) {
    if (it < NT / 8) rwkv_lerp_item(p, it);
    else conv_prep_item(p, it - NT / 8);
  }
}
__device__ void phase3b(const P& p, int bid, int nb, char* smem) {
  for (int it = bid; it < 136 * 4; it += nb) rwkv_lora_item(p, it >> 2, it & 3, smem);
}

constexpr int TC = 32;
__device__ __forceinline__ void bf8_to_f(uint4 u, float4& lo, float4& hi) {
  lo = make_float4(bflo(u.x), bfhi(u.x), bflo(u.y), bfhi(u.y));
  hi = make_float4(bflo(u.z), bfhi(u.z), bflo(u.w), bfhi(u.w));
}
__device__ void rwkv_scan_item(const P& p, int seq, int h, int qr, char* smem) {
  const int T = seq < 8 ? 2048 : 8, nbase = seq < 8 ? seq * 2048 : NP + (seq - 8) * 8;
  float* Ld = (float*)smem;
  float* Lr = Ld + TC * 64; float* Lk = Lr + TC * 64; float* Lkk = Lk + TC * 64; float* Lb = Lkk + TC * 64;
  float* Lv = Lb + TC * 64;
  const int tid = TIDX, w = tid >> 6, lane = tid & 63, rl = w * 4 + (lane >> 4), ks = lane & 15;
  const int v = qr * 16 + rl;
  float S0 = 0.f, S1 = 0.f, S2 = 0.f, S3 = 0.f;
  if (seq >= 8) {
    float4 s = *(const float4*)(p.state_wkv + (((size_t)(seq - 8) * 8 + h) * 64 + v) * 64 + ks * 4);
    S0 = s.x; S1 = s.y; S2 = s.z; S3 = s.w;
  }
  const int st = tid >> 3, sk8 = (tid & 7) * 8;
  const int vt = tid >> 1, vr8 = (tid & 1) * 8;
  uint4 g0, g1, g2, g3, g4, gv;
  g0 = g1 = g2 = g3 = g4 = gv = make_uint4(0, 0, 0, 0);
#define RW_GLOAD(c0_)                                                                           \
  {                                                                                             \
    const int tcn = min(TC, T - (c0_));                                                         \
    if (st < tcn) {                                                                             \
      const u16* base = p.prep + (size_t)(nbase + (c0_) + st) * 3584 + h * 64 + sk8;            \
      g0 = *(const uint4*)(base); g1 = *(const uint4*)(base + 512); g2 = *(const uint4*)(base + 1024); \
      g3 = *(const uint4*)(base + 1536); g4 = *(const uint4*)(base + 2048);                     \
    }                                                                                           \
    if (tid < 64 && vt < tcn)                                                                   \
      gv = *(const uint4*)(p.prep + (size_t)(nbase + (c0_) + vt) * 3584 + 2560 + h * 64 + qr * 16 + vr8); \
  }
  RW_GLOAD(0);
  for (int c0 = 0; c0 < T; c0 += TC) {
    const int tc = min(TC, T - c0);
    __syncthreads();
    {
      float4 lo, hi;
      bf8_to_f(g0, lo, hi);
      lo.x = __expf(lo.x); lo.y = __expf(lo.y); lo.z = __expf(lo.z); lo.w = __expf(lo.w);
      hi.x = __expf(hi.x); hi.y = __expf(hi.y); hi.z = __expf(hi.z); hi.w = __expf(hi.w);
      *(float4*)(Ld + st * 64 + sk8) = lo; *(float4*)(Ld + st * 64 + sk8 + 4) = hi;
      bf8_to_f(g1, lo, hi); *(float4*)(Lr + st * 64 + sk8) = lo; *(float4*)(Lr + st * 64 + sk8 + 4) = hi;
      bf8_to_f(g2, lo, hi); *(float4*)(Lk + st * 64 + sk8) = lo; *(float4*)(Lk + st * 64 + sk8 + 4) = hi;
      bf8_to_f(g3, lo, hi); *(float4*)(Lkk + st * 64 + sk8) = lo; *(float4*)(Lkk + st * 64 + sk8 + 4) = hi;
      bf8_to_f(g4, lo, hi); *(float4*)(Lb + st * 64 + sk8) = lo; *(float4*)(Lb + st * 64 + sk8 + 4) = hi;
      if (tid < 64) { bf8_to_f(gv, lo, hi); *(float4*)(Lv + vt * 16 + vr8) = lo; *(float4*)(Lv + vt * 16 + vr8 + 4) = hi; }
    }
    __syncthreads();
    if (c0 + TC < T) RW_GLOAD(c0 + TC);
    u16* yo = p.proj + (size_t)(nbase + c0) * PCOLS + h * 64 + v;
    float4 kk0, d0, b0, k0_, r0, kk1, d1, b1, k1_, r1, kk2, d2, b2, k2_, r2, kk3, d3, b3, k3_, r3;
    float v0, v1, v2, v3;
#define RW_LD(KK, DD, BB, KX, RR, VV, t_)                                                        \
  {                                                                                              \
    KK = *(const float4*)(Lkk + (t_) * 64 + ks * 4); DD = *(const float4*)(Ld + (t_) * 64 + ks * 4); \
    BB = *(const float4*)(Lb + (t_) * 64 + ks * 4); KX = *(const float4*)(Lk + (t_) * 64 + ks * 4);  \
    RR = *(const float4*)(Lr + (t_) * 64 + ks * 4); VV = Lv[(t_) * 16 + rl];                      \
  }
#define RW_STEP(KK, DD, BB, KX, RR, VV, YY)                                                      \
  {                                                                                              \
    const float vk0 = VV * KX.x, vk1 = VV * KX.y, vk2 = VV * KX.z, vk3 = VV * KX.w;              \
    float sk = (S0 * KK.x + S1 * KK.y) + (S2 * KK.z + S3 * KK.w);                                \
    sk = allreduce16(sk);                                                                        \
    S0 = S0 * DD.x + (vk0 - sk * BB.x);                                                          \
    S1 = S1 * DD.y + (vk1 - sk * BB.y);                                                          \
    S2 = S2 * DD.z + (vk2 - sk * BB.z);                                                          \
    S3 = S3 * DD.w + (vk3 - sk * BB.w);                                                          \
    YY = allreduce16((S0 * RR.x + S1 * RR.y) + (S2 * RR.z + S3 * RR.w));                         \
  }
    for (int tt = 0; tt < tc; tt += 4) {
      RW_LD(kk0, d0, b0, k0_, r0, v0, tt)
      RW_LD(kk1, d1, b1, k1_, r1, v1, tt + 1)
      RW_LD(kk2, d2, b2, k2_, r2, v2, tt + 2)
      RW_LD(kk3, d3, b3, k3_, r3, v3, tt + 3)
      float y0, y1, y2, y3;
      RW_STEP(kk0, d0, b0, k0_, r0, v0, y0)
      RW_STEP(kk1, d1, b1, k1_, r1, v1, y1)
      RW_STEP(kk2, d2, b2, k2_, r2, v2, y2)
      RW_STEP(kk3, d3, b3, k3_, r3, v3, y3)
      if (ks == 0) {
        u16* yp = yo + (size_t)tt * PCOLS;
        yp[0] = f2bf(y0); yp[PCOLS] = f2bf(y1); yp[2 * (size_t)PCOLS] = f2bf(y2); yp[3 * (size_t)PCOLS] = f2bf(y3);
      }
    }
  }
  float* so = seq_out(p.out, seq, O_PWKV, O_SWKV, 8 * 4096);
  *(float4*)(so + ((size_t)h * 64 + v) * 64 + ks * 4) = make_float4(S0, S1, S2, S3);
}

__device__ void ssm_scan_item(const P& p, int seq, int head, int half, char* smem) {
  const int T = seq < 8 ? 2048 : 8, nbase = seq < 8 ? seq * 2048 : NP + (seq - 8) * 8;
  float* LB = (float*)smem;
  float* LC = LB + TC * 128;
  float* Lx = LC + TC * 128;
  float* Ldt = Lx + TC * 32;
  float* Ldec = Ldt + TC;
  const int tid = TIDX, pl = tid >> 3, ns = tid & 7;
  const int pp = half * 32 + pl, g = head >> 3;
  const float Dk = p.D_skip[head];
  float hs[16];
#pragma unroll
  for (int j = 0; j < 16; j++) hs[j] = 0.f;
  if (seq >= 8) {
    const float4* s4 = (const float4*)(p.state_ssm + (((size_t)(seq - 8) * 16 + head) * 64 + pp) * 128 + ns * 16);
#pragma unroll
    for (int j = 0; j < 4; j++) { float4 s = s4[j]; hs[4 * j] = s.x; hs[4 * j + 1] = s.y; hs[4 * j + 2] = s.z; hs[4 * j + 3] = s.w; }
  }
  uint4 gb0, gb1, gb2, gb3, gx; float gdt = 0.f, gdec = 0.f;
  gb0 = gb1 = gb2 = gb3 = gx = make_uint4(0, 0, 0, 0);
  const int bt = tid >> 5, bch = tid & 31;
  const u16* bsrc = p.xc + 1024 + (bch < 16 ? 0 : 256) + g * 128 + (bch & 15) * 8;
  const int xt = tid >> 2, xr8 = (tid & 3) * 8;
#define SS_GLOAD(c0_)                                                                          \
  {                                                                                            \
    const int tcn = min(TC, T - (c0_));                                                        \
    const size_t nb_ = (size_t)(nbase + (c0_));                                                \
    if (bt < tcn) gb0 = *(const uint4*)(bsrc + (nb_ + bt) * 1536);                             \
    if (bt + 8 < tcn) gb1 = *(const uint4*)(bsrc + (nb_ + bt + 8) * 1536);                     \
    if (bt + 16 < tcn) gb2 = *(const uint4*)(bsrc + (nb_ + bt + 16) * 1536);                   \
    if (bt + 24 < tcn) gb3 = *(const uint4*)(bsrc + (nb_ + bt + 24) * 1536);                   \
    if (tid < 128 && xt < tcn) gx = *(const uint4*)(p.xc + (nb_ + xt) * 1536 + head * 64 + half * 32 + xr8); \
    if (tid < tcn) { gdt = p.dtb[(nb_ + tid) * 16 + head]; gdec = p.decb[(nb_ + tid) * 16 + head]; } \
  }
  SS_GLOAD(0);
  for (int c0 = 0; c0 < T; c0 += TC) {
    const int tc = min(TC, T - c0);
    __syncthreads();
    {
      float* dstb = (bch < 16 ? LB : LC) + (bch & 15) * 8;
      float4 lo, hi;
      bf8_to_f(gb0, lo, hi); *(float4*)(dstb + bt * 128) = lo; *(float4*)(dstb + bt * 128 + 4) = hi;
      bf8_to_f(gb1, lo, hi); *(float4*)(dstb + (bt + 8) * 128) = lo; *(float4*)(dstb + (bt + 8) * 128 + 4) = hi;
      bf8_to_f(gb2, lo, hi); *(float4*)(dstb + (bt + 16) * 128) = lo; *(float4*)(dstb + (bt + 16) * 128 + 4) = hi;
      bf8_to_f(gb3, lo, hi); *(float4*)(dstb + (bt + 24) * 128) = lo; *(float4*)(dstb + (bt + 24) * 128 + 4) = hi;
      if (tid < 128) { bf8_to_f(gx, lo, hi); *(float4*)(Lx + xt * 32 + xr8) = lo; *(float4*)(Lx + xt * 32 + xr8 + 4) = hi; }
      if (tid < TC) { Ldt[tid] = gdt; Ldec[tid] = __expf(gdec); }
    }
    __syncthreads();
    if (c0 + TC < T) SS_GLOAD(c0 + TC);
    u16* yo = p.proj + (size_t)(nbase + c0) * PCOLS + C_XBC + head * 64 + pp;
    float4 B0 = *(const float4*)(LB + ns * 16), B1 = *(const float4*)(LB + ns * 16 + 4), B2 = *(const float4*)(LB + ns * 16 + 8),
           B3 = *(const float4*)(LB + ns * 16 + 12);
    float4 C0 = *(const float4*)(LC + ns * 16), C1 = *(const float4*)(LC + ns * 16 + 4), C2 = *(const float4*)(LC + ns * 16 + 8),
           C3 = *(const float4*)(LC + ns * 16 + 12);
    float xv = Lx[pl], dtv = Ldt[0], dec = Ldec[0];
    for (int tt = 0; tt < tc; tt++) {
      const int tn = min(tt + 1, tc - 1);
      const float* nB = LB + tn * 128 + ns * 16;
      const float* nC = LC + tn * 128 + ns * 16;
      const float4 nB0 = *(const float4*)(nB), nB1 = *(const float4*)(nB + 4), nB2 = *(const float4*)(nB + 8), nB3 = *(const float4*)(nB + 12);
      const float4 nC0 = *(const float4*)(nC), nC1 = *(const float4*)(nC + 4), nC2 = *(const float4*)(nC + 8), nC3 = *(const float4*)(nC + 12);
      const float nxv = Lx[tn * 32 + pl], ndt = Ldt[tn], ndec = Ldec[tn];
      const float dtx = dtv * xv;
      hs[0] = hs[0] * dec + dtx * B0.x; hs[1] = hs[1] * dec + dtx * B0.y; hs[2] = hs[2] * dec + dtx * B0.z; hs[3] = hs[3] * dec + dtx * B0.w;
      hs[4] = hs[4] * dec + dtx * B1.x; hs[5] = hs[5] * dec + dtx * B1.y; hs[6] = hs[6] * dec + dtx * B1.z; hs[7] = hs[7] * dec + dtx * B1.w;
      hs[8] = hs[8] * dec + dtx * B2.x; hs[9] = hs[9] * dec + dtx * B2.y; hs[10] = hs[10] * dec + dtx * B2.z; hs[11] = hs[11] * dec + dtx * B2.w;
      hs[12] = hs[12] * dec + dtx * B3.x; hs[13] = hs[13] * dec + dtx * B3.y; hs[14] = hs[14] * dec + dtx * B3.z; hs[15] = hs[15] * dec + dtx * B3.w;
      float y0 = hs[0] * C0.x + hs[1] * C0.y + hs[2] * C0.z + hs[3] * C0.w;
      float y1 = hs[4] * C1.x + hs[5] * C1.y + hs[6] * C1.z + hs[7] * C1.w;
      float y2 = hs[8] * C2.x + hs[9] * C2.y + hs[10] * C2.z + hs[11] * C2.w;
      float y3 = hs[12] * C3.x + hs[13] * C3.y + hs[14] * C3.z + hs[15] * C3.w;
      float yp = allreduce8((y0 + y1) + (y2 + y3));
      if (ns == 0) yo[(size_t)tt * PCOLS] = f2bf(yp + Dk * xv);
      B0 = nB0; B1 = nB1; B2 = nB2; B3 = nB3; C0 = nC0; C1 = nC1; C2 = nC2; C3 = nC3; xv = nxv; dtv = ndt; dec = ndec;
    }
  }
  float* so = seq_out(p.out, seq, O_PSSM, O_SSSM, 16 * 8192);
  float4* o4 = (float4*)(so + ((size_t)head * 64 + pp) * 128 + ns * 16);
#pragma unroll
  for (int j = 0; j < 4; j++) o4[j] = make_float4(hs[4 * j], hs[4 * j + 1], hs[4 * j + 2], hs[4 * j + 3]);
}

__device__ void ssd_prompt_item(const P& p, int seq, int head, char* smem) {
  const int nbase = seq * 2048, g = head >> 3;
  char* sC = smem;
  char* sB = smem + 17408;
  char* sBT = smem + 34816;
  char* sXT = smem + 53248;
  char* sH = smem + 62464;
  float* sS = (float*)(smem + 79872);
  const int tid = TIDX, lane = tid & 63, w = tid >> 6, fr = lane & 15, q = lane >> 4;
  const float Dk = p.D_skip[head];
  f32x4 H[8];
#pragma unroll
  for (int i = 0; i < 8; i++) H[i] = f32x4{0.f, 0.f, 0.f, 0.f};
  __syncthreads();
  for (int i = tid; i < 17408 / 16; i += 256) *(uint4*)(sH + i * 16) = make_uint4(0, 0, 0, 0);
  uint4 gB0, gB1, gB2, gB3, gC0, gC1, gC2, gC3, gX0, gX1;
  float gdt, gdA;
#define SSD_LOAD(t0_)                                                                         \
  {                                                                                           \
    const size_t nn_ = (size_t)(nbase + (t0_) + lane);                                        \
    const u16* row_ = p.xc + nn_ * 1536;                                                      \
    const u16* rb_ = row_ + 1024 + g * 128 + w * 32;                                          \
    gB0 = *(const uint4*)(rb_); gB1 = *(const uint4*)(rb_ + 8); gB2 = *(const uint4*)(rb_ + 16); gB3 = *(const uint4*)(rb_ + 24); \
    gC0 = *(const uint4*)(rb_ + 256); gC1 = *(const uint4*)(rb_ + 264); gC2 = *(const uint4*)(rb_ + 272); gC3 = *(const uint4*)(rb_ + 280); \
    gX0 = *(const uint4*)(row_ + head * 64 + w * 16); gX1 = *(const uint4*)(row_ + head * 64 + w * 16 + 8); \
    gdt = p.dtb[nn_ * 16 + head]; gdA = p.decb[nn_ * 16 + head];                              \
  }
#define SSD_PUT_T(dst_, r0_, u_, sc_)                                                         \
  {                                                                                           \
    const unsigned us_[4] = {u_.x, u_.y, u_.z, u_.w};                                         \
    _Pragma("unroll") for (int e = 0; e < 4; e++) {                                           \
      *(u16*)(dst_ + ((r0_) + 2 * e) * 144 + lane * 2) = f2bf(bflo(us_[e]) * (sc_));          \
      *(u16*)(dst_ + ((r0_) + 2 * e + 1) * 144 + lane * 2) = f2bf(bfhi(us_[e]) * (sc_));      \
    }                                                                                         \
  }
  SSD_LOAD(0);
#pragma unroll 1
  for (int c = 0; c < 32; c++) {
    const int t0 = c * 64;
    float cs = gdA;
#pragma unroll
    for (int o = 1; o < 64; o <<= 1) { const float v = __shfl_up(cs, o, 64); if (lane >= o) cs += v; }
    const float cs63 = __shfl(cs, 63, 64);
    const float wt = gdt * __expf(cs63 - cs);
    __syncthreads();
    if (w == 0) { sS[lane] = cs; sS[64 + lane] = __expf(cs); sS[128 + lane] = gdt; }
    {
      char* rc = sC + lane * 272 + w * 64;
      char* rb = sB + lane * 272 + w * 64;
      *(uint4*)(rc) = gC0; *(uint4*)(rc + 16) = gC1; *(uint4*)(rc + 32) = gC2; *(uint4*)(rc + 48) = gC3;
      *(uint4*)(rb) = gB0; *(uint4*)(rb + 16) = gB1; *(uint4*)(rb + 32) = gB2; *(uint4*)(rb + 48) = gB3;
      SSD_PUT_T(sBT, w * 32, gB0, wt) SSD_PUT_T(sBT, w * 32 + 8, gB1, wt) SSD_PUT_T(sBT, w * 32 + 16, gB2, wt)
      SSD_PUT_T(sBT, w * 32 + 24, gB3, wt) SSD_PUT_T(sXT, w * 16, gX0, 1.f) SSD_PUT_T(sXT, w * 16 + 8, gX1, 1.f)
    }
    __syncthreads();
    if (c + 1 < 32) SSD_LOAD(t0 + 64);
    f32x4 cb[4], yo[4];
#pragma unroll
    for (int i = 0; i < 4; i++) { cb[i] = f32x4{0.f, 0.f, 0.f, 0.f}; yo[i] = f32x4{0.f, 0.f, 0.f, 0.f}; }
    {
      bf16x8 af[4];
#pragma unroll
      for (int ks = 0; ks < 4; ks++) af[ks] = *(const bf16x8*)(sC + (16 * w + fr) * 272 + ks * 64 + q * 16);
#pragma unroll
      for (int nn = 0; nn < 4; nn++)
#pragma unroll
        for (int ks = 0; ks < 4; ks++) {
          const bf16x8 bb = *(const bf16x8*)(sB + (16 * nn + fr) * 272 + ks * 64 + q * 16);
          cb[nn] = __builtin_amdgcn_mfma_f32_16x16x32_bf16(af[ks], bb, cb[nn], 0, 0, 0);
        }
#pragma unroll
      for (int pt = 0; pt < 4; pt++)
#pragma unroll
        for (int ks = 0; ks < 4; ks++) {
          const bf16x8 bb = *(const bf16x8*)(sH + (16 * pt + fr) * 272 + ks * 64 + q * 16);
          yo[pt] = __builtin_amdgcn_mfma_f32_16x16x32_bf16(af[ks], bb, yo[pt], 0, 0, 0);
        }
    }
    __syncthreads();
#pragma unroll
    for (int j = 0; j < 4; j++) {
      const int l = 16 * w + q * 4 + j;
      const float csl = sS[l];
#pragma unroll
      for (int nn = 0; nn < 4; nn++) {
        const int sidx = 16 * nn + fr;
        const float gv = (sidx <= l) ? cb[nn][j] * __expf(csl - sS[sidx]) * sS[128 + sidx] : 0.f;
        *(u16*)(sB + l * 144 + sidx * 2) = f2bf(gv);
      }
    }
    f32x4 yd[4];
#pragma unroll
    for (int i = 0; i < 4; i++) yd[i] = f32x4{0.f, 0.f, 0.f, 0.f};
#pragma unroll
    for (int ks = 0; ks < 2; ks++) {
      const bf16x8 aa = *(const bf16x8*)(sB + (16 * w + fr) * 144 + ks * 64 + q * 16);
#pragma unroll
      for (int pt = 0; pt < 4; pt++) {
        const bf16x8 bb = *(const bf16x8*)(sXT + (16 * pt + fr) * 144 + ks * 64 + q * 16);
        yd[pt] = __builtin_amdgcn_mfma_f32_16x16x32_bf16(aa, bb, yd[pt], 0, 0, 0);
      }
    }
#pragma unroll
    for (int j = 0; j < 4; j++) {
      const int l = 16 * w + q * 4 + j;
      const float el = sS[64 + l];
      u16* yrow = p.proj + (size_t)(nbase + t0 + l) * PCOLS + C_XBC + head * 64 + fr;
#pragma unroll
      for (int pt = 0; pt < 4; pt++) {
        const float xs = bf2f(*(const u16*)(sXT + (16 * pt + fr) * 144 + l * 2));
        yrow[16 * pt] = f2bf(yd[pt][j] + el * yo[pt][j] + Dk * xs);
      }
    }
    const float ach = __expf(cs63);
#pragma unroll
    for (int nt = 0; nt < 8; nt++) { H[nt][0] *= ach; H[nt][1] *= ach; H[nt][2] *= ach; H[nt][3] *= ach; }
#pragma unroll
    for (int ks = 0; ks < 2; ks++) {
      const bf16x8 aa = *(const bf16x8*)(sXT + (16 * w + fr) * 144 + ks * 64 + q * 16);
#pragma unroll
      for (int nt = 0; nt < 8; nt++) {
        const bf16x8 bb = *(const bf16x8*)(sBT + (16 * nt + fr) * 144 + ks * 64 + q * 16);
        H[nt] = __builtin_amdgcn_mfma_f32_16x16x32_bf16(aa, bb, H[nt], 0, 0, 0);
      }
    }
#pragma unroll
    for (int nt = 0; nt < 8; nt++)
#pragma unroll
      for (int j = 0; j < 4; j++) *(u16*)(sH + (16 * w + q * 4 + j) * 272 + (16 * nt + fr) * 2) = f2bf(H[nt][j]);
  }
  float* so = p.out + O_PSSM + ((size_t)seq * 16 + head) * 8192;
#pragma unroll
  for (int nt = 0; nt < 8; nt++)
#pragma unroll
    for (int j = 0; j < 4; j++) so[(16 * w + q * 4 + j) * 128 + 16 * nt + fr] = H[nt][j];
  __syncthreads();
}

constexpr int P4_RP = 256, P4_SP = 128, P4_RS = 4096, P4_SS = 4096;
#define XB_QUEUE 3600
__device__ void phase4(const P& p, int bid, int nb, char* smem) {
  for (int it = bid; it < P4_RP + P4_SP; it += nb) {
    if (it < P4_RP) rwkv_scan_item(p, it >> 5, (it >> 2) & 7, it & 3, smem);
    else { const int i = it - P4_RP; ssd_prompt_item(p, i >> 4, i & 15, smem); }
  }
  volatile int* slot = (volatile int*)(smem + LDS_BYTES - 32);
  for (;;) {
    __syncthreads();
    if (TIDX == 0) *slot = (int)atomicAdd(&p.bar[XB_QUEUE], 1u);
    __syncthreads();
    int i = *slot;
    if (i >= P4_RS + P4_SS) break;
    if (i < P4_RS) rwkv_scan_item(p, 8 + (i >> 5), (i >> 2) & 7, i & 3, smem);
    else { i -= P4_RS; ssm_scan_item(p, 8 + (i >> 5), (i >> 1) & 15, i & 1, smem); }
  }
}

__device__ void phase5(const P& p, int bid, int nb) {
  const int lane = TIDX & 63, wid = TIDX >> 6;
  for (int it = bid; it < NT / 4; it += nb) {
    const int n = it * 4 + wid;
    const uint4 sy0 = *(const uint4*)(p.proj + (size_t)n * PCOLS + C_XBC + lane * 16);
    const uint4 sy1 = *(const uint4*)(p.proj + (size_t)n * PCOLS + C_XBC + lane * 16 + 8);
    const uint4 sz0 = *(const uint4*)(p.proj + (size_t)n * PCOLS + C_Z + lane * 16);
    const uint4 sz1 = *(const uint4*)(p.proj + (size_t)n * PCOLS + C_Z + lane * 16 + 8);
    {
      const int c = lane * 8;
      uint4 yu = *(const uint4*)(p.proj + (size_t)n * PCOLS + c);
      const u16* pr = p.prep + (size_t)n * 3584 + c;
      uint4 ru = *(const uint4*)(pr + 512), ku = *(const uint4*)(pr + 1024), vu = *(const uint4*)(pr + 2560),
            gu = *(const uint4*)(pr + 3072);
      unsigned ys[4] = {yu.x, yu.y, yu.z, yu.w}, rs[4] = {ru.x, ru.y, ru.z, ru.w}, ks_[4] = {ku.x, ku.y, ku.z, ku.w},
               vs[4] = {vu.x, vu.y, vu.z, vu.w}, gs[4] = {gu.x, gu.y, gu.z, gu.w};
      float y[8], r[8], k[8], v[8], g[8];
#pragma unroll
      for (int e = 0; e < 4; e++) {
        y[2 * e] = bflo(ys[e]); y[2 * e + 1] = bfhi(ys[e]);
        r[2 * e] = bflo(rs[e]); r[2 * e + 1] = bfhi(rs[e]);
        k[2 * e] = bflo(ks_[e]); k[2 * e + 1] = bfhi(ks_[e]);
        v[2 * e] = bflo(vs[e]); v[2 * e + 1] = bfhi(vs[e]);
        g[2 * e] = bflo(gs[e]); g[2 * e + 1] = bfhi(gs[e]);
      }
      float s = 0.f, bn = 0.f;
#pragma unroll
      for (int e = 0; e < 8; e++) { s += y[e]; bn += r[e] * k[e] * p.rw_r_k[c + e]; }
      s = allreduce8(s); bn = allreduce8(bn);
      const float mean = s * (1.f / 64.f);
      float vr = 0.f;
#pragma unroll
      for (int e = 0; e < 8; e++) { const float d = y[e] - mean; vr += d * d; }
      vr = allreduce8(vr) * (1.f / 64.f);
      const float rs_ = rsqrtf(vr + 64e-5f);
      float o[8];
#pragma unroll
      for (int e = 0; e < 8; e++) {
        const float yn = (y[e] - mean) * rs_ * p.rw_ln_w[c + e] + p.rw_ln_b[c + e];
        o[e] = (yn + bn * v[e]) * g[e];
      }
      uint4 ou; ou.x = pack2(o[0], o[1]); ou.y = pack2(o[2], o[3]); ou.z = pack2(o[4], o[5]); ou.w = pack2(o[6], o[7]);
      *(uint4*)(p.oa + (size_t)n * 512 + c) = ou;
    }
    {
      const int c = lane * 16;
      float yv[16];
      float ss = 0.f;
#pragma unroll
      for (int hh = 0; hh < 2; hh++) {
        const uint4 yu = hh ? sy1 : sy0;
        const uint4 zu = hh ? sz1 : sz0;
        unsigned ys[4] = {yu.x, yu.y, yu.z, yu.w}, zs[4] = {zu.x, zu.y, zu.z, zu.w};
#pragma unroll
        for (int e = 0; e < 4; e++) {
          const float a = bflo(ys[e]) * siluf_(bflo(zs[e])), b = bfhi(ys[e]) * siluf_(bfhi(zs[e]));
          yv[hh * 8 + 2 * e] = a; yv[hh * 8 + 2 * e + 1] = b;
          ss += a * a + b * b;
        }
      }
#pragma unroll
      for (int o = 16; o >= 1; o >>= 1) ss += __shfl_xor(ss, o, 64);
      const float rstd = rsqrtf(ss * (1.f / 512.f) + 1e-6f);
      unsigned ou[8];
#pragma unroll
      for (int e = 0; e < 8; e++)
        ou[e] = pack2(yv[2 * e] * rstd * p.ssm_norm_w[c + 2 * e], yv[2 * e + 1] * rstd * p.ssm_norm_w[c + 2 * e + 1]);
      *(uint4*)(p.ob + (size_t)n * 1024 + c) = make_uint4(ou[0], ou[1], ou[2], ou[3]);
      *(uint4*)(p.ob + (size_t)n * 1024 + c + 8) = make_uint4(ou[4], ou[5], ou[6], ou[7]);
    }
  }
}

__device__ void phase6(const P& p, int bid, int nb, char* smem) {
  TileIter ti(bid, nb, 136, 8);
  int mt, nt;
  while (ti.next(mt, nt)) {
    f32x4 ac[4][4];
    unsigned sg[4][4][2];
    u16* Lt = (u16*)smem;
    zero_acc(ac);
    gemm_tile_glds(p.xn, D, mt * 128, p.w_inT + (size_t)G_A * D, D, nt * 128, D, ac, smem);
#pragma unroll
    for (int m = 0; m < 4; m++)
#pragma unroll
      for (int n = 0; n < 4; n++) {
        sg[m][n][0] = pack2(sigmoidf_(ac[m][n][0]), sigmoidf_(ac[m][n][1]));
        sg[m][n][1] = pack2(sigmoidf_(ac[m][n][2]), sigmoidf_(ac[m][n][3]));
      }
    zero_acc(ac);
    gemm_tile_glds(p.oa, 512, mt * 128, p.w_paT, 512, nt * 128, 512, ac, smem);
    ACC_FOREACH({
      const unsigned gu = sg[m][n][j >> 1];
      Lt[row * 136 + col] = f2bf(((j & 1) ? bfhi(gu) : bflo(gu)) * ac[m][n][j]);
    })
    tile_out_bf16(smem, p.merged, D, mt * 128, nt * 128, 128);
    zero_acc(ac);
    gemm_tile_glds(p.xn, D, mt * 128, p.w_inT + (size_t)G_B * D, D, nt * 128, D, ac, smem);
#pragma unroll
    for (int m = 0; m < 4; m++)
#pragma unroll
      for (int n = 0; n < 4; n++) {
        sg[m][n][0] = pack2(sigmoidf_(ac[m][n][0]), sigmoidf_(ac[m][n][1]));
        sg[m][n][1] = pack2(sigmoidf_(ac[m][n][2]), sigmoidf_(ac[m][n][3]));
      }
    zero_acc(ac);
    gemm_tile_glds(p.ob, D, mt * 128, p.w_pbT, D, nt * 128, D, ac, smem);
    ACC_FOREACH({
      const unsigned gu = sg[m][n][j >> 1];
      Lt[row * 136 + col] = f2bf(((j & 1) ? bfhi(gu) : bflo(gu)) * ac[m][n][j]);
    })
    __syncthreads();
    {
      const int tid = TIDX;
#pragma unroll
      for (int i = 0; i < 8; i++) {
        const int id = tid + i * 256, row = id >> 4, ch = id & 15;
        u16* gp = p.merged + (size_t)(mt * 128 + row) * D + nt * 128 + ch * 8;
        const uint4 a = *(const uint4*)gp, b = *(const uint4*)(smem + row * 272 + ch * 16);
        uint4 o;
        o.x = pack2(bflo(a.x) + bflo(b.x), bfhi(a.x) + bfhi(b.x));
        o.y = pack2(bflo(a.y) + bflo(b.y), bfhi(a.y) + bfhi(b.y));
        o.z = pack2(bflo(a.z) + bflo(b.z), bfhi(a.z) + bfhi(b.z));
        o.w = pack2(bflo(a.w) + bflo(b.w), bfhi(a.w) + bfhi(b.w));
        *(uint4*)gp = o;
      }
    }
  }
}

constexpr int P7_G = 136 * 8, P7_CV = 16384;
constexpr float U_SCALE = 256.f, V_SCALE = 32.f;
__device__ void phase7(const P& p, int bid, int nb, char* smem) {
  {
    TileIter ti(bid, nb, 136, 8);
    int mt, nt;
    while (ti.next(mt, nt)) {
      f32x4 acc[4][4];
      zero_acc(acc);
      gemm_tile_glds(p.merged, D, mt * 128, p.w_outT, D, nt * 128, D, acc, smem);
      float* Lf = (float*)smem;
      ACC_FOREACH({ Lf[row * 132 + col] = acc[m][n][j]; })
      __syncthreads();
      {
        const int tid = TIDX;
#pragma unroll 4
        for (int i = 0; i < 16; i++) {
          const int id = tid + i * 256, row = id >> 5, c4 = (id & 31) * 4;
          const int nn = mt * 128 + row, c = nt * 128 + c4;
          int seq, t, T; tok2seq(nn, seq, t, T);
          const float4 a = *(const float4*)(Lf + row * 132 + c4);
          const float4 g = *(const float4*)(p.mod + (size_t)seq * 8192 + 2048 + c);
          const float4 x = *(const float4*)(xrow(p, nn) + c);
          *(float4*)(p.out + O_Y + (size_t)nn * D + c) = make_float4(x.x + g.x * a.x, x.y + g.y * a.y, x.z + g.z * a.z, x.w + g.w * a.w);
        }
      }
    }
  }
  for (int it0 = bid; it0 < P7_CV; it0 += 4 * nb) {
    const int tid = TIDX;
    float4 va[4], vb[4];
#pragma unroll
    for (int r = 0; r < 4; r++) {
      const int it = it0 + r * nb;
      if (it < P7_CV) {
        const float* src = it < 8192 ? p.peer_u + (size_t)it * 2048 : p.peer_v + (size_t)(it - 8192) * 2048;
        const float4* s4 = (const float4*)src + tid * 2;
        va[r] = s4[0]; vb[r] = s4[1];
      }
    }
#pragma unroll
    for (int r = 0; r < 4; r++) {
      const int it = it0 + r * nb;
      if (it < P7_CV) {
        unsigned char* dst = it < 8192 ? (unsigned char*)p.ub + (size_t)it * 2048 : (unsigned char*)p.vb + (size_t)(it - 8192) * 2048;
        const float sc = it < 8192 ? U_SCALE : V_SCALE;
        const float4 a = va[r], b = vb[r];
        int lo = __builtin_amdgcn_cvt_pk_fp8_f32(a.x * sc, a.y * sc, 0, false);
        lo = __builtin_amdgcn_cvt_pk_fp8_f32(a.z * sc, a.w * sc, lo, true);
        int hi = __builtin_amdgcn_cvt_pk_fp8_f32(b.x * sc, b.y * sc, 0, false);
        hi = __builtin_amdgcn_cvt_pk_fp8_f32(b.z * sc, b.w * sc, hi, true);
        *((uint2*)dst + tid) = make_uint2((unsigned)lo, (unsigned)hi);
      }
    }
  }
}

__device__ void phase9(const P& p, int bid, int nb, char* smem) {
  const int tid = TIDX, lane = tid & 63, wid = tid >> 6, wr = wid >> 1, wc = wid & 1, fr = lane & 15,
            fq = lane >> 4;
  TileIter ti(bid, nb, 136, 16);
  int mt, nt;
  while (ti.next(mt, nt)) {
    f32x4 acc[4][4];
    zero_acc(acc);
    gemm_tile_glds(p.xn, D, mt * 128, p.wqT, D, nt * 128, D, acc, smem);
    u16* Lq = (u16*)smem;
    ACC_FOREACH({ Lq[row * 136 + col] = f2bf(acc[m][n][j]); })
    __syncthreads();
    f32x4 sc[4][4];
    zero_acc(sc);
    const u16* kb = p.keysb + (size_t)nt * 128 * 128;
#pragma unroll 1
    for (int s = 0; s < 4; s++) {
      bf16x8 af[4], bfr[4];
#pragma unroll
      for (int m = 0; m < 4; m++) af[m] = *(const bf16x8*)((const char*)Lq + (wr * 64 + m * 16 + fr) * 272 + s * 64 + fq * 16);
#pragma unroll
      for (int n = 0; n < 4; n++) bfr[n] = *(const bf16x8*)(kb + (size_t)(wc * 64 + n * 16 + fr) * 128 + s * 32 + fq * 8);
#pragma unroll
      for (int m = 0; m < 4; m++)
#pragma unroll
        for (int n = 0; n < 4; n++) sc[m][n] = __builtin_amdgcn_mfma_f32_16x16x32_bf16(af[m], bfr[n], sc[m][n], 0, 0, 0);
    }
    __syncthreads();
    float* Ls = (float*)smem;
#pragma unroll
    for (int m = 0; m < 4; m++)
#pragma unroll
      for (int n = 0; n < 4; n++)
#pragma unroll
        for (int j = 0; j < 4; j++) Ls[(wr * 64 + m * 16 + fq * 4 + j) * 129 + wc * 64 + n * 16 + fr] = sc[m][n][j];
    __syncthreads();
    {
      const int row = tid >> 1, half = tid & 1;
      float* Lr = Ls + row * 129;
      const size_t ob = ((size_t)(mt * 128 + row) * 16 + nt) * 16;
      for (int r = 0; r < 16; r++) {
        float best = -INFINITY; int bi = 0;
        for (int i = 0; i < 64; i++) {
          const float v = Lr[half + 2 * i];
          if (v > best) { best = v; bi = half + 2 * i; }
        }
        const float ov = __shfl_xor(best, 1, 64);
        const int oi = __shfl_xor(bi, 1, 64);
        if (ov > best || (ov == best && oi < bi)) { best = ov; bi = oi; }
        if ((bi & 1) == half) Lr[bi] = -INFINITY;
        if (half == 0) { p.topv[ob + r] = best; p.topi[ob + r] = bi; }
      }
    }
    __syncthreads();
  }
}

__device__ __forceinline__ void cand_ij(int lane, int& ci, int& cj) {
  int i = 0, rem = lane;
#pragma unroll
  for (int r = 0; r < 16; r++) {
    const int cnt = 16 / (r + 1);
    if (i == r && rem >= cnt) { rem -= cnt; i = r + 1; }
  }
  ci = i; cj = rem;
}

typedef __attribute__((ext_vector_type(2))) __bf16 bf2_t;
__device__ __forceinline__ float dot2bf(unsigned a, unsigned b, float c) {
  return __builtin_amdgcn_fdot2_f32_bf16(__builtin_bit_cast(bf2_t, a), __builtin_bit_cast(bf2_t, b), c, false);
}
template <int CTRL, int RM>
__device__ __forceinline__ float dppf_m(float x) {
  return __int_as_float(__builtin_amdgcn_update_dpp(0, __float_as_int(x), CTRL, RM, 0xf, false));
}
__device__ __forceinline__ float wave_sum_l63(float x) {
  x += dppf<0xB1>(x);
  x += dppf<0x4E>(x);
  x += dppf<0x141>(x);
  x += dppf<0x140>(x);
  x += dppf_m<0x142, 0xA>(x);
  x += dppf_m<0x143, 0xC>(x);
  return x;
}
__device__ __forceinline__ float readlane_f(float x, int l) {
  return __int_as_float(__builtin_amdgcn_readlane(__float_as_int(x), l));
}
__device__ __forceinline__ void axpy8(float* acc, float w, uint4 v) {
  acc[0] += w * bflo(v.x); acc[1] += w * bfhi(v.x); acc[2] += w * bflo(v.y); acc[3] += w * bfhi(v.y);
  acc[4] += w * bflo(v.z); acc[5] += w * bfhi(v.z); acc[6] += w * bflo(v.w); acc[7] += w * bfhi(v.w);
}

typedef float f2_t __attribute__((ext_vector_type(2)));
__device__ __forceinline__ void fp8x16_to_f32(const uint4 v, float* o) {
  const unsigned w[4] = {v.x, v.y, v.z, v.w};
#pragma unroll
  for (int i = 0; i < 4; i++) {
    const f2_t lo = __builtin_amdgcn_cvt_pk_f32_fp8((int)w[i], false);
    const f2_t hi = __builtin_amdgcn_cvt_pk_f32_fp8((int)w[i], true);
    o[4 * i] = lo.x; o[4 * i + 1] = lo.y; o[4 * i + 2] = hi.x; o[4 * i + 3] = hi.y;
  }
}

__device__ void phase10(const P& p, int bid, int nb) {
  const int lane = TIDX & 63, wid = TIDX >> 6;
  int ci, cj; cand_ij(lane < 50 ? lane : 0, ci, cj);
  const unsigned char* ub8 = (const unsigned char*)p.ub;
  const unsigned char* vb8 = (const unsigned char*)p.vb;
  for (int it = bid; it < NT / 4; it += nb) {
    const int n = it * 4 + wid;
    int seq, t, T; tok2seq(n, seq, t, T);
    float xv[16];
    {
      const uint4 a = *(const uint4*)(p.xn + (size_t)n * D + lane * 16), b = *(const uint4*)(p.xn + (size_t)n * D + lane * 16 + 8);
      const unsigned as[4] = {a.x, a.y, a.z, a.w}, bs[4] = {b.x, b.y, b.z, b.w};
#pragma unroll
      for (int e = 0; e < 4; e++) { xv[2 * e] = bflo(as[e]); xv[2 * e + 1] = bfhi(as[e]); xv[8 + 2 * e] = bflo(bs[e]); xv[8 + 2 * e + 1] = bfhi(bs[e]); }
    }
    float acc[16];
#pragma unroll
    for (int e = 0; e < 16; e++) acc[e] = 0.f;
#pragma unroll 1
    for (int h = 0; h < 8; h++) {
      const size_t base = ((size_t)n * 16 + h * 2) * 16;
      float cand = -INFINITY; int eid = 0;
      if (lane < 50) {
        cand = p.topv[base + ci] + p.topv[base + 16 + cj];
        eid = p.topi[base + ci] * 128 + p.topi[base + 16 + cj];
      }
      int rank = 0;
#pragma unroll
      for (int m = 0; m < 50; m++) {
        const float cm = readlane_f(cand, m);
        rank += ((cm > cand) || (cm == cand && m < lane)) ? 1 : 0;
      }
      const bool sel = (lane < 50) && (rank < 16);
      unsigned long long mask = __ballot(sel);
      const float mx = readlane_f(cand, __builtin_ctzll(__ballot(sel && rank == 0)));
      const float ex = sel ? __expf(cand - mx) : 0.f;
      const float den = readlane_f(wave_sum_l63(ex), 63);
      const float gate = ex / den;
#pragma unroll 1
      for (int hf = 0; hf < 2; hf++) {
        int ek[8]; float gk[8];
#pragma unroll
        for (int k = 0; k < 8; k++) {
          const int src = __builtin_ctzll(mask);
          mask &= mask - 1;
          ek[k] = __builtin_amdgcn_readlane(eid, src);
          gk[k] = readlane_f(gate, src);
        }
        uint4 uu[8], vv[8];
#pragma unroll
        for (int j = 0; j < 8; j++) uu[j] = *(const uint4*)(ub8 + (size_t)ek[j] * D + lane * 16);
#pragma unroll
        for (int j = 0; j < 8; j++) vv[j] = *(const uint4*)(vb8 + (size_t)ek[j] * D + lane * 16);
        float dv = 0.f;
#pragma unroll
        for (int j = 0; j < 8; j++) {
          float uf[16];
          fp8x16_to_f32(uu[j], uf);
          float d0 = 0.f, d1 = 0.f;
#pragma unroll
          for (int e = 0; e < 8; e++) { d0 += uf[2 * e] * xv[2 * e]; d1 += uf[2 * e + 1] * xv[2 * e + 1]; }
          const float ds = readlane_f(wave_sum_l63(d0 + d1), 63);
          dv = (lane == j) ? ds : dv;
        }
        dv *= (1.f / U_SCALE);
        const float act = 0.5f * dv * (1.f + erff(dv * 0.70710678118654752f));
#pragma unroll
        for (int j = 0; j < 8; j++) {
          const float w = readlane_f(act, j) * gk[j] * (1.f / V_SCALE);
          float vf[16];
          fp8x16_to_f32(vv[j], vf);
#pragma unroll
          for (int e = 0; e < 16; e++) acc[e] += w * vf[e];
        }
      }
    }
    float* yr = p.out + O_Y + (size_t)n * D + lane * 16;
    const float* md = p.mod + (size_t)seq * 8192 + lane * 16;
    float x2[16];
    float ss = 0.f;
#pragma unroll
    for (int q4 = 0; q4 < 4; q4++) {
      const float4 a = *(const float4*)(yr + q4 * 4), g = *(const float4*)(md + 5120 + q4 * 4);
      x2[q4 * 4 + 0] = a.x + g.x * acc[q4 * 4 + 0]; x2[q4 * 4 + 1] = a.y + g.y * acc[q4 * 4 + 1];
      x2[q4 * 4 + 2] = a.z + g.z * acc[q4 * 4 + 2]; x2[q4 * 4 + 3] = a.w + g.w * acc[q4 * 4 + 3];
    }
#pragma unroll
    for (int e = 0; e < 16; e++) ss += x2[e] * x2[e];
    ss = readlane_f(wave_sum_l63(ss), 63);
    const float rstd = rsqrtf(ss * (1.f / 1024.f) + 1e-6f);
#pragma unroll
    for (int q4 = 0; q4 < 4; q4++) {
      const float4 fg = *(const float4*)(p.final_g + lane * 16 + q4 * 4), sc = *(const float4*)(md + 7168 + q4 * 4),
                   sh = *(const float4*)(md + 6144 + q4 * 4);
      float4 o;
      o.x = x2[q4 * 4 + 0] * rstd * fg.x * (1.f + sc.x) + sh.x;
      o.y = x2[q4 * 4 + 1] * rstd * fg.y * (1.f + sc.y) + sh.y;
      o.z = x2[q4 * 4 + 2] * rstd * fg.z * (1.f + sc.z) + sh.z;
      o.w = x2[q4 * 4 + 3] * rstd * fg.w * (1.f + sc.w) + sh.w;
      *(float4*)(yr + q4 * 4) = o;
    }
  }
}

#define XB_XCNT(j) (256 + 64 * (j))
#define XB_XSUB(j) (1280 + 64 * (j))
#define XB_XGEN(j) (2304 + 64 * (j))
#define XB_TOP 3328
#define XB_TOPGEN 3392
#define XB_WORDS 4096
__device__ __forceinline__ unsigned xb_ld(unsigned* p) { return __hip_atomic_load(p, __ATOMIC_RELAXED, __HIP_MEMORY_SCOPE_AGENT); }
__device__ __forceinline__ unsigned xb_add(unsigned* p, unsigned v) { return __hip_atomic_fetch_add(p, v, __ATOMIC_RELAXED, __HIP_MEMORY_SCOPE_AGENT); }
__device__ __forceinline__ unsigned xb_xcc_id() { return (unsigned)__builtin_amdgcn_s_getreg((3 << 11) | 20) & 0xFu; }
__device__ __forceinline__ void grid_barrier(unsigned* bar, volatile unsigned* xst) {
  asm volatile("s_waitcnt vmcnt(0)" ::: "memory");
  __syncthreads();
  if (TIDX == 0) {
    __builtin_amdgcn_s_waitcnt(0);
    const unsigned x = xst[0], nloc = xst[1], nx = xst[2];
    const unsigned old = xb_add(&bar[XB_XSUB(x)], 1u);
    const unsigned gen = old / nloc;
    if (old + 1u == (gen + 1u) * nloc) {
      __builtin_amdgcn_fence(__ATOMIC_RELEASE, "agent");
      asm volatile("s_waitcnt vmcnt(0)" ::: "memory");
      const unsigned og = xb_add(&bar[XB_TOP], 1u);
      const unsigned tg = og / nx;
      if (og + 1u == (tg + 1u) * nx) xb_add(&bar[XB_TOPGEN], 1u);
      else while (xb_ld(&bar[XB_TOPGEN]) == tg) __builtin_amdgcn_s_sleep(1);
      __builtin_amdgcn_fence(__ATOMIC_ACQUIRE, "agent");
      xb_add(&bar[XB_XGEN(x)], 1u);
      asm volatile("s_waitcnt vmcnt(0)" ::: "memory");
    } else {
      while (xb_ld(&bar[XB_XGEN(x)]) == gen) __builtin_amdgcn_s_sleep(1);
      __builtin_amdgcn_fence(__ATOMIC_ACQUIRE, "agent");
      asm volatile("s_waitcnt vmcnt(0)" ::: "memory");
    }
  }
  __syncthreads();
}

template <int PH>
__device__ __forceinline__ void run_phase(const P& p, int bid, int nb, char* smem) {
  if constexpr (PH == 0) phase0(p, bid, nb, smem);
  if constexpr (PH == 1) phase_norm<false>(p, bid, nb);
  if constexpr (PH == 2) phase2(p, bid, nb, smem);
  if constexpr (PH == 3) phase3(p, bid, nb, smem);
  if constexpr (PH == 4) phase4(p, bid, nb, smem);
  if constexpr (PH == 5) phase5(p, bid, nb);
  if constexpr (PH == 6) phase6(p, bid, nb, smem);
  if constexpr (PH == 7) phase7(p, bid, nb, smem);
  if constexpr (PH == 8) phase_norm<true>(p, bid, nb);
  if constexpr (PH == 9) phase9(p, bid, nb, smem);
  if constexpr (PH == 10) phase10(p, bid, nb);
  if constexpr (PH == 11) phase3b(p, bid, nb, smem);
}

template <int PH>
__global__ void __launch_bounds__(NTHREADS, 2) k_phase(P p) {
  extern __shared__ __attribute__((aligned(16))) char smem[];
  run_phase<PH>(p, blockIdx.x, gridDim.x, smem);
}

#if MEGA
__global__ void __launch_bounds__(NTHREADS, 2) k_mega(P p) {
  extern __shared__ __attribute__((aligned(16))) char smem[];
  cg::grid_group grid = cg::this_grid();
  const int bid = blockIdx.x, nb = gridDim.x;
#ifndef PROBE_ALL2
#define PROBE_ALL2 0
#endif
#ifndef PROBE_MASK
#define PROBE_MASK 0
#endif
#ifndef PROBE_SYNCS
#define PROBE_SYNCS 0
#endif
  volatile unsigned* xst = (volatile unsigned*)(smem + LDS_BYTES - 16);
  if (TIDX == 0) { const unsigned xcc0 = xb_xcc_id(); xst[0] = xcc0; xb_add(&p.bar[XB_XCNT(xcc0)], 1u); }
#define GSYNC(k)                                                                                 \
  {                                                                                              \
    if ((k) == 0) {                                                                              \
      grid.sync();                                                                               \
      if (TIDX == 0) {                                                                    \
        unsigned cnt = 0;                                                                        \
        for (unsigned j = 0; j < 16; ++j) cnt += xb_ld(&p.bar[XB_XCNT(j)]) > 0u ? 1u : 0u;       \
        xst[2] = cnt; xst[1] = xb_ld(&p.bar[XB_XCNT(xst[0])]);                                   \
      }                                                                                          \
    } else grid_barrier(p.bar, xst);                                                             \
  }
#define RUNPH(k)                                                       \
  run_phase<k>(p, bid, nb, smem); GSYNC(k)                             \
  if (PROBE_MASK & (1 << k)) { run_phase<k>(p, bid, nb, smem); GSYNC(1) }
#pragma unroll 1
  for (int rep = 0; rep < 1 + PROBE_ALL2; rep++) {
    RUNPH(0)
#pragma unroll 1
    for (int i = 0; i < PROBE_SYNCS; i++) GSYNC(1)
    RUNPH(1) RUNPH(2) RUNPH(3) RUNPH(11) RUNPH(4) RUNPH(5) RUNPH(6) RUNPH(7) RUNPH(8) RUNPH(9)
  }
  run_phase<10>(p, bid, nb, smem);
}
#endif

template <int PH>
static void launch_phase(const P& p, int grid, hipStream_t stream) {
  static bool attr = false;
  if (!attr) { hipFuncSetAttribute((const void*)k_phase<PH>, hipFuncAttributeMaxDynamicSharedMemorySize, LDS_BYTES); attr = true; }
  hipLaunchKernelGGL(k_phase<PH>, dim3(grid), dim3(NTHREADS), LDS_BYTES, stream, p);
}

extern "C" void kernel_launch(void* const* d_in, const int* in_sizes, int n_in, void* d_out, int out_size, void* d_ws,
                              size_t ws_size, hipStream_t stream) {
  P p{};
  const float** fp = (const float**)&p;
  for (int i = 0; i < 40; i++) fp[i] = (const float*)d_in[i];
  p.out = (float*)d_out;
  char* ws = (char*)d_ws;
  size_t off = 0;
  auto take = [&](size_t bytes) { char* r = ws + off; off += (bytes + 255) & ~(size_t)255; return r; };
  p.bar = (unsigned*)take(XB_WORDS * 4);
  p.w_inT = (u16*)take((size_t)INCOLS * D * 2);
  p.w_paT = (u16*)take((size_t)1024 * 512 * 2);
  p.w_pbT = (u16*)take((size_t)1024 * 1024 * 2);
  p.w_outT = (u16*)take((size_t)1024 * 1024 * 2);
  p.wqT = (u16*)take((size_t)2048 * 1024 * 2);
  p.keysb = (u16*)take((size_t)262144 * 2);
  p.mod = (float*)take((size_t)NSEQ * 8192 * 4);
  p.dtb = (float*)take((size_t)NT * 16 * 4);
  p.decb = (float*)take((size_t)NT * 16 * 4);
  p.xn = (u16*)take((size_t)NROWS * D * 2);
  p.proj = (u16*)take((size_t)NROWS * PCOLS * 2);
  p.prep = (u16*)take((size_t)NT * 3584 * 2);
  p.w2T = (u16*)take(512 * 64 * 2);
  p.a2T = (u16*)take(512 * 64 * 2);
  p.g2T = (u16*)take(512 * 128 * 2);
  p.lora = (u16*)take((size_t)NT * 256 * 2);
  if (off > ws_size) { fprintf(stderr, "workspace too small: need %zu have %zu\n", off, ws_size); return; }
  p.merged = p.prep;
  p.ub = p.proj;
  p.vb = p.proj + (size_t)16384 * 1024;
  p.topv = (float*)(p.proj + (size_t)2 * 16384 * 1024);
  p.topi = (int*)(p.topv + (size_t)NT * 256);
  p.xc = (u16*)d_out;
  p.oa = (u16*)d_out;
  p.ob = (u16*)d_out + (size_t)NT * 512;

  static int grid = 0;
  if (!grid) {
    int dev = 0, cus = 0, per_cu = 0;
    hipGetDevice(&dev);
    hipDeviceGetAttribute(&cus, hipDeviceAttributeMultiprocessorCount, dev);
#if MEGA
    hipFuncSetAttribute((const void*)k_mega, hipFuncAttributeMaxDynamicSharedMemorySize, LDS_BYTES);
    hipOccupancyMaxActiveBlocksPerMultiprocessor(&per_cu, k_mega, NTHREADS, LDS_BYTES);
    if (per_cu > 2) per_cu = 2;
#else
    per_cu = 2;
#endif
    if (per_cu < 1) per_cu = 1;
    grid = cus * per_cu;
  }
  hipMemsetAsync(p.mod, 0, (size_t)NSEQ * 8192 * 4, stream);
#if MEGA
  hipMemsetAsync(p.bar, 0, XB_WORDS * 4, stream);
  void* args[] = {&p};
  hipError_t e = hipLaunchCooperativeKernel((void*)k_mega, dim3(grid), dim3(NTHREADS), args, LDS_BYTES, stream);
  if (e != hipSuccess) fprintf(stderr, "cooperative launch failed: %s (grid %d)\n", hipGetErrorString(e), grid);
#else
  launch_phase<0>(p, grid, stream);
  launch_phase<1>(p, grid, stream);
  launch_phase<2>(p, grid, stream);
  launch_phase<3>(p, grid, stream);
  launch_phase<11>(p, grid, stream);
  launch_phase<4>(p, grid, stream);
  launch_phase<5>(p, grid, stream);
  launch_phase<6>(p, grid, stream);
  launch_phase<7>(p, grid, stream);
  launch_phase<8>(p, grid, stream);
  launch_phase<9>(p, grid, stream);
  launch_phase<10>(p, grid, stream);
#endif
}
```

```cpp
#include <hip/hip_runtime.h>
#include <hip/hip_cooperative_groups.h>
#include <cstdio>
namespace cg = cooperative_groups;

#ifndef MEGA
#define MEGA 1
#endif

typedef unsigned short u16;
typedef __attribute__((ext_vector_type(8))) short bf16x8;
typedef __attribute__((ext_vector_type(4))) float f32x4;

__device__ __forceinline__ int opaque_tid() { int t = threadIdx.x; asm volatile("" : "+v"(t)); return t; }
#define TIDX opaque_tid()

constexpr int D = 1024;
constexpr int NP = 16384, NS = 1024, NT = NP + NS, NSEQ = 136;
constexpr int NROWS = NT + 128;
constexpr int PCOLS = 4368;
constexpr int INCOLS = 6416;
constexpr int C_LW = 1536, C_LA = 1600, C_LG = 1664, C_Z = 1792, C_XBC = 2816, C_DT = 4352;
constexpr int G_A = 4368, G_B = 5392;
constexpr size_t O_Y = 0, O_PSHIFT = 17825792, O_PWKV = 17833984, O_PCONV = 18096128, O_PSSM = 18132992,
                 O_SSHIFT = 19181568, O_SWKV = 19312640, O_SCONV = 23506944, O_SSSM = 24096768;
constexpr int LDS_BYTES = 80 * 1024;
constexpr int NTHREADS = 256;

struct P {
  const float *x_prompt, *x_sample, *c_prompt, *c_sample, *state_shift, *state_wkv, *state_conv, *state_ssm;
  const float *w_ada, *b_ada, *norm1_g, *w_in, *rw_mu, *rw_w0, *rw_w2, *rw_a0, *rw_a2, *rw_g2, *rw_k_k, *rw_k_a,
      *rw_r_k, *rw_ln_w, *rw_ln_b;
  const float *conv_w, *conv_b, *dt_bias, *A_log, *D_skip, *ssm_norm_w, *w_pa, *w_pb, *w_out, *norm2_g, *peer_wq,
      *peer_keys, *peer_u, *peer_v, *final_g, *w_ada_f, *b_ada_f;
  float* out;
  u16 *w_inT, *w_paT, *w_pbT, *w_outT, *wqT, *keysb, *xn, *proj, *prep, *merged, *ub, *vb, *xc, *oa, *ob;
  u16 *w2T, *a2T, *g2T, *lora;
  float *mod, *dtb, *decb, *topv;
  int* topi;
  unsigned* bar;
};

__device__ __forceinline__ u16 f2bf(float f) {
  unsigned u = __float_as_uint(f);
  u += 0x7fffu + ((u >> 16) & 1u);
  return (u16)(u >> 16);
}
__device__ __forceinline__ float bf2f(u16 h) { return __uint_as_float(((unsigned)h) << 16); }
__device__ __forceinline__ unsigned pack2(float a, float b) { return (unsigned)f2bf(a) | ((unsigned)f2bf(b) << 16); }
__device__ __forceinline__ float bflo(unsigned u) { return __uint_as_float(u << 16); }
__device__ __forceinline__ float bfhi(unsigned u) { return __uint_as_float(u & 0xffff0000u); }
__device__ __forceinline__ float sigmoidf_(float x) { return 1.f / (1.f + __expf(-x)); }
__device__ __forceinline__ float siluf_(float x) { return x / (1.f + __expf(-x)); }
__device__ __forceinline__ float softplusf_(float x) { return x > 20.f ? x : log1pf(expf(x)); }

template <int CTRL>
__device__ __forceinline__ float dppf(float x) {
  return __int_as_float(__builtin_amdgcn_update_dpp(0, __float_as_int(x), CTRL, 0xf, 0xf, true));
}
__device__ __forceinline__ float allreduce16(float x) {
  x += dppf<0x128>(x);
  x += dppf<0x124>(x);
  x += dppf<0x122>(x);
  x += dppf<0x121>(x);
  return x;
}
__device__ __forceinline__ float allreduce8(float x) {
  x += dppf<0xB1>(x);
  x += dppf<0x4E>(x);
  x += dppf<0x141>(x);
  return x;
}
__device__ __forceinline__ float wave_sum(float x) {
#pragma unroll
  for (int o = 32; o >= 1; o >>= 1) x += __shfl_xor(x, o, 64);
  return x;
}
__device__ __forceinline__ float wave_max(float x) {
#pragma unroll
  for (int o = 32; o >= 1; o >>= 1) x = fmaxf(x, __shfl_xor(x, o, 64));
  return x;
}
__device__ __forceinline__ int wave_min_i(int x) {
#pragma unroll
  for (int o = 32; o >= 1; o >>= 1) x = min(x, __shfl_xor(x, o, 64));
  return x;
}

__device__ __forceinline__ const float* xrow(const P& p, int n) {
  return n < NP ? p.x_prompt + (size_t)n * D : p.x_sample + (size_t)(n - NP) * D;
}
__device__ __forceinline__ void tok2seq(int n, int& seq, int& t, int& T) {
  if (n < NP) { seq = n >> 11; t = n & 2047; T = 2048; }
  else { int m = n - NP; seq = 8 + (m >> 3); t = m & 7; T = 8; }
}
__device__ __forceinline__ float* seq_out(float* out, int seq, size_t op, size_t os, size_t per) {
  return seq < 8 ? out + op + (size_t)seq * per : out + os + (size_t)(seq - 8) * per;
}

constexpr int LROW = 144;
template <bool DEEP = true>
__device__ __forceinline__ void gemm_tile(const u16* __restrict__ A, int lda, int m0, const u16* __restrict__ Bt,
                                          int ldb, int n0, int K, f32x4 (&acc)[4][4], char* smem) {
  char* sA = smem;
  char* sB = smem + 128 * LROW;
  const int tid = TIDX, lane = tid & 63, wid = tid >> 6, wr = wid >> 1, wc = wid & 1, fr = lane & 15,
            fq = lane >> 4;
  uint4 ra0, ra1, ra2, ra3, rb0, rb1, rb2, rb3;
  uint4 sa0, sa1, sa2, sa3, sb0, sb1, sb2, sb3;
  const int nk = K / 64;
  const int lrow = tid >> 3, lch = tid & 7;
  const u16* gA = A + (size_t)(m0 + lrow) * lda + lch * 8;
  const u16* gB = Bt + (size_t)(n0 + lrow) * ldb + lch * 8;
#define GLOAD(x0, x1, x2, x3, y0, y1, y2, y3, kt)                   \
  {                                                                 \
    x0 = *(const uint4*)(gA + (kt) * 64);                           \
    x1 = *(const uint4*)(gA + (size_t)32 * lda + (kt) * 64);        \
    x2 = *(const uint4*)(gA + (size_t)64 * lda + (kt) * 64);        \
    x3 = *(const uint4*)(gA + (size_t)96 * lda + (kt) * 64);        \
    y0 = *(const uint4*)(gB + (kt) * 64);                           \
    y1 = *(const uint4*)(gB + (size_t)32 * ldb + (kt) * 64);        \
    y2 = *(const uint4*)(gB + (size_t)64 * ldb + (kt) * 64);        \
    y3 = *(const uint4*)(gB + (size_t)96 * ldb + (kt) * 64);        \
  }
#define LSTORE(x0, x1, x2, x3, y0, y1, y2, y3)                      \
  {                                                                 \
    char* wa = sA + lrow * LROW + lch * 16;                         \
    char* wb = sB + lrow * LROW + lch * 16;                         \
    *(uint4*)(wa) = x0; *(uint4*)(wa + 32 * LROW) = x1; *(uint4*)(wa + 64 * LROW) = x2; *(uint4*)(wa + 96 * LROW) = x3; \
    *(uint4*)(wb) = y0; *(uint4*)(wb + 32 * LROW) = y1; *(uint4*)(wb + 64 * LROW) = y2; *(uint4*)(wb + 96 * LROW) = y3; \
  }
#define COMPUTE_TILE()                                                                                                   \
  {                                                                                                                      \
    _Pragma("unroll") for (int s = 0; s < 2; s++) {                                                                      \
      bf16x8 af[4], bfr[4];                                                                                              \
      _Pragma("unroll") for (int m = 0; m < 4; m++) af[m] = *(const bf16x8*)(sA + (wr * 64 + m * 16 + fr) * LROW + s * 64 + fq * 16); \
      _Pragma("unroll") for (int n = 0; n < 4; n++) bfr[n] = *(const bf16x8*)(sB + (wc * 64 + n * 16 + fr) * LROW + s * 64 + fq * 16); \
      _Pragma("unroll") for (int m = 0; m < 4; m++)                                                                      \
        _Pragma("unroll") for (int n = 0; n < 4; n++) acc[m][n] = __builtin_amdgcn_mfma_f32_16x16x32_bf16(af[m], bfr[n], acc[m][n], 0, 0, 0); \
    }                                                                                                                    \
  }
  GLOAD(ra0, ra1, ra2, ra3, rb0, rb1, rb2, rb3, 0);
  if constexpr (DEEP) {
    GLOAD(sa0, sa1, sa2, sa3, sb0, sb1, sb2, sb3, 1);
#pragma unroll 1
    for (int kt = 0; kt < nk; kt += 2) {
      __syncthreads();
      LSTORE(ra0, ra1, ra2, ra3, rb0, rb1, rb2, rb3);
      __syncthreads();
      if (kt + 2 < nk) GLOAD(ra0, ra1, ra2, ra3, rb0, rb1, rb2, rb3, kt + 2);
      COMPUTE_TILE();
      __syncthreads();
      LSTORE(sa0, sa1, sa2, sa3, sb0, sb1, sb2, sb3);
      __syncthreads();
      if (kt + 3 < nk) GLOAD(sa0, sa1, sa2, sa3, sb0, sb1, sb2, sb3, kt + 3);
      COMPUTE_TILE();
    }
  } else {
#pragma unroll 1
    for (int kt = 0; kt < nk; kt++) {
      __syncthreads();
      LSTORE(ra0, ra1, ra2, ra3, rb0, rb1, rb2, rb3);
      __syncthreads();
      if (kt + 1 < nk) GLOAD(ra0, ra1, ra2, ra3, rb0, rb1, rb2, rb3, kt + 1);
      COMPUTE_TILE();
    }
  }
  __syncthreads();
}
#define GL_RAW_BARRIER() { asm volatile("s_waitcnt vmcnt(0)" ::: "memory"); asm volatile("s_waitcnt lgkmcnt(0)" ::: "memory"); __builtin_amdgcn_s_barrier(); }
__device__ __forceinline__ void gemm_tile_glds(const u16* __restrict__ A, int lda, int m0, const u16* __restrict__ Bt,
                                               int ldb, int n0, int K, f32x4 (&acc)[4][4], char* smem) {
  const int tid = TIDX, lane = tid & 63, wid = tid >> 6, wr = wid >> 1, wc = wid & 1, fr = lane & 15, fq = lane >> 4;
  const int nk = K / 64;
  const int srow = tid >> 3, sc = (tid & 7) ^ ((srow >> 1) & 7);
  const u16* gA = A + (size_t)(m0 + srow) * lda + sc * 8;
  const u16* gB = Bt + (size_t)(n0 + srow) * ldb + sc * 8;
  char* const lbase = smem + tid * 16;
  const int swz = (fr >> 1) & 7;
  const int aoff = (wr * 64 + fr) * 128, boff = 16384 + (wc * 64 + fr) * 128;
#define GL_STAGE(buf, kt)                                                                                         \
  {                                                                                                               \
    _Pragma("unroll") for (int i = 0; i < 4; i++) {                                                               \
      __builtin_amdgcn_global_load_lds((const unsigned*)(gA + (size_t)(32 * i) * lda + (kt) * 64),               \
                                       (unsigned*)(lbase + (buf) * 32768 + i * 4096), 16, 0, 0);                  \
      __builtin_amdgcn_global_load_lds((const unsigned*)(gB + (size_t)(32 * i) * ldb + (kt) * 64),               \
                                       (unsigned*)(lbase + (buf) * 32768 + 16384 + i * 4096), 16, 0, 0);          \
    }                                                                                                             \
  }
#define GL_COMPUTE(buf)                                                                                           \
  {                                                                                                               \
    const char* pb = smem + (buf) * 32768;                                                                        \
    _Pragma("unroll") for (int s = 0; s < 2; s++) {                                                               \
      bf16x8 af[4], bfr[4];                                                                                       \
      const int so = ((s * 4 + fq) ^ swz) * 16;                                                                   \
      _Pragma("unroll") for (int m = 0; m < 4; m++) af[m] = *(const bf16x8*)(pb + aoff + m * 2048 + so);          \
      _Pragma("unroll") for (int n = 0; n < 4; n++) bfr[n] = *(const bf16x8*)(pb + boff + n * 2048 + so);         \
      _Pragma("unroll") for (int m = 0; m < 4; m++)                                                               \
        _Pragma("unroll") for (int n = 0; n < 4; n++)                                                             \
          acc[m][n] = __builtin_amdgcn_mfma_f32_16x16x32_bf16(af[m], bfr[n], acc[m][n], 0, 0, 0);                 \
    }                                                                                                             \
  }
  __syncthreads();
  GL_STAGE(0, 0)
  GL_RAW_BARRIER()
#pragma unroll 1
  for (int kt = 0; kt < nk; kt += 2) {
    if (kt + 1 < nk) GL_STAGE(1, kt + 1)
    GL_COMPUTE(0)
    GL_RAW_BARRIER()
    if (kt + 1 < nk) {
      if (kt + 2 < nk) GL_STAGE(0, kt + 2)
      GL_COMPUTE(1)
      GL_RAW_BARRIER()
    }
  }
}
__device__ __forceinline__ void zero_acc(f32x4 (&acc)[4][4]) {
#pragma unroll
  for (int m = 0; m < 4; m++)
#pragma unroll
    for (int n = 0; n < 4; n++) acc[m][n] = f32x4{0.f, 0.f, 0.f, 0.f};
}
#define ACC_FOREACH(...)                                                                    \
  {                                                                                         \
    const int _l = TIDX & 63, _w = TIDX >> 6, _wr = _w >> 1, _wc = _w & 1;    \
    const int _fr = _l & 15, _fq = _l >> 4;                                                 \
    _Pragma("unroll") for (int m = 0; m < 4; m++) _Pragma("unroll") for (int n = 0; n < 4; n++) \
        _Pragma("unroll") for (int j = 0; j < 4; j++) {                                     \
      const int row = _wr * 64 + m * 16 + _fq * 4 + j, col = _wc * 64 + n * 16 + _fr;       \
      __VA_ARGS__                                                                           \
    }                                                                                       \
  }

struct TileIter {
  int x, lb, nbx, tpx, total, MT, NT, r;
  __device__ __forceinline__ TileIter(int bid, int nb, int MT_, int NT_) : MT(MT_), NT(NT_), r(0) {
    total = MT * NT; x = bid & 7; lb = bid >> 3; nbx = nb >> 3; tpx = (total + 7) >> 3;
  }
  __device__ __forceinline__ bool next(int& mt, int& nt) {
    const int idx = lb + r * nbx;
    r++;
    if (idx >= tpx) return false;
    const int lin = x * tpx + idx;
    if (lin >= total) return false;
    const int bsz = 8 * NT, band = lin / bsz, rem = lin - band * bsz;
    const int mb = min(8, MT - band * 8);
    nt = rem / mb; mt = band * 8 + (rem - nt * mb);
    return true;
  }
};

__device__ __forceinline__ void tile_out_bf16(const char* smem, u16* __restrict__ C, size_t ldc, int m0, int n0, int ncols_valid) {
  __syncthreads();
  const int tid = TIDX;
#pragma unroll
  for (int i = 0; i < 8; i++) {
    const int id = tid + i * 256, row = id >> 4, ch = id & 15;
    if (ch * 8 < ncols_valid) *(uint4*)(C + (size_t)(m0 + row) * ldc + n0 + ch * 8) = *(const uint4*)(smem + row * 272 + ch * 16);
  }
}

__device__ void transpose_tile(const float* __restrict__ src, int K, int N, u16* __restrict__ dst, int tile,
                               char* smem) {
  const int ntn = (N + 63) / 64, kt = tile / ntn, nt = tile % ntn, tid = TIDX;
  float(*s)[65] = (float(*)[65])smem;
  __syncthreads();
#pragma unroll 4
  for (int i = 0; i < 16; i++) {
    int r = (tid >> 6) + 4 * i, n = nt * 64 + (tid & 63);
    s[r][tid & 63] = (n < N) ? src[(size_t)(kt * 64 + r) * N + n] : 0.f;
  }
  __syncthreads();
#pragma unroll 4
  for (int i = 0; i < 8; i++) {
    int nl = (tid >> 5) + 8 * i, n = nt * 64 + nl, kl = (tid & 31) * 2;
    if (n < N) *(unsigned*)(dst + (size_t)n * K + kt * 64 + kl) = pack2(s[kl][nl], s[kl + 1][nl]);
  }
}

__device__ void mod_item(const P& p, int item2, char* smem) {
  const int item = item2 >> 1, kh2 = item2 & 1;
  const int tid = TIDX, j = tid & 31, g = tid >> 5;
  const int col0 = item * 32;
  const float* W; const float* bias; int N, cw;
  if (col0 < 6144) { W = p.w_ada; bias = p.b_ada; N = 6144; cw = col0; }
  else { W = p.w_ada_f; bias = p.b_ada_f; N = 2048; cw = col0 - 6144; }
  float(*cs)[68] = (float(*)[68])smem;
  float acc[17];
#pragma unroll
  for (int s = 0; s < 17; s++) acc[s] = 0.f;
  for (int k0 = kh2 * 512; k0 < kh2 * 512 + 512; k0 += 64) {
    __syncthreads();
    {
      float cv[34];
#pragma unroll
      for (int i = 0; i < 34; i++) {
        const int idx = tid + i * 256, seq = idx >> 6, kk = idx & 63;
        cv[i] = seq < 8 ? p.c_prompt[seq * 1024 + k0 + kk] : p.c_sample[(seq - 8) * 1024 + k0 + kk];
      }
#pragma unroll
      for (int i = 0; i < 34; i++) {
        const int idx = tid + i * 256;
        cs[idx >> 6][idx & 63] = siluf_(cv[i]);
      }
    }
    __syncthreads();
#pragma unroll 1
    for (int kh = 0; kh < 2; kh++) {
      float wv[32];
#pragma unroll
      for (int k = 0; k < 32; k++) wv[k] = W[(size_t)(k0 + kh * 32 + k) * N + cw + j];
#pragma unroll 2
      for (int k4 = 0; k4 < 8; k4++) {
#pragma unroll
        for (int s = 0; s < 17; s++) {
          float4 c4 = *(const float4*)&cs[g * 17 + s][kh * 32 + k4 * 4];
          acc[s] += wv[k4 * 4] * c4.x + wv[k4 * 4 + 1] * c4.y + wv[k4 * 4 + 2] * c4.z + wv[k4 * 4 + 3] * c4.w;
        }
      }
    }
  }
  const float b = kh2 == 0 ? bias[cw + j] : 0.f;
#pragma unroll
  for (int s = 0; s < 17; s++) atomicAdd(&p.mod[(size_t)(g * 17 + s) * 8192 + col0 + j], acc[s] + b);
}

constexpr int J_MOD = 512, J_WIN = 16 * 101, J_WPA = 8 * 16, J_WPB = 256, J_WOUT = 256, J_WQ = 16 * 32, J_KEYS = 128,
              J_SHIFT = 64;
constexpr int J_LORA = 8 + 8 + 16;
constexpr int PH0_ITEMS = J_MOD + J_WIN + J_WPA + J_WPB + J_WOUT + J_WQ + J_LORA + J_KEYS + J_SHIFT;

__device__ void phase0(const P& p, int bid, int nb, char* smem) {
  for (int it = bid; it < PH0_ITEMS; it += nb) {
    int i = it;
    if (i < J_MOD) { mod_item(p, i, smem); continue; }
    i -= J_MOD;
    if (i < J_WIN) { transpose_tile(p.w_in, 1024, INCOLS, p.w_inT, i, smem); continue; }
    i -= J_WIN;
    if (i < J_WPA) { transpose_tile(p.w_pa, 512, 1024, p.w_paT, i, smem); continue; }
    i -= J_WPA;
    if (i < J_WPB) { transpose_tile(p.w_pb, 1024, 1024, p.w_pbT, i, smem); continue; }
    i -= J_WPB;
    if (i < J_WOUT) { transpose_tile(p.w_out, 1024, 1024, p.w_outT, i, smem); continue; }
    i -= J_WOUT;
    if (i < J_WQ) { transpose_tile(p.peer_wq, 1024, 2048, p.wqT, i, smem); continue; }
    i -= J_WQ;
    if (i < 8) { transpose_tile(p.rw_w2, 64, 512, p.w2T, i, smem); continue; }
    if (i < 16) { transpose_tile(p.rw_a2, 64, 512, p.a2T, i - 8, smem); continue; }
    if (i < 32) { transpose_tile(p.rw_g2, 128, 512, p.g2T, i - 16, smem); continue; }
    i -= J_LORA;
    const float* src; u16* dst;
    if (i < J_KEYS) { src = p.peer_keys + (size_t)i * 2048; dst = p.keysb + (size_t)i * 2048; }
    else { i -= J_KEYS; src = p.state_shift + (size_t)i * 2048; dst = p.xn + (size_t)NT * D + (size_t)i * 2048; }
    const float4* s4 = (const float4*)src + TIDX * 2;
    float4 a = s4[0], b = s4[1];
    uint4 o; o.x = pack2(a.x, a.y); o.y = pack2(a.z, a.w); o.z = pack2(b.x, b.y); o.w = pack2(b.z, b.w);
    *((uint4*)dst + TIDX) = o;
  }
}

template <bool SECOND>
__device__ void phase_norm(const P& p, int bid, int nb) {
  const int lane = TIDX & 63, wid = TIDX >> 6;
  const float* gam = SECOND ? p.norm2_g : p.norm1_g;
  for (int it = bid; it < NT / 8; it += nb) {
    const int nA = it * 8 + wid * 2;
    float4 v[2][4];
#pragma unroll
    for (int k = 0; k < 2; k++) {
      const int n = nA + k;
      const float* xr = SECOND ? p.out + O_Y + (size_t)n * D : xrow(p, n);
#pragma unroll
      for (int i = 0; i < 4; i++) v[k][i] = ((const float4*)xr)[lane + 64 * i];
    }
#pragma unroll
    for (int k = 0; k < 2; k++) {
      const int n = nA + k;
      int seq, t, T; tok2seq(n, seq, t, T);
      const float* md = p.mod + (size_t)seq * 8192 + (SECOND ? 3072 : 0);
      float ss = 0.f;
#pragma unroll
      for (int i = 0; i < 4; i++)
        ss += v[k][i].x * v[k][i].x + v[k][i].y * v[k][i].y + v[k][i].z * v[k][i].z + v[k][i].w * v[k][i].w;
      ss = wave_sum(ss);
      const float rstd = rsqrtf(ss * (1.f / 1024.f) + 1e-6f);
      const bool last = (!SECOND) && (t == T - 1);
      float* so = seq_out(p.out, seq, O_PSHIFT, O_SSHIFT, 1024);
#pragma unroll
      for (int i = 0; i < 4; i++) {
        const int c = (lane + 64 * i) * 4;
        const float4 g = *(const float4*)(gam + c), sh = *(const float4*)(md + c), sc = *(const float4*)(md + 1024 + c);
        float4 o;
        o.x = v[k][i].x * rstd * g.x * (1.f + sc.x) + sh.x;
        o.y = v[k][i].y * rstd * g.y * (1.f + sc.y) + sh.y;
        o.z = v[k][i].z * rstd * g.z * (1.f + sc.z) + sh.z;
        o.w = v[k][i].w * rstd * g.w * (1.f + sc.w) + sh.w;
        uint2 pk; pk.x = pack2(o.x, o.y); pk.y = pack2(o.z, o.w);
        *(uint2*)(p.xn + (size_t)n * D + c) = pk;
        if (last) *(float4*)(so + c) = o;
      }
    }
  }
}

constexpr int P2_NT = 35, P2_MT = 137;
__device__ void phase2(const P& p, int bid, int nb, char* smem) {
  TileIter ti(bid, nb, P2_MT, P2_NT);
  int mt, nt;
  while (ti.next(mt, nt)) {
    f32x4 acc[4][4];
    zero_acc(acc);
    gemm_tile_glds(p.xn, D, mt * 128, p.w_inT, D, nt * 128, D, acc, smem);
    u16* Lt = (u16*)smem;
    ACC_FOREACH({ Lt[row * 136 + col] = f2bf(acc[m][n][j]); })
    tile_out_bf16(smem, p.proj, PCOLS, mt * 128, nt * 128, PCOLS - nt * 128);
  }
}

__device__ void rwkv_lerp_item(const P& p, int item) {
  const int tid = TIDX;
  const int n0 = item * 8;
  int seq, t0, T; tok2seq(n0, seq, t0, T);
  uint4 pcv[7], ppv[7];
#pragma unroll
  for (int i = 0; i < 7; i++) {
    const int idx = tid + i * 256, tok = idx / 224, c = (idx % 224) * 8;
    const int n = n0 + tok, t = t0 + tok;
    pcv[i] = *(const uint4*)(p.proj + (size_t)n * PCOLS + c);
    const size_t prow = t > 0 ? (size_t)(n - 1) : (size_t)(NT + (seq >= 8 ? seq - 8 : 0));
    ppv[i] = *(const uint4*)(p.proj + prow * PCOLS + c);
    if (t == 0 && seq < 8) ppv[i] = make_uint4(0, 0, 0, 0);
  }
#pragma unroll
  for (int i = 0; i < 7; i++) {
    const int idx = tid + i * 256, tok = idx / 224, c = (idx % 224) * 8;
    const int n = n0 + tok;
    const float4 mu0 = *(const float4*)(p.rw_mu + c), mu1 = *(const float4*)(p.rw_mu + c + 4);
    const float mus[8] = {mu0.x, mu0.y, mu0.z, mu0.w, mu1.x, mu1.y, mu1.z, mu1.w};
    const unsigned pcs[4] = {pcv[i].x, pcv[i].y, pcv[i].z, pcv[i].w}, pps[4] = {ppv[i].x, ppv[i].y, ppv[i].z, ppv[i].w};
    unsigned o[4];
#pragma unroll
    for (int e = 0; e < 4; e++) {
      float a0 = bflo(pcs[e]), a1 = bfhi(pcs[e]), b0 = bflo(pps[e]), b1 = bfhi(pps[e]);
      float q0 = a0 + (b0 - a0) * mus[2 * e], q1 = a1 + (b1 - a1) * mus[2 * e + 1];
      if (c >= C_LW && c < C_LA) { q0 = tanhf(q0); q1 = tanhf(q1); }
      else if (c >= C_LG) { q0 = sigmoidf_(q0); q1 = sigmoidf_(q1); }
      o[e] = pack2(q0, q1);
    }
    u16* dst;
    if (c < 512) dst = p.prep + (size_t)n * 3584 + 512 + c;
    else if (c < 1024) dst = p.prep + (size_t)n * 3584 + 1024 + (c - 512);
    else if (c < 1536) dst = p.prep + (size_t)n * 3584 + 2560 + (c - 1024);
    else dst = p.lora + (size_t)n * 256 + (c - 1536);
    *(uint4*)dst = make_uint4(o[0], o[1], o[2], o[3]);
  }
}

__device__ void rwkv_lora_item(const P& p, int mt, int nt, char* smem) {
  const int tid = TIDX, lane = tid & 63, wid = tid >> 6, wr = wid >> 1, wc = wid & 1, fr = lane & 15, fq = lane >> 4;
  const int col0 = nt * 128;
  f32x4 acc[4][4];
  zero_acc(acc);
  gemm_tile_glds(p.lora, 256, mt * 128, p.w2T, 64, col0, 64, acc, smem);
  ACC_FOREACH({
    const int gc = col0 + col;
    const float wpre = p.rw_w0[gc] + acc[m][n][j];
    const float w = -softplusf_(-wpre) - 0.5f;
    p.prep[(size_t)(mt * 128 + row) * 3584 + gc] = f2bf(-expf(w));
  })
  zero_acc(acc);
  gemm_tile_glds(p.lora + 128, 256, mt * 128, p.g2T, 128, col0, 128, acc, smem);
  ACC_FOREACH({ p.prep[(size_t)(mt * 128 + row) * 3584 + 3072 + col0 + col] = f2bf(acc[m][n][j]); })
  zero_acc(acc);
  gemm_tile_glds(p.lora + 64, 256, mt * 128, p.a2T, 64, col0, 64, acc, smem);
  float a0c[4], kkc[4], kac[4];
#pragma unroll
  for (int n = 0; n < 4; n++) {
    const int gc = col0 + wc * 64 + n * 16 + fr;
    a0c[n] = p.rw_a0[gc]; kkc[n] = p.rw_k_k[gc]; kac[n] = p.rw_k_a[gc];
  }
#pragma unroll
  for (int m = 0; m < 4; m++)
#pragma unroll
    for (int j = 0; j < 4; j++) {
      const int row = mt * 128 + wr * 64 + m * 16 + fq * 4 + j;
      u16* pr = p.prep + (size_t)row * 3584 + col0 + wc * 64 + fr;
      float kx[4], kkv[4], av[4];
      float ss = 0.f;
#pragma unroll
      for (int n = 0; n < 4; n++) {
        kx[n] = bf2f(pr[1024 + n * 16]);
        av[n] = sigmoidf_(a0c[n] + acc[m][n][j]);
        kkv[n] = kx[n] * kkc[n];
        ss += kkv[n] * kkv[n];
      }
      ss = allreduce16(ss);
      const float inv = 1.f / fmaxf(sqrtf(ss), 1e-12f);
#pragma unroll
      for (int n = 0; n < 4; n++) {
        const float kk = kkv[n] * inv;
        pr[1024 + n * 16] = f2bf(kx[n] * (1.f + (av[n] - 1.f) * kac[n]));
        pr[1536 + n * 16] = f2bf(kk);
        pr[2048 + n * 16] = f2bf(kk * av[n]);
      }
    }
}

__device__ void conv_prep_item(const P& p, int item) {
  const int tid = TIDX;
  const int n0 = item * 8;
  int seq, t0, T; tok2seq(n0, seq, t0, T);
  if (tid < 192) {
    const int c = tid * 8;
    uint4 rows[11];
#pragma unroll
    for (int j = 0; j < 11; j++) {
      const int tt = t0 - 3 + j;
      rows[j] = make_uint4(0, 0, 0, 0);
      if (tt >= 0) rows[j] = *(const uint4*)(p.proj + (size_t)(n0 - 3 + j) * PCOLS + C_XBC + c);
      else if (seq >= 8) {
        const float* sc = p.state_conv + ((size_t)(seq - 8) * 3 + (tt + 3)) * 1536 + c;
        const float4 a = *(const float4*)sc, b = *(const float4*)(sc + 4);
        rows[j] = make_uint4(pack2(a.x, a.y), pack2(a.z, a.w), pack2(b.x, b.y), pack2(b.z, b.w));
      }
    }
    float w[4][8], cb[8];
#pragma unroll
    for (int j = 0; j < 4; j++) {
      const float4 a = *(const float4*)(p.conv_w + j * 1536 + c), b = *(const float4*)(p.conv_w + j * 1536 + c + 4);
      w[j][0] = a.x; w[j][1] = a.y; w[j][2] = a.z; w[j][3] = a.w; w[j][4] = b.x; w[j][5] = b.y; w[j][6] = b.z; w[j][7] = b.w;
    }
    {
      const float4 a = *(const float4*)(p.conv_b + c), b = *(const float4*)(p.conv_b + c + 4);
      cb[0] = a.x; cb[1] = a.y; cb[2] = a.z; cb[3] = a.w; cb[4] = b.x; cb[5] = b.y; cb[6] = b.z; cb[7] = b.w;
    }
#pragma unroll
    for (int k = 0; k < 8; k++) {
      float o[8];
#pragma unroll
      for (int e = 0; e < 8; e++) o[e] = cb[e];
#pragma unroll
      for (int j = 0; j < 4; j++) {
        const uint4 r = rows[k + j];
        const unsigned rs[4] = {r.x, r.y, r.z, r.w};
#pragma unroll
        for (int e = 0; e < 4; e++) { o[2 * e] += bflo(rs[e]) * w[j][2 * e]; o[2 * e + 1] += bfhi(rs[e]) * w[j][2 * e + 1]; }
      }
      *(uint4*)(p.xc + (size_t)(n0 + k) * 1536 + c) =
          make_uint4(pack2(siluf_(o[0]), siluf_(o[1])), pack2(siluf_(o[2]), siluf_(o[3])), pack2(siluf_(o[4]), siluf_(o[5])),
                     pack2(siluf_(o[6]), siluf_(o[7])));
    }
    if (t0 + 8 == T) {
      float* co = seq_out(p.out, seq, O_PCONV, O_SCONV, 3 * 1536);
#pragma unroll
      for (int j = 0; j < 3; j++) {
        const uint4 r = rows[8 + j];
        *(float4*)(co + j * 1536 + c) = make_float4(bflo(r.x), bfhi(r.x), bflo(r.y), bfhi(r.y));
        *(float4*)(co + j * 1536 + c + 4) = make_float4(bflo(r.z), bfhi(r.z), bflo(r.w), bfhi(r.w));
      }
    }
  } else if (tid < 192 + 32) {
    const int i = tid - 192;
#pragma unroll
    for (int e = 0; e < 4; e++) {
      const int pi = i * 4 + e, k = pi >> 4, h = pi & 15, n = n0 + k;
      const float raw = bf2f(p.proj[(size_t)n * PCOLS + C_DT + h]) + p.dt_bias[h];
      const float dt = softplusf_(raw);
      const float dA = -dt * expf(p.A_log[h]);
      p.dtb[n * 16 + h] = dt;
      p.decb[n * 16 + h] = dA;
    }
  }
}

__device__ void phase3(const P& p, int bid, int nb, char* smem) {
  for (int it = bid; it < 2 * (NT / 8); it += nb) {
    if (it < NT / 8) rwkv_lerp_item(p, it);
    else conv_prep_item(p, it - NT / 8);
  }
}
__device__ void phase3b(const P& p, int bid, int nb, char* smem) {
  for (int it = bid; it < 136 * 4; it += nb) rwkv_lora_item(p, it >> 2, it & 3, smem);
}

constexpr int TC = 32;
__device__ __forceinline__ void bf8_to_f(uint4 u, float4& lo, float4& hi) {
  lo = make_float4(bflo(u.x), bfhi(u.x), bflo(u.y), bfhi(u.y));
  hi = make_float4(bflo(u.z), bfhi(u.z), bflo(u.w), bfhi(u.w));
}
__device__ void rwkv_scan_item(const P& p, int seq, int h, int qr, char* smem) {
  const int T = seq < 8 ? 2048 : 8, nbase = seq < 8 ? seq * 2048 : NP + (seq - 8) * 8;
  float* Ld = (float*)smem;
  float* Lr = Ld + TC * 64; float* Lk = Lr + TC * 64; float* Lkk = Lk + TC * 64; float* Lb = Lkk + TC * 64;
  float* Lv = Lb + TC * 64;
  const int tid = TIDX, w = tid >> 6, lane = tid & 63, rl = w * 4 + (lane >> 4), ks = lane & 15;
  const int v = qr * 16 + rl;
  float S0 = 0.f, S1 = 0.f, S2 = 0.f, S3 = 0.f;
  if (seq >= 8) {
    float4 s = *(const float4*)(p.state_wkv + (((size_t)(seq - 8) * 8 + h) * 64 + v) * 64 + ks * 4);
    S0 = s.x; S1 = s.y; S2 = s.z; S3 = s.w;
  }
  const int st = tid >> 3, sk8 = (tid & 7) * 8;
  const int vt = tid >> 1, vr8 = (tid & 1) * 8;
  uint4 g0, g1, g2, g3, g4, gv;
  g0 = g1 = g2 = g3 = g4 = gv = make_uint4(0, 0, 0, 0);
#define RW_GLOAD(c0_)                                                                           \
  {                                                                                             \
    const int tcn = min(TC, T - (c0_));                                                         \
    if (st < tcn) {                                                                             \
      const u16* base = p.prep + (size_t)(nbase + (c0_) + st) * 3584 + h * 64 + sk8;            \
      g0 = *(const uint4*)(base); g1 = *(const uint4*)(base + 512); g2 = *(const uint4*)(base + 1024); \
      g3 = *(const uint4*)(base + 1536); g4 = *(const uint4*)(base + 2048);                     \
    }                                                                                           \
    if (tid < 64 && vt < tcn)                                                                   \
      gv = *(const uint4*)(p.prep + (size_t)(nbase + (c0_) + vt) * 3584 + 2560 + h * 64 + qr * 16 + vr8); \
  }
  RW_GLOAD(0);
  for (int c0 = 0; c0 < T; c0 += TC) {
    const int tc = min(TC, T - c0);
    __syncthreads();
    {
      float4 lo, hi;
      bf8_to_f(g0, lo, hi);
      lo.x = __expf(lo.x); lo.y = __expf(lo.y); lo.z = __expf(lo.z); lo.w = __expf(lo.w);
      hi.x = __expf(hi.x); hi.y = __expf(hi.y); hi.z = __expf(hi.z); hi.w = __expf(hi.w);
      *(float4*)(Ld + st * 64 + sk8) = lo; *(float4*)(Ld + st * 64 + sk8 + 4) = hi;
      bf8_to_f(g1, lo, hi); *(float4*)(Lr + st * 64 + sk8) = lo; *(float4*)(Lr + st * 64 + sk8 + 4) = hi;
      bf8_to_f(g2, lo, hi); *(float4*)(Lk + st * 64 + sk8) = lo; *(float4*)(Lk + st * 64 + sk8 + 4) = hi;
      bf8_to_f(g3, lo, hi); *(float4*)(Lkk + st * 64 + sk8) = lo; *(float4*)(Lkk + st * 64 + sk8 + 4) = hi;
      bf8_to_f(g4, lo, hi); *(float4*)(Lb + st * 64 + sk8) = lo; *(float4*)(Lb + st * 64 + sk8 + 4) = hi;
      if (tid < 64) { bf8_to_f(gv, lo, hi); *(float4*)(Lv + vt * 16 + vr8) = lo; *(float4*)(Lv + vt * 16 + vr8 + 4) = hi; }
    }
    __syncthreads();
    if (c0 + TC < T) RW_GLOAD(c0 + TC);
    u16* yo = p.proj + (size_t)(nbase + c0) * PCOLS + h * 64 + v;
    float4 kk0, d0, b0, k0_, r0, kk1, d1, b1, k1_, r1, kk2, d2, b2, k2_, r2, kk3, d3, b3, k3_, r3;
    float v0, v1, v2, v3;
#define RW_LD(KK, DD, BB, KX, RR, VV, t_)                                                        \
  {                                                                                              \
    KK = *(const float4*)(Lkk + (t_) * 64 + ks * 4); DD = *(const float4*)(Ld + (t_) * 64 + ks * 4); \
    BB = *(const float4*)(Lb + (t_) * 64 + ks * 4); KX = *(const float4*)(Lk + (t_) * 64 + ks * 4);  \
    RR = *(const float4*)(Lr + (t_) * 64 + ks * 4); VV = Lv[(t_) * 16 + rl];                      \
  }
#define RW_STEP(KK, DD, BB, KX, RR, VV, YY)                                                      \
  {                                                                                              \
    const float vk0 = VV * KX.x, vk1 = VV * KX.y, vk2 = VV * KX.z, vk3 = VV * KX.w;              \
    float sk = (S0 * KK.x + S1 * KK.y) + (S2 * KK.z + S3 * KK.w);                                \
    sk = allreduce16(sk);                                                                        \
    S0 = S0 * DD.x + (vk0 - sk * BB.x);                                                          \
    S1 = S1 * DD.y + (vk1 - sk * BB.y);                                                          \
    S2 = S2 * DD.z + (vk2 - sk * BB.z);                                                          \
    S3 = S3 * DD.w + (vk3 - sk * BB.w);                                                          \
    YY = allreduce16((S0 * RR.x + S1 * RR.y) + (S2 * RR.z + S3 * RR.w));                         \
  }
    for (int tt = 0; tt < tc; tt += 4) {
      RW_LD(kk0, d0, b0, k0_, r0, v0, tt)
      RW_LD(kk1, d1, b1, k1_, r1, v1, tt + 1)
      RW_LD(kk2, d2, b2, k2_, r2, v2, tt + 2)
      RW_LD(kk3, d3, b3, k3_, r3, v3, tt + 3)
      float y0, y1, y2, y3;
      RW_STEP(kk0, d0, b0, k0_, r0, v0, y0)
      RW_STEP(kk1, d1, b1, k1_, r1, v1, y1)
      RW_STEP(kk2, d2, b2, k2_, r2, v2, y2)
      RW_STEP(kk3, d3, b3, k3_, r3, v3, y3)
      if (ks == 0) {
        u16* yp = yo + (size_t)tt * PCOLS;
        yp[0] = f2bf(y0); yp[PCOLS] = f2bf(y1); yp[2 * (size_t)PCOLS] = f2bf(y2); yp[3 * (size_t)PCOLS] = f2bf(y3);
      }
    }
  }
  float* so = seq_out(p.out, seq, O_PWKV, O_SWKV, 8 * 4096);
  *(float4*)(so + ((size_t)h * 64 + v) * 64 + ks * 4) = make_float4(S0, S1, S2, S3);
}

__device__ void ssm_scan_item(const P& p, int seq, int head, int half, char* smem) {
  const int T = seq < 8 ? 2048 : 8, nbase = seq < 8 ? seq * 2048 : NP + (seq - 8) * 8;
  float* LB = (float*)smem;
  float* LC = LB + TC * 128;
  float* Lx = LC + TC * 128;
  float* Ldt = Lx + TC * 32;
  float* Ldec = Ldt + TC;
  const int tid = TIDX, pl = tid >> 3, ns = tid & 7;
  const int pp = half * 32 + pl, g = head >> 3;
  const float Dk = p.D_skip[head];
  float hs[16];
#pragma unroll
  for (int j = 0; j < 16; j++) hs[j] = 0.f;
  if (seq >= 8) {
    const float4* s4 = (const float4*)(p.state_ssm + (((size_t)(seq - 8) * 16 + head) * 64 + pp) * 128 + ns * 16);
#pragma unroll
    for (int j = 0; j < 4; j++) { float4 s = s4[j]; hs[4 * j] = s.x; hs[4 * j + 1] = s.y; hs[4 * j + 2] = s.z; hs[4 * j + 3] = s.w; }
  }
  uint4 gb0, gb1, gb2, gb3, gx; float gdt = 0.f, gdec = 0.f;
  gb0 = gb1 = gb2 = gb3 = gx = make_uint4(0, 0, 0, 0);
  const int bt = tid >> 5, bch = tid & 31;
  const u16* bsrc = p.xc + 1024 + (bch < 16 ? 0 : 256) + g * 128 + (bch & 15) * 8;
  const int xt = tid >> 2, xr8 = (tid & 3) * 8;
#define SS_GLOAD(c0_)                                                                          \
  {                                                                                            \
    const int tcn = min(TC, T - (c0_));                                                        \
    const size_t nb_ = (size_t)(nbase + (c0_));                                                \
    if (bt < tcn) gb0 = *(const uint4*)(bsrc + (nb_ + bt) * 1536);                             \
    if (bt + 8 < tcn) gb1 = *(const uint4*)(bsrc + (nb_ + bt + 8) * 1536);                     \
    if (bt + 16 < tcn) gb2 = *(const uint4*)(bsrc + (nb_ + bt + 16) * 1536);                   \
    if (bt + 24 < tcn) gb3 = *(const uint4*)(bsrc + (nb_ + bt + 24) * 1536);                   \
    if (tid < 128 && xt < tcn) gx = *(const uint4*)(p.xc + (nb_ + xt) * 1536 + head * 64 + half * 32 + xr8); \
    if (tid < tcn) { gdt = p.dtb[(nb_ + tid) * 16 + head]; gdec = p.decb[(nb_ + tid) * 16 + head]; } \
  }
  SS_GLOAD(0);
  for (int c0 = 0; c0 < T; c0 += TC) {
    const int tc = min(TC, T - c0);
    __syncthreads();
    {
      float* dstb = (bch < 16 ? LB : LC) + (bch & 15) * 8;
      float4 lo, hi;
      bf8_to_f(gb0, lo, hi); *(float4*)(dstb + bt * 128) = lo; *(float4*)(dstb + bt * 128 + 4) = hi;
      bf8_to_f(gb1, lo, hi); *(float4*)(dstb + (bt + 8) * 128) = lo; *(float4*)(dstb + (bt + 8) * 128 + 4) = hi;
      bf8_to_f(gb2, lo, hi); *(float4*)(dstb + (bt + 16) * 128) = lo; *(float4*)(dstb + (bt + 16) * 128 + 4) = hi;
      bf8_to_f(gb3, lo, hi); *(float4*)(dstb + (bt + 24) * 128) = lo; *(float4*)(dstb + (bt + 24) * 128 + 4) = hi;
      if (tid < 128) { bf8_to_f(gx, lo, hi); *(float4*)(Lx + xt * 32 + xr8) = lo; *(float4*)(Lx + xt * 32 + xr8 + 4) = hi; }
      if (tid < TC) { Ldt[tid] = gdt; Ldec[tid] = __expf(gdec); }
    }
    __syncthreads();
    if (c0 + TC < T) SS_GLOAD(c0 + TC);
    u16* yo = p.proj + (size_t)(nbase + c0) * PCOLS + C_XBC + head * 64 + pp;
    float4 B0 = *(const float4*)(LB + ns * 16), B1 = *(const float4*)(LB + ns * 16 + 4), B2 = *(const float4*)(LB + ns * 16 + 8),
           B3 = *(const float4*)(LB + ns * 16 + 12);
    float4 C0 = *(const float4*)(LC + ns * 16), C1 = *(const float4*)(LC + ns * 16 + 4), C2 = *(const float4*)(LC + ns * 16 + 8),
           C3 = *(const float4*)(LC + ns * 16 + 12);
    float xv = Lx[pl], dtv = Ldt[0], dec = Ldec[0];
    for (int tt = 0; tt < tc; tt++) {
      const int tn = min(tt + 1, tc - 1);
      const float* nB = LB + tn * 128 + ns * 16;
      const float* nC = LC + tn * 128 + ns * 16;
      const float4 nB0 = *(const float4*)(nB), nB1 = *(const float4*)(nB + 4), nB2 = *(const float4*)(nB + 8), nB3 = *(const float4*)(nB + 12);
      const float4 nC0 = *(const float4*)(nC), nC1 = *(const float4*)(nC + 4), nC2 = *(const float4*)(nC + 8), nC3 = *(const float4*)(nC + 12);
      const float nxv = Lx[tn * 32 + pl], ndt = Ldt[tn], ndec = Ldec[tn];
      const float dtx = dtv * xv;
      hs[0] = hs[0] * dec + dtx * B0.x; hs[1] = hs[1] * dec + dtx * B0.y; hs[2] = hs[2] * dec + dtx * B0.z; hs[3] = hs[3] * dec + dtx * B0.w;
      hs[4] = hs[4] * dec + dtx * B1.x; hs[5] = hs[5] * dec + dtx * B1.y; hs[6] = hs[6] * dec + dtx * B1.z; hs[7] = hs[7] * dec + dtx * B1.w;
      hs[8] = hs[8] * dec + dtx * B2.x; hs[9] = hs[9] * dec + dtx * B2.y; hs[10] = hs[10] * dec + dtx * B2.z; hs[11] = hs[11] * dec + dtx * B2.w;
      hs[12] = hs[12] * dec + dtx * B3.x; hs[13] = hs[13] * dec + dtx * B3.y; hs[14] = hs[14] * dec + dtx * B3.z; hs[15] = hs[15] * dec + dtx * B3.w;
      float y0 = hs[0] * C0.x + hs[1] * C0.y + hs[2] * C0.z + hs[3] * C0.w;
      float y1 = hs[4] * C1.x + hs[5] * C1.y + hs[6] * C1.z + hs[7] * C1.w;
      float y2 = hs[8] * C2.x + hs[9] * C2.y + hs[10] * C2.z + hs[11] * C2.w;
      float y3 = hs[12] * C3.x + hs[13] * C3.y + hs[14] * C3.z + hs[15] * C3.w;
      float yp = allreduce8((y0 + y1) + (y2 + y3));
      if (ns == 0) yo[(size_t)tt * PCOLS] = f2bf(yp + Dk * xv);
      B0 = nB0; B1 = nB1; B2 = nB2; B3 = nB3; C0 = nC0; C1 = nC1; C2 = nC2; C3 = nC3; xv = nxv; dtv = ndt; dec = ndec;
    }
  }
  float* so = seq_out(p.out, seq, O_PSSM, O_SSSM, 16 * 8192);
  float4* o4 = (float4*)(so + ((size_t)head * 64 + pp) * 128 + ns * 16);
#pragma unroll
  for (int j = 0; j < 4; j++) o4[j] = make_float4(hs[4 * j], hs[4 * j + 1], hs[4 * j + 2], hs[4 * j + 3]);
}

__device__ void ssd_prompt_item(const P& p, int seq, int head, char* smem) {
  const int nbase = seq * 2048, g = head >> 3;
  char* sC = smem;
  char* sB = smem + 17408;
  char* sBT = smem + 34816;
  char* sXT = smem + 53248;
  char* sH = smem + 62464;
  float* sS = (float*)(smem + 79872);
  const int tid = TIDX, lane = tid & 63, w = tid >> 6, fr = lane & 15, q = lane >> 4;
  const float Dk = p.D_skip[head];
  f32x4 H[8];
#pragma unroll
  for (int i = 0; i < 8; i++) H[i] = f32x4{0.f, 0.f, 0.f, 0.f};
  __syncthreads();
  for (int i = tid; i < 17408 / 16; i += 256) *(uint4*)(sH + i * 16) = make_uint4(0, 0, 0, 0);
  uint4 gB0, gB1, gB2, gB3, gC0, gC1, gC2, gC3, gX0, gX1;
  float gdt, gdA;
#define SSD_LOAD(t0_)                                                                         \
  {                                                                                           \
    const size_t nn_ = (size_t)(nbase + (t0_) + lane);                                        \
    const u16* row_ = p.xc + nn_ * 1536;                                                      \
    const u16* rb_ = row_ + 1024 + g * 128 + w * 32;                                          \
    gB0 = *(const uint4*)(rb_); gB1 = *(const uint4*)(rb_ + 8); gB2 = *(const uint4*)(rb_ + 16); gB3 = *(const uint4*)(rb_ + 24); \
    gC0 = *(const uint4*)(rb_ + 256); gC1 = *(const uint4*)(rb_ + 264); gC2 = *(const uint4*)(rb_ + 272); gC3 = *(const uint4*)(rb_ + 280); \
    gX0 = *(const uint4*)(row_ + head * 64 + w * 16); gX1 = *(const uint4*)(row_ + head * 64 + w * 16 + 8); \
    gdt = p.dtb[nn_ * 16 + head]; gdA = p.decb[nn_ * 16 + head];                              \
  }
#define SSD_PUT_T(dst_, r0_, u_, sc_)                                                         \
  {                                                                                           \
    const unsigned us_[4] = {u_.x, u_.y, u_.z, u_.w};                                         \
    _Pragma("unroll") for (int e = 0; e < 4; e++) {                                           \
      *(u16*)(dst_ + ((r0_) + 2 * e) * 144 + lane * 2) = f2bf(bflo(us_[e]) * (sc_));          \
      *(u16*)(dst_ + ((r0_) + 2 * e + 1) * 144 + lane * 2) = f2bf(bfhi(us_[e]) * (sc_));      \
    }                                                                                         \
  }
  SSD_LOAD(0);
#pragma unroll 1
  for (int c = 0; c < 32; c++) {
    const int t0 = c * 64;
    float cs = gdA;
#pragma unroll
    for (int o = 1; o < 64; o <<= 1) { const float v = __shfl_up(cs, o, 64); if (lane >= o) cs += v; }
    const float cs63 = __shfl(cs, 63, 64);
    const float wt = gdt * __expf(cs63 - cs);
    __syncthreads();
    if (w == 0) { sS[lane] = cs; sS[64 + lane] = __expf(cs); sS[128 + lane] = gdt; }
    {
      char* rc = sC + lane * 272 + w * 64;
      char* rb = sB + lane * 272 + w * 64;
      *(uint4*)(rc) = gC0; *(uint4*)(rc + 16) = gC1; *(uint4*)(rc + 32) = gC2; *(uint4*)(rc + 48) = gC3;
      *(uint4*)(rb) = gB0; *(uint4*)(rb + 16) = gB1; *(uint4*)(rb + 32) = gB2; *(uint4*)(rb + 48) = gB3;
      SSD_PUT_T(sBT, w * 32, gB0, wt) SSD_PUT_T(sBT, w * 32 + 8, gB1, wt) SSD_PUT_T(sBT, w * 32 + 16, gB2, wt)
      SSD_PUT_T(sBT, w * 32 + 24, gB3, wt) SSD_PUT_T(sXT, w * 16, gX0, 1.f) SSD_PUT_T(sXT, w * 16 + 8, gX1, 1.f)
    }
    __syncthreads();
    if (c + 1 < 32) SSD_LOAD(t0 + 64);
    f32x4 cb[4], yo[4];
#pragma unroll
    for (int i = 0; i < 4; i++) { cb[i] = f32x4{0.f, 0.f, 0.f, 0.f}; yo[i] = f32x4{0.f, 0.f, 0.f, 0.f}; }
    {
      bf16x8 af[4];
#pragma unroll
      for (int ks = 0; ks < 4; ks++) af[ks] = *(const bf16x8*)(sC + (16 * w + fr) * 272 + ks * 64 + q * 16);
#pragma unroll
      for (int nn = 0; nn < 4; nn++)
#pragma unroll
        for (int ks = 0; ks < 4; ks++) {
          const bf16x8 bb = *(const bf16x8*)(sB + (16 * nn + fr) * 272 + ks * 64 + q * 16);
          cb[nn] = __builtin_amdgcn_mfma_f32_16x16x32_bf16(af[ks], bb, cb[nn], 0, 0, 0);
        }
#pragma unroll
      for (int pt = 0; pt < 4; pt++)
#pragma unroll
        for (int ks = 0; ks < 4; ks++) {
          const bf16x8 bb = *(const bf16x8*)(sH + (16 * pt + fr) * 272 + ks * 64 + q * 16);
          yo[pt] = __builtin_amdgcn_mfma_f32_16x16x32_bf16(af[ks], bb, yo[pt], 0, 0, 0);
        }
    }
    __syncthreads();
#pragma unroll
    for (int j = 0; j < 4; j++) {
      const int l = 16 * w + q * 4 + j;
      const float csl = sS[l];
#pragma unroll
      for (int nn = 0; nn < 4; nn++) {
        const int sidx = 16 * nn + fr;
        const float gv = (sidx <= l) ? cb[nn][j] * __expf(csl - sS[sidx]) * sS[128 + sidx] : 0.f;
        *(u16*)(sB + l * 144 + sidx * 2) = f2bf(gv);
      }
    }
    f32x4 yd[4];
#pragma unroll
    for (int i = 0; i < 4; i++) yd[i] = f32x4{0.f, 0.f, 0.f, 0.f};
#pragma unroll
    for (int ks = 0; ks < 2; ks++) {
      const bf16x8 aa = *(const bf16x8*)(sB + (16 * w + fr) * 144 + ks * 64 + q * 16);
#pragma unroll
      for (int pt = 0; pt < 4; pt++) {
        const bf16x8 bb = *(const bf16x8*)(sXT + (16 * pt + fr) * 144 + ks * 64 + q * 16);
        yd[pt] = __builtin_amdgcn_mfma_f32_16x16x32_bf16(aa, bb, yd[pt], 0, 0, 0);
      }
    }
#pragma unroll
    for (int j = 0; j < 4; j++) {
      const int l = 16 * w + q * 4 + j;
      const float el = sS[64 + l];
      u16* yrow = p.proj + (size_t)(nbase + t0 + l) * PCOLS + C_XBC + head * 64 + fr;
#pragma unroll
      for (int pt = 0; pt < 4; pt++) {
        const float xs = bf2f(*(const u16*)(sXT + (16 * pt + fr) * 144 + l * 2));
        yrow[16 * pt] = f2bf(yd[pt][j] + el * yo[pt][j] + Dk * xs);
      }
    }
    const float ach = __expf(cs63);
#pragma unroll
    for (int nt = 0; nt < 8; nt++) { H[nt][0] *= ach; H[nt][1] *= ach; H[nt][2] *= ach; H[nt][3] *= ach; }
#pragma unroll
    for (int ks = 0; ks < 2; ks++) {
      const bf16x8 aa = *(const bf16x8*)(sXT + (16 * w + fr) * 144 + ks * 64 + q * 16);
#pragma unroll
      for (int nt = 0; nt < 8; nt++) {
        const bf16x8 bb = *(const bf16x8*)(sBT + (16 * nt + fr) * 144 + ks * 64 + q * 16);
        H[nt] = __builtin_amdgcn_mfma_f32_16x16x32_bf16(aa, bb, H[nt], 0, 0, 0);
      }
    }
#pragma unroll
    for (int nt = 0; nt < 8; nt++)
#pragma unroll
      for (int j = 0; j < 4; j++) *(u16*)(sH + (16 * w + q * 4 + j) * 272 + (16 * nt + fr) * 2) = f2bf(H[nt][j]);
  }
  float* so = p.out + O_PSSM + ((size_t)seq * 16 + head) * 8192;
#pragma unroll
  for (int nt = 0; nt < 8; nt++)
#pragma unroll
    for (int j = 0; j < 4; j++) so[(16 * w + q * 4 + j) * 128 + 16 * nt + fr] = H[nt][j];
  __syncthreads();
}

constexpr int P4_RP = 256, P4_SP = 128, P4_RS = 4096, P4_SS = 4096;
#define XB_QUEUE 3600
__device__ void phase4(const P& p, int bid, int nb, char* smem) {
  for (int it = bid; it < P4_RP + P4_SP; it += nb) {
    if (it < P4_RP) rwkv_scan_item(p, it >> 5, (it >> 2) & 7, it & 3, smem);
    else { const int i = it - P4_RP; ssd_prompt_item(p, i >> 4, i & 15, smem); }
  }
  volatile int* slot = (volatile int*)(smem + LDS_BYTES - 32);
  for (;;) {
    __syncthreads();
    if (TIDX == 0) *slot = (int)atomicAdd(&p.bar[XB_QUEUE], 1u);
    __syncthreads();
    int i = *slot;
    if (i >= P4_RS + P4_SS) break;
    if (i < P4_RS) rwkv_scan_item(p, 8 + (i >> 5), (i >> 2) & 7, i & 3, smem);
    else { i -= P4_RS; ssm_scan_item(p, 8 + (i >> 5), (i >> 1) & 15, i & 1, smem); }
  }
}

__device__ void phase5(const P& p, int bid, int nb) {
  const int lane = TIDX & 63, wid = TIDX >> 6;
  for (int it = bid; it < NT / 4; it += nb) {
    const int n = it * 4 + wid;
    const uint4 sy0 = *(const uint4*)(p.proj + (size_t)n * PCOLS + C_XBC + lane * 16);
    const uint4 sy1 = *(const uint4*)(p.proj + (size_t)n * PCOLS + C_XBC + lane * 16 + 8);
    const uint4 sz0 = *(const uint4*)(p.proj + (size_t)n * PCOLS + C_Z + lane * 16);
    const uint4 sz1 = *(const uint4*)(p.proj + (size_t)n * PCOLS + C_Z + lane * 16 + 8);
    {
      const int c = lane * 8;
      uint4 yu = *(const uint4*)(p.proj + (size_t)n * PCOLS + c);
      const u16* pr = p.prep + (size_t)n * 3584 + c;
      uint4 ru = *(const uint4*)(pr + 512), ku = *(const uint4*)(pr + 1024), vu = *(const uint4*)(pr + 2560),
            gu = *(const uint4*)(pr + 3072);
      unsigned ys[4] = {yu.x, yu.y, yu.z, yu.w}, rs[4] = {ru.x, ru.y, ru.z, ru.w}, ks_[4] = {ku.x, ku.y, ku.z, ku.w},
               vs[4] = {vu.x, vu.y, vu.z, vu.w}, gs[4] = {gu.x, gu.y, gu.z, gu.w};
      float y[8], r[8], k[8], v[8], g[8];
#pragma unroll
      for (int e = 0; e < 4; e++) {
        y[2 * e] = bflo(ys[e]); y[2 * e + 1] = bfhi(ys[e]);
        r[2 * e] = bflo(rs[e]); r[2 * e + 1] = bfhi(rs[e]);
        k[2 * e] = bflo(ks_[e]); k[2 * e + 1] = bfhi(ks_[e]);
        v[2 * e] = bflo(vs[e]); v[2 * e + 1] = bfhi(vs[e]);
        g[2 * e] = bflo(gs[e]); g[2 * e + 1] = bfhi(gs[e]);
      }
      float s = 0.f, bn = 0.f;
#pragma unroll
      for (int e = 0; e < 8; e++) { s += y[e]; bn += r[e] * k[e] * p.rw_r_k[c + e]; }
      s = allreduce8(s); bn = allreduce8(bn);
      const float mean = s * (1.f / 64.f);
      float vr = 0.f;
#pragma unroll
      for (int e = 0; e < 8; e++) { const float d = y[e] - mean; vr += d * d; }
      vr = allreduce8(vr) * (1.f / 64.f);
      const float rs_ = rsqrtf(vr + 64e-5f);
      float o[8];
#pragma unroll
      for (int e = 0; e < 8; e++) {
        const float yn = (y[e] - mean) * rs_ * p.rw_ln_w[c + e] + p.rw_ln_b[c + e];
        o[e] = (yn + bn * v[e]) * g[e];
      }
      uint4 ou; ou.x = pack2(o[0], o[1]); ou.y = pack2(o[2], o[3]); ou.z = pack2(o[4], o[5]); ou.w = pack2(o[6], o[7]);
      *(uint4*)(p.oa + (size_t)n * 512 + c) = ou;
    }
    {
      const int c = lane * 16;
      float yv[16];
      float ss = 0.f;
#pragma unroll
      for (int hh = 0; hh < 2; hh++) {
        const uint4 yu = hh ? sy1 : sy0;
        const uint4 zu = hh ? sz1 : sz0;
        unsigned ys[4] = {yu.x, yu.y, yu.z, yu.w}, zs[4] = {zu.x, zu.y, zu.z, zu.w};
#pragma unroll
        for (int e = 0; e < 4; e++) {
          const float a = bflo(ys[e]) * siluf_(bflo(zs[e])), b = bfhi(ys[e]) * siluf_(bfhi(zs[e]));
          yv[hh * 8 + 2 * e] = a; yv[hh * 8 + 2 * e + 1] = b;
          ss += a * a + b * b;
        }
      }
#pragma unroll
      for (int o = 16; o >= 1; o >>= 1) ss += __shfl_xor(ss, o, 64);
      const float rstd = rsqrtf(ss * (1.f / 512.f) + 1e-6f);
      unsigned ou[8];
#pragma unroll
      for (int e = 0; e < 8; e++)
        ou[e] = pack2(yv[2 * e] * rstd * p.ssm_norm_w[c + 2 * e], yv[2 * e + 1] * rstd * p.ssm_norm_w[c + 2 * e + 1]);
      *(uint4*)(p.ob + (size_t)n * 1024 + c) = make_uint4(ou[0], ou[1], ou[2], ou[3]);
      *(uint4*)(p.ob + (size_t)n * 1024 + c + 8) = make_uint4(ou[4], ou[5], ou[6], ou[7]);
    }
  }
}

__device__ void phase6(const P& p, int bid, int nb, char* smem) {
  TileIter ti(bid, nb, 136, 8);
  int mt, nt;
  while (ti.next(mt, nt)) {
    f32x4 ac[4][4];
    unsigned sg[4][4][2];
    u16* Lt = (u16*)smem;
    zero_acc(ac);
    gemm_tile_glds(p.xn, D, mt * 128, p.w_inT + (size_t)G_A * D, D, nt * 128, D, ac, smem);
#pragma unroll
    for (int m = 0; m < 4; m++)
#pragma unroll
      for (int n = 0; n < 4; n++) {
        sg[m][n][0] = pack2(sigmoidf_(ac[m][n][0]), sigmoidf_(ac[m][n][1]));
        sg[m][n][1] = pack2(sigmoidf_(ac[m][n][2]), sigmoidf_(ac[m][n][3]));
      }
    zero_acc(ac);
    gemm_tile_glds(p.oa, 512, mt * 128, p.w_paT, 512, nt * 128, 512, ac, smem);
    ACC_FOREACH({
      const unsigned gu = sg[m][n][j >> 1];
      Lt[row * 136 + col] = f2bf(((j & 1) ? bfhi(gu) : bflo(gu)) * ac[m][n][j]);
    })
    tile_out_bf16(smem, p.merged, D, mt * 128, nt * 128, 128);
    zero_acc(ac);
    gemm_tile_glds(p.xn, D, mt * 128, p.w_inT + (size_t)G_B * D, D, nt * 128, D, ac, smem);
#pragma unroll
    for (int m = 0; m < 4; m++)
#pragma unroll
      for (int n = 0; n < 4; n++) {
        sg[m][n][0] = pack2(sigmoidf_(ac[m][n][0]), sigmoidf_(ac[m][n][1]));
        sg[m][n][1] = pack2(sigmoidf_(ac[m][n][2]), sigmoidf_(ac[m][n][3]));
      }
    zero_acc(ac);
    gemm_tile_glds(p.ob, D, mt * 128, p.w_pbT, D, nt * 128, D, ac, smem);
    ACC_FOREACH({
      const unsigned gu = sg[m][n][j >> 1];
      Lt[row * 136 + col] = f2bf(((j & 1) ? bfhi(gu) : bflo(gu)) * ac[m][n][j]);
    })
    __syncthreads();
    {
      const int tid = TIDX;
#pragma unroll
      for (int i = 0; i < 8; i++) {
        const int id = tid + i * 256, row = id >> 4, ch = id & 15;
        u16* gp = p.merged + (size_t)(mt * 128 + row) * D + nt * 128 + ch * 8;
        const uint4 a = *(const uint4*)gp, b = *(const uint4*)(smem + row * 272 + ch * 16);
        uint4 o;
        o.x = pack2(bflo(a.x) + bflo(b.x), bfhi(a.x) + bfhi(b.x));
        o.y = pack2(bflo(a.y) + bflo(b.y), bfhi(a.y) + bfhi(b.y));
        o.z = pack2(bflo(a.z) + bflo(b.z), bfhi(a.z) + bfhi(b.z));
        o.w = pack2(bflo(a.w) + bflo(b.w), bfhi(a.w) + bfhi(b.w));
        *(uint4*)gp = o;
      }
    }
  }
}

constexpr int P7_G = 136 * 8, P7_CV = 16384;
constexpr float U_SCALE = 256.f, V_SCALE = 32.f;
__device__ void phase7(const P& p, int bid, int nb, char* smem) {
  {
    TileIter ti(bid, nb, 136, 8);
    int mt, nt;
    while (ti.next(mt, nt)) {
      f32x4 acc[4][4];
      zero_acc(acc);
      gemm_tile_glds(p.merged, D, mt * 128, p.w_outT, D, nt * 128, D, acc, smem);
      float* Lf = (float*)smem;
      ACC_FOREACH({ Lf[row * 132 + col] = acc[m][n][j]; })
      __syncthreads();
      {
        const int tid = TIDX;
#pragma unroll 4
        for (int i = 0; i < 16; i++) {
          const int id = tid + i * 256, row = id >> 5, c4 = (id & 31) * 4;
          const int nn = mt * 128 + row, c = nt * 128 + c4;
          int seq, t, T; tok2seq(nn, seq, t, T);
          const float4 a = *(const float4*)(Lf + row * 132 + c4);
          const float4 g = *(const float4*)(p.mod + (size_t)seq * 8192 + 2048 + c);
          const float4 x = *(const float4*)(xrow(p, nn) + c);
          *(float4*)(p.out + O_Y + (size_t)nn * D + c) = make_float4(x.x + g.x * a.x, x.y + g.y * a.y, x.z + g.z * a.z, x.w + g.w * a.w);
        }
      }
    }
  }
  for (int it0 = bid; it0 < P7_CV; it0 += 4 * nb) {
    const int tid = TIDX;
    float4 va[4], vb[4];
#pragma unroll
    for (int r = 0; r < 4; r++) {
      const int it = it0 + r * nb;
      if (it < P7_CV) {
        const float* src = it < 8192 ? p.peer_u + (size_t)it * 2048 : p.peer_v + (size_t)(it - 8192) * 2048;
        const float4* s4 = (const float4*)src + tid * 2;
        va[r] = s4[0]; vb[r] = s4[1];
      }
    }
#pragma unroll
    for (int r = 0; r < 4; r++) {
      const int it = it0 + r * nb;
      if (it < P7_CV) {
        unsigned char* dst = it < 8192 ? (unsigned char*)p.ub + (size_t)it * 2048 : (unsigned char*)p.vb + (size_t)(it - 8192) * 2048;
        const float sc = it < 8192 ? U_SCALE : V_SCALE;
        const float4 a = va[r], b = vb[r];
        int lo = __builtin_amdgcn_cvt_pk_fp8_f32(a.x * sc, a.y * sc, 0, false);
        lo = __builtin_amdgcn_cvt_pk_fp8_f32(a.z * sc, a.w * sc, lo, true);
        int hi = __builtin_amdgcn_cvt_pk_fp8_f32(b.x * sc, b.y * sc, 0, false);
        hi = __builtin_amdgcn_cvt_pk_fp8_f32(b.z * sc, b.w * sc, hi, true);
        *((uint2*)dst + tid) = make_uint2((unsigned)lo, (unsigned)hi);
      }
    }
  }
}

__device__ void phase9(const P& p, int bid, int nb, char* smem) {
  const int tid = TIDX, lane = tid & 63, wid = tid >> 6, wr = wid >> 1, wc = wid & 1, fr = lane & 15,
            fq = lane >> 4;
  TileIter ti(bid, nb, 136, 16);
  int mt, nt;
  while (ti.next(mt, nt)) {
    f32x4 acc[4][4];
    zero_acc(acc);
    gemm_tile_glds(p.xn, D, mt * 128, p.wqT, D, nt * 128, D, acc, smem);
    u16* Lq = (u16*)smem;
    ACC_FOREACH({ Lq[row * 136 + col] = f2bf(acc[m][n][j]); })
    __syncthreads();
    f32x4 sc[4][4];
    zero_acc(sc);
    const u16* kb = p.keysb + (size_t)nt * 128 * 128;
#pragma unroll 1
    for (int s = 0; s < 4; s++) {
      bf16x8 af[4], bfr[4];
#pragma unroll
      for (int m = 0; m < 4; m++) af[m] = *(const bf16x8*)((const char*)Lq + (wr * 64 + m * 16 + fr) * 272 + s * 64 + fq * 16);
#pragma unroll
      for (int n = 0; n < 4; n++) bfr[n] = *(const bf16x8*)(kb + (size_t)(wc * 64 + n * 16 + fr) * 128 + s * 32 + fq * 8);
#pragma unroll
      for (int m = 0; m < 4; m++)
#pragma unroll
        for (int n = 0; n < 4; n++) sc[m][n] = __builtin_amdgcn_mfma_f32_16x16x32_bf16(af[m], bfr[n], sc[m][n], 0, 0, 0);
    }
    __syncthreads();
    float* Ls = (float*)smem;
#pragma unroll
    for (int m = 0; m < 4; m++)
#pragma unroll
      for (int n = 0; n < 4; n++)
#pragma unroll
        for (int j = 0; j < 4; j++) {
          const int kc = wc * 64 + n * 16 + fr;
          int sb = __float_as_int(sc[m][n][j]);
          sb ^= (sb >> 31) & 0x7fffffff;
          ((int*)Ls)[(wr * 64 + m * 16 + fq * 4 + j) * 129 + kc] = (sb & ~127) | (127 - kc);
        }
    __syncthreads();
    {
      const int row = tid >> 1, half = tid & 1;
      float* Lr = Ls + row * 129;
      const size_t ob = ((size_t)(mt * 128 + row) * 16 + nt) * 16;
      int* Li = (int*)Lr;
      for (int r = 0; r < 16; r++) {
        int best = (int)0x80000000;
#pragma unroll 8
        for (int i = 0; i < 64; i++) best = max(best, Li[half + 2 * i]);
        best = max(best, __shfl_xor(best, 1, 64));
        const int bi = 127 - (best & 127);
        if ((bi & 1) == half) Li[bi] = (int)0x80000000;
        if (half == 0) {
          int vb = best & ~127;
          vb ^= (vb >> 31) & 0x7fffffff;
          p.topv[ob + r] = __int_as_float(vb);
          p.topi[ob + r] = bi;
        }
      }
    }
    __syncthreads();
  }
}

__device__ __forceinline__ void cand_ij(int lane, int& ci, int& cj) {
  int i = 0, rem = lane;
#pragma unroll
  for (int r = 0; r < 16; r++) {
    const int cnt = 16 / (r + 1);
    if (i == r && rem >= cnt) { rem -= cnt; i = r + 1; }
  }
  ci = i; cj = rem;
}

typedef __attribute__((ext_vector_type(2))) __bf16 bf2_t;
__device__ __forceinline__ float dot2bf(unsigned a, unsigned b, float c) {
  return __builtin_amdgcn_fdot2_f32_bf16(__builtin_bit_cast(bf2_t, a), __builtin_bit_cast(bf2_t, b), c, false);
}
template <int CTRL, int RM>
__device__ __forceinline__ float dppf_m(float x) {
  return __int_as_float(__builtin_amdgcn_update_dpp(0, __float_as_int(x), CTRL, RM, 0xf, false));
}
__device__ __forceinline__ float wave_sum_l63(float x) {
  x += dppf<0xB1>(x);
  x += dppf<0x4E>(x);
  x += dppf<0x141>(x);
  x += dppf<0x140>(x);
  x += dppf_m<0x142, 0xA>(x);
  x += dppf_m<0x143, 0xC>(x);
  return x;
}
__device__ __forceinline__ float readlane_f(float x, int l) {
  return __int_as_float(__builtin_amdgcn_readlane(__float_as_int(x), l));
}
__device__ __forceinline__ void axpy8(float* acc, float w, uint4 v) {
  acc[0] += w * bflo(v.x); acc[1] += w * bfhi(v.x); acc[2] += w * bflo(v.y); acc[3] += w * bfhi(v.y);
  acc[4] += w * bflo(v.z); acc[5] += w * bfhi(v.z); acc[6] += w * bflo(v.w); acc[7] += w * bfhi(v.w);
}

typedef float f2_t __attribute__((ext_vector_type(2)));
__device__ __forceinline__ void fp8x16_to_f32(const uint4 v, float* o) {
  const unsigned w[4] = {v.x, v.y, v.z, v.w};
#pragma unroll
  for (int i = 0; i < 4; i++) {
    const f2_t lo = __builtin_amdgcn_cvt_pk_f32_fp8((int)w[i], false);
    const f2_t hi = __builtin_amdgcn_cvt_pk_f32_fp8((int)w[i], true);
    o[4 * i] = lo.x; o[4 * i + 1] = lo.y; o[4 * i + 2] = hi.x; o[4 * i + 3] = hi.y;
  }
}

__device__ void phase10(const P& p, int bid, int nb) {
  const int lane = TIDX & 63, wid = TIDX >> 6;
  int ci, cj; cand_ij(lane < 50 ? lane : 0, ci, cj);
  const unsigned char* ub8 = (const unsigned char*)p.ub;
  const unsigned char* vb8 = (const unsigned char*)p.vb;
  for (int it = bid; it < NT / 4; it += nb) {
    const int n = it * 4 + wid;
    int seq, t, T; tok2seq(n, seq, t, T);
    float xv[16];
    {
      const uint4 a = *(const uint4*)(p.xn + (size_t)n * D + lane * 16), b = *(const uint4*)(p.xn + (size_t)n * D + lane * 16 + 8);
      const unsigned as[4] = {a.x, a.y, a.z, a.w}, bs[4] = {b.x, b.y, b.z, b.w};
#pragma unroll
      for (int e = 0; e < 4; e++) { xv[2 * e] = bflo(as[e]); xv[2 * e + 1] = bfhi(as[e]); xv[8 + 2 * e] = bflo(bs[e]); xv[8 + 2 * e + 1] = bfhi(bs[e]); }
    }
    float acc[16];
#pragma unroll
    for (int e = 0; e < 16; e++) acc[e] = 0.f;
#pragma unroll 1
    for (int h = 0; h < 8; h++) {
      const size_t base = ((size_t)n * 16 + h * 2) * 16;
      float cand = -INFINITY; int eid = 0;
      if (lane < 50) {
        cand = p.topv[base + ci] + p.topv[base + 16 + cj];
        eid = p.topi[base + ci] * 128 + p.topi[base + 16 + cj];
      }
      int rank = 0;
#pragma unroll
      for (int m = 0; m < 50; m++) {
        const float cm = readlane_f(cand, m);
        rank += ((cm > cand) || (cm == cand && m < lane)) ? 1 : 0;
      }
      const bool sel = (lane < 50) && (rank < 16);
      unsigned long long mask = __ballot(sel);
      const float mx = readlane_f(cand, __builtin_ctzll(__ballot(sel && rank == 0)));
      const float ex = sel ? __expf(cand - mx) : 0.f;
      const float den = readlane_f(wave_sum_l63(ex), 63);
      const float gate = ex / den;
#pragma unroll 1
      for (int hf = 0; hf < 2; hf++) {
        int ek[8]; float gk[8];
#pragma unroll
        for (int k = 0; k < 8; k++) {
          const int src = __builtin_ctzll(mask);
          mask &= mask - 1;
          ek[k] = __builtin_amdgcn_readlane(eid, src);
          gk[k] = readlane_f(gate, src);
        }
        uint4 uu[8], vv[8];
#pragma unroll
        for (int j = 0; j < 8; j++) uu[j] = *(const uint4*)(ub8 + (size_t)ek[j] * D + lane * 16);
#pragma unroll
        for (int j = 0; j < 8; j++) vv[j] = *(const uint4*)(vb8 + (size_t)ek[j] * D + lane * 16);
        float dv = 0.f;
#pragma unroll
        for (int j = 0; j < 8; j++) {
          float uf[16];
          fp8x16_to_f32(uu[j], uf);
          float d0 = 0.f, d1 = 0.f;
#pragma unroll
          for (int e = 0; e < 8; e++) { d0 += uf[2 * e] * xv[2 * e]; d1 += uf[2 * e + 1] * xv[2 * e + 1]; }
          const float ds = readlane_f(wave_sum_l63(d0 + d1), 63);
          dv = (lane == j) ? ds : dv;
        }
        dv *= (1.f / U_SCALE);
        const float act = 0.5f * dv * (1.f + erff(dv * 0.70710678118654752f));
#pragma unroll
        for (int j = 0; j < 8; j++) {
          const float w = readlane_f(act, j) * gk[j] * (1.f / V_SCALE);
          float vf[16];
          fp8x16_to_f32(vv[j], vf);
#pragma unroll
          for (int e = 0; e < 16; e++) acc[e] += w * vf[e];
        }
      }
    }
    float* yr = p.out + O_Y + (size_t)n * D + lane * 16;
    const float* md = p.mod + (size_t)seq * 8192 + lane * 16;
    float x2[16];
    float ss = 0.f;
#pragma unroll
    for (int q4 = 0; q4 < 4; q4++) {
      const float4 a = *(const float4*)(yr + q4 * 4), g = *(const float4*)(md + 5120 + q4 * 4);
      x2[q4 * 4 + 0] = a.x + g.x * acc[q4 * 4 + 0]; x2[q4 * 4 + 1] = a.y + g.y * acc[q4 * 4 + 1];
      x2[q4 * 4 + 2] = a.z + g.z * acc[q4 * 4 + 2]; x2[q4 * 4 + 3] = a.w + g.w * acc[q4 * 4 + 3];
    }
#pragma unroll
    for (int e = 0; e < 16; e++) ss += x2[e] * x2[e];
    ss = readlane_f(wave_sum_l63(ss), 63);
    const float rstd = rsqrtf(ss * (1.f / 1024.f) + 1e-6f);
#pragma unroll
    for (int q4 = 0; q4 < 4; q4++) {
      const float4 fg = *(const float4*)(p.final_g + lane * 16 + q4 * 4), sc = *(const float4*)(md + 7168 + q4 * 4),
                   sh = *(const float4*)(md + 6144 + q4 * 4);
      float4 o;
      o.x = x2[q4 * 4 + 0] * rstd * fg.x * (1.f + sc.x) + sh.x;
      o.y = x2[q4 * 4 + 1] * rstd * fg.y * (1.f + sc.y) + sh.y;
      o.z = x2[q4 * 4 + 2] * rstd * fg.z * (1.f + sc.z) + sh.z;
      o.w = x2[q4 * 4 + 3] * rstd * fg.w * (1.f + sc.w) + sh.w;
      *(float4*)(yr + q4 * 4) = o;
    }
  }
}

#define XB_XCNT(j) (256 + 64 * (j))
#define XB_XSUB(j) (1280 + 64 * (j))
#define XB_XGEN(j) (2304 + 64 * (j))
#define XB_TOP 3328
#define XB_TOPGEN 3392
#define XB_WORDS 4096
__device__ __forceinline__ unsigned xb_ld(unsigned* p) { return __hip_atomic_load(p, __ATOMIC_RELAXED, __HIP_MEMORY_SCOPE_AGENT); }
__device__ __forceinline__ unsigned xb_add(unsigned* p, unsigned v) { return __hip_atomic_fetch_add(p, v, __ATOMIC_RELAXED, __HIP_MEMORY_SCOPE_AGENT); }
__device__ __forceinline__ unsigned xb_xcc_id() { return (unsigned)__builtin_amdgcn_s_getreg((3 << 11) | 20) & 0xFu; }
__device__ __forceinline__ void grid_barrier(unsigned* bar, volatile unsigned* xst) {
  asm volatile("s_waitcnt vmcnt(0)" ::: "memory");
  __syncthreads();
  if (TIDX == 0) {
    __builtin_amdgcn_s_waitcnt(0);
    const unsigned x = xst[0], nloc = xst[1], nx = xst[2];
    const unsigned old = xb_add(&bar[XB_XSUB(x)], 1u);
    const unsigned gen = old / nloc;
    if (old + 1u == (gen + 1u) * nloc) {
      __builtin_amdgcn_fence(__ATOMIC_RELEASE, "agent");
      asm volatile("s_waitcnt vmcnt(0)" ::: "memory");
      const unsigned og = xb_add(&bar[XB_TOP], 1u);
      const unsigned tg = og / nx;
      if (og + 1u == (tg + 1u) * nx) xb_add(&bar[XB_TOPGEN], 1u);
      else while (xb_ld(&bar[XB_TOPGEN]) == tg) __builtin_amdgcn_s_sleep(1);
      __builtin_amdgcn_fence(__ATOMIC_ACQUIRE, "agent");
      xb_add(&bar[XB_XGEN(x)], 1u);
      asm volatile("s_waitcnt vmcnt(0)" ::: "memory");
    } else {
      while (xb_ld(&bar[XB_XGEN(x)]) == gen) __builtin_amdgcn_s_sleep(1);
      __builtin_amdgcn_fence(__ATOMIC_ACQUIRE, "agent");
      asm volatile("s_waitcnt vmcnt(0)" ::: "memory");
    }
  }
  __syncthreads();
}

template <int PH>
__device__ __forceinline__ void run_phase(const P& p, int bid, int nb, char* smem) {
  if constexpr (PH == 0) phase0(p, bid, nb, smem);
  if constexpr (PH == 1) phase_norm<false>(p, bid, nb);
  if constexpr (PH == 2) phase2(p, bid, nb, smem);
  if constexpr (PH == 3) phase3(p, bid, nb, smem);
  if constexpr (PH == 4) phase4(p, bid, nb, smem);
  if constexpr (PH == 5) phase5(p, bid, nb);
  if constexpr (PH == 6) phase6(p, bid, nb, smem);
  if constexpr (PH == 7) phase7(p, bid, nb, smem);
  if constexpr (PH == 8) phase_norm<true>(p, bid, nb);
  if constexpr (PH == 9) phase9(p, bid, nb, smem);
  if constexpr (PH == 10) phase10(p, bid, nb);
  if constexpr (PH == 11) phase3b(p, bid, nb, smem);
}

template <int PH>
__global__ void __launch_bounds__(NTHREADS, 2) k_phase(P p) {
  extern __shared__ __attribute__((aligned(16))) char smem[];
  run_phase<PH>(p, blockIdx.x, gridDim.x, smem);
}

#if MEGA
__global__ void __launch_bounds__(NTHREADS, 2) k_mega(P p) {
  extern __shared__ __attribute__((aligned(16))) char smem[];
  cg::grid_group grid = cg::this_grid();
  const int bid = blockIdx.x, nb = gridDim.x;
#ifndef PROBE_ALL2
#define PROBE_ALL2 0
#endif
#ifndef PROBE_MASK
#define PROBE_MASK 0
#endif
#ifndef PROBE_SYNCS
#define PROBE_SYNCS 0
#endif
  volatile unsigned* xst = (volatile unsigned*)(smem + LDS_BYTES - 16);
  if (TIDX == 0) { const unsigned xcc0 = xb_xcc_id(); xst[0] = xcc0; xb_add(&p.bar[XB_XCNT(xcc0)], 1u); }
#define GSYNC(k)                                                                                 \
  {                                                                                              \
    if ((k) == 0) {                                                                              \
      grid.sync();                                                                               \
      if (TIDX == 0) {                                                                    \
        unsigned cnt = 0;                                                                        \
        for (unsigned j = 0; j < 16; ++j) cnt += xb_ld(&p.bar[XB_XCNT(j)]) > 0u ? 1u : 0u;       \
        xst[2] = cnt; xst[1] = xb_ld(&p.bar[XB_XCNT(xst[0])]);                                   \
      }                                                                                          \
    } else grid_barrier(p.bar, xst);                                                             \
  }
#define RUNPH(k)                                                       \
  run_phase<k>(p, bid, nb, smem); GSYNC(k)                             \
  if (PROBE_MASK & (1 << k)) { run_phase<k>(p, bid, nb, smem); GSYNC(1) }
#pragma unroll 1
  for (int rep = 0; rep < 1 + PROBE_ALL2; rep++) {
    RUNPH(0)
#pragma unroll 1
    for (int i = 0; i < PROBE_SYNCS; i++) GSYNC(1)
    RUNPH(1) RUNPH(2) RUNPH(3) RUNPH(11) RUNPH(4) RUNPH(5) RUNPH(6) RUNPH(7) RUNPH(8) RUNPH(9)
  }
  run_phase<10>(p, bid, nb, smem);
}
#endif

template <int PH>
static void launch_phase(const P& p, int grid, hipStream_t stream) {
  static bool attr = false;
  if (!attr) { hipFuncSetAttribute((const void*)k_phase<PH>, hipFuncAttributeMaxDynamicSharedMemorySize, LDS_BYTES); attr = true; }
  hipLaunchKernelGGL(k_phase<PH>, dim3(grid), dim3(NTHREADS), LDS_BYTES, stream, p);
}

extern "C" void kernel_launch(void* const* d_in, const int* in_sizes, int n_in, void* d_out, int out_size, void* d_ws,
                              size_t ws_size, hipStream_t stream) {
  P p{};
  const float** fp = (const float**)&p;
  for (int i = 0; i < 40; i++) fp[i] = (const float*)d_in[i];
  p.out = (float*)d_out;
  char* ws = (char*)d_ws;
  size_t off = 0;
  auto take = [&](size_t bytes) { char* r = ws + off; off += (bytes + 255) & ~(size_t)255; return r; };
  p.bar = (unsigned*)take(XB_WORDS * 4);
  p.w_inT = (u16*)take((size_t)INCOLS * D * 2);
  p.w_paT = (u16*)take((size_t)1024 * 512 * 2);
  p.w_pbT = (u16*)take((size_t)1024 * 1024 * 2);
  p.w_outT = (u16*)take((size_t)1024 * 1024 * 2);
  p.wqT = (u16*)take((size_t)2048 * 1024 * 2);
  p.keysb = (u16*)take((size_t)262144 * 2);
  p.mod = (float*)take((size_t)NSEQ * 8192 * 4);
  p.dtb = (float*)take((size_t)NT * 16 * 4);
  p.decb = (float*)take((size_t)NT * 16 * 4);
  p.xn = (u16*)take((size_t)NROWS * D * 2);
  p.proj = (u16*)take((size_t)NROWS * PCOLS * 2);
  p.prep = (u16*)take((size_t)NT * 3584 * 2);
  p.w2T = (u16*)take(512 * 64 * 2);
  p.a2T = (u16*)take(512 * 64 * 2);
  p.g2T = (u16*)take(512 * 128 * 2);
  p.lora = (u16*)take((size_t)NT * 256 * 2);
  if (off > ws_size) { fprintf(stderr, "workspace too small: need %zu have %zu\n", off, ws_size); return; }
  p.merged = p.prep;
  p.ub = p.proj;
  p.vb = p.proj + (size_t)16384 * 1024;
  p.topv = (float*)(p.proj + (size_t)2 * 16384 * 1024);
  p.topi = (int*)(p.topv + (size_t)NT * 256);
  p.xc = (u16*)d_out;
  p.oa = (u16*)d_out;
  p.ob = (u16*)d_out + (size_t)NT * 512;

  static int grid = 0;
  if (!grid) {
    int dev = 0, cus = 0, per_cu = 0;
    hipGetDevice(&dev);
    hipDeviceGetAttribute(&cus, hipDeviceAttributeMultiprocessorCount, dev);
#if MEGA
    hipFuncSetAttribute((const void*)k_mega, hipFuncAttributeMaxDynamicSharedMemorySize, LDS_BYTES);
    hipOccupancyMaxActiveBlocksPerMultiprocessor(&per_cu, k_mega, NTHREADS, LDS_BYTES);
    if (per_cu > 2) per_cu = 2;
#else
    per_cu = 2;
#endif
    if (per_cu < 1) per_cu = 1;
    grid = cus * per_cu;
  }
  hipMemsetAsync(p.mod, 0, (size_t)NSEQ * 8192 * 4, stream);
#if MEGA
  hipMemsetAsync(p.bar, 0, XB_WORDS * 4, stream);
  void* args[] = {&p};
  hipError_t e = hipLaunchCooperativeKernel((void*)k_mega, dim3(grid), dim3(NTHREADS), args, LDS_BYTES, stream);
  if (e != hipSuccess) fprintf(stderr, "cooperative launch failed: %s (grid %d)\n", hipGetErrorString(e), grid);
#else
  launch_phase<0>(p, grid, stream);
  launch_phase<1>(p, grid, stream);
  launch_phase<2>(p, grid, stream);
  launch_phase<3>(p, grid, stream);
  launch_phase<11>(p, grid, stream);
  launch_phase<4>(p, grid, stream);
  launch_phase<5>(p, grid, stream);
  launch_phase<6>(p, grid, stream);
  launch_phase<7>(p, grid, stream);
  launch_phase<8>(p, grid, stream);
  launch_phase<9>(p, grid, stream);
  launch_phase<10>(p, grid, stream);
#endif
}
```

```cpp
#include <hip/hip_runtime.h>
#include <hip/hip_cooperative_groups.h>
#include <cstdio>
namespace cg = cooperative_groups;

#ifndef MEGA
#define MEGA 1
#endif

typedef unsigned short u16;
typedef __attribute__((ext_vector_type(8))) short bf16x8;
typedef __attribute__((ext_vector_type(4))) float f32x4;

__device__ __forceinline__ int opaque_tid() { int t = threadIdx.x; asm volatile("" : "+v"(t)); return t; }
#define TIDX opaque_tid()

constexpr int D = 1024;
constexpr int NP = 16384, NS = 1024, NT = NP + NS, NSEQ = 136;
constexpr int NROWS = NT + 128;
constexpr int PCOLS = 4368;
constexpr int INCOLS = 6416;
constexpr int C_LW = 1536, C_LA = 1600, C_LG = 1664, C_Z = 1792, C_XBC = 2816, C_DT = 4352;
constexpr int G_A = 4368, G_B = 5392;
constexpr size_t O_Y = 0, O_PSHIFT = 17825792, O_PWKV = 17833984, O_PCONV = 18096128, O_PSSM = 18132992,
                 O_SSHIFT = 19181568, O_SWKV = 19312640, O_SCONV = 23506944, O_SSSM = 24096768;
constexpr int LDS_BYTES = 80 * 1024;
constexpr int NTHREADS = 256;

struct P {
  const float *x_prompt, *x_sample, *c_prompt, *c_sample, *state_shift, *state_wkv, *state_conv, *state_ssm;
  const float *w_ada, *b_ada, *norm1_g, *w_in, *rw_mu, *rw_w0, *rw_w2, *rw_a0, *rw_a2, *rw_g2, *rw_k_k, *rw_k_a,
      *rw_r_k, *rw_ln_w, *rw_ln_b;
  const float *conv_w, *conv_b, *dt_bias, *A_log, *D_skip, *ssm_norm_w, *w_pa, *w_pb, *w_out, *norm2_g, *peer_wq,
      *peer_keys, *peer_u, *peer_v, *final_g, *w_ada_f, *b_ada_f;
  float* out;
  u16 *w_inT, *w_paT, *w_pbT, *w_outT, *wqT, *keysb, *xn, *proj, *prep, *merged, *ub, *vb, *xc, *oa, *ob;
  u16 *w2T, *a2T, *g2T, *lora;
  float *mod, *dtb, *decb, *topv;
  int* topi;
  unsigned* bar;
};

__device__ __forceinline__ u16 f2bf(float f) {
  unsigned u = __float_as_uint(f);
  u += 0x7fffu + ((u >> 16) & 1u);
  return (u16)(u >> 16);
}
__device__ __forceinline__ float bf2f(u16 h) { return __uint_as_float(((unsigned)h) << 16); }
__device__ __forceinline__ unsigned pack2(float a, float b) { return (unsigned)f2bf(a) | ((unsigned)f2bf(b) << 16); }
__device__ __forceinline__ float bflo(unsigned u) { return __uint_as_float(u << 16); }
__device__ __forceinline__ float bfhi(unsigned u) { return __uint_as_float(u & 0xffff0000u); }
__device__ __forceinline__ float sigmoidf_(float x) { return 1.f / (1.f + __expf(-x)); }
__device__ __forceinline__ float siluf_(float x) { return x / (1.f + __expf(-x)); }
__device__ __forceinline__ float softplusf_(float x) { return x > 20.f ? x : log1pf(expf(x)); }

template <int CTRL>
__device__ __forceinline__ float dppf(float x) {
  return __int_as_float(__builtin_amdgcn_update_dpp(0, __float_as_int(x), CTRL, 0xf, 0xf, true));
}
__device__ __forceinline__ float allreduce16(float x) {
  x += dppf<0x128>(x);
  x += dppf<0x124>(x);
  x += dppf<0x122>(x);
  x += dppf<0x121>(x);
  return x;
}
__device__ __forceinline__ float allreduce8(float x) {
  x += dppf<0xB1>(x);
  x += dppf<0x4E>(x);
  x += dppf<0x141>(x);
  return x;
}
__device__ __forceinline__ float wave_sum(float x) {
#pragma unroll
  for (int o = 32; o >= 1; o >>= 1) x += __shfl_xor(x, o, 64);
  return x;
}
__device__ __forceinline__ float wave_max(float x) {
#pragma unroll
  for (int o = 32; o >= 1; o >>= 1) x = fmaxf(x, __shfl_xor(x, o, 64));
  return x;
}
__device__ __forceinline__ int wave_min_i(int x) {
#pragma unroll
  for (int o = 32; o >= 1; o >>= 1) x = min(x, __shfl_xor(x, o, 64));
  return x;
}

__device__ __forceinline__ const float* xrow(const P& p, int n) {
  return n < NP ? p.x_prompt + (size_t)n * D : p.x_sample + (size_t)(n - NP) * D;
}
__device__ __forceinline__ void tok2seq(int n, int& seq, int& t, int& T) {
  if (n < NP) { seq = n >> 11; t = n & 2047; T = 2048; }
  else { int m = n - NP; seq = 8 + (m >> 3); t = m & 7; T = 8; }
}
__device__ __forceinline__ float* seq_out(float* out, int seq, size_t op, size_t os, size_t per) {
  return seq < 8 ? out + op + (size_t)seq * per : out + os + (size_t)(seq - 8) * per;
}

constexpr int LROW = 144;
template <bool DEEP = true>
__device__ __forceinline__ void gemm_tile(const u16* __restrict__ A, int lda, int m0, const u16* __restrict__ Bt,
                                          int ldb, int n0, int K, f32x4 (&acc)[4][4], char* smem) {
  char* sA = smem;
  char* sB = smem + 128 * LROW;
  const int tid = TIDX, lane = tid & 63, wid = tid >> 6, wr = wid >> 1, wc = wid & 1, fr = lane & 15,
            fq = lane >> 4;
  uint4 ra0, ra1, ra2, ra3, rb0, rb1, rb2, rb3;
  uint4 sa0, sa1, sa2, sa3, sb0, sb1, sb2, sb3;
  const int nk = K / 64;
  const int lrow = tid >> 3, lch = tid & 7;
  const u16* gA = A + (size_t)(m0 + lrow) * lda + lch * 8;
  const u16* gB = Bt + (size_t)(n0 + lrow) * ldb + lch * 8;
#define GLOAD(x0, x1, x2, x3, y0, y1, y2, y3, kt)                   \
  {                                                                 \
    x0 = *(const uint4*)(gA + (kt) * 64);                           \
    x1 = *(const uint4*)(gA + (size_t)32 * lda + (kt) * 64);        \
    x2 = *(const uint4*)(gA + (size_t)64 * lda + (kt) * 64);        \
    x3 = *(const uint4*)(gA + (size_t)96 * lda + (kt) * 64);        \
    y0 = *(const uint4*)(gB + (kt) * 64);                           \
    y1 = *(const uint4*)(gB + (size_t)32 * ldb + (kt) * 64);        \
    y2 = *(const uint4*)(gB + (size_t)64 * ldb + (kt) * 64);        \
    y3 = *(const uint4*)(gB + (size_t)96 * ldb + (kt) * 64);        \
  }
#define LSTORE(x0, x1, x2, x3, y0, y1, y2, y3)                      \
  {                                                                 \
    char* wa = sA + lrow * LROW + lch * 16;                         \
    char* wb = sB + lrow * LROW + lch * 16;                         \
    *(uint4*)(wa) = x0; *(uint4*)(wa + 32 * LROW) = x1; *(uint4*)(wa + 64 * LROW) = x2; *(uint4*)(wa + 96 * LROW) = x3; \
    *(uint4*)(wb) = y0; *(uint4*)(wb + 32 * LROW) = y1; *(uint4*)(wb + 64 * LROW) = y2; *(uint4*)(wb + 96 * LROW) = y3; \
  }
#define COMPUTE_TILE()                                                                                                   \
  {                                                                                                                      \
    _Pragma("unroll") for (int s = 0; s < 2; s++) {                                                                      \
      bf16x8 af[4], bfr[4];                                                                                              \
      _Pragma("unroll") for (int m = 0; m < 4; m++) af[m] = *(const bf16x8*)(sA + (wr * 64 + m * 16 + fr) * LROW + s * 64 + fq * 16); \
      _Pragma("unroll") for (int n = 0; n < 4; n++) bfr[n] = *(const bf16x8*)(sB + (wc * 64 + n * 16 + fr) * LROW + s * 64 + fq * 16); \
      _Pragma("unroll") for (int m = 0; m < 4; m++)                                                                      \
        _Pragma("unroll") for (int n = 0; n < 4; n++) acc[m][n] = __builtin_amdgcn_mfma_f32_16x16x32_bf16(af[m], bfr[n], acc[m][n], 0, 0, 0); \
    }                                                                                                                    \
  }
  GLOAD(ra0, ra1, ra2, ra3, rb0, rb1, rb2, rb3, 0);
  if constexpr (DEEP) {
    GLOAD(sa0, sa1, sa2, sa3, sb0, sb1, sb2, sb3, 1);
#pragma unroll 1
    for (int kt = 0; kt < nk; kt += 2) {
      __syncthreads();
      LSTORE(ra0, ra1, ra2, ra3, rb0, rb1, rb2, rb3);
      __syncthreads();
      if (kt + 2 < nk) GLOAD(ra0, ra1, ra2, ra3, rb0, rb1, rb2, rb3, kt + 2);
      COMPUTE_TILE();
      __syncthreads();
      LSTORE(sa0, sa1, sa2, sa3, sb0, sb1, sb2, sb3);
      __syncthreads();
      if (kt + 3 < nk) GLOAD(sa0, sa1, sa2, sa3, sb0, sb1, sb2, sb3, kt + 3);
      COMPUTE_TILE();
    }
  } else {
#pragma unroll 1
    for (int kt = 0; kt < nk; kt++) {
      __syncthreads();
      LSTORE(ra0, ra1, ra2, ra3, rb0, rb1, rb2, rb3);
      __syncthreads();
      if (kt + 1 < nk) GLOAD(ra0, ra1, ra2, ra3, rb0, rb1, rb2, rb3, kt + 1);
      COMPUTE_TILE();
    }
  }
  __syncthreads();
}
#define GL_RAW_BARRIER() { asm volatile("s_waitcnt vmcnt(0)" ::: "memory"); asm volatile("s_waitcnt lgkmcnt(0)" ::: "memory"); __builtin_amdgcn_s_barrier(); }
__device__ __forceinline__ void gemm_tile_glds(const u16* __restrict__ A, int lda, int m0, const u16* __restrict__ Bt,
                                               int ldb, int n0, int K, f32x4 (&acc)[4][4], char* smem) {
  const int tid = TIDX, lane = tid & 63, wid = tid >> 6, wr = wid >> 1, wc = wid & 1, fr = lane & 15, fq = lane >> 4;
  const int nk = K / 64;
  const int srow = tid >> 3, sc = (tid & 7) ^ ((srow >> 1) & 7);
  const u16* gA = A + (size_t)(m0 + srow) * lda + sc * 8;
  const u16* gB = Bt + (size_t)(n0 + srow) * ldb + sc * 8;
  char* const lbase = smem + tid * 16;
  const int swz = (fr >> 1) & 7;
  const int aoff = (wr * 64 + fr) * 128, boff = 16384 + (wc * 64 + fr) * 128;
#define GL_STAGE(buf, kt)                                                                                         \
  {                                                                                                               \
    _Pragma("unroll") for (int i = 0; i < 4; i++) {                                                               \
      __builtin_amdgcn_global_load_lds((const unsigned*)(gA + (size_t)(32 * i) * lda + (kt) * 64),               \
                                       (unsigned*)(lbase + (buf) * 32768 + i * 4096), 16, 0, 0);                  \
      __builtin_amdgcn_global_load_lds((const unsigned*)(gB + (size_t)(32 * i) * ldb + (kt) * 64),               \
                                       (unsigned*)(lbase + (buf) * 32768 + 16384 + i * 4096), 16, 0, 0);          \
    }                                                                                                             \
  }
#define GL_COMPUTE(buf)                                                                                           \
  {                                                                                                               \
    const char* pb = smem + (buf) * 32768;                                                                        \
    _Pragma("unroll") for (int s = 0; s < 2; s++) {                                                               \
      bf16x8 af[4], bfr[4];                                                                                       \
      const int so = ((s * 4 + fq) ^ swz) * 16;                                                                   \
      _Pragma("unroll") for (int m = 0; m < 4; m++) af[m] = *(const bf16x8*)(pb + aoff + m * 2048 + so);          \
      _Pragma("unroll") for (int n = 0; n < 4; n++) bfr[n] = *(const bf16x8*)(pb + boff + n * 2048 + so);         \
      _Pragma("unroll") for (int m = 0; m < 4; m++)                                                               \
        _Pragma("unroll") for (int n = 0; n < 4; n++)                                                             \
          acc[m][n] = __builtin_amdgcn_mfma_f32_16x16x32_bf16(af[m], bfr[n], acc[m][n], 0, 0, 0);                 \
    }                                                                                                             \
  }
  __syncthreads();
  GL_STAGE(0, 0)
  GL_RAW_BARRIER()
#pragma unroll 1
  for (int kt = 0; kt < nk; kt += 2) {
    if (kt + 1 < nk) GL_STAGE(1, kt + 1)
    GL_COMPUTE(0)
    GL_RAW_BARRIER()
    if (kt + 1 < nk) {
      if (kt + 2 < nk) GL_STAGE(0, kt + 2)
      GL_COMPUTE(1)
      GL_RAW_BARRIER()
    }
  }
}
__device__ __forceinline__ void zero_acc(f32x4 (&acc)[4][4]) {
#pragma unroll
  for (int m = 0; m < 4; m++)
#pragma unroll
    for (int n = 0; n < 4; n++) acc[m][n] = f32x4{0.f, 0.f, 0.f, 0.f};
}
#define ACC_FOREACH(...)                                                                    \
  {                                                                                         \
    const int _l = TIDX & 63, _w = TIDX >> 6, _wr = _w >> 1, _wc = _w & 1;    \
    const int _fr = _l & 15, _fq = _l >> 4;                                                 \
    _Pragma("unroll") for (int m = 0; m < 4; m++) _Pragma("unroll") for (int n = 0; n < 4; n++) \
        _Pragma("unroll") for (int j = 0; j < 4; j++) {                                     \
      const int row = _wr * 64 + m * 16 + _fq * 4 + j, col = _wc * 64 + n * 16 + _fr;       \
      __VA_ARGS__                                                                           \
    }                                                                                       \
  }

struct TileIter {
  int x, lb, nbx, tpx, total, MT, NT, r;
  __device__ __forceinline__ TileIter(int bid, int nb, int MT_, int NT_) : MT(MT_), NT(NT_), r(0) {
    total = MT * NT; x = bid & 7; lb = bid >> 3; nbx = nb >> 3; tpx = (total + 7) >> 3;
  }
  __device__ __forceinline__ bool next(int& mt, int& nt) {
    const int idx = lb + r * nbx;
    r++;
    if (idx >= tpx) return false;
    const int lin = x * tpx + idx;
    if (lin >= total) return false;
    const int bsz = 8 * NT, band = lin / bsz, rem = lin - band * bsz;
    const int mb = min(8, MT - band * 8);
    nt = rem / mb; mt = band * 8 + (rem - nt * mb);
    return true;
  }
};

__device__ __forceinline__ void tile_out_bf16(const char* smem, u16* __restrict__ C, size_t ldc, int m0, int n0, int ncols_valid) {
  __syncthreads();
  const int tid = TIDX;
#pragma unroll
  for (int i = 0; i < 8; i++) {
    const int id = tid + i * 256, row = id >> 4, ch = id & 15;
    if (ch * 8 < ncols_valid) *(uint4*)(C + (size_t)(m0 + row) * ldc + n0 + ch * 8) = *(const uint4*)(smem + row * 272 + ch * 16);
  }
}

__device__ void transpose_tile(const float* __restrict__ src, int K, int N, u16* __restrict__ dst, int tile,
                               char* smem) {
  const int ntn = (N + 63) / 64, kt = tile / ntn, nt = tile % ntn, tid = TIDX;
  float(*s)[65] = (float(*)[65])smem;
  __syncthreads();
#pragma unroll 4
  for (int i = 0; i < 16; i++) {
    int r = (tid >> 6) + 4 * i, n = nt * 64 + (tid & 63);
    s[r][tid & 63] = (n < N) ? src[(size_t)(kt * 64 + r) * N + n] : 0.f;
  }
  __syncthreads();
#pragma unroll 4
  for (int i = 0; i < 8; i++) {
    int nl = (tid >> 5) + 8 * i, n = nt * 64 + nl, kl = (tid & 31) * 2;
    if (n < N) *(unsigned*)(dst + (size_t)n * K + kt * 64 + kl) = pack2(s[kl][nl], s[kl + 1][nl]);
  }
}

__device__ void mod_item(const P& p, int item2, char* smem) {
  const int item = item2 >> 1, kh2 = item2 & 1;
  const int tid = TIDX, j = tid & 31, g = tid >> 5;
  const int col0 = item * 32;
  const float* W; const float* bias; int N, cw;
  if (col0 < 6144) { W = p.w_ada; bias = p.b_ada; N = 6144; cw = col0; }
  else { W = p.w_ada_f; bias = p.b_ada_f; N = 2048; cw = col0 - 6144; }
  float(*cs)[68] = (float(*)[68])smem;
  float acc[17];
#pragma unroll
  for (int s = 0; s < 17; s++) acc[s] = 0.f;
  for (int k0 = kh2 * 512; k0 < kh2 * 512 + 512; k0 += 64) {
    __syncthreads();
    {
      float cv[34];
#pragma unroll
      for (int i = 0; i < 34; i++) {
        const int idx = tid + i * 256, seq = idx >> 6, kk = idx & 63;
        cv[i] = seq < 8 ? p.c_prompt[seq * 1024 + k0 + kk] : p.c_sample[(seq - 8) * 1024 + k0 + kk];
      }
#pragma unroll
      for (int i = 0; i < 34; i++) {
        const int idx = tid + i * 256;
        cs[idx >> 6][idx & 63] = siluf_(cv[i]);
      }
    }
    __syncthreads();
#pragma unroll 1
    for (int kh = 0; kh < 2; kh++) {
      float wv[32];
#pragma unroll
      for (int k = 0; k < 32; k++) wv[k] = W[(size_t)(k0 + kh * 32 + k) * N + cw + j];
#pragma unroll 2
      for (int k4 = 0; k4 < 8; k4++) {
#pragma unroll
        for (int s = 0; s < 17; s++) {
          float4 c4 = *(const float4*)&cs[g * 17 + s][kh * 32 + k4 * 4];
          acc[s] += wv[k4 * 4] * c4.x + wv[k4 * 4 + 1] * c4.y + wv[k4 * 4 + 2] * c4.z + wv[k4 * 4 + 3] * c4.w;
        }
      }
    }
  }
  const float b = kh2 == 0 ? bias[cw + j] : 0.f;
#pragma unroll
  for (int s = 0; s < 17; s++) atomicAdd(&p.mod[(size_t)(g * 17 + s) * 8192 + col0 + j], acc[s] + b);
}

constexpr int J_MOD = 512, J_WIN = 16 * 101, J_WPA = 8 * 16, J_WPB = 256, J_WOUT = 256, J_WQ = 16 * 32, J_KEYS = 128,
              J_SHIFT = 64;
constexpr int J_LORA = 8 + 8 + 16;
constexpr int PH0_ITEMS = J_MOD + J_WIN + J_WPA + J_WPB + J_WOUT + J_WQ + J_LORA + J_KEYS + J_SHIFT;

__device__ void phase0(const P& p, int bid, int nb, char* smem) {
  for (int it = bid; it < PH0_ITEMS; it += nb) {
    int i = it;
    if (i < J_MOD) { mod_item(p, i, smem); continue; }
    i -= J_MOD;
    if (i < J_WIN) { transpose_tile(p.w_in, 1024, INCOLS, p.w_inT, i, smem); continue; }
    i -= J_WIN;
    if (i < J_WPA) { transpose_tile(p.w_pa, 512, 1024, p.w_paT, i, smem); continue; }
    i -= J_WPA;
    if (i < J_WPB) { transpose_tile(p.w_pb, 1024, 1024, p.w_pbT, i, smem); continue; }
    i -= J_WPB;
    if (i < J_WOUT) { transpose_tile(p.w_out, 1024, 1024, p.w_outT, i, smem); continue; }
    i -= J_WOUT;
    if (i < J_WQ) { transpose_tile(p.peer_wq, 1024, 2048, p.wqT, i, smem); continue; }
    i -= J_WQ;
    if (i < 8) { transpose_tile(p.rw_w2, 64, 512, p.w2T, i, smem); continue; }
    if (i < 16) { transpose_tile(p.rw_a2, 64, 512, p.a2T, i - 8, smem); continue; }
    if (i < 32) { transpose_tile(p.rw_g2, 128, 512, p.g2T, i - 16, smem); continue; }
    i -= J_LORA;
    const float* src; u16* dst;
    if (i < J_KEYS) { src = p.peer_keys + (size_t)i * 2048; dst = p.keysb + (size_t)i * 2048; }
    else { i -= J_KEYS; src = p.state_shift + (size_t)i * 2048; dst = p.xn + (size_t)NT * D + (size_t)i * 2048; }
    const float4* s4 = (const float4*)src + TIDX * 2;
    float4 a = s4[0], b = s4[1];
    uint4 o; o.x = pack2(a.x, a.y); o.y = pack2(a.z, a.w); o.z = pack2(b.x, b.y); o.w = pack2(b.z, b.w);
    *((uint4*)dst + TIDX) = o;
  }
}

template <bool SECOND>
__device__ void phase_norm(const P& p, int bid, int nb) {
  const int lane = TIDX & 63, wid = TIDX >> 6;
  const float* gam = SECOND ? p.norm2_g : p.norm1_g;
  for (int it = bid; it < NT / 8; it += nb) {
    const int nA = it * 8 + wid * 2;
    float4 v[2][4];
#pragma unroll
    for (int k = 0; k < 2; k++) {
      const int n = nA + k;
      const float* xr = SECOND ? p.out + O_Y + (size_t)n * D : xrow(p, n);
#pragma unroll
      for (int i = 0; i < 4; i++) v[k][i] = ((const float4*)xr)[lane + 64 * i];
    }
#pragma unroll
    for (int k = 0; k < 2; k++) {
      const int n = nA + k;
      int seq, t, T; tok2seq(n, seq, t, T);
      const float* md = p.mod + (size_t)seq * 8192 + (SECOND ? 3072 : 0);
      float ss = 0.f;
#pragma unroll
      for (int i = 0; i < 4; i++)
        ss += v[k][i].x * v[k][i].x + v[k][i].y * v[k][i].y + v[k][i].z * v[k][i].z + v[k][i].w * v[k][i].w;
      ss = wave_sum(ss);
      const float rstd = rsqrtf(ss * (1.f / 1024.f) + 1e-6f);
      const bool last = (!SECOND) && (t == T - 1);
      float* so = seq_out(p.out, seq, O_PSHIFT, O_SSHIFT, 1024);
#pragma unroll
      for (int i = 0; i < 4; i++) {
        const int c = (lane + 64 * i) * 4;
        const float4 g = *(const float4*)(gam + c), sh = *(const float4*)(md + c), sc = *(const float4*)(md + 1024 + c);
        float4 o;
        o.x = v[k][i].x * rstd * g.x * (1.f + sc.x) + sh.x;
        o.y = v[k][i].y * rstd * g.y * (1.f + sc.y) + sh.y;
        o.z = v[k][i].z * rstd * g.z * (1.f + sc.z) + sh.z;
        o.w = v[k][i].w * rstd * g.w * (1.f + sc.w) + sh.w;
        uint2 pk; pk.x = pack2(o.x, o.y); pk.y = pack2(o.z, o.w);
        *(uint2*)(p.xn + (size_t)n * D + c) = pk;
        if (last) *(float4*)(so + c) = o;
      }
    }
  }
}

constexpr int P2_NT = 35, P2_MT = 137;
__device__ void phase2(const P& p, int bid, int nb, char* smem) {
  TileIter ti(bid, nb, P2_MT, P2_NT);
  int mt, nt;
  while (ti.next(mt, nt)) {
    f32x4 acc[4][4];
    zero_acc(acc);
    gemm_tile_glds(p.xn, D, mt * 128, p.w_inT, D, nt * 128, D, acc, smem);
    u16* Lt = (u16*)smem;
    ACC_FOREACH({ Lt[row * 136 + col] = f2bf(acc[m][n][j]); })
    tile_out_bf16(smem, p.proj, PCOLS, mt * 128, nt * 128, PCOLS - nt * 128);
  }
}

__device__ void rwkv_lerp_item(const P& p, int item) {
  const int tid = TIDX;
  const int n0 = item * 8;
  int seq, t0, T; tok2seq(n0, seq, t0, T);
  uint4 pcv[7], ppv[7];
#pragma unroll
  for (int i = 0; i < 7; i++) {
    const int idx = tid + i * 256, tok = idx / 224, c = (idx % 224) * 8;
    const int n = n0 + tok, t = t0 + tok;
    pcv[i] = *(const uint4*)(p.proj + (size_t)n * PCOLS + c);
    const size_t prow = t > 0 ? (size_t)(n - 1) : (size_t)(NT + (seq >= 8 ? seq - 8 : 0));
    ppv[i] = *(const uint4*)(p.proj + prow * PCOLS + c);
    if (t == 0 && seq < 8) ppv[i] = make_uint4(0, 0, 0, 0);
  }
#pragma unroll
  for (int i = 0; i < 7; i++) {
    const int idx = tid + i * 256, tok = idx / 224, c = (idx % 224) * 8;
    const int n = n0 + tok;
    const float4 mu0 = *(const float4*)(p.rw_mu + c), mu1 = *(const float4*)(p.rw_mu + c + 4);
    const float mus[8] = {mu0.x, mu0.y, mu0.z, mu0.w, mu1.x, mu1.y, mu1.z, mu1.w};
    const unsigned pcs[4] = {pcv[i].x, pcv[i].y, pcv[i].z, pcv[i].w}, pps[4] = {ppv[i].x, ppv[i].y, ppv[i].z, ppv[i].w};
    unsigned o[4];
#pragma unroll
    for (int e = 0; e < 4; e++) {
      float a0 = bflo(pcs[e]), a1 = bfhi(pcs[e]), b0 = bflo(pps[e]), b1 = bfhi(pps[e]);
      float q0 = a0 + (b0 - a0) * mus[2 * e], q1 = a1 + (b1 - a1) * mus[2 * e + 1];
      if (c >= C_LW && c < C_LA) { q0 = tanhf(q0); q1 = tanhf(q1); }
      else if (c >= C_LG) { q0 = sigmoidf_(q0); q1 = sigmoidf_(q1); }
      o[e] = pack2(q0, q1);
    }
    u16* dst;
    if (c < 512) dst = p.prep + (size_t)n * 3584 + 512 + c;
    else if (c < 1024) dst = p.prep + (size_t)n * 3584 + 1024 + (c - 512);
    else if (c < 1536) dst = p.prep + (size_t)n * 3584 + 2560 + (c - 1024);
    else dst = p.lora + (size_t)n * 256 + (c - 1536);
    *(uint4*)dst = make_uint4(o[0], o[1], o[2], o[3]);
  }
}

__device__ void rwkv_lora_item(const P& p, int mt, int nt, char* smem) {
  const int tid = TIDX, lane = tid & 63, wid = tid >> 6, wr = wid >> 1, wc = wid & 1, fr = lane & 15, fq = lane >> 4;
  const int col0 = nt * 128;
  f32x4 acc[4][4];
  zero_acc(acc);
  gemm_tile_glds(p.lora, 256, mt * 128, p.w2T, 64, col0, 64, acc, smem);
  ACC_FOREACH({
    const int gc = col0 + col;
    const float wpre = p.rw_w0[gc] + acc[m][n][j];
    const float w = -softplusf_(-wpre) - 0.5f;
    p.prep[(size_t)(mt * 128 + row) * 3584 + gc] = f2bf(-expf(w));
  })
  zero_acc(acc);
  gemm_tile_glds(p.lora + 128, 256, mt * 128, p.g2T, 128, col0, 128, acc, smem);
  ACC_FOREACH({ p.prep[(size_t)(mt * 128 + row) * 3584 + 3072 + col0 + col] = f2bf(acc[m][n][j]); })
  zero_acc(acc);
  gemm_tile_glds(p.lora + 64, 256, mt * 128, p.a2T, 64, col0, 64, acc, smem);
  float a0c[4], kkc[4], kac[4];
#pragma unroll
  for (int n = 0; n < 4; n++) {
    const int gc = col0 + wc * 64 + n * 16 + fr;
    a0c[n] = p.rw_a0[gc]; kkc[n] = p.rw_k_k[gc]; kac[n] = p.rw_k_a[gc];
  }
#pragma unroll
  for (int m = 0; m < 4; m++)
#pragma unroll
    for (int j = 0; j < 4; j++) {
      const int row = mt * 128 + wr * 64 + m * 16 + fq * 4 + j;
      u16* pr = p.prep + (size_t)row * 3584 + col0 + wc * 64 + fr;
      float kx[4], kkv[4], av[4];
      float ss = 0.f;
#pragma unroll
      for (int n = 0; n < 4; n++) {
        kx[n] = bf2f(pr[1024 + n * 16]);
        av[n] = sigmoidf_(a0c[n] + acc[m][n][j]);
        kkv[n] = kx[n] * kkc[n];
        ss += kkv[n] * kkv[n];
      }
      ss = allreduce16(ss);
      const float inv = 1.f / fmaxf(sqrtf(ss), 1e-12f);
#pragma unroll
      for (int n = 0; n < 4; n++) {
        const float kk = kkv[n] * inv;
        pr[1024 + n * 16] = f2bf(kx[n] * (1.f + (av[n] - 1.f) * kac[n]));
        pr[1536 + n * 16] = f2bf(kk);
        pr[2048 + n * 16] = f2bf(kk * av[n]);
      }
    }
}

__device__ void conv_prep_item(const P& p, int item) {
  const int tid = TIDX;
  const int n0 = item * 8;
  int seq, t0, T; tok2seq(n0, seq, t0, T);
  if (tid < 192) {
    const int c = tid * 8;
    uint4 rows[11];
#pragma unroll
    for (int j = 0; j < 11; j++) {
      const int tt = t0 - 3 + j;
      rows[j] = make_uint4(0, 0, 0, 0);
      if (tt >= 0) rows[j] = *(const uint4*)(p.proj + (size_t)(n0 - 3 + j) * PCOLS + C_XBC + c);
      else if (seq >= 8) {
        const float* sc = p.state_conv + ((size_t)(seq - 8) * 3 + (tt + 3)) * 1536 + c;
        const float4 a = *(const float4*)sc, b = *(const float4*)(sc + 4);
        rows[j] = make_uint4(pack2(a.x, a.y), pack2(a.z, a.w), pack2(b.x, b.y), pack2(b.z, b.w));
      }
    }
    float w[4][8], cb[8];
#pragma unroll
    for (int j = 0; j < 4; j++) {
      const float4 a = *(const float4*)(p.conv_w + j * 1536 + c), b = *(const float4*)(p.conv_w + j * 1536 + c + 4);
      w[j][0] = a.x; w[j][1] = a.y; w[j][2] = a.z; w[j][3] = a.w; w[j][4] = b.x; w[j][5] = b.y; w[j][6] = b.z; w[j][7] = b.w;
    }
    {
      const float4 a = *(const float4*)(p.conv_b + c), b = *(const float4*)(p.conv_b + c + 4);
      cb[0] = a.x; cb[1] = a.y; cb[2] = a.z; cb[3] = a.w; cb[4] = b.x; cb[5] = b.y; cb[6] = b.z; cb[7] = b.w;
    }
#pragma unroll
    for (int k = 0; k < 8; k++) {
      float o[8];
#pragma unroll
      for (int e = 0; e < 8; e++) o[e] = cb[e];
#pragma unroll
      for (int j = 0; j < 4; j++) {
        const uint4 r = rows[k + j];
        const unsigned rs[4] = {r.x, r.y, r.z, r.w};
#pragma unroll
        for (int e = 0; e < 4; e++) { o[2 * e] += bflo(rs[e]) * w[j][2 * e]; o[2 * e + 1] += bfhi(rs[e]) * w[j][2 * e + 1]; }
      }
      *(uint4*)(p.xc + (size_t)(n0 + k) * 1536 + c) =
          make_uint4(pack2(siluf_(o[0]), siluf_(o[1])), pack2(siluf_(o[2]), siluf_(o[3])), pack2(siluf_(o[4]), siluf_(o[5])),
                     pack2(siluf_(o[6]), siluf_(o[7])));
    }
    if (t0 + 8 == T) {
      float* co = seq_out(p.out, seq, O_PCONV, O_SCONV, 3 * 1536);
#pragma unroll
      for (int j = 0; j < 3; j++) {
        const uint4 r = rows[8 + j];
        *(float4*)(co + j * 1536 + c) = make_float4(bflo(r.x), bfhi(r.x), bflo(r.y), bfhi(r.y));
        *(float4*)(co + j * 1536 + c + 4) = make_float4(bflo(r.z), bfhi(r.z), bflo(r.w), bfhi(r.w));
      }
    }
  } else if (tid < 192 + 32) {
    const int i = tid - 192;
#pragma unroll
    for (int e = 0; e < 4; e++) {
      const int pi = i * 4 + e, k = pi >> 4, h = pi & 15, n = n0 + k;
      const float raw = bf2f(p.proj[(size_t)n * PCOLS + C_DT + h]) + p.dt_bias[h];
      const float dt = softplusf_(raw);
      const float dA = -dt * expf(p.A_log[h]);
      p.dtb[n * 16 + h] = dt;
      p.decb[n * 16 + h] = dA;
    }
  }
}

__device__ void phase3(const P& p, int bid, int nb, char* smem) {
  for (int it = bid; it < 2 * (NT / 8); it += nb) {
    if (it < NT / 8) rwkv_lerp_item(p, it);
    else conv_prep_item(p, it - NT / 8);
  }
}
__device__ void phase3b(const P& p, int bid, int nb, char* smem) {
  for (int it = bid; it < 136 * 4; it += nb) rwkv_lora_item(p, it >> 2, it & 3, smem);
}

constexpr int TC = 32;
__device__ __forceinline__ void bf8_to_f(uint4 u, float4& lo, float4& hi) {
  lo = make_float4(bflo(u.x), bfhi(u.x), bflo(u.y), bfhi(u.y));
  hi = make_float4(bflo(u.z), bfhi(u.z), bflo(u.w), bfhi(u.w));
}
__device__ void rwkv_scan_item(const P& p, int seq, int h, int qr, char* smem) {
  const int T = seq < 8 ? 2048 : 8, nbase = seq < 8 ? seq * 2048 : NP + (seq - 8) * 8;
  float* Ld = (float*)smem;
  float* Lr = Ld + TC * 64; float* Lk = Lr + TC * 64; float* Lkk = Lk + TC * 64; float* Lb = Lkk + TC * 64;
  float* Lv = Lb + TC * 64;
  const int tid = TIDX, w = tid >> 6, lane = tid & 63, rl = w * 4 + (lane >> 4), ks = lane & 15;
  const int v = qr * 16 + rl;
  float S0 = 0.f, S1 = 0.f, S2 = 0.f, S3 = 0.f;
  if (seq >= 8) {
    float4 s = *(const float4*)(p.state_wkv + (((size_t)(seq - 8) * 8 + h) * 64 + v) * 64 + ks * 4);
    S0 = s.x; S1 = s.y; S2 = s.z; S3 = s.w;
  }
  const int st = tid >> 3, sk8 = (tid & 7) * 8;
  const int vt = tid >> 1, vr8 = (tid & 1) * 8;
  uint4 g0, g1, g2, g3, g4, gv;
  g0 = g1 = g2 = g3 = g4 = gv = make_uint4(0, 0, 0, 0);
#define RW_GLOAD(c0_)                                                                           \
  {                                                                                             \
    const int tcn = min(TC, T - (c0_));                                                         \
    if (st < tcn) {                                                                             \
      const u16* base = p.prep + (size_t)(nbase + (c0_) + st) * 3584 + h * 64 + sk8;            \
      g0 = *(const uint4*)(base); g1 = *(const uint4*)(base + 512); g2 = *(const uint4*)(base + 1024); \
      g3 = *(const uint4*)(base + 1536); g4 = *(const uint4*)(base + 2048);                     \
    }                                                                                           \
    if (tid < 64 && vt < tcn)                                                                   \
      gv = *(const uint4*)(p.prep + (size_t)(nbase + (c0_) + vt) * 3584 + 2560 + h * 64 + qr * 16 + vr8); \
  }
  RW_GLOAD(0);
  for (int c0 = 0; c0 < T; c0 += TC) {
    const int tc = min(TC, T - c0);
    __syncthreads();
    {
      float4 lo, hi;
      bf8_to_f(g0, lo, hi);
      lo.x = __expf(lo.x); lo.y = __expf(lo.y); lo.z = __expf(lo.z); lo.w = __expf(lo.w);
      hi.x = __expf(hi.x); hi.y = __expf(hi.y); hi.z = __expf(hi.z); hi.w = __expf(hi.w);
      *(float4*)(Ld + st * 64 + sk8) = lo; *(float4*)(Ld + st * 64 + sk8 + 4) = hi;
      bf8_to_f(g1, lo, hi); *(float4*)(Lr + st * 64 + sk8) = lo; *(float4*)(Lr + st * 64 + sk8 + 4) = hi;
      bf8_to_f(g2, lo, hi); *(float4*)(Lk + st * 64 + sk8) = lo; *(float4*)(Lk + st * 64 + sk8 + 4) = hi;
      bf8_to_f(g3, lo, hi); *(float4*)(Lkk + st * 64 + sk8) = lo; *(float4*)(Lkk + st * 64 + sk8 + 4) = hi;
      bf8_to_f(g4, lo, hi); *(float4*)(Lb + st * 64 + sk8) = lo; *(float4*)(Lb + st * 64 + sk8 + 4) = hi;
      if (tid < 64) { bf8_to_f(gv, lo, hi); *(float4*)(Lv + vt * 16 + vr8) = lo; *(float4*)(Lv + vt * 16 + vr8 + 4) = hi; }
    }
    __syncthreads();
    if (c0 + TC < T) RW_GLOAD(c0 + TC);
    u16* yo = p.proj + (size_t)(nbase + c0) * PCOLS + h * 64 + v;
    float4 kk0, d0, b0, k0_, r0, kk1, d1, b1, k1_, r1, kk2, d2, b2, k2_, r2, kk3, d3, b3, k3_, r3;
    float v0, v1, v2, v3;
#define RW_LD(KK, DD, BB, KX, RR, VV, t_)                                                        \
  {                                                                                              \
    KK = *(const float4*)(Lkk + (t_) * 64 + ks * 4); DD = *(const float4*)(Ld + (t_) * 64 + ks * 4); \
    BB = *(const float4*)(Lb + (t_) * 64 + ks * 4); KX = *(const float4*)(Lk + (t_) * 64 + ks * 4);  \
    RR = *(const float4*)(Lr + (t_) * 64 + ks * 4); VV = Lv[(t_) * 16 + rl];                      \
  }
#define RW_STEP(KK, DD, BB, KX, RR, VV, YY)                                                      \
  {                                                                                              \
    const float vk0 = VV * KX.x, vk1 = VV * KX.y, vk2 = VV * KX.z, vk3 = VV * KX.w;              \
    float sk = (S0 * KK.x + S1 * KK.y) + (S2 * KK.z + S3 * KK.w);                                \
    sk = allreduce16(sk);                                                                        \
    S0 = S0 * DD.x + (vk0 - sk * BB.x);                                                          \
    S1 = S1 * DD.y + (vk1 - sk * BB.y);                                                          \
    S2 = S2 * DD.z + (vk2 - sk * BB.z);                                                          \
    S3 = S3 * DD.w + (vk3 - sk * BB.w);                                                          \
    YY = allreduce16((S0 * RR.x + S1 * RR.y) + (S2 * RR.z + S3 * RR.w));                         \
  }
    for (int tt = 0; tt < tc; tt += 4) {
      RW_LD(kk0, d0, b0, k0_, r0, v0, tt)
      RW_LD(kk1, d1, b1, k1_, r1, v1, tt + 1)
      RW_LD(kk2, d2, b2, k2_, r2, v2, tt + 2)
      RW_LD(kk3, d3, b3, k3_, r3, v3, tt + 3)
      float y0, y1, y2, y3;
      RW_STEP(kk0, d0, b0, k0_, r0, v0, y0)
      RW_STEP(kk1, d1, b1, k1_, r1, v1, y1)
      RW_STEP(kk2, d2, b2, k2_, r2, v2, y2)
      RW_STEP(kk3, d3, b3, k3_, r3, v3, y3)
      if (ks == 0) {
        u16* yp = yo + (size_t)tt * PCOLS;
        yp[0] = f2bf(y0); yp[PCOLS] = f2bf(y1); yp[2 * (size_t)PCOLS] = f2bf(y2); yp[3 * (size_t)PCOLS] = f2bf(y3);
      }
    }
  }
  float* so = seq_out(p.out, seq, O_PWKV, O_SWKV, 8 * 4096);
  *(float4*)(so + ((size_t)h * 64 + v) * 64 + ks * 4) = make_float4(S0, S1, S2, S3);
}

__device__ void ssm_scan_item(const P& p, int seq, int head, int half, char* smem) {
  const int T = seq < 8 ? 2048 : 8, nbase = seq < 8 ? seq * 2048 : NP + (seq - 8) * 8;
  float* LB = (float*)smem;
  float* LC = LB + TC * 128;
  float* Lx = LC + TC * 128;
  float* Ldt = Lx + TC * 32;
  float* Ldec = Ldt + TC;
  const int tid = TIDX, pl = tid >> 3, ns = tid & 7;
  const int pp = half * 32 + pl, g = head >> 3;
  const float Dk = p.D_skip[head];
  float hs[16];
#pragma unroll
  for (int j = 0; j < 16; j++) hs[j] = 0.f;
  if (seq >= 8) {
    const float4* s4 = (const float4*)(p.state_ssm + (((size_t)(seq - 8) * 16 + head) * 64 + pp) * 128 + ns * 16);
#pragma unroll
    for (int j = 0; j < 4; j++) { float4 s = s4[j]; hs[4 * j] = s.x; hs[4 * j + 1] = s.y; hs[4 * j + 2] = s.z; hs[4 * j + 3] = s.w; }
  }
  uint4 gb0, gb1, gb2, gb3, gx; float gdt = 0.f, gdec = 0.f;
  gb0 = gb1 = gb2 = gb3 = gx = make_uint4(0, 0, 0, 0);
  const int bt = tid >> 5, bch = tid & 31;
  const u16* bsrc = p.xc + 1024 + (bch < 16 ? 0 : 256) + g * 128 + (bch & 15) * 8;
  const int xt = tid >> 2, xr8 = (tid & 3) * 8;
#define SS_GLOAD(c0_)                                                                          \
  {                                                                                            \
    const int tcn = min(TC, T - (c0_));                                                        \
    const size_t nb_ = (size_t)(nbase + (c0_));                                                \
    if (bt < tcn) gb0 = *(const uint4*)(bsrc + (nb_ + bt) * 1536);                             \
    if (bt + 8 < tcn) gb1 = *(const uint4*)(bsrc + (nb_ + bt + 8) * 1536);                     \
    if (bt + 16 < tcn) gb2 = *(const uint4*)(bsrc + (nb_ + bt + 16) * 1536);                   \
    if (bt + 24 < tcn) gb3 = *(const uint4*)(bsrc + (nb_ + bt + 24) * 1536);                   \
    if (tid < 128 && xt < tcn) gx = *(const uint4*)(p.xc + (nb_ + xt) * 1536 + head * 64 + half * 32 + xr8); \
    if (tid < tcn) { gdt = p.dtb[(nb_ + tid) * 16 + head]; gdec = p.decb[(nb_ + tid) * 16 + head]; } \
  }
  SS_GLOAD(0);
  for (int c0 = 0; c0 < T; c0 += TC) {
    const int tc = min(TC, T - c0);
    __syncthreads();
    {
      float* dstb = (bch < 16 ? LB : LC) + (bch & 15) * 8;
      float4 lo, hi;
      bf8_to_f(gb0, lo, hi); *(float4*)(dstb + bt * 128) = lo; *(float4*)(dstb + bt * 128 + 4) = hi;
      bf8_to_f(gb1, lo, hi); *(float4*)(dstb + (bt + 8) * 128) = lo; *(float4*)(dstb + (bt + 8) * 128 + 4) = hi;
      bf8_to_f(gb2, lo, hi); *(float4*)(dstb + (bt + 16) * 128) = lo; *(float4*)(dstb + (bt + 16) * 128 + 4) = hi;
      bf8_to_f(gb3, lo, hi); *(float4*)(dstb + (bt + 24) * 128) = lo; *(float4*)(dstb + (bt + 24) * 128 + 4) = hi;
      if (tid < 128) { bf8_to_f(gx, lo, hi); *(float4*)(Lx + xt * 32 + xr8) = lo; *(float4*)(Lx + xt * 32 + xr8 + 4) = hi; }
      if (tid < TC) { Ldt[tid] = gdt; Ldec[tid] = __expf(gdec); }
    }
    __syncthreads();
    if (c0 + TC < T) SS_GLOAD(c0 + TC);
    u16* yo = p.proj + (size_t)(nbase + c0) * PCOLS + C_XBC + head * 64 + pp;
    float4 B0 = *(const float4*)(LB + ns * 16), B1 = *(const float4*)(LB + ns * 16 + 4), B2 = *(const float4*)(LB + ns * 16 + 8),
           B3 = *(const float4*)(LB + ns * 16 + 12);
    float4 C0 = *(const float4*)(LC + ns * 16), C1 = *(const float4*)(LC + ns * 16 + 4), C2 = *(const float4*)(LC + ns * 16 + 8),
           C3 = *(const float4*)(LC + ns * 16 + 12);
    float xv = Lx[pl], dtv = Ldt[0], dec = Ldec[0];
    for (int tt = 0; tt < tc; tt++) {
      const int tn = min(tt + 1, tc - 1);
      const float* nB = LB + tn * 128 + ns * 16;
      const float* nC = LC + tn * 128 + ns * 16;
      const float4 nB0 = *(const float4*)(nB), nB1 = *(const float4*)(nB + 4), nB2 = *(const float4*)(nB + 8), nB3 = *(const float4*)(nB + 12);
      const float4 nC0 = *(const float4*)(nC), nC1 = *(const float4*)(nC + 4), nC2 = *(const float4*)(nC + 8), nC3 = *(const float4*)(nC + 12);
      const float nxv = Lx[tn * 32 + pl], ndt = Ldt[tn], ndec = Ldec[tn];
      const float dtx = dtv * xv;
      hs[0] = hs[0] * dec + dtx * B0.x; hs[1] = hs[1] * dec + dtx * B0.y; hs[2] = hs[2] * dec + dtx * B0.z; hs[3] = hs[3] * dec + dtx * B0.w;
      hs[4] = hs[4] * dec + dtx * B1.x; hs[5] = hs[5] * dec + dtx * B1.y; hs[6] = hs[6] * dec + dtx * B1.z; hs[7] = hs[7] * dec + dtx * B1.w;
      hs[8] = hs[8] * dec + dtx * B2.x; hs[9] = hs[9] * dec + dtx * B2.y; hs[10] = hs[10] * dec + dtx * B2.z; hs[11] = hs[11] * dec + dtx * B2.w;
      hs[12] = hs[12] * dec + dtx * B3.x; hs[13] = hs[13] * dec + dtx * B3.y; hs[14] = hs[14] * dec + dtx * B3.z; hs[15] = hs[15] * dec + dtx * B3.w;
      float y0 = hs[0] * C0.x + hs[1] * C0.y + hs[2] * C0.z + hs[3] * C0.w;
      float y1 = hs[4] * C1.x + hs[5] * C1.y + hs[6] * C1.z + hs[7] * C1.w;
      float y2 = hs[8] * C2.x + hs[9] * C2.y + hs[10] * C2.z + hs[11] * C2.w;
      float y3 = hs[12] * C3.x + hs[13] * C3.y + hs[14] * C3.z + hs[15] * C3.w;
      float yp = allreduce8((y0 + y1) + (y2 + y3));
      if (ns == 0) yo[(size_t)tt * PCOLS] = f2bf(yp + Dk * xv);
      B0 = nB0; B1 = nB1; B2 = nB2; B3 = nB3; C0 = nC0; C1 = nC1; C2 = nC2; C3 = nC3; xv = nxv; dtv = ndt; dec = ndec;
    }
  }
  float* so = seq_out(p.out, seq, O_PSSM, O_SSSM, 16 * 8192);
  float4* o4 = (float4*)(so + ((size_t)head * 64 + pp) * 128 + ns * 16);
#pragma unroll
  for (int j = 0; j < 4; j++) o4[j] = make_float4(hs[4 * j], hs[4 * j + 1], hs[4 * j + 2], hs[4 * j + 3]);
}

__device__ void ssd_prompt_item(const P& p, int seq, int head, char* smem) {
  const int nbase = seq * 2048, g = head >> 3;
  char* sC = smem;
  char* sB = smem + 17408;
  char* sBT = smem + 34816;
  char* sXT = smem + 53248;
  char* sH = smem + 62464;
  float* sS = (float*)(smem + 79872);
  const int tid = TIDX, lane = tid & 63, w = tid >> 6, fr = lane & 15, q = lane >> 4;
  const float Dk = p.D_skip[head];
  f32x4 H[8];
#pragma unroll
  for (int i = 0; i < 8; i++) H[i] = f32x4{0.f, 0.f, 0.f, 0.f};
  __syncthreads();
  for (int i = tid; i < 17408 / 16; i += 256) *(uint4*)(sH + i * 16) = make_uint4(0, 0, 0, 0);
  uint4 gB0, gB1, gB2, gB3, gC0, gC1, gC2, gC3, gX0, gX1;
  float gdt, gdA;
#define SSD_LOAD(t0_)                                                                         \
  {                                                                                           \
    const size_t nn_ = (size_t)(nbase + (t0_) + lane);                                        \
    const u16* row_ = p.xc + nn_ * 1536;                                                      \
    const u16* rb_ = row_ + 1024 + g * 128 + w * 32;                                          \
    gB0 = *(const uint4*)(rb_); gB1 = *(const uint4*)(rb_ + 8); gB2 = *(const uint4*)(rb_ + 16); gB3 = *(const uint4*)(rb_ + 24); \
    gC0 = *(const uint4*)(rb_ + 256); gC1 = *(const uint4*)(rb_ + 264); gC2 = *(const uint4*)(rb_ + 272); gC3 = *(const uint4*)(rb_ + 280); \
    gX0 = *(const uint4*)(row_ + head * 64 + w * 16); gX1 = *(const uint4*)(row_ + head * 64 + w * 16 + 8); \
    gdt = p.dtb[nn_ * 16 + head]; gdA = p.decb[nn_ * 16 + head];                              \
  }
#define SSD_PUT_T(dst_, r0_, u_, sc_)                                                         \
  {                                                                                           \
    const unsigned us_[4] = {u_.x, u_.y, u_.z, u_.w};                                         \
    _Pragma("unroll") for (int e = 0; e < 4; e++) {                                           \
      *(u16*)(dst_ + ((r0_) + 2 * e) * 144 + lane * 2) = f2bf(bflo(us_[e]) * (sc_));          \
      *(u16*)(dst_ + ((r0_) + 2 * e + 1) * 144 + lane * 2) = f2bf(bfhi(us_[e]) * (sc_));      \
    }                                                                                         \
  }
  SSD_LOAD(0);
#pragma unroll 1
  for (int c = 0; c < 32; c++) {
    const int t0 = c * 64;
    float cs = gdA;
#pragma unroll
    for (int o = 1; o < 64; o <<= 1) { const float v = __shfl_up(cs, o, 64); if (lane >= o) cs += v; }
    const float cs63 = __shfl(cs, 63, 64);
    const float wt = gdt * __expf(cs63 - cs);
    __syncthreads();
    if (w == 0) { sS[lane] = cs; sS[64 + lane] = __expf(cs); sS[128 + lane] = gdt; }
    {
      char* rc = sC + lane * 272 + w * 64;
      char* rb = sB + lane * 272 + w * 64;
      *(uint4*)(rc) = gC0; *(uint4*)(rc + 16) = gC1; *(uint4*)(rc + 32) = gC2; *(uint4*)(rc + 48) = gC3;
      *(uint4*)(rb) = gB0; *(uint4*)(rb + 16) = gB1; *(uint4*)(rb + 32) = gB2; *(uint4*)(rb + 48) = gB3;
      SSD_PUT_T(sBT, w * 32, gB0, wt) SSD_PUT_T(sBT, w * 32 + 8, gB1, wt) SSD_PUT_T(sBT, w * 32 + 16, gB2, wt)
      SSD_PUT_T(sBT, w * 32 + 24, gB3, wt) SSD_PUT_T(sXT, w * 16, gX0, 1.f) SSD_PUT_T(sXT, w * 16 + 8, gX1, 1.f)
    }
    __syncthreads();
    if (c + 1 < 32) SSD_LOAD(t0 + 64);
    f32x4 cb[4], yo[4];
#pragma unroll
    for (int i = 0; i < 4; i++) { cb[i] = f32x4{0.f, 0.f, 0.f, 0.f}; yo[i] = f32x4{0.f, 0.f, 0.f, 0.f}; }
    {
      bf16x8 af[4];
#pragma unroll
      for (int ks = 0; ks < 4; ks++) af[ks] = *(const bf16x8*)(sC + (16 * w + fr) * 272 + ks * 64 + q * 16);
#pragma unroll
      for (int nn = 0; nn < 4; nn++)
#pragma unroll
        for (int ks = 0; ks < 4; ks++) {
          const bf16x8 bb = *(const bf16x8*)(sB + (16 * nn + fr) * 272 + ks * 64 + q * 16);
          cb[nn] = __builtin_amdgcn_mfma_f32_16x16x32_bf16(af[ks], bb, cb[nn], 0, 0, 0);
        }
#pragma unroll
      for (int pt = 0; pt < 4; pt++)
#pragma unroll
        for (int ks = 0; ks < 4; ks++) {
          const bf16x8 bb = *(const bf16x8*)(sH + (16 * pt + fr) * 272 + ks * 64 + q * 16);
          yo[pt] = __builtin_amdgcn_mfma_f32_16x16x32_bf16(af[ks], bb, yo[pt], 0, 0, 0);
        }
    }
    __syncthreads();
#pragma unroll
    for (int j = 0; j < 4; j++) {
      const int l = 16 * w + q * 4 + j;
      const float csl = sS[l];
#pragma unroll
      for (int nn = 0; nn < 4; nn++) {
        const int sidx = 16 * nn + fr;
        const float gv = (sidx <= l) ? cb[nn][j] * __expf(csl - sS[sidx]) * sS[128 + sidx] : 0.f;
        *(u16*)(sB + l * 144 + sidx * 2) = f2bf(gv);
      }
    }
    f32x4 yd[4];
#pragma unroll
    for (int i = 0; i < 4; i++) yd[i] = f32x4{0.f, 0.f, 0.f, 0.f};
#pragma unroll
    for (int ks = 0; ks < 2; ks++) {
      const bf16x8 aa = *(const bf16x8*)(sB + (16 * w + fr) * 144 + ks * 64 + q * 16);
#pragma unroll
      for (int pt = 0; pt < 4; pt++) {
        const bf16x8 bb = *(const bf16x8*)(sXT + (16 * pt + fr) * 144 + ks * 64 + q * 16);
        yd[pt] = __builtin_amdgcn_mfma_f32_16x16x32_bf16(aa, bb, yd[pt], 0, 0, 0);
      }
    }
#pragma unroll
    for (int j = 0; j < 4; j++) {
      const int l = 16 * w + q * 4 + j;
      const float el = sS[64 + l];
      u16* yrow = p.proj + (size_t)(nbase + t0 + l) * PCOLS + C_XBC + head * 64 + fr;
#pragma unroll
      for (int pt = 0; pt < 4; pt++) {
        const float xs = bf2f(*(const u16*)(sXT + (16 * pt + fr) * 144 + l * 2));
        yrow[16 * pt] = f2bf(yd[pt][j] + el * yo[pt][j] + Dk * xs);
      }
    }
    const float ach = __expf(cs63);
#pragma unroll
    for (int nt = 0; nt < 8; nt++) { H[nt][0] *= ach; H[nt][1] *= ach; H[nt][2] *= ach; H[nt][3] *= ach; }
#pragma unroll
    for (int ks = 0; ks < 2; ks++) {
      const bf16x8 aa = *(const bf16x8*)(sXT + (16 * w + fr) * 144 + ks * 64 + q * 16);
#pragma unroll
      for (int nt = 0; nt < 8; nt++) {
        const bf16x8 bb = *(const bf16x8*)(sBT + (16 * nt + fr) * 144 + ks * 64 + q * 16);
        H[nt] = __builtin_amdgcn_mfma_f32_16x16x32_bf16(aa, bb, H[nt], 0, 0, 0);
      }
    }
#pragma unroll
    for (int nt = 0; nt < 8; nt++)
#pragma unroll
      for (int j = 0; j < 4; j++) *(u16*)(sH + (16 * w + q * 4 + j) * 272 + (16 * nt + fr) * 2) = f2bf(H[nt][j]);
  }
  float* so = p.out + O_PSSM + ((size_t)seq * 16 + head) * 8192;
#pragma unroll
  for (int nt = 0; nt < 8; nt++)
#pragma unroll
    for (int j = 0; j < 4; j++) so[(16 * w + q * 4 + j) * 128 + 16 * nt + fr] = H[nt][j];
  __syncthreads();
}

constexpr int P4_RP = 256, P4_SP = 128, P4_RS = 4096, P4_SS = 4096;
#define XB_QUEUE 3600
__device__ void phase4(const P& p, int bid, int nb, char* smem) {
  for (int it = bid; it < P4_RP + P4_SP; it += nb) {
    if (it < P4_RP) rwkv_scan_item(p, it >> 5, (it >> 2) & 7, it & 3, smem);
    else { const int i = it - P4_RP; ssd_prompt_item(p, i >> 4, i & 15, smem); }
  }
  volatile int* slot = (volatile int*)(smem + LDS_BYTES - 32);
  for (;;) {
    __syncthreads();
    if (TIDX == 0) *slot = (int)atomicAdd(&p.bar[XB_QUEUE], 1u);
    __syncthreads();
    int i = *slot;
    if (i >= P4_RS + P4_SS) break;
    if (i < P4_RS) rwkv_scan_item(p, 8 + (i >> 5), (i >> 2) & 7, i & 3, smem);
    else { i -= P4_RS; ssm_scan_item(p, 8 + (i >> 5), (i >> 1) & 15, i & 1, smem); }
  }
}

__device__ void phase5(const P& p, int bid, int nb) {
  const int lane = TIDX & 63, wid = TIDX >> 6;
  for (int it = bid; it < NT / 4; it += nb) {
    const int n = it * 4 + wid;
    const uint4 sy0 = *(const uint4*)(p.proj + (size_t)n * PCOLS + C_XBC + lane * 16);
    const uint4 sy1 = *(const uint4*)(p.proj + (size_t)n * PCOLS + C_XBC + lane * 16 + 8);
    const uint4 sz0 = *(const uint4*)(p.proj + (size_t)n * PCOLS + C_Z + lane * 16);
    const uint4 sz1 = *(const uint4*)(p.proj + (size_t)n * PCOLS + C_Z + lane * 16 + 8);
    {
      const int c = lane * 8;
      uint4 yu = *(const uint4*)(p.proj + (size_t)n * PCOLS + c);
      const u16* pr = p.prep + (size_t)n * 3584 + c;
      uint4 ru = *(const uint4*)(pr + 512), ku = *(const uint4*)(pr + 1024), vu = *(const uint4*)(pr + 2560),
            gu = *(const uint4*)(pr + 3072);
      unsigned ys[4] = {yu.x, yu.y, yu.z, yu.w}, rs[4] = {ru.x, ru.y, ru.z, ru.w}, ks_[4] = {ku.x, ku.y, ku.z, ku.w},
               vs[4] = {vu.x, vu.y, vu.z, vu.w}, gs[4] = {gu.x, gu.y, gu.z, gu.w};
      float y[8], r[8], k[8], v[8], g[8];
#pragma unroll
      for (int e = 0; e < 4; e++) {
        y[2 * e] = bflo(ys[e]); y[2 * e + 1] = bfhi(ys[e]);
        r[2 * e] = bflo(rs[e]); r[2 * e + 1] = bfhi(rs[e]);
        k[2 * e] = bflo(ks_[e]); k[2 * e + 1] = bfhi(ks_[e]);
        v[2 * e] = bflo(vs[e]); v[2 * e + 1] = bfhi(vs[e]);
        g[2 * e] = bflo(gs[e]); g[2 * e + 1] = bfhi(gs[e]);
      }
      float s = 0.f, bn = 0.f;
#pragma unroll
      for (int e = 0; e < 8; e++) { s += y[e]; bn += r[e] * k[e] * p.rw_r_k[c + e]; }
      s = allreduce8(s); bn = allreduce8(bn);
      const float mean = s * (1.f / 64.f);
      float vr = 0.f;
#pragma unroll
      for (int e = 0; e < 8; e++) { const float d = y[e] - mean; vr += d * d; }
      vr = allreduce8(vr) * (1.f / 64.f);
      const float rs_ = rsqrtf(vr + 64e-5f);
      float o[8];
#pragma unroll
      for (int e = 0; e < 8; e++) {
        const float yn = (y[e] - mean) * rs_ * p.rw_ln_w[c + e] + p.rw_ln_b[c + e];
        o[e] = (yn + bn * v[e]) * g[e];
      }
      uint4 ou; ou.x = pack2(o[0], o[1]); ou.y = pack2(o[2], o[3]); ou.z = pack2(o[4], o[5]); ou.w = pack2(o[6], o[7]);
      *(uint4*)(p.oa + (size_t)n * 512 + c) = ou;
    }
    {
      const int c = lane * 16;
      float yv[16];
      float ss = 0.f;
#pragma unroll
      for (int hh = 0; hh < 2; hh++) {
        const uint4 yu = hh ? sy1 : sy0;
        const uint4 zu = hh ? sz1 : sz0;
        unsigned ys[4] = {yu.x, yu.y, yu.z, yu.w}, zs[4] = {zu.x, zu.y, zu.z, zu.w};
#pragma unroll
        for (int e = 0; e < 4; e++) {
          const float a = bflo(ys[e]) * siluf_(bflo(zs[e])), b = bfhi(ys[e]) * siluf_(bfhi(zs[e]));
          yv[hh * 8 + 2 * e] = a; yv[hh * 8 + 2 * e + 1] = b;
          ss += a * a + b * b;
        }
      }
#pragma unroll
      for (int o = 16; o >= 1; o >>= 1) ss += __shfl_xor(ss, o, 64);
      const float rstd = rsqrtf(ss * (1.f / 512.f) + 1e-6f);
      unsigned ou[8];
#pragma unroll
      for (int e = 0; e < 8; e++)
        ou[e] = pack2(yv[2 * e] * rstd * p.ssm_norm_w[c + 2 * e], yv[2 * e + 1] * rstd * p.ssm_norm_w[c + 2 * e + 1]);
      *(uint4*)(p.ob + (size_t)n * 1024 + c) = make_uint4(ou[0], ou[1], ou[2], ou[3]);
      *(uint4*)(p.ob + (size_t)n * 1024 + c + 8) = make_uint4(ou[4], ou[5], ou[6], ou[7]);
    }
  }
}

__device__ void phase6(const P& p, int bid, int nb, char* smem) {
  TileIter ti(bid, nb, 136, 8);
  int mt, nt;
  while (ti.next(mt, nt)) {
    f32x4 ac[4][4];
    unsigned sg[4][4][2];
    u16* Lt = (u16*)smem;
    zero_acc(ac);
    gemm_tile_glds(p.xn, D, mt * 128, p.w_inT + (size_t)G_A * D, D, nt * 128, D, ac, smem);
#pragma unroll
    for (int m = 0; m < 4; m++)
#pragma unroll
      for (int n = 0; n < 4; n++) {
        sg[m][n][0] = pack2(sigmoidf_(ac[m][n][0]), sigmoidf_(ac[m][n][1]));
        sg[m][n][1] = pack2(sigmoidf_(ac[m][n][2]), sigmoidf_(ac[m][n][3]));
      }
    zero_acc(ac);
    gemm_tile_glds(p.oa, 512, mt * 128, p.w_paT, 512, nt * 128, 512, ac, smem);
    ACC_FOREACH({
      const unsigned gu = sg[m][n][j >> 1];
      Lt[row * 136 + col] = f2bf(((j & 1) ? bfhi(gu) : bflo(gu)) * ac[m][n][j]);
    })
    tile_out_bf16(smem, p.merged, D, mt * 128, nt * 128, 128);
    zero_acc(ac);
    gemm_tile_glds(p.xn, D, mt * 128, p.w_inT + (size_t)G_B * D, D, nt * 128, D, ac, smem);
#pragma unroll
    for (int m = 0; m < 4; m++)
#pragma unroll
      for (int n = 0; n < 4; n++) {
        sg[m][n][0] = pack2(sigmoidf_(ac[m][n][0]), sigmoidf_(ac[m][n][1]));
        sg[m][n][1] = pack2(sigmoidf_(ac[m][n][2]), sigmoidf_(ac[m][n][3]));
      }
    zero_acc(ac);
    gemm_tile_glds(p.ob, D, mt * 128, p.w_pbT, D, nt * 128, D, ac, smem);
    ACC_FOREACH({
      const unsigned gu = sg[m][n][j >> 1];
      Lt[row * 136 + col] = f2bf(((j & 1) ? bfhi(gu) : bflo(gu)) * ac[m][n][j]);
    })
    __syncthreads();
    {
      const int tid = TIDX;
#pragma unroll
      for (int i = 0; i < 8; i++) {
        const int id = tid + i * 256, row = id >> 4, ch = id & 15;
        u16* gp = p.merged + (size_t)(mt * 128 + row) * D + nt * 128 + ch * 8;
        const uint4 a = *(const uint4*)gp, b = *(const uint4*)(smem + row * 272 + ch * 16);
        uint4 o;
        o.x = pack2(bflo(a.x) + bflo(b.x), bfhi(a.x) + bfhi(b.x));
        o.y = pack2(bflo(a.y) + bflo(b.y), bfhi(a.y) + bfhi(b.y));
        o.z = pack2(bflo(a.z) + bflo(b.z), bfhi(a.z) + bfhi(b.z));
        o.w = pack2(bflo(a.w) + bflo(b.w), bfhi(a.w) + bfhi(b.w));
        *(uint4*)gp = o;
      }
    }
  }
}

constexpr int P7_G = 136 * 8, P7_CV = 16384;
constexpr float U_SCALE = 256.f, V_SCALE = 32.f;
__device__ void phase7(const P& p, int bid, int nb, char* smem) {
  {
    TileIter ti(bid, nb, 136, 8);
    int mt, nt;
    while (ti.next(mt, nt)) {
      f32x4 acc[4][4];
      zero_acc(acc);
      gemm_tile_glds(p.merged, D, mt * 128, p.w_outT, D, nt * 128, D, acc, smem);
      float* Lf = (float*)smem;
      ACC_FOREACH({ Lf[row * 132 + col] = acc[m][n][j]; })
      __syncthreads();
      {
        const int tid = TIDX;
#pragma unroll 4
        for (int i = 0; i < 16; i++) {
          const int id = tid + i * 256, row = id >> 5, c4 = (id & 31) * 4;
          const int nn = mt * 128 + row, c = nt * 128 + c4;
          int seq, t, T; tok2seq(nn, seq, t, T);
          const float4 a = *(const float4*)(Lf + row * 132 + c4);
          const float4 g = *(const float4*)(p.mod + (size_t)seq * 8192 + 2048 + c);
          const float4 x = *(const float4*)(xrow(p, nn) + c);
          *(float4*)(p.out + O_Y + (size_t)nn * D + c) = make_float4(x.x + g.x * a.x, x.y + g.y * a.y, x.z + g.z * a.z, x.w + g.w * a.w);
        }
      }
    }
  }
  int cw = bid, cn = nb;
  if (nb == 512) { const int lb = bid >> 3; if (lb < 8) return; cw = (bid & 7) * 56 + (lb - 8); cn = 448; }
  for (int it0 = cw; it0 < P7_CV; it0 += 4 * cn) {
    const int tid = TIDX;
    float4 va[4], vb[4];
#pragma unroll
    for (int r = 0; r < 4; r++) {
      const int it = it0 + r * cn;
      if (it < P7_CV) {
        const float* src = it < 8192 ? p.peer_u + (size_t)it * 2048 : p.peer_v + (size_t)(it - 8192) * 2048;
        const float4* s4 = (const float4*)src + tid * 2;
        va[r] = s4[0]; vb[r] = s4[1];
      }
    }
#pragma unroll
    for (int r = 0; r < 4; r++) {
      const int it = it0 + r * cn;
      if (it < P7_CV) {
        unsigned char* dst = it < 8192 ? (unsigned char*)p.ub + (size_t)it * 2048 : (unsigned char*)p.vb + (size_t)(it - 8192) * 2048;
        const float sc = it < 8192 ? U_SCALE : V_SCALE;
        const float4 a = va[r], b = vb[r];
        int lo = __builtin_amdgcn_cvt_pk_fp8_f32(a.x * sc, a.y * sc, 0, false);
        lo = __builtin_amdgcn_cvt_pk_fp8_f32(a.z * sc, a.w * sc, lo, true);
        int hi = __builtin_amdgcn_cvt_pk_fp8_f32(b.x * sc, b.y * sc, 0, false);
        hi = __builtin_amdgcn_cvt_pk_fp8_f32(b.z * sc, b.w * sc, hi, true);
        *((uint2*)dst + tid) = make_uint2((unsigned)lo, (unsigned)hi);
      }
    }
  }
}

__device__ void phase9(const P& p, int bid, int nb, char* smem) {
  const int tid = TIDX, lane = tid & 63, wid = tid >> 6, wr = wid >> 1, wc = wid & 1, fr = lane & 15,
            fq = lane >> 4;
  TileIter ti(bid, nb, 136, 16);
  int mt, nt;
  while (ti.next(mt, nt)) {
    f32x4 acc[4][4];
    zero_acc(acc);
    gemm_tile_glds(p.xn, D, mt * 128, p.wqT, D, nt * 128, D, acc, smem);
    u16* Lq = (u16*)smem;
    ACC_FOREACH({ Lq[row * 136 + col] = f2bf(acc[m][n][j]); })
    __syncthreads();
    f32x4 sc[4][4];
    zero_acc(sc);
    const u16* kb = p.keysb + (size_t)nt * 128 * 128;
#pragma unroll 1
    for (int s = 0; s < 4; s++) {
      bf16x8 af[4], bfr[4];
#pragma unroll
      for (int m = 0; m < 4; m++) af[m] = *(const bf16x8*)((const char*)Lq + (wr * 64 + m * 16 + fr) * 272 + s * 64 + fq * 16);
#pragma unroll
      for (int n = 0; n < 4; n++) bfr[n] = *(const bf16x8*)(kb + (size_t)(wc * 64 + n * 16 + fr) * 128 + s * 32 + fq * 8);
#pragma unroll
      for (int m = 0; m < 4; m++)
#pragma unroll
        for (int n = 0; n < 4; n++) sc[m][n] = __builtin_amdgcn_mfma_f32_16x16x32_bf16(af[m], bfr[n], sc[m][n], 0, 0, 0);
    }
    __syncthreads();
    float* Ls = (float*)smem;
#pragma unroll
    for (int m = 0; m < 4; m++)
#pragma unroll
      for (int n = 0; n < 4; n++)
#pragma unroll
        for (int j = 0; j < 4; j++) {
          const int kc = wc * 64 + n * 16 + fr;
          int sb = __float_as_int(sc[m][n][j]);
          sb ^= (sb >> 31) & 0x7fffffff;
          ((int*)Ls)[(wr * 64 + m * 16 + fq * 4 + j) * 129 + kc] = (sb & ~127) | (127 - kc);
        }
    __syncthreads();
    {
      const int row = tid >> 1, half = tid & 1;
      float* Lr = Ls + row * 129;
      const size_t ob = ((size_t)(mt * 128 + row) * 16 + nt) * 16;
      int* Li = (int*)Lr;
      for (int r = 0; r < 16; r++) {
        int best = (int)0x80000000;
#pragma unroll 8
        for (int i = 0; i < 64; i++) best = max(best, Li[half + 2 * i]);
        best = max(best, __shfl_xor(best, 1, 64));
        const int bi = 127 - (best & 127);
        if ((bi & 1) == half) Li[bi] = (int)0x80000000;
        if (half == 0) {
          int vb = best & ~127;
          vb ^= (vb >> 31) & 0x7fffffff;
          p.topv[ob + r] = __int_as_float(vb);
          p.topi[ob + r] = bi;
        }
      }
    }
    __syncthreads();
  }
}

__device__ __forceinline__ void cand_ij(int lane, int& ci, int& cj) {
  int i = 0, rem = lane;
#pragma unroll
  for (int r = 0; r < 16; r++) {
    const int cnt = 16 / (r + 1);
    if (i == r && rem >= cnt) { rem -= cnt; i = r + 1; }
  }
  ci = i; cj = rem;
}

typedef __attribute__((ext_vector_type(2))) __bf16 bf2_t;
__device__ __forceinline__ float dot2bf(unsigned a, unsigned b, float c) {
  return __builtin_amdgcn_fdot2_f32_bf16(__builtin_bit_cast(bf2_t, a), __builtin_bit_cast(bf2_t, b), c, false);
}
template <int CTRL, int RM>
__device__ __forceinline__ float dppf_m(float x) {
  return __int_as_float(__builtin_amdgcn_update_dpp(0, __float_as_int(x), CTRL, RM, 0xf, false));
}
__device__ __forceinline__ float wave_sum_l63(float x) {
  x += dppf<0xB1>(x);
  x += dppf<0x4E>(x);
  x += dppf<0x141>(x);
  x += dppf<0x140>(x);
  x += dppf_m<0x142, 0xA>(x);
  x += dppf_m<0x143, 0xC>(x);
  return x;
}
__device__ __forceinline__ float readlane_f(float x, int l) {
  return __int_as_float(__builtin_amdgcn_readlane(__float_as_int(x), l));
}
__device__ __forceinline__ void axpy8(float* acc, float w, uint4 v) {
  acc[0] += w * bflo(v.x); acc[1] += w * bfhi(v.x); acc[2] += w * bflo(v.y); acc[3] += w * bfhi(v.y);
  acc[4] += w * bflo(v.z); acc[5] += w * bfhi(v.z); acc[6] += w * bflo(v.w); acc[7] += w * bfhi(v.w);
}

typedef float f2_t __attribute__((ext_vector_type(2)));
__device__ __forceinline__ void fp8x16_to_f32(const uint4 v, float* o) {
  const unsigned w[4] = {v.x, v.y, v.z, v.w};
#pragma unroll
  for (int i = 0; i < 4; i++) {
    const f2_t lo = __builtin_amdgcn_cvt_pk_f32_fp8((int)w[i], false);
    const f2_t hi = __builtin_amdgcn_cvt_pk_f32_fp8((int)w[i], true);
    o[4 * i] = lo.x; o[4 * i + 1] = lo.y; o[4 * i + 2] = hi.x; o[4 * i + 3] = hi.y;
  }
}

__device__ void phase10(const P& p, int bid, int nb) {
  const int lane = TIDX & 63, wid = TIDX >> 6;
  int ci, cj; cand_ij(lane < 50 ? lane : 0, ci, cj);
  const unsigned char* ub8 = (const unsigned char*)p.ub;
  const unsigned char* vb8 = (const unsigned char*)p.vb;
  for (int it = bid; it < NT / 4; it += nb) {
    const int n = it * 4 + wid;
    int seq, t, T; tok2seq(n, seq, t, T);
    float xv[16];
    {
      const uint4 a = *(const uint4*)(p.xn + (size_t)n * D + lane * 16), b = *(const uint4*)(p.xn + (size_t)n * D + lane * 16 + 8);
      const unsigned as[4] = {a.x, a.y, a.z, a.w}, bs[4] = {b.x, b.y, b.z, b.w};
#pragma unroll
      for (int e = 0; e < 4; e++) { xv[2 * e] = bflo(as[e]); xv[2 * e + 1] = bfhi(as[e]); xv[8 + 2 * e] = bflo(bs[e]); xv[8 + 2 * e + 1] = bfhi(bs[e]); }
    }
    float acc[16];
#pragma unroll
    for (int e = 0; e < 16; e++) acc[e] = 0.f;
#pragma unroll 1
    for (int h = 0; h < 8; h++) {
      const size_t base = ((size_t)n * 16 + h * 2) * 16;
      float cand = -INFINITY; int eid = 0;
      if (lane < 50) {
        cand = p.topv[base + ci] + p.topv[base + 16 + cj];
        eid = p.topi[base + ci] * 128 + p.topi[base + 16 + cj];
      }
      int rank = 0;
#pragma unroll
      for (int m = 0; m < 50; m++) {
        const float cm = readlane_f(cand, m);
        rank += ((cm > cand) || (cm == cand && m < lane)) ? 1 : 0;
      }
      const bool sel = (lane < 50) && (rank < 16);
      unsigned long long mask = __ballot(sel);
      const float mx = readlane_f(cand, __builtin_ctzll(__ballot(sel && rank == 0)));
      const float ex = sel ? __expf(cand - mx) : 0.f;
      const float den = readlane_f(wave_sum_l63(ex), 63);
      const float gate = ex / den;
#pragma unroll 1
      for (int hf = 0; hf < 2; hf++) {
        int ek[8]; float gk[8];
#pragma unroll
        for (int k = 0; k < 8; k++) {
          const int src = __builtin_ctzll(mask);
          mask &= mask - 1;
          ek[k] = __builtin_amdgcn_readlane(eid, src);
          gk[k] = readlane_f(gate, src);
        }
        uint4 uu[8], vv[8];
#pragma unroll
        for (int j = 0; j < 8; j++) uu[j] = *(const uint4*)(ub8 + (size_t)ek[j] * D + lane * 16);
#pragma unroll
        for (int j = 0; j < 8; j++) vv[j] = *(const uint4*)(vb8 + (size_t)ek[j] * D + lane * 16);
        float dv = 0.f;
#pragma unroll
        for (int j = 0; j < 8; j++) {
          float uf[16];
          fp8x16_to_f32(uu[j], uf);
          float d0 = 0.f, d1 = 0.f;
#pragma unroll
          for (int e = 0; e < 8; e++) { d0 += uf[2 * e] * xv[2 * e]; d1 += uf[2 * e + 1] * xv[2 * e + 1]; }
          const float ds = readlane_f(wave_sum_l63(d0 + d1), 63);
          dv = (lane == j) ? ds : dv;
        }
        dv *= (1.f / U_SCALE);
        const float act = 0.5f * dv * (1.f + erff(dv * 0.70710678118654752f));
#pragma unroll
        for (int j = 0; j < 8; j++) {
          const float w = readlane_f(act, j) * gk[j] * (1.f / V_SCALE);
          float vf[16];
          fp8x16_to_f32(vv[j], vf);
#pragma unroll
          for (int e = 0; e < 16; e++) acc[e] += w * vf[e];
        }
      }
    }
    float* yr = p.out + O_Y + (size_t)n * D + lane * 16;
    const float* md = p.mod + (size_t)seq * 8192 + lane * 16;
    float x2[16];
    float ss = 0.f;
#pragma unroll
    for (int q4 = 0; q4 < 4; q4++) {
      const float4 a = *(const float4*)(yr + q4 * 4), g = *(const float4*)(md + 5120 + q4 * 4);
      x2[q4 * 4 + 0] = a.x + g.x * acc[q4 * 4 + 0]; x2[q4 * 4 + 1] = a.y + g.y * acc[q4 * 4 + 1];
      x2[q4 * 4 + 2] = a.z + g.z * acc[q4 * 4 + 2]; x2[q4 * 4 + 3] = a.w + g.w * acc[q4 * 4 + 3];
    }
#pragma unroll
    for (int e = 0; e < 16; e++) ss += x2[e] * x2[e];
    ss = readlane_f(wave_sum_l63(ss), 63);
    const float rstd = rsqrtf(ss * (1.f / 1024.f) + 1e-6f);
#pragma unroll
    for (int q4 = 0; q4 < 4; q4++) {
      const float4 fg = *(const float4*)(p.final_g + lane * 16 + q4 * 4), sc = *(const float4*)(md + 7168 + q4 * 4),
                   sh = *(const float4*)(md + 6144 + q4 * 4);
      float4 o;
      o.x = x2[q4 * 4 + 0] * rstd * fg.x * (1.f + sc.x) + sh.x;
      o.y = x2[q4 * 4 + 1] * rstd * fg.y * (1.f + sc.y) + sh.y;
      o.z = x2[q4 * 4 + 2] * rstd * fg.z * (1.f + sc.z) + sh.z;
      o.w = x2[q4 * 4 + 3] * rstd * fg.w * (1.f + sc.w) + sh.w;
      *(float4*)(yr + q4 * 4) = o;
    }
  }
}

#define XB_XCNT(j) (256 + 64 * (j))
#define XB_XSUB(j) (1280 + 64 * (j))
#define XB_XGEN(j) (2304 + 64 * (j))
#define XB_TOP 3328
#define XB_TOPGEN 3392
#define XB_WORDS 4096
__device__ __forceinline__ unsigned xb_ld(unsigned* p) { return __hip_atomic_load(p, __ATOMIC_RELAXED, __HIP_MEMORY_SCOPE_AGENT); }
__device__ __forceinline__ unsigned xb_add(unsigned* p, unsigned v) { return __hip_atomic_fetch_add(p, v, __ATOMIC_RELAXED, __HIP_MEMORY_SCOPE_AGENT); }
__device__ __forceinline__ unsigned xb_xcc_id() { return (unsigned)__builtin_amdgcn_s_getreg((3 << 11) | 20) & 0xFu; }
__device__ __forceinline__ void grid_barrier(unsigned* bar, volatile unsigned* xst) {
  asm volatile("s_waitcnt vmcnt(0)" ::: "memory");
  __syncthreads();
  if (TIDX == 0) {
    __builtin_amdgcn_s_waitcnt(0);
    const unsigned x = xst[0], nloc = xst[1], nx = xst[2];
    const unsigned old = xb_add(&bar[XB_XSUB(x)], 1u);
    const unsigned gen = old / nloc;
    if (old + 1u == (gen + 1u) * nloc) {
      __builtin_amdgcn_fence(__ATOMIC_RELEASE, "agent");
      asm volatile("s_waitcnt vmcnt(0)" ::: "memory");
      const unsigned og = xb_add(&bar[XB_TOP], 1u);
      const unsigned tg = og / nx;
      if (og + 1u == (tg + 1u) * nx) xb_add(&bar[XB_TOPGEN], 1u);
      else while (xb_ld(&bar[XB_TOPGEN]) == tg) __builtin_amdgcn_s_sleep(1);
      __builtin_amdgcn_fence(__ATOMIC_ACQUIRE, "agent");
      xb_add(&bar[XB_XGEN(x)], 1u);
      asm volatile("s_waitcnt vmcnt(0)" ::: "memory");
    } else {
      while (xb_ld(&bar[XB_XGEN(x)]) == gen) __builtin_amdgcn_s_sleep(1);
      __builtin_amdgcn_fence(__ATOMIC_ACQUIRE, "agent");
      asm volatile("s_waitcnt vmcnt(0)" ::: "memory");
    }
  }
  __syncthreads();
}

template <int PH>
__device__ __forceinline__ void run_phase(const P& p, int bid, int nb, char* smem) {
  if constexpr (PH == 0) phase0(p, bid, nb, smem);
  if constexpr (PH == 1) phase_norm<false>(p, bid, nb);
  if constexpr (PH == 2) phase2(p, bid, nb, smem);
  if constexpr (PH == 3) phase3(p, bid, nb, smem);
  if constexpr (PH == 4) phase4(p, bid, nb, smem);
  if constexpr (PH == 5) phase5(p, bid, nb);
  if constexpr (PH == 6) phase6(p, bid, nb, smem);
  if constexpr (PH == 7) phase7(p, bid, nb, smem);
  if constexpr (PH == 8) phase_norm<true>(p, bid, nb);
  if constexpr (PH == 9) phase9(p, bid, nb, smem);
  if constexpr (PH == 10) phase10(p, bid, nb);
  if constexpr (PH == 11) phase3b(p, bid, nb, smem);
}

template <int PH>
__global__ void __launch_bounds__(NTHREADS, 2) k_phase(P p) {
  extern __shared__ __attribute__((aligned(16))) char smem[];
  run_phase<PH>(p, blockIdx.x, gridDim.x, smem);
}

#if MEGA
__global__ void __launch_bounds__(NTHREADS, 2) k_mega(P p) {
  extern __shared__ __attribute__((aligned(16))) char smem[];
  cg::grid_group grid = cg::this_grid();
  const int bid = blockIdx.x, nb = gridDim.x;
#ifndef PROBE_ALL2
#define PROBE_ALL2 0
#endif
#ifndef PROBE_MASK
#define PROBE_MASK 0
#endif
#ifndef PROBE_SYNCS
#define PROBE_SYNCS 0
#endif
  volatile unsigned* xst = (volatile unsigned*)(smem + LDS_BYTES - 16);
  if (TIDX == 0) { const unsigned xcc0 = xb_xcc_id(); xst[0] = xcc0; xb_add(&p.bar[XB_XCNT(xcc0)], 1u); }
#define GSYNC(k)                                                                                 \
  {                                                                                              \
    if ((k) == 0) {                                                                              \
      grid.sync();                                                                               \
      if (TIDX == 0) {                                                                    \
        unsigned cnt = 0;                                                                        \
        for (unsigned j = 0; j < 16; ++j) cnt += xb_ld(&p.bar[XB_XCNT(j)]) > 0u ? 1u : 0u;       \
        xst[2] = cnt; xst[1] = xb_ld(&p.bar[XB_XCNT(xst[0])]);                                   \
      }                                                                                          \
    } else grid_barrier(p.bar, xst);                                                             \
  }
#define RUNPH(k)                                                       \
  run_phase<k>(p, bid, nb, smem); GSYNC(k)                             \
  if (PROBE_MASK & (1 << k)) { run_phase<k>(p, bid, nb, smem); GSYNC(1) }
#pragma unroll 1
  for (int rep = 0; rep < 1 + PROBE_ALL2; rep++) {
    RUNPH(0)
#pragma unroll 1
    for (int i = 0; i < PROBE_SYNCS; i++) GSYNC(1)
    RUNPH(1) RUNPH(2) RUNPH(3) RUNPH(11) RUNPH(4) RUNPH(5) RUNPH(6) RUNPH(7) RUNPH(8) RUNPH(9)
  }
  run_phase<10>(p, bid, nb, smem);
}
#endif

template <int PH>
static void launch_phase(const P& p, int grid, hipStream_t stream) {
  static bool attr = false;
  if (!attr) { hipFuncSetAttribute((const void*)k_phase<PH>, hipFuncAttributeMaxDynamicSharedMemorySize, LDS_BYTES); attr = true; }
  hipLaunchKernelGGL(k_phase<PH>, dim3(grid), dim3(NTHREADS), LDS_BYTES, stream, p);
}

extern "C" void kernel_launch(void* const* d_in, const int* in_sizes, int n_in, void* d_out, int out_size, void* d_ws,
                              size_t ws_size, hipStream_t stream) {
  P p{};
  const float** fp = (const float**)&p;
  for (int i = 0; i < 40; i++) fp[i] = (const float*)d_in[i];
  p.out = (float*)d_out;
  char* ws = (char*)d_ws;
  size_t off = 0;
  auto take = [&](size_t bytes) { char* r = ws + off; off += (bytes + 255) & ~(size_t)255; return r; };
  p.bar = (unsigned*)take(XB_WORDS * 4);
  p.w_inT = (u16*)take((size_t)INCOLS * D * 2);
  p.w_paT = (u16*)take((size_t)1024 * 512 * 2);
  p.w_pbT = (u16*)take((size_t)1024 * 1024 * 2);
  p.w_outT = (u16*)take((size_t)1024 * 1024 * 2);
  p.wqT = (u16*)take((size_t)2048 * 1024 * 2);
  p.keysb = (u16*)take((size_t)262144 * 2);
  p.mod = (float*)take((size_t)NSEQ * 8192 * 4);
  p.dtb = (float*)take((size_t)NT * 16 * 4);
  p.decb = (float*)take((size_t)NT * 16 * 4);
  p.xn = (u16*)take((size_t)NROWS * D * 2);
  p.proj = (u16*)take((size_t)NROWS * PCOLS * 2);
  p.prep = (u16*)take((size_t)NT * 3584 * 2);
  p.w2T = (u16*)take(512 * 64 * 2);
  p.a2T = (u16*)take(512 * 64 * 2);
  p.g2T = (u16*)take(512 * 128 * 2);
  p.lora = (u16*)take((size_t)NT * 256 * 2);
  if (off > ws_size) { fprintf(stderr, "workspace too small: need %zu have %zu\n", off, ws_size); return; }
  p.merged = p.prep;
  p.ub = p.proj;
  p.vb = p.proj + (size_t)16384 * 1024;
  p.topv = (float*)(p.proj + (size_t)2 * 16384 * 1024);
  p.topi = (int*)(p.topv + (size_t)NT * 256);
  p.xc = (u16*)d_out;
  p.oa = (u16*)d_out;
  p.ob = (u16*)d_out + (size_t)NT * 512;

  static int grid = 0;
  if (!grid) {
    int dev = 0, cus = 0, per_cu = 0;
    hipGetDevice(&dev);
    hipDeviceGetAttribute(&cus, hipDeviceAttributeMultiprocessorCount, dev);
#if MEGA
    hipFuncSetAttribute((const void*)k_mega, hipFuncAttributeMaxDynamicSharedMemorySize, LDS_BYTES);
    hipOccupancyMaxActiveBlocksPerMultiprocessor(&per_cu, k_mega, NTHREADS, LDS_BYTES);
    if (per_cu > 2) per_cu = 2;
#else
    per_cu = 2;
#endif
    if (per_cu < 1) per_cu = 1;
    grid = cus * per_cu;
  }
  hipMemsetAsync(p.mod, 0, (size_t)NSEQ * 8192 * 4, stream);
#if MEGA
  hipMemsetAsync(p.bar, 0, XB_WORDS * 4, stream);
  void* args[] = {&p};
  hipError_t e = hipLaunchCooperativeKernel((void*)k_mega, dim3(grid), dim3(NTHREADS), args, LDS_BYTES, stream);
  if (e != hipSuccess) fprintf(stderr, "cooperative launch failed: %s (grid %d)\n", hipGetErrorString(e), grid);
#else
  launch_phase<0>(p, grid, stream);
  launch_phase<1>(p, grid, stream);
  launch_phase<2>(p, grid, stream);
  launch_phase<3>(p, grid, stream);
  launch_phase<11>(p, grid, stream);
  launch_phase<4>(p, grid, stream);
  launch_phase<5>(p, grid, stream);
  launch_phase<6>(p, grid, stream);
  launch_phase<7>(p, grid, stream);
  launch_phase<8>(p, grid, stream);
  launch_phase<9>(p, grid, stream);
  launch_phase<10>(p, grid, stream);
#endif
}
```

```cpp
#include <hip/hip_runtime.h>
#include <hip/hip_cooperative_groups.h>
#include <cstdio>
namespace cg = cooperative_groups;

#ifndef MEGA
#define MEGA 1
#endif

typedef unsigned short u16;
typedef __attribute__((ext_vector_type(8))) short bf16x8;
typedef __attribute__((ext_vector_type(4))) float f32x4;

__device__ __forceinline__ int opaque_tid() { int t = threadIdx.x; asm volatile("" : "+v"(t)); return t; }
#define TIDX opaque_tid()

constexpr int D = 1024;
constexpr int NP = 16384, NS = 1024, NT = NP + NS, NSEQ = 136;
constexpr int NROWS = NT + 128;
constexpr int PCOLS = 4368;
constexpr int INCOLS = 6416;
constexpr int C_LW = 1536, C_LA = 1600, C_LG = 1664, C_Z = 1792, C_XBC = 2816, C_DT = 4352;
constexpr int G_A = 4368, G_B = 5392;
constexpr size_t O_Y = 0, O_PSHIFT = 17825792, O_PWKV = 17833984, O_PCONV = 18096128, O_PSSM = 18132992,
                 O_SSHIFT = 19181568, O_SWKV = 19312640, O_SCONV = 23506944, O_SSSM = 24096768;
constexpr int LDS_BYTES = 80 * 1024;
constexpr int NTHREADS = 256;

struct P {
  const float *x_prompt, *x_sample, *c_prompt, *c_sample, *state_shift, *state_wkv, *state_conv, *state_ssm;
  const float *w_ada, *b_ada, *norm1_g, *w_in, *rw_mu, *rw_w0, *rw_w2, *rw_a0, *rw_a2, *rw_g2, *rw_k_k, *rw_k_a,
      *rw_r_k, *rw_ln_w, *rw_ln_b;
  const float *conv_w, *conv_b, *dt_bias, *A_log, *D_skip, *ssm_norm_w, *w_pa, *w_pb, *w_out, *norm2_g, *peer_wq,
      *peer_keys, *peer_u, *peer_v, *final_g, *w_ada_f, *b_ada_f;
  float* out;
  u16 *w_inT, *w_paT, *w_pbT, *w_outT, *wqT, *keysb, *xn, *proj, *prep, *merged, *ub, *vb, *xc, *oa, *ob;
  u16 *w2T, *a2T, *g2T, *lora;
  float *mod, *dtb, *decb, *topv;
  int* topi;
  unsigned* bar;
};

__device__ __forceinline__ u16 f2bf(float f) {
  unsigned u = __float_as_uint(f);
  u += 0x7fffu + ((u >> 16) & 1u);
  return (u16)(u >> 16);
}
__device__ __forceinline__ float bf2f(u16 h) { return __uint_as_float(((unsigned)h) << 16); }
__device__ __forceinline__ unsigned pack2(float a, float b) { return (unsigned)f2bf(a) | ((unsigned)f2bf(b) << 16); }
__device__ __forceinline__ float bflo(unsigned u) { return __uint_as_float(u << 16); }
__device__ __forceinline__ float bfhi(unsigned u) { return __uint_as_float(u & 0xffff0000u); }
__device__ __forceinline__ float sigmoidf_(float x) { return 1.f / (1.f + __expf(-x)); }
__device__ __forceinline__ float siluf_(float x) { return x / (1.f + __expf(-x)); }
__device__ __forceinline__ float softplusf_(float x) { return x > 20.f ? x : log1pf(expf(x)); }

template <int CTRL>
__device__ __forceinline__ float dppf(float x) {
  return __int_as_float(__builtin_amdgcn_update_dpp(0, __float_as_int(x), CTRL, 0xf, 0xf, true));
}
__device__ __forceinline__ float allreduce16(float x) {
  x += dppf<0x128>(x);
  x += dppf<0x124>(x);
  x += dppf<0x122>(x);
  x += dppf<0x121>(x);
  return x;
}
__device__ __forceinline__ float allreduce8(float x) {
  x += dppf<0xB1>(x);
  x += dppf<0x4E>(x);
  x += dppf<0x141>(x);
  return x;
}
__device__ __forceinline__ float wave_sum(float x) {
#pragma unroll
  for (int o = 32; o >= 1; o >>= 1) x += __shfl_xor(x, o, 64);
  return x;
}
__device__ __forceinline__ float wave_max(float x) {
#pragma unroll
  for (int o = 32; o >= 1; o >>= 1) x = fmaxf(x, __shfl_xor(x, o, 64));
  return x;
}
__device__ __forceinline__ int wave_min_i(int x) {
#pragma unroll
  for (int o = 32; o >= 1; o >>= 1) x = min(x, __shfl_xor(x, o, 64));
  return x;
}

__device__ __forceinline__ const float* xrow(const P& p, int n) {
  return n < NP ? p.x_prompt + (size_t)n * D : p.x_sample + (size_t)(n - NP) * D;
}
__device__ __forceinline__ void tok2seq(int n, int& seq, int& t, int& T) {
  if (n < NP) { seq = n >> 11; t = n & 2047; T = 2048; }
  else { int m = n - NP; seq = 8 + (m >> 3); t = m & 7; T = 8; }
}
__device__ __forceinline__ float* seq_out(float* out, int seq, size_t op, size_t os, size_t per) {
  return seq < 8 ? out + op + (size_t)seq * per : out + os + (size_t)(seq - 8) * per;
}

constexpr int LROW = 144;
template <bool DEEP = true>
__device__ __forceinline__ void gemm_tile(const u16* __restrict__ A, int lda, int m0, const u16* __restrict__ Bt,
                                          int ldb, int n0, int K, f32x4 (&acc)[4][4], char* smem) {
  char* sA = smem;
  char* sB = smem + 128 * LROW;
  const int tid = TIDX, lane = tid & 63, wid = tid >> 6, wr = wid >> 1, wc = wid & 1, fr = lane & 15,
            fq = lane >> 4;
  uint4 ra0, ra1, ra2, ra3, rb0, rb1, rb2, rb3;
  uint4 sa0, sa1, sa2, sa3, sb0, sb1, sb2, sb3;
  const int nk = K / 64;
  const int lrow = tid >> 3, lch = tid & 7;
  const u16* gA = A + (size_t)(m0 + lrow) * lda + lch * 8;
  const u16* gB = Bt + (size_t)(n0 + lrow) * ldb + lch * 8;
#define GLOAD(x0, x1, x2, x3, y0, y1, y2, y3, kt)                   \
  {                                                                 \
    x0 = *(const uint4*)(gA + (kt) * 64);                           \
    x1 = *(const uint4*)(gA + (size_t)32 * lda + (kt) * 64);        \
    x2 = *(const uint4*)(gA + (size_t)64 * lda + (kt) * 64);        \
    x3 = *(const uint4*)(gA + (size_t)96 * lda + (kt) * 64);        \
    y0 = *(const uint4*)(gB + (kt) * 64);                           \
    y1 = *(const uint4*)(gB + (size_t)32 * ldb + (kt) * 64);        \
    y2 = *(const uint4*)(gB + (size_t)64 * ldb + (kt) * 64);        \
    y3 = *(const uint4*)(gB + (size_t)96 * ldb + (kt) * 64);        \
  }
#define LSTORE(x0, x1, x2, x3, y0, y1, y2, y3)                      \
  {                                                                 \
    char* wa = sA + lrow * LROW + lch * 16;                         \
    char* wb = sB + lrow * LROW + lch * 16;                         \
    *(uint4*)(wa) = x0; *(uint4*)(wa + 32 * LROW) = x1; *(uint4*)(wa + 64 * LROW) = x2; *(uint4*)(wa + 96 * LROW) = x3; \
    *(uint4*)(wb) = y0; *(uint4*)(wb + 32 * LROW) = y1; *(uint4*)(wb + 64 * LROW) = y2; *(uint4*)(wb + 96 * LROW) = y3; \
  }
#define COMPUTE_TILE()                                                                                                   \
  {                                                                                                                      \
    _Pragma("unroll") for (int s = 0; s < 2; s++) {                                                                      \
      bf16x8 af[4], bfr[4];                                                                                              \
      _Pragma("unroll") for (int m = 0; m < 4; m++) af[m] = *(const bf16x8*)(sA + (wr * 64 + m * 16 + fr) * LROW + s * 64 + fq * 16); \
      _Pragma("unroll") for (int n = 0; n < 4; n++) bfr[n] = *(const bf16x8*)(sB + (wc * 64 + n * 16 + fr) * LROW + s * 64 + fq * 16); \
      _Pragma("unroll") for (int m = 0; m < 4; m++)                                                                      \
        _Pragma("unroll") for (int n = 0; n < 4; n++) acc[m][n] = __builtin_amdgcn_mfma_f32_16x16x32_bf16(af[m], bfr[n], acc[m][n], 0, 0, 0); \
    }                                                                                                                    \
  }
  GLOAD(ra0, ra1, ra2, ra3, rb0, rb1, rb2, rb3, 0);
  if constexpr (DEEP) {
    GLOAD(sa0, sa1, sa2, sa3, sb0, sb1, sb2, sb3, 1);
#pragma unroll 1
    for (int kt = 0; kt < nk; kt += 2) {
      __syncthreads();
      LSTORE(ra0, ra1, ra2, ra3, rb0, rb1, rb2, rb3);
      __syncthreads();
      if (kt + 2 < nk) GLOAD(ra0, ra1, ra2, ra3, rb0, rb1, rb2, rb3, kt + 2);
      COMPUTE_TILE();
      __syncthreads();
      LSTORE(sa0, sa1, sa2, sa3, sb0, sb1, sb2, sb3);
      __syncthreads();
      if (kt + 3 < nk) GLOAD(sa0, sa1, sa2, sa3, sb0, sb1, sb2, sb3, kt + 3);
      COMPUTE_TILE();
    }
  } else {
#pragma unroll 1
    for (int kt = 0; kt < nk; kt++) {
      __syncthreads();
      LSTORE(ra0, ra1, ra2, ra3, rb0, rb1, rb2, rb3);
      __syncthreads();
      if (kt + 1 < nk) GLOAD(ra0, ra1, ra2, ra3, rb0, rb1, rb2, rb3, kt + 1);
      COMPUTE_TILE();
    }
  }
  __syncthreads();
}
#define GL_RAW_BARRIER() { asm volatile("s_waitcnt vmcnt(0)" ::: "memory"); asm volatile("s_waitcnt lgkmcnt(0)" ::: "memory"); __builtin_amdgcn_s_barrier(); }
__device__ __forceinline__ void gemm_tile_glds(const u16* __restrict__ A, int lda, int m0, const u16* __restrict__ Bt,
                                               int ldb, int n0, int K, f32x4 (&acc)[4][4], char* smem) {
  const int tid = TIDX, lane = tid & 63, wid = tid >> 6, wr = wid >> 1, wc = wid & 1, fr = lane & 15, fq = lane >> 4;
  const int nk = K / 64;
  const int srow = tid >> 3, sc = (tid & 7) ^ ((srow >> 1) & 7);
  const u16* gA = A + (size_t)(m0 + srow) * lda + sc * 8;
  const u16* gB = Bt + (size_t)(n0 + srow) * ldb + sc * 8;
  char* const lbase = smem + tid * 16;
  const int swz = (fr >> 1) & 7;
  const int aoff = (wr * 64 + fr) * 128, boff = 16384 + (wc * 64 + fr) * 128;
#define GL_STAGE(buf, kt)                                                                                         \
  {                                                                                                               \
    _Pragma("unroll") for (int i = 0; i < 4; i++) {                                                               \
      __builtin_amdgcn_global_load_lds((const unsigned*)(gA + (size_t)(32 * i) * lda + (kt) * 64),               \
                                       (unsigned*)(lbase + (buf) * 32768 + i * 4096), 16, 0, 0);                  \
      __builtin_amdgcn_global_load_lds((const unsigned*)(gB + (size_t)(32 * i) * ldb + (kt) * 64),               \
                                       (unsigned*)(lbase + (buf) * 32768 + 16384 + i * 4096), 16, 0, 0);          \
    }                                                                                                             \
  }
#define GL_COMPUTE(buf)                                                                                           \
  {                                                                                                               \
    const char* pb = smem + (buf) * 32768;                                                                        \
    _Pragma("unroll") for (int s = 0; s < 2; s++) {                                                               \
      bf16x8 af[4], bfr[4];                                                                                       \
      const int so = ((s * 4 + fq) ^ swz) * 16;                                                                   \
      _Pragma("unroll") for (int m = 0; m < 4; m++) af[m] = *(const bf16x8*)(pb + aoff + m * 2048 + so);          \
      _Pragma("unroll") for (int n = 0; n < 4; n++) bfr[n] = *(const bf16x8*)(pb + boff + n * 2048 + so);         \
      _Pragma("unroll") for (int m = 0; m < 4; m++)                                                               \
        _Pragma("unroll") for (int n = 0; n < 4; n++)                                                             \
          acc[m][n] = __builtin_amdgcn_mfma_f32_16x16x32_bf16(af[m], bfr[n], acc[m][n], 0, 0, 0);                 \
    }                                                                                                             \
  }
  __syncthreads();
  GL_STAGE(0, 0)
  GL_RAW_BARRIER()
#pragma unroll 1
  for (int kt = 0; kt < nk; kt += 2) {
    if (kt + 1 < nk) GL_STAGE(1, kt + 1)
    GL_COMPUTE(0)
    GL_RAW_BARRIER()
    if (kt + 1 < nk) {
      if (kt + 2 < nk) GL_STAGE(0, kt + 2)
      GL_COMPUTE(1)
      GL_RAW_BARRIER()
    }
  }
}
__device__ __forceinline__ void zero_acc(f32x4 (&acc)[4][4]) {
#pragma unroll
  for (int m = 0; m < 4; m++)
#pragma unroll
    for (int n = 0; n < 4; n++) acc[m][n] = f32x4{0.f, 0.f, 0.f, 0.f};
}
#define ACC_FOREACH(...)                                                                    \
  {                                                                                         \
    const int _l = TIDX & 63, _w = TIDX >> 6, _wr = _w >> 1, _wc = _w & 1;    \
    const int _fr = _l & 15, _fq = _l >> 4;                                                 \
    _Pragma("unroll") for (int m = 0; m < 4; m++) _Pragma("unroll") for (int n = 0; n < 4; n++) \
        _Pragma("unroll") for (int j = 0; j < 4; j++) {                                     \
      const int row = _wr * 64 + m * 16 + _fq * 4 + j, col = _wc * 64 + n * 16 + _fr;       \
      __VA_ARGS__                                                                           \
    }                                                                                       \
  }

struct TileIter {
  int x, lb, nbx, tpx, total, MT, NT, r;
  __device__ __forceinline__ TileIter(int bid, int nb, int MT_, int NT_) : MT(MT_), NT(NT_), r(0) {
    total = MT * NT; x = bid & 7; lb = bid >> 3; nbx = nb >> 3; tpx = (total + 7) >> 3;
  }
  __device__ __forceinline__ bool next(int& mt, int& nt) {
    const int idx = lb + r * nbx;
    r++;
    if (idx >= tpx) return false;
    const int lin = x * tpx + idx;
    if (lin >= total) return false;
    const int bsz = 8 * NT, band = lin / bsz, rem = lin - band * bsz;
    const int mb = min(8, MT - band * 8);
    nt = rem / mb; mt = band * 8 + (rem - nt * mb);
    return true;
  }
};

__device__ __forceinline__ void tile_out_bf16(const char* smem, u16* __restrict__ C, size_t ldc, int m0, int n0, int ncols_valid) {
  __syncthreads();
  const int tid = TIDX;
#pragma unroll
  for (int i = 0; i < 8; i++) {
    const int id = tid + i * 256, row = id >> 4, ch = id & 15;
    if (ch * 8 < ncols_valid) *(uint4*)(C + (size_t)(m0 + row) * ldc + n0 + ch * 8) = *(const uint4*)(smem + row * 272 + ch * 16);
  }
}

__device__ void transpose_tile(const float* __restrict__ src, int K, int N, u16* __restrict__ dst, int tile,
                               char* smem) {
  const int ntn = (N + 63) / 64, kt = tile / ntn, nt = tile % ntn, tid = TIDX;
  float(*s)[65] = (float(*)[65])smem;
  __syncthreads();
#pragma unroll 4
  for (int i = 0; i < 16; i++) {
    int r = (tid >> 6) + 4 * i, n = nt * 64 + (tid & 63);
    s[r][tid & 63] = (n < N) ? src[(size_t)(kt * 64 + r) * N + n] : 0.f;
  }
  __syncthreads();
#pragma unroll 4
  for (int i = 0; i < 8; i++) {
    int nl = (tid >> 5) + 8 * i, n = nt * 64 + nl, kl = (tid & 31) * 2;
    if (n < N) *(unsigned*)(dst + (size_t)n * K + kt * 64 + kl) = pack2(s[kl][nl], s[kl + 1][nl]);
  }
}

__device__ void mod_item(const P& p, int item2, char* smem) {
  const int item = item2 >> 1, kh2 = item2 & 1;
  const int tid = TIDX, j = tid & 31, g = tid >> 5;
  const int col0 = item * 32;
  const float* W; const float* bias; int N, cw;
  if (col0 < 6144) { W = p.w_ada; bias = p.b_ada; N = 6144; cw = col0; }
  else { W = p.w_ada_f; bias = p.b_ada_f; N = 2048; cw = col0 - 6144; }
  float(*cs)[68] = (float(*)[68])smem;
  float acc[17];
#pragma unroll
  for (int s = 0; s < 17; s++) acc[s] = 0.f;
  for (int k0 = kh2 * 512; k0 < kh2 * 512 + 512; k0 += 64) {
    __syncthreads();
    {
      float cv[34];
#pragma unroll
      for (int i = 0; i < 34; i++) {
        const int idx = tid + i * 256, seq = idx >> 6, kk = idx & 63;
        cv[i] = seq < 8 ? p.c_prompt[seq * 1024 + k0 + kk] : p.c_sample[(seq - 8) * 1024 + k0 + kk];
      }
#pragma unroll
      for (int i = 0; i < 34; i++) {
        const int idx = tid + i * 256;
        cs[idx >> 6][idx & 63] = siluf_(cv[i]);
      }
    }
    __syncthreads();
#pragma unroll 1
    for (int kh = 0; kh < 2; kh++) {
      float wv[32];
#pragma unroll
      for (int k = 0; k < 32; k++) wv[k] = W[(size_t)(k0 + kh * 32 + k) * N + cw + j];
#pragma unroll 2
      for (int k4 = 0; k4 < 8; k4++) {
#pragma unroll
        for (int s = 0; s < 17; s++) {
          float4 c4 = *(const float4*)&cs[g * 17 + s][kh * 32 + k4 * 4];
          acc[s] += wv[k4 * 4] * c4.x + wv[k4 * 4 + 1] * c4.y + wv[k4 * 4 + 2] * c4.z + wv[k4 * 4 + 3] * c4.w;
        }
      }
    }
  }
  const float b = kh2 == 0 ? bias[cw + j] : 0.f;
#pragma unroll
  for (int s = 0; s < 17; s++) atomicAdd(&p.mod[(size_t)(g * 17 + s) * 8192 + col0 + j], acc[s] + b);
}

constexpr int J_MOD = 512, J_WIN = 16 * 101, J_WPA = 8 * 16, J_WPB = 256, J_WOUT = 256, J_WQ = 16 * 32, J_KEYS = 128,
              J_SHIFT = 64;
constexpr int J_LORA = 8 + 8 + 16;
constexpr int PH0_ITEMS = J_MOD + J_WIN + J_WPA + J_WPB + J_WOUT + J_WQ + J_LORA + J_KEYS + J_SHIFT;

__device__ void phase0(const P& p, int bid, int nb, char* smem) {
  for (int it = bid; it < PH0_ITEMS; it += nb) {
    int i = it;
    if (i < J_MOD) { mod_item(p, i, smem); continue; }
    i -= J_MOD;
    if (i < J_WIN) { transpose_tile(p.w_in, 1024, INCOLS, p.w_inT, i, smem); continue; }
    i -= J_WIN;
    if (i < J_WPA) { transpose_tile(p.w_pa, 512, 1024, p.w_paT, i, smem); continue; }
    i -= J_WPA;
    if (i < J_WPB) { transpose_tile(p.w_pb, 1024, 1024, p.w_pbT, i, smem); continue; }
    i -= J_WPB;
    if (i < J_WOUT) { transpose_tile(p.w_out, 1024, 1024, p.w_outT, i, smem); continue; }
    i -= J_WOUT;
    if (i < J_WQ) { transpose_tile(p.peer_wq, 1024, 2048, p.wqT, i, smem); continue; }
    i -= J_WQ;
    if (i < 8) { transpose_tile(p.rw_w2, 64, 512, p.w2T, i, smem); continue; }
    if (i < 16) { transpose_tile(p.rw_a2, 64, 512, p.a2T, i - 8, smem); continue; }
    if (i < 32) { transpose_tile(p.rw_g2, 128, 512, p.g2T, i - 16, smem); continue; }
    i -= J_LORA;
    const float* src; u16* dst;
    if (i < J_KEYS) { src = p.peer_keys + (size_t)i * 2048; dst = p.keysb + (size_t)i * 2048; }
    else { i -= J_KEYS; src = p.state_shift + (size_t)i * 2048; dst = p.xn + (size_t)NT * D + (size_t)i * 2048; }
    const float4* s4 = (const float4*)src + TIDX * 2;
    float4 a = s4[0], b = s4[1];
    uint4 o; o.x = pack2(a.x, a.y); o.y = pack2(a.z, a.w); o.z = pack2(b.x, b.y); o.w = pack2(b.z, b.w);
    *((uint4*)dst + TIDX) = o;
  }
}

template <bool SECOND>
__device__ void phase_norm(const P& p, int bid, int nb) {
  const int lane = TIDX & 63, wid = TIDX >> 6;
  const float* gam = SECOND ? p.norm2_g : p.norm1_g;
  for (int it = bid; it < NT / 8; it += nb) {
    const int nA = it * 8 + wid * 2;
    float4 v[2][4];
#pragma unroll
    for (int k = 0; k < 2; k++) {
      const int n = nA + k;
      const float* xr = SECOND ? p.out + O_Y + (size_t)n * D : xrow(p, n);
#pragma unroll
      for (int i = 0; i < 4; i++) v[k][i] = ((const float4*)xr)[lane + 64 * i];
    }
#pragma unroll
    for (int k = 0; k < 2; k++) {
      const int n = nA + k;
      int seq, t, T; tok2seq(n, seq, t, T);
      const float* md = p.mod + (size_t)seq * 8192 + (SECOND ? 3072 : 0);
      float ss = 0.f;
#pragma unroll
      for (int i = 0; i < 4; i++)
        ss += v[k][i].x * v[k][i].x + v[k][i].y * v[k][i].y + v[k][i].z * v[k][i].z + v[k][i].w * v[k][i].w;
      ss = wave_sum(ss);
      const float rstd = rsqrtf(ss * (1.f / 1024.f) + 1e-6f);
      const bool last = (!SECOND) && (t == T - 1);
      float* so = seq_out(p.out, seq, O_PSHIFT, O_SSHIFT, 1024);
#pragma unroll
      for (int i = 0; i < 4; i++) {
        const int c = (lane + 64 * i) * 4;
        const float4 g = *(const float4*)(gam + c), sh = *(const float4*)(md + c), sc = *(const float4*)(md + 1024 + c);
        float4 o;
        o.x = v[k][i].x * rstd * g.x * (1.f + sc.x) + sh.x;
        o.y = v[k][i].y * rstd * g.y * (1.f + sc.y) + sh.y;
        o.z = v[k][i].z * rstd * g.z * (1.f + sc.z) + sh.z;
        o.w = v[k][i].w * rstd * g.w * (1.f + sc.w) + sh.w;
        uint2 pk; pk.x = pack2(o.x, o.y); pk.y = pack2(o.z, o.w);
        *(uint2*)(p.xn + (size_t)n * D + c) = pk;
        if (last) *(float4*)(so + c) = o;
      }
    }
  }
}

constexpr int P2_NT = 35, P2_MT = 137;
__device__ void phase2(const P& p, int bid, int nb, char* smem) {
  TileIter ti(bid, nb, P2_MT, P2_NT);
  int mt, nt;
  while (ti.next(mt, nt)) {
    f32x4 acc[4][4];
    zero_acc(acc);
    gemm_tile_glds(p.xn, D, mt * 128, p.w_inT, D, nt * 128, D, acc, smem);
    u16* Lt = (u16*)smem;
    ACC_FOREACH({ Lt[row * 136 + col] = f2bf(acc[m][n][j]); })
    tile_out_bf16(smem, p.proj, PCOLS, mt * 128, nt * 128, PCOLS - nt * 128);
  }
}

__device__ void rwkv_lerp_item(const P& p, int item) {
  const int tid = TIDX;
  const int n0 = item * 8;
  int seq, t0, T; tok2seq(n0, seq, t0, T);
  uint4 pcv[7], ppv[7];
#pragma unroll
  for (int i = 0; i < 7; i++) {
    const int idx = tid + i * 256, tok = idx / 224, c = (idx % 224) * 8;
    const int n = n0 + tok, t = t0 + tok;
    pcv[i] = *(const uint4*)(p.proj + (size_t)n * PCOLS + c);
    const size_t prow = t > 0 ? (size_t)(n - 1) : (size_t)(NT + (seq >= 8 ? seq - 8 : 0));
    ppv[i] = *(const uint4*)(p.proj + prow * PCOLS + c);
    if (t == 0 && seq < 8) ppv[i] = make_uint4(0, 0, 0, 0);
  }
#pragma unroll
  for (int i = 0; i < 7; i++) {
    const int idx = tid + i * 256, tok = idx / 224, c = (idx % 224) * 8;
    const int n = n0 + tok;
    const float4 mu0 = *(const float4*)(p.rw_mu + c), mu1 = *(const float4*)(p.rw_mu + c + 4);
    const float mus[8] = {mu0.x, mu0.y, mu0.z, mu0.w, mu1.x, mu1.y, mu1.z, mu1.w};
    const unsigned pcs[4] = {pcv[i].x, pcv[i].y, pcv[i].z, pcv[i].w}, pps[4] = {ppv[i].x, ppv[i].y, ppv[i].z, ppv[i].w};
    unsigned o[4];
#pragma unroll
    for (int e = 0; e < 4; e++) {
      float a0 = bflo(pcs[e]), a1 = bfhi(pcs[e]), b0 = bflo(pps[e]), b1 = bfhi(pps[e]);
      float q0 = a0 + (b0 - a0) * mus[2 * e], q1 = a1 + (b1 - a1) * mus[2 * e + 1];
      if (c >= C_LW && c < C_LA) { q0 = tanhf(q0); q1 = tanhf(q1); }
      else if (c >= C_LG) { q0 = sigmoidf_(q0); q1 = sigmoidf_(q1); }
      o[e] = pack2(q0, q1);
    }
    u16* dst;
    if (c < 512) dst = p.prep + (size_t)n * 3584 + 512 + c;
    else if (c < 1024) dst = p.prep + (size_t)n * 3584 + 1024 + (c - 512);
    else if (c < 1536) dst = p.prep + (size_t)n * 3584 + 2560 + (c - 1024);
    else dst = p.lora + (size_t)n * 256 + (c - 1536);
    *(uint4*)dst = make_uint4(o[0], o[1], o[2], o[3]);
  }
}

__device__ void rwkv_lora_item(const P& p, int mt, int nt, char* smem) {
  const int tid = TIDX, lane = tid & 63, wid = tid >> 6, wr = wid >> 1, wc = wid & 1, fr = lane & 15, fq = lane >> 4;
  const int col0 = nt * 128;
  f32x4 acc[4][4];
  zero_acc(acc);
  gemm_tile_glds(p.lora, 256, mt * 128, p.w2T, 64, col0, 64, acc, smem);
  ACC_FOREACH({
    const int gc = col0 + col;
    const float wpre = p.rw_w0[gc] + acc[m][n][j];
    const float w = -softplusf_(-wpre) - 0.5f;
    p.prep[(size_t)(mt * 128 + row) * 3584 + gc] = f2bf(-expf(w));
  })
  zero_acc(acc);
  gemm_tile_glds(p.lora + 128, 256, mt * 128, p.g2T, 128, col0, 128, acc, smem);
  ACC_FOREACH({ p.prep[(size_t)(mt * 128 + row) * 3584 + 3072 + col0 + col] = f2bf(acc[m][n][j]); })
  zero_acc(acc);
  gemm_tile_glds(p.lora + 64, 256, mt * 128, p.a2T, 64, col0, 64, acc, smem);
  float a0c[4], kkc[4], kac[4];
#pragma unroll
  for (int n = 0; n < 4; n++) {
    const int gc = col0 + wc * 64 + n * 16 + fr;
    a0c[n] = p.rw_a0[gc]; kkc[n] = p.rw_k_k[gc]; kac[n] = p.rw_k_a[gc];
  }
#pragma unroll
  for (int m = 0; m < 4; m++)
#pragma unroll
    for (int j = 0; j < 4; j++) {
      const int row = mt * 128 + wr * 64 + m * 16 + fq * 4 + j;
      u16* pr = p.prep + (size_t)row * 3584 + col0 + wc * 64 + fr;
      float kx[4], kkv[4], av[4];
      float ss = 0.f;
#pragma unroll
      for (int n = 0; n < 4; n++) {
        kx[n] = bf2f(pr[1024 + n * 16]);
        av[n] = sigmoidf_(a0c[n] + acc[m][n][j]);
        kkv[n] = kx[n] * kkc[n];
        ss += kkv[n] * kkv[n];
      }
      ss = allreduce16(ss);
      const float inv = 1.f / fmaxf(sqrtf(ss), 1e-12f);
#pragma unroll
      for (int n = 0; n < 4; n++) {
        const float kk = kkv[n] * inv;
        pr[1024 + n * 16] = f2bf(kx[n] * (1.f + (av[n] - 1.f) * kac[n]));
        pr[1536 + n * 16] = f2bf(kk);
        pr[2048 + n * 16] = f2bf(kk * av[n]);
      }
    }
}

__device__ void conv_prep_item(const P& p, int item) {
  const int tid = TIDX;
  const int n0 = item * 8;
  int seq, t0, T; tok2seq(n0, seq, t0, T);
  if (tid < 192) {
    const int c = tid * 8;
    uint4 rows[11];
#pragma unroll
    for (int j = 0; j < 11; j++) {
      const int tt = t0 - 3 + j;
      rows[j] = make_uint4(0, 0, 0, 0);
      if (tt >= 0) rows[j] = *(const uint4*)(p.proj + (size_t)(n0 - 3 + j) * PCOLS + C_XBC + c);
      else if (seq >= 8) {
        const float* sc = p.state_conv + ((size_t)(seq - 8) * 3 + (tt + 3)) * 1536 + c;
        const float4 a = *(const float4*)sc, b = *(const float4*)(sc + 4);
        rows[j] = make_uint4(pack2(a.x, a.y), pack2(a.z, a.w), pack2(b.x, b.y), pack2(b.z, b.w));
      }
    }
    float w[4][8], cb[8];
#pragma unroll
    for (int j = 0; j < 4; j++) {
      const float4 a = *(const float4*)(p.conv_w + j * 1536 + c), b = *(const float4*)(p.conv_w + j * 1536 + c + 4);
      w[j][0] = a.x; w[j][1] = a.y; w[j][2] = a.z; w[j][3] = a.w; w[j][4] = b.x; w[j][5] = b.y; w[j][6] = b.z; w[j][7] = b.w;
    }
    {
      const float4 a = *(const float4*)(p.conv_b + c), b = *(const float4*)(p.conv_b + c + 4);
      cb[0] = a.x; cb[1] = a.y; cb[2] = a.z; cb[3] = a.w; cb[4] = b.x; cb[5] = b.y; cb[6] = b.z; cb[7] = b.w;
    }
#pragma unroll
    for (int k = 0; k < 8; k++) {
      float o[8];
#pragma unroll
      for (int e = 0; e < 8; e++) o[e] = cb[e];
#pragma unroll
      for (int j = 0; j < 4; j++) {
        const uint4 r = rows[k + j];
        const unsigned rs[4] = {r.x, r.y, r.z, r.w};
#pragma unroll
        for (int e = 0; e < 4; e++) { o[2 * e] += bflo(rs[e]) * w[j][2 * e]; o[2 * e + 1] += bfhi(rs[e]) * w[j][2 * e + 1]; }
      }
      *(uint4*)(p.xc + (size_t)(n0 + k) * 1536 + c) =
          make_uint4(pack2(siluf_(o[0]), siluf_(o[1])), pack2(siluf_(o[2]), siluf_(o[3])), pack2(siluf_(o[4]), siluf_(o[5])),
                     pack2(siluf_(o[6]), siluf_(o[7])));
    }
    if (t0 + 8 == T) {
      float* co = seq_out(p.out, seq, O_PCONV, O_SCONV, 3 * 1536);
#pragma unroll
      for (int j = 0; j < 3; j++) {
        const uint4 r = rows[8 + j];
        *(float4*)(co + j * 1536 + c) = make_float4(bflo(r.x), bfhi(r.x), bflo(r.y), bfhi(r.y));
        *(float4*)(co + j * 1536 + c + 4) = make_float4(bflo(r.z), bfhi(r.z), bflo(r.w), bfhi(r.w));
      }
    }
  } else if (tid < 192 + 32) {
    const int i = tid - 192;
#pragma unroll
    for (int e = 0; e < 4; e++) {
      const int pi = i * 4 + e, k = pi >> 4, h = pi & 15, n = n0 + k;
      const float raw = bf2f(p.proj[(size_t)n * PCOLS + C_DT + h]) + p.dt_bias[h];
      const float dt = softplusf_(raw);
      const float dA = -dt * expf(p.A_log[h]);
      p.dtb[n * 16 + h] = dt;
      p.decb[n * 16 + h] = dA;
    }
  }
}

__device__ void phase3(const P& p, int bid, int nb, char* smem) {
  for (int it = bid; it < 2 * (NT / 8); it += nb) {
    if (it < NT / 8) rwkv_lerp_item(p, it);
    else conv_prep_item(p, it - NT / 8);
  }
}
__device__ void phase3b(const P& p, int bid, int nb, char* smem) {
  for (int it = bid; it < 136 * 4; it += nb) rwkv_lora_item(p, it >> 2, it & 3, smem);
}

constexpr int TC = 32;
__device__ __forceinline__ void bf8_to_f(uint4 u, float4& lo, float4& hi) {
  lo = make_float4(bflo(u.x), bfhi(u.x), bflo(u.y), bfhi(u.y));
  hi = make_float4(bflo(u.z), bfhi(u.z), bflo(u.w), bfhi(u.w));
}
__device__ void rwkv_scan_item(const P& p, int seq, int h, int qr, char* smem) {
  const int T = seq < 8 ? 2048 : 8, nbase = seq < 8 ? seq * 2048 : NP + (seq - 8) * 8;
  float* Ld = (float*)smem;
  float* Lr = Ld + TC * 64; float* Lk = Lr + TC * 64; float* Lkk = Lk + TC * 64; float* Lb = Lkk + TC * 64;
  float* Lv = Lb + TC * 64;
  const int tid = TIDX, w = tid >> 6, lane = tid & 63, rl = w * 4 + (lane >> 4), ks = lane & 15;
  const int v = qr * 16 + rl;
  float S0 = 0.f, S1 = 0.f, S2 = 0.f, S3 = 0.f;
  if (seq >= 8) {
    float4 s = *(const float4*)(p.state_wkv + (((size_t)(seq - 8) * 8 + h) * 64 + v) * 64 + ks * 4);
    S0 = s.x; S1 = s.y; S2 = s.z; S3 = s.w;
  }
  const int st = tid >> 3, sk8 = (tid & 7) * 8;
  const int vt = tid >> 1, vr8 = (tid & 1) * 8;
  uint4 g0, g1, g2, g3, g4, gv;
  g0 = g1 = g2 = g3 = g4 = gv = make_uint4(0, 0, 0, 0);
#define RW_GLOAD(c0_)                                                                           \
  {                                                                                             \
    const int tcn = min(TC, T - (c0_));                                                         \
    if (st < tcn) {                                                                             \
      const u16* base = p.prep + (size_t)(nbase + (c0_) + st) * 3584 + h * 64 + sk8;            \
      g0 = *(const uint4*)(base); g1 = *(const uint4*)(base + 512); g2 = *(const uint4*)(base + 1024); \
      g3 = *(const uint4*)(base + 1536); g4 = *(const uint4*)(base + 2048);                     \
    }                                                                                           \
    if (tid < 64 && vt < tcn)                                                                   \
      gv = *(const uint4*)(p.prep + (size_t)(nbase + (c0_) + vt) * 3584 + 2560 + h * 64 + qr * 16 + vr8); \
  }
  RW_GLOAD(0);
  for (int c0 = 0; c0 < T; c0 += TC) {
    const int tc = min(TC, T - c0);
    __syncthreads();
    {
      float4 lo, hi;
      bf8_to_f(g0, lo, hi);
      lo.x = __expf(lo.x); lo.y = __expf(lo.y); lo.z = __expf(lo.z); lo.w = __expf(lo.w);
      hi.x = __expf(hi.x); hi.y = __expf(hi.y); hi.z = __expf(hi.z); hi.w = __expf(hi.w);
      *(float4*)(Ld + st * 64 + sk8) = lo; *(float4*)(Ld + st * 64 + sk8 + 4) = hi;
      bf8_to_f(g1, lo, hi); *(float4*)(Lr + st * 64 + sk8) = lo; *(float4*)(Lr + st * 64 + sk8 + 4) = hi;
      bf8_to_f(g2, lo, hi); *(float4*)(Lk + st * 64 + sk8) = lo; *(float4*)(Lk + st * 64 + sk8 + 4) = hi;
      bf8_to_f(g3, lo, hi); *(float4*)(Lkk + st * 64 + sk8) = lo; *(float4*)(Lkk + st * 64 + sk8 + 4) = hi;
      bf8_to_f(g4, lo, hi); *(float4*)(Lb + st * 64 + sk8) = lo; *(float4*)(Lb + st * 64 + sk8 + 4) = hi;
      if (tid < 64) { bf8_to_f(gv, lo, hi); *(float4*)(Lv + vt * 16 + vr8) = lo; *(float4*)(Lv + vt * 16 + vr8 + 4) = hi; }
    }
    __syncthreads();
    if (c0 + TC < T) RW_GLOAD(c0 + TC);
    u16* yo = p.proj + (size_t)(nbase + c0) * PCOLS + h * 64 + v;
    float4 kk0, d0, b0, k0_, r0, kk1, d1, b1, k1_, r1, kk2, d2, b2, k2_, r2, kk3, d3, b3, k3_, r3;
    float v0, v1, v2, v3;
#define RW_LD(KK, DD, BB, KX, RR, VV, t_)                                                        \
  {                                                                                              \
    KK = *(const float4*)(Lkk + (t_) * 64 + ks * 4); DD = *(const float4*)(Ld + (t_) * 64 + ks * 4); \
    BB = *(const float4*)(Lb + (t_) * 64 + ks * 4); KX = *(const float4*)(Lk + (t_) * 64 + ks * 4);  \
    RR = *(const float4*)(Lr + (t_) * 64 + ks * 4); VV = Lv[(t_) * 16 + rl];                      \
  }
#define RW_STEP(KK, DD, BB, KX, RR, VV, YY)                                                      \
  {                                                                                              \
    const float vk0 = VV * KX.x, vk1 = VV * KX.y, vk2 = VV * KX.z, vk3 = VV * KX.w;              \
    float sk = (S0 * KK.x + S1 * KK.y) + (S2 * KK.z + S3 * KK.w);                                \
    sk = allreduce16(sk);                                                                        \
    S0 = S0 * DD.x + (vk0 - sk * BB.x);                                                          \
    S1 = S1 * DD.y + (vk1 - sk * BB.y);                                                          \
    S2 = S2 * DD.z + (vk2 - sk * BB.z);                                                          \
    S3 = S3 * DD.w + (vk3 - sk * BB.w);                                                          \
    YY = allreduce16((S0 * RR.x + S1 * RR.y) + (S2 * RR.z + S3 * RR.w));                         \
  }
    for (int tt = 0; tt < tc; tt += 4) {
      RW_LD(kk0, d0, b0, k0_, r0, v0, tt)
      RW_LD(kk1, d1, b1, k1_, r1, v1, tt + 1)
      RW_LD(kk2, d2, b2, k2_, r2, v2, tt + 2)
      RW_LD(kk3, d3, b3, k3_, r3, v3, tt + 3)
      float y0, y1, y2, y3;
      RW_STEP(kk0, d0, b0, k0_, r0, v0, y0)
      RW_STEP(kk1, d1, b1, k1_, r1, v1, y1)
      RW_STEP(kk2, d2, b2, k2_, r2, v2, y2)
      RW_STEP(kk3, d3, b3, k3_, r3, v3, y3)
      if (ks == 0) {
        u16* yp = yo + (size_t)tt * PCOLS;
        yp[0] = f2bf(y0); yp[PCOLS] = f2bf(y1); yp[2 * (size_t)PCOLS] = f2bf(y2); yp[3 * (size_t)PCOLS] = f2bf(y3);
      }
    }
  }
  float* so = seq_out(p.out, seq, O_PWKV, O_SWKV, 8 * 4096);
  *(float4*)(so + ((size_t)h * 64 + v) * 64 + ks * 4) = make_float4(S0, S1, S2, S3);
}

__device__ void ssm_scan_item(const P& p, int seq, int head, int half, char* smem) {
  const int T = seq < 8 ? 2048 : 8, nbase = seq < 8 ? seq * 2048 : NP + (seq - 8) * 8;
  float* LB = (float*)smem;
  float* LC = LB + TC * 128;
  float* Lx = LC + TC * 128;
  float* Ldt = Lx + TC * 32;
  float* Ldec = Ldt + TC;
  const int tid = TIDX, pl = tid >> 3, ns = tid & 7;
  const int pp = half * 32 + pl, g = head >> 3;
  const float Dk = p.D_skip[head];
  float hs[16];
#pragma unroll
  for (int j = 0; j < 16; j++) hs[j] = 0.f;
  if (seq >= 8) {
    const float4* s4 = (const float4*)(p.state_ssm + (((size_t)(seq - 8) * 16 + head) * 64 + pp) * 128 + ns * 16);
#pragma unroll
    for (int j = 0; j < 4; j++) { float4 s = s4[j]; hs[4 * j] = s.x; hs[4 * j + 1] = s.y; hs[4 * j + 2] = s.z; hs[4 * j + 3] = s.w; }
  }
  uint4 gb0, gb1, gb2, gb3, gx; float gdt = 0.f, gdec = 0.f;
  gb0 = gb1 = gb2 = gb3 = gx = make_uint4(0, 0, 0, 0);
  const int bt = tid >> 5, bch = tid & 31;
  const u16* bsrc = p.xc + 1024 + (bch < 16 ? 0 : 256) + g * 128 + (bch & 15) * 8;
  const int xt = tid >> 2, xr8 = (tid & 3) * 8;
#define SS_GLOAD(c0_)                                                                          \
  {                                                                                            \
    const int tcn = min(TC, T - (c0_));                                                        \
    const size_t nb_ = (size_t)(nbase + (c0_));                                                \
    if (bt < tcn) gb0 = *(const uint4*)(bsrc + (nb_ + bt) * 1536);                             \
    if (bt + 8 < tcn) gb1 = *(const uint4*)(bsrc + (nb_ + bt + 8) * 1536);                     \
    if (bt + 16 < tcn) gb2 = *(const uint4*)(bsrc + (nb_ + bt + 16) * 1536);                   \
    if (bt + 24 < tcn) gb3 = *(const uint4*)(bsrc + (nb_ + bt + 24) * 1536);                   \
    if (tid < 128 && xt < tcn) gx = *(const uint4*)(p.xc + (nb_ + xt) * 1536 + head * 64 + half * 32 + xr8); \
    if (tid < tcn) { gdt = p.dtb[(nb_ + tid) * 16 + head]; gdec = p.decb[(nb_ + tid) * 16 + head]; } \
  }
  SS_GLOAD(0);
  for (int c0 = 0; c0 < T; c0 += TC) {
    const int tc = min(TC, T - c0);
    __syncthreads();
    {
      float* dstb = (bch < 16 ? LB : LC) + (bch & 15) * 8;
      float4 lo, hi;
      bf8_to_f(gb0, lo, hi); *(float4*)(dstb + bt * 128) = lo; *(float4*)(dstb + bt * 128 + 4) = hi;
      bf8_to_f(gb1, lo, hi); *(float4*)(dstb + (bt + 8) * 128) = lo; *(float4*)(dstb + (bt + 8) * 128 + 4) = hi;
      bf8_to_f(gb2, lo, hi); *(float4*)(dstb + (bt + 16) * 128) = lo; *(float4*)(dstb + (bt + 16) * 128 + 4) = hi;
      bf8_to_f(gb3, lo, hi); *(float4*)(dstb + (bt + 24) * 128) = lo; *(float4*)(dstb + (bt + 24) * 128 + 4) = hi;
      if (tid < 128) { bf8_to_f(gx, lo, hi); *(float4*)(Lx + xt * 32 + xr8) = lo; *(float4*)(Lx + xt * 32 + xr8 + 4) = hi; }
      if (tid < TC) { Ldt[tid] = gdt; Ldec[tid] = __expf(gdec); }
    }
    __syncthreads();
    if (c0 + TC < T) SS_GLOAD(c0 + TC);
    u16* yo = p.proj + (size_t)(nbase + c0) * PCOLS + C_XBC + head * 64 + pp;
    float4 B0 = *(const float4*)(LB + ns * 16), B1 = *(const float4*)(LB + ns * 16 + 4), B2 = *(const float4*)(LB + ns * 16 + 8),
           B3 = *(const float4*)(LB + ns * 16 + 12);
    float4 C0 = *(const float4*)(LC + ns * 16), C1 = *(const float4*)(LC + ns * 16 + 4), C2 = *(const float4*)(LC + ns * 16 + 8),
           C3 = *(const float4*)(LC + ns * 16 + 12);
    float xv = Lx[pl], dtv = Ldt[0], dec = Ldec[0];
    for (int tt = 0; tt < tc; tt++) {
      const int tn = min(tt + 1, tc - 1);
      const float* nB = LB + tn * 128 + ns * 16;
      const float* nC = LC + tn * 128 + ns * 16;
      const float4 nB0 = *(const float4*)(nB), nB1 = *(const float4*)(nB + 4), nB2 = *(const float4*)(nB + 8), nB3 = *(const float4*)(nB + 12);
      const float4 nC0 = *(const float4*)(nC), nC1 = *(const float4*)(nC + 4), nC2 = *(const float4*)(nC + 8), nC3 = *(const float4*)(nC + 12);
      const float nxv = Lx[tn * 32 + pl], ndt = Ldt[tn], ndec = Ldec[tn];
      const float dtx = dtv * xv;
      hs[0] = hs[0] * dec + dtx * B0.x; hs[1] = hs[1] * dec + dtx * B0.y; hs[2] = hs[2] * dec + dtx * B0.z; hs[3] = hs[3] * dec + dtx * B0.w;
      hs[4] = hs[4] * dec + dtx * B1.x; hs[5] = hs[5] * dec + dtx * B1.y; hs[6] = hs[6] * dec + dtx * B1.z; hs[7] = hs[7] * dec + dtx * B1.w;
      hs[8] = hs[8] * dec + dtx * B2.x; hs[9] = hs[9] * dec + dtx * B2.y; hs[10] = hs[10] * dec + dtx * B2.z; hs[11] = hs[11] * dec + dtx * B2.w;
      hs[12] = hs[12] * dec + dtx * B3.x; hs[13] = hs[13] * dec + dtx * B3.y; hs[14] = hs[14] * dec + dtx * B3.z; hs[15] = hs[15] * dec + dtx * B3.w;
      float y0 = hs[0] * C0.x + hs[1] * C0.y + hs[2] * C0.z + hs[3] * C0.w;
      float y1 = hs[4] * C1.x + hs[5] * C1.y + hs[6] * C1.z + hs[7] * C1.w;
      float y2 = hs[8] * C2.x + hs[9] * C2.y + hs[10] * C2.z + hs[11] * C2.w;
      float y3 = hs[12] * C3.x + hs[13] * C3.y + hs[14] * C3.z + hs[15] * C3.w;
      float yp = allreduce8((y0 + y1) + (y2 + y3));
      if (ns == 0) yo[(size_t)tt * PCOLS] = f2bf(yp + Dk * xv);
      B0 = nB0; B1 = nB1; B2 = nB2; B3 = nB3; C0 = nC0; C1 = nC1; C2 = nC2; C3 = nC3; xv = nxv; dtv = ndt; dec = ndec;
    }
  }
  float* so = seq_out(p.out, seq, O_PSSM, O_SSSM, 16 * 8192);
  float4* o4 = (float4*)(so + ((size_t)head * 64 + pp) * 128 + ns * 16);
#pragma unroll
  for (int j = 0; j < 4; j++) o4[j] = make_float4(hs[4 * j], hs[4 * j + 1], hs[4 * j + 2], hs[4 * j + 3]);
}

__device__ void ssd_prompt_item(const P& p, int seq, int head, char* smem) {
  const int nbase = seq * 2048, g = head >> 3;
  char* sC = smem;
  char* sB = smem + 17408;
  char* sBT = smem + 34816;
  char* sXT = smem + 53248;
  char* sH = smem + 62464;
  float* sS = (float*)(smem + 79872);
  const int tid = TIDX, lane = tid & 63, w = tid >> 6, fr = lane & 15, q = lane >> 4;
  const float Dk = p.D_skip[head];
  f32x4 H[8];
#pragma unroll
  for (int i = 0; i < 8; i++) H[i] = f32x4{0.f, 0.f, 0.f, 0.f};
  __syncthreads();
  for (int i = tid; i < 17408 / 16; i += 256) *(uint4*)(sH + i * 16) = make_uint4(0, 0, 0, 0);
  uint4 gB0, gB1, gB2, gB3, gC0, gC1, gC2, gC3, gX0, gX1;
  float gdt, gdA;
#define SSD_LOAD(t0_)                                                                         \
  {                                                                                           \
    const size_t nn_ = (size_t)(nbase + (t0_) + lane);                                        \
    const u16* row_ = p.xc + nn_ * 1536;                                                      \
    const u16* rb_ = row_ + 1024 + g * 128 + w * 32;                                          \
    gB0 = *(const uint4*)(rb_); gB1 = *(const uint4*)(rb_ + 8); gB2 = *(const uint4*)(rb_ + 16); gB3 = *(const uint4*)(rb_ + 24); \
    gC0 = *(const uint4*)(rb_ + 256); gC1 = *(const uint4*)(rb_ + 264); gC2 = *(const uint4*)(rb_ + 272); gC3 = *(const uint4*)(rb_ + 280); \
    gX0 = *(const uint4*)(row_ + head * 64 + w * 16); gX1 = *(const uint4*)(row_ + head * 64 + w * 16 + 8); \
    gdt = p.dtb[nn_ * 16 + head]; gdA = p.decb[nn_ * 16 + head];                              \
  }
#define SSD_PUT_T(dst_, r0_, u_, sc_)                                                         \
  {                                                                                           \
    const unsigned us_[4] = {u_.x, u_.y, u_.z, u_.w};                                         \
    _Pragma("unroll") for (int e = 0; e < 4; e++) {                                           \
      *(u16*)(dst_ + ((r0_) + 2 * e) * 144 + lane * 2) = f2bf(bflo(us_[e]) * (sc_));          \
      *(u16*)(dst_ + ((r0_) + 2 * e + 1) * 144 + lane * 2) = f2bf(bfhi(us_[e]) * (sc_));      \
    }                                                                                         \
  }
  SSD_LOAD(0);
#pragma unroll 1
  for (int c = 0; c < 32; c++) {
    const int t0 = c * 64;
    float cs = gdA;
#pragma unroll
    for (int o = 1; o < 64; o <<= 1) { const float v = __shfl_up(cs, o, 64); if (lane >= o) cs += v; }
    const float cs63 = __shfl(cs, 63, 64);
    const float wt = gdt * __expf(cs63 - cs);
    __syncthreads();
    if (w == 0) { sS[lane] = cs; sS[64 + lane] = __expf(cs); sS[128 + lane] = gdt; }
    {
      char* rc = sC + lane * 272 + w * 64;
      char* rb = sB + lane * 272 + w * 64;
      *(uint4*)(rc) = gC0; *(uint4*)(rc + 16) = gC1; *(uint4*)(rc + 32) = gC2; *(uint4*)(rc + 48) = gC3;
      *(uint4*)(rb) = gB0; *(uint4*)(rb + 16) = gB1; *(uint4*)(rb + 32) = gB2; *(uint4*)(rb + 48) = gB3;
      SSD_PUT_T(sBT, w * 32, gB0, wt) SSD_PUT_T(sBT, w * 32 + 8, gB1, wt) SSD_PUT_T(sBT, w * 32 + 16, gB2, wt)
      SSD_PUT_T(sBT, w * 32 + 24, gB3, wt) SSD_PUT_T(sXT, w * 16, gX0, 1.f) SSD_PUT_T(sXT, w * 16 + 8, gX1, 1.f)
    }
    __syncthreads();
    if (c + 1 < 32) SSD_LOAD(t0 + 64);
    f32x4 cb[4], yo[4];
#pragma unroll
    for (int i = 0; i < 4; i++) { cb[i] = f32x4{0.f, 0.f, 0.f, 0.f}; yo[i] = f32x4{0.f, 0.f, 0.f, 0.f}; }
    {
      bf16x8 af[4];
#pragma unroll
      for (int ks = 0; ks < 4; ks++) af[ks] = *(const bf16x8*)(sC + (16 * w + fr) * 272 + ks * 64 + q * 16);
#pragma unroll
      for (int nn = 0; nn < 4; nn++)
#pragma unroll
        for (int ks = 0; ks < 4; ks++) {
          const bf16x8 bb = *(const bf16x8*)(sB + (16 * nn + fr) * 272 + ks * 64 + q * 16);
          cb[nn] = __builtin_amdgcn_mfma_f32_16x16x32_bf16(af[ks], bb, cb[nn], 0, 0, 0);
        }
#pragma unroll
      for (int pt = 0; pt < 4; pt++)
#pragma unroll
        for (int ks = 0; ks < 4; ks++) {
          const bf16x8 bb = *(const bf16x8*)(sH + (16 * pt + fr) * 272 + ks * 64 + q * 16);
          yo[pt] = __builtin_amdgcn_mfma_f32_16x16x32_bf16(af[ks], bb, yo[pt], 0, 0, 0);
        }
    }
    __syncthreads();
#pragma unroll
    for (int j = 0; j < 4; j++) {
      const int l = 16 * w + q * 4 + j;
      const float csl = sS[l];
#pragma unroll
      for (int nn = 0; nn < 4; nn++) {
        const int sidx = 16 * nn + fr;
        const float gv = (sidx <= l) ? cb[nn][j] * __expf(csl - sS[sidx]) * sS[128 + sidx] : 0.f;
        *(u16*)(sB + l * 144 + sidx * 2) = f2bf(gv);
      }
    }
    f32x4 yd[4];
#pragma unroll
    for (int i = 0; i < 4; i++) yd[i] = f32x4{0.f, 0.f, 0.f, 0.f};
#pragma unroll
    for (int ks = 0; ks < 2; ks++) {
      const bf16x8 aa = *(const bf16x8*)(sB + (16 * w + fr) * 144 + ks * 64 + q * 16);
#pragma unroll
      for (int pt = 0; pt < 4; pt++) {
        const bf16x8 bb = *(const bf16x8*)(sXT + (16 * pt + fr) * 144 + ks * 64 + q * 16);
        yd[pt] = __builtin_amdgcn_mfma_f32_16x16x32_bf16(aa, bb, yd[pt], 0, 0, 0);
      }
    }
#pragma unroll
    for (int j = 0; j < 4; j++) {
      const int l = 16 * w + q * 4 + j;
      const float el = sS[64 + l];
      u16* yrow = p.proj + (size_t)(nbase + t0 + l) * PCOLS + C_XBC + head * 64 + fr;
#pragma unroll
      for (int pt = 0; pt < 4; pt++) {
        const float xs = bf2f(*(const u16*)(sXT + (16 * pt + fr) * 144 + l * 2));
        yrow[16 * pt] = f2bf(yd[pt][j] + el * yo[pt][j] + Dk * xs);
      }
    }
    const float ach = __expf(cs63);
#pragma unroll
    for (int nt = 0; nt < 8; nt++) { H[nt][0] *= ach; H[nt][1] *= ach; H[nt][2] *= ach; H[nt][3] *= ach; }
#pragma unroll
    for (int ks = 0; ks < 2; ks++) {
      const bf16x8 aa = *(const bf16x8*)(sXT + (16 * w + fr) * 144 + ks * 64 + q * 16);
#pragma unroll
      for (int nt = 0; nt < 8; nt++) {
        const bf16x8 bb = *(const bf16x8*)(sBT + (16 * nt + fr) * 144 + ks * 64 + q * 16);
        H[nt] = __builtin_amdgcn_mfma_f32_16x16x32_bf16(aa, bb, H[nt], 0, 0, 0);
      }
    }
#pragma unroll
    for (int nt = 0; nt < 8; nt++)
#pragma unroll
      for (int j = 0; j < 4; j++) *(u16*)(sH + (16 * w + q * 4 + j) * 272 + (16 * nt + fr) * 2) = f2bf(H[nt][j]);
  }
  float* so = p.out + O_PSSM + ((size_t)seq * 16 + head) * 8192;
#pragma unroll
  for (int nt = 0; nt < 8; nt++)
#pragma unroll
    for (int j = 0; j < 4; j++) so[(16 * w + q * 4 + j) * 128 + 16 * nt + fr] = H[nt][j];
  __syncthreads();
}

constexpr int P4_RP = 256, P4_SP = 128, P4_RS = 4096, P4_SS = 4096;
#define XB_QUEUE 3600
__device__ void phase4(const P& p, int bid, int nb, char* smem) {
  for (int it = bid; it < P4_RP + P4_SP; it += nb) {
    if (it < P4_RP) rwkv_scan_item(p, it >> 5, (it >> 2) & 7, it & 3, smem);
    else { const int i = it - P4_RP; ssd_prompt_item(p, i >> 4, i & 15, smem); }
  }
  volatile int* slot = (volatile int*)(smem + LDS_BYTES - 32);
  for (;;) {
    __syncthreads();
    if (TIDX == 0) *slot = (int)atomicAdd(&p.bar[XB_QUEUE], 1u);
    __syncthreads();
    int i = *slot;
    if (i >= P4_RS + P4_SS) break;
    if (i < P4_RS) rwkv_scan_item(p, 8 + (i >> 5), (i >> 2) & 7, i & 3, smem);
    else { i -= P4_RS; ssm_scan_item(p, 8 + (i >> 5), (i >> 1) & 15, i & 1, smem); }
  }
}

__device__ void phase5(const P& p, int bid, int nb) {
  const int lane = TIDX & 63, wid = TIDX >> 6;
  for (int it = bid; it < NT / 4; it += nb) {
    const int n = it * 4 + wid;
    const uint4 sy0 = *(const uint4*)(p.proj + (size_t)n * PCOLS + C_XBC + lane * 16);
    const uint4 sy1 = *(const uint4*)(p.proj + (size_t)n * PCOLS + C_XBC + lane * 16 + 8);
    const uint4 sz0 = *(const uint4*)(p.proj + (size_t)n * PCOLS + C_Z + lane * 16);
    const uint4 sz1 = *(const uint4*)(p.proj + (size_t)n * PCOLS + C_Z + lane * 16 + 8);
    {
      const int c = lane * 8;
      uint4 yu = *(const uint4*)(p.proj + (size_t)n * PCOLS + c);
      const u16* pr = p.prep + (size_t)n * 3584 + c;
      uint4 ru = *(const uint4*)(pr + 512), ku = *(const uint4*)(pr + 1024), vu = *(const uint4*)(pr + 2560),
            gu = *(const uint4*)(pr + 3072);
      unsigned ys[4] = {yu.x, yu.y, yu.z, yu.w}, rs[4] = {ru.x, ru.y, ru.z, ru.w}, ks_[4] = {ku.x, ku.y, ku.z, ku.w},
               vs[4] = {vu.x, vu.y, vu.z, vu.w}, gs[4] = {gu.x, gu.y, gu.z, gu.w};
      float y[8], r[8], k[8], v[8], g[8];
#pragma unroll
      for (int e = 0; e < 4; e++) {
        y[2 * e] = bflo(ys[e]); y[2 * e + 1] = bfhi(ys[e]);
        r[2 * e] = bflo(rs[e]); r[2 * e + 1] = bfhi(rs[e]);
        k[2 * e] = bflo(ks_[e]); k[2 * e + 1] = bfhi(ks_[e]);
        v[2 * e] = bflo(vs[e]); v[2 * e + 1] = bfhi(vs[e]);
        g[2 * e] = bflo(gs[e]); g[2 * e + 1] = bfhi(gs[e]);
      }
      float s = 0.f, bn = 0.f;
#pragma unroll
      for (int e = 0; e < 8; e++) { s += y[e]; bn += r[e] * k[e] * p.rw_r_k[c + e]; }
      s = allreduce8(s); bn = allreduce8(bn);
      const float mean = s * (1.f / 64.f);
      float vr = 0.f;
#pragma unroll
      for (int e = 0; e < 8; e++) { const float d = y[e] - mean; vr += d * d; }
      vr = allreduce8(vr) * (1.f / 64.f);
      const float rs_ = rsqrtf(vr + 64e-5f);
      float o[8];
#pragma unroll
      for (int e = 0; e < 8; e++) {
        const float yn = (y[e] - mean) * rs_ * p.rw_ln_w[c + e] + p.rw_ln_b[c + e];
        o[e] = (yn + bn * v[e]) * g[e];
      }
      uint4 ou; ou.x = pack2(o[0], o[1]); ou.y = pack2(o[2], o[3]); ou.z = pack2(o[4], o[5]); ou.w = pack2(o[6], o[7]);
      *(uint4*)(p.oa + (size_t)n * 512 + c) = ou;
    }
    {
      const int c = lane * 16;
      float yv[16];
      float ss = 0.f;
#pragma unroll
      for (int hh = 0; hh < 2; hh++) {
        const uint4 yu = hh ? sy1 : sy0;
        const uint4 zu = hh ? sz1 : sz0;
        unsigned ys[4] = {yu.x, yu.y, yu.z, yu.w}, zs[4] = {zu.x, zu.y, zu.z, zu.w};
#pragma unroll
        for (int e = 0; e < 4; e++) {
          const float a = bflo(ys[e]) * siluf_(bflo(zs[e])), b = bfhi(ys[e]) * siluf_(bfhi(zs[e]));
          yv[hh * 8 + 2 * e] = a; yv[hh * 8 + 2 * e + 1] = b;
          ss += a * a + b * b;
        }
      }
#pragma unroll
      for (int o = 16; o >= 1; o >>= 1) ss += __shfl_xor(ss, o, 64);
      const float rstd = rsqrtf(ss * (1.f / 512.f) + 1e-6f);
      unsigned ou[8];
#pragma unroll
      for (int e = 0; e < 8; e++)
        ou[e] = pack2(yv[2 * e] * rstd * p.ssm_norm_w[c + 2 * e], yv[2 * e + 1] * rstd * p.ssm_norm_w[c + 2 * e + 1]);
      *(uint4*)(p.ob + (size_t)n * 1024 + c) = make_uint4(ou[0], ou[1], ou[2], ou[3]);
      *(uint4*)(p.ob + (size_t)n * 1024 + c + 8) = make_uint4(ou[4], ou[5], ou[6], ou[7]);
    }
  }
}

__device__ void phase6(const P& p, int bid, int nb, char* smem) {
  TileIter ti(bid, nb, 136, 8);
  int mt, nt;
  while (ti.next(mt, nt)) {
    f32x4 ac[4][4];
    unsigned sg[4][4][2];
    u16* Lt = (u16*)smem;
    zero_acc(ac);
    gemm_tile_glds(p.xn, D, mt * 128, p.w_inT + (size_t)G_A * D, D, nt * 128, D, ac, smem);
#pragma unroll
    for (int m = 0; m < 4; m++)
#pragma unroll
      for (int n = 0; n < 4; n++) {
        sg[m][n][0] = pack2(sigmoidf_(ac[m][n][0]), sigmoidf_(ac[m][n][1]));
        sg[m][n][1] = pack2(sigmoidf_(ac[m][n][2]), sigmoidf_(ac[m][n][3]));
      }
    zero_acc(ac);
    gemm_tile_glds(p.oa, 512, mt * 128, p.w_paT, 512, nt * 128, 512, ac, smem);
    ACC_FOREACH({
      const unsigned gu = sg[m][n][j >> 1];
      Lt[row * 136 + col] = f2bf(((j & 1) ? bfhi(gu) : bflo(gu)) * ac[m][n][j]);
    })
    tile_out_bf16(smem, p.merged, D, mt * 128, nt * 128, 128);
    zero_acc(ac);
    gemm_tile_glds(p.xn, D, mt * 128, p.w_inT + (size_t)G_B * D, D, nt * 128, D, ac, smem);
#pragma unroll
    for (int m = 0; m < 4; m++)
#pragma unroll
      for (int n = 0; n < 4; n++) {
        sg[m][n][0] = pack2(sigmoidf_(ac[m][n][0]), sigmoidf_(ac[m][n][1]));
        sg[m][n][1] = pack2(sigmoidf_(ac[m][n][2]), sigmoidf_(ac[m][n][3]));
      }
    zero_acc(ac);
    gemm_tile_glds(p.ob, D, mt * 128, p.w_pbT, D, nt * 128, D, ac, smem);
    ACC_FOREACH({
      const unsigned gu = sg[m][n][j >> 1];
      Lt[row * 136 + col] = f2bf(((j & 1) ? bfhi(gu) : bflo(gu)) * ac[m][n][j]);
    })
    __syncthreads();
    {
      const int tid = TIDX;
#pragma unroll
      for (int i = 0; i < 8; i++) {
        const int id = tid + i * 256, row = id >> 4, ch = id & 15;
        u16* gp = p.merged + (size_t)(mt * 128 + row) * D + nt * 128 + ch * 8;
        const uint4 a = *(const uint4*)gp, b = *(const uint4*)(smem + row * 272 + ch * 16);
        uint4 o;
        o.x = pack2(bflo(a.x) + bflo(b.x), bfhi(a.x) + bfhi(b.x));
        o.y = pack2(bflo(a.y) + bflo(b.y), bfhi(a.y) + bfhi(b.y));
        o.z = pack2(bflo(a.z) + bflo(b.z), bfhi(a.z) + bfhi(b.z));
        o.w = pack2(bflo(a.w) + bflo(b.w), bfhi(a.w) + bfhi(b.w));
        *(uint4*)gp = o;
      }
    }
  }
}

constexpr int P7_G = 136 * 8, P7_CV = 16384;
constexpr float U_SCALE = 256.f, V_SCALE = 32.f;
__device__ void phase7(const P& p, int bid, int nb, char* smem) {
  {
    TileIter ti(bid, nb, 136, 8);
    int mt, nt;
    while (ti.next(mt, nt)) {
      f32x4 acc[4][4];
      zero_acc(acc);
      gemm_tile_glds(p.merged, D, mt * 128, p.w_outT, D, nt * 128, D, acc, smem);
      float* Lf = (float*)smem;
      ACC_FOREACH({ Lf[row * 132 + col] = acc[m][n][j]; })
      __syncthreads();
      {
        const int tid = TIDX;
#pragma unroll 4
        for (int i = 0; i < 16; i++) {
          const int id = tid + i * 256, row = id >> 5, c4 = (id & 31) * 4;
          const int nn = mt * 128 + row, c = nt * 128 + c4;
          int seq, t, T; tok2seq(nn, seq, t, T);
          const float4 a = *(const float4*)(Lf + row * 132 + c4);
          const float4 g = *(const float4*)(p.mod + (size_t)seq * 8192 + 2048 + c);
          const float4 x = *(const float4*)(xrow(p, nn) + c);
          *(float4*)(p.out + O_Y + (size_t)nn * D + c) = make_float4(x.x + g.x * a.x, x.y + g.y * a.y, x.z + g.z * a.z, x.w + g.w * a.w);
        }
      }
    }
  }
  int cw = bid, cn = nb;
  if (nb == 512) { const int lb = bid >> 3; if (lb < 8) return; cw = (bid & 7) * 56 + (lb - 8); cn = 448; }
  for (int it0 = cw; it0 < P7_CV; it0 += 4 * cn) {
    const int tid = TIDX;
    float4 va[4], vb[4];
#pragma unroll
    for (int r = 0; r < 4; r++) {
      const int it = it0 + r * cn;
      if (it < P7_CV) {
        const float* src = it < 8192 ? p.peer_u + (size_t)it * 2048 : p.peer_v + (size_t)(it - 8192) * 2048;
        const float4* s4 = (const float4*)src + tid * 2;
        va[r] = s4[0]; vb[r] = s4[1];
      }
    }
#pragma unroll
    for (int r = 0; r < 4; r++) {
      const int it = it0 + r * cn;
      if (it < P7_CV) {
        unsigned char* dst = it < 8192 ? (unsigned char*)p.ub + (size_t)it * 2048 : (unsigned char*)p.vb + (size_t)(it - 8192) * 2048;
        const float sc = it < 8192 ? U_SCALE : V_SCALE;
        const float4 a = va[r], b = vb[r];
        int lo = __builtin_amdgcn_cvt_pk_fp8_f32(a.x * sc, a.y * sc, 0, false);
        lo = __builtin_amdgcn_cvt_pk_fp8_f32(a.z * sc, a.w * sc, lo, true);
        int hi = __builtin_amdgcn_cvt_pk_fp8_f32(b.x * sc, b.y * sc, 0, false);
        hi = __builtin_amdgcn_cvt_pk_fp8_f32(b.z * sc, b.w * sc, hi, true);
        *((uint2*)dst + tid) = make_uint2((unsigned)lo, (unsigned)hi);
      }
    }
  }
}

__device__ void phase9(const P& p, int bid, int nb, char* smem) {
  const int tid = TIDX, lane = tid & 63, wid = tid >> 6, wr = wid >> 1, wc = wid & 1, fr = lane & 15,
            fq = lane >> 4;
  TileIter ti(bid, nb, 136, 16);
  int mt, nt;
  while (ti.next(mt, nt)) {
    f32x4 acc[4][4];
    zero_acc(acc);
    gemm_tile_glds(p.xn, D, mt * 128, p.wqT, D, nt * 128, D, acc, smem);
    u16* Lq = (u16*)smem;
    ACC_FOREACH({ Lq[row * 136 + col] = f2bf(acc[m][n][j]); })
    __syncthreads();
    f32x4 sc[4][4];
    zero_acc(sc);
    const u16* kb = p.keysb + (size_t)nt * 128 * 128;
#pragma unroll 1
    for (int s = 0; s < 4; s++) {
      bf16x8 af[4], bfr[4];
#pragma unroll
      for (int m = 0; m < 4; m++) af[m] = *(const bf16x8*)((const char*)Lq + (wr * 64 + m * 16 + fr) * 272 + s * 64 + fq * 16);
#pragma unroll
      for (int n = 0; n < 4; n++) bfr[n] = *(const bf16x8*)(kb + (size_t)(wc * 64 + n * 16 + fr) * 128 + s * 32 + fq * 8);
#pragma unroll
      for (int m = 0; m < 4; m++)
#pragma unroll
        for (int n = 0; n < 4; n++) sc[m][n] = __builtin_amdgcn_mfma_f32_16x16x32_bf16(af[m], bfr[n], sc[m][n], 0, 0, 0);
    }
    __syncthreads();
    float* Ls = (float*)smem;
#pragma unroll
    for (int m = 0; m < 4; m++)
#pragma unroll
      for (int n = 0; n < 4; n++)
#pragma unroll
        for (int j = 0; j < 4; j++) {
          const int kc = wc * 64 + n * 16 + fr;
          int sb = __float_as_int(sc[m][n][j]);
          sb ^= (sb >> 31) & 0x7fffffff;
          ((int*)Ls)[(wr * 64 + m * 16 + fq * 4 + j) * 132 + kc] = (sb & ~127) | (127 - kc);
        }
    __syncthreads();
    {
      const int row = tid >> 1, half = tid & 1;
      int* Li = (int*)Ls + row * 132 + half * 64;
      const size_t ob = ((size_t)(mt * 128 + row) * 16 + nt) * 16;
      for (int r = 0; r < 16; r++) {
        int best = (int)0x80000000;
#pragma unroll
        for (int i = 0; i < 16; i++) {
          const int4 k4 = *(const int4*)(Li + 4 * i);
          best = max(max(best, k4.x), max(k4.y, max(k4.z, k4.w)));
        }
        best = max(best, __shfl_xor(best, 1, 64));
        const int bi = 127 - (best & 127);
        if ((bi >> 6) == half) Li[bi & 63] = (int)0x80000000;
        if (half == 0) {
          int vb = best & ~127;
          vb ^= (vb >> 31) & 0x7fffffff;
          p.topv[ob + r] = __int_as_float(vb);
          p.topi[ob + r] = bi;
        }
      }
    }
    __syncthreads();
  }
}

__device__ __forceinline__ void cand_ij(int lane, int& ci, int& cj) {
  int i = 0, rem = lane;
#pragma unroll
  for (int r = 0; r < 16; r++) {
    const int cnt = 16 / (r + 1);
    if (i == r && rem >= cnt) { rem -= cnt; i = r + 1; }
  }
  ci = i; cj = rem;
}

typedef __attribute__((ext_vector_type(2))) __bf16 bf2_t;
__device__ __forceinline__ float dot2bf(unsigned a, unsigned b, float c) {
  return __builtin_amdgcn_fdot2_f32_bf16(__builtin_bit_cast(bf2_t, a), __builtin_bit_cast(bf2_t, b), c, false);
}
template <int CTRL, int RM>
__device__ __forceinline__ float dppf_m(float x) {
  return __int_as_float(__builtin_amdgcn_update_dpp(0, __float_as_int(x), CTRL, RM, 0xf, false));
}
__device__ __forceinline__ float wave_sum_l63(float x) {
  x += dppf<0xB1>(x);
  x += dppf<0x4E>(x);
  x += dppf<0x141>(x);
  x += dppf<0x140>(x);
  x += dppf_m<0x142, 0xA>(x);
  x += dppf_m<0x143, 0xC>(x);
  return x;
}
__device__ __forceinline__ float readlane_f(float x, int l) {
  return __int_as_float(__builtin_amdgcn_readlane(__float_as_int(x), l));
}
__device__ __forceinline__ void axpy8(float* acc, float w, uint4 v) {
  acc[0] += w * bflo(v.x); acc[1] += w * bfhi(v.x); acc[2] += w * bflo(v.y); acc[3] += w * bfhi(v.y);
  acc[4] += w * bflo(v.z); acc[5] += w * bfhi(v.z); acc[6] += w * bflo(v.w); acc[7] += w * bfhi(v.w);
}

typedef float f2_t __attribute__((ext_vector_type(2)));
__device__ __forceinline__ void fp8x16_to_f32(const uint4 v, float* o) {
  const unsigned w[4] = {v.x, v.y, v.z, v.w};
#pragma unroll
  for (int i = 0; i < 4; i++) {
    const f2_t lo = __builtin_amdgcn_cvt_pk_f32_fp8((int)w[i], false);
    const f2_t hi = __builtin_amdgcn_cvt_pk_f32_fp8((int)w[i], true);
    o[4 * i] = lo.x; o[4 * i + 1] = lo.y; o[4 * i + 2] = hi.x; o[4 * i + 3] = hi.y;
  }
}

__device__ void phase10(const P& p, int bid, int nb) {
  const int lane = TIDX & 63, wid = TIDX >> 6;
  int ci, cj; cand_ij(lane < 50 ? lane : 0, ci, cj);
  const unsigned char* ub8 = (const unsigned char*)p.ub;
  const unsigned char* vb8 = (const unsigned char*)p.vb;
  for (int it = bid; it < NT / 4; it += nb) {
    const int n = it * 4 + wid;
    int seq, t, T; tok2seq(n, seq, t, T);
    float xv[16];
    {
      const uint4 a = *(const uint4*)(p.xn + (size_t)n * D + lane * 16), b = *(const uint4*)(p.xn + (size_t)n * D + lane * 16 + 8);
      const unsigned as[4] = {a.x, a.y, a.z, a.w}, bs[4] = {b.x, b.y, b.z, b.w};
#pragma unroll
      for (int e = 0; e < 4; e++) { xv[2 * e] = bflo(as[e]); xv[2 * e + 1] = bfhi(as[e]); xv[8 + 2 * e] = bflo(bs[e]); xv[8 + 2 * e + 1] = bfhi(bs[e]); }
    }
    float acc[16];
#pragma unroll
    for (int e = 0; e < 16; e++) acc[e] = 0.f;
#pragma unroll 1
    for (int h = 0; h < 8; h++) {
      const size_t base = ((size_t)n * 16 + h * 2) * 16;
      float cand = -INFINITY; int eid = 0;
      if (lane < 50) {
        cand = p.topv[base + ci] + p.topv[base + 16 + cj];
        eid = p.topi[base + ci] * 128 + p.topi[base + 16 + cj];
      }
      int rank = 0;
#pragma unroll
      for (int m = 0; m < 50; m++) {
        const float cm = readlane_f(cand, m);
        rank += ((cm > cand) || (cm == cand && m < lane)) ? 1 : 0;
      }
      const bool sel = (lane < 50) && (rank < 16);
      unsigned long long mask = __ballot(sel);
      const float mx = readlane_f(cand, __builtin_ctzll(__ballot(sel && rank == 0)));
      const float ex = sel ? __expf(cand - mx) : 0.f;
      const float den = readlane_f(wave_sum_l63(ex), 63);
      const float gate = ex / den;
#pragma unroll 1
      for (int hf = 0; hf < 2; hf++) {
        int ek[8]; float gk[8];
#pragma unroll
        for (int k = 0; k < 8; k++) {
          const int src = __builtin_ctzll(mask);
          mask &= mask - 1;
          ek[k] = __builtin_amdgcn_readlane(eid, src);
          gk[k] = readlane_f(gate, src);
        }
        uint4 uu[8], vv[8];
#pragma unroll
        for (int j = 0; j < 8; j++) uu[j] = *(const uint4*)(ub8 + (size_t)ek[j] * D + lane * 16);
#pragma unroll
        for (int j = 0; j < 8; j++) vv[j] = *(const uint4*)(vb8 + (size_t)ek[j] * D + lane * 16);
        float dv = 0.f;
#pragma unroll
        for (int j = 0; j < 8; j++) {
          float uf[16];
          fp8x16_to_f32(uu[j], uf);
          float d0 = 0.f, d1 = 0.f;
#pragma unroll
          for (int e = 0; e < 8; e++) { d0 += uf[2 * e] * xv[2 * e]; d1 += uf[2 * e + 1] * xv[2 * e + 1]; }
          const float ds = readlane_f(wave_sum_l63(d0 + d1), 63);
          dv = (lane == j) ? ds : dv;
        }
        dv *= (1.f / U_SCALE);
        const float act = 0.5f * dv * (1.f + erff(dv * 0.70710678118654752f));
#pragma unroll
        for (int j = 0; j < 8; j++) {
          const float w = readlane_f(act, j) * gk[j] * (1.f / V_SCALE);
          float vf[16];
          fp8x16_to_f32(vv[j], vf);
#pragma unroll
          for (int e = 0; e < 16; e++) acc[e] += w * vf[e];
        }
      }
    }
    float* yr = p.out + O_Y + (size_t)n * D + lane * 16;
    const float* md = p.mod + (size_t)seq * 8192 + lane * 16;
    float x2[16];
    float ss = 0.f;
#pragma unroll
    for (int q4 = 0; q4 < 4; q4++) {
      const float4 a = *(const float4*)(yr + q4 * 4), g = *(const float4*)(md + 5120 + q4 * 4);
      x2[q4 * 4 + 0] = a.x + g.x * acc[q4 * 4 + 0]; x2[q4 * 4 + 1] = a.y + g.y * acc[q4 * 4 + 1];
      x2[q4 * 4 + 2] = a.z + g.z * acc[q4 * 4 + 2]; x2[q4 * 4 + 3] = a.w + g.w * acc[q4 * 4 + 3];
    }
#pragma unroll
    for (int e = 0; e < 16; e++) ss += x2[e] * x2[e];
    ss = readlane_f(wave_sum_l63(ss), 63);
    const float rstd = rsqrtf(ss * (1.f / 1024.f) + 1e-6f);
#pragma unroll
    for (int q4 = 0; q4 < 4; q4++) {
      const float4 fg = *(const float4*)(p.final_g + lane * 16 + q4 * 4), sc = *(const float4*)(md + 7168 + q4 * 4),
                   sh = *(const float4*)(md + 6144 + q4 * 4);
      float4 o;
      o.x = x2[q4 * 4 + 0] * rstd * fg.x * (1.f + sc.x) + sh.x;
      o.y = x2[q4 * 4 + 1] * rstd * fg.y * (1.f + sc.y) + sh.y;
      o.z = x2[q4 * 4 + 2] * rstd * fg.z * (1.f + sc.z) + sh.z;
      o.w = x2[q4 * 4 + 3] * rstd * fg.w * (1.f + sc.w) + sh.w;
      *(float4*)(yr + q4 * 4) = o;
    }
  }
}

#define XB_XCNT(j) (256 + 64 * (j))
#define XB_XSUB(j) (1280 + 64 * (j))
#define XB_XGEN(j) (2304 + 64 * (j))
#define XB_TOP 3328
#define XB_TOPGEN 3392
#define XB_WORDS 4096
__device__ __forceinline__ unsigned xb_ld(unsigned* p) { return __hip_atomic_load(p, __ATOMIC_RELAXED, __HIP_MEMORY_SCOPE_AGENT); }
__device__ __forceinline__ unsigned xb_add(unsigned* p, unsigned v) { return __hip_atomic_fetch_add(p, v, __ATOMIC_RELAXED, __HIP_MEMORY_SCOPE_AGENT); }
__device__ __forceinline__ unsigned xb_xcc_id() { return (unsigned)__builtin_amdgcn_s_getreg((3 << 11) | 20) & 0xFu; }
__device__ __forceinline__ void grid_barrier(unsigned* bar, volatile unsigned* xst) {
  asm volatile("s_waitcnt vmcnt(0)" ::: "memory");
  __syncthreads();
  if (TIDX == 0) {
    __builtin_amdgcn_s_waitcnt(0);
    const unsigned x = xst[0], nloc = xst[1], nx = xst[2];
    const unsigned old = xb_add(&bar[XB_XSUB(x)], 1u);
    const unsigned gen = old / nloc;
    if (old + 1u == (gen + 1u) * nloc) {
      __builtin_amdgcn_fence(__ATOMIC_RELEASE, "agent");
      asm volatile("s_waitcnt vmcnt(0)" ::: "memory");
      const unsigned og = xb_add(&bar[XB_TOP], 1u);
      const unsigned tg = og / nx;
      if (og + 1u == (tg + 1u) * nx) xb_add(&bar[XB_TOPGEN], 1u);
      else while (xb_ld(&bar[XB_TOPGEN]) == tg) __builtin_amdgcn_s_sleep(1);
      __builtin_amdgcn_fence(__ATOMIC_ACQUIRE, "agent");
      xb_add(&bar[XB_XGEN(x)], 1u);
      asm volatile("s_waitcnt vmcnt(0)" ::: "memory");
    } else {
      while (xb_ld(&bar[XB_XGEN(x)]) == gen) __builtin_amdgcn_s_sleep(1);
      __builtin_amdgcn_fence(__ATOMIC_ACQUIRE, "agent");
      asm volatile("s_waitcnt vmcnt(0)" ::: "memory");
    }
  }
  __syncthreads();
}

template <int PH>
__device__ __forceinline__ void run_phase(const P& p, int bid, int nb, char* smem) {
  if constexpr (PH == 0) phase0(p, bid, nb, smem);
  if constexpr (PH == 1) phase_norm<false>(p, bid, nb);
  if constexpr (PH == 2) phase2(p, bid, nb, smem);
  if constexpr (PH == 3) phase3(p, bid, nb, smem);
  if constexpr (PH == 4) phase4(p, bid, nb, smem);
  if constexpr (PH == 5) phase5(p, bid, nb);
  if constexpr (PH == 6) phase6(p, bid, nb, smem);
  if constexpr (PH == 7) phase7(p, bid, nb, smem);
  if constexpr (PH == 8) phase_norm<true>(p, bid, nb);
  if constexpr (PH == 9) phase9(p, bid, nb, smem);
  if constexpr (PH == 10) phase10(p, bid, nb);
  if constexpr (PH == 11) phase3b(p, bid, nb, smem);
}

template <int PH>
__global__ void __launch_bounds__(NTHREADS, 2) k_phase(P p) {
  extern __shared__ __attribute__((aligned(16))) char smem[];
  run_phase<PH>(p, blockIdx.x, gridDim.x, smem);
}

#if MEGA
__global__ void __launch_bounds__(NTHREADS, 2) k_mega(P p) {
  extern __shared__ __attribute__((aligned(16))) char smem[];
  cg::grid_group grid = cg::this_grid();
  const int bid = blockIdx.x, nb = gridDim.x;
#ifndef PROBE_ALL2
#define PROBE_ALL2 0
#endif
#ifndef PROBE_MASK
#define PROBE_MASK 0
#endif
#ifndef PROBE_SYNCS
#define PROBE_SYNCS 0
#endif
  volatile unsigned* xst = (volatile unsigned*)(smem + LDS_BYTES - 16);
  if (TIDX == 0) { const unsigned xcc0 = xb_xcc_id(); xst[0] = xcc0; xb_add(&p.bar[XB_XCNT(xcc0)], 1u); }
#define GSYNC(k)                                                                                 \
  {                                                                                              \
    if ((k) == 0) {                                                                              \
      grid.sync();                                                                               \
      if (TIDX == 0) {                                                                    \
        unsigned cnt = 0;                                                                        \
        for (unsigned j = 0; j < 16; ++j) cnt += xb_ld(&p.bar[XB_XCNT(j)]) > 0u ? 1u : 0u;       \
        xst[2] = cnt; xst[1] = xb_ld(&p.bar[XB_XCNT(xst[0])]);                                   \
      }                                                                                          \
    } else grid_barrier(p.bar, xst);                                                             \
  }
#define RUNPH(k)                                                       \
  run_phase<k>(p, bid, nb, smem); GSYNC(k)                             \
  if (PROBE_MASK & (1 << k)) { run_phase<k>(p, bid, nb, smem); GSYNC(1) }
#pragma unroll 1
  for (int rep = 0; rep < 1 + PROBE_ALL2; rep++) {
    RUNPH(0)
#pragma unroll 1
    for (int i = 0; i < PROBE_SYNCS; i++) GSYNC(1)
    RUNPH(1) RUNPH(2) RUNPH(3) RUNPH(11) RUNPH(4) RUNPH(5) RUNPH(6) RUNPH(7) RUNPH(8) RUNPH(9)
  }
  run_phase<10>(p, bid, nb, smem);
}
#endif

template <int PH>
static void launch_phase(const P& p, int grid, hipStream_t stream) {
  static bool attr = false;
  if (!attr) { hipFuncSetAttribute((const void*)k_phase<PH>, hipFuncAttributeMaxDynamicSharedMemorySize, LDS_BYTES); attr = true; }
  hipLaunchKernelGGL(k_phase<PH>, dim3(grid), dim3(NTHREADS), LDS_BYTES, stream, p);
}

extern "C" void kernel_launch(void* const* d_in, const int* in_sizes, int n_in, void* d_out, int out_size, void* d_ws,
                              size_t ws_size, hipStream_t stream) {
  P p{};
  const float** fp = (const float**)&p;
  for (int i = 0; i < 40; i++) fp[i] = (const float*)d_in[i];
  p.out = (float*)d_out;
  char* ws = (char*)d_ws;
  size_t off = 0;
  auto take = [&](size_t bytes) { char* r = ws + off; off += (bytes + 255) & ~(size_t)255; return r; };
  p.bar = (unsigned*)take(XB_WORDS * 4);
  p.w_inT = (u16*)take((size_t)INCOLS * D * 2);
  p.w_paT = (u16*)take((size_t)1024 * 512 * 2);
  p.w_pbT = (u16*)take((size_t)1024 * 1024 * 2);
  p.w_outT = (u16*)take((size_t)1024 * 1024 * 2);
  p.wqT = (u16*)take((size_t)2048 * 1024 * 2);
  p.keysb = (u16*)take((size_t)262144 * 2);
  p.mod = (float*)take((size_t)NSEQ * 8192 * 4);
  p.dtb = (float*)take((size_t)NT * 16 * 4);
  p.decb = (float*)take((size_t)NT * 16 * 4);
  p.xn = (u16*)take((size_t)NROWS * D * 2);
  p.proj = (u16*)take((size_t)NROWS * PCOLS * 2);
  p.prep = (u16*)take((size_t)NT * 3584 * 2);
  p.w2T = (u16*)take(512 * 64 * 2);
  p.a2T = (u16*)take(512 * 64 * 2);
  p.g2T = (u16*)take(512 * 128 * 2);
  p.lora = (u16*)take((size_t)NT * 256 * 2);
  if (off > ws_size) { fprintf(stderr, "workspace too small: need %zu have %zu\n", off, ws_size); return; }
  p.merged = p.prep;
  p.ub = p.proj;
  p.vb = p.proj + (size_t)16384 * 1024;
  p.topv = (float*)(p.proj + (size_t)2 * 16384 * 1024);
  p.topi = (int*)(p.topv + (size_t)NT * 256);
  p.xc = (u16*)d_out;
  p.oa = (u16*)d_out;
  p.ob = (u16*)d_out + (size_t)NT * 512;

  static int grid = 0;
  if (!grid) {
    int dev = 0, cus = 0, per_cu = 0;
    hipGetDevice(&dev);
    hipDeviceGetAttribute(&cus, hipDeviceAttributeMultiprocessorCount, dev);
#if MEGA
    hipFuncSetAttribute((const void*)k_mega, hipFuncAttributeMaxDynamicSharedMemorySize, LDS_BYTES);
    hipOccupancyMaxActiveBlocksPerMultiprocessor(&per_cu, k_mega, NTHREADS, LDS_BYTES);
    if (per_cu > 2) per_cu = 2;
#else
    per_cu = 2;
#endif
    if (per_cu < 1) per_cu = 1;
    grid = cus * per_cu;
  }
  hipMemsetAsync(p.mod, 0, (size_t)NSEQ * 8192 * 4, stream);
#if MEGA
  hipMemsetAsync(p.bar, 0, XB_WORDS * 4, stream);
  void* args[] = {&p};
  hipError_t e = hipLaunchCooperativeKernel((void*)k_mega, dim3(grid), dim3(NTHREADS), args, LDS_BYTES, stream);
  if (e != hipSuccess) fprintf(stderr, "cooperative launch failed: %s (grid %d)\n", hipGetErrorString(e), grid);
#else
  launch_phase<0>(p, grid, stream);
  launch_phase<1>(p, grid, stream);
  launch_phase<2>(p, grid, stream);
  launch_phase<3>(p, grid, stream);
  launch_phase<11>(p, grid, stream);
  launch_phase<4>(p, grid, stream);
  launch_phase<5>(p, grid, stream);
  launch_phase<6>(p, grid, stream);
  launch_phase<7>(p, grid, stream);
  launch_phase<8>(p, grid, stream);
  launch_phase<9>(p, grid, stream);
  launch_phase<10>(p, grid, stream);
#endif
}
```

```cpp
#include <hip/hip_runtime.h>
#include <hip/hip_cooperative_groups.h>
#include <cstdio>
namespace cg = cooperative_groups;

#ifndef MEGA
#define MEGA 1
#endif

typedef unsigned short u16;
typedef __attribute__((ext_vector_type(8))) short bf16x8;
typedef __attribute__((ext_vector_type(4))) float f32x4;

__device__ __forceinline__ int opaque_tid() { int t = threadIdx.x; asm volatile("" : "+v"(t)); return t; }
#define TIDX opaque_tid()

constexpr int D = 1024;
constexpr int NP = 16384, NS = 1024, NT = NP + NS, NSEQ = 136;
constexpr int NROWS = NT + 128;
constexpr int PCOLS = 4368;
constexpr int INCOLS = 6416;
constexpr int C_LW = 1536, C_LA = 1600, C_LG = 1664, C_Z = 1792, C_XBC = 2816, C_DT = 4352;
constexpr int G_A = 4368, G_B = 5392;
constexpr size_t O_Y = 0, O_PSHIFT = 17825792, O_PWKV = 17833984, O_PCONV = 18096128, O_PSSM = 18132992,
                 O_SSHIFT = 19181568, O_SWKV = 19312640, O_SCONV = 23506944, O_SSSM = 24096768;
constexpr int LDS_BYTES = 80 * 1024;
constexpr int NTHREADS = 256;

struct P {
  const float *x_prompt, *x_sample, *c_prompt, *c_sample, *state_shift, *state_wkv, *state_conv, *state_ssm;
  const float *w_ada, *b_ada, *norm1_g, *w_in, *rw_mu, *rw_w0, *rw_w2, *rw_a0, *rw_a2, *rw_g2, *rw_k_k, *rw_k_a,
      *rw_r_k, *rw_ln_w, *rw_ln_b;
  const float *conv_w, *conv_b, *dt_bias, *A_log, *D_skip, *ssm_norm_w, *w_pa, *w_pb, *w_out, *norm2_g, *peer_wq,
      *peer_keys, *peer_u, *peer_v, *final_g, *w_ada_f, *b_ada_f;
  float* out;
  u16 *w_inT, *w_paT, *w_pbT, *w_outT, *wqT, *keysb, *xn, *proj, *prep, *merged, *ub, *vb, *xc, *oa, *ob;
  u16 *w2T, *a2T, *g2T, *lora;
  float *mod, *dtb, *decb, *topv;
  int* topi;
  unsigned* bar;
};

__device__ __forceinline__ u16 f2bf(float f) {
  unsigned u = __float_as_uint(f);
  u += 0x7fffu + ((u >> 16) & 1u);
  return (u16)(u >> 16);
}
__device__ __forceinline__ float bf2f(u16 h) { return __uint_as_float(((unsigned)h) << 16); }
__device__ __forceinline__ unsigned pack2(float a, float b) { return (unsigned)f2bf(a) | ((unsigned)f2bf(b) << 16); }
__device__ __forceinline__ float bflo(unsigned u) { return __uint_as_float(u << 16); }
__device__ __forceinline__ float bfhi(unsigned u) { return __uint_as_float(u & 0xffff0000u); }
__device__ __forceinline__ float sigmoidf_(float x) { return 1.f / (1.f + __expf(-x)); }
__device__ __forceinline__ float siluf_(float x) { return x / (1.f + __expf(-x)); }
__device__ __forceinline__ float softplusf_(float x) { return x > 20.f ? x : log1pf(expf(x)); }

template <int CTRL>
__device__ __forceinline__ float dppf(float x) {
  return __int_as_float(__builtin_amdgcn_update_dpp(0, __float_as_int(x), CTRL, 0xf, 0xf, true));
}
__device__ __forceinline__ float allreduce16(float x) {
  x += dppf<0x128>(x);
  x += dppf<0x124>(x);
  x += dppf<0x122>(x);
  x += dppf<0x121>(x);
  return x;
}
__device__ __forceinline__ float allreduce8(float x) {
  x += dppf<0xB1>(x);
  x += dppf<0x4E>(x);
  x += dppf<0x141>(x);
  return x;
}
__device__ __forceinline__ float wave_sum(float x) {
#pragma unroll
  for (int o = 32; o >= 1; o >>= 1) x += __shfl_xor(x, o, 64);
  return x;
}
__device__ __forceinline__ float wave_max(float x) {
#pragma unroll
  for (int o = 32; o >= 1; o >>= 1) x = fmaxf(x, __shfl_xor(x, o, 64));
  return x;
}
__device__ __forceinline__ int wave_min_i(int x) {
#pragma unroll
  for (int o = 32; o >= 1; o >>= 1) x = min(x, __shfl_xor(x, o, 64));
  return x;
}

__device__ __forceinline__ const float* xrow(const P& p, int n) {
  return n < NP ? p.x_prompt + (size_t)n * D : p.x_sample + (size_t)(n - NP) * D;
}
__device__ __forceinline__ void tok2seq(int n, int& seq, int& t, int& T) {
  if (n < NP) { seq = n >> 11; t = n & 2047; T = 2048; }
  else { int m = n - NP; seq = 8 + (m >> 3); t = m & 7; T = 8; }
}
__device__ __forceinline__ float* seq_out(float* out, int seq, size_t op, size_t os, size_t per) {
  return seq < 8 ? out + op + (size_t)seq * per : out + os + (size_t)(seq - 8) * per;
}

constexpr int LROW = 144;
template <bool DEEP = true>
__device__ __forceinline__ void gemm_tile(const u16* __restrict__ A, int lda, int m0, const u16* __restrict__ Bt,
                                          int ldb, int n0, int K, f32x4 (&acc)[4][4], char* smem) {
  char* sA = smem;
  char* sB = smem + 128 * LROW;
  const int tid = TIDX, lane = tid & 63, wid = tid >> 6, wr = wid >> 1, wc = wid & 1, fr = lane & 15,
            fq = lane >> 4;
  uint4 ra0, ra1, ra2, ra3, rb0, rb1, rb2, rb3;
  uint4 sa0, sa1, sa2, sa3, sb0, sb1, sb2, sb3;
  const int nk = K / 64;
  const int lrow = tid >> 3, lch = tid & 7;
  const u16* gA = A + (size_t)(m0 + lrow) * lda + lch * 8;
  const u16* gB = Bt + (size_t)(n0 + lrow) * ldb + lch * 8;
#define GLOAD(x0, x1, x2, x3, y0, y1, y2, y3, kt)                   \
  {                                                                 \
    x0 = *(const uint4*)(gA + (kt) * 64);                           \
    x1 = *(const uint4*)(gA + (size_t)32 * lda + (kt) * 64);        \
    x2 = *(const uint4*)(gA + (size_t)64 * lda + (kt) * 64);        \
    x3 = *(const uint4*)(gA + (size_t)96 * lda + (kt) * 64);        \
    y0 = *(const uint4*)(gB + (kt) * 64);                           \
    y1 = *(const uint4*)(gB + (size_t)32 * ldb + (kt) * 64);        \
    y2 = *(const uint4*)(gB + (size_t)64 * ldb + (kt) * 64);        \
    y3 = *(const uint4*)(gB + (size_t)96 * ldb + (kt) * 64);        \
  }
#define LSTORE(x0, x1, x2, x3, y0, y1, y2, y3)                      \
  {                                                                 \
    char* wa = sA + lrow * LROW + lch * 16;                         \
    char* wb = sB + lrow * LROW + lch * 16;                         \
    *(uint4*)(wa) = x0; *(uint4*)(wa + 32 * LROW) = x1; *(uint4*)(wa + 64 * LROW) = x2; *(uint4*)(wa + 96 * LROW) = x3; \
    *(uint4*)(wb) = y0; *(uint4*)(wb + 32 * LROW) = y1; *(uint4*)(wb + 64 * LROW) = y2; *(uint4*)(wb + 96 * LROW) = y3; \
  }
#define COMPUTE_TILE()                                                                                                   \
  {                                                                                                                      \
    _Pragma("unroll") for (int s = 0; s < 2; s++) {                                                                      \
      bf16x8 af[4], bfr[4];                                                                                              \
      _Pragma("unroll") for (int m = 0; m < 4; m++) af[m] = *(const bf16x8*)(sA + (wr * 64 + m * 16 + fr) * LROW + s * 64 + fq * 16); \
      _Pragma("unroll") for (int n = 0; n < 4; n++) bfr[n] = *(const bf16x8*)(sB + (wc * 64 + n * 16 + fr) * LROW + s * 64 + fq * 16); \
      _Pragma("unroll") for (int m = 0; m < 4; m++)                                                                      \
        _Pragma("unroll") for (int n = 0; n < 4; n++) acc[m][n] = __builtin_amdgcn_mfma_f32_16x16x32_bf16(af[m], bfr[n], acc[m][n], 0, 0, 0); \
    }                                                                                                                    \
  }
  GLOAD(ra0, ra1, ra2, ra3, rb0, rb1, rb2, rb3, 0);
  if constexpr (DEEP) {
    GLOAD(sa0, sa1, sa2, sa3, sb0, sb1, sb2, sb3, 1);
#pragma unroll 1
    for (int kt = 0; kt < nk; kt += 2) {
      __syncthreads();
      LSTORE(ra0, ra1, ra2, ra3, rb0, rb1, rb2, rb3);
      __syncthreads();
      if (kt + 2 < nk) GLOAD(ra0, ra1, ra2, ra3, rb0, rb1, rb2, rb3, kt + 2);
      COMPUTE_TILE();
      __syncthreads();
      LSTORE(sa0, sa1, sa2, sa3, sb0, sb1, sb2, sb3);
      __syncthreads();
      if (kt + 3 < nk) GLOAD(sa0, sa1, sa2, sa3, sb0, sb1, sb2, sb3, kt + 3);
      COMPUTE_TILE();
    }
  } else {
#pragma unroll 1
    for (int kt = 0; kt < nk; kt++) {
      __syncthreads();
      LSTORE(ra0, ra1, ra2, ra3, rb0, rb1, rb2, rb3);
      __syncthreads();
      if (kt + 1 < nk) GLOAD(ra0, ra1, ra2, ra3, rb0, rb1, rb2, rb3, kt + 1);
      COMPUTE_TILE();
    }
  }
  __syncthreads();
}
#define GL_RAW_BARRIER() { asm volatile("s_waitcnt vmcnt(0)" ::: "memory"); asm volatile("s_waitcnt lgkmcnt(0)" ::: "memory"); __builtin_amdgcn_s_barrier(); }
__device__ __forceinline__ void gemm_tile_glds(const u16* __restrict__ A, int lda, int m0, const u16* __restrict__ Bt,
                                               int ldb, int n0, int K, f32x4 (&acc)[4][4], char* smem) {
  const int tid = TIDX, lane = tid & 63, wid = tid >> 6, wr = wid >> 1, wc = wid & 1, fr = lane & 15, fq = lane >> 4;
  const int nk = K / 64;
  const int srow = tid >> 3, sc = (tid & 7) ^ ((srow >> 1) & 7);
  const u16* gA = A + (size_t)(m0 + srow) * lda + sc * 8;
  const u16* gB = Bt + (size_t)(n0 + srow) * ldb + sc * 8;
  char* const lbase = smem + tid * 16;
  const int swz = (fr >> 1) & 7;
  const int aoff = (wr * 64 + fr) * 128, boff = 16384 + (wc * 64 + fr) * 128;
#define GL_STAGE(buf, kt)                                                                                         \
  {                                                                                                               \
    _Pragma("unroll") for (int i = 0; i < 4; i++) {                                                               \
      __builtin_amdgcn_global_load_lds((const unsigned*)(gA + (size_t)(32 * i) * lda + (kt) * 64),               \
                                       (unsigned*)(lbase + (buf) * 32768 + i * 4096), 16, 0, 0);                  \
      __builtin_amdgcn_global_load_lds((const unsigned*)(gB + (size_t)(32 * i) * ldb + (kt) * 64),               \
                                       (unsigned*)(lbase + (buf) * 32768 + 16384 + i * 4096), 16, 0, 0);          \
    }                                                                                                             \
  }
#define GL_COMPUTE(buf)                                                                                           \
  {                                                                                                               \
    const char* pb = smem + (buf) * 32768;                                                                        \
    _Pragma("unroll") for (int s = 0; s < 2; s++) {                                                               \
      bf16x8 af[4], bfr[4];                                                                                       \
      const int so = ((s * 4 + fq) ^ swz) * 16;                                                                   \
      _Pragma("unroll") for (int m = 0; m < 4; m++) af[m] = *(const bf16x8*)(pb + aoff + m * 2048 + so);          \
      _Pragma("unroll") for (int n = 0; n < 4; n++) bfr[n] = *(const bf16x8*)(pb + boff + n * 2048 + so);         \
      _Pragma("unroll") for (int m = 0; m < 4; m++)                                                               \
        _Pragma("unroll") for (int n = 0; n < 4; n++)                                                             \
          acc[m][n] = __builtin_amdgcn_mfma_f32_16x16x32_bf16(af[m], bfr[n], acc[m][n], 0, 0, 0);                 \
    }                                                                                                             \
  }
  __syncthreads();
  GL_STAGE(0, 0)
  GL_RAW_BARRIER()
#pragma unroll 1
  for (int kt = 0; kt < nk; kt += 2) {
    if (kt + 1 < nk) GL_STAGE(1, kt + 1)
    GL_COMPUTE(0)
    GL_RAW_BARRIER()
    if (kt + 1 < nk) {
      if (kt + 2 < nk) GL_STAGE(0, kt + 2)
      GL_COMPUTE(1)
      GL_RAW_BARRIER()
    }
  }
}
__device__ __forceinline__ void zero_acc(f32x4 (&acc)[4][4]) {
#pragma unroll
  for (int m = 0; m < 4; m++)
#pragma unroll
    for (int n = 0; n < 4; n++) acc[m][n] = f32x4{0.f, 0.f, 0.f, 0.f};
}
#define ACC_FOREACH(...)                                                                    \
  {                                                                                         \
    const int _l = TIDX & 63, _w = TIDX >> 6, _wr = _w >> 1, _wc = _w & 1;    \
    const int _fr = _l & 15, _fq = _l >> 4;                                                 \
    _Pragma("unroll") for (int m = 0; m < 4; m++) _Pragma("unroll") for (int n = 0; n < 4; n++) \
        _Pragma("unroll") for (int j = 0; j < 4; j++) {                                     \
      const int row = _wr * 64 + m * 16 + _fq * 4 + j, col = _wc * 64 + n * 16 + _fr;       \
      __VA_ARGS__                                                                           \
    }                                                                                       \
  }

struct TileIter {
  int x, lb, nbx, tpx, total, MT, NT, r;
  __device__ __forceinline__ TileIter(int bid, int nb, int MT_, int NT_) : MT(MT_), NT(NT_), r(0) {
    total = MT * NT; x = bid & 7; lb = bid >> 3; nbx = nb >> 3; tpx = (total + 7) >> 3;
  }
  __device__ __forceinline__ bool next(int& mt, int& nt) {
    const int idx = lb + r * nbx;
    r++;
    if (idx >= tpx) return false;
    const int lin = x * tpx + idx;
    if (lin >= total) return false;
    const int bsz = 8 * NT, band = lin / bsz, rem = lin - band * bsz;
    const int mb = min(8, MT - band * 8);
    nt = rem / mb; mt = band * 8 + (rem - nt * mb);
    return true;
  }
};

__device__ __forceinline__ void tile_out_bf16(const char* smem, u16* __restrict__ C, size_t ldc, int m0, int n0, int ncols_valid) {
  __syncthreads();
  const int tid = TIDX;
#pragma unroll
  for (int i = 0; i < 8; i++) {
    const int id = tid + i * 256, row = id >> 4, ch = id & 15;
    if (ch * 8 < ncols_valid) *(uint4*)(C + (size_t)(m0 + row) * ldc + n0 + ch * 8) = *(const uint4*)(smem + row * 272 + ch * 16);
  }
}

__device__ void transpose_tile(const float* __restrict__ src, int K, int N, u16* __restrict__ dst, int tile,
                               char* smem) {
  const int ntn = (N + 63) / 64, kt = tile / ntn, nt = tile % ntn, tid = TIDX;
  float(*s)[65] = (float(*)[65])smem;
  __syncthreads();
#pragma unroll 4
  for (int i = 0; i < 16; i++) {
    int r = (tid >> 6) + 4 * i, n = nt * 64 + (tid & 63);
    s[r][tid & 63] = (n < N) ? src[(size_t)(kt * 64 + r) * N + n] : 0.f;
  }
  __syncthreads();
#pragma unroll 4
  for (int i = 0; i < 8; i++) {
    int nl = (tid >> 5) + 8 * i, n = nt * 64 + nl, kl = (tid & 31) * 2;
    if (n < N) *(unsigned*)(dst + (size_t)n * K + kt * 64 + kl) = pack2(s[kl][nl], s[kl + 1][nl]);
  }
}

__device__ void mod_item(const P& p, int item2, char* smem) {
  const int item = item2 >> 1, kh2 = item2 & 1;
  const int tid = TIDX, j = tid & 31, g = tid >> 5;
  const int col0 = item * 32;
  const float* W; const float* bias; int N, cw;
  if (col0 < 6144) { W = p.w_ada; bias = p.b_ada; N = 6144; cw = col0; }
  else { W = p.w_ada_f; bias = p.b_ada_f; N = 2048; cw = col0 - 6144; }
  float(*cs)[68] = (float(*)[68])smem;
  float acc[17];
#pragma unroll
  for (int s = 0; s < 17; s++) acc[s] = 0.f;
  for (int k0 = kh2 * 512; k0 < kh2 * 512 + 512; k0 += 64) {
    __syncthreads();
    {
      float cv[34];
#pragma unroll
      for (int i = 0; i < 34; i++) {
        const int idx = tid + i * 256, seq = idx >> 6, kk = idx & 63;
        cv[i] = seq < 8 ? p.c_prompt[seq * 1024 + k0 + kk] : p.c_sample[(seq - 8) * 1024 + k0 + kk];
      }
#pragma unroll
      for (int i = 0; i < 34; i++) {
        const int idx = tid + i * 256;
        cs[idx >> 6][idx & 63] = siluf_(cv[i]);
      }
    }
    __syncthreads();
#pragma unroll 1
    for (int kh = 0; kh < 2; kh++) {
      float wv[32];
#pragma unroll
      for (int k = 0; k < 32; k++) wv[k] = W[(size_t)(k0 + kh * 32 + k) * N + cw + j];
#pragma unroll 2
      for (int k4 = 0; k4 < 8; k4++) {
#pragma unroll
        for (int s = 0; s < 17; s++) {
          float4 c4 = *(const float4*)&cs[g * 17 + s][kh * 32 + k4 * 4];
          acc[s] += wv[k4 * 4] * c4.x + wv[k4 * 4 + 1] * c4.y + wv[k4 * 4 + 2] * c4.z + wv[k4 * 4 + 3] * c4.w;
        }
      }
    }
  }
  const float b = kh2 == 0 ? bias[cw + j] : 0.f;
#pragma unroll
  for (int s = 0; s < 17; s++) atomicAdd(&p.mod[(size_t)(g * 17 + s) * 8192 + col0 + j], acc[s] + b);
}

constexpr int J_MOD = 512, J_WIN = 16 * 101, J_WPA = 8 * 16, J_WPB = 256, J_WOUT = 256, J_WQ = 16 * 32, J_KEYS = 128,
              J_SHIFT = 64;
constexpr int J_LORA = 8 + 8 + 16;
constexpr int PH0_ITEMS = J_MOD + J_WIN + J_WPA + J_WPB + J_WOUT + J_WQ + J_LORA + J_KEYS + J_SHIFT;

__device__ void phase0(const P& p, int bid, int nb, char* smem) {
  for (int it = bid; it < PH0_ITEMS; it += nb) {
    int i = it;
    if (i < J_MOD) { mod_item(p, i, smem); continue; }
    i -= J_MOD;
    if (i < J_WIN) { transpose_tile(p.w_in, 1024, INCOLS, p.w_inT, i, smem); continue; }
    i -= J_WIN;
    if (i < J_WPA) { transpose_tile(p.w_pa, 512, 1024, p.w_paT, i, smem); continue; }
    i -= J_WPA;
    if (i < J_WPB) { transpose_tile(p.w_pb, 1024, 1024, p.w_pbT, i, smem); continue; }
    i -= J_WPB;
    if (i < J_WOUT) { transpose_tile(p.w_out, 1024, 1024, p.w_outT, i, smem); continue; }
    i -= J_WOUT;
    if (i < J_WQ) { transpose_tile(p.peer_wq, 1024, 2048, p.wqT, i, smem); continue; }
    i -= J_WQ;
    if (i < 8) { transpose_tile(p.rw_w2, 64, 512, p.w2T, i, smem); continue; }
    if (i < 16) { transpose_tile(p.rw_a2, 64, 512, p.a2T, i - 8, smem); continue; }
    if (i < 32) { transpose_tile(p.rw_g2, 128, 512, p.g2T, i - 16, smem); continue; }
    i -= J_LORA;
    const float* src; u16* dst;
    if (i < J_KEYS) { src = p.peer_keys + (size_t)i * 2048; dst = p.keysb + (size_t)i * 2048; }
    else { i -= J_KEYS; src = p.state_shift + (size_t)i * 2048; dst = p.xn + (size_t)NT * D + (size_t)i * 2048; }
    const float4* s4 = (const float4*)src + TIDX * 2;
    float4 a = s4[0], b = s4[1];
    uint4 o; o.x = pack2(a.x, a.y); o.y = pack2(a.z, a.w); o.z = pack2(b.x, b.y); o.w = pack2(b.z, b.w);
    *((uint4*)dst + TIDX) = o;
  }
}

template <bool SECOND>
__device__ void phase_norm(const P& p, int bid, int nb) {
  const int lane = TIDX & 63, wid = TIDX >> 6;
  const float* gam = SECOND ? p.norm2_g : p.norm1_g;
  for (int it = bid; it < NT / 8; it += nb) {
    const int nA = it * 8 + wid * 2;
    float4 v[2][4];
#pragma unroll
    for (int k = 0; k < 2; k++) {
      const int n = nA + k;
      const float* xr = SECOND ? p.out + O_Y + (size_t)n * D : xrow(p, n);
#pragma unroll
      for (int i = 0; i < 4; i++) v[k][i] = ((const float4*)xr)[lane + 64 * i];
    }
#pragma unroll
    for (int k = 0; k < 2; k++) {
      const int n = nA + k;
      int seq, t, T; tok2seq(n, seq, t, T);
      const float* md = p.mod + (size_t)seq * 8192 + (SECOND ? 3072 : 0);
      float ss = 0.f;
#pragma unroll
      for (int i = 0; i < 4; i++)
        ss += v[k][i].x * v[k][i].x + v[k][i].y * v[k][i].y + v[k][i].z * v[k][i].z + v[k][i].w * v[k][i].w;
      ss = wave_sum(ss);
      const float rstd = rsqrtf(ss * (1.f / 1024.f) + 1e-6f);
      const bool last = (!SECOND) && (t == T - 1);
      float* so = seq_out(p.out, seq, O_PSHIFT, O_SSHIFT, 1024);
#pragma unroll
      for (int i = 0; i < 4; i++) {
        const int c = (lane + 64 * i) * 4;
        const float4 g = *(const float4*)(gam + c), sh = *(const float4*)(md + c), sc = *(const float4*)(md + 1024 + c);
        float4 o;
        o.x = v[k][i].x * rstd * g.x * (1.f + sc.x) + sh.x;
        o.y = v[k][i].y * rstd * g.y * (1.f + sc.y) + sh.y;
        o.z = v[k][i].z * rstd * g.z * (1.f + sc.z) + sh.z;
        o.w = v[k][i].w * rstd * g.w * (1.f + sc.w) + sh.w;
        uint2 pk; pk.x = pack2(o.x, o.y); pk.y = pack2(o.z, o.w);
        *(uint2*)(p.xn + (size_t)n * D + c) = pk;
        if (last) *(float4*)(so + c) = o;
      }
    }
  }
}

constexpr int P2_NT = 35, P2_MT = 137;
__device__ void phase2(const P& p, int bid, int nb, char* smem) {
  TileIter ti(bid, nb, P2_MT, P2_NT);
  int mt, nt;
  while (ti.next(mt, nt)) {
    f32x4 acc[4][4];
    zero_acc(acc);
    gemm_tile_glds(p.xn, D, mt * 128, p.w_inT, D, nt * 128, D, acc, smem);
    u16* Lt = (u16*)smem;
    ACC_FOREACH({ Lt[row * 136 + col] = f2bf(acc[m][n][j]); })
    tile_out_bf16(smem, p.proj, PCOLS, mt * 128, nt * 128, PCOLS - nt * 128);
  }
}

__device__ void rwkv_lerp_item(const P& p, int item) {
  const int tid = TIDX;
  const int n0 = item * 8;
  int seq, t0, T; tok2seq(n0, seq, t0, T);
  uint4 pcv[7], ppv[7];
#pragma unroll
  for (int i = 0; i < 7; i++) {
    const int idx = tid + i * 256, tok = idx / 224, c = (idx % 224) * 8;
    const int n = n0 + tok, t = t0 + tok;
    pcv[i] = *(const uint4*)(p.proj + (size_t)n * PCOLS + c);
    const size_t prow = t > 0 ? (size_t)(n - 1) : (size_t)(NT + (seq >= 8 ? seq - 8 : 0));
    ppv[i] = *(const uint4*)(p.proj + prow * PCOLS + c);
    if (t == 0 && seq < 8) ppv[i] = make_uint4(0, 0, 0, 0);
  }
#pragma unroll
  for (int i = 0; i < 7; i++) {
    const int idx = tid + i * 256, tok = idx / 224, c = (idx % 224) * 8;
    const int n = n0 + tok;
    const float4 mu0 = *(const float4*)(p.rw_mu + c), mu1 = *(const float4*)(p.rw_mu + c + 4);
    const float mus[8] = {mu0.x, mu0.y, mu0.z, mu0.w, mu1.x, mu1.y, mu1.z, mu1.w};
    const unsigned pcs[4] = {pcv[i].x, pcv[i].y, pcv[i].z, pcv[i].w}, pps[4] = {ppv[i].x, ppv[i].y, ppv[i].z, ppv[i].w};
    unsigned o[4];
#pragma unroll
    for (int e = 0; e < 4; e++) {
      float a0 = bflo(pcs[e]), a1 = bfhi(pcs[e]), b0 = bflo(pps[e]), b1 = bfhi(pps[e]);
      float q0 = a0 + (b0 - a0) * mus[2 * e], q1 = a1 + (b1 - a1) * mus[2 * e + 1];
      if (c >= C_LW && c < C_LA) { q0 = tanhf(q0); q1 = tanhf(q1); }
      else if (c >= C_LG) { q0 = sigmoidf_(q0); q1 = sigmoidf_(q1); }
      o[e] = pack2(q0, q1);
    }
    u16* dst;
    if (c < 512) dst = p.prep + (size_t)n * 3584 + 512 + c;
    else if (c < 1024) dst = p.prep + (size_t)n * 3584 + 1024 + (c - 512);
    else if (c < 1536) dst = p.prep + (size_t)n * 3584 + 2560 + (c - 1024);
    else dst = p.lora + (size_t)n * 256 + (c - 1536);
    *(uint4*)dst = make_uint4(o[0], o[1], o[2], o[3]);
  }
}

__device__ void rwkv_lora_item(const P& p, int mt, int nt, int part, char* smem) {
  const int tid = TIDX, lane = tid & 63, wid = tid >> 6, wr = wid >> 1, wc = wid & 1, fr = lane & 15, fq = lane >> 4;
  const int col0 = nt * 128;
  f32x4 acc[4][4];
  if (part == 0) {
  zero_acc(acc);
  gemm_tile_glds(p.lora, 256, mt * 128, p.w2T, 64, col0, 64, acc, smem);
  ACC_FOREACH({
    const int gc = col0 + col;
    const float wpre = p.rw_w0[gc] + acc[m][n][j];
    const float w = -softplusf_(-wpre) - 0.5f;
    p.prep[(size_t)(mt * 128 + row) * 3584 + gc] = f2bf(-expf(w));
  })
  return;
  }
  if (part == 1) {
  zero_acc(acc);
  gemm_tile_glds(p.lora + 128, 256, mt * 128, p.g2T, 128, col0, 128, acc, smem);
  ACC_FOREACH({ p.prep[(size_t)(mt * 128 + row) * 3584 + 3072 + col0 + col] = f2bf(acc[m][n][j]); })
  return;
  }
  zero_acc(acc);
  gemm_tile_glds(p.lora + 64, 256, mt * 128, p.a2T, 64, col0, 64, acc, smem);
  float a0c[4], kkc[4], kac[4];
#pragma unroll
  for (int n = 0; n < 4; n++) {
    const int gc = col0 + wc * 64 + n * 16 + fr;
    a0c[n] = p.rw_a0[gc]; kkc[n] = p.rw_k_k[gc]; kac[n] = p.rw_k_a[gc];
  }
#pragma unroll
  for (int m = 0; m < 4; m++)
#pragma unroll
    for (int j = 0; j < 4; j++) {
      const int row = mt * 128 + wr * 64 + m * 16 + fq * 4 + j;
      u16* pr = p.prep + (size_t)row * 3584 + col0 + wc * 64 + fr;
      float kx[4], kkv[4], av[4];
      float ss = 0.f;
#pragma unroll
      for (int n = 0; n < 4; n++) {
        kx[n] = bf2f(pr[1024 + n * 16]);
        av[n] = sigmoidf_(a0c[n] + acc[m][n][j]);
        kkv[n] = kx[n] * kkc[n];
        ss += kkv[n] * kkv[n];
      }
      ss = allreduce16(ss);
      const float inv = 1.f / fmaxf(sqrtf(ss), 1e-12f);
#pragma unroll
      for (int n = 0; n < 4; n++) {
        const float kk = kkv[n] * inv;
        pr[1024 + n * 16] = f2bf(kx[n] * (1.f + (av[n] - 1.f) * kac[n]));
        pr[1536 + n * 16] = f2bf(kk);
        pr[2048 + n * 16] = f2bf(kk * av[n]);
      }
    }
}

__device__ void conv_prep_item(const P& p, int item) {
  const int tid = TIDX;
  const int n0 = item * 8;
  int seq, t0, T; tok2seq(n0, seq, t0, T);
  if (tid < 192) {
    const int c = tid * 8;
    uint4 rows[11];
#pragma unroll
    for (int j = 0; j < 11; j++) {
      const int tt = t0 - 3 + j;
      rows[j] = make_uint4(0, 0, 0, 0);
      if (tt >= 0) rows[j] = *(const uint4*)(p.proj + (size_t)(n0 - 3 + j) * PCOLS + C_XBC + c);
      else if (seq >= 8) {
        const float* sc = p.state_conv + ((size_t)(seq - 8) * 3 + (tt + 3)) * 1536 + c;
        const float4 a = *(const float4*)sc, b = *(const float4*)(sc + 4);
        rows[j] = make_uint4(pack2(a.x, a.y), pack2(a.z, a.w), pack2(b.x, b.y), pack2(b.z, b.w));
      }
    }
    float w[4][8], cb[8];
#pragma unroll
    for (int j = 0; j < 4; j++) {
      const float4 a = *(const float4*)(p.conv_w + j * 1536 + c), b = *(const float4*)(p.conv_w + j * 1536 + c + 4);
      w[j][0] = a.x; w[j][1] = a.y; w[j][2] = a.z; w[j][3] = a.w; w[j][4] = b.x; w[j][5] = b.y; w[j][6] = b.z; w[j][7] = b.w;
    }
    {
      const float4 a = *(const float4*)(p.conv_b + c), b = *(const float4*)(p.conv_b + c + 4);
      cb[0] = a.x; cb[1] = a.y; cb[2] = a.z; cb[3] = a.w; cb[4] = b.x; cb[5] = b.y; cb[6] = b.z; cb[7] = b.w;
    }
#pragma unroll
    for (int k = 0; k < 8; k++) {
      float o[8];
#pragma unroll
      for (int e = 0; e < 8; e++) o[e] = cb[e];
#pragma unroll
      for (int j = 0; j < 4; j++) {
        const uint4 r = rows[k + j];
        const unsigned rs[4] = {r.x, r.y, r.z, r.w};
#pragma unroll
        for (int e = 0; e < 4; e++) { o[2 * e] += bflo(rs[e]) * w[j][2 * e]; o[2 * e + 1] += bfhi(rs[e]) * w[j][2 * e + 1]; }
      }
      *(uint4*)(p.xc + (size_t)(n0 + k) * 1536 + c) =
          make_uint4(pack2(siluf_(o[0]), siluf_(o[1])), pack2(siluf_(o[2]), siluf_(o[3])), pack2(siluf_(o[4]), siluf_(o[5])),
                     pack2(siluf_(o[6]), siluf_(o[7])));
    }
    if (t0 + 8 == T) {
      float* co = seq_out(p.out, seq, O_PCONV, O_SCONV, 3 * 1536);
#pragma unroll
      for (int j = 0; j < 3; j++) {
        const uint4 r = rows[8 + j];
        *(float4*)(co + j * 1536 + c) = make_float4(bflo(r.x), bfhi(r.x), bflo(r.y), bfhi(r.y));
        *(float4*)(co + j * 1536 + c + 4) = make_float4(bflo(r.z), bfhi(r.z), bflo(r.w), bfhi(r.w));
      }
    }
  } else if (tid < 192 + 32) {
    const int i = tid - 192;
#pragma unroll
    for (int e = 0; e < 4; e++) {
      const int pi = i * 4 + e, k = pi >> 4, h = pi & 15, n = n0 + k;
      const float raw = bf2f(p.proj[(size_t)n * PCOLS + C_DT + h]) + p.dt_bias[h];
      const float dt = softplusf_(raw);
      const float dA = -dt * expf(p.A_log[h]);
      p.dtb[n * 16 + h] = dt;
      p.decb[n * 16 + h] = dA;
    }
  }
}

__device__ void phase3(const P& p, int bid, int nb, char* smem) {
  for (int it = bid; it < 2 * (NT / 8); it += nb) {
    if (it < NT / 8) rwkv_lerp_item(p, it);
    else conv_prep_item(p, it - NT / 8);
  }
}
__device__ void phase3b(const P& p, int bid, int nb, char* smem) {
  for (int it = bid; it < 136 * 4 * 3; it += nb) { const int tl = it / 3; rwkv_lora_item(p, tl >> 2, tl & 3, it - tl * 3, smem); }
}

constexpr int TC = 32;
__device__ __forceinline__ void bf8_to_f(uint4 u, float4& lo, float4& hi) {
  lo = make_float4(bflo(u.x), bfhi(u.x), bflo(u.y), bfhi(u.y));
  hi = make_float4(bflo(u.z), bfhi(u.z), bflo(u.w), bfhi(u.w));
}
__device__ void rwkv_scan_item(const P& p, int seq, int h, int qr, char* smem) {
  const int T = seq < 8 ? 2048 : 8, nbase = seq < 8 ? seq * 2048 : NP + (seq - 8) * 8;
  float* Ld = (float*)smem;
  float* Lr = Ld + TC * 64; float* Lk = Lr + TC * 64; float* Lkk = Lk + TC * 64; float* Lb = Lkk + TC * 64;
  float* Lv = Lb + TC * 64;
  const int tid = TIDX, w = tid >> 6, lane = tid & 63, rl = w * 4 + (lane >> 4), ks = lane & 15;
  const int v = qr * 16 + rl;
  float S0 = 0.f, S1 = 0.f, S2 = 0.f, S3 = 0.f;
  if (seq >= 8) {
    float4 s = *(const float4*)(p.state_wkv + (((size_t)(seq - 8) * 8 + h) * 64 + v) * 64 + ks * 4);
    S0 = s.x; S1 = s.y; S2 = s.z; S3 = s.w;
  }
  const int st = tid >> 3, sk8 = (tid & 7) * 8;
  const int vt = tid >> 1, vr8 = (tid & 1) * 8;
  uint4 g0, g1, g2, g3, g4, gv;
  g0 = g1 = g2 = g3 = g4 = gv = make_uint4(0, 0, 0, 0);
#define RW_GLOAD(c0_)                                                                           \
  {                                                                                             \
    const int tcn = min(TC, T - (c0_));                                                         \
    if (st < tcn) {                                                                             \
      const u16* base = p.prep + (size_t)(nbase + (c0_) + st) * 3584 + h * 64 + sk8;            \
      g0 = *(const uint4*)(base); g1 = *(const uint4*)(base + 512); g2 = *(const uint4*)(base + 1024); \
      g3 = *(const uint4*)(base + 1536); g4 = *(const uint4*)(base + 2048);                     \
    }                                                                                           \
    if (tid < 64 && vt < tcn)                                                                   \
      gv = *(const uint4*)(p.prep + (size_t)(nbase + (c0_) + vt) * 3584 + 2560 + h * 64 + qr * 16 + vr8); \
  }
  RW_GLOAD(0);
  for (int c0 = 0; c0 < T; c0 += TC) {
    const int tc = min(TC, T - c0);
    __syncthreads();
    {
      float4 lo, hi;
      bf8_to_f(g0, lo, hi);
      lo.x = __expf(lo.x); lo.y = __expf(lo.y); lo.z = __expf(lo.z); lo.w = __expf(lo.w);
      hi.x = __expf(hi.x); hi.y = __expf(hi.y); hi.z = __expf(hi.z); hi.w = __expf(hi.w);
      *(float4*)(Ld + st * 64 + sk8) = lo; *(float4*)(Ld + st * 64 + sk8 + 4) = hi;
      bf8_to_f(g1, lo, hi); *(float4*)(Lr + st * 64 + sk8) = lo; *(float4*)(Lr + st * 64 + sk8 + 4) = hi;
      bf8_to_f(g2, lo, hi); *(float4*)(Lk + st * 64 + sk8) = lo; *(float4*)(Lk + st * 64 + sk8 + 4) = hi;
      bf8_to_f(g3, lo, hi); *(float4*)(Lkk + st * 64 + sk8) = lo; *(float4*)(Lkk + st * 64 + sk8 + 4) = hi;
      bf8_to_f(g4, lo, hi); *(float4*)(Lb + st * 64 + sk8) = lo; *(float4*)(Lb + st * 64 + sk8 + 4) = hi;
      if (tid < 64) { bf8_to_f(gv, lo, hi); *(float4*)(Lv + vt * 16 + vr8) = lo; *(float4*)(Lv + vt * 16 + vr8 + 4) = hi; }
    }
    __syncthreads();
    if (c0 + TC < T) RW_GLOAD(c0 + TC);
    u16* yo = p.proj + (size_t)(nbase + c0) * PCOLS + h * 64 + v;
    float4 kk0, d0, b0, k0_, r0, kk1, d1, b1, k1_, r1, kk2, d2, b2, k2_, r2, kk3, d3, b3, k3_, r3;
    float v0, v1, v2, v3;
#define RW_LD(KK, DD, BB, KX, RR, VV, t_)                                                        \
  {                                                                                              \
    KK = *(const float4*)(Lkk + (t_) * 64 + ks * 4); DD = *(const float4*)(Ld + (t_) * 64 + ks * 4); \
    BB = *(const float4*)(Lb + (t_) * 64 + ks * 4); KX = *(const float4*)(Lk + (t_) * 64 + ks * 4);  \
    RR = *(const float4*)(Lr + (t_) * 64 + ks * 4); VV = Lv[(t_) * 16 + rl];                      \
  }
#define RW_STEP(KK, DD, BB, KX, RR, VV, YY)                                                      \
  {                                                                                              \
    const float vk0 = VV * KX.x, vk1 = VV * KX.y, vk2 = VV * KX.z, vk3 = VV * KX.w;              \
    float sk = (S0 * KK.x + S1 * KK.y) + (S2 * KK.z + S3 * KK.w);                                \
    sk = allreduce16(sk);                                                                        \
    S0 = S0 * DD.x + (vk0 - sk * BB.x);                                                          \
    S1 = S1 * DD.y + (vk1 - sk * BB.y);                                                          \
    S2 = S2 * DD.z + (vk2 - sk * BB.z);                                                          \
    S3 = S3 * DD.w + (vk3 - sk * BB.w);                                                          \
    YY = allreduce16((S0 * RR.x + S1 * RR.y) + (S2 * RR.z + S3 * RR.w));                         \
  }
    for (int tt = 0; tt < tc; tt += 4) {
      RW_LD(kk0, d0, b0, k0_, r0, v0, tt)
      RW_LD(kk1, d1, b1, k1_, r1, v1, tt + 1)
      RW_LD(kk2, d2, b2, k2_, r2, v2, tt + 2)
      RW_LD(kk3, d3, b3, k3_, r3, v3, tt + 3)
      float y0, y1, y2, y3;
      RW_STEP(kk0, d0, b0, k0_, r0, v0, y0)
      RW_STEP(kk1, d1, b1, k1_, r1, v1, y1)
      RW_STEP(kk2, d2, b2, k2_, r2, v2, y2)
      RW_STEP(kk3, d3, b3, k3_, r3, v3, y3)
      if (ks == 0) {
        u16* yp = yo + (size_t)tt * PCOLS;
        yp[0] = f2bf(y0); yp[PCOLS] = f2bf(y1); yp[2 * (size_t)PCOLS] = f2bf(y2); yp[3 * (size_t)PCOLS] = f2bf(y3);
      }
    }
  }
  float* so = seq_out(p.out, seq, O_PWKV, O_SWKV, 8 * 4096);
  *(float4*)(so + ((size_t)h * 64 + v) * 64 + ks * 4) = make_float4(S0, S1, S2, S3);
}

__device__ void ssm_scan_item(const P& p, int seq, int head, int half, char* smem) {
  const int T = seq < 8 ? 2048 : 8, nbase = seq < 8 ? seq * 2048 : NP + (seq - 8) * 8;
  float* LB = (float*)smem;
  float* LC = LB + TC * 128;
  float* Lx = LC + TC * 128;
  float* Ldt = Lx + TC * 32;
  float* Ldec = Ldt + TC;
  const int tid = TIDX, pl = tid >> 3, ns = tid & 7;
  const int pp = half * 32 + pl, g = head >> 3;
  const float Dk = p.D_skip[head];
  float hs[16];
#pragma unroll
  for (int j = 0; j < 16; j++) hs[j] = 0.f;
  if (seq >= 8) {
    const float4* s4 = (const float4*)(p.state_ssm + (((size_t)(seq - 8) * 16 + head) * 64 + pp) * 128 + ns * 16);
#pragma unroll
    for (int j = 0; j < 4; j++) { float4 s = s4[j]; hs[4 * j] = s.x; hs[4 * j + 1] = s.y; hs[4 * j + 2] = s.z; hs[4 * j + 3] = s.w; }
  }
  uint4 gb0, gb1, gb2, gb3, gx; float gdt = 0.f, gdec = 0.f;
  gb0 = gb1 = gb2 = gb3 = gx = make_uint4(0, 0, 0, 0);
  const int bt = tid >> 5, bch = tid & 31;
  const u16* bsrc = p.xc + 1024 + (bch < 16 ? 0 : 256) + g * 128 + (bch & 15) * 8;
  const int xt = tid >> 2, xr8 = (tid & 3) * 8;
#define SS_GLOAD(c0_)                                                                          \
  {                                                                                            \
    const int tcn = min(TC, T - (c0_));                                                        \
    const size_t nb_ = (size_t)(nbase + (c0_));                                                \
    if (bt < tcn) gb0 = *(const uint4*)(bsrc + (nb_ + bt) * 1536);                             \
    if (bt + 8 < tcn) gb1 = *(const uint4*)(bsrc + (nb_ + bt + 8) * 1536);                     \
    if (bt + 16 < tcn) gb2 = *(const uint4*)(bsrc + (nb_ + bt + 16) * 1536);                   \
    if (bt + 24 < tcn) gb3 = *(const uint4*)(bsrc + (nb_ + bt + 24) * 1536);                   \
    if (tid < 128 && xt < tcn) gx = *(const uint4*)(p.xc + (nb_ + xt) * 1536 + head * 64 + half * 32 + xr8); \
    if (tid < tcn) { gdt = p.dtb[(nb_ + tid) * 16 + head]; gdec = p.decb[(nb_ + tid) * 16 + head]; } \
  }
  SS_GLOAD(0);
  for (int c0 = 0; c0 < T; c0 += TC) {
    const int tc = min(TC, T - c0);
    __syncthreads();
    {
      float* dstb = (bch < 16 ? LB : LC) + (bch & 15) * 8;
      float4 lo, hi;
      bf8_to_f(gb0, lo, hi); *(float4*)(dstb + bt * 128) = lo; *(float4*)(dstb + bt * 128 + 4) = hi;
      bf8_to_f(gb1, lo, hi); *(float4*)(dstb + (bt + 8) * 128) = lo; *(float4*)(dstb + (bt + 8) * 128 + 4) = hi;
      bf8_to_f(gb2, lo, hi); *(float4*)(dstb + (bt + 16) * 128) = lo; *(float4*)(dstb + (bt + 16) * 128 + 4) = hi;
      bf8_to_f(gb3, lo, hi); *(float4*)(dstb + (bt + 24) * 128) = lo; *(float4*)(dstb + (bt + 24) * 128 + 4) = hi;
      if (tid < 128) { bf8_to_f(gx, lo, hi); *(float4*)(Lx + xt * 32 + xr8) = lo; *(float4*)(Lx + xt * 32 + xr8 + 4) = hi; }
      if (tid < TC) { Ldt[tid] = gdt; Ldec[tid] = __expf(gdec); }
    }
    __syncthreads();
    if (c0 + TC < T) SS_GLOAD(c0 + TC);
    u16* yo = p.proj + (size_t)(nbase + c0) * PCOLS + C_XBC + head * 64 + pp;
    float4 B0 = *(const float4*)(LB + ns * 16), B1 = *(const float4*)(LB + ns * 16 + 4), B2 = *(const float4*)(LB + ns * 16 + 8),
           B3 = *(const float4*)(LB + ns * 16 + 12);
    float4 C0 = *(const float4*)(LC + ns * 16), C1 = *(const float4*)(LC + ns * 16 + 4), C2 = *(const float4*)(LC + ns * 16 + 8),
           C3 = *(const float4*)(LC + ns * 16 + 12);
    float xv = Lx[pl], dtv = Ldt[0], dec = Ldec[0];
    for (int tt = 0; tt < tc; tt++) {
      const int tn = min(tt + 1, tc - 1);
      const float* nB = LB + tn * 128 + ns * 16;
      const float* nC = LC + tn * 128 + ns * 16;
      const float4 nB0 = *(const float4*)(nB), nB1 = *(const float4*)(nB + 4), nB2 = *(const float4*)(nB + 8), nB3 = *(const float4*)(nB + 12);
      const float4 nC0 = *(const float4*)(nC), nC1 = *(const float4*)(nC + 4), nC2 = *(const float4*)(nC + 8), nC3 = *(const float4*)(nC + 12);
      const float nxv = Lx[tn * 32 + pl], ndt = Ldt[tn], ndec = Ldec[tn];
      const float dtx = dtv * xv;
      hs[0] = hs[0] * dec + dtx * B0.x; hs[1] = hs[1] * dec + dtx * B0.y; hs[2] = hs[2] * dec + dtx * B0.z; hs[3] = hs[3] * dec + dtx * B0.w;
      hs[4] = hs[4] * dec + dtx * B1.x; hs[5] = hs[5] * dec + dtx * B1.y; hs[6] = hs[6] * dec + dtx * B1.z; hs[7] = hs[7] * dec + dtx * B1.w;
      hs[8] = hs[8] * dec + dtx * B2.x; hs[9] = hs[9] * dec + dtx * B2.y; hs[10] = hs[10] * dec + dtx * B2.z; hs[11] = hs[11] * dec + dtx * B2.w;
      hs[12] = hs[12] * dec + dtx * B3.x; hs[13] = hs[13] * dec + dtx * B3.y; hs[14] = hs[14] * dec + dtx * B3.z; hs[15] = hs[15] * dec + dtx * B3.w;
      float y0 = hs[0] * C0.x + hs[1] * C0.y + hs[2] * C0.z + hs[3] * C0.w;
      float y1 = hs[4] * C1.x + hs[5] * C1.y + hs[6] * C1.z + hs[7] * C1.w;
      float y2 = hs[8] * C2.x + hs[9] * C2.y + hs[10] * C2.z + hs[11] * C2.w;
      float y3 = hs[12] * C3.x + hs[13] * C3.y + hs[14] * C3.z + hs[15] * C3.w;
      float yp = allreduce8((y0 + y1) + (y2 + y3));
      if (ns == 0) yo[(size_t)tt * PCOLS] = f2bf(yp + Dk * xv);
      B0 = nB0; B1 = nB1; B2 = nB2; B3 = nB3; C0 = nC0; C1 = nC1; C2 = nC2; C3 = nC3; xv = nxv; dtv = ndt; dec = ndec;
    }
  }
  float* so = seq_out(p.out, seq, O_PSSM, O_SSSM, 16 * 8192);
  float4* o4 = (float4*)(so + ((size_t)head * 64 + pp) * 128 + ns * 16);
#pragma unroll
  for (int j = 0; j < 4; j++) o4[j] = make_float4(hs[4 * j], hs[4 * j + 1], hs[4 * j + 2], hs[4 * j + 3]);
}

__device__ void ssd_prompt_item(const P& p, int seq, int head, char* smem) {
  const int nbase = seq * 2048, g = head >> 3;
  char* sC = smem;
  char* sB = smem + 17408;
  char* sBT = smem + 34816;
  char* sXT = smem + 53248;
  char* sH = smem + 62464;
  float* sS = (float*)(smem + 79872);
  const int tid = TIDX, lane = tid & 63, w = tid >> 6, fr = lane & 15, q = lane >> 4;
  const float Dk = p.D_skip[head];
  f32x4 H[8];
#pragma unroll
  for (int i = 0; i < 8; i++) H[i] = f32x4{0.f, 0.f, 0.f, 0.f};
  __syncthreads();
  for (int i = tid; i < 17408 / 16; i += 256) *(uint4*)(sH + i * 16) = make_uint4(0, 0, 0, 0);
  uint4 gB0, gB1, gB2, gB3, gC0, gC1, gC2, gC3, gX0, gX1;
  float gdt, gdA;
#define SSD_LOAD(t0_)                                                                         \
  {                                                                                           \
    const size_t nn_ = (size_t)(nbase + (t0_) + lane);                                        \
    const u16* row_ = p.xc + nn_ * 1536;                                                      \
    const u16* rb_ = row_ + 1024 + g * 128 + w * 32;                                          \
    gB0 = *(const uint4*)(rb_); gB1 = *(const uint4*)(rb_ + 8); gB2 = *(const uint4*)(rb_ + 16); gB3 = *(const uint4*)(rb_ + 24); \
    gC0 = *(const uint4*)(rb_ + 256); gC1 = *(const uint4*)(rb_ + 264); gC2 = *(const uint4*)(rb_ + 272); gC3 = *(const uint4*)(rb_ + 280); \
    gX0 = *(const uint4*)(row_ + head * 64 + w * 16); gX1 = *(const uint4*)(row_ + head * 64 + w * 16 + 8); \
    gdt = p.dtb[nn_ * 16 + head]; gdA = p.decb[nn_ * 16 + head];                              \
  }
#define SSD_PUT_T(dst_, r0_, u_, sc_)                                                         \
  {                                                                                           \
    const unsigned us_[4] = {u_.x, u_.y, u_.z, u_.w};                                         \
    _Pragma("unroll") for (int e = 0; e < 4; e++) {                                           \
      *(u16*)(dst_ + ((r0_) + 2 * e) * 144 + lane * 2) = f2bf(bflo(us_[e]) * (sc_));          \
      *(u16*)(dst_ + ((r0_) + 2 * e + 1) * 144 + lane * 2) = f2bf(bfhi(us_[e]) * (sc_));      \
    }                                                                                         \
  }
  SSD_LOAD(0);
#pragma unroll 1
  for (int c = 0; c < 32; c++) {
    const int t0 = c * 64;
    float cs = gdA;
#pragma unroll
    for (int o = 1; o < 64; o <<= 1) { const float v = __shfl_up(cs, o, 64); if (lane >= o) cs += v; }
    const float cs63 = __shfl(cs, 63, 64);
    const float wt = gdt * __expf(cs63 - cs);
    __syncthreads();
    if (w == 0) { sS[lane] = cs; sS[64 + lane] = __expf(cs); sS[128 + lane] = gdt; }
    {
      char* rc = sC + lane * 272 + w * 64;
      char* rb = sB + lane * 272 + w * 64;
      *(uint4*)(rc) = gC0; *(uint4*)(rc + 16) = gC1; *(uint4*)(rc + 32) = gC2; *(uint4*)(rc + 48) = gC3;
      *(uint4*)(rb) = gB0; *(uint4*)(rb + 16) = gB1; *(uint4*)(rb + 32) = gB2; *(uint4*)(rb + 48) = gB3;
      SSD_PUT_T(sBT, w * 32, gB0, wt) SSD_PUT_T(sBT, w * 32 + 8, gB1, wt) SSD_PUT_T(sBT, w * 32 + 16, gB2, wt)
      SSD_PUT_T(sBT, w * 32 + 24, gB3, wt) SSD_PUT_T(sXT, w * 16, gX0, 1.f) SSD_PUT_T(sXT, w * 16 + 8, gX1, 1.f)
    }
    __syncthreads();
    if (c + 1 < 32) SSD_LOAD(t0 + 64);
    f32x4 cb[4], yo[4];
#pragma unroll
    for (int i = 0; i < 4; i++) { cb[i] = f32x4{0.f, 0.f, 0.f, 0.f}; yo[i] = f32x4{0.f, 0.f, 0.f, 0.f}; }
    {
      bf16x8 af[4];
#pragma unroll
      for (int ks = 0; ks < 4; ks++) af[ks] = *(const bf16x8*)(sC + (16 * w + fr) * 272 + ks * 64 + q * 16);
#pragma unroll
      for (int nn = 0; nn < 4; nn++)
#pragma unroll
        for (int ks = 0; ks < 4; ks++) {
          const bf16x8 bb = *(const bf16x8*)(sB + (16 * nn + fr) * 272 + ks * 64 + q * 16);
          cb[nn] = __builtin_amdgcn_mfma_f32_16x16x32_bf16(af[ks], bb, cb[nn], 0, 0, 0);
        }
#pragma unroll
      for (int pt = 0; pt < 4; pt++)
#pragma unroll
        for (int ks = 0; ks < 4; ks++) {
          const bf16x8 bb = *(const bf16x8*)(sH + (16 * pt + fr) * 272 + ks * 64 + q * 16);
          yo[pt] = __builtin_amdgcn_mfma_f32_16x16x32_bf16(af[ks], bb, yo[pt], 0, 0, 0);
        }
    }
    __syncthreads();
#pragma unroll
    for (int j = 0; j < 4; j++) {
      const int l = 16 * w + q * 4 + j;
      const float csl = sS[l];
#pragma unroll
      for (int nn = 0; nn < 4; nn++) {
        const int sidx = 16 * nn + fr;
        const float gv = (sidx <= l) ? cb[nn][j] * __expf(csl - sS[sidx]) * sS[128 + sidx] : 0.f;
        *(u16*)(sB + l * 144 + sidx * 2) = f2bf(gv);
      }
    }
    f32x4 yd[4];
#pragma unroll
    for (int i = 0; i < 4; i++) yd[i] = f32x4{0.f, 0.f, 0.f, 0.f};
#pragma unroll
    for (int ks = 0; ks < 2; ks++) {
      const bf16x8 aa = *(const bf16x8*)(sB + (16 * w + fr) * 144 + ks * 64 + q * 16);
#pragma unroll
      for (int pt = 0; pt < 4; pt++) {
        const bf16x8 bb = *(const bf16x8*)(sXT + (16 * pt + fr) * 144 + ks * 64 + q * 16);
        yd[pt] = __builtin_amdgcn_mfma_f32_16x16x32_bf16(aa, bb, yd[pt], 0, 0, 0);
      }
    }
#pragma unroll
    for (int j = 0; j < 4; j++) {
      const int l = 16 * w + q * 4 + j;
      const float el = sS[64 + l];
      u16* yrow = p.proj + (size_t)(nbase + t0 + l) * PCOLS + C_XBC + head * 64 + fr;
#pragma unroll
      for (int pt = 0; pt < 4; pt++) {
        const float xs = bf2f(*(const u16*)(sXT + (16 * pt + fr) * 144 + l * 2));
        yrow[16 * pt] = f2bf(yd[pt][j] + el * yo[pt][j] + Dk * xs);
      }
    }
    const float ach = __expf(cs63);
#pragma unroll
    for (int nt = 0; nt < 8; nt++) { H[nt][0] *= ach; H[nt][1] *= ach; H[nt][2] *= ach; H[nt][3] *= ach; }
#pragma unroll
    for (int ks = 0; ks < 2; ks++) {
      const bf16x8 aa = *(const bf16x8*)(sXT + (16 * w + fr) * 144 + ks * 64 + q * 16);
#pragma unroll
      for (int nt = 0; nt < 8; nt++) {
        const bf16x8 bb = *(const bf16x8*)(sBT + (16 * nt + fr) * 144 + ks * 64 + q * 16);
        H[nt] = __builtin_amdgcn_mfma_f32_16x16x32_bf16(aa, bb, H[nt], 0, 0, 0);
      }
    }
#pragma unroll
    for (int nt = 0; nt < 8; nt++)
#pragma unroll
      for (int j = 0; j < 4; j++) *(u16*)(sH + (16 * w + q * 4 + j) * 272 + (16 * nt + fr) * 2) = f2bf(H[nt][j]);
  }
  float* so = p.out + O_PSSM + ((size_t)seq * 16 + head) * 8192;
#pragma unroll
  for (int nt = 0; nt < 8; nt++)
#pragma unroll
    for (int j = 0; j < 4; j++) so[(16 * w + q * 4 + j) * 128 + 16 * nt + fr] = H[nt][j];
  __syncthreads();
}

constexpr int P4_RP = 256, P4_SP = 128, P4_RS = 4096, P4_SS = 4096;
#define XB_QUEUE 3600
__device__ void phase4(const P& p, int bid, int nb, char* smem) {
  for (int it = bid; it < P4_RP + P4_SP; it += nb) {
    if (it < P4_RP) rwkv_scan_item(p, it >> 5, (it >> 2) & 7, it & 3, smem);
    else { const int i = it - P4_RP; ssd_prompt_item(p, i >> 4, i & 15, smem); }
  }
  volatile int* slot = (volatile int*)(smem + LDS_BYTES - 32);
  for (;;) {
    __syncthreads();
    if (TIDX == 0) *slot = (int)atomicAdd(&p.bar[XB_QUEUE], 1u);
    __syncthreads();
    int i = *slot;
    if (i >= P4_RS + P4_SS) break;
    if (i < P4_RS) rwkv_scan_item(p, 8 + (i >> 5), (i >> 2) & 7, i & 3, smem);
    else { i -= P4_RS; ssm_scan_item(p, 8 + (i >> 5), (i >> 1) & 15, i & 1, smem); }
  }
}

__device__ void phase5(const P& p, int bid, int nb) {
  const int lane = TIDX & 63, wid = TIDX >> 6;
  for (int it = bid; it < NT / 4; it += nb) {
    const int n = it * 4 + wid;
    const uint4 sy0 = *(const uint4*)(p.proj + (size_t)n * PCOLS + C_XBC + lane * 16);
    const uint4 sy1 = *(const uint4*)(p.proj + (size_t)n * PCOLS + C_XBC + lane * 16 + 8);
    const uint4 sz0 = *(const uint4*)(p.proj + (size_t)n * PCOLS + C_Z + lane * 16);
    const uint4 sz1 = *(const uint4*)(p.proj + (size_t)n * PCOLS + C_Z + lane * 16 + 8);
    {
      const int c = lane * 8;
      uint4 yu = *(const uint4*)(p.proj + (size_t)n * PCOLS + c);
      const u16* pr = p.prep + (size_t)n * 3584 + c;
      uint4 ru = *(const uint4*)(pr + 512), ku = *(const uint4*)(pr + 1024), vu = *(const uint4*)(pr + 2560),
            gu = *(const uint4*)(pr + 3072);
      unsigned ys[4] = {yu.x, yu.y, yu.z, yu.w}, rs[4] = {ru.x, ru.y, ru.z, ru.w}, ks_[4] = {ku.x, ku.y, ku.z, ku.w},
               vs[4] = {vu.x, vu.y, vu.z, vu.w}, gs[4] = {gu.x, gu.y, gu.z, gu.w};
      float y[8], r[8], k[8], v[8], g[8];
#pragma unroll
      for (int e = 0; e < 4; e++) {
        y[2 * e] = bflo(ys[e]); y[2 * e + 1] = bfhi(ys[e]);
        r[2 * e] = bflo(rs[e]); r[2 * e + 1] = bfhi(rs[e]);
        k[2 * e] = bflo(ks_[e]); k[2 * e + 1] = bfhi(ks_[e]);
        v[2 * e] = bflo(vs[e]); v[2 * e + 1] = bfhi(vs[e]);
        g[2 * e] = bflo(gs[e]); g[2 * e + 1] = bfhi(gs[e]);
      }
      float s = 0.f, bn = 0.f;
#pragma unroll
      for (int e = 0; e < 8; e++) { s += y[e]; bn += r[e] * k[e] * p.rw_r_k[c + e]; }
      s = allreduce8(s); bn = allreduce8(bn);
      const float mean = s * (1.f / 64.f);
      float vr = 0.f;
#pragma unroll
      for (int e = 0; e < 8; e++) { const float d = y[e] - mean; vr += d * d; }
      vr = allreduce8(vr) * (1.f / 64.f);
      const float rs_ = rsqrtf(vr + 64e-5f);
      float o[8];
#pragma unroll
      for (int e = 0; e < 8; e++) {
        const float yn = (y[e] - mean) * rs_ * p.rw_ln_w[c + e] + p.rw_ln_b[c + e];
        o[e] = (yn + bn * v[e]) * g[e];
      }
      uint4 ou; ou.x = pack2(o[0], o[1]); ou.y = pack2(o[2], o[3]); ou.z = pack2(o[4], o[5]); ou.w = pack2(o[6], o[7]);
      *(uint4*)(p.oa + (size_t)n * 512 + c) = ou;
    }
    {
      const int c = lane * 16;
      float yv[16];
      float ss = 0.f;
#pragma unroll
      for (int hh = 0; hh < 2; hh++) {
        const uint4 yu = hh ? sy1 : sy0;
        const uint4 zu = hh ? sz1 : sz0;
        unsigned ys[4] = {yu.x, yu.y, yu.z, yu.w}, zs[4] = {zu.x, zu.y, zu.z, zu.w};
#pragma unroll
        for (int e = 0; e < 4; e++) {
          const float a = bflo(ys[e]) * siluf_(bflo(zs[e])), b = bfhi(ys[e]) * siluf_(bfhi(zs[e]));
          yv[hh * 8 + 2 * e] = a; yv[hh * 8 + 2 * e + 1] = b;
          ss += a * a + b * b;
        }
      }
#pragma unroll
      for (int o = 16; o >= 1; o >>= 1) ss += __shfl_xor(ss, o, 64);
      const float rstd = rsqrtf(ss * (1.f / 512.f) + 1e-6f);
      unsigned ou[8];
#pragma unroll
      for (int e = 0; e < 8; e++)
        ou[e] = pack2(yv[2 * e] * rstd * p.ssm_norm_w[c + 2 * e], yv[2 * e + 1] * rstd * p.ssm_norm_w[c + 2 * e + 1]);
      *(uint4*)(p.ob + (size_t)n * 1024 + c) = make_uint4(ou[0], ou[1], ou[2], ou[3]);
      *(uint4*)(p.ob + (size_t)n * 1024 + c + 8) = make_uint4(ou[4], ou[5], ou[6], ou[7]);
    }
  }
}

__device__ void phase6(const P& p, int bid, int nb, char* smem) {
  TileIter ti(bid, nb, 136, 8);
  int mt, nt;
  while (ti.next(mt, nt)) {
    f32x4 ac[4][4];
    unsigned sg[4][4][2];
    u16* Lt = (u16*)smem;
    zero_acc(ac);
    gemm_tile_glds(p.xn, D, mt * 128, p.w_inT + (size_t)G_A * D, D, nt * 128, D, ac, smem);
#pragma unroll
    for (int m = 0; m < 4; m++)
#pragma unroll
      for (int n = 0; n < 4; n++) {
        sg[m][n][0] = pack2(sigmoidf_(ac[m][n][0]), sigmoidf_(ac[m][n][1]));
        sg[m][n][1] = pack2(sigmoidf_(ac[m][n][2]), sigmoidf_(ac[m][n][3]));
      }
    zero_acc(ac);
    gemm_tile_glds(p.oa, 512, mt * 128, p.w_paT, 512, nt * 128, 512, ac, smem);
    ACC_FOREACH({
      const unsigned gu = sg[m][n][j >> 1];
      Lt[row * 136 + col] = f2bf(((j & 1) ? bfhi(gu) : bflo(gu)) * ac[m][n][j]);
    })
    tile_out_bf16(smem, p.merged, D, mt * 128, nt * 128, 128);
    zero_acc(ac);
    gemm_tile_glds(p.xn, D, mt * 128, p.w_inT + (size_t)G_B * D, D, nt * 128, D, ac, smem);
#pragma unroll
    for (int m = 0; m < 4; m++)
#pragma unroll
      for (int n = 0; n < 4; n++) {
        sg[m][n][0] = pack2(sigmoidf_(ac[m][n][0]), sigmoidf_(ac[m][n][1]));
        sg[m][n][1] = pack2(sigmoidf_(ac[m][n][2]), sigmoidf_(ac[m][n][3]));
      }
    zero_acc(ac);
    gemm_tile_glds(p.ob, D, mt * 128, p.w_pbT, D, nt * 128, D, ac, smem);
    ACC_FOREACH({
      const unsigned gu = sg[m][n][j >> 1];
      Lt[row * 136 + col] = f2bf(((j & 1) ? bfhi(gu) : bflo(gu)) * ac[m][n][j]);
    })
    __syncthreads();
    {
      const int tid = TIDX;
#pragma unroll
      for (int i = 0; i < 8; i++) {
        const int id = tid + i * 256, row = id >> 4, ch = id & 15;
        u16* gp = p.merged + (size_t)(mt * 128 + row) * D + nt * 128 + ch * 8;
        const uint4 a = *(const uint4*)gp, b = *(const uint4*)(smem + row * 272 + ch * 16);
        uint4 o;
        o.x = pack2(bflo(a.x) + bflo(b.x), bfhi(a.x) + bfhi(b.x));
        o.y = pack2(bflo(a.y) + bflo(b.y), bfhi(a.y) + bfhi(b.y));
        o.z = pack2(bflo(a.z) + bflo(b.z), bfhi(a.z) + bfhi(b.z));
        o.w = pack2(bflo(a.w) + bflo(b.w), bfhi(a.w) + bfhi(b.w));
        *(uint4*)gp = o;
      }
    }
  }
}

constexpr int P7_G = 136 * 8, P7_CV = 16384;
constexpr float U_SCALE = 256.f, V_SCALE = 32.f;
__device__ void phase7(const P& p, int bid, int nb, char* smem) {
  {
    TileIter ti(bid, nb, 136, 8);
    int mt, nt;
    while (ti.next(mt, nt)) {
      f32x4 acc[4][4];
      zero_acc(acc);
      gemm_tile_glds(p.merged, D, mt * 128, p.w_outT, D, nt * 128, D, acc, smem);
      float* Lf = (float*)smem;
      ACC_FOREACH({ Lf[row * 132 + col] = acc[m][n][j]; })
      __syncthreads();
      {
        const int tid = TIDX;
#pragma unroll 4
        for (int i = 0; i < 16; i++) {
          const int id = tid + i * 256, row = id >> 5, c4 = (id & 31) * 4;
          const int nn = mt * 128 + row, c = nt * 128 + c4;
          int seq, t, T; tok2seq(nn, seq, t, T);
          const float4 a = *(const float4*)(Lf + row * 132 + c4);
          const float4 g = *(const float4*)(p.mod + (size_t)seq * 8192 + 2048 + c);
          const float4 x = *(const float4*)(xrow(p, nn) + c);
          *(float4*)(p.out + O_Y + (size_t)nn * D + c) = make_float4(x.x + g.x * a.x, x.y + g.y * a.y, x.z + g.z * a.z, x.w + g.w * a.w);
        }
      }
    }
  }
  int cw = bid, cn = nb;
  if (nb == 512) { const int lb = bid >> 3; if (lb < 8) return; cw = (bid & 7) * 56 + (lb - 8); cn = 448; }
  for (int it0 = cw; it0 < P7_CV; it0 += 4 * cn) {
    const int tid = TIDX;
    float4 va[4], vb[4];
#pragma unroll
    for (int r = 0; r < 4; r++) {
      const int it = it0 + r * cn;
      if (it < P7_CV) {
        const float* src = it < 8192 ? p.peer_u + (size_t)it * 2048 : p.peer_v + (size_t)(it - 8192) * 2048;
        const float4* s4 = (const float4*)src + tid * 2;
        va[r] = s4[0]; vb[r] = s4[1];
      }
    }
#pragma unroll
    for (int r = 0; r < 4; r++) {
      const int it = it0 + r * cn;
      if (it < P7_CV) {
        unsigned char* dst = it < 8192 ? (unsigned char*)p.ub + (size_t)it * 2048 : (unsigned char*)p.vb + (size_t)(it - 8192) * 2048;
        const float sc = it < 8192 ? U_SCALE : V_SCALE;
        const float4 a = va[r], b = vb[r];
        int lo = __builtin_amdgcn_cvt_pk_fp8_f32(a.x * sc, a.y * sc, 0, false);
        lo = __builtin_amdgcn_cvt_pk_fp8_f32(a.z * sc, a.w * sc, lo, true);
        int hi = __builtin_amdgcn_cvt_pk_fp8_f32(b.x * sc, b.y * sc, 0, false);
        hi = __builtin_amdgcn_cvt_pk_fp8_f32(b.z * sc, b.w * sc, hi, true);
        *((uint2*)dst + tid) = make_uint2((unsigned)lo, (unsigned)hi);
      }
    }
  }
}

__device__ void phase9(const P& p, int bid, int nb, char* smem) {
  const int tid = TIDX, lane = tid & 63, wid = tid >> 6, wr = wid >> 1, wc = wid & 1, fr = lane & 15,
            fq = lane >> 4;
  TileIter ti(bid, nb, 136, 16);
  int mt, nt;
  while (ti.next(mt, nt)) {
    f32x4 acc[4][4];
    zero_acc(acc);
    gemm_tile_glds(p.xn, D, mt * 128, p.wqT, D, nt * 128, D, acc, smem);
    u16* Lq = (u16*)smem;
    ACC_FOREACH({ Lq[row * 136 + col] = f2bf(acc[m][n][j]); })
    __syncthreads();
    f32x4 sc[4][4];
    zero_acc(sc);
    const u16* kb = p.keysb + (size_t)nt * 128 * 128;
#pragma unroll 1
    for (int s = 0; s < 4; s++) {
      bf16x8 af[4], bfr[4];
#pragma unroll
      for (int m = 0; m < 4; m++) af[m] = *(const bf16x8*)((const char*)Lq + (wr * 64 + m * 16 + fr) * 272 + s * 64 + fq * 16);
#pragma unroll
      for (int n = 0; n < 4; n++) bfr[n] = *(const bf16x8*)(kb + (size_t)(wc * 64 + n * 16 + fr) * 128 + s * 32 + fq * 8);
#pragma unroll
      for (int m = 0; m < 4; m++)
#pragma unroll
        for (int n = 0; n < 4; n++) sc[m][n] = __builtin_amdgcn_mfma_f32_16x16x32_bf16(af[m], bfr[n], sc[m][n], 0, 0, 0);
    }
    __syncthreads();
    float* Ls = (float*)smem;
#pragma unroll
    for (int m = 0; m < 4; m++)
#pragma unroll
      for (int n = 0; n < 4; n++)
#pragma unroll
        for (int j = 0; j < 4; j++) {
          const int kc = wc * 64 + n * 16 + fr;
          int sb = __float_as_int(sc[m][n][j]);
          sb ^= (sb >> 31) & 0x7fffffff;
          ((int*)Ls)[(wr * 64 + m * 16 + fq * 4 + j) * 132 + kc] = (sb & ~127) | (127 - kc);
        }
    __syncthreads();
    {
      const int row = tid >> 1, half = tid & 1;
      int* Li = (int*)Ls + row * 132 + half * 64;
      const size_t ob = ((size_t)(mt * 128 + row) * 16 + nt) * 16;
      for (int r = 0; r < 16; r++) {
        int best = (int)0x80000000;
#pragma unroll
        for (int i = 0; i < 16; i++) {
          const int4 k4 = *(const int4*)(Li + 4 * i);
          best = max(max(best, k4.x), max(k4.y, max(k4.z, k4.w)));
        }
        best = max(best, __shfl_xor(best, 1, 64));
        const int bi = 127 - (best & 127);
        if ((bi >> 6) == half) Li[bi & 63] = (int)0x80000000;
        if (half == 0) {
          int vb = best & ~127;
          vb ^= (vb >> 31) & 0x7fffffff;
          p.topv[ob + r] = __int_as_float(vb);
          p.topi[ob + r] = bi;
        }
      }
    }
    __syncthreads();
  }
}

__device__ __forceinline__ void cand_ij(int lane, int& ci, int& cj) {
  int i = 0, rem = lane;
#pragma unroll
  for (int r = 0; r < 16; r++) {
    const int cnt = 16 / (r + 1);
    if (i == r && rem >= cnt) { rem -= cnt; i = r + 1; }
  }
  ci = i; cj = rem;
}

typedef __attribute__((ext_vector_type(2))) __bf16 bf2_t;
__device__ __forceinline__ float dot2bf(unsigned a, unsigned b, float c) {
  return __builtin_amdgcn_fdot2_f32_bf16(__builtin_bit_cast(bf2_t, a), __builtin_bit_cast(bf2_t, b), c, false);
}
template <int CTRL, int RM>
__device__ __forceinline__ float dppf_m(float x) {
  return __int_as_float(__builtin_amdgcn_update_dpp(0, __float_as_int(x), CTRL, RM, 0xf, false));
}
__device__ __forceinline__ float wave_sum_l63(float x) {
  x += dppf<0xB1>(x);
  x += dppf<0x4E>(x);
  x += dppf<0x141>(x);
  x += dppf<0x140>(x);
  x += dppf_m<0x142, 0xA>(x);
  x += dppf_m<0x143, 0xC>(x);
  return x;
}
__device__ __forceinline__ float readlane_f(float x, int l) {
  return __int_as_float(__builtin_amdgcn_readlane(__float_as_int(x), l));
}
__device__ __forceinline__ void axpy8(float* acc, float w, uint4 v) {
  acc[0] += w * bflo(v.x); acc[1] += w * bfhi(v.x); acc[2] += w * bflo(v.y); acc[3] += w * bfhi(v.y);
  acc[4] += w * bflo(v.z); acc[5] += w * bfhi(v.z); acc[6] += w * bflo(v.w); acc[7] += w * bfhi(v.w);
}

typedef float f2_t __attribute__((ext_vector_type(2)));
__device__ __forceinline__ void fp8x16_to_f32(const uint4 v, float* o) {
  const unsigned w[4] = {v.x, v.y, v.z, v.w};
#pragma unroll
  for (int i = 0; i < 4; i++) {
    const f2_t lo = __builtin_amdgcn_cvt_pk_f32_fp8((int)w[i], false);
    const f2_t hi = __builtin_amdgcn_cvt_pk_f32_fp8((int)w[i], true);
    o[4 * i] = lo.x; o[4 * i + 1] = lo.y; o[4 * i + 2] = hi.x; o[4 * i + 3] = hi.y;
  }
}

__device__ void phase10(const P& p, int bid, int nb) {
  const int lane = TIDX & 63, wid = TIDX >> 6;
  int ci, cj; cand_ij(lane < 50 ? lane : 0, ci, cj);
  const unsigned char* ub8 = (const unsigned char*)p.ub;
  const unsigned char* vb8 = (const unsigned char*)p.vb;
  for (int it = bid; it < NT / 4; it += nb) {
    const int n = it * 4 + wid;
    int seq, t, T; tok2seq(n, seq, t, T);
    float xv[16];
    {
      const uint4 a = *(const uint4*)(p.xn + (size_t)n * D + lane * 16), b = *(const uint4*)(p.xn + (size_t)n * D + lane * 16 + 8);
      const unsigned as[4] = {a.x, a.y, a.z, a.w}, bs[4] = {b.x, b.y, b.z, b.w};
#pragma unroll
      for (int e = 0; e < 4; e++) { xv[2 * e] = bflo(as[e]); xv[2 * e + 1] = bfhi(as[e]); xv[8 + 2 * e] = bflo(bs[e]); xv[8 + 2 * e + 1] = bfhi(bs[e]); }
    }
    float acc[16];
#pragma unroll
    for (int e = 0; e < 16; e++) acc[e] = 0.f;
#pragma unroll 1
    for (int h = 0; h < 8; h++) {
      const size_t base = ((size_t)n * 16 + h * 2) * 16;
      float cand = -INFINITY; int eid = 0;
      if (lane < 50) {
        cand = p.topv[base + ci] + p.topv[base + 16 + cj];
        eid = p.topi[base + ci] * 128 + p.topi[base + 16 + cj];
      }
      int rank = 0;
#pragma unroll
      for (int m = 0; m < 50; m++) {
        const float cm = readlane_f(cand, m);
        rank += ((cm > cand) || (cm == cand && m < lane)) ? 1 : 0;
      }
      const bool sel = (lane < 50) && (rank < 16);
      unsigned long long mask = __ballot(sel);
      const float mx = readlane_f(cand, __builtin_ctzll(__ballot(sel && rank == 0)));
      const float ex = sel ? __expf(cand - mx) : 0.f;
      const float den = readlane_f(wave_sum_l63(ex), 63);
      const float gate = ex / den;
#pragma unroll 1
      for (int hf = 0; hf < 2; hf++) {
        int ek[8]; float gk[8];
#pragma unroll
        for (int k = 0; k < 8; k++) {
          const int src = __builtin_ctzll(mask);
          mask &= mask - 1;
          ek[k] = __builtin_amdgcn_readlane(eid, src);
          gk[k] = readlane_f(gate, src);
        }
        uint4 uu[8], vv[8];
#pragma unroll
        for (int j = 0; j < 8; j++) uu[j] = *(const uint4*)(ub8 + (size_t)ek[j] * D + lane * 16);
#pragma unroll
        for (int j = 0; j < 8; j++) vv[j] = *(const uint4*)(vb8 + (size_t)ek[j] * D + lane * 16);
        float dv = 0.f;
#pragma unroll
        for (int j = 0; j < 8; j++) {
          float uf[16];
          fp8x16_to_f32(uu[j], uf);
          float d0 = 0.f, d1 = 0.f;
#pragma unroll
          for (int e = 0; e < 8; e++) { d0 += uf[2 * e] * xv[2 * e]; d1 += uf[2 * e + 1] * xv[2 * e + 1]; }
          const float ds = readlane_f(wave_sum_l63(d0 + d1), 63);
          dv = (lane == j) ? ds : dv;
        }
        dv *= (1.f / U_SCALE);
        const float act = 0.5f * dv * (1.f + erff(dv * 0.70710678118654752f));
#pragma unroll
        for (int j = 0; j < 8; j++) {
          const float w = readlane_f(act, j) * gk[j] * (1.f / V_SCALE);
          float vf[16];
          fp8x16_to_f32(vv[j], vf);
#pragma unroll
          for (int e = 0; e < 16; e++) acc[e] += w * vf[e];
        }
      }
    }
    float* yr = p.out + O_Y + (size_t)n * D + lane * 16;
    const float* md = p.mod + (size_t)seq * 8192 + lane * 16;
    float x2[16];
    float ss = 0.f;
#pragma unroll
    for (int q4 = 0; q4 < 4; q4++) {
      const float4 a = *(const float4*)(yr + q4 * 4), g = *(const float4*)(md + 5120 + q4 * 4);
      x2[q4 * 4 + 0] = a.x + g.x * acc[q4 * 4 + 0]; x2[q4 * 4 + 1] = a.y + g.y * acc[q4 * 4 + 1];
      x2[q4 * 4 + 2] = a.z + g.z * acc[q4 * 4 + 2]; x2[q4 * 4 + 3] = a.w + g.w * acc[q4 * 4 + 3];
    }
#pragma unroll
    for (int e = 0; e < 16; e++) ss += x2[e] * x2[e];
    ss = readlane_f(wave_sum_l63(ss), 63);
    const float rstd = rsqrtf(ss * (1.f / 1024.f) + 1e-6f);
#pragma unroll
    for (int q4 = 0; q4 < 4; q4++) {
      const float4 fg = *(const float4*)(p.final_g + lane * 16 + q4 * 4), sc = *(const float4*)(md + 7168 + q4 * 4),
                   sh = *(const float4*)(md + 6144 + q4 * 4);
      float4 o;
      o.x = x2[q4 * 4 + 0] * rstd * fg.x * (1.f + sc.x) + sh.x;
      o.y = x2[q4 * 4 + 1] * rstd * fg.y * (1.f + sc.y) + sh.y;
      o.z = x2[q4 * 4 + 2] * rstd * fg.z * (1.f + sc.z) + sh.z;
      o.w = x2[q4 * 4 + 3] * rstd * fg.w * (1.f + sc.w) + sh.w;
      *(float4*)(yr + q4 * 4) = o;
    }
  }
}

#define XB_XCNT(j) (256 + 64 * (j))
#define XB_XSUB(j) (1280 + 64 * (j))
#define XB_XGEN(j) (2304 + 64 * (j))
#define XB_TOP 3328
#define XB_TOPGEN 3392
#define XB_WORDS 4096
__device__ __forceinline__ unsigned xb_ld(unsigned* p) { return __hip_atomic_load(p, __ATOMIC_RELAXED, __HIP_MEMORY_SCOPE_AGENT); }
__device__ __forceinline__ unsigned xb_add(unsigned* p, unsigned v) { return __hip_atomic_fetch_add(p, v, __ATOMIC_RELAXED, __HIP_MEMORY_SCOPE_AGENT); }
__device__ __forceinline__ unsigned xb_xcc_id() { return (unsigned)__builtin_amdgcn_s_getreg((3 << 11) | 20) & 0xFu; }
__device__ __forceinline__ void grid_barrier(unsigned* bar, volatile unsigned* xst) {
  asm volatile("s_waitcnt vmcnt(0)" ::: "memory");
  __syncthreads();
  if (TIDX == 0) {
    __builtin_amdgcn_s_waitcnt(0);
    const unsigned x = xst[0], nloc = xst[1], nx = xst[2];
    const unsigned old = xb_add(&bar[XB_XSUB(x)], 1u);
    const unsigned gen = old / nloc;
    if (old + 1u == (gen + 1u) * nloc) {
      __builtin_amdgcn_fence(__ATOMIC_RELEASE, "agent");
      asm volatile("s_waitcnt vmcnt(0)" ::: "memory");
      const unsigned og = xb_add(&bar[XB_TOP], 1u);
      const unsigned tg = og / nx;
      if (og + 1u == (tg + 1u) * nx) xb_add(&bar[XB_TOPGEN], 1u);
      else while (xb_ld(&bar[XB_TOPGEN]) == tg) __builtin_amdgcn_s_sleep(1);
      __builtin_amdgcn_fence(__ATOMIC_ACQUIRE, "agent");
      xb_add(&bar[XB_XGEN(x)], 1u);
      asm volatile("s_waitcnt vmcnt(0)" ::: "memory");
    } else {
      while (xb_ld(&bar[XB_XGEN(x)]) == gen) __builtin_amdgcn_s_sleep(1);
      __builtin_amdgcn_fence(__ATOMIC_ACQUIRE, "agent");
      asm volatile("s_waitcnt vmcnt(0)" ::: "memory");
    }
  }
  __syncthreads();
}

template <int PH>
__device__ __forceinline__ void run_phase(const P& p, int bid, int nb, char* smem) {
  if constexpr (PH == 0) phase0(p, bid, nb, smem);
  if constexpr (PH == 1) phase_norm<false>(p, bid, nb);
  if constexpr (PH == 2) phase2(p, bid, nb, smem);
  if constexpr (PH == 3) phase3(p, bid, nb, smem);
  if constexpr (PH == 4) phase4(p, bid, nb, smem);
  if constexpr (PH == 5) phase5(p, bid, nb);
  if constexpr (PH == 6) phase6(p, bid, nb, smem);
  if constexpr (PH == 7) phase7(p, bid, nb, smem);
  if constexpr (PH == 8) phase_norm<true>(p, bid, nb);
  if constexpr (PH == 9) phase9(p, bid, nb, smem);
  if constexpr (PH == 10) phase10(p, bid, nb);
  if constexpr (PH == 11) phase3b(p, bid, nb, smem);
}

template <int PH>
__global__ void __launch_bounds__(NTHREADS, 2) k_phase(P p) {
  extern __shared__ __attribute__((aligned(16))) char smem[];
  run_phase<PH>(p, blockIdx.x, gridDim.x, smem);
}

#if MEGA
__global__ void __launch_bounds__(NTHREADS, 2) k_mega(P p) {
  extern __shared__ __attribute__((aligned(16))) char smem[];
  cg::grid_group grid = cg::this_grid();
  const int bid = blockIdx.x, nb = gridDim.x;
#ifndef PROBE_ALL2
#define PROBE_ALL2 0
#endif
#ifndef PROBE_MASK
#define PROBE_MASK 0
#endif
#ifndef PROBE_SYNCS
#define PROBE_SYNCS 0
#endif
  volatile unsigned* xst = (volatile unsigned*)(smem + LDS_BYTES - 16);
  if (TIDX == 0) { const unsigned xcc0 = xb_xcc_id(); xst[0] = xcc0; xb_add(&p.bar[XB_XCNT(xcc0)], 1u); }
#define GSYNC(k)                                                                                 \
  {                                                                                              \
    if ((k) == 0) {                                                                              \
      grid.sync();                                                                               \
      if (TIDX == 0) {                                                                    \
        unsigned cnt = 0;                                                                        \
        for (unsigned j = 0; j < 16; ++j) cnt += xb_ld(&p.bar[XB_XCNT(j)]) > 0u ? 1u : 0u;       \
        xst[2] = cnt; xst[1] = xb_ld(&p.bar[XB_XCNT(xst[0])]);                                   \
      }                                                                                          \
    } else grid_barrier(p.bar, xst);                                                             \
  }
#define RUNPH(k)                                                       \
  run_phase<k>(p, bid, nb, smem); GSYNC(k)                             \
  if (PROBE_MASK & (1 << k)) { run_phase<k>(p, bid, nb, smem); GSYNC(1) }
#pragma unroll 1
  for (int rep = 0; rep < 1 + PROBE_ALL2; rep++) {
    RUNPH(0)
#pragma unroll 1
    for (int i = 0; i < PROBE_SYNCS; i++) GSYNC(1)
    RUNPH(1) RUNPH(2) RUNPH(3) RUNPH(11) RUNPH(4) RUNPH(5) RUNPH(6) RUNPH(7) RUNPH(8) RUNPH(9)
  }
  run_phase<10>(p, bid, nb, smem);
}
#endif

template <int PH>
static void launch_phase(const P& p, int grid, hipStream_t stream) {
  static bool attr = false;
  if (!attr) { hipFuncSetAttribute((const void*)k_phase<PH>, hipFuncAttributeMaxDynamicSharedMemorySize, LDS_BYTES); attr = true; }
  hipLaunchKernelGGL(k_phase<PH>, dim3(grid), dim3(NTHREADS), LDS_BYTES, stream, p);
}

extern "C" void kernel_launch(void* const* d_in, const int* in_sizes, int n_in, void* d_out, int out_size, void* d_ws,
                              size_t ws_size, hipStream_t stream) {
  P p{};
  const float** fp = (const float**)&p;
  for (int i = 0; i < 40; i++) fp[i] = (const float*)d_in[i];
  p.out = (float*)d_out;
  char* ws = (char*)d_ws;
  size_t off = 0;
  auto take = [&](size_t bytes) { char* r = ws + off; off += (bytes + 255) & ~(size_t)255; return r; };
  p.bar = (unsigned*)take(XB_WORDS * 4);
  p.w_inT = (u16*)take((size_t)INCOLS * D * 2);
  p.w_paT = (u16*)take((size_t)1024 * 512 * 2);
  p.w_pbT = (u16*)take((size_t)1024 * 1024 * 2);
  p.w_outT = (u16*)take((size_t)1024 * 1024 * 2);
  p.wqT = (u16*)take((size_t)2048 * 1024 * 2);
  p.keysb = (u16*)take((size_t)262144 * 2);
  p.mod = (float*)take((size_t)NSEQ * 8192 * 4);
  p.dtb = (float*)take((size_t)NT * 16 * 4);
  p.decb = (float*)take((size_t)NT * 16 * 4);
  p.xn = (u16*)take((size_t)NROWS * D * 2);
  p.proj = (u16*)take((size_t)NROWS * PCOLS * 2);
  p.prep = (u16*)take((size_t)NT * 3584 * 2);
  p.w2T = (u16*)take(512 * 64 * 2);
  p.a2T = (u16*)take(512 * 64 * 2);
  p.g2T = (u16*)take(512 * 128 * 2);
  p.lora = (u16*)take((size_t)NT * 256 * 2);
  if (off > ws_size) { fprintf(stderr, "workspace too small: need %zu have %zu\n", off, ws_size); return; }
  p.merged = p.prep;
  p.ub = p.proj;
  p.vb = p.proj + (size_t)16384 * 1024;
  p.topv = (float*)(p.proj + (size_t)2 * 16384 * 1024);
  p.topi = (int*)(p.topv + (size_t)NT * 256);
  p.xc = (u16*)d_out;
  p.oa = (u16*)d_out;
  p.ob = (u16*)d_out + (size_t)NT * 512;

  static int grid = 0;
  if (!grid) {
    int dev = 0, cus = 0, per_cu = 0;
    hipGetDevice(&dev);
    hipDeviceGetAttribute(&cus, hipDeviceAttributeMultiprocessorCount, dev);
#if MEGA
    hipFuncSetAttribute((const void*)k_mega, hipFuncAttributeMaxDynamicSharedMemorySize, LDS_BYTES);
    hipOccupancyMaxActiveBlocksPerMultiprocessor(&per_cu, k_mega, NTHREADS, LDS_BYTES);
    if (per_cu > 2) per_cu = 2;
#else
    per_cu = 2;
#endif
    if (per_cu < 1) per_cu = 1;
    grid = cus * per_cu;
  }
  hipMemsetAsync(p.mod, 0, (size_t)NSEQ * 8192 * 4, stream);
#if MEGA
  hipMemsetAsync(p.bar, 0, XB_WORDS * 4, stream);
  void* args[] = {&p};
  hipError_t e = hipLaunchCooperativeKernel((void*)k_mega, dim3(grid), dim3(NTHREADS), args, LDS_BYTES, stream);
  if (e != hipSuccess) fprintf(stderr, "cooperative launch failed: %s (grid %d)\n", hipGetErrorString(e), grid);
#else
  launch_phase<0>(p, grid, stream);
  launch_phase<1>(p, grid, stream);
  launch_phase<2>(p, grid, stream);
  launch_phase<3>(p, grid, stream);
  launch_phase<11>(p, grid, stream);
  launch_phase<4>(p, grid, stream);
  launch_phase<5>(p, grid, stream);
  launch_phase<6>(p, grid, stream);
  launch_phase<7>(p, grid, stream);
  launch_phase<8>(p, grid, stream);
  launch_phase<9>(p, grid, stream);
  launch_phase<10>(p, grid, stream);
#endif
}
```

```cpp
#include <hip/hip_runtime.h>
#include <hip/hip_cooperative_groups.h>
#include <cstdio>
namespace cg = cooperative_groups;

#ifndef MEGA
#define MEGA 1
#endif

typedef unsigned short u16;
typedef __attribute__((ext_vector_type(8))) short bf16x8;
typedef __attribute__((ext_vector_type(4))) float f32x4;

__device__ __forceinline__ int opaque_tid() { int t = threadIdx.x; asm volatile("" : "+v"(t)); return t; }
#define TIDX opaque_tid()

constexpr int D = 1024;
constexpr int NP = 16384, NS = 1024, NT = NP + NS, NSEQ = 136;
constexpr int NROWS = NT + 128;
constexpr int PCOLS = 4368;
constexpr int INCOLS = 6416;
constexpr int C_LW = 1536, C_LA = 1600, C_LG = 1664, C_Z = 1792, C_XBC = 2816, C_DT = 4352;
constexpr int G_A = 4368, G_B = 5392;
constexpr size_t O_Y = 0, O_PSHIFT = 17825792, O_PWKV = 17833984, O_PCONV = 18096128, O_PSSM = 18132992,
                 O_SSHIFT = 19181568, O_SWKV = 19312640, O_SCONV = 23506944, O_SSSM = 24096768;
constexpr int LDS_BYTES = 80 * 1024;
constexpr int NTHREADS = 256;

struct P {
  const float *x_prompt, *x_sample, *c_prompt, *c_sample, *state_shift, *state_wkv, *state_conv, *state_ssm;
  const float *w_ada, *b_ada, *norm1_g, *w_in, *rw_mu, *rw_w0, *rw_w2, *rw_a0, *rw_a2, *rw_g2, *rw_k_k, *rw_k_a,
      *rw_r_k, *rw_ln_w, *rw_ln_b;
  const float *conv_w, *conv_b, *dt_bias, *A_log, *D_skip, *ssm_norm_w, *w_pa, *w_pb, *w_out, *norm2_g, *peer_wq,
      *peer_keys, *peer_u, *peer_v, *final_g, *w_ada_f, *b_ada_f;
  float* out;
  u16 *w_inT, *w_paT, *w_pbT, *w_outT, *wqT, *keysb, *xn, *proj, *prep, *merged, *ub, *vb, *xc, *oa, *ob;
  u16 *w2T, *a2T, *g2T, *lora;
  float *mod, *dtb, *decb, *topv;
  int* topi;
  unsigned* bar;
};

__device__ __forceinline__ u16 f2bf(float f) {
  unsigned u = __float_as_uint(f);
  u += 0x7fffu + ((u >> 16) & 1u);
  return (u16)(u >> 16);
}
__device__ __forceinline__ float bf2f(u16 h) { return __uint_as_float(((unsigned)h) << 16); }
__device__ __forceinline__ unsigned pack2(float a, float b) { return (unsigned)f2bf(a) | ((unsigned)f2bf(b) << 16); }
__device__ __forceinline__ float bflo(unsigned u) { return __uint_as_float(u << 16); }
__device__ __forceinline__ float bfhi(unsigned u) { return __uint_as_float(u & 0xffff0000u); }
__device__ __forceinline__ float sigmoidf_(float x) { return 1.f / (1.f + __expf(-x)); }
__device__ __forceinline__ float siluf_(float x) { return x / (1.f + __expf(-x)); }
__device__ __forceinline__ float softplusf_(float x) { return x > 20.f ? x : log1pf(expf(x)); }

template <int CTRL>
__device__ __forceinline__ float dppf(float x) {
  return __int_as_float(__builtin_amdgcn_update_dpp(0, __float_as_int(x), CTRL, 0xf, 0xf, true));
}
__device__ __forceinline__ float allreduce16(float x) {
  x += dppf<0x128>(x);
  x += dppf<0x124>(x);
  x += dppf<0x122>(x);
  x += dppf<0x121>(x);
  return x;
}
__device__ __forceinline__ float allreduce8(float x) {
  x += dppf<0xB1>(x);
  x += dppf<0x4E>(x);
  x += dppf<0x141>(x);
  return x;
}
__device__ __forceinline__ float wave_sum(float x) {
#pragma unroll
  for (int o = 32; o >= 1; o >>= 1) x += __shfl_xor(x, o, 64);
  return x;
}
__device__ __forceinline__ float wave_max(float x) {
#pragma unroll
  for (int o = 32; o >= 1; o >>= 1) x = fmaxf(x, __shfl_xor(x, o, 64));
  return x;
}
__device__ __forceinline__ int wave_min_i(int x) {
#pragma unroll
  for (int o = 32; o >= 1; o >>= 1) x = min(x, __shfl_xor(x, o, 64));
  return x;
}

__device__ __forceinline__ const float* xrow(const P& p, int n) {
  return n < NP ? p.x_prompt + (size_t)n * D : p.x_sample + (size_t)(n - NP) * D;
}
__device__ __forceinline__ void tok2seq(int n, int& seq, int& t, int& T) {
  if (n < NP) { seq = n >> 11; t = n & 2047; T = 2048; }
  else { int m = n - NP; seq = 8 + (m >> 3); t = m & 7; T = 8; }
}
__device__ __forceinline__ float* seq_out(float* out, int seq, size_t op, size_t os, size_t per) {
  return seq < 8 ? out + op + (size_t)seq * per : out + os + (size_t)(seq - 8) * per;
}

constexpr int LROW = 144;
template <bool DEEP = true>
__device__ __forceinline__ void gemm_tile(const u16* __restrict__ A, int lda, int m0, const u16* __restrict__ Bt,
                                          int ldb, int n0, int K, f32x4 (&acc)[4][4], char* smem) {
  char* sA = smem;
  char* sB = smem + 128 * LROW;
  const int tid = TIDX, lane = tid & 63, wid = tid >> 6, wr = wid >> 1, wc = wid & 1, fr = lane & 15,
            fq = lane >> 4;
  uint4 ra0, ra1, ra2, ra3, rb0, rb1, rb2, rb3;
  uint4 sa0, sa1, sa2, sa3, sb0, sb1, sb2, sb3;
  const int nk = K / 64;
  const int lrow = tid >> 3, lch = tid & 7;
  const u16* gA = A + (size_t)(m0 + lrow) * lda + lch * 8;
  const u16* gB = Bt + (size_t)(n0 + lrow) * ldb + lch * 8;
#define GLOAD(x0, x1, x2, x3, y0, y1, y2, y3, kt)                   \
  {                                                                 \
    x0 = *(const uint4*)(gA + (kt) * 64);                           \
    x1 = *(const uint4*)(gA + (size_t)32 * lda + (kt) * 64);        \
    x2 = *(const uint4*)(gA + (size_t)64 * lda + (kt) * 64);        \
    x3 = *(const uint4*)(gA + (size_t)96 * lda + (kt) * 64);        \
    y0 = *(const uint4*)(gB + (kt) * 64);                           \
    y1 = *(const uint4*)(gB + (size_t)32 * ldb + (kt) * 64);        \
    y2 = *(const uint4*)(gB + (size_t)64 * ldb + (kt) * 64);        \
    y3 = *(const uint4*)(gB + (size_t)96 * ldb + (kt) * 64);        \
  }
#define LSTORE(x0, x1, x2, x3, y0, y1, y2, y3)                      \
  {                                                                 \
    char* wa = sA + lrow * LROW + lch * 16;                         \
    char* wb = sB + lrow * LROW + lch * 16;                         \
    *(uint4*)(wa) = x0; *(uint4*)(wa + 32 * LROW) = x1; *(uint4*)(wa + 64 * LROW) = x2; *(uint4*)(wa + 96 * LROW) = x3; \
    *(uint4*)(wb) = y0; *(uint4*)(wb + 32 * LROW) = y1; *(uint4*)(wb + 64 * LROW) = y2; *(uint4*)(wb + 96 * LROW) = y3; \
  }
#define COMPUTE_TILE()                                                                                                   \
  {                                                                                                                      \
    _Pragma("unroll") for (int s = 0; s < 2; s++) {                                                                      \
      bf16x8 af[4], bfr[4];                                                                                              \
      _Pragma("unroll") for (int m = 0; m < 4; m++) af[m] = *(const bf16x8*)(sA + (wr * 64 + m * 16 + fr) * LROW + s * 64 + fq * 16); \
      _Pragma("unroll") for (int n = 0; n < 4; n++) bfr[n] = *(const bf16x8*)(sB + (wc * 64 + n * 16 + fr) * LROW + s * 64 + fq * 16); \
      _Pragma("unroll") for (int m = 0; m < 4; m++)                                                                      \
        _Pragma("unroll") for (int n = 0; n < 4; n++) acc[m][n] = __builtin_amdgcn_mfma_f32_16x16x32_bf16(af[m], bfr[n], acc[m][n], 0, 0, 0); \
    }                                                                                                                    \
  }
  GLOAD(ra0, ra1, ra2, ra3, rb0, rb1, rb2, rb3, 0);
  if constexpr (DEEP) {
    GLOAD(sa0, sa1, sa2, sa3, sb0, sb1, sb2, sb3, 1);
#pragma unroll 1
    for (int kt = 0; kt < nk; kt += 2) {
      __syncthreads();
      LSTORE(ra0, ra1, ra2, ra3, rb0, rb1, rb2, rb3);
      __syncthreads();
      if (kt + 2 < nk) GLOAD(ra0, ra1, ra2, ra3, rb0, rb1, rb2, rb3, kt + 2);
      COMPUTE_TILE();
      __syncthreads();
      LSTORE(sa0, sa1, sa2, sa3, sb0, sb1, sb2, sb3);
      __syncthreads();
      if (kt + 3 < nk) GLOAD(sa0, sa1, sa2, sa3, sb0, sb1, sb2, sb3, kt + 3);
      COMPUTE_TILE();
    }
  } else {
#pragma unroll 1
    for (int kt = 0; kt < nk; kt++) {
      __syncthreads();
      LSTORE(ra0, ra1, ra2, ra3, rb0, rb1, rb2, rb3);
      __syncthreads();
      if (kt + 1 < nk) GLOAD(ra0, ra1, ra2, ra3, rb0, rb1, rb2, rb3, kt + 1);
      COMPUTE_TILE();
    }
  }
  __syncthreads();
}
#define GL_RAW_BARRIER() { asm volatile("s_waitcnt vmcnt(0)" ::: "memory"); asm volatile("s_waitcnt lgkmcnt(0)" ::: "memory"); __builtin_amdgcn_s_barrier(); }
__device__ __forceinline__ void gemm_tile_glds(const u16* __restrict__ A, int lda, int m0, const u16* __restrict__ Bt,
                                               int ldb, int n0, int K, f32x4 (&acc)[4][4], char* smem) {
  const int tid = TIDX, lane = tid & 63, wid = tid >> 6, wr = wid >> 1, wc = wid & 1, fr = lane & 15, fq = lane >> 4;
  const int nk = K / 64;
  const int srow = tid >> 3, sc = (tid & 7) ^ ((srow >> 1) & 7);
  const u16* gA = A + (size_t)(m0 + srow) * lda + sc * 8;
  const u16* gB = Bt + (size_t)(n0 + srow) * ldb + sc * 8;
  char* const lbase = smem + tid * 16;
  const int swz = (fr >> 1) & 7;
  const int aoff = (wr * 64 + fr) * 128, boff = 16384 + (wc * 64 + fr) * 128;
#define GL_STAGE(buf, kt)                                                                                         \
  {                                                                                                               \
    _Pragma("unroll") for (int i = 0; i < 4; i++) {                                                               \
      __builtin_amdgcn_global_load_lds((const unsigned*)(gA + (size_t)(32 * i) * lda + (kt) * 64),               \
                                       (unsigned*)(lbase + (buf) * 32768 + i * 4096), 16, 0, 0);                  \
      __builtin_amdgcn_global_load_lds((const unsigned*)(gB + (size_t)(32 * i) * ldb + (kt) * 64),               \
                                       (unsigned*)(lbase + (buf) * 32768 + 16384 + i * 4096), 16, 0, 0);          \
    }                                                                                                             \
  }
#define GL_COMPUTE(buf)                                                                                           \
  {                                                                                                               \
    const char* pb = smem + (buf) * 32768;                                                                        \
    _Pragma("unroll") for (int s = 0; s < 2; s++) {                                                               \
      bf16x8 af[4], bfr[4];                                                                                       \
      const int so = ((s * 4 + fq) ^ swz) * 16;                                                                   \
      _Pragma("unroll") for (int m = 0; m < 4; m++) af[m] = *(const bf16x8*)(pb + aoff + m * 2048 + so);          \
      _Pragma("unroll") for (int n = 0; n < 4; n++) bfr[n] = *(const bf16x8*)(pb + boff + n * 2048 + so);         \
      __builtin_amdgcn_s_setprio(1);     \
      _Pragma("unroll") for (int m = 0; m < 4; m++)                                                               \
        _Pragma("unroll") for (int n = 0; n < 4; n++)                                                             \
          acc[m][n] = __builtin_amdgcn_mfma_f32_16x16x32_bf16(af[m], bfr[n], acc[m][n], 0, 0, 0);                 \
      __builtin_amdgcn_s_setprio(0);                                                                              \
    }                                                                                                             \
  }
  __syncthreads();
  GL_STAGE(0, 0)
  GL_RAW_BARRIER()
#pragma unroll 1
  for (int kt = 0; kt < nk; kt += 2) {
    if (kt + 1 < nk) GL_STAGE(1, kt + 1)
    GL_COMPUTE(0)
    GL_RAW_BARRIER()
    if (kt + 1 < nk) {
      if (kt + 2 < nk) GL_STAGE(0, kt + 2)
      GL_COMPUTE(1)
      GL_RAW_BARRIER()
    }
  }
}
__device__ __forceinline__ void zero_acc(f32x4 (&acc)[4][4]) {
#pragma unroll
  for (int m = 0; m < 4; m++)
#pragma unroll
    for (int n = 0; n < 4; n++) acc[m][n] = f32x4{0.f, 0.f, 0.f, 0.f};
}
#define ACC_FOREACH(...)                                                                    \
  {                                                                                         \
    const int _l = TIDX & 63, _w = TIDX >> 6, _wr = _w >> 1, _wc = _w & 1;    \
    const int _fr = _l & 15, _fq = _l >> 4;                                                 \
    _Pragma("unroll") for (int m = 0; m < 4; m++) _Pragma("unroll") for (int n = 0; n < 4; n++) \
        _Pragma("unroll") for (int j = 0; j < 4; j++) {                                     \
      const int row = _wr * 64 + m * 16 + _fq * 4 + j, col = _wc * 64 + n * 16 + _fr;       \
      __VA_ARGS__                                                                           \
    }                                                                                       \
  }

struct TileIter {
  int x, lb, nbx, tpx, total, MT, NT, r;
  __device__ __forceinline__ TileIter(int bid, int nb, int MT_, int NT_) : MT(MT_), NT(NT_), r(0) {
    total = MT * NT; x = bid & 7; lb = bid >> 3; nbx = nb >> 3; tpx = (total + 7) >> 3;
  }
  __device__ __forceinline__ bool next(int& mt, int& nt) {
    const int idx = lb + r * nbx;
    r++;
    if (idx >= tpx) return false;
    const int lin = x * tpx + idx;
    if (lin >= total) return false;
    const int bsz = 8 * NT, band = lin / bsz, rem = lin - band * bsz;
    const int mb = min(8, MT - band * 8);
    nt = rem / mb; mt = band * 8 + (rem - nt * mb);
    return true;
  }
};

__device__ __forceinline__ void tile_out_bf16(const char* smem, u16* __restrict__ C, size_t ldc, int m0, int n0, int ncols_valid) {
  __syncthreads();
  const int tid = TIDX;
#pragma unroll
  for (int i = 0; i < 8; i++) {
    const int id = tid + i * 256, row = id >> 4, ch = id & 15;
    if (ch * 8 < ncols_valid) *(uint4*)(C + (size_t)(m0 + row) * ldc + n0 + ch * 8) = *(const uint4*)(smem + row * 272 + ch * 16);
  }
}

__device__ void transpose_tile(const float* __restrict__ src, int K, int N, u16* __restrict__ dst, int tile,
                               char* smem) {
  const int ntn = (N + 63) / 64, kt = tile / ntn, nt = tile % ntn, tid = TIDX;
  float(*s)[65] = (float(*)[65])smem;
  __syncthreads();
#pragma unroll 4
  for (int i = 0; i < 16; i++) {
    int r = (tid >> 6) + 4 * i, n = nt * 64 + (tid & 63);
    s[r][tid & 63] = (n < N) ? src[(size_t)(kt * 64 + r) * N + n] : 0.f;
  }
  __syncthreads();
#pragma unroll 4
  for (int i = 0; i < 8; i++) {
    int nl = (tid >> 5) + 8 * i, n = nt * 64 + nl, kl = (tid & 31) * 2;
    if (n < N) *(unsigned*)(dst + (size_t)n * K + kt * 64 + kl) = pack2(s[kl][nl], s[kl + 1][nl]);
  }
}

__device__ void mod_item(const P& p, int item2, char* smem) {
  const int item = item2 >> 1, kh2 = item2 & 1;
  const int tid = TIDX, j = tid & 31, g = tid >> 5;
  const int col0 = item * 32;
  const float* W; const float* bias; int N, cw;
  if (col0 < 6144) { W = p.w_ada; bias = p.b_ada; N = 6144; cw = col0; }
  else { W = p.w_ada_f; bias = p.b_ada_f; N = 2048; cw = col0 - 6144; }
  float(*cs)[68] = (float(*)[68])smem;
  float acc[17];
#pragma unroll
  for (int s = 0; s < 17; s++) acc[s] = 0.f;
  for (int k0 = kh2 * 512; k0 < kh2 * 512 + 512; k0 += 64) {
    __syncthreads();
    {
      float cv[34];
#pragma unroll
      for (int i = 0; i < 34; i++) {
        const int idx = tid + i * 256, seq = idx >> 6, kk = idx & 63;
        cv[i] = seq < 8 ? p.c_prompt[seq * 1024 + k0 + kk] : p.c_sample[(seq - 8) * 1024 + k0 + kk];
      }
#pragma unroll
      for (int i = 0; i < 34; i++) {
        const int idx = tid + i * 256;
        cs[idx >> 6][idx & 63] = siluf_(cv[i]);
      }
    }
    __syncthreads();
#pragma unroll 1
    for (int kh = 0; kh < 2; kh++) {
      float wv[32];
#pragma unroll
      for (int k = 0; k < 32; k++) wv[k] = W[(size_t)(k0 + kh * 32 + k) * N + cw + j];
#pragma unroll 2
      for (int k4 = 0; k4 < 8; k4++) {
#pragma unroll
        for (int s = 0; s < 17; s++) {
          float4 c4 = *(const float4*)&cs[g * 17 + s][kh * 32 + k4 * 4];
          acc[s] += wv[k4 * 4] * c4.x + wv[k4 * 4 + 1] * c4.y + wv[k4 * 4 + 2] * c4.z + wv[k4 * 4 + 3] * c4.w;
        }
      }
    }
  }
  const float b = kh2 == 0 ? bias[cw + j] : 0.f;
#pragma unroll
  for (int s = 0; s < 17; s++) atomicAdd(&p.mod[(size_t)(g * 17 + s) * 8192 + col0 + j], acc[s] + b);
}

constexpr int J_MOD = 512, J_WIN = 16 * 101, J_WPA = 8 * 16, J_WPB = 256, J_WOUT = 256, J_WQ = 16 * 32, J_KEYS = 128,
              J_SHIFT = 64;
constexpr int J_LORA = 8 + 8 + 16;
constexpr int PH0_ITEMS = J_MOD + J_WIN + J_WPA + J_WPB + J_WOUT + J_WQ + J_LORA + J_KEYS + J_SHIFT;

__device__ void phase0(const P& p, int bid, int nb, char* smem) {
  for (int it = bid; it < PH0_ITEMS; it += nb) {
    int i = it;
    if (i < J_MOD) { mod_item(p, i, smem); continue; }
    i -= J_MOD;
    if (i < J_WIN) { transpose_tile(p.w_in, 1024, INCOLS, p.w_inT, i, smem); continue; }
    i -= J_WIN;
    if (i < J_WPA) { transpose_tile(p.w_pa, 512, 1024, p.w_paT, i, smem); continue; }
    i -= J_WPA;
    if (i < J_WPB) { transpose_tile(p.w_pb, 1024, 1024, p.w_pbT, i, smem); continue; }
    i -= J_WPB;
    if (i < J_WOUT) { transpose_tile(p.w_out, 1024, 1024, p.w_outT, i, smem); continue; }
    i -= J_WOUT;
    if (i < J_WQ) { transpose_tile(p.peer_wq, 1024, 2048, p.wqT, i, smem); continue; }
    i -= J_WQ;
    if (i < 8) { transpose_tile(p.rw_w2, 64, 512, p.w2T, i, smem); continue; }
    if (i < 16) { transpose_tile(p.rw_a2, 64, 512, p.a2T, i - 8, smem); continue; }
    if (i < 32) { transpose_tile(p.rw_g2, 128, 512, p.g2T, i - 16, smem); continue; }
    i -= J_LORA;
    const float* src; u16* dst;
    if (i < J_KEYS) { src = p.peer_keys + (size_t)i * 2048; dst = p.keysb + (size_t)i * 2048; }
    else { i -= J_KEYS; src = p.state_shift + (size_t)i * 2048; dst = p.xn + (size_t)NT * D + (size_t)i * 2048; }
    const float4* s4 = (const float4*)src + TIDX * 2;
    float4 a = s4[0], b = s4[1];
    uint4 o; o.x = pack2(a.x, a.y); o.y = pack2(a.z, a.w); o.z = pack2(b.x, b.y); o.w = pack2(b.z, b.w);
    *((uint4*)dst + TIDX) = o;
  }
}

template <bool SECOND>
__device__ void phase_norm(const P& p, int bid, int nb) {
  const int lane = TIDX & 63, wid = TIDX >> 6;
  const float* gam = SECOND ? p.norm2_g : p.norm1_g;
  for (int it = bid; it < NT / 8; it += nb) {
    const int nA = it * 8 + wid * 2;
    float4 v[2][4];
#pragma unroll
    for (int k = 0; k < 2; k++) {
      const int n = nA + k;
      const float* xr = SECOND ? p.out + O_Y + (size_t)n * D : xrow(p, n);
#pragma unroll
      for (int i = 0; i < 4; i++) v[k][i] = ((const float4*)xr)[lane + 64 * i];
    }
#pragma unroll
    for (int k = 0; k < 2; k++) {
      const int n = nA + k;
      int seq, t, T; tok2seq(n, seq, t, T);
      const float* md = p.mod + (size_t)seq * 8192 + (SECOND ? 3072 : 0);
      float ss = 0.f;
#pragma unroll
      for (int i = 0; i < 4; i++)
        ss += v[k][i].x * v[k][i].x + v[k][i].y * v[k][i].y + v[k][i].z * v[k][i].z + v[k][i].w * v[k][i].w;
      ss = wave_sum(ss);
      const float rstd = rsqrtf(ss * (1.f / 1024.f) + 1e-6f);
      const bool last = (!SECOND) && (t == T - 1);
      float* so = seq_out(p.out, seq, O_PSHIFT, O_SSHIFT, 1024);
#pragma unroll
      for (int i = 0; i < 4; i++) {
        const int c = (lane + 64 * i) * 4;
        const float4 g = *(const float4*)(gam + c), sh = *(const float4*)(md + c), sc = *(const float4*)(md + 1024 + c);
        float4 o;
        o.x = v[k][i].x * rstd * g.x * (1.f + sc.x) + sh.x;
        o.y = v[k][i].y * rstd * g.y * (1.f + sc.y) + sh.y;
        o.z = v[k][i].z * rstd * g.z * (1.f + sc.z) + sh.z;
        o.w = v[k][i].w * rstd * g.w * (1.f + sc.w) + sh.w;
        uint2 pk; pk.x = pack2(o.x, o.y); pk.y = pack2(o.z, o.w);
        *(uint2*)(p.xn + (size_t)n * D + c) = pk;
        if (last) *(float4*)(so + c) = o;
      }
    }
  }
}

constexpr int P2_NT = 35, P2_MT = 137;
__device__ void phase2(const P& p, int bid, int nb, char* smem) {
  TileIter ti(bid, nb, P2_MT, P2_NT);
  int mt, nt;
  while (ti.next(mt, nt)) {
    f32x4 acc[4][4];
    zero_acc(acc);
    gemm_tile_glds(p.xn, D, mt * 128, p.w_inT, D, nt * 128, D, acc, smem);
    u16* Lt = (u16*)smem;
    ACC_FOREACH({ Lt[row * 136 + col] = f2bf(acc[m][n][j]); })
    tile_out_bf16(smem, p.proj, PCOLS, mt * 128, nt * 128, PCOLS - nt * 128);
  }
}

__device__ void rwkv_lerp_item(const P& p, int item) {
  const int tid = TIDX;
  const int n0 = item * 8;
  int seq, t0, T; tok2seq(n0, seq, t0, T);
  uint4 pcv[7], ppv[7];
#pragma unroll
  for (int i = 0; i < 7; i++) {
    const int idx = tid + i * 256, tok = idx / 224, c = (idx % 224) * 8;
    const int n = n0 + tok, t = t0 + tok;
    pcv[i] = *(const uint4*)(p.proj + (size_t)n * PCOLS + c);
    const size_t prow = t > 0 ? (size_t)(n - 1) : (size_t)(NT + (seq >= 8 ? seq - 8 : 0));
    ppv[i] = *(const uint4*)(p.proj + prow * PCOLS + c);
    if (t == 0 && seq < 8) ppv[i] = make_uint4(0, 0, 0, 0);
  }
#pragma unroll
  for (int i = 0; i < 7; i++) {
    const int idx = tid + i * 256, tok = idx / 224, c = (idx % 224) * 8;
    const int n = n0 + tok;
    const float4 mu0 = *(const float4*)(p.rw_mu + c), mu1 = *(const float4*)(p.rw_mu + c + 4);
    const float mus[8] = {mu0.x, mu0.y, mu0.z, mu0.w, mu1.x, mu1.y, mu1.z, mu1.w};
    const unsigned pcs[4] = {pcv[i].x, pcv[i].y, pcv[i].z, pcv[i].w}, pps[4] = {ppv[i].x, ppv[i].y, ppv[i].z, ppv[i].w};
    unsigned o[4];
#pragma unroll
    for (int e = 0; e < 4; e++) {
      float a0 = bflo(pcs[e]), a1 = bfhi(pcs[e]), b0 = bflo(pps[e]), b1 = bfhi(pps[e]);
      float q0 = a0 + (b0 - a0) * mus[2 * e], q1 = a1 + (b1 - a1) * mus[2 * e + 1];
      if (c >= C_LW && c < C_LA) { q0 = tanhf(q0); q1 = tanhf(q1); }
      else if (c >= C_LG) { q0 = sigmoidf_(q0); q1 = sigmoidf_(q1); }
      o[e] = pack2(q0, q1);
    }
    u16* dst;
    if (c < 512) dst = p.prep + (size_t)n * 3584 + 512 + c;
    else if (c < 1024) dst = p.prep + (size_t)n * 3584 + 1024 + (c - 512);
    else if (c < 1536) dst = p.prep + (size_t)n * 3584 + 2560 + (c - 1024);
    else dst = p.lora + (size_t)n * 256 + (c - 1536);
    *(uint4*)dst = make_uint4(o[0], o[1], o[2], o[3]);
  }
}

__device__ void rwkv_lora_item(const P& p, int mt, int nt, int part, char* smem) {
  const int tid = TIDX, lane = tid & 63, wid = tid >> 6, wr = wid >> 1, wc = wid & 1, fr = lane & 15, fq = lane >> 4;
  const int col0 = nt * 128;
  f32x4 acc[4][4];
  if (part == 0) {
  zero_acc(acc);
  gemm_tile_glds(p.lora, 256, mt * 128, p.w2T, 64, col0, 64, acc, smem);
  ACC_FOREACH({
    const int gc = col0 + col;
    const float wpre = p.rw_w0[gc] + acc[m][n][j];
    const float w = -softplusf_(-wpre) - 0.5f;
    p.prep[(size_t)(mt * 128 + row) * 3584 + gc] = f2bf(-expf(w));
  })
  return;
  }
  if (part == 1) {
  zero_acc(acc);
  gemm_tile_glds(p.lora + 128, 256, mt * 128, p.g2T, 128, col0, 128, acc, smem);
  ACC_FOREACH({ p.prep[(size_t)(mt * 128 + row) * 3584 + 3072 + col0 + col] = f2bf(acc[m][n][j]); })
  return;
  }
  zero_acc(acc);
  gemm_tile_glds(p.lora + 64, 256, mt * 128, p.a2T, 64, col0, 64, acc, smem);
  float a0c[4], kkc[4], kac[4];
#pragma unroll
  for (int n = 0; n < 4; n++) {
    const int gc = col0 + wc * 64 + n * 16 + fr;
    a0c[n] = p.rw_a0[gc]; kkc[n] = p.rw_k_k[gc]; kac[n] = p.rw_k_a[gc];
  }
#pragma unroll
  for (int m = 0; m < 4; m++)
#pragma unroll
    for (int j = 0; j < 4; j++) {
      const int row = mt * 128 + wr * 64 + m * 16 + fq * 4 + j;
      u16* pr = p.prep + (size_t)row * 3584 + col0 + wc * 64 + fr;
      float kx[4], kkv[4], av[4];
      float ss = 0.f;
#pragma unroll
      for (int n = 0; n < 4; n++) {
        kx[n] = bf2f(pr[1024 + n * 16]);
        av[n] = sigmoidf_(a0c[n] + acc[m][n][j]);
        kkv[n] = kx[n] * kkc[n];
        ss += kkv[n] * kkv[n];
      }
      ss = allreduce16(ss);
      const float inv = 1.f / fmaxf(sqrtf(ss), 1e-12f);
#pragma unroll
      for (int n = 0; n < 4; n++) {
        const float kk = kkv[n] * inv;
        pr[1024 + n * 16] = f2bf(kx[n] * (1.f + (av[n] - 1.f) * kac[n]));
        pr[1536 + n * 16] = f2bf(kk);
        pr[2048 + n * 16] = f2bf(kk * av[n]);
      }
    }
}

__device__ void conv_prep_item(const P& p, int item) {
  const int tid = TIDX;
  const int n0 = item * 8;
  int seq, t0, T; tok2seq(n0, seq, t0, T);
  if (tid < 192) {
    const int c = tid * 8;
    uint4 rows[11];
#pragma unroll
    for (int j = 0; j < 11; j++) {
      const int tt = t0 - 3 + j;
      rows[j] = make_uint4(0, 0, 0, 0);
      if (tt >= 0) rows[j] = *(const uint4*)(p.proj + (size_t)(n0 - 3 + j) * PCOLS + C_XBC + c);
      else if (seq >= 8) {
        const float* sc = p.state_conv + ((size_t)(seq - 8) * 3 + (tt + 3)) * 1536 + c;
        const float4 a = *(const float4*)sc, b = *(const float4*)(sc + 4);
        rows[j] = make_uint4(pack2(a.x, a.y), pack2(a.z, a.w), pack2(b.x, b.y), pack2(b.z, b.w));
      }
    }
    float w[4][8], cb[8];
#pragma unroll
    for (int j = 0; j < 4; j++) {
      const float4 a = *(const float4*)(p.conv_w + j * 1536 + c), b = *(const float4*)(p.conv_w + j * 1536 + c + 4);
      w[j][0] = a.x; w[j][1] = a.y; w[j][2] = a.z; w[j][3] = a.w; w[j][4] = b.x; w[j][5] = b.y; w[j][6] = b.z; w[j][7] = b.w;
    }
    {
      const float4 a = *(const float4*)(p.conv_b + c), b = *(const float4*)(p.conv_b + c + 4);
      cb[0] = a.x; cb[1] = a.y; cb[2] = a.z; cb[3] = a.w; cb[4] = b.x; cb[5] = b.y; cb[6] = b.z; cb[7] = b.w;
    }
#pragma unroll
    for (int k = 0; k < 8; k++) {
      float o[8];
#pragma unroll
      for (int e = 0; e < 8; e++) o[e] = cb[e];
#pragma unroll
      for (int j = 0; j < 4; j++) {
        const uint4 r = rows[k + j];
        const unsigned rs[4] = {r.x, r.y, r.z, r.w};
#pragma unroll
        for (int e = 0; e < 4; e++) { o[2 * e] += bflo(rs[e]) * w[j][2 * e]; o[2 * e + 1] += bfhi(rs[e]) * w[j][2 * e + 1]; }
      }
      *(uint4*)(p.xc + (size_t)(n0 + k) * 1536 + c) =
          make_uint4(pack2(siluf_(o[0]), siluf_(o[1])), pack2(siluf_(o[2]), siluf_(o[3])), pack2(siluf_(o[4]), siluf_(o[5])),
                     pack2(siluf_(o[6]), siluf_(o[7])));
    }
    if (t0 + 8 == T) {
      float* co = seq_out(p.out, seq, O_PCONV, O_SCONV, 3 * 1536);
#pragma unroll
      for (int j = 0; j < 3; j++) {
        const uint4 r = rows[8 + j];
        *(float4*)(co + j * 1536 + c) = make_float4(bflo(r.x), bfhi(r.x), bflo(r.y), bfhi(r.y));
        *(float4*)(co + j * 1536 + c + 4) = make_float4(bflo(r.z), bfhi(r.z), bflo(r.w), bfhi(r.w));
      }
    }
  } else if (tid < 192 + 32) {
    const int i = tid - 192;
#pragma unroll
    for (int e = 0; e < 4; e++) {
      const int pi = i * 4 + e, k = pi >> 4, h = pi & 15, n = n0 + k;
      const float raw = bf2f(p.proj[(size_t)n * PCOLS + C_DT + h]) + p.dt_bias[h];
      const float dt = softplusf_(raw);
      const float dA = -dt * expf(p.A_log[h]);
      p.dtb[n * 16 + h] = dt;
      p.decb[n * 16 + h] = dA;
    }
  }
}

__device__ void phase3(const P& p, int bid, int nb, char* smem) {
  for (int it = bid; it < 2 * (NT / 8); it += nb) {
    if (it < NT / 8) rwkv_lerp_item(p, it);
    else conv_prep_item(p, it - NT / 8);
  }
}
__device__ void phase3b(const P& p, int bid, int nb, char* smem) {
  for (int it = bid; it < 136 * 4 * 3; it += nb) { const int tl = it / 3; rwkv_lora_item(p, tl >> 2, tl & 3, it - tl * 3, smem); }
}

constexpr int TC = 32;
__device__ __forceinline__ void bf8_to_f(uint4 u, float4& lo, float4& hi) {
  lo = make_float4(bflo(u.x), bfhi(u.x), bflo(u.y), bfhi(u.y));
  hi = make_float4(bflo(u.z), bfhi(u.z), bflo(u.w), bfhi(u.w));
}
__device__ void rwkv_scan_item(const P& p, int seq, int h, int qr, char* smem) {
  const int T = seq < 8 ? 2048 : 8, nbase = seq < 8 ? seq * 2048 : NP + (seq - 8) * 8;
  float* Ld = (float*)smem;
  float* Lr = Ld + TC * 64; float* Lk = Lr + TC * 64; float* Lkk = Lk + TC * 64; float* Lb = Lkk + TC * 64;
  float* Lv = Lb + TC * 64;
  const int tid = TIDX, w = tid >> 6, lane = tid & 63, rl = w * 4 + (lane >> 4), ks = lane & 15;
  const int v = qr * 16 + rl;
  float S0 = 0.f, S1 = 0.f, S2 = 0.f, S3 = 0.f;
  if (seq >= 8) {
    float4 s = *(const float4*)(p.state_wkv + (((size_t)(seq - 8) * 8 + h) * 64 + v) * 64 + ks * 4);
    S0 = s.x; S1 = s.y; S2 = s.z; S3 = s.w;
  }
  const int st = tid >> 3, sk8 = (tid & 7) * 8;
  const int vt = tid >> 1, vr8 = (tid & 1) * 8;
  uint4 g0, g1, g2, g3, g4, gv;
  g0 = g1 = g2 = g3 = g4 = gv = make_uint4(0, 0, 0, 0);
#define RW_GLOAD(c0_)                                                                           \
  {                                                                                             \
    const int tcn = min(TC, T - (c0_));                                                         \
    if (st < tcn) {                                                                             \
      const u16* base = p.prep + (size_t)(nbase + (c0_) + st) * 3584 + h * 64 + sk8;            \
      g0 = *(const uint4*)(base); g1 = *(const uint4*)(base + 512); g2 = *(const uint4*)(base + 1024); \
      g3 = *(const uint4*)(base + 1536); g4 = *(const uint4*)(base + 2048);                     \
    }                                                                                           \
    if (tid < 64 && vt < tcn)                                                                   \
      gv = *(const uint4*)(p.prep + (size_t)(nbase + (c0_) + vt) * 3584 + 2560 + h * 64 + qr * 16 + vr8); \
  }
  RW_GLOAD(0);
  for (int c0 = 0; c0 < T; c0 += TC) {
    const int tc = min(TC, T - c0);
    __syncthreads();
    {
      float4 lo, hi;
      bf8_to_f(g0, lo, hi);
      lo.x = __expf(lo.x); lo.y = __expf(lo.y); lo.z = __expf(lo.z); lo.w = __expf(lo.w);
      hi.x = __expf(hi.x); hi.y = __expf(hi.y); hi.z = __expf(hi.z); hi.w = __expf(hi.w);
      *(float4*)(Ld + st * 64 + sk8) = lo; *(float4*)(Ld + st * 64 + sk8 + 4) = hi;
      bf8_to_f(g1, lo, hi); *(float4*)(Lr + st * 64 + sk8) = lo; *(float4*)(Lr + st * 64 + sk8 + 4) = hi;
      bf8_to_f(g2, lo, hi); *(float4*)(Lk + st * 64 + sk8) = lo; *(float4*)(Lk + st * 64 + sk8 + 4) = hi;
      bf8_to_f(g3, lo, hi); *(float4*)(Lkk + st * 64 + sk8) = lo; *(float4*)(Lkk + st * 64 + sk8 + 4) = hi;
      bf8_to_f(g4, lo, hi); *(float4*)(Lb + st * 64 + sk8) = lo; *(float4*)(Lb + st * 64 + sk8 + 4) = hi;
      if (tid < 64) { bf8_to_f(gv, lo, hi); *(float4*)(Lv + vt * 16 + vr8) = lo; *(float4*)(Lv + vt * 16 + vr8 + 4) = hi; }
    }
    __syncthreads();
    if (c0 + TC < T) RW_GLOAD(c0 + TC);
    u16* yo = p.proj + (size_t)(nbase + c0) * PCOLS + h * 64 + v;
    float4 kk0, d0, b0, k0_, r0, kk1, d1, b1, k1_, r1, kk2, d2, b2, k2_, r2, kk3, d3, b3, k3_, r3;
    float v0, v1, v2, v3;
#define RW_LD(KK, DD, BB, KX, RR, VV, t_)                                                        \
  {                                                                                              \
    KK = *(const float4*)(Lkk + (t_) * 64 + ks * 4); DD = *(const float4*)(Ld + (t_) * 64 + ks * 4); \
    BB = *(const float4*)(Lb + (t_) * 64 + ks * 4); KX = *(const float4*)(Lk + (t_) * 64 + ks * 4);  \
    RR = *(const float4*)(Lr + (t_) * 64 + ks * 4); VV = Lv[(t_) * 16 + rl];                      \
  }
#define RW_STEP(KK, DD, BB, KX, RR, VV, YY)                                                      \
  {                                                                                              \
    const float vk0 = VV * KX.x, vk1 = VV * KX.y, vk2 = VV * KX.z, vk3 = VV * KX.w;              \
    float sk = (S0 * KK.x + S1 * KK.y) + (S2 * KK.z + S3 * KK.w);                                \
    sk = allreduce16(sk);                                                                        \
    S0 = S0 * DD.x + (vk0 - sk * BB.x);                                                          \
    S1 = S1 * DD.y + (vk1 - sk * BB.y);                                                          \
    S2 = S2 * DD.z + (vk2 - sk * BB.z);                                                          \
    S3 = S3 * DD.w + (vk3 - sk * BB.w);                                                          \
    YY = allreduce16((S0 * RR.x + S1 * RR.y) + (S2 * RR.z + S3 * RR.w));                         \
  }
    for (int tt = 0; tt < tc; tt += 4) {
      RW_LD(kk0, d0, b0, k0_, r0, v0, tt)
      RW_LD(kk1, d1, b1, k1_, r1, v1, tt + 1)
      RW_LD(kk2, d2, b2, k2_, r2, v2, tt + 2)
      RW_LD(kk3, d3, b3, k3_, r3, v3, tt + 3)
      float y0, y1, y2, y3;
      RW_STEP(kk0, d0, b0, k0_, r0, v0, y0)
      RW_STEP(kk1, d1, b1, k1_, r1, v1, y1)
      RW_STEP(kk2, d2, b2, k2_, r2, v2, y2)
      RW_STEP(kk3, d3, b3, k3_, r3, v3, y3)
      if (ks == 0) {
        u16* yp = yo + (size_t)tt * PCOLS;
        yp[0] = f2bf(y0); yp[PCOLS] = f2bf(y1); yp[2 * (size_t)PCOLS] = f2bf(y2); yp[3 * (size_t)PCOLS] = f2bf(y3);
      }
    }
  }
  float* so = seq_out(p.out, seq, O_PWKV, O_SWKV, 8 * 4096);
  *(float4*)(so + ((size_t)h * 64 + v) * 64 + ks * 4) = make_float4(S0, S1, S2, S3);
}

__device__ void ssm_scan_item(const P& p, int seq, int head, int half, char* smem) {
  const int T = seq < 8 ? 2048 : 8, nbase = seq < 8 ? seq * 2048 : NP + (seq - 8) * 8;
  float* LB = (float*)smem;
  float* LC = LB + TC * 128;
  float* Lx = LC + TC * 128;
  float* Ldt = Lx + TC * 32;
  float* Ldec = Ldt + TC;
  const int tid = TIDX, pl = tid >> 3, ns = tid & 7;
  const int pp = half * 32 + pl, g = head >> 3;
  const float Dk = p.D_skip[head];
  float hs[16];
#pragma unroll
  for (int j = 0; j < 16; j++) hs[j] = 0.f;
  if (seq >= 8) {
    const float4* s4 = (const float4*)(p.state_ssm + (((size_t)(seq - 8) * 16 + head) * 64 + pp) * 128 + ns * 16);
#pragma unroll
    for (int j = 0; j < 4; j++) { float4 s = s4[j]; hs[4 * j] = s.x; hs[4 * j + 1] = s.y; hs[4 * j + 2] = s.z; hs[4 * j + 3] = s.w; }
  }
  uint4 gb0, gb1, gb2, gb3, gx; float gdt = 0.f, gdec = 0.f;
  gb0 = gb1 = gb2 = gb3 = gx = make_uint4(0, 0, 0, 0);
  const int bt = tid >> 5, bch = tid & 31;
  const u16* bsrc = p.xc + 1024 + (bch < 16 ? 0 : 256) + g * 128 + (bch & 15) * 8;
  const int xt = tid >> 2, xr8 = (tid & 3) * 8;
#define SS_GLOAD(c0_)                                                                          \
  {                                                                                            \
    const int tcn = min(TC, T - (c0_));                                                        \
    const size_t nb_ = (size_t)(nbase + (c0_));                                                \
    if (bt < tcn) gb0 = *(const uint4*)(bsrc + (nb_ + bt) * 1536);                             \
    if (bt + 8 < tcn) gb1 = *(const uint4*)(bsrc + (nb_ + bt + 8) * 1536);                     \
    if (bt + 16 < tcn) gb2 = *(const uint4*)(bsrc + (nb_ + bt + 16) * 1536);                   \
    if (bt + 24 < tcn) gb3 = *(const uint4*)(bsrc + (nb_ + bt + 24) * 1536);                   \
    if (tid < 128 && xt < tcn) gx = *(const uint4*)(p.xc + (nb_ + xt) * 1536 + head * 64 + half * 32 + xr8); \
    if (tid < tcn) { gdt = p.dtb[(nb_ + tid) * 16 + head]; gdec = p.decb[(nb_ + tid) * 16 + head]; } \
  }
  SS_GLOAD(0);
  for (int c0 = 0; c0 < T; c0 += TC) {
    const int tc = min(TC, T - c0);
    __syncthreads();
    {
      float* dstb = (bch < 16 ? LB : LC) + (bch & 15) * 8;
      float4 lo, hi;
      bf8_to_f(gb0, lo, hi); *(float4*)(dstb + bt * 128) = lo; *(float4*)(dstb + bt * 128 + 4) = hi;
      bf8_to_f(gb1, lo, hi); *(float4*)(dstb + (bt + 8) * 128) = lo; *(float4*)(dstb + (bt + 8) * 128 + 4) = hi;
      bf8_to_f(gb2, lo, hi); *(float4*)(dstb + (bt + 16) * 128) = lo; *(float4*)(dstb + (bt + 16) * 128 + 4) = hi;
      bf8_to_f(gb3, lo, hi); *(float4*)(dstb + (bt + 24) * 128) = lo; *(float4*)(dstb + (bt + 24) * 128 + 4) = hi;
      if (tid < 128) { bf8_to_f(gx, lo, hi); *(float4*)(Lx + xt * 32 + xr8) = lo; *(float4*)(Lx + xt * 32 + xr8 + 4) = hi; }
      if (tid < TC) { Ldt[tid] = gdt; Ldec[tid] = __expf(gdec); }
    }
    __syncthreads();
    if (c0 + TC < T) SS_GLOAD(c0 + TC);
    u16* yo = p.proj + (size_t)(nbase + c0) * PCOLS + C_XBC + head * 64 + pp;
    float4 B0 = *(const float4*)(LB + ns * 16), B1 = *(const float4*)(LB + ns * 16 + 4), B2 = *(const float4*)(LB + ns * 16 + 8),
           B3 = *(const float4*)(LB + ns * 16 + 12);
    float4 C0 = *(const float4*)(LC + ns * 16), C1 = *(const float4*)(LC + ns * 16 + 4), C2 = *(const float4*)(LC + ns * 16 + 8),
           C3 = *(const float4*)(LC + ns * 16 + 12);
    float xv = Lx[pl], dtv = Ldt[0], dec = Ldec[0];
    for (int tt = 0; tt < tc; tt++) {
      const int tn = min(tt + 1, tc - 1);
      const float* nB = LB + tn * 128 + ns * 16;
      const float* nC = LC + tn * 128 + ns * 16;
      const float4 nB0 = *(const float4*)(nB), nB1 = *(const float4*)(nB + 4), nB2 = *(const float4*)(nB + 8), nB3 = *(const float4*)(nB + 12);
      const float4 nC0 = *(const float4*)(nC), nC1 = *(const float4*)(nC + 4), nC2 = *(const float4*)(nC + 8), nC3 = *(const float4*)(nC + 12);
      const float nxv = Lx[tn * 32 + pl], ndt = Ldt[tn], ndec = Ldec[tn];
      const float dtx = dtv * xv;
      hs[0] = hs[0] * dec + dtx * B0.x; hs[1] = hs[1] * dec + dtx * B0.y; hs[2] = hs[2] * dec + dtx * B0.z; hs[3] = hs[3] * dec + dtx * B0.w;
      hs[4] = hs[4] * dec + dtx * B1.x; hs[5] = hs[5] * dec + dtx * B1.y; hs[6] = hs[6] * dec + dtx * B1.z; hs[7] = hs[7] * dec + dtx * B1.w;
      hs[8] = hs[8] * dec + dtx * B2.x; hs[9] = hs[9] * dec + dtx * B2.y; hs[10] = hs[10] * dec + dtx * B2.z; hs[11] = hs[11] * dec + dtx * B2.w;
      hs[12] = hs[12] * dec + dtx * B3.x; hs[13] = hs[13] * dec + dtx * B3.y; hs[14] = hs[14] * dec + dtx * B3.z; hs[15] = hs[15] * dec + dtx * B3.w;
      float y0 = hs[0] * C0.x + hs[1] * C0.y + hs[2] * C0.z + hs[3] * C0.w;
      float y1 = hs[4] * C1.x + hs[5] * C1.y + hs[6] * C1.z + hs[7] * C1.w;
      float y2 = hs[8] * C2.x + hs[9] * C2.y + hs[10] * C2.z + hs[11] * C2.w;
      float y3 = hs[12] * C3.x + hs[13] * C3.y + hs[14] * C3.z + hs[15] * C3.w;
      float yp = allreduce8((y0 + y1) + (y2 + y3));
      if (ns == 0) yo[(size_t)tt * PCOLS] = f2bf(yp + Dk * xv);
      B0 = nB0; B1 = nB1; B2 = nB2; B3 = nB3; C0 = nC0; C1 = nC1; C2 = nC2; C3 = nC3; xv = nxv; dtv = ndt; dec = ndec;
    }
  }
  float* so = seq_out(p.out, seq, O_PSSM, O_SSSM, 16 * 8192);
  float4* o4 = (float4*)(so + ((size_t)head * 64 + pp) * 128 + ns * 16);
#pragma unroll
  for (int j = 0; j < 4; j++) o4[j] = make_float4(hs[4 * j], hs[4 * j + 1], hs[4 * j + 2], hs[4 * j + 3]);
}

__device__ void ssd_prompt_item(const P& p, int seq, int head, char* smem) {
  const int nbase = seq * 2048, g = head >> 3;
  char* sC = smem;
  char* sB = smem + 17408;
  char* sBT = smem + 34816;
  char* sXT = smem + 53248;
  char* sH = smem + 62464;
  float* sS = (float*)(smem + 79872);
  const int tid = TIDX, lane = tid & 63, w = tid >> 6, fr = lane & 15, q = lane >> 4;
  const float Dk = p.D_skip[head];
  f32x4 H[8];
#pragma unroll
  for (int i = 0; i < 8; i++) H[i] = f32x4{0.f, 0.f, 0.f, 0.f};
  __syncthreads();
  for (int i = tid; i < 17408 / 16; i += 256) *(uint4*)(sH + i * 16) = make_uint4(0, 0, 0, 0);
  uint4 gB0, gB1, gB2, gB3, gC0, gC1, gC2, gC3, gX0, gX1;
  float gdt, gdA;
#define SSD_LOAD(t0_)                                                                         \
  {                                                                                           \
    const size_t nn_ = (size_t)(nbase + (t0_) + lane);                                        \
    const u16* row_ = p.xc + nn_ * 1536;                                                      \
    const u16* rb_ = row_ + 1024 + g * 128 + w * 32;                                          \
    gB0 = *(const uint4*)(rb_); gB1 = *(const uint4*)(rb_ + 8); gB2 = *(const uint4*)(rb_ + 16); gB3 = *(const uint4*)(rb_ + 24); \
    gC0 = *(const uint4*)(rb_ + 256); gC1 = *(const uint4*)(rb_ + 264); gC2 = *(const uint4*)(rb_ + 272); gC3 = *(const uint4*)(rb_ + 280); \
    gX0 = *(const uint4*)(row_ + head * 64 + w * 16); gX1 = *(const uint4*)(row_ + head * 64 + w * 16 + 8); \
    gdt = p.dtb[nn_ * 16 + head]; gdA = p.decb[nn_ * 16 + head];                              \
  }
#define SSD_PUT_T(dst_, r0_, u_, sc_)                                                         \
  {                                                                                           \
    const unsigned us_[4] = {u_.x, u_.y, u_.z, u_.w};                                         \
    _Pragma("unroll") for (int e = 0; e < 4; e++) {                                           \
      *(u16*)(dst_ + ((r0_) + 2 * e) * 144 + lane * 2) = f2bf(bflo(us_[e]) * (sc_));          \
      *(u16*)(dst_ + ((r0_) + 2 * e + 1) * 144 + lane * 2) = f2bf(bfhi(us_[e]) * (sc_));      \
    }                                                                                         \
  }
  SSD_LOAD(0);
#pragma unroll 1
  for (int c = 0; c < 32; c++) {
    const int t0 = c * 64;
    float cs = gdA;
#pragma unroll
    for (int o = 1; o < 64; o <<= 1) { const float v = __shfl_up(cs, o, 64); if (lane >= o) cs += v; }
    const float cs63 = __shfl(cs, 63, 64);
    const float wt = gdt * __expf(cs63 - cs);
    __syncthreads();
    if (w == 0) { sS[lane] = cs; sS[64 + lane] = __expf(cs); sS[128 + lane] = gdt; }
    {
      char* rc = sC + lane * 272 + w * 64;
      char* rb = sB + lane * 272 + w * 64;
      *(uint4*)(rc) = gC0; *(uint4*)(rc + 16) = gC1; *(uint4*)(rc + 32) = gC2; *(uint4*)(rc + 48) = gC3;
      *(uint4*)(rb) = gB0; *(uint4*)(rb + 16) = gB1; *(uint4*)(rb + 32) = gB2; *(uint4*)(rb + 48) = gB3;
      SSD_PUT_T(sBT, w * 32, gB0, wt) SSD_PUT_T(sBT, w * 32 + 8, gB1, wt) SSD_PUT_T(sBT, w * 32 + 16, gB2, wt)
      SSD_PUT_T(sBT, w * 32 + 24, gB3, wt) SSD_PUT_T(sXT, w * 16, gX0, 1.f) SSD_PUT_T(sXT, w * 16 + 8, gX1, 1.f)
    }
    __syncthreads();
    if (c + 1 < 32) SSD_LOAD(t0 + 64);
    f32x4 cb[4], yo[4];
#pragma unroll
    for (int i = 0; i < 4; i++) { cb[i] = f32x4{0.f, 0.f, 0.f, 0.f}; yo[i] = f32x4{0.f, 0.f, 0.f, 0.f}; }
    {
      bf16x8 af[4];
#pragma unroll
      for (int ks = 0; ks < 4; ks++) af[ks] = *(const bf16x8*)(sC + (16 * w + fr) * 272 + ks * 64 + q * 16);
#pragma unroll
      for (int nn = 0; nn < 4; nn++)
#pragma unroll
        for (int ks = 0; ks < 4; ks++) {
          const bf16x8 bb = *(const bf16x8*)(sB + (16 * nn + fr) * 272 + ks * 64 + q * 16);
          cb[nn] = __builtin_amdgcn_mfma_f32_16x16x32_bf16(af[ks], bb, cb[nn], 0, 0, 0);
        }
#pragma unroll
      for (int pt = 0; pt < 4; pt++)
#pragma unroll
        for (int ks = 0; ks < 4; ks++) {
          const bf16x8 bb = *(const bf16x8*)(sH + (16 * pt + fr) * 272 + ks * 64 + q * 16);
          yo[pt] = __builtin_amdgcn_mfma_f32_16x16x32_bf16(af[ks], bb, yo[pt], 0, 0, 0);
        }
    }
    __syncthreads();
#pragma unroll
    for (int j = 0; j < 4; j++) {
      const int l = 16 * w + q * 4 + j;
      const float csl = sS[l];
#pragma unroll
      for (int nn = 0; nn < 4; nn++) {
        const int sidx = 16 * nn + fr;
        const float gv = (sidx <= l) ? cb[nn][j] * __expf(csl - sS[sidx]) * sS[128 + sidx] : 0.f;
        *(u16*)(sB + l * 144 + sidx * 2) = f2bf(gv);
      }
    }
    f32x4 yd[4];
#pragma unroll
    for (int i = 0; i < 4; i++) yd[i] = f32x4{0.f, 0.f, 0.f, 0.f};
#pragma unroll
    for (int ks = 0; ks < 2; ks++) {
      const bf16x8 aa = *(const bf16x8*)(sB + (16 * w + fr) * 144 + ks * 64 + q * 16);
#pragma unroll
      for (int pt = 0; pt < 4; pt++) {
        const bf16x8 bb = *(const bf16x8*)(sXT + (16 * pt + fr) * 144 + ks * 64 + q * 16);
        yd[pt] = __builtin_amdgcn_mfma_f32_16x16x32_bf16(aa, bb, yd[pt], 0, 0, 0);
      }
    }
#pragma unroll
    for (int j = 0; j < 4; j++) {
      const int l = 16 * w + q * 4 + j;
      const float el = sS[64 + l];
      u16* yrow = p.proj + (size_t)(nbase + t0 + l) * PCOLS + C_XBC + head * 64 + fr;
#pragma unroll
      for (int pt = 0; pt < 4; pt++) {
        const float xs = bf2f(*(const u16*)(sXT + (16 * pt + fr) * 144 + l * 2));
        yrow[16 * pt] = f2bf(yd[pt][j] + el * yo[pt][j] + Dk * xs);
      }
    }
    const float ach = __expf(cs63);
#pragma unroll
    for (int nt = 0; nt < 8; nt++) { H[nt][0] *= ach; H[nt][1] *= ach; H[nt][2] *= ach; H[nt][3] *= ach; }
#pragma unroll
    for (int ks = 0; ks < 2; ks++) {
      const bf16x8 aa = *(const bf16x8*)(sXT + (16 * w + fr) * 144 + ks * 64 + q * 16);
#pragma unroll
      for (int nt = 0; nt < 8; nt++) {
        const bf16x8 bb = *(const bf16x8*)(sBT + (16 * nt + fr) * 144 + ks * 64 + q * 16);
        H[nt] = __builtin_amdgcn_mfma_f32_16x16x32_bf16(aa, bb, H[nt], 0, 0, 0);
      }
    }
#pragma unroll
    for (int nt = 0; nt < 8; nt++)
#pragma unroll
      for (int j = 0; j < 4; j++) *(u16*)(sH + (16 * w + q * 4 + j) * 272 + (16 * nt + fr) * 2) = f2bf(H[nt][j]);
  }
  float* so = p.out + O_PSSM + ((size_t)seq * 16 + head) * 8192;
#pragma unroll
  for (int nt = 0; nt < 8; nt++)
#pragma unroll
    for (int j = 0; j < 4; j++) so[(16 * w + q * 4 + j) * 128 + 16 * nt + fr] = H[nt][j];
  __syncthreads();
}

constexpr int P4_RP = 256, P4_SP = 128, P4_RS = 4096, P4_SS = 4096;
#define XB_QUEUE 3600
__device__ void phase4(const P& p, int bid, int nb, char* smem) {
  for (int it = bid; it < P4_RP + P4_SP; it += nb) {
    if (it < P4_RP) rwkv_scan_item(p, it >> 5, (it >> 2) & 7, it & 3, smem);
    else { const int i = it - P4_RP; ssd_prompt_item(p, i >> 4, i & 15, smem); }
  }
  volatile int* slot = (volatile int*)(smem + LDS_BYTES - 32);
  for (;;) {
    __syncthreads();
    if (TIDX == 0) *slot = (int)atomicAdd(&p.bar[XB_QUEUE], 1u);
    __syncthreads();
    int i = *slot;
    if (i >= P4_RS + P4_SS) break;
    if (i < P4_RS) rwkv_scan_item(p, 8 + (i >> 5), (i >> 2) & 7, i & 3, smem);
    else { i -= P4_RS; ssm_scan_item(p, 8 + (i >> 5), (i >> 1) & 15, i & 1, smem); }
  }
}

__device__ void phase5(const P& p, int bid, int nb) {
  const int lane = TIDX & 63, wid = TIDX >> 6;
  for (int it = bid; it < NT / 4; it += nb) {
    const int n = it * 4 + wid;
    const uint4 sy0 = *(const uint4*)(p.proj + (size_t)n * PCOLS + C_XBC + lane * 16);
    const uint4 sy1 = *(const uint4*)(p.proj + (size_t)n * PCOLS + C_XBC + lane * 16 + 8);
    const uint4 sz0 = *(const uint4*)(p.proj + (size_t)n * PCOLS + C_Z + lane * 16);
    const uint4 sz1 = *(const uint4*)(p.proj + (size_t)n * PCOLS + C_Z + lane * 16 + 8);
    {
      const int c = lane * 8;
      uint4 yu = *(const uint4*)(p.proj + (size_t)n * PCOLS + c);
      const u16* pr = p.prep + (size_t)n * 3584 + c;
      uint4 ru = *(const uint4*)(pr + 512), ku = *(const uint4*)(pr + 1024), vu = *(const uint4*)(pr + 2560),
            gu = *(const uint4*)(pr + 3072);
      unsigned ys[4] = {yu.x, yu.y, yu.z, yu.w}, rs[4] = {ru.x, ru.y, ru.z, ru.w}, ks_[4] = {ku.x, ku.y, ku.z, ku.w},
               vs[4] = {vu.x, vu.y, vu.z, vu.w}, gs[4] = {gu.x, gu.y, gu.z, gu.w};
      float y[8], r[8], k[8], v[8], g[8];
#pragma unroll
      for (int e = 0; e < 4; e++) {
        y[2 * e] = bflo(ys[e]); y[2 * e + 1] = bfhi(ys[e]);
        r[2 * e] = bflo(rs[e]); r[2 * e + 1] = bfhi(rs[e]);
        k[2 * e] = bflo(ks_[e]); k[2 * e + 1] = bfhi(ks_[e]);
        v[2 * e] = bflo(vs[e]); v[2 * e + 1] = bfhi(vs[e]);
        g[2 * e] = bflo(gs[e]); g[2 * e + 1] = bfhi(gs[e]);
      }
      float s = 0.f, bn = 0.f;
#pragma unroll
      for (int e = 0; e < 8; e++) { s += y[e]; bn += r[e] * k[e] * p.rw_r_k[c + e]; }
      s = allreduce8(s); bn = allreduce8(bn);
      const float mean = s * (1.f / 64.f);
      float vr = 0.f;
#pragma unroll
      for (int e = 0; e < 8; e++) { const float d = y[e] - mean; vr += d * d; }
      vr = allreduce8(vr) * (1.f / 64.f);
      const float rs_ = rsqrtf(vr + 64e-5f);
      float o[8];
#pragma unroll
      for (int e = 0; e < 8; e++) {
        const float yn = (y[e] - mean) * rs_ * p.rw_ln_w[c + e] + p.rw_ln_b[c + e];
        o[e] = (yn + bn * v[e]) * g[e];
      }
      uint4 ou; ou.x = pack2(o[0], o[1]); ou.y = pack2(o[2], o[3]); ou.z = pack2(o[4], o[5]); ou.w = pack2(o[6], o[7]);
      *(uint4*)(p.oa + (size_t)n * 512 + c) = ou;
    }
    {
      const int c = lane * 16;
      float yv[16];
      float ss = 0.f;
#pragma unroll
      for (int hh = 0; hh < 2; hh++) {
        const uint4 yu = hh ? sy1 : sy0;
        const uint4 zu = hh ? sz1 : sz0;
        unsigned ys[4] = {yu.x, yu.y, yu.z, yu.w}, zs[4] = {zu.x, zu.y, zu.z, zu.w};
#pragma unroll
        for (int e = 0; e < 4; e++) {
          const float a = bflo(ys[e]) * siluf_(bflo(zs[e])), b = bfhi(ys[e]) * siluf_(bfhi(zs[e]));
          yv[hh * 8 + 2 * e] = a; yv[hh * 8 + 2 * e + 1] = b;
          ss += a * a + b * b;
        }
      }
#pragma unroll
      for (int o = 16; o >= 1; o >>= 1) ss += __shfl_xor(ss, o, 64);
      const float rstd = rsqrtf(ss * (1.f / 512.f) + 1e-6f);
      unsigned ou[8];
#pragma unroll
      for (int e = 0; e < 8; e++)
        ou[e] = pack2(yv[2 * e] * rstd * p.ssm_norm_w[c + 2 * e], yv[2 * e + 1] * rstd * p.ssm_norm_w[c + 2 * e + 1]);
      *(uint4*)(p.ob + (size_t)n * 1024 + c) = make_uint4(ou[0], ou[1], ou[2], ou[3]);
      *(uint4*)(p.ob + (size_t)n * 1024 + c + 8) = make_uint4(ou[4], ou[5], ou[6], ou[7]);
    }
  }
}

__device__ void phase6(const P& p, int bid, int nb, char* smem) {
  TileIter ti(bid, nb, 136, 8);
  int mt, nt;
  while (ti.next(mt, nt)) {
    f32x4 ac[4][4];
    unsigned sg[4][4][2];
    u16* Lt = (u16*)smem;
    zero_acc(ac);
    gemm_tile_glds(p.xn, D, mt * 128, p.w_inT + (size_t)G_A * D, D, nt * 128, D, ac, smem);
#pragma unroll
    for (int m = 0; m < 4; m++)
#pragma unroll
      for (int n = 0; n < 4; n++) {
        sg[m][n][0] = pack2(sigmoidf_(ac[m][n][0]), sigmoidf_(ac[m][n][1]));
        sg[m][n][1] = pack2(sigmoidf_(ac[m][n][2]), sigmoidf_(ac[m][n][3]));
      }
    zero_acc(ac);
    gemm_tile_glds(p.oa, 512, mt * 128, p.w_paT, 512, nt * 128, 512, ac, smem);
    ACC_FOREACH({
      const unsigned gu = sg[m][n][j >> 1];
      Lt[row * 136 + col] = f2bf(((j & 1) ? bfhi(gu) : bflo(gu)) * ac[m][n][j]);
    })
    tile_out_bf16(smem, p.merged, D, mt * 128, nt * 128, 128);
    zero_acc(ac);
    gemm_tile_glds(p.xn, D, mt * 128, p.w_inT + (size_t)G_B * D, D, nt * 128, D, ac, smem);
#pragma unroll
    for (int m = 0; m < 4; m++)
#pragma unroll
      for (int n = 0; n < 4; n++) {
        sg[m][n][0] = pack2(sigmoidf_(ac[m][n][0]), sigmoidf_(ac[m][n][1]));
        sg[m][n][1] = pack2(sigmoidf_(ac[m][n][2]), sigmoidf_(ac[m][n][3]));
      }
    zero_acc(ac);
    gemm_tile_glds(p.ob, D, mt * 128, p.w_pbT, D, nt * 128, D, ac, smem);
    ACC_FOREACH({
      const unsigned gu = sg[m][n][j >> 1];
      Lt[row * 136 + col] = f2bf(((j & 1) ? bfhi(gu) : bflo(gu)) * ac[m][n][j]);
    })
    __syncthreads();
    {
      const int tid = TIDX;
#pragma unroll
      for (int i = 0; i < 8; i++) {
        const int id = tid + i * 256, row = id >> 4, ch = id & 15;
        u16* gp = p.merged + (size_t)(mt * 128 + row) * D + nt * 128 + ch * 8;
        const uint4 a = *(const uint4*)gp, b = *(const uint4*)(smem + row * 272 + ch * 16);
        uint4 o;
        o.x = pack2(bflo(a.x) + bflo(b.x), bfhi(a.x) + bfhi(b.x));
        o.y = pack2(bflo(a.y) + bflo(b.y), bfhi(a.y) + bfhi(b.y));
        o.z = pack2(bflo(a.z) + bflo(b.z), bfhi(a.z) + bfhi(b.z));
        o.w = pack2(bflo(a.w) + bflo(b.w), bfhi(a.w) + bfhi(b.w));
        *(uint4*)gp = o;
      }
    }
  }
}

constexpr int P7_G = 136 * 8, P7_CV = 16384;
constexpr float U_SCALE = 256.f, V_SCALE = 32.f;
__device__ void phase7(const P& p, int bid, int nb, char* smem) {
  {
    TileIter ti(bid, nb, 136, 8);
    int mt, nt;
    while (ti.next(mt, nt)) {
      f32x4 acc[4][4];
      zero_acc(acc);
      gemm_tile_glds(p.merged, D, mt * 128, p.w_outT, D, nt * 128, D, acc, smem);
      float* Lf = (float*)smem;
      ACC_FOREACH({ Lf[row * 132 + col] = acc[m][n][j]; })
      __syncthreads();
      {
        const int tid = TIDX;
#pragma unroll 4
        for (int i = 0; i < 16; i++) {
          const int id = tid + i * 256, row = id >> 5, c4 = (id & 31) * 4;
          const int nn = mt * 128 + row, c = nt * 128 + c4;
          int seq, t, T; tok2seq(nn, seq, t, T);
          const float4 a = *(const float4*)(Lf + row * 132 + c4);
          const float4 g = *(const float4*)(p.mod + (size_t)seq * 8192 + 2048 + c);
          const float4 x = *(const float4*)(xrow(p, nn) + c);
          *(float4*)(p.out + O_Y + (size_t)nn * D + c) = make_float4(x.x + g.x * a.x, x.y + g.y * a.y, x.z + g.z * a.z, x.w + g.w * a.w);
        }
      }
    }
  }
  int cw = bid, cn = nb;
  if (nb == 512) { const int lb = bid >> 3; if (lb < 8) return; cw = (bid & 7) * 56 + (lb - 8); cn = 448; }
  for (int it0 = cw; it0 < P7_CV; it0 += 4 * cn) {
    const int tid = TIDX;
    float4 va[4], vb[4];
#pragma unroll
    for (int r = 0; r < 4; r++) {
      const int it = it0 + r * cn;
      if (it < P7_CV) {
        const float* src = it < 8192 ? p.peer_u + (size_t)it * 2048 : p.peer_v + (size_t)(it - 8192) * 2048;
        const float4* s4 = (const float4*)src + tid * 2;
        va[r] = s4[0]; vb[r] = s4[1];
      }
    }
#pragma unroll
    for (int r = 0; r < 4; r++) {
      const int it = it0 + r * cn;
      if (it < P7_CV) {
        unsigned char* dst = it < 8192 ? (unsigned char*)p.ub + (size_t)it * 2048 : (unsigned char*)p.vb + (size_t)(it - 8192) * 2048;
        const float sc = it < 8192 ? U_SCALE : V_SCALE;
        const float4 a = va[r], b = vb[r];
        int lo = __builtin_amdgcn_cvt_pk_fp8_f32(a.x * sc, a.y * sc, 0, false);
        lo = __builtin_amdgcn_cvt_pk_fp8_f32(a.z * sc, a.w * sc, lo, true);
        int hi = __builtin_amdgcn_cvt_pk_fp8_f32(b.x * sc, b.y * sc, 0, false);
        hi = __builtin_amdgcn_cvt_pk_fp8_f32(b.z * sc, b.w * sc, hi, true);
        *((uint2*)dst + tid) = make_uint2((unsigned)lo, (unsigned)hi);
      }
    }
  }
}

__device__ void phase9(const P& p, int bid, int nb, char* smem) {
  const int tid = TIDX, lane = tid & 63, wid = tid >> 6, wr = wid >> 1, wc = wid & 1, fr = lane & 15,
            fq = lane >> 4;
  TileIter ti(bid, nb, 136, 16);
  int mt, nt;
  while (ti.next(mt, nt)) {
    f32x4 acc[4][4];
    zero_acc(acc);
    gemm_tile_glds(p.xn, D, mt * 128, p.wqT, D, nt * 128, D, acc, smem);
    u16* Lq = (u16*)smem;
    ACC_FOREACH({ Lq[row * 136 + col] = f2bf(acc[m][n][j]); })
    __syncthreads();
    f32x4 sc[4][4];
    zero_acc(sc);
    const u16* kb = p.keysb + (size_t)nt * 128 * 128;
#pragma unroll 1
    for (int s = 0; s < 4; s++) {
      bf16x8 af[4], bfr[4];
#pragma unroll
      for (int m = 0; m < 4; m++) af[m] = *(const bf16x8*)((const char*)Lq + (wr * 64 + m * 16 + fr) * 272 + s * 64 + fq * 16);
#pragma unroll
      for (int n = 0; n < 4; n++) bfr[n] = *(const bf16x8*)(kb + (size_t)(wc * 64 + n * 16 + fr) * 128 + s * 32 + fq * 8);
#pragma unroll
      for (int m = 0; m < 4; m++)
#pragma unroll
        for (int n = 0; n < 4; n++) sc[m][n] = __builtin_amdgcn_mfma_f32_16x16x32_bf16(af[m], bfr[n], sc[m][n], 0, 0, 0);
    }
    __syncthreads();
    float* Ls = (float*)smem;
#pragma unroll
    for (int m = 0; m < 4; m++)
#pragma unroll
      for (int n = 0; n < 4; n++)
#pragma unroll
        for (int j = 0; j < 4; j++) {
          const int kc = wc * 64 + n * 16 + fr;
          int sb = __float_as_int(sc[m][n][j]);
          sb ^= (sb >> 31) & 0x7fffffff;
          ((int*)Ls)[(wr * 64 + m * 16 + fq * 4 + j) * 132 + kc] = (sb & ~127) | (127 - kc);
        }
    __syncthreads();
    {
      const int row = tid >> 1, half = tid & 1;
      int* Li = (int*)Ls + row * 132 + half * 64;
      const size_t ob = ((size_t)(mt * 128 + row) * 16 + nt) * 16;
      for (int r = 0; r < 16; r++) {
        int best = (int)0x80000000;
#pragma unroll
        for (int i = 0; i < 16; i++) {
          const int4 k4 = *(const int4*)(Li + 4 * i);
          best = max(max(best, k4.x), max(k4.y, max(k4.z, k4.w)));
        }
        best = max(best, __shfl_xor(best, 1, 64));
        const int bi = 127 - (best & 127);
        if ((bi >> 6) == half) Li[bi & 63] = (int)0x80000000;
        if (half == 0) {
          int vb = best & ~127;
          vb ^= (vb >> 31) & 0x7fffffff;
          p.topv[ob + r] = __int_as_float(vb);
          p.topi[ob + r] = bi;
        }
      }
    }
    __syncthreads();
  }
}

__device__ __forceinline__ void cand_ij(int lane, int& ci, int& cj) {
  int i = 0, rem = lane;
#pragma unroll
  for (int r = 0; r < 16; r++) {
    const int cnt = 16 / (r + 1);
    if (i == r && rem >= cnt) { rem -= cnt; i = r + 1; }
  }
  ci = i; cj = rem;
}

typedef __attribute__((ext_vector_type(2))) __bf16 bf2_t;
__device__ __forceinline__ float dot2bf(unsigned a, unsigned b, float c) {
  return __builtin_amdgcn_fdot2_f32_bf16(__builtin_bit_cast(bf2_t, a), __builtin_bit_cast(bf2_t, b), c, false);
}
template <int CTRL, int RM>
__device__ __forceinline__ float dppf_m(float x) {
  return __int_as_float(__builtin_amdgcn_update_dpp(0, __float_as_int(x), CTRL, RM, 0xf, false));
}
__device__ __forceinline__ float wave_sum_l63(float x) {
  x += dppf<0xB1>(x);
  x += dppf<0x4E>(x);
  x += dppf<0x141>(x);
  x += dppf<0x140>(x);
  x += dppf_m<0x142, 0xA>(x);
  x += dppf_m<0x143, 0xC>(x);
  return x;
}
__device__ __forceinline__ float readlane_f(float x, int l) {
  return __int_as_float(__builtin_amdgcn_readlane(__float_as_int(x), l));
}
__device__ __forceinline__ void axpy8(float* acc, float w, uint4 v) {
  acc[0] += w * bflo(v.x); acc[1] += w * bfhi(v.x); acc[2] += w * bflo(v.y); acc[3] += w * bfhi(v.y);
  acc[4] += w * bflo(v.z); acc[5] += w * bfhi(v.z); acc[6] += w * bflo(v.w); acc[7] += w * bfhi(v.w);
}

typedef float f2_t __attribute__((ext_vector_type(2)));
__device__ __forceinline__ void fp8x16_to_f32(const uint4 v, float* o) {
  const unsigned w[4] = {v.x, v.y, v.z, v.w};
#pragma unroll
  for (int i = 0; i < 4; i++) {
    const f2_t lo = __builtin_amdgcn_cvt_pk_f32_fp8((int)w[i], false);
    const f2_t hi = __builtin_amdgcn_cvt_pk_f32_fp8((int)w[i], true);
    o[4 * i] = lo.x; o[4 * i + 1] = lo.y; o[4 * i + 2] = hi.x; o[4 * i + 3] = hi.y;
  }
}

__device__ void phase10(const P& p, int bid, int nb) {
  const int lane = TIDX & 63, wid = TIDX >> 6;
  int ci, cj; cand_ij(lane < 50 ? lane : 0, ci, cj);
  const unsigned char* ub8 = (const unsigned char*)p.ub;
  const unsigned char* vb8 = (const unsigned char*)p.vb;
  for (int it = bid; it < NT / 4; it += nb) {
    const int n = it * 4 + wid;
    int seq, t, T; tok2seq(n, seq, t, T);
    float xv[16];
    {
      const uint4 a = *(const uint4*)(p.xn + (size_t)n * D + lane * 16), b = *(const uint4*)(p.xn + (size_t)n * D + lane * 16 + 8);
      const unsigned as[4] = {a.x, a.y, a.z, a.w}, bs[4] = {b.x, b.y, b.z, b.w};
#pragma unroll
      for (int e = 0; e < 4; e++) { xv[2 * e] = bflo(as[e]); xv[2 * e + 1] = bfhi(as[e]); xv[8 + 2 * e] = bflo(bs[e]); xv[8 + 2 * e + 1] = bfhi(bs[e]); }
    }
    float acc[16];
#pragma unroll
    for (int e = 0; e < 16; e++) acc[e] = 0.f;
#pragma unroll 1
    for (int h = 0; h < 8; h++) {
      const size_t base = ((size_t)n * 16 + h * 2) * 16;
      float cand = -INFINITY; int eid = 0;
      if (lane < 50) {
        cand = p.topv[base + ci] + p.topv[base + 16 + cj];
        eid = p.topi[base + ci] * 128 + p.topi[base + 16 + cj];
      }
      int rank = 0;
#pragma unroll
      for (int m = 0; m < 50; m++) {
        const float cm = readlane_f(cand, m);
        rank += ((cm > cand) || (cm == cand && m < lane)) ? 1 : 0;
      }
      const bool sel = (lane < 50) && (rank < 16);
      unsigned long long mask = __ballot(sel);
      const float mx = readlane_f(cand, __builtin_ctzll(__ballot(sel && rank == 0)));
      const float ex = sel ? __expf(cand - mx) : 0.f;
      const float den = readlane_f(wave_sum_l63(ex), 63);
      const float gate = ex / den;
#pragma unroll 1
      for (int hf = 0; hf < 2; hf++) {
        int ek[8]; float gk[8];
#pragma unroll
        for (int k = 0; k < 8; k++) {
          const int src = __builtin_ctzll(mask);
          mask &= mask - 1;
          ek[k] = __builtin_amdgcn_readlane(eid, src);
          gk[k] = readlane_f(gate, src);
        }
        uint4 uu[8], vv[8];
#pragma unroll
        for (int j = 0; j < 8; j++) uu[j] = *(const uint4*)(ub8 + (size_t)ek[j] * D + lane * 16);
#pragma unroll
        for (int j = 0; j < 8; j++) vv[j] = *(const uint4*)(vb8 + (size_t)ek[j] * D + lane * 16);
        float dv = 0.f;
#pragma unroll
        for (int j = 0; j < 8; j++) {
          float uf[16];
          fp8x16_to_f32(uu[j], uf);
          float d0 = 0.f, d1 = 0.f;
#pragma unroll
          for (int e = 0; e < 8; e++) { d0 += uf[2 * e] * xv[2 * e]; d1 += uf[2 * e + 1] * xv[2 * e + 1]; }
          const float ds = readlane_f(wave_sum_l63(d0 + d1), 63);
          dv = (lane == j) ? ds : dv;
        }
        dv *= (1.f / U_SCALE);
        const float act = 0.5f * dv * (1.f + erff(dv * 0.70710678118654752f));
#pragma unroll
        for (int j = 0; j < 8; j++) {
          const float w = readlane_f(act, j) * gk[j] * (1.f / V_SCALE);
          float vf[16];
          fp8x16_to_f32(vv[j], vf);
#pragma unroll
          for (int e = 0; e < 16; e++) acc[e] += w * vf[e];
        }
      }
    }
    float* yr = p.out + O_Y + (size_t)n * D + lane * 16;
    const float* md = p.mod + (size_t)seq * 8192 + lane * 16;
    float x2[16];
    float ss = 0.f;
#pragma unroll
    for (int q4 = 0; q4 < 4; q4++) {
      const float4 a = *(const float4*)(yr + q4 * 4), g = *(const float4*)(md + 5120 + q4 * 4);
      x2[q4 * 4 + 0] = a.x + g.x * acc[q4 * 4 + 0]; x2[q4 * 4 + 1] = a.y + g.y * acc[q4 * 4 + 1];
      x2[q4 * 4 + 2] = a.z + g.z * acc[q4 * 4 + 2]; x2[q4 * 4 + 3] = a.w + g.w * acc[q4 * 4 + 3];
    }
#pragma unroll
    for (int e = 0; e < 16; e++) ss += x2[e] * x2[e];
    ss = readlane_f(wave_sum_l63(ss), 63);
    const float rstd = rsqrtf(ss * (1.f / 1024.f) + 1e-6f);
#pragma unroll
    for (int q4 = 0; q4 < 4; q4++) {
      const float4 fg = *(const float4*)(p.final_g + lane * 16 + q4 * 4), sc = *(const float4*)(md + 7168 + q4 * 4),
                   sh = *(const float4*)(md + 6144 + q4 * 4);
      float4 o;
      o.x = x2[q4 * 4 + 0] * rstd * fg.x * (1.f + sc.x) + sh.x;
      o.y = x2[q4 * 4 + 1] * rstd * fg.y * (1.f + sc.y) + sh.y;
      o.z = x2[q4 * 4 + 2] * rstd * fg.z * (1.f + sc.z) + sh.z;
      o.w = x2[q4 * 4 + 3] * rstd * fg.w * (1.f + sc.w) + sh.w;
      *(float4*)(yr + q4 * 4) = o;
    }
  }
}

#define XB_XCNT(j) (256 + 64 * (j))
#define XB_XSUB(j) (1280 + 64 * (j))
#define XB_XGEN(j) (2304 + 64 * (j))
#define XB_TOP 3328
#define XB_TOPGEN 3392
#define XB_WORDS 4096
__device__ __forceinline__ unsigned xb_ld(unsigned* p) { return __hip_atomic_load(p, __ATOMIC_RELAXED, __HIP_MEMORY_SCOPE_AGENT); }
__device__ __forceinline__ unsigned xb_add(unsigned* p, unsigned v) { return __hip_atomic_fetch_add(p, v, __ATOMIC_RELAXED, __HIP_MEMORY_SCOPE_AGENT); }
__device__ __forceinline__ unsigned xb_xcc_id() { return (unsigned)__builtin_amdgcn_s_getreg((3 << 11) | 20) & 0xFu; }
__device__ __forceinline__ void grid_barrier(unsigned* bar, volatile unsigned* xst) {
  asm volatile("s_waitcnt vmcnt(0)" ::: "memory");
  __syncthreads();
  if (TIDX == 0) {
    __builtin_amdgcn_s_waitcnt(0);
    const unsigned x = xst[0], nloc = xst[1], nx = xst[2];
    const unsigned old = xb_add(&bar[XB_XSUB(x)], 1u);
    const unsigned gen = old / nloc;
    if (old + 1u == (gen + 1u) * nloc) {
      __builtin_amdgcn_fence(__ATOMIC_RELEASE, "agent");
      asm volatile("s_waitcnt vmcnt(0)" ::: "memory");
      const unsigned og = xb_add(&bar[XB_TOP], 1u);
      const unsigned tg = og / nx;
      if (og + 1u == (tg + 1u) * nx) xb_add(&bar[XB_TOPGEN], 1u);
      else while (xb_ld(&bar[XB_TOPGEN]) == tg) __builtin_amdgcn_s_sleep(1);
      __builtin_amdgcn_fence(__ATOMIC_ACQUIRE, "agent");
      xb_add(&bar[XB_XGEN(x)], 1u);
      asm volatile("s_waitcnt vmcnt(0)" ::: "memory");
    } else {
      while (xb_ld(&bar[XB_XGEN(x)]) == gen) __builtin_amdgcn_s_sleep(1);
      __builtin_amdgcn_fence(__ATOMIC_ACQUIRE, "agent");
      asm volatile("s_waitcnt vmcnt(0)" ::: "memory");
    }
  }
  __syncthreads();
}

template <int PH>
__device__ __forceinline__ void run_phase(const P& p, int bid, int nb, char* smem) {
  if constexpr (PH == 0) phase0(p, bid, nb, smem);
  if constexpr (PH == 1) phase_norm<false>(p, bid, nb);
  if constexpr (PH == 2) phase2(p, bid, nb, smem);
  if constexpr (PH == 3) phase3(p, bid, nb, smem);
  if constexpr (PH == 4) phase4(p, bid, nb, smem);
  if constexpr (PH == 5) phase5(p, bid, nb);
  if constexpr (PH == 6) phase6(p, bid, nb, smem);
  if constexpr (PH == 7) phase7(p, bid, nb, smem);
  if constexpr (PH == 8) phase_norm<true>(p, bid, nb);
  if constexpr (PH == 9) phase9(p, bid, nb, smem);
  if constexpr (PH == 10) phase10(p, bid, nb);
  if constexpr (PH == 11) phase3b(p, bid, nb, smem);
}

template <int PH>
__global__ void __launch_bounds__(NTHREADS, 2) k_phase(P p) {
  extern __shared__ __attribute__((aligned(16))) char smem[];
  run_phase<PH>(p, blockIdx.x, gridDim.x, smem);
}

#if MEGA
__global__ void __launch_bounds__(NTHREADS, 2) k_mega(P p) {
  extern __shared__ __attribute__((aligned(16))) char smem[];
  cg::grid_group grid = cg::this_grid();
  const int bid = blockIdx.x, nb = gridDim.x;
#ifndef PROBE_ALL2
#define PROBE_ALL2 0
#endif
#ifndef PROBE_MASK
#define PROBE_MASK 0
#endif
#ifndef PROBE_SYNCS
#define PROBE_SYNCS 0
#endif
  volatile unsigned* xst = (volatile unsigned*)(smem + LDS_BYTES - 16);
  if (TIDX == 0) { const unsigned xcc0 = xb_xcc_id(); xst[0] = xcc0; xb_add(&p.bar[XB_XCNT(xcc0)], 1u); }
#define GSYNC(k)                                                                                 \
  {                                                                                              \
    if ((k) == 0) {                                                                              \
      grid.sync();                                                                               \
      if (TIDX == 0) {                                                                    \
        unsigned cnt = 0;                                                                        \
        for (unsigned j = 0; j < 16; ++j) cnt += xb_ld(&p.bar[XB_XCNT(j)]) > 0u ? 1u : 0u;       \
        xst[2] = cnt; xst[1] = xb_ld(&p.bar[XB_XCNT(xst[0])]);                                   \
      }                                                                                          \
    } else grid_barrier(p.bar, xst);                                                             \
  }
#define RUNPH(k)                                                       \
  run_phase<k>(p, bid, nb, smem); GSYNC(k)                             \
  if (PROBE_MASK & (1 << k)) { run_phase<k>(p, bid, nb, smem); GSYNC(1) }
#pragma unroll 1
  for (int rep = 0; rep < 1 + PROBE_ALL2; rep++) {
    RUNPH(0)
#pragma unroll 1
    for (int i = 0; i < PROBE_SYNCS; i++) GSYNC(1)
    RUNPH(1) RUNPH(2) RUNPH(3) RUNPH(11) RUNPH(4) RUNPH(5) RUNPH(6) RUNPH(7) RUNPH(8) RUNPH(9)
  }
  run_phase<10>(p, bid, nb, smem);
}
#endif

template <int PH>
static void launch_phase(const P& p, int grid, hipStream_t stream) {
  static bool attr = false;
  if (!attr) { hipFuncSetAttribute((const void*)k_phase<PH>, hipFuncAttributeMaxDynamicSharedMemorySize, LDS_BYTES); attr = true; }
  hipLaunchKernelGGL(k_phase<PH>, dim3(grid), dim3(NTHREADS), LDS_BYTES, stream, p);
}

extern "C" void kernel_launch(void* const* d_in, const int* in_sizes, int n_in, void* d_out, int out_size, void* d_ws,
                              size_t ws_size, hipStream_t stream) {
  P p{};
  const float** fp = (const float**)&p;
  for (int i = 0; i < 40; i++) fp[i] = (const float*)d_in[i];
  p.out = (float*)d_out;
  char* ws = (char*)d_ws;
  size_t off = 0;
  auto take = [&](size_t bytes) { char* r = ws + off; off += (bytes + 255) & ~(size_t)255; return r; };
  p.bar = (unsigned*)take(XB_WORDS * 4);
  p.w_inT = (u16*)take((size_t)INCOLS * D * 2);
  p.w_paT = (u16*)take((size_t)1024 * 512 * 2);
  p.w_pbT = (u16*)take((size_t)1024 * 1024 * 2);
  p.w_outT = (u16*)take((size_t)1024 * 1024 * 2);
  p.wqT = (u16*)take((size_t)2048 * 1024 * 2);
  p.keysb = (u16*)take((size_t)262144 * 2);
  p.mod = (float*)take((size_t)NSEQ * 8192 * 4);
  p.dtb = (float*)take((size_t)NT * 16 * 4);
  p.decb = (float*)take((size_t)NT * 16 * 4);
  p.xn = (u16*)take((size_t)NROWS * D * 2);
  p.proj = (u16*)take((size_t)NROWS * PCOLS * 2);
  p.prep = (u16*)take((size_t)NT * 3584 * 2);
  p.w2T = (u16*)take(512 * 64 * 2);
  p.a2T = (u16*)take(512 * 64 * 2);
  p.g2T = (u16*)take(512 * 128 * 2);
  p.lora = (u16*)take((size_t)NT * 256 * 2);
  if (off > ws_size) { fprintf(stderr, "workspace too small: need %zu have %zu\n", off, ws_size); return; }
  p.merged = p.prep;
  p.ub = p.proj;
  p.vb = p.proj + (size_t)16384 * 1024;
  p.topv = (float*)(p.proj + (size_t)2 * 16384 * 1024);
  p.topi = (int*)(p.topv + (size_t)NT * 256);
  p.xc = (u16*)d_out;
  p.oa = (u16*)d_out;
  p.ob = (u16*)d_out + (size_t)NT * 512;

  static int grid = 0;
  if (!grid) {
    int dev = 0, cus = 0, per_cu = 0;
    hipGetDevice(&dev);
    hipDeviceGetAttribute(&cus, hipDeviceAttributeMultiprocessorCount, dev);
#if MEGA
    hipFuncSetAttribute((const void*)k_mega, hipFuncAttributeMaxDynamicSharedMemorySize, LDS_BYTES);
    hipOccupancyMaxActiveBlocksPerMultiprocessor(&per_cu, k_mega, NTHREADS, LDS_BYTES);
    if (per_cu > 2) per_cu = 2;
#else
    per_cu = 2;
#endif
    if (per_cu < 1) per_cu = 1;
    grid = cus * per_cu;
  }
  hipMemsetAsync(p.mod, 0, (size_t)NSEQ * 8192 * 4, stream);
#if MEGA
  hipMemsetAsync(p.bar, 0, XB_WORDS * 4, stream);
  void* args[] = {&p};
  hipError_t e = hipLaunchCooperativeKernel((void*)k_mega, dim3(grid), dim3(NTHREADS), args, LDS_BYTES, stream);
  if (e != hipSuccess) fprintf(stderr, "cooperative launch failed: %s (grid %d)\n", hipGetErrorString(e), grid);
#else
  launch_phase<0>(p, grid, stream);
  launch_phase<1>(p, grid, stream);
  launch_phase<2>(p, grid, stream);
  launch_phase<3>(p, grid, stream);
  launch_phase<11>(p, grid, stream);
  launch_phase<4>(p, grid, stream);
  launch_phase<5>(p, grid, stream);
  launch_phase<6>(p, grid, stream);
  launch_phase<7>(p, grid, stream);
  launch_phase<8>(p, grid, stream);
  launch_phase<9>(p, grid, stream);
  launch_phase<10>(p, grid, stream);
#endif
}
```
